# Optimizing an MI355X kernel written in HIP

```python
import math
import jax, jax.numpy as jnp
from jax import lax
import numpy as np

D_MODEL = 1024
BATCH = 16
SEQ = 2048
DEPTH = 1
DEC_BATCH = 8
DEC_SEQ = 2048
PAST_LEN = 128

N_META = 16
GRID_W = 64
CONV_WIDTH = 512
CONV_GROUPS = 8
CONV_KERNEL = 3
N_HEADS = 8
N_KV_HEADS = 2
Q_PER_KV = N_HEADS // N_KV_HEADS
HEAD_DIM = 64
AXIS_DIM = HEAD_DIM // 2
ROPE_THETA = 10000.0
Q_BLOCK = 128
ATTN_WIDTH = N_HEADS * HEAD_DIM
KV_WIDTH = N_KV_HEADS * HEAD_DIM
MIX_WIDTH = CONV_WIDTH + ATTN_WIDTH
IN_WIDTH = 3 * CONV_WIDTH + ATTN_WIDTH + 2 * KV_WIDTH
IN_SPLITS = [CONV_WIDTH, 2 * CONV_WIDTH, 3 * CONV_WIDTH,
             3 * CONV_WIDTH + ATTN_WIDTH, 3 * CONV_WIDTH + ATTN_WIDTH + KV_WIDTH]
PEER_HEADS = 8
PEER_NKEYS = 128
PEER_EXPERTS = PEER_NKEYS * PEER_NKEYS
PEER_QDIM = 256
PEER_HALF = PEER_QDIM // 2
PEER_TOPK = 16
PEER_CHUNK = 256
EPS = 1e-6

kernel_name = 'hymba_conv_gqa_peer_encoder'


def rmsnorm(x, g):
    x32 = x.astype(jnp.float32)
    y = x32 * lax.rsqrt(jnp.mean(x32 * x32, axis=-1, keepdims=True) + EPS)
    return (y * g.astype(jnp.float32)).astype(x.dtype)


def group_rmsnorm(x, g, n_groups):
    shp = x.shape
    x32 = x.astype(jnp.float32).reshape(shp[:-1] + (n_groups, shp[-1] // n_groups))
    y = x32 * lax.rsqrt(jnp.mean(x32 * x32, axis=-1, keepdims=True) + EPS)
    return (y.reshape(shp) * g.astype(jnp.float32)).astype(x.dtype)


def axial_rope_tables(n_tokens):
    rows = n_tokens // GRID_W
    row_ids = jnp.repeat(jnp.arange(rows, dtype=jnp.int32), GRID_W)
    col_ids = jnp.tile(jnp.arange(GRID_W, dtype=jnp.int32), rows)
    meta = jnp.zeros((N_META,), jnp.int32)
    row = jnp.concatenate([meta, row_ids]).astype(jnp.float32)
    col = jnp.concatenate([meta, col_ids]).astype(jnp.float32)
    freqs = ROPE_THETA ** (-jnp.arange(0, AXIS_DIM, 2, dtype=jnp.float32) / AXIS_DIM)
    ang_r = row[:, None] * freqs[None, :]
    ang_c = col[:, None] * freqs[None, :]
    return (jnp.cos(ang_r), jnp.sin(ang_r), jnp.cos(ang_c), jnp.sin(ang_c))


def _rotate(x, cos, sin):
    half = x.shape[-1] // 2
    x1, x2 = x[..., :half], x[..., half:]
    cos = cos[None, :, None, :]
    sin = sin[None, :, None, :]
    return jnp.concatenate([x1 * cos - x2 * sin, x2 * cos + x1 * sin], axis=-1)


def apply_axial_rope(x, tables):
    cos_r, sin_r, cos_c, sin_c = tables
    x32 = x.astype(jnp.float32)
    out = jnp.concatenate([_rotate(x32[..., :AXIS_DIM], cos_r, sin_r),
                           _rotate(x32[..., AXIS_DIM:], cos_c, sin_c)], axis=-1)
    return out.astype(x.dtype)


def attend_block(qb, k, v):
    s = jnp.einsum('bqgrd,bkgd->bgrqk', qb, k, preferred_element_type=jnp.float32) * (HEAD_DIM ** -0.5)
    p = jax.nn.softmax(s, axis=-1).astype(v.dtype)
    return jnp.einsum('bgrqk,bkgd->bqgrd', p, v)


def gqa_attention(q, k, v):
    Bx, L = q.shape[0], q.shape[1]
    n = L - N_META
    out_meta = attend_block(q[:, :N_META], k, v)
    q_real = q[:, N_META:].reshape(Bx, n // Q_BLOCK, Q_BLOCK, N_KV_HEADS, Q_PER_KV, HEAD_DIM)
    q_real = jnp.moveaxis(q_real, 1, 0)
    out_real = lax.map(lambda qb: attend_block(qb, k, v), q_real)
    out_real = jnp.moveaxis(out_real, 0, 1).reshape(Bx, n, N_KV_HEADS, Q_PER_KV, HEAD_DIM)
    return jnp.concatenate([out_meta, out_real], axis=1)


def depthwise_conv3(u, w):
    up = jnp.pad(u, ((0, 0), (1, 1), (0, 0)))
    return up[:, :-2] * w[0] + up[:, 1:-1] * w[1] + up[:, 2:] * w[2]


def peer_ffn(x, wq, subkeys, u_tab, v_tab):
    Bx, L, D = x.shape
    T = Bx * L
    xf = x.reshape(T, D)
    q = (xf @ wq).reshape(T, PEER_HEADS, 2, PEER_HALF)
    s = jnp.einsum('thpc,hpnc->thpn', q, subkeys, preferred_element_type=jnp.float32)
    sv, si = lax.top_k(s, PEER_TOPK)
    cand = (sv[..., 0, :, None] + sv[..., 1, None, :]).reshape(T, PEER_HEADS, PEER_TOPK * PEER_TOPK)
    cand_idx = (si[..., 0, :, None] * PEER_NKEYS + si[..., 1, None, :]).reshape(T, PEER_HEADS, PEER_TOPK * PEER_TOPK)
    cv, cp = lax.top_k(cand, PEER_TOPK)
    eidx = jnp.take_along_axis(cand_idx, cp, axis=-1)
    gates = jax.nn.softmax(cv, axis=-1).astype(x.dtype)
    pad = (-T) % PEER_CHUNK
    nc = (T + pad) // PEER_CHUNK
    xp = jnp.pad(xf, ((0, pad), (0, 0))).reshape(nc, PEER_CHUNK, D)
    ip = jnp.pad(eidx, ((0, pad), (0, 0), (0, 0))).reshape(nc, PEER_CHUNK, PEER_HEADS, PEER_TOPK)
    gp = jnp.pad(gates, ((0, pad), (0, 0), (0, 0))).reshape(nc, PEER_CHUNK, PEER_HEADS, PEER_TOPK)

    def chunk(args):
        xc, ic, gc = args
        uc = jnp.take(u_tab, ic, axis=0)
        a = jax.nn.gelu(jnp.einsum('thkd,td->thk', uc, xc), approximate=False) * gc
        vc = jnp.take(v_tab, ic, axis=0)
        return jnp.einsum('thk,thkd->td', a, vc)

    out = lax.map(chunk, (xp, ip, gp))
    return out.reshape(nc * PEER_CHUNK, D)[:T].reshape(Bx, L, D)


def layer(h, tables, norm_mix_g, w_in, conv_w, q_norm_g, k_norm_g, conv_out_g, attn_out_g,
          w_out, norm_ffn_g, peer_wq, peer_subkeys, peer_u, peer_v):
    Bx, L, _ = h.shape
    xn = rmsnorm(h, norm_mix_g)
    z = xn @ w_in
    gate_b, gate_c, hc, q, k, v = jnp.split(z, IN_SPLITS, axis=-1)
    y_conv = gate_b * depthwise_conv3(gate_c * hc, conv_w)
    y_conv = group_rmsnorm(y_conv, conv_out_g, CONV_GROUPS)
    q = rmsnorm(q.reshape(Bx, L, N_HEADS, HEAD_DIM), q_norm_g)
    k = rmsnorm(k.reshape(Bx, L, N_KV_HEADS, HEAD_DIM), k_norm_g)
    q = apply_axial_rope(q, tables).reshape(Bx, L, N_KV_HEADS, Q_PER_KV, HEAD_DIM)
    k = apply_axial_rope(k, tables)
    v = v.reshape(Bx, L, N_KV_HEADS, HEAD_DIM)
    y_attn = gqa_attention(q, k, v).reshape(Bx, L, ATTN_WIDTH)
    y_attn = group_rmsnorm(y_attn, attn_out_g, N_HEADS)
    h = h + jnp.concatenate([y_conv, y_attn], axis=-1) @ w_out
    h = h + peer_ffn(rmsnorm(h, norm_ffn_g), peer_wq, peer_subkeys, peer_u, peer_v)
    return h


def encode(x, meta_tokens, norm_mix_g, w_in, conv_w, q_norm_g, k_norm_g, conv_out_g, attn_out_g,
           w_out, norm_ffn_g, peer_wq, peer_subkeys, peer_u, peer_v):
    Bx, n, _ = x.shape
    meta = jnp.broadcast_to(meta_tokens.astype(x.dtype)[None], (Bx, N_META, D_MODEL))
    h = jnp.concatenate([meta, x], axis=1)
    tables = axial_rope_tables(n)
    for l in range(DEPTH):
        h = layer(h, tables, norm_mix_g[l], w_in[l], conv_w[l], q_norm_g[l], k_norm_g[l],
                  conv_out_g[l], attn_out_g[l], w_out[l], norm_ffn_g[l], peer_wq[l],
                  peer_subkeys[l], peer_u[l], peer_v[l])
    return h[:, N_META:]


def setup_inputs(seed: int = 0) -> dict:
    key = jax.random.key(seed)
    ks = jax.random.split(key, 16)
    nrm = jax.random.normal
    f32 = jnp.float32
    return {
        'x_prompt': nrm(ks[0], (BATCH, SEQ, D_MODEL), f32),
        'x_sample': nrm(ks[1], (DEC_BATCH, DEC_SEQ, D_MODEL), f32),
        'meta_tokens': nrm(ks[2], (N_META, D_MODEL), f32),
        'norm_mix_g': 1.0 + 0.05 * nrm(ks[3], (DEPTH, D_MODEL), f32),
        'w_in': nrm(ks[4], (DEPTH, D_MODEL, IN_WIDTH), f32) * D_MODEL ** -0.5,
        'conv_w': nrm(ks[5], (DEPTH, CONV_KERNEL, CONV_WIDTH), f32) * CONV_KERNEL ** -0.5,
        'q_norm_g': 1.0 + 0.05 * nrm(ks[6], (DEPTH, HEAD_DIM), f32),
        'k_norm_g': 1.0 + 0.05 * nrm(ks[7], (DEPTH, HEAD_DIM), f32),
        'conv_out_g': 1.0 + 0.05 * nrm(ks[8], (DEPTH, CONV_WIDTH), f32),
        'attn_out_g': 1.0 + 0.05 * nrm(ks[9], (DEPTH, ATTN_WIDTH), f32),
        'w_out': nrm(ks[10], (DEPTH, MIX_WIDTH, D_MODEL), f32) * MIX_WIDTH ** -0.5,
        'norm_ffn_g': 1.0 + 0.05 * nrm(ks[11], (DEPTH, D_MODEL), f32),
        'peer_wq': nrm(ks[12], (DEPTH, D_MODEL, PEER_HEADS * PEER_QDIM), f32) * D_MODEL ** -0.5,
        'peer_subkeys': nrm(ks[13], (DEPTH, PEER_HEADS, 2, PEER_NKEYS, PEER_HALF), f32) * PEER_HALF ** -0.5,
        'peer_u': nrm(ks[14], (DEPTH, PEER_EXPERTS, D_MODEL), f32) * D_MODEL ** -0.5,
        'peer_v': nrm(ks[15], (DEPTH, PEER_EXPERTS, D_MODEL), f32) * 0.25,
    }


def reference(x_prompt, x_sample, meta_tokens, norm_mix_g, w_in, conv_w, q_norm_g, k_norm_g,
              conv_out_g, attn_out_g, w_out, norm_ffn_g, peer_wq, peer_subkeys, peer_u, peer_v):
    y_prompt = encode(x_prompt, meta_tokens, norm_mix_g, w_in, conv_w, q_norm_g, k_norm_g,
                      conv_out_g, attn_out_g, w_out, norm_ffn_g, peer_wq, peer_subkeys, peer_u, peer_v)
    y_sample = encode(x_sample, meta_tokens, norm_mix_g, w_in, conv_w, q_norm_g, k_norm_g,
                      conv_out_g, attn_out_g, w_out, norm_ffn_g, peer_wq, peer_subkeys, peer_u, peer_v)
    return (y_prompt, y_sample)
```

```cpp
#include <hip/hip_runtime.h>
#include <hip/hip_cooperative_groups.h>
#include <cstdint>
#include <cstdio>
namespace cg = cooperative_groups;

#ifndef MK_N_LAUNCHES
#define MK_N_LAUNCHES 9
#endif

typedef unsigned short bf16_t;
typedef short bf16x8 __attribute__((ext_vector_type(8)));
typedef float f32x4 __attribute__((ext_vector_type(4)));
typedef unsigned u32x4 __attribute__((ext_vector_type(4)));
typedef unsigned u32x2 __attribute__((ext_vector_type(2)));

constexpr int NB = 24, NBP = 16, SEQ = 2048, DM = 1024, NTOK = NB * SEQ;
constexpr int NMETA = 16, INW = 2304, KROWS = 2112;
constexpr int NKEYS = SEQ + NMETA;
constexpr int PQ = 2048;
constexpr float EPS = 1e-6f;
constexpr float C2 = 0.125f * 1.4426950408889634f;
constexpr int NWAVES = 8, NTHR = 512;
constexpr int LDS_BYTES = 147456;
constexpr int NPHASE = 9;

constexpr size_t MiB = 1u << 20;
constexpr size_t WS_CTL = 0;
constexpr size_t WS_WIN = 1 * MiB;
constexpr size_t WS_WOUT = 6 * MiB;
constexpr size_t WS_WQ = 8 * MiB;
constexpr size_t WS_SUBK = 12 * MiB;
constexpr size_t WS_ZMETA = 12 * MiB + 512 * 1024;
constexpr size_t WS_UT = 13 * MiB;
constexpr size_t WS_VT = 45 * MiB;
constexpr size_t WS_KB = 77 * MiB;
constexpr size_t WS_VB = 90 * MiB;
constexpr size_t WS_XA = 103 * MiB;
constexpr size_t WS_ZB = 199 * MiB;
constexpr size_t WS_QB = 415 * MiB;
constexpr size_t WS_END = 463 * MiB;

struct Args {
    const float* xp; const float* xs; const float* meta; const float* g_mix; const float* w_in; const float* conv_w;
    const float* qg; const float* kg; const float* conv_g; const float* attn_g; const float* w_out; const float* g_ffn;
    const float* wq; const float* subk; const float* pu; const float* pv;
    float* out; unsigned char* ws; int ph_lo, ph_hi;
};

__device__ __forceinline__ unsigned f2bf(float f) { unsigned u = __builtin_bit_cast(unsigned, f); return (u + 0x7fffu + ((u >> 16) & 1u)) >> 16; }
__device__ __forceinline__ unsigned pk2(float lo, float hi) { return f2bf(lo) | (f2bf(hi) << 16); }
__device__ __forceinline__ float bflo(unsigned w) { return __builtin_bit_cast(float, w << 16); }
__device__ __forceinline__ float bfhi(unsigned w) { return __builtin_bit_cast(float, w & 0xffff0000u); }
__device__ __forceinline__ float bf2f(bf16_t h) { return __builtin_bit_cast(float, (unsigned)h << 16); }
__device__ __forceinline__ void unpack8(u32x4 w, float* f) {
    f[0] = bflo(w.x); f[1] = bfhi(w.x); f[2] = bflo(w.y); f[3] = bfhi(w.y); f[4] = bflo(w.z); f[5] = bfhi(w.z); f[6] = bflo(w.w); f[7] = bfhi(w.w);
}
__device__ __forceinline__ u32x4 pack8(const float* f) { u32x4 w; w.x = pk2(f[0], f[1]); w.y = pk2(f[2], f[3]); w.z = pk2(f[4], f[5]); w.w = pk2(f[6], f[7]); return w; }
__device__ __forceinline__ float wave_sum(float v) {
#pragma unroll
    for (int o = 1; o < 64; o <<= 1) v += __shfl_xor(v, o);
    return v;
}
__device__ __forceinline__ float wave_max(float v) {
#pragma unroll
    for (int o = 1; o < 64; o <<= 1) v = fmaxf(v, __shfl_xor(v, o));
    return v;
}
__device__ __forceinline__ const float* xrow_ptr(const Args& a, int r) { return r < NBP * SEQ ? a.xp + (size_t)r * DM : a.xs + (size_t)(r - NBP * SEQ) * DM; }

__device__ __forceinline__ void p0_transpose_item(const float* W, int K, int N, bf16_t* WT, float* scr, int item, int lane) {
    const int nblk = N / 32, kb = item / nblk, nb = item % nblk, k0 = 64 * kb, n0 = 32 * nb;
#pragma unroll 8
    for (int i = 0; i < 32; ++i) { const int kk = 2 * i + (lane >> 5); scr[kk * 33 + (lane & 31)] = W[(size_t)(k0 + kk) * N + n0 + (lane & 31)]; }
    asm volatile("s_waitcnt lgkmcnt(0)" ::: "memory");
    const int c = lane & 7;
#pragma unroll
    for (int j = 0; j < 4; ++j) { const int n = (lane >> 3) + 8 * j; const float* s = scr + (8 * c) * 33 + n;
        u32x4 o; o.x = pk2(s[0 * 33], s[1 * 33]); o.y = pk2(s[2 * 33], s[3 * 33]); o.z = pk2(s[4 * 33], s[5 * 33]); o.w = pk2(s[6 * 33], s[7 * 33]);
        *(u32x4*)(WT + (size_t)(n0 + n) * K + k0 + 8 * c) = o; }
    asm volatile("s_waitcnt lgkmcnt(0)" ::: "memory");
}
__device__ __forceinline__ void cast_region(const float* src, bf16_t* dst, size_t n, size_t gtid, size_t nthreads) {
    for (size_t i = gtid * 8; i < n; i += nthreads * 8) {
        const f32x4 a = *(const f32x4*)(src + i), b = *(const f32x4*)(src + i + 4);
        u32x4 o; o.x = pk2(a.x, a.y); o.y = pk2(a.z, a.w); o.z = pk2(b.x, b.y); o.w = pk2(b.z, b.w);
        *(u32x4*)(dst + i) = o;
    }
}
__device__ __forceinline__ void p0_prologue(const Args& a, unsigned char* lds, int tid, int lane, int wave) {
    const int G = gridDim.x, gw = blockIdx.x * NWAVES + wave, NGW = G * NWAVES;
    float* ldsf = (float*)lds;
    if (blockIdx.x < INW / 64) {
        float* xm = ldsf;
        float* red = ldsf + 16 * 1024;
#pragma unroll
        for (int rr = 0; rr < 2; ++rr) { const int r = 2 * wave + rr; f32x4 v[4]; float ss = 0.f;
#pragma unroll
            for (int j = 0; j < 4; ++j) { v[j] = *(const f32x4*)(a.meta + (size_t)r * DM + (lane + 64 * j) * 4); ss += v[j].x * v[j].x + v[j].y * v[j].y + v[j].z * v[j].z + v[j].w * v[j].w; }
            const float rstd = 1.0f / sqrtf(wave_sum(ss) * (1.0f / DM) + EPS);
#pragma unroll
            for (int j = 0; j < 4; ++j) { const int c = (lane + 64 * j) * 4; const f32x4 g = *(const f32x4*)(a.g_mix + c); *(f32x4*)(xm + r * 1024 + c) = v[j] * rstd * g; }
        }
        __syncthreads();
        const int n0 = blockIdx.x * 64, k0 = wave * 128;
        float acc[16];
#pragma unroll
        for (int r = 0; r < 16; ++r) acc[r] = 0.f;
        for (int k = k0; k < k0 + 128; ++k) { const float wv = a.w_in[(size_t)k * INW + n0 + lane];
#pragma unroll
            for (int r = 0; r < 16; ++r) acc[r] += xm[r * 1024 + k] * wv; }
#pragma unroll
        for (int r = 0; r < 16; ++r) red[(wave * 16 + r) * 64 + lane] = acc[r];
        __syncthreads();
        float* zmeta = (float*)(a.ws + WS_ZMETA);
        for (int o = tid; o < 1024; o += NTHR) { const int r = o >> 6, c = o & 63; float s = 0.f;
#pragma unroll
            for (int w = 0; w < 8; ++w) s += red[(w * 16 + r) * 64 + c];
            zmeta[r * INW + n0 + c] = s; }
        __syncthreads();
    }
    {
        float* scr = ldsf + wave * (64 * 33);
        constexpr int I_IN = (DM / 64) * (INW / 32), I_OUT = (DM / 64) * (DM / 32), I_WQ = (DM / 64) * (PQ / 32);
        for (int it = gw; it < I_IN + I_OUT + I_WQ; it += NGW) {
            int r = it;
            if (r < I_IN) { p0_transpose_item(a.w_in, DM, INW, (bf16_t*)(a.ws + WS_WIN), scr, r, lane); continue; } r -= I_IN;
            if (r < I_OUT) { p0_transpose_item(a.w_out, DM, DM, (bf16_t*)(a.ws + WS_WOUT), scr, r, lane); continue; } r -= I_OUT;
            p0_transpose_item(a.wq, DM, PQ, (bf16_t*)(a.ws + WS_WQ), scr, r, lane);
        }
    }
    {
        const size_t gtid = (size_t)blockIdx.x * NTHR + tid, nth = (size_t)G * NTHR;
        cast_region(a.subk, (bf16_t*)(a.ws + WS_SUBK), (size_t)16 * 128 * 128, gtid, nth);
        cast_region(a.pu, (bf16_t*)(a.ws + WS_UT), (size_t)16384 * DM, gtid, nth);
        cast_region(a.pv, (bf16_t*)(a.ws + WS_VT), (size_t)16384 * DM, gtid, nth);
    }
    {
        bf16_t* XA = (bf16_t*)(a.ws + WS_XA);
        for (int r = gw; r < NTOK; r += NGW) {
            const float* xr = xrow_ptr(a, r); f32x4 v[4]; float ss = 0.f;
#pragma unroll
            for (int j = 0; j < 4; ++j) { v[j] = *(const f32x4*)(xr + (lane + 64 * j) * 4); ss += v[j].x * v[j].x + v[j].y * v[j].y + v[j].z * v[j].z + v[j].w * v[j].w; }
            const float rstd = 1.0f / sqrtf(wave_sum(ss) * (1.0f / DM) + EPS);
#pragma unroll
            for (int j = 0; j < 4; ++j) { const int c = (lane + 64 * j) * 4; const f32x4 g = *(const f32x4*)(a.g_mix + c); const f32x4 o = v[j] * rstd * g;
                u32x2 w; w.x = pk2(o.x, o.y); w.y = pk2(o.z, o.w); *(u32x2*)(XA + (size_t)r * DM + c) = w; }
        }
    }
}

struct EpiStoreBf16 { bf16_t* C; int ldc;
    __device__ __forceinline__ void operator()(int row, int col, f32x4 v) const { u32x2 w; w.x = pk2(v.x, v.y); w.y = pk2(v.z, v.w); *(u32x2*)(C + (size_t)row * ldc + col) = w; } };
struct EpiResidF32 { const float* xp; const float* xs; float* out;
    __device__ __forceinline__ void operator()(int row, int col, f32x4 v) const {
        const float* xr = row < NBP * SEQ ? xp + (size_t)row * DM : xs + (size_t)(row - NBP * SEQ) * DM;
        const f32x4 x = *(const f32x4*)(xr + col); *(f32x4*)(out + (size_t)row * DM + col) = x + v; } };
template <class Epi>
__device__ __forceinline__ void gemm_simple(const bf16_t* A, int lda, const bf16_t* Bt, int ldb, int M, int N, int K, const Epi& epi, int gw, int NGW, int lane) {
    const int tn = N / 32, tiles = (M / 32) * tn, fr = lane & 15, fq = lane >> 4;
    for (int t = gw; t < tiles; t += NGW) {
        const int m0 = (t / tn) * 32, n0 = (t % tn) * 32;
        f32x4 acc[2][2];
#pragma unroll
        for (int i = 0; i < 2; ++i)
#pragma unroll
            for (int j = 0; j < 2; ++j) acc[i][j] = (f32x4){0.f, 0.f, 0.f, 0.f};
        const bf16_t* ap = A + (size_t)(m0 + fr) * lda + fq * 8; const bf16_t* bp = Bt + (size_t)(n0 + fr) * ldb + fq * 8;
        for (int k0 = 0; k0 < K; k0 += 32) {
            bf16x8 af[2], bfv[2];
#pragma unroll
            for (int i = 0; i < 2; ++i) { af[i] = *(const bf16x8*)(ap + (size_t)i * 16 * lda + k0); bfv[i] = *(const bf16x8*)(bp + (size_t)i * 16 * ldb + k0); }
#pragma unroll
            for (int ni = 0; ni < 2; ++ni)
#pragma unroll
                for (int mi = 0; mi < 2; ++mi) acc[ni][mi] = __builtin_amdgcn_mfma_f32_16x16x32_bf16(bfv[ni], af[mi], acc[ni][mi], 0, 0, 0);
        }
#pragma unroll
        for (int ni = 0; ni < 2; ++ni)
#pragma unroll
            for (int mi = 0; mi < 2; ++mi) epi(m0 + mi * 16 + fr, n0 + ni * 16 + fq * 4, acc[ni][mi]);
    }
}

__device__ __forceinline__ void rope8(float* v, int i, int t, int lane) {
    const int pos = (i < 4) ? (t >> 6) : (t & 63);
#pragma unroll
    for (int j = 0; j < 8; ++j) {
        const float other = __shfl_xor(v[j], 2);
        const int f = (i & 1) * 8 + j;
        const float freq = exp2f(-(float)f * (13.287712379549449f / 16.0f));
        const float rev = (float)pos * freq * 0.15915494309189535f;
        const float fr = rev - floorf(rev);
        const float sn = __builtin_amdgcn_sinf(fr), cs = __builtin_amdgcn_cosf(fr);
        v[j] = (i & 2) ? v[j] * cs + other * sn : v[j] * cs - other * sn;
    }
}
__device__ __forceinline__ void p2_pass(const Args& a, int lane, int gw, int NGW) {
    const bf16_t* ZB = (const bf16_t*)(a.ws + WS_ZB); const float* zmeta = (const float*)(a.ws + WS_ZMETA);
    bf16_t* XA = (bf16_t*)(a.ws + WS_XA); bf16_t* QB = (bf16_t*)(a.ws + WS_QB); bf16_t* KB = (bf16_t*)(a.ws + WS_KB); bf16_t* VB = (bf16_t*)(a.ws + WS_VB);
    const int i = lane & 7;
    for (int it = gw; it < NTOK + NB * 64; it += NGW) {
        if (it < NTOK) {
            const int r = it, b = r >> 11, t = r & 2047; const bf16_t* zr = ZB + (size_t)r * INW; const int c0 = lane * 8;
            float gb[8], uc[8], up[8], un[8], tmp[8];
            unpack8(*(const u32x4*)(zr + c0), gb);
            unpack8(*(const u32x4*)(zr + 512 + c0), uc); unpack8(*(const u32x4*)(zr + 1024 + c0), tmp);
#pragma unroll
            for (int j = 0; j < 8; ++j) uc[j] *= tmp[j];
            if (t > 0) { unpack8(*(const u32x4*)(zr - INW + 512 + c0), up); unpack8(*(const u32x4*)(zr - INW + 1024 + c0), tmp);
#pragma unroll
                for (int j = 0; j < 8; ++j) up[j] *= tmp[j]; }
            else {
#pragma unroll
                for (int j = 0; j < 8; ++j) up[j] = zmeta[15 * INW + 512 + c0 + j] * zmeta[15 * INW + 1024 + c0 + j]; }
            if (t < SEQ - 1) { unpack8(*(const u32x4*)(zr + INW + 512 + c0), un); unpack8(*(const u32x4*)(zr + INW + 1024 + c0), tmp);
#pragma unroll
                for (int j = 0; j < 8; ++j) un[j] *= tmp[j]; }
            else {
#pragma unroll
                for (int j = 0; j < 8; ++j) un[j] = 0.f; }
            float y[8], ss = 0.f;
#pragma unroll
            for (int j = 0; j < 8; ++j) { const int c = c0 + j; y[j] = gb[j] * (up[j] * a.conv_w[c] + uc[j] * a.conv_w[512 + c] + un[j] * a.conv_w[1024 + c]); ss += y[j] * y[j]; }
            ss += __shfl_xor(ss, 1); ss += __shfl_xor(ss, 2); ss += __shfl_xor(ss, 4);
            float rstd = 1.0f / sqrtf(ss * (1.0f / 64.0f) + EPS);
#pragma unroll
            for (int j = 0; j < 8; ++j) y[j] = y[j] * rstd * a.conv_g[c0 + j];
            *(u32x4*)(XA + (size_t)r * DM + c0) = pack8(y);
            float q[8]; unpack8(*(const u32x4*)(zr + 1536 + c0), q); ss = 0.f;
#pragma unroll
            for (int j = 0; j < 8; ++j) ss += q[j] * q[j];
            ss += __shfl_xor(ss, 1); ss += __shfl_xor(ss, 2); ss += __shfl_xor(ss, 4);
            rstd = 1.0f / sqrtf(ss * (1.0f / 64.0f) + EPS);
#pragma unroll
            for (int j = 0; j < 8; ++j) q[j] = q[j] * rstd * a.qg[i * 8 + j];
            rope8(q, i, t, lane);
#pragma unroll
            for (int j = 0; j < 8; ++j) q[j] *= C2;
            *(u32x4*)(QB + (size_t)r * 512 + c0) = pack8(q);
            const int l16 = lane & 15, g = l16 >> 3;
            float k[8]; unpack8(*(const u32x4*)(zr + 2048 + l16 * 8), k); ss = 0.f;
#pragma unroll
            for (int j = 0; j < 8; ++j) ss += k[j] * k[j];
            ss += __shfl_xor(ss, 1); ss += __shfl_xor(ss, 2); ss += __shfl_xor(ss, 4);
            rstd = 1.0f / sqrtf(ss * (1.0f / 64.0f) + EPS);
#pragma unroll
            for (int j = 0; j < 8; ++j) k[j] = k[j] * rstd * a.kg[i * 8 + j];
            rope8(k, i, t, lane);
            const size_t krow = ((size_t)(b * 2 + g) * KROWS + t) * 64 + i * 8;
            if (lane < 16) *(u32x4*)(KB + krow) = pack8(k);
            else if (lane < 32) *(u32x4*)(VB + krow) = *(const u32x4*)(zr + 2176 + l16 * 8);
        } else {
            const int it2 = it - NTOK, b = it2 >> 6, j64 = it2 & 63; const int l16 = lane & 15, g = l16 >> 3;
            float k[8], v[8];
            if (j64 < NMETA) {
                const float* zm = zmeta + j64 * INW; float ss = 0.f;
#pragma unroll
                for (int j = 0; j < 8; ++j) { k[j] = zm[2048 + l16 * 8 + j]; v[j] = zm[2176 + l16 * 8 + j]; ss += k[j] * k[j]; }
                ss += __shfl_xor(ss, 1); ss += __shfl_xor(ss, 2); ss += __shfl_xor(ss, 4);
                const float rstd = 1.0f / sqrtf(ss * (1.0f / 64.0f) + EPS);
#pragma unroll
                for (int j = 0; j < 8; ++j) k[j] = k[j] * rstd * a.kg[i * 8 + j];
            } else {
#pragma unroll
                for (int j = 0; j < 8; ++j) { k[j] = 0.f; v[j] = 0.f; }
            }
            const size_t krow = ((size_t)(b * 2 + g) * KROWS + SEQ + j64) * 64 + i * 8;
            if (lane < 16) *(u32x4*)(KB + krow) = pack8(k);
            else if (lane < 32) *(u32x4*)(VB + krow) = pack8(v);
        }
    }
}

__device__ __forceinline__ void p3_attn_simple(const Args& a, unsigned char* lds, int lane, int wave, int gw, int NGW) {
    const bf16_t* QB = (const bf16_t*)(a.ws + WS_QB); const bf16_t* KB = (const bf16_t*)(a.ws + WS_KB); const bf16_t* VB = (const bf16_t*)(a.ws + WS_VB);
    bf16_t* XA = (bf16_t*)(a.ws + WS_XA);
    float* pl = (float*)lds + wave * KROWS;
    for (int it = gw; it < NTOK * 8; it += NGW) {
        const int h = it / NTOK, r = it % NTOK, b = r >> 11, g = h >> 2;
        float qf[64];
#pragma unroll
        for (int c = 0; c < 8; ++c) unpack8(*(const u32x4*)(QB + (size_t)r * 512 + h * 64 + c * 8), qf + c * 8);
        const bf16_t* Kp = KB + (size_t)(b * 2 + g) * KROWS * 64; const bf16_t* Vp = VB + (size_t)(b * 2 + g) * KROWS * 64;
        float m = -INFINITY;
        for (int jj = 0; jj < 33; ++jj) { const int key = lane + 64 * jj; const bf16_t* kr = Kp + (size_t)key * 64; float s = 0.f;
#pragma unroll
            for (int c = 0; c < 8; ++c) { float kf[8]; unpack8(*(const u32x4*)(kr + c * 8), kf);
#pragma unroll
                for (int j = 0; j < 8; ++j) s += qf[c * 8 + j] * kf[j]; }
            if (key >= NKEYS) s = -INFINITY;
            pl[key] = s; m = fmaxf(m, s); }
        m = wave_max(m);
        float l = 0.f;
        for (int jj = 0; jj < 33; ++jj) { const int key = lane + 64 * jj; const float p = exp2f(pl[key] - m); pl[key] = p; l += p; }
        l = wave_sum(l);
        asm volatile("s_waitcnt lgkmcnt(0)" ::: "memory");
        float o = 0.f;
#pragma unroll 8
        for (int key = 0; key < NKEYS; ++key) o += pl[key] * bf2f(Vp[(size_t)key * 64 + lane]);
        o /= l;
        const float ss = wave_sum(o * o); const float rstd = 1.0f / sqrtf(ss * (1.0f / 64.0f) + EPS);
        XA[(size_t)r * DM + 512 + h * 64 + lane] = (bf16_t)f2bf(o * rstd * a.attn_g[h * 64 + lane]);
        asm volatile("s_waitcnt lgkmcnt(0)" ::: "memory");
    }
}

__device__ __forceinline__ void p5_norm(const Args& a, int lane, int gw, int NGW) {
    bf16_t* XA = (bf16_t*)(a.ws + WS_XA);
    for (int r = gw; r < NTOK; r += NGW) {
        const float* xr = a.out + (size_t)r * DM; f32x4 v[4]; float ss = 0.f;
#pragma unroll
        for (int j = 0; j < 4; ++j) { v[j] = *(const f32x4*)(xr + (lane + 64 * j) * 4); ss += v[j].x * v[j].x + v[j].y * v[j].y + v[j].z * v[j].z + v[j].w * v[j].w; }
        const float rstd = 1.0f / sqrtf(wave_sum(ss) * (1.0f / DM) + EPS);
#pragma unroll
        for (int j = 0; j < 4; ++j) { const int c = (lane + 64 * j) * 4; const f32x4 g = *(const f32x4*)(a.g_ffn + c); const f32x4 o = v[j] * rstd * g;
            u32x2 w; w.x = pk2(o.x, o.y); w.y = pk2(o.z, o.w); *(u32x2*)(XA + (size_t)r * DM + c) = w; }
    }
}

__device__ __forceinline__ void p7_topk_simple(const Args& a, int lane, int gw, int NGW) {
    const bf16_t* QP = (const bf16_t*)(a.ws + WS_ZB);
    int* EIDX = (int*)(a.ws + WS_QB); float* GATE = (float*)(a.ws + WS_QB + (size_t)NTOK * 128 * 4);
    for (int it = gw; it < (NTOK / 64) * 8; it += NGW) {
        const int h = it & 7, tok = (it >> 3) * 64 + lane;
        float top[2][16];
#pragma unroll
        for (int p = 0; p < 2; ++p) {
            float q[128];
#pragma unroll
            for (int c = 0; c < 16; ++c) unpack8(*(const u32x4*)(QP + (size_t)tok * PQ + h * 256 + p * 128 + c * 8), q + c * 8);
#pragma unroll
            for (int i = 0; i < 16; ++i) top[p][i] = -INFINITY;
            const float* sk = a.subk + (size_t)((h * 2 + p) * 128) * 128;
            for (int n = 0; n < 128; ++n) {
                float s = 0.f;
#pragma unroll
                for (int c = 0; c < 128; ++c) s += q[c] * sk[n * 128 + c];
                float x = __builtin_bit_cast(float, (__builtin_bit_cast(unsigned, s) & ~127u) | (unsigned)n);
#pragma unroll
                for (int i = 0; i < 16; ++i) { const float hi = fmaxf(top[p][i], x); x = fminf(top[p][i], x); top[p][i] = hi; }
            }
        }
        float tc[16];
#pragma unroll
        for (int i = 0; i < 16; ++i) tc[i] = -INFINITY;
#pragma unroll
        for (int i = 0; i < 16; ++i)
#pragma unroll
            for (int j = 0; j < 16; ++j) if ((i + 1) * (j + 1) <= 16) {
                const float c = top[0][i] + top[1][j];
                float x = __builtin_bit_cast(float, (__builtin_bit_cast(unsigned, c) & ~255u) | (unsigned)(i * 16 + j));
#pragma unroll
                for (int k = 0; k < 16; ++k) { const float hi = fmaxf(tc[k], x); x = fminf(tc[k], x); tc[k] = hi; }
            }
        float e[16], sum = 0.f;
#pragma unroll
        for (int k = 0; k < 16; ++k) { e[k] = expf(tc[k] - tc[0]); sum += e[k]; }
        const float inv = 1.0f / sum;
        int eo[16]; float go[16];
#pragma unroll
        for (int k = 0; k < 16; ++k) {
            const unsigned code = __builtin_bit_cast(unsigned, tc[k]) & 255u; const unsigned ci = code >> 4, cj = code & 15u;
            unsigned ia = 0, ib = 0;
#pragma unroll
            for (int ii = 0; ii < 16; ++ii) { ia = (ci == (unsigned)ii) ? (__builtin_bit_cast(unsigned, top[0][ii]) & 127u) : ia; ib = (cj == (unsigned)ii) ? (__builtin_bit_cast(unsigned, top[1][ii]) & 127u) : ib; }
            eo[k] = (int)(ia * 128u + ib); go[k] = e[k] * inv;
        }
        int* ep = EIDX + ((size_t)tok * 8 + h) * 16; float* gp = GATE + ((size_t)tok * 8 + h) * 16;
#pragma unroll
        for (int k = 0; k < 16; k += 4) { *(int4*)(ep + k) = make_int4(eo[k], eo[k + 1], eo[k + 2], eo[k + 3]); *(f32x4*)(gp + k) = (f32x4){go[k], go[k + 1], go[k + 2], go[k + 3]}; }
    }
}

__device__ __forceinline__ void p8_peer_simple(const Args& a, int lane, int gw, int NGW) {
    const bf16_t* XA = (const bf16_t*)(a.ws + WS_XA); const bf16_t* UT = (const bf16_t*)(a.ws + WS_UT); const bf16_t* VT = (const bf16_t*)(a.ws + WS_VT);
    const int* EIDX = (const int*)(a.ws + WS_QB); const float* GATE = (const float*)(a.ws + WS_QB + (size_t)NTOK * 128 * 4);
    for (int r = gw; r < NTOK; r += NGW) {
        float xf[16], out[16];
        unpack8(*(const u32x4*)(XA + (size_t)r * DM + lane * 16), xf); unpack8(*(const u32x4*)(XA + (size_t)r * DM + lane * 16 + 8), xf + 8);
#pragma unroll
        for (int j = 0; j < 16; ++j) out[j] = 0.f;
        for (int h = 0; h < 8; ++h) {
            const int e_l = EIDX[((size_t)r * 8 + h) * 16 + (lane & 15)]; const float g_l = GATE[((size_t)r * 8 + h) * 16 + (lane & 15)];
            float part[16];
#pragma unroll
            for (int k = 0; k < 16; ++k) { const int e = __shfl(e_l, k); const bf16_t* ur = UT + (size_t)e * DM + lane * 16;
                float uf[16]; unpack8(*(const u32x4*)ur, uf); unpack8(*(const u32x4*)(ur + 8), uf + 8); float s = 0.f;
#pragma unroll
                for (int j = 0; j < 16; ++j) s += uf[j] * xf[j];
                part[k] = s; }
#pragma unroll
            for (int k = 0; k < 16; ++k) { const float d = wave_sum(part[k]); const float ge = 0.5f * d * (1.0f + erff(d * 0.70710678118654752f)); part[k] = ge * __shfl(g_l, k); }
#pragma unroll
            for (int k = 0; k < 16; ++k) { const int e = __shfl(e_l, k); const bf16_t* vr = VT + (size_t)e * DM + lane * 16;
                float vf[16]; unpack8(*(const u32x4*)vr, vf); unpack8(*(const u32x4*)(vr + 8), vf + 8);
#pragma unroll
                for (int j = 0; j < 16; ++j) out[j] += part[k] * vf[j]; }
        }
        float* orow = a.out + (size_t)r * DM + lane * 16;
#pragma unroll
        for (int j = 0; j < 4; ++j) { f32x4 hv = *(const f32x4*)(orow + j * 4); hv.x += out[j * 4]; hv.y += out[j * 4 + 1]; hv.z += out[j * 4 + 2]; hv.w += out[j * 4 + 3]; *(f32x4*)(orow + j * 4) = hv; }
    }
}

__global__ void __launch_bounds__(NTHR, 2) enc_fwd(Args a) {
    extern __shared__ __attribute__((aligned(16))) unsigned char lds[];
    cg::grid_group grid = cg::this_grid();
    const int tid = threadIdx.x, lane = tid & 63, wave = __builtin_amdgcn_readfirstlane(tid >> 6);
    const int G = gridDim.x, gw = blockIdx.x * NWAVES + wave, NGW = G * NWAVES;
    const int lo = a.ph_lo, hi = a.ph_hi;
#define IN(k) (lo <= (k) && (k) < hi)
#define SEAM(k) do { if (IN(k) && IN((k) + 1)) grid.sync(); } while (0)
    if (IN(0)) { p0_prologue(a, lds, tid, lane, wave); } SEAM(0);
    if (IN(1)) { EpiStoreBf16 E{(bf16_t*)(a.ws + WS_ZB), INW}; gemm_simple((const bf16_t*)(a.ws + WS_XA), DM, (const bf16_t*)(a.ws + WS_WIN), DM, NTOK, INW, DM, E, gw, NGW, lane); } SEAM(1);
    if (IN(2)) { p2_pass(a, lane, gw, NGW); } SEAM(2);
    if (IN(3)) { p3_attn_simple(a, lds, lane, wave, gw, NGW); } SEAM(3);
    if (IN(4)) { EpiResidF32 E{a.xp, a.xs, a.out}; gemm_simple((const bf16_t*)(a.ws + WS_XA), DM, (const bf16_t*)(a.ws + WS_WOUT), DM, NTOK, DM, DM, E, gw, NGW, lane); } SEAM(4);
    if (IN(5)) { p5_norm(a, lane, gw, NGW); } SEAM(5);
    if (IN(6)) { EpiStoreBf16 E{(bf16_t*)(a.ws + WS_ZB), PQ}; gemm_simple((const bf16_t*)(a.ws + WS_XA), DM, (const bf16_t*)(a.ws + WS_WQ), DM, NTOK, PQ, DM, E, gw, NGW, lane); } SEAM(6);
    if (IN(7)) { p7_topk_simple(a, lane, gw, NGW); } SEAM(7);
    if (IN(8)) { p8_peer_simple(a, lane, gw, NGW); }
#undef IN
#undef SEAM
}

extern "C" void kernel_launch(void* const* d_in, const int* in_sizes, int n_in, void* d_out, int out_size, void* d_ws, size_t ws_size, hipStream_t stream) {
    static int grid = 0;
    if (grid == 0) {
        if (n_in != 16 || out_size != NTOK * DM || ws_size < WS_END) { fprintf(stderr, "kernel_launch: unexpected shapes (n_in %d out %d ws %zu)\n", n_in, out_size, ws_size); grid = -1; return; }
        int dev = 0, cus = 0, per_cu = 0;
        (void)hipGetDevice(&dev); (void)hipDeviceGetAttribute(&cus, hipDeviceAttributeMultiprocessorCount, dev);
        (void)hipFuncSetAttribute((const void*)enc_fwd, hipFuncAttributeMaxDynamicSharedMemorySize, LDS_BYTES);
        (void)hipOccupancyMaxActiveBlocksPerMultiprocessor(&per_cu, (const void*)enc_fwd, NTHR, LDS_BYTES);
        if (per_cu < 1) { fprintf(stderr, "kernel_launch: occupancy query says %d blocks/CU\n", per_cu); per_cu = 1; }
        (void)hipGetLastError();
        grid = cus * 1;
    }
    if (grid < 0) return;
    Args a{};
    a.xp = (const float*)d_in[0]; a.xs = (const float*)d_in[1]; a.meta = (const float*)d_in[2]; a.g_mix = (const float*)d_in[3]; a.w_in = (const float*)d_in[4];
    a.conv_w = (const float*)d_in[5]; a.qg = (const float*)d_in[6]; a.kg = (const float*)d_in[7]; a.conv_g = (const float*)d_in[8]; a.attn_g = (const float*)d_in[9];
    a.w_out = (const float*)d_in[10]; a.g_ffn = (const float*)d_in[11]; a.wq = (const float*)d_in[12]; a.subk = (const float*)d_in[13]; a.pu = (const float*)d_in[14]; a.pv = (const float*)d_in[15];
    a.out = (float*)d_out; a.ws = (unsigned char*)d_ws;
    constexpr int NL = MK_N_LAUNCHES;
    for (int li = 0; li < NL; ++li) {
        a.ph_lo = (NL == 1) ? 0 : li; a.ph_hi = (NL == 1) ? NPHASE : li + 1;
        void* args[] = {&a};
        hipError_t e = hipLaunchCooperativeKernel((const void*)enc_fwd, dim3(grid), dim3(NTHR), args, LDS_BYTES, stream);
        if (e != hipSuccess) { fprintf(stderr, "kernel_launch: launch %d failed: %s\n", li, hipGetErrorString(e)); break; }
    }
}
```

```cpp
#include <hip/hip_runtime.h>
#include <hip/hip_cooperative_groups.h>
#include <cstdint>
#include <cstdio>
namespace cg = cooperative_groups;

#ifndef MK_N_LAUNCHES
#define MK_N_LAUNCHES 1
#endif

typedef unsigned short bf16_t;
typedef short bf16x8 __attribute__((ext_vector_type(8)));
typedef float f32x4 __attribute__((ext_vector_type(4)));
typedef unsigned u32x4 __attribute__((ext_vector_type(4)));
typedef unsigned u32x2 __attribute__((ext_vector_type(2)));
#define LAS __attribute__((address_space(3)))

constexpr int NB = 24, NBP = 16, SEQ = 2048, DM = 1024, NTOK = NB * SEQ;
constexpr int NMETA = 16, INW = 2304, KROWS = 2112;
constexpr int NKEYS = SEQ + NMETA;
constexpr int PQ = 2048;
constexpr float EPS = 1e-6f;
constexpr float C2 = 0.125f * 1.4426950408889634f;
constexpr int NWAVES = 8, NTHR = 512;
constexpr int LDS_BYTES = 163840;
constexpr int NPHASE = 11;

constexpr size_t MiB = 1u << 20;
constexpr size_t WS_CTL = 0;
constexpr size_t WS_WIN = 1 * MiB;
constexpr size_t WS_WOUT = 6 * MiB;
constexpr size_t WS_WQ = 8 * MiB;
constexpr size_t WS_SUBK = 12 * MiB;
constexpr size_t WS_ZMETA = 12 * MiB + 512 * 1024;
constexpr size_t WS_ROPE = WS_ZMETA + 256 * 1024;
constexpr size_t WS_UT = 13 * MiB;
constexpr size_t WS_USC = 29 * MiB, WS_VSC = WS_USC + 64 * 1024;
constexpr size_t WS_SS = WS_USC + 256 * 1024;
constexpr size_t SLICE4 = (size_t)16384 * 128;
constexpr size_t WS_XA = 32 * MiB;
constexpr size_t WS_EI = WS_XA, WS_GT = WS_XA + 12 * MiB;
constexpr size_t WS_Z = 128 * MiB;
constexpr size_t WS_HB = WS_Z;
constexpr size_t WS_QP = WS_Z + 96 * MiB;
constexpr size_t WS_PB = WS_QP;
constexpr size_t WS_AB = WS_PB + (size_t)4 * 49152 * 128 * 4;
constexpr size_t WS_Q = 416 * MiB;
constexpr size_t WS_X8 = WS_Q;
constexpr size_t WS_KB = 464 * MiB;
constexpr size_t WS_VB = 477 * MiB;
constexpr size_t WS_END = 490 * MiB;
constexpr float X8SCALE = 8.0f;
constexpr float A8SCALE = 256.0f;

struct Args {
    const float* xp; const float* xs; const float* meta; const float* g_mix; const float* w_in; const float* conv_w;
    const float* qg; const float* kg; const float* conv_g; const float* attn_g; const float* w_out; const float* g_ffn;
    const float* wq; const float* subk; const float* pu; const float* pv;
    float* out; unsigned char* ws; int ph_lo, ph_hi;
};

__device__ __forceinline__ unsigned f2bf(float f) { unsigned u = __builtin_bit_cast(unsigned, f); return (u + 0x7fffu + ((u >> 16) & 1u)) >> 16; }
typedef float f32x2_pk __attribute__((ext_vector_type(2))); typedef __bf16 bf16x2_pk __attribute__((ext_vector_type(2)));
__device__ __forceinline__ unsigned pk2(float lo, float hi) { const f32x2_pk v = {lo, hi}; const bf16x2_pk b = __builtin_convertvector(v, bf16x2_pk); return __builtin_bit_cast(unsigned, b); }
__device__ __forceinline__ float bflo(unsigned w) { return __builtin_bit_cast(float, w << 16); }
__device__ __forceinline__ float bfhi(unsigned w) { return __builtin_bit_cast(float, w & 0xffff0000u); }
__device__ __forceinline__ float bf2f(bf16_t h) { return __builtin_bit_cast(float, (unsigned)h << 16); }
__device__ __forceinline__ void unpack8(u32x4 w, float* f) {
    f[0] = bflo(w.x); f[1] = bfhi(w.x); f[2] = bflo(w.y); f[3] = bfhi(w.y); f[4] = bflo(w.z); f[5] = bfhi(w.z); f[6] = bflo(w.w); f[7] = bfhi(w.w);
}
__device__ __forceinline__ u32x4 pack8(const float* f) { u32x4 w; w.x = pk2(f[0], f[1]); w.y = pk2(f[2], f[3]); w.z = pk2(f[4], f[5]); w.w = pk2(f[6], f[7]); return w; }
__device__ __forceinline__ float wave_sum(float v) {
#pragma unroll
    for (int o = 1; o < 64; o <<= 1) v += __shfl_xor(v, o);
    return v;
}
__device__ __forceinline__ float wave_max(float v) {
#pragma unroll
    for (int o = 1; o < 64; o <<= 1) v = fmaxf(v, __shfl_xor(v, o));
    return v;
}
__device__ __forceinline__ const float* xrow_ptr(const Args& a, int r) { return r < NBP * SEQ ? a.xp + (size_t)r * DM : a.xs + (size_t)(r - NBP * SEQ) * DM; }

__device__ __forceinline__ int permin(int n  ) {
    if (n >= 512 && n < 1536) { const int hc = (n - 512) >> 9, c = (n - 512) & 511; return 512 + (c >> 7) * 256 + hc * 128 + (c & 127); }
    if (n >= 1536 && n < 2048) { const int c = n - 1536, hh = c >> 6, half = (c >> 5) & 1; return 1536 + 256 * (hh >> 2) + 128 * half + 32 * (hh & 3) + (c & 31); }
    if (n >= 2048) { const int c = n - 2048, s = c >> 6, half = (c >> 5) & 1; return 2048 + 128 * half + 32 * s + (c & 31); }
    return n; }
__device__ __forceinline__ void p0_transpose_item(const float* W, int K, int N, bf16_t* WT, float* scr, int item, int lane, const float* gk = nullptr  , bool dperm = false) {
    const int nblk = N / 32, kb = item / nblk, nb = item % nblk, k0 = 64 * kb, n0 = 32 * nb, nd0 = dperm ? permin(n0) : n0;
#pragma unroll 8
    for (int i = 0; i < 32; ++i) { const int kk = 2 * i + (lane >> 5); scr[kk * 33 + (lane & 31)] = W[(size_t)(k0 + kk) * N + n0 + (lane & 31)] * (gk ? gk[k0 + kk] : 1.0f); }
    asm volatile("s_waitcnt lgkmcnt(0)" ::: "memory");
    const int c = lane & 7;
#pragma unroll
    for (int j = 0; j < 4; ++j) { const int n = (lane >> 3) + 8 * j; const float* s = scr + (8 * c) * 33 + n;
        u32x4 o; o.x = pk2(s[0 * 33], s[1 * 33]); o.y = pk2(s[2 * 33], s[3 * 33]); o.z = pk2(s[4 * 33], s[5 * 33]); o.w = pk2(s[6 * 33], s[7 * 33]);
        *(u32x4*)(WT + (size_t)(nd0 + n) * K + k0 + 8 * c) = o; }
    asm volatile("s_waitcnt lgkmcnt(0)" ::: "memory");
}
__device__ __forceinline__ void cast_region(const float* src, bf16_t* dst, size_t n, size_t gtid, size_t nthreads) {
    for (size_t i = gtid * 8; i < n; i += nthreads * 8) {
        const f32x4 a = *(const f32x4*)(src + i), b = *(const f32x4*)(src + i + 4);
        u32x4 o; o.x = pk2(a.x, a.y); o.y = pk2(a.z, a.w); o.z = pk2(b.x, b.y); o.w = pk2(b.z, b.w);
        *(u32x4*)(dst + i) = o;
    }
}
template <bool PERM64> __device__ __forceinline__ void table_fp4(const float* src, unsigned char* dst, float* scale, const float* gcol  , int gw, int NGW, int lane) {
    f32x4 v[4], vn[4], g[4];
#pragma unroll
    for (int j = 0; j < 4; ++j) g[j] = gcol ? *(const f32x4*)(gcol + lane * 16 + 4 * j) : (f32x4){1.f, 1.f, 1.f, 1.f};
    if (gw < 16384) {
#pragma unroll
        for (int j = 0; j < 4; ++j) v[j] = __builtin_nontemporal_load((const f32x4*)(src + (size_t)gw * DM + lane * 16 + 4 * j)); }
    for (int row = gw; row < 16384; row += NGW) {
        { const int rn = row + NGW < 16384 ? row + NGW : row;
#pragma unroll
          for (int j = 0; j < 4; ++j) vn[j] = __builtin_nontemporal_load((const f32x4*)(src + (size_t)rn * DM + lane * 16 + 4 * j)); }
        float m = 0.f;
#pragma unroll
        for (int j = 0; j < 4; ++j) { v[j] = v[j] * g[j]; m = fmaxf(fmaxf(m, fmaxf(fabsf(v[j].x), fabsf(v[j].y))), fmaxf(fabsf(v[j].z), fabsf(v[j].w))); }
        m = wave_max(m);
        const float s = fmaxf(m, 1e-30f) * (1.0f / 6.0f), inv = 1.0f / s;
        unsigned char* rowp = dst + (size_t)(lane >> 4) * SLICE4 + (size_t)row * 128;
        if (!PERM64) {
            unsigned w0 = 0u, w1 = 0u;
            w0 = __builtin_amdgcn_cvt_scalef32_pk_fp4_f32(w0, v[0].x * inv, v[0].y * inv, 1.0f, 0); w0 = __builtin_amdgcn_cvt_scalef32_pk_fp4_f32(w0, v[0].z * inv, v[0].w * inv, 1.0f, 1);
            w0 = __builtin_amdgcn_cvt_scalef32_pk_fp4_f32(w0, v[1].x * inv, v[1].y * inv, 1.0f, 2); w0 = __builtin_amdgcn_cvt_scalef32_pk_fp4_f32(w0, v[1].z * inv, v[1].w * inv, 1.0f, 3);
            w1 = __builtin_amdgcn_cvt_scalef32_pk_fp4_f32(w1, v[2].x * inv, v[2].y * inv, 1.0f, 0); w1 = __builtin_amdgcn_cvt_scalef32_pk_fp4_f32(w1, v[2].z * inv, v[2].w * inv, 1.0f, 1);
            w1 = __builtin_amdgcn_cvt_scalef32_pk_fp4_f32(w1, v[3].x * inv, v[3].y * inv, 1.0f, 2); w1 = __builtin_amdgcn_cvt_scalef32_pk_fp4_f32(w1, v[3].z * inv, v[3].w * inv, 1.0f, 3);
            *(u32x2*)(rowp + (lane & 15) * 8) = (u32x2){w0, w1};
        } else {
            unsigned char* gp = rowp + ((lane & 15) >> 2) * 32 + (lane & 3) * 2;
#pragma unroll
            for (int m = 0; m < 4; ++m) { unsigned wm = 0u;
                wm = __builtin_amdgcn_cvt_scalef32_pk_fp4_f32(wm, v[0][m] * inv, v[1][m] * inv, 1.0f, 0); wm = __builtin_amdgcn_cvt_scalef32_pk_fp4_f32(wm, v[2][m] * inv, v[3][m] * inv, 1.0f, 1);
                *(unsigned short*)(gp + 8 * m) = (unsigned short)wm; }
        }
        if (lane == 0) scale[row] = s;
#pragma unroll
        for (int j = 0; j < 4; ++j) v[j] = vn[j];
    }
}
__device__ __forceinline__ void p0_prologue(const Args& a, unsigned char* lds, int tid, int lane, int wave) {
    const int G = gridDim.x, gw = blockIdx.x * NWAVES + wave, NGW = G * NWAVES;
    float* ldsf = (float*)lds;
    if (blockIdx.x < INW / 64) {
        float* xm = ldsf;
        float* red = ldsf + 16 * 1024;
#pragma unroll
        for (int rr = 0; rr < 2; ++rr) { const int r = 2 * wave + rr; f32x4 v[4]; float ss = 0.f;
#pragma unroll
            for (int j = 0; j < 4; ++j) { v[j] = *(const f32x4*)(a.meta + (size_t)r * DM + (lane + 64 * j) * 4); ss += v[j].x * v[j].x + v[j].y * v[j].y + v[j].z * v[j].z + v[j].w * v[j].w; }
            const float rstd = 1.0f / sqrtf(wave_sum(ss) * (1.0f / DM) + EPS);
#pragma unroll
            for (int j = 0; j < 4; ++j) { const int c = (lane + 64 * j) * 4; const f32x4 g = *(const f32x4*)(a.g_mix + c); *(f32x4*)(xm + r * 1024 + c) = v[j] * rstd * g; }
        }
        __syncthreads();
        const int n0 = blockIdx.x * 64, k0 = wave * 128;
        float acc[16];
#pragma unroll
        for (int r = 0; r < 16; ++r) acc[r] = 0.f;
        for (int kb = k0; kb < k0 + 128; kb += 16) { float wv[16];
#pragma unroll
            for (int q = 0; q < 16; ++q) wv[q] = a.w_in[(size_t)(kb + q) * INW + n0 + lane];
#pragma unroll
            for (int q = 0; q < 16; ++q)
#pragma unroll
                for (int r = 0; r < 16; ++r) acc[r] += xm[r * 1024 + kb + q] * wv[q]; }
#pragma unroll
        for (int r = 0; r < 16; ++r) red[(wave * 16 + r) * 64 + lane] = acc[r];
        __syncthreads();
        float* zmeta = (float*)(a.ws + WS_ZMETA);
        for (int o = tid; o < 1024; o += NTHR) { const int r = o >> 6, c = o & 63; float s = 0.f;
#pragma unroll
            for (int w = 0; w < 8; ++w) s += red[(w * 16 + r) * 64 + c];
            zmeta[r * INW + n0 + c] = s; }
        __syncthreads();
    }
    if (blockIdx.x == INW / 64) {
        float* rope = (float*)(a.ws + WS_ROPE);
        for (int i = tid; i < 64 * 16; i += NTHR) { const int pos = i >> 4, f = i & 15;
            const float freq = exp2f(-(float)f * (13.287712379549449f / 16.0f)); const float rev = (float)pos * freq * 0.15915494309189535f; const float fr = rev - floorf(rev);
            rope[2 * i] = __builtin_amdgcn_cosf(fr); rope[2 * i + 1] = __builtin_amdgcn_sinf(fr); }
    }
    if ((int)blockIdx.x > INW / 64 || G <= INW / 64 + 1) {
        float* scr = ldsf + wave * (64 * 33);
        constexpr int I_IN = (DM / 64) * (INW / 32), I_OUT = (DM / 64) * (DM / 32), I_WQ = (DM / 64) * (PQ / 32);
        const int first = (G <= INW / 64 + 1) ? 0 : INW / 64 + 1, nw = (G - first) * NWAVES;
        for (int it = ((int)blockIdx.x - first) * NWAVES + wave; it < I_IN + I_OUT + I_WQ; it += nw) {
            int r = it;
            if (r < I_IN) { p0_transpose_item(a.w_in, DM, INW, (bf16_t*)(a.ws + WS_WIN), scr, r, lane, nullptr, true); continue; } r -= I_IN;
            if (r < I_OUT) { p0_transpose_item(a.w_out, DM, DM, (bf16_t*)(a.ws + WS_WOUT), scr, r, lane); continue; } r -= I_OUT;
            p0_transpose_item(a.wq, DM, PQ, (bf16_t*)(a.ws + WS_WQ), scr, r, lane, a.g_ffn);
        }
    }
    {
        const size_t gtid = (size_t)blockIdx.x * NTHR + tid, nth = (size_t)G * NTHR;
        cast_region(a.subk, (bf16_t*)(a.ws + WS_SUBK), (size_t)16 * 128 * 128, gtid, nth);
        for (size_t i = gtid; i < (size_t)NTOK; i += nth) ((float*)(a.ws + WS_SS))[i] = 0.f;
    }
    {
        bf16_t* XA = (bf16_t*)(a.ws + WS_XA);
        f32x4 g[4], v[4], vn[4];
#pragma unroll
        for (int j = 0; j < 4; ++j) g[j] = *(const f32x4*)(a.g_mix + (lane + 64 * j) * 4);
        if (gw < NTOK) { const float* xr = xrow_ptr(a, gw);
#pragma unroll
            for (int j = 0; j < 4; ++j) v[j] = __builtin_nontemporal_load((const f32x4*)(xr + (lane + 64 * j) * 4)); }
        for (int r = gw; r < NTOK; r += NGW) {
            { const float* xn = xrow_ptr(a, r + NGW < NTOK ? r + NGW : r);
#pragma unroll
              for (int j = 0; j < 4; ++j) vn[j] = __builtin_nontemporal_load((const f32x4*)(xn + (lane + 64 * j) * 4)); }
            float ss = 0.f;
#pragma unroll
            for (int j = 0; j < 4; ++j) ss += v[j].x * v[j].x + v[j].y * v[j].y + v[j].z * v[j].z + v[j].w * v[j].w;
            const float rstd = 1.0f / sqrtf(wave_sum(ss) * (1.0f / DM) + EPS);
#pragma unroll
            for (int j = 0; j < 4; ++j) { const int c = (lane + 64 * j) * 4; const f32x4 o = v[j] * rstd * g[j];
                u32x2 w; w.x = pk2(o.x, o.y); w.y = pk2(o.z, o.w); *(u32x2*)(XA + (size_t)r * DM + c) = w; }
#pragma unroll
            for (int j = 0; j < 4; ++j) v[j] = vn[j];
        }
    }
}

constexpr int ZW = 1024;
struct P2In { u32x4 w[4]; };
__device__ __forceinline__ void p2_load(P2In& in, const bf16_t* ZB, int r, int lane) {
    const int t = r & 2047, c0 = lane * 8; const bf16_t* zr = ZB + (size_t)r * ZW;
    const bf16_t* zp = (t > 0) ? zr - ZW : zr; const bf16_t* zn = (t < SEQ - 1) ? zr + ZW : zr;
    in.w[0] = *(const u32x4*)(zr + c0); in.w[1] = *(const u32x4*)(zr + 512 + c0); in.w[2] = *(const u32x4*)(zp + 512 + c0); in.w[3] = *(const u32x4*)(zn + 512 + c0);
}
__device__ __forceinline__ void p2_pass(const Args& a, int lane, int gw, int NGW) {
    const bf16_t* ZB = (const bf16_t*)(a.ws + WS_Z); const float* zmeta = (const float*)(a.ws + WS_ZMETA);
    bf16_t* XA = (bf16_t*)(a.ws + WS_XA);
    const int c0 = lane * 8;
    float cw0[8], cw1[8], cw2[8], cgn[8];
#pragma unroll
    for (int j = 0; j < 8; ++j) { cw0[j] = a.conv_w[c0 + j]; cw1[j] = a.conv_w[512 + c0 + j]; cw2[j] = a.conv_w[1024 + c0 + j]; cgn[j] = a.conv_g[c0 + j]; }
    P2In cur, nxt, nx2;
    if (gw < NTOK) { p2_load(cur, ZB, gw, lane); p2_load(nxt, ZB, gw + NGW < NTOK ? gw + NGW : gw, lane); }
    for (int it = gw; it < NTOK; it += NGW) {
        {
            const int r = it, t = r & 2047;
            { const int rn = it + 2 * NGW < NTOK ? it + 2 * NGW : it; p2_load(nx2, ZB, rn, lane); }
            float gb[8], uc[8], up[8], un[8];
            unpack8(cur.w[0], gb); unpack8(cur.w[1], uc); unpack8(cur.w[2], up);
            if (t == 0) {
#pragma unroll
                for (int j = 0; j < 8; ++j) up[j] = zmeta[15 * INW + 512 + c0 + j] * zmeta[15 * INW + 1024 + c0 + j]; }
            unpack8(cur.w[3], un);
#pragma unroll
            for (int j = 0; j < 8; ++j) un[j] = (t < SEQ - 1) ? un[j] : 0.f;
            float y[8], ss = 0.f;
#pragma unroll
            for (int j = 0; j < 8; ++j) { y[j] = gb[j] * (up[j] * cw0[j] + uc[j] * cw1[j] + un[j] * cw2[j]); ss += y[j] * y[j]; }
            ss += __shfl_xor(ss, 1); ss += __shfl_xor(ss, 2); ss += __shfl_xor(ss, 4);
            const float rstd = 1.0f / sqrtf(ss * (1.0f / 64.0f) + EPS);
#pragma unroll
            for (int j = 0; j < 8; ++j) y[j] = y[j] * rstd * cgn[j];
            *(u32x4*)(XA + (size_t)r * DM + c0) = pack8(y);
            cur = nxt; nxt = nx2;
        }
    }
}
__device__ __forceinline__ void kv_meta_rows(const Args& a, int lane, int gw, int NGW) {
    const float* zmeta = (const float*)(a.ws + WS_ZMETA); bf16_t* KB = (bf16_t*)(a.ws + WS_KB); bf16_t* VB = (bf16_t*)(a.ws + WS_VB);
    const int i = lane & 7;
    for (int it = NTOK + gw; it < NTOK + NB * 64; it += NGW) {
        {
            const int it2 = it - NTOK, b = it2 >> 6, j64 = it2 & 63; const int l16 = lane & 15, g = l16 >> 3;
            float k[8], v[8];
            if (j64 < NMETA) {
                const float* zm = zmeta + j64 * INW; float ss = 0.f;
#pragma unroll
                for (int j = 0; j < 8; ++j) { k[j] = zm[2048 + l16 * 8 + j]; v[j] = zm[2176 + l16 * 8 + j]; ss += k[j] * k[j]; }
                ss += __shfl_xor(ss, 1); ss += __shfl_xor(ss, 2); ss += __shfl_xor(ss, 4);
                const float rstd = 1.0f / sqrtf(ss * (1.0f / 64.0f) + EPS);
#pragma unroll
                for (int j = 0; j < 8; ++j) k[j] = k[j] * rstd * a.kg[i * 8 + j];
            } else {
#pragma unroll
                for (int j = 0; j < 8; ++j) { k[j] = 0.f; v[j] = 0.f; }
            }
            const size_t krow = ((size_t)(b * 2 + g) * KROWS + SEQ + j64) * 64 + i * 8;
            if (lane < 16) *(u32x4*)(KB + krow) = pack8(k);
            else if (lane < 32) *(u32x4*)(VB + krow) = pack8(v);
        }
    }
}

typedef float f32x16 __attribute__((ext_vector_type(16)));
__device__ __forceinline__ void ce_desc(float& a, float& b) { float h, l; asm("v_max_f32_e32 %0, %1, %2" : "=v"(h) : "v"(a), "v"(b)); asm("v_min_f32_e32 %0, %1, %2" : "=v"(l) : "v"(a), "v"(b)); a = h; b = l; }
__device__ __forceinline__ float vmaxf(float a, float b) { float h; asm("v_max_f32_e32 %0, %1, %2" : "=v"(h) : "v"(a), "v"(b)); return h; }
template <int N> __device__ __forceinline__ void bitonic_sort_desc(float* v) {
#pragma unroll
    for (int k = 2; k <= N; k <<= 1)
#pragma unroll
        for (int j = k >> 1; j > 0; j >>= 1)
#pragma unroll
            for (int i = 0; i < N; ++i) { const int l = i ^ j; if (l > i) { if ((i & k) == 0) ce_desc(v[i], v[l]); else ce_desc(v[l], v[i]); } }
}
__device__ __forceinline__ void sort16_desc(float* v) {
    ce_desc(v[0], v[13]); ce_desc(v[1], v[12]); ce_desc(v[2], v[15]); ce_desc(v[3], v[14]); ce_desc(v[4], v[8]); ce_desc(v[5], v[6]); ce_desc(v[7], v[11]); ce_desc(v[9], v[10]);
    ce_desc(v[0], v[5]); ce_desc(v[1], v[7]); ce_desc(v[2], v[9]); ce_desc(v[3], v[4]); ce_desc(v[6], v[13]); ce_desc(v[8], v[14]); ce_desc(v[10], v[15]); ce_desc(v[11], v[12]);
    ce_desc(v[0], v[1]); ce_desc(v[2], v[3]); ce_desc(v[4], v[5]); ce_desc(v[6], v[8]); ce_desc(v[7], v[9]); ce_desc(v[10], v[11]); ce_desc(v[12], v[13]); ce_desc(v[14], v[15]);
    ce_desc(v[0], v[2]); ce_desc(v[1], v[3]); ce_desc(v[4], v[10]); ce_desc(v[5], v[11]); ce_desc(v[6], v[7]); ce_desc(v[8], v[9]); ce_desc(v[12], v[14]); ce_desc(v[13], v[15]);
    ce_desc(v[1], v[2]); ce_desc(v[3], v[12]); ce_desc(v[4], v[6]); ce_desc(v[5], v[7]); ce_desc(v[8], v[10]); ce_desc(v[9], v[11]); ce_desc(v[13], v[14]);
    ce_desc(v[1], v[4]); ce_desc(v[2], v[6]); ce_desc(v[5], v[8]); ce_desc(v[7], v[10]); ce_desc(v[9], v[13]); ce_desc(v[11], v[14]);
    ce_desc(v[2], v[4]); ce_desc(v[3], v[6]); ce_desc(v[9], v[12]); ce_desc(v[11], v[13]);
    ce_desc(v[3], v[5]); ce_desc(v[6], v[8]); ce_desc(v[7], v[9]); ce_desc(v[10], v[12]);
    ce_desc(v[3], v[4]); ce_desc(v[5], v[6]); ce_desc(v[7], v[8]); ce_desc(v[9], v[10]); ce_desc(v[11], v[12]);
    ce_desc(v[6], v[7]); ce_desc(v[8], v[9]);
}
template <int N> __device__ __forceinline__ void bitonic_merge_desc(float* v) {
#pragma unroll
    for (int j = N >> 1; j > 0; j >>= 1)
#pragma unroll
        for (int i = 0; i < N; ++i) { const int l = i ^ j; if (l > i) ce_desc(v[i], v[l]); }
}
__device__ __forceinline__ void merge_top16(float* x, const float* y) {
#pragma unroll
    for (int i = 0; i < 16; ++i) x[i] = vmaxf(x[i], y[15 - i]);
    bitonic_merge_desc<16>(x);
}
__device__ __forceinline__ void insert16(float* t, float x) {
#pragma unroll
    for (int k = 0; k < 16; ++k) ce_desc(t[k], x);
}
constexpr int SK_ROW = 272, SK_MAT = 128 * SK_ROW;
__device__ __forceinline__ void p7_half(const bf16_t* qrow  , const LAS unsigned char* skl  , int hi4, float* T) {
    f32x16 acc[4];
#pragma unroll
    for (int nb = 0; nb < 4; ++nb)
#pragma unroll
        for (int r = 0; r < 16; ++r) acc[nb][r] = 0.f;
    bf16x8 bq[8];
#pragma unroll
    for (int ks = 0; ks < 8; ++ks) bq[ks] = *(const bf16x8*)(qrow + ks * 16);
#pragma unroll
    for (int ks = 0; ks < 8; ++ks) {
#pragma unroll
        for (int nb = 0; nb < 4; ++nb) { const bf16x8 ak = *(const LAS bf16x8*)(skl + nb * 32 * SK_ROW + ks * 32); acc[nb] = __builtin_amdgcn_mfma_f32_32x32x16_bf16(ak, bq[ks], acc[nb], 0, 0, 0); }
        if (ks & 1) __builtin_amdgcn_sched_barrier(0);
    }
    float L[16];
#pragma unroll
    for (int nb = 0; nb < 4; ++nb) {
        float v[16];
#pragma unroll
        for (int r = 0; r < 16; ++r) { const float sc = acc[nb][r]; v[r] = __uint_as_float((__float_as_uint(sc) & ~127u) | (unsigned)(nb * 16 + r)); }
        sort16_desc(v);
        if (nb == 0) {
#pragma unroll
            for (int r = 0; r < 16; ++r) L[r] = v[r];
        } else merge_top16(L, v);
    }
#pragma unroll
    for (int r = 0; r < 16; ++r) { const unsigned w = __builtin_bit_cast(unsigned, L[r]); T[r] = __builtin_bit_cast(float, w + (w & 0x3Cu) + (unsigned)hi4); }
}
__device__ __forceinline__ unsigned pick_byte(unsigned p0, unsigned p1, unsigned p2, unsigned p3, unsigned i) {
    const unsigned sel = (i & 7u) | 0x0c0c0c00u;
    const unsigned lo = __builtin_amdgcn_perm(p1, p0, sel), hi = __builtin_amdgcn_perm(p3, p2, sel);
    return (i & 8u) ? hi : lo;
}
__device__ __forceinline__ void p7_topk(const Args& a, unsigned char* lds, int tid, int lane, int wave) {
    const bf16_t* QP = (const bf16_t*)(a.ws + WS_QP); const bf16_t* SUBK = (const bf16_t*)(a.ws + WS_SUBK);
    unsigned short* EIDX = (unsigned short*)(a.ws + WS_EI); float* GATE = (float*)(a.ws + WS_GT);
    const int r32 = lane & 31, hi = lane >> 5;
    const int hp = blockIdx.x & 3, grp = blockIdx.x >> 2, ngrp = gridDim.x >> 2;
    { const u32x4* src = (const u32x4*)(SUBK + (size_t)hp * 4 * 128 * 128);
      for (int i = tid; i < 4 * 128 * 16; i += NTHR) { const int row = i >> 4, ch = i & 15; *(LAS u32x4*)((LAS unsigned char*)lds + row * SK_ROW + ch * 16) = src[i]; } }
    __syncthreads();
    const LAS unsigned char* skl = (const LAS unsigned char*)lds + r32 * SK_ROW + 16 * hi;
    for (int blk = grp * NWAVES + wave; blk < NTOK / 32; blk += ngrp * NWAVES) {
        const int tok = blk * 32 + r32;
        float M0[16], M1[16];
        {
            float B0[16], B1[16];
            p7_half(QP + (size_t)tok * PQ + (2 * hp) * 256 + 8 * hi, skl + 0 * SK_MAT, 4 * hi, M0);
            p7_half(QP + (size_t)tok * PQ + (2 * hp) * 256 + 128 + 8 * hi, skl + 1 * SK_MAT, 4 * hi, M1);
            p7_half(QP + (size_t)tok * PQ + (2 * hp + 1) * 256 + 8 * hi, skl + 2 * SK_MAT, 4 * hi, B0);
            p7_half(QP + (size_t)tok * PQ + (2 * hp + 1) * 256 + 128 + 8 * hi, skl + 3 * SK_MAT, 4 * hi, B1);
#pragma unroll
            for (int i = 0; i < 16; ++i) {
                const auto r0 = __builtin_amdgcn_permlane32_swap(__builtin_bit_cast(unsigned, M0[i]), __builtin_bit_cast(unsigned, B0[i]), false, false);
                const unsigned a0 = r0[0], b0 = r0[1]; M0[i] = __builtin_bit_cast(float, a0); B0[i] = __builtin_bit_cast(float, b0);
                const auto r1 = __builtin_amdgcn_permlane32_swap(__builtin_bit_cast(unsigned, M1[i]), __builtin_bit_cast(unsigned, B1[i]), false, false);
                const unsigned a1 = r1[0], b1 = r1[1]; M1[i] = __builtin_bit_cast(float, a1); B1[i] = __builtin_bit_cast(float, b1); }
            merge_top16(M0, B0); merge_top16(M1, B1);
        }
        const int h = 2 * hp + hi;
#define CAND(i, j) __builtin_bit_cast(float, (__builtin_bit_cast(unsigned, M0[i] + M1[j]) & ~255u) | (unsigned)((i) * 16 + (j)))
        float tc[16], l2[16], l3[16];
#pragma unroll
        for (int j = 0; j < 16; ++j) tc[j] = CAND(0, j);
#pragma unroll
        for (int j = 0; j < 8; ++j) { l2[j] = CAND(1, j); l2[8 + j] = CAND(15 - j, 0); }
        bitonic_merge_desc<16>(l2);
        merge_top16(tc, l2);
        l3[0] = CAND(2, 0); l3[1] = CAND(2, 1); l3[2] = CAND(2, 2); l3[3] = CAND(2, 3); l3[4] = CAND(2, 4); l3[5] = CAND(3, 0); l3[6] = CAND(3, 1); l3[7] = CAND(3, 2); l3[8] = CAND(3, 3);
        l3[9] = CAND(4, 0); l3[10] = CAND(4, 1); l3[11] = CAND(4, 2); l3[12] = CAND(5, 0); l3[13] = CAND(5, 1); l3[14] = CAND(6, 0); l3[15] = CAND(6, 1);
        sort16_desc(l3);
        merge_top16(tc, l3);
        insert16(tc, CAND(7, 0)); insert16(tc, CAND(7, 1));
#undef CAND
#define PK4(M, q) ((__builtin_bit_cast(unsigned, M[4 * (q)]) & 127u) | ((__builtin_bit_cast(unsigned, M[4 * (q) + 1]) & 127u) << 8) | ((__builtin_bit_cast(unsigned, M[4 * (q) + 2]) & 127u) << 16) | ((__builtin_bit_cast(unsigned, M[4 * (q) + 3]) & 127u) << 24))
        const unsigned a0 = PK4(M0, 0), a1 = PK4(M0, 1), a2 = PK4(M0, 2), a3 = PK4(M0, 3), b0 = PK4(M1, 0), b1 = PK4(M1, 1), b2 = PK4(M1, 2), b3 = PK4(M1, 3);
#undef PK4
        float e[16], sum = 0.f;
#pragma unroll
        for (int k = 0; k < 16; ++k) { e[k] = exp2f((tc[k] - tc[0]) * 1.4426950408889634f); sum += e[k]; }
        const float inv = 1.0f / sum;
        int eo[16];
#pragma unroll
        for (int k = 0; k < 16; ++k) { const unsigned code = __builtin_bit_cast(unsigned, tc[k]) & 255u; eo[k] = (int)(pick_byte(a0, a1, a2, a3, code >> 4) * 128u + pick_byte(b0, b1, b2, b3, code & 15u)); e[k] *= inv; }
        unsigned short* ep = EIDX + ((size_t)tok * 8 + h) * 16; float* gp = GATE + ((size_t)tok * 8 + h) * 16;
#pragma unroll
        for (int k = 0; k < 16; k += 8) { u32x4 pk; pk.x = (unsigned)eo[k] | ((unsigned)eo[k + 1] << 16); pk.y = (unsigned)eo[k + 2] | ((unsigned)eo[k + 3] << 16); pk.z = (unsigned)eo[k + 4] | ((unsigned)eo[k + 5] << 16); pk.w = (unsigned)eo[k + 6] | ((unsigned)eo[k + 7] << 16); *(u32x4*)(ep + k) = pk; }
#pragma unroll
        for (int k = 0; k < 16; k += 4) *(f32x4*)(gp + k) = (f32x4){e[k], e[k + 1], e[k + 2], e[k + 3]};
    }
}

typedef _Float16 h2_t __attribute__((ext_vector_type(2)));
typedef float f32x2 __attribute__((ext_vector_type(2)));
__device__ __forceinline__ float dot32_fp4(u32x4 w, const h2_t* xh) {
    float acc = 0.f;
#pragma unroll
    for (int d = 0; d < 4; ++d) {
        const unsigned wd = w[d];
        acc = __builtin_amdgcn_fdot2(__builtin_amdgcn_cvt_scalef32_pk_f16_fp4(wd, 1.0f, 0), xh[4 * d], acc, false);
        acc = __builtin_amdgcn_fdot2(__builtin_amdgcn_cvt_scalef32_pk_f16_fp4(wd, 1.0f, 1), xh[4 * d + 1], acc, false);
        acc = __builtin_amdgcn_fdot2(__builtin_amdgcn_cvt_scalef32_pk_f16_fp4(wd, 1.0f, 2), xh[4 * d + 2], acc, false);
        acc = __builtin_amdgcn_fdot2(__builtin_amdgcn_cvt_scalef32_pk_f16_fp4(wd, 1.0f, 3), xh[4 * d + 3], acc, false);
    }
    return acc;
}
typedef int i32x4 __attribute__((ext_vector_type(4)));
struct PMeta { unsigned p[8]; };
#define GAS __attribute__((address_space(1)))
template <class T> __device__ __forceinline__ GAS T* sgpr_ptr(T* p) { asm volatile("" : "+s"(p)); return (GAS T*)p; }
__device__ __forceinline__ void pm_load(PMeta& m, const unsigned short* EIDX, int t  , int seg) {
    const GAS unsigned char* rb = sgpr_ptr((const unsigned char*)(EIDX + (size_t)t * 128)); const unsigned lo = (unsigned)seg * 32u;
#pragma unroll
    for (int q = 0; q < 2; ++q) { const u32x4 ev = __builtin_nontemporal_load((const GAS u32x4*)(rb + (lo + q * 16u))); m.p[4 * q] = ev.x; m.p[4 * q + 1] = ev.y; m.p[4 * q + 2] = ev.z; m.p[4 * q + 3] = ev.w; }
}
#define SCHED_FENCE() __builtin_amdgcn_sched_barrier(0)
__device__ __forceinline__ void rows16_load(u32x4 (&w)[16], const unsigned char* Tbase, unsigned lane_off, const PMeta& m) {
#pragma unroll
    for (int j = 0; j < 16; ++j) { const unsigned pw = m.p[j >> 1]; const unsigned e = (j & 1) ? (pw >> 16) : (pw & 0xffffu); w[j] = *(const u32x4*)(Tbase + (e * 128u + lane_off)); }
}
#define PEER_GEOM() const int s4 = blockIdx.x & 3, th = (blockIdx.x >> 2) & 1, wq = (blockIdx.x >> 3) * NWAVES + wave, NWQ = (gridDim.x >> 3) * NWAVES, t_beg = th * (NTOK / 2) + wq, t_end = (th + 1) * (NTOK / 2)
#define TCL(t) ((t) < t_end ? (t) : t_end - 1)
typedef int v8i_t __attribute__((ext_vector_type(8)));
struct UTok { u32x4 A[8][2]; u32x4 B[2][2]; };
__device__ __forceinline__ void u_issue(UTok& T, const unsigned char* Ts  , const unsigned char* x8row  , unsigned idlo, unsigned idhi, int lane) {
    const int r16 = lane >> 2; const unsigned c16 = (unsigned)(lane & 3) * 16u; const unsigned q16 = (unsigned)(lane >> 4) * 16u;
#pragma unroll
    for (int h = 0; h < 8; ++h) { const unsigned e = (unsigned)__shfl((int)(h < 4 ? idlo : idhi), (h & 3) * 16 + r16);
#pragma unroll
        for (int ks = 0; ks < 2; ++ks) T.A[h][ks] = *(const u32x4*)(Ts + (e * 128u + 64u * ks + c16)); }
#pragma unroll
    for (int ks = 0; ks < 2; ++ks)
#pragma unroll
        for (int hf = 0; hf < 2; ++hf) T.B[ks][hf] = __builtin_nontemporal_load((const GAS u32x4*)(sgpr_ptr(x8row) + (128u * ks + 64u * hf + q16)));
}
__device__ __forceinline__ void u_compute(const UTok& T, int lane, float* dst  ) {
    f32x4 acc[8];
#pragma unroll
    for (int h = 0; h < 8; ++h) {
        acc[h] = (f32x4){0.f, 0.f, 0.f, 0.f};
#pragma unroll
        for (int ks = 0; ks < 2; ++ks) {
            const int src = (4 * (lane & 15) + (lane >> 4)) * 4;
            const v8i_t av = {__builtin_amdgcn_ds_bpermute(src, (int)T.A[h][ks].x), __builtin_amdgcn_ds_bpermute(src, (int)T.A[h][ks].y), __builtin_amdgcn_ds_bpermute(src, (int)T.A[h][ks].z), __builtin_amdgcn_ds_bpermute(src, (int)T.A[h][ks].w), 0, 0, 0, 0};
            const v8i_t bv = {(int)T.B[ks][0].x, (int)T.B[ks][0].y, (int)T.B[ks][0].z, (int)T.B[ks][0].w, (int)T.B[ks][1].x, (int)T.B[ks][1].y, (int)T.B[ks][1].z, (int)T.B[ks][1].w};
            acc[h] = __builtin_amdgcn_mfma_scale_f32_16x16x128_f8f6f4(av, bv, acc[h], 4  , 0  , 0, 0x7F7F7F7F, 0, 0x7F7F7F7F);
        }
    }
    const int j16 = lane & 15; f32x4 r = acc[0];
#pragma unroll
    for (int h = 1; h < 8; ++h) r = (j16 == h) ? acc[h] : r;
    if (j16 < 8) __builtin_nontemporal_store(r, (GAS f32x4*)(sgpr_ptr((unsigned char*)dst) + (unsigned)(j16 * 16 + (lane >> 4) * 4) * 4u));
}
__device__ __forceinline__ void p8a_u(const Args& a, int lane, int wave) {
    const unsigned short* EIDX = (const unsigned short*)(a.ws + WS_EI); float* PB = (float*)(a.ws + WS_PB);
    PEER_GEOM();
    const unsigned char* Ts = a.ws + WS_UT + (size_t)s4 * SLICE4; const unsigned char* x8 = a.ws + WS_X8 + s4 * 256;
    float* pb = PB + (size_t)s4 * NTOK * 128;
#define IDLOAD(lo, hi, t) do { const GAS unsigned short* ip_ = sgpr_ptr(EIDX + (size_t)(t) * 128); lo = ip_[lane]; hi = ip_[64 + lane]; } while (0)
    UTok TA, TB; unsigned ia0, ia1, ib0, ib1;
    IDLOAD(ia0, ia1, TCL(t_beg)); IDLOAD(ib0, ib1, TCL(t_beg + NWQ));
    u_issue(TA, Ts, x8 + (size_t)TCL(t_beg) * DM, ia0, ia1, lane);
    IDLOAD(ia0, ia1, TCL(t_beg + 2 * NWQ));
    for (int t = t_beg; t < t_end; t += 2 * NWQ) {
        SCHED_FENCE();
        u_issue(TB, Ts, x8 + (size_t)TCL(t + NWQ) * DM, ib0, ib1, lane); IDLOAD(ib0, ib1, TCL(t + 3 * NWQ));
        SCHED_FENCE();
        u_compute(TA, lane, pb + (size_t)t * 128);
        SCHED_FENCE();
        u_issue(TA, Ts, x8 + (size_t)TCL(t + 2 * NWQ) * DM, ia0, ia1, lane); IDLOAD(ia0, ia1, TCL(t + 4 * NWQ));
        SCHED_FENCE();
        if (t + NWQ < t_end) u_compute(TB, lane, pb + (size_t)(t + NWQ) * 128);
    }
#undef IDLOAD
}
__device__ __forceinline__ void p8c_combine(const Args& a, unsigned char* lds, int tid) {
    const float* PB = (const float*)(a.ws + WS_PB); unsigned* AB = (unsigned*)(a.ws + WS_AB); const float* GATE = (const float*)(a.ws + WS_GT); const float* SS = (const float*)(a.ws + WS_SS);
    const unsigned short* EIDX = (const unsigned short*)(a.ws + WS_EI); const float* su = (const float*)(a.ws + WS_USC); const float* sv = (const float*)(a.ws + WS_VSC);
    const size_t n4 = (size_t)NTOK * 128 / 4, nth = (size_t)gridDim.x * NTHR;
    LAS float* su_l = (LAS float*)lds; LAS float* sv_l = su_l + 16384;
    for (int i = tid; i < 16384 / 4; i += NTHR) { *(LAS f32x4*)(su_l + 4 * i) = *(const f32x4*)(su + 4 * i); *(LAS f32x4*)(sv_l + 4 * i) = *(const f32x4*)(sv + 4 * i); }
    __syncthreads();
    float calib;
    { unsigned a1 = 0u; a1 = __builtin_amdgcn_cvt_scalef32_pk_fp4_f32(a1, 1.0f, 1.0f, 1.0f, 0); a1 = __builtin_amdgcn_cvt_scalef32_pk_fp4_f32(a1, 1.0f, 1.0f, 1.0f, 1);
      a1 = __builtin_amdgcn_cvt_scalef32_pk_fp4_f32(a1, 1.0f, 1.0f, 1.0f, 2); a1 = __builtin_amdgcn_cvt_scalef32_pk_fp4_f32(a1, 1.0f, 1.0f, 1.0f, 3);
      unsigned b1 = (unsigned)__builtin_amdgcn_cvt_pk_fp8_f32(1.0f, 1.0f, 0, false); b1 = (unsigned)__builtin_amdgcn_cvt_pk_fp8_f32(1.0f, 1.0f, (int)b1, true);
      const v8i_t av = {(int)a1, (int)a1, (int)a1, (int)a1, 0, 0, 0, 0}, bv = {(int)b1, (int)b1, (int)b1, (int)b1, (int)b1, (int)b1, (int)b1, (int)b1};
      const f32x4 c = __builtin_amdgcn_mfma_scale_f32_16x16x128_f8f6f4(av, bv, (f32x4){0.f, 0.f, 0.f, 0.f}, 4, 0, 0, 0x7F7F7F7F, 0, 0x7F7F7F7F);
      calib = 128.0f / c[0] * (1.0f / X8SCALE); }
    for (size_t i = (size_t)blockIdx.x * NTHR + tid; i < n4; i += nth) {
        f32x4 d = __builtin_nontemporal_load((const f32x4*)PB + i);
#pragma unroll
        for (int s2 = 1; s2 < 4; ++s2) d += __builtin_nontemporal_load((const f32x4*)PB + (size_t)s2 * n4 + i);
        const f32x4 g = __builtin_nontemporal_load((const f32x4*)GATE + i); const u32x2 ew = __builtin_nontemporal_load((const u32x2*)EIDX + i);
        const unsigned e[4] = {ew.x & 0xffffu, ew.x >> 16, ew.y & 0xffffu, ew.y >> 16}; float o[4];
        const float cr = calib / sqrtf(SS[i >> 5] * (1.0f / DM) + EPS);
#pragma unroll
        for (int j = 0; j < 4; ++j) { const float z = d[j] * su_l[e[j]] * cr; o[j] = 0.5f * z * (1.0f + erff(z * 0.70710678118654752f)) * g[j] * sv_l[e[j]]; }
        unsigned w8 = (unsigned)__builtin_amdgcn_cvt_pk_fp8_f32(o[0] * A8SCALE, o[1] * A8SCALE, 0, false); w8 = (unsigned)__builtin_amdgcn_cvt_pk_fp8_f32(o[2] * A8SCALE, o[3] * A8SCALE, (int)w8, true); AB[i] = w8;
    }
}
typedef int v2i_t __attribute__((ext_vector_type(2)));
constexpr int VROW = 144, VIMG = 128 * VROW;
struct VRec { u32x4 a8[2]; u32x2 h; };
__device__ __forceinline__ void v_token(const u32x4 (&w)[16], const VRec& rc, LAS unsigned char* vl  , float oscale, int lane, float* dst  , bool do_store) {
    const int seg = lane >> 3, c8 = lane & 7, i16 = lane & 15, q = lane >> 4;
#pragma unroll
    for (int j = 0; j < 16; ++j) *(LAS u32x4*)(vl + (seg * 16 + j) * VROW + c8 * 16) = w[j];
    asm volatile("s_waitcnt lgkmcnt(0)" ::: "memory");
    const v8i_t av = {(int)rc.a8[0].x, (int)rc.a8[0].y, (int)rc.a8[0].z, (int)rc.a8[0].w, (int)rc.a8[1].x, (int)rc.a8[1].y, (int)rc.a8[1].z, (int)rc.a8[1].w};
    const LAS unsigned char* rp = vl + (32 * q + i16) * VROW;
    float val[4] = {0.f, 0.f, 0.f, 0.f};
#pragma unroll
    for (int cb = 0; cb < 16; ++cb) {
        const v2i_t r1 = __builtin_amdgcn_ds_read_tr4_b64_v2i32((LAS v2i_t*)(rp + cb * 8)), r2 = __builtin_amdgcn_ds_read_tr4_b64_v2i32((LAS v2i_t*)(rp + 16 * VROW + cb * 8));
        const v8i_t bv = {r1.x, r1.y, r2.x, r2.y, 0, 0, 0, 0};
        const f32x4 acc = __builtin_amdgcn_mfma_scale_f32_16x16x128_f8f6f4(av, bv, (f32x4){0.f, 0.f, 0.f, 0.f}, 0  , 4  , 0, 0x7F7F7F7F, 0, 0x7F7F7F7F);
        const float a0 = acc[0]; val[cb & 3] = (q == (cb >> 2)) ? a0 : val[cb & 3];
    }
    asm volatile("s_waitcnt lgkmcnt(0)" ::: "memory");
    if (do_store) {
        __builtin_nontemporal_store((f32x4){bflo(rc.h.x) + val[0] * oscale, bfhi(rc.h.x) + val[1] * oscale, bflo(rc.h.y) + val[2] * oscale, bfhi(rc.h.y) + val[3] * oscale}, (GAS f32x4*)(sgpr_ptr((unsigned char*)dst) + (unsigned)lane * 16u));
    } else asm volatile("" :: "v"(val[0]), "v"(val[1]), "v"(val[2]), "v"(val[3]));
}
__device__ __forceinline__ void p8b_v(const Args& a, unsigned char* lds, int lane, int wave, bool do_store) {
    const unsigned short* EIDX = (const unsigned short*)(a.ws + WS_EI); const unsigned char* AB = a.ws + WS_AB; const bf16_t* HB = (const bf16_t*)(a.ws + WS_HB);
    PEER_GEOM();
    const int seg = lane >> 3, c8 = lane & 7, q = lane >> 4;
    const unsigned char* Ts = a.ws + WS_UT + (size_t)(4 + s4) * SLICE4; const unsigned loff = c8 * 16;
    LAS unsigned char* vl = (LAS unsigned char*)lds + wave * VIMG;
    float oscale;
    { unsigned a1 = 0u; a1 = __builtin_amdgcn_cvt_scalef32_pk_fp4_f32(a1, 1.0f, 1.0f, 1.0f, 0); a1 = __builtin_amdgcn_cvt_scalef32_pk_fp4_f32(a1, 1.0f, 1.0f, 1.0f, 1);
      a1 = __builtin_amdgcn_cvt_scalef32_pk_fp4_f32(a1, 1.0f, 1.0f, 1.0f, 2); a1 = __builtin_amdgcn_cvt_scalef32_pk_fp4_f32(a1, 1.0f, 1.0f, 1.0f, 3);
      unsigned b1 = (unsigned)__builtin_amdgcn_cvt_pk_fp8_f32(1.0f, 1.0f, 0, false); b1 = (unsigned)__builtin_amdgcn_cvt_pk_fp8_f32(1.0f, 1.0f, (int)b1, true);
      const v8i_t av = {(int)b1, (int)b1, (int)b1, (int)b1, (int)b1, (int)b1, (int)b1, (int)b1}, bv = {(int)a1, (int)a1, (int)a1, (int)a1, 0, 0, 0, 0};
      const f32x4 c = __builtin_amdgcn_mfma_scale_f32_16x16x128_f8f6f4(av, bv, (f32x4){0.f, 0.f, 0.f, 0.f}, 0, 4, 0, 0x7F7F7F7F, 0, 0x7F7F7F7F);
      oscale = 128.0f / c[0] * (1.0f / A8SCALE); }
    const unsigned aoff = (unsigned)q * 16u, hoff = (unsigned)(s4 * 256 + 4 * lane) * 2u;
#define REC_LOAD(R, t) do { const GAS unsigned char* ab_ = sgpr_ptr(AB + (size_t)(t) * 128); R.a8[0] = __builtin_nontemporal_load((const GAS u32x4*)(ab_ + aoff)); R.a8[1] = __builtin_nontemporal_load((const GAS u32x4*)(ab_ + (64u + aoff))); \
        R.h = __builtin_nontemporal_load((const GAS u32x2*)(sgpr_ptr((const unsigned char*)(HB + (size_t)(t) * DM)) + hoff)); } while (0)
    PMeta mA, mB; u32x4 wA[16], wB[16]; VRec rA, rB;
    pm_load(mA, EIDX, TCL(t_beg), seg); pm_load(mB, EIDX, TCL(t_beg + NWQ), seg);
    rows16_load(wA, Ts, loff, mA); REC_LOAD(rA, TCL(t_beg));
    pm_load(mA, EIDX, TCL(t_beg + 2 * NWQ), seg);
    for (int t = t_beg; t < t_end; t += 2 * NWQ) {
        SCHED_FENCE();
        rows16_load(wB, Ts, loff, mB); REC_LOAD(rB, TCL(t + NWQ)); pm_load(mB, EIDX, TCL(t + 3 * NWQ), seg);
        SCHED_FENCE();
        v_token(wA, rA, vl, oscale, lane, a.out + (size_t)t * DM + s4 * 256, do_store);
        SCHED_FENCE();
        rows16_load(wA, Ts, loff, mA); REC_LOAD(rA, TCL(t + 2 * NWQ)); pm_load(mA, EIDX, TCL(t + 4 * NWQ), seg);
        SCHED_FENCE();
        if (t + NWQ < t_end) v_token(wB, rB, vl, oscale, lane, a.out + (size_t)(t + NWQ) * DM + s4 * 256, do_store);
    }
#undef REC_LOAD
#undef TCL
#undef PEER_GEOM
}

namespace pg8 {
#define PG8_LAS __attribute__((address_space(3)))
typedef unsigned short bf16_t;
typedef short bf16x8 __attribute__((ext_vector_type(8)));
typedef float f32x4 __attribute__((ext_vector_type(4)));
typedef unsigned u32x4 __attribute__((ext_vector_type(4)));
constexpr int BM = 256, BK = 64, HALF = 128, HTB = HALF * BK * 2  , STAGE_BYTES = 8 * HTB, NXCD = 8, WGM = 8;

__host__ __device__ __forceinline__ int lds_byte(int r, int c) { const int st = (r >> 4) * 2 + (c >> 5), rr = r & 15, cc = c & 31, ob = rr * 64 + cc * 2; return st * 1024 + (ob ^ (((ob >> 9) & 1) << 5)); }
__host__ __device__ __forceinline__ void stage_rc(int b, int& R, int& C) { const int st = b / 1024, sb = b % 1024, swz = sb ^ (((sb >> 9) & 1) << 5); R = (st >> 1) * 16 + swz / 64; C = (st & 1) * 32 + (swz % 64) / 2; }
__host__ __device__ __forceinline__ int perm32(int rho) { const int n = rho >> 4, i = rho & 15; return 8 * (i >> 2) + 4 * n + (i & 3); }

struct Unit { int pm, pn; };
struct Gemm { const bf16_t* A; const bf16_t* Bt; int M, N, K; };

struct StaticOrder {
    int nM, nN, nwg, G, c;
    __host__ __device__ void init(int M, int N, int G_, int c_) { nM = M / BM; nN = N / BM; nwg = nM * nN; G = G_; c = c_; }
    __host__ __device__ bool next(int i, Unit& u) const {
        const long L = (long)i * G + c; if (L >= nwg) return false;
        int wgid = (int)L; { const int q = nwg / NXCD, r = nwg % NXCD, xcd = wgid % NXCD, off = wgid / NXCD; wgid = (xcd < r ? xcd * (q + 1) : r * (q + 1) + (xcd - r) * q) + off; }
        const int nig = WGM * nN, gid = wgid / nig, fm = gid * WGM, gsz = (nM - fm) < WGM ? (nM - fm) : WGM;
        u.pm = fm + ((wgid % nig) % gsz); u.pn = (wgid % nig) / gsz; return true;
    }
    __device__ __forceinline__ void a_ready(const Unit&) const {}
    __device__ __forceinline__ void done(const Unit&) const {}
};


__device__ __forceinline__ unsigned cvt_pk_bf16(float lo, float hi) { unsigned r; asm volatile("v_cvt_pk_bf16_f32 %0, %1, %2" : "=v"(r) : "v"(lo), "v"(hi)); return r; }
struct EpiInProj {
    static constexpr bool PERM = true, AFTER_DRAIN = false;
    bf16_t* O; bf16_t* QB; bf16_t* KB; bf16_t* VB; const float* rope; const float* qg; const float* kg;
    template <bool NORM> __device__ __forceinline__ void head_row(f32x4 a00, f32x4 a01, f32x4 a10, f32x4 a11, const float* g0, const float* g1, int t, int fq, bf16_t* dst  ) const {
        float x0[8] = {a00[0], a00[1], a00[2], a00[3], a01[0], a01[1], a01[2], a01[3]}, x1[8] = {a10[0], a10[1], a10[2], a10[3], a11[0], a11[1], a11[2], a11[3]};
        if (NORM) {
            float ss = 0.f;
#pragma unroll
            for (int e = 0; e < 8; ++e) ss += x0[e] * x0[e] + x1[e] * x1[e];
            ss += __shfl_xor(ss, 16); ss += __shfl_xor(ss, 32);
            const float rstd = 1.0f / sqrtf(ss * (1.0f / 64.0f) + 1e-6f);
            const float* r0 = rope + (((t >> 6) * 16 + (fq & 1) * 8) * 2); const float* r1 = rope + (((t & 63) * 16 + (fq & 1) * 8) * 2);
            f32x4 c0[4], c1[4];
#pragma unroll
            for (int q4 = 0; q4 < 4; ++q4) { c0[q4] = *(const f32x4*)(r0 + 4 * q4); c1[q4] = *(const f32x4*)(r1 + 4 * q4); }
#pragma unroll
            for (int e = 0; e < 8; ++e) { x0[e] *= rstd * g0[e]; x1[e] *= rstd * g1[e]; }
#pragma unroll
            for (int e = 0; e < 8; ++e) { const float o0 = __shfl_xor(x0[e], 32), o1 = __shfl_xor(x1[e], 32);
                const float cs0 = c0[e >> 1][(e & 1) * 2], sn0 = c0[e >> 1][(e & 1) * 2 + 1], cs1 = c1[e >> 1][(e & 1) * 2], sn1 = c1[e >> 1][(e & 1) * 2 + 1];
                x0[e] = (fq & 2) ? x0[e] * cs0 + o0 * sn0 : x0[e] * cs0 - o0 * sn0; x1[e] = (fq & 2) ? x1[e] * cs1 + o1 * sn1 : x1[e] * cs1 - o1 * sn1; }
        }
        u32x4 w; w.x = cvt_pk_bf16(x0[0], x0[1]); w.y = cvt_pk_bf16(x0[2], x0[3]); w.z = cvt_pk_bf16(x0[4], x0[5]); w.w = cvt_pk_bf16(x0[6], x0[7]); *(u32x4*)dst = w;
        w.x = cvt_pk_bf16(x1[0], x1[1]); w.y = cvt_pk_bf16(x1[2], x1[3]); w.z = cvt_pk_bf16(x1[4], x1[5]); w.w = cvt_pk_bf16(x1[6], x1[7]); *(u32x4*)(dst + 32) = w;
    }
    __device__ __forceinline__ void operator()(const f32x4 (&acc)[2][2][4][2], const Unit& u, int wr, int wc, int fr, int fq) const {
        const int row0 = u.pm * BM + wr * 64 + fr, pn = u.pn;
        if (pn < 2) {
            const int col0 = 256 * pn + wc * 32 + 8 * fq;
#pragma unroll
            for (int ai = 0; ai < 2; ++ai)
#pragma unroll
                for (int m = 0; m < 4; ++m) { bf16_t* rowp = O + (size_t)(row0 + ai * HALF + m * 16) * 1024 + col0;
#pragma unroll
                    for (int bj = 0; bj < 2; ++bj) { const f32x4 v0 = acc[ai][bj][m][0], v1 = acc[ai][bj][m][1];
                        u32x4 w; w.x = cvt_pk_bf16(v0[0], v0[1]); w.y = cvt_pk_bf16(v0[2], v0[3]); w.z = cvt_pk_bf16(v1[0], v1[1]); w.w = cvt_pk_bf16(v1[2], v1[3]);
                        *(u32x4*)(rowp + bj * HALF) = w; } }
        } else if (pn < 6) {
            const int col0 = 512 + 128 * (pn - 2) + wc * 32 + 8 * fq;
#pragma unroll
            for (int ai = 0; ai < 2; ++ai)
#pragma unroll
                for (int m = 0; m < 4; ++m) { const f32x4 v0 = acc[ai][0][m][0] * acc[ai][1][m][0], v1 = acc[ai][0][m][1] * acc[ai][1][m][1];
                    u32x4 w; w.x = cvt_pk_bf16(v0[0], v0[1]); w.y = cvt_pk_bf16(v0[2], v0[3]); w.z = cvt_pk_bf16(v1[0], v1[1]); w.w = cvt_pk_bf16(v1[2], v1[3]);
                    *(u32x4*)(O + (size_t)(row0 + ai * HALF + m * 16) * 1024 + col0) = w; }
        } else if (pn < 8) {
            float g0[8], g1[8];
#pragma unroll
            for (int e = 0; e < 8; ++e) { g0[e] = qg[8 * fq + e] * C2; g1[e] = qg[32 + 8 * fq + e] * C2; }
            const int hh = 4 * (pn - 6) + wc;
#pragma unroll
            for (int ai = 0; ai < 2; ++ai)
#pragma unroll
                for (int m = 0; m < 4; ++m) { const int r = row0 + ai * HALF + m * 16;
                    head_row<true>(acc[ai][0][m][0], acc[ai][0][m][1], acc[ai][1][m][0], acc[ai][1][m][1], g0, g1, r & 2047, fq, QB + (size_t)r * 512 + hh * 64 + 8 * fq); }
        } else {
            float g0[8], g1[8];
#pragma unroll
            for (int e = 0; e < 8; ++e) { g0[e] = kg[8 * fq + e]; g1[e] = kg[32 + 8 * fq + e]; }
            const int g = wc & 1;
#pragma unroll
            for (int ai = 0; ai < 2; ++ai)
#pragma unroll
                for (int m = 0; m < 4; ++m) { const int r = row0 + ai * HALF + m * 16, b = r >> 11, t = r & 2047; const size_t krow = ((size_t)(b * 2 + g) * KROWS + t) * 64 + 8 * fq;
                    if (wc < 2) head_row<true>(acc[ai][0][m][0], acc[ai][0][m][1], acc[ai][1][m][0], acc[ai][1][m][1], g0, g1, t, fq, KB + krow);
                    else head_row<false>(acc[ai][0][m][0], acc[ai][0][m][1], acc[ai][1][m][0], acc[ai][1][m][1], g0, g1, t, fq, VB + krow); }
        }
    }
};
struct EpiBf16Rs {
    static constexpr bool PERM = true, AFTER_DRAIN = false;
    bf16_t* O; int ldc; const float* ss;
    __device__ __forceinline__ void operator()(const f32x4 (&acc)[2][2][4][2], const Unit& u, int wr, int wc, int fr, int fq) const {
        const int row0 = u.pm * BM + wr * 64 + fr; const int col0 = u.pn * BM + wc * 32 + 8 * fq;
        float rs[2][4];
#pragma unroll
        for (int ai = 0; ai < 2; ++ai)
#pragma unroll
            for (int m = 0; m < 4; ++m) rs[ai][m] = ss[row0 + ai * HALF + m * 16];
#pragma unroll
        for (int ai = 0; ai < 2; ++ai)
#pragma unroll
            for (int m = 0; m < 4; ++m) { const int r = row0 + ai * HALF + m * 16; const float f = 1.0f / sqrtf(rs[ai][m] * (1.0f / 1024.0f) + 1e-6f); bf16_t* rowp = O + (size_t)r * ldc + col0;
#pragma unroll
                for (int bj = 0; bj < 2; ++bj) { const f32x4 v0 = acc[ai][bj][m][0] * f, v1 = acc[ai][bj][m][1] * f;
                    u32x4 w; w.x = cvt_pk_bf16(v0[0], v0[1]); w.y = cvt_pk_bf16(v0[2], v0[3]); w.z = cvt_pk_bf16(v1[0], v1[1]); w.w = cvt_pk_bf16(v1[2], v1[3]);
                    *(u32x4*)(rowp + bj * HALF) = w; } }
    }
};
struct EpiResidNorm {
    static constexpr bool PERM = true, AFTER_DRAIN = false;
    const float* xp; const float* xs; float* out; int split_row; bf16_t* hb; unsigned char* h8; float* ss; float x8scale;
    __device__ __forceinline__ const float* xrow(int r, int col0) const { return (r < split_row ? xp + (size_t)r * 1024 : xs + (size_t)(r - split_row) * 1024) + col0; }
    __device__ __forceinline__ void operator()(const f32x4 (&acc)[2][2][4][2], const Unit& u, int wr, int wc, int fr, int fq) const {
        const int col0 = u.pn * BM + wc * 32 + 8 * fq, rbase = u.pm * BM + wr * 64 + fr;
        f32x4 xv[4][2][2];
#pragma unroll
        for (int m = 0; m < 4; ++m) { const float* xr = xrow(rbase + m * 16, col0);
#pragma unroll
            for (int bj = 0; bj < 2; ++bj) { xv[m][bj][0] = *(const f32x4*)(xr + bj * HALF); xv[m][bj][1] = *(const f32x4*)(xr + bj * HALF + 4); } }
#pragma unroll
        for (int ai = 0; ai < 2; ++ai)
#pragma unroll
            for (int m = 0; m < 4; ++m) { const int r = rbase + ai * HALF + m * 16;
                bf16_t* brow = hb + (size_t)r * 1024 + col0; unsigned char* qrow = h8 + (size_t)r * 1024 + col0; float s = 0.f;
                f32x4 h[2][2];
#pragma unroll
                for (int bj = 0; bj < 2; ++bj) { h[bj][0] = xv[m][bj][0] + acc[ai][bj][m][0]; h[bj][1] = xv[m][bj][1] + acc[ai][bj][m][1]; }
                if (ai == 0) { const float* xr = xrow(r + HALF, col0);
#pragma unroll
                    for (int bj = 0; bj < 2; ++bj) { xv[m][bj][0] = *(const f32x4*)(xr + bj * HALF); xv[m][bj][1] = *(const f32x4*)(xr + bj * HALF + 4); } }
#pragma unroll
                for (int bj = 0; bj < 2; ++bj) { const f32x4 h0 = h[bj][0], h1 = h[bj][1];
                    u32x4 wb; wb.x = cvt_pk_bf16(h0[0], h0[1]); wb.y = cvt_pk_bf16(h0[2], h0[3]); wb.z = cvt_pk_bf16(h1[0], h1[1]); wb.w = cvt_pk_bf16(h1[2], h1[3]); *(u32x4*)(brow + bj * HALF) = wb;
                    unsigned w0 = (unsigned)__builtin_amdgcn_cvt_pk_fp8_f32(h0[0] * x8scale, h0[1] * x8scale, 0, false); w0 = (unsigned)__builtin_amdgcn_cvt_pk_fp8_f32(h0[2] * x8scale, h0[3] * x8scale, (int)w0, true);
                    unsigned w1 = (unsigned)__builtin_amdgcn_cvt_pk_fp8_f32(h1[0] * x8scale, h1[1] * x8scale, 0, false); w1 = (unsigned)__builtin_amdgcn_cvt_pk_fp8_f32(h1[2] * x8scale, h1[3] * x8scale, (int)w1, true);
                    *(u32x2*)(qrow + bj * HALF) = (u32x2){w0, w1};
                    s += ((h0[0] * h0[0] + h0[1] * h0[1]) + (h0[2] * h0[2] + h0[3] * h0[3])) + ((h1[0] * h1[0] + h1[1] * h1[1]) + (h1[2] * h1[2] + h1[3] * h1[3])); }
                s += __shfl_xor(s, 16); s += __shfl_xor(s, 32);
                if (fq == 0) atomicAdd(ss + r, s); }
    }
};
struct EpiResid {
    static constexpr bool PERM = false, AFTER_DRAIN = false;
    const float* xp; const float* xs; float* out; int split_row;
    __device__ __forceinline__ void operator()(const f32x4 (&acc)[2][2][4][2], const Unit& u, int wr, int wc, int fr, int fq) const {
        const int col0 = u.pn * BM + wc * 32 + 4 * fq;
#pragma unroll
        for (int ai = 0; ai < 2; ++ai)
#pragma unroll
            for (int m = 0; m < 4; ++m) { const int r = u.pm * BM + ai * HALF + wr * 64 + m * 16 + fr;
                const float* xr = (r < split_row ? xp + (size_t)r * 1024 : xs + (size_t)(r - split_row) * 1024) + col0; float* orow = out + (size_t)r * 1024 + col0;
#pragma unroll
                for (int bj = 0; bj < 2; ++bj)
#pragma unroll
                    for (int n = 0; n < 2; ++n) { const f32x4 bs = *(const f32x4*)(xr + bj * HALF + n * 16); *(f32x4*)(orow + bj * HALF + n * 16) = bs + acc[ai][bj][m][n]; } }
    }
};

template <class Epi, class Sched, bool ALIGN_EPI = false, bool SP2 = false>
__device__ __forceinline__ void gemm_phase(PG8_LAS unsigned char* lds, const Gemm g, const Sched& S, const Epi& E) {
    const int tid = threadIdx.x, wid = __builtin_amdgcn_readfirstlane(tid >> 6), lane = tid & 63, wr = wid >> 2, wc = wid & 3, fr = lane & 15, fq = lane >> 4;
    const int K = g.K, nt = K / BK;
    unsigned voffA[2], voffB[2];
#pragma unroll
    for (int i = 0; i < 2; ++i) { int R, C; stage_rc(tid * 16 + i * 8192, R, C); const int Rb = Epi::PERM ? ((R & ~31) + perm32(R & 31)) : R;
        voffA[i] = (unsigned)(R * K + C) * 2u; voffB[i] = (unsigned)(Rb * K + C) * 2u; }
    const size_t kstep = (size_t)(BK * 2);
    const size_t hstep = (size_t)HALF * K * 2;
    const size_t tstep = 2 * hstep;
    const unsigned ldsw = (unsigned)wid * 1024u;
    const int aoff = lds_byte(wr * 64 + fr, fq * 8), boff = lds_byte(wc * 32 + fr, fq * 8);
#define PG8_SA(b, h) (((b) * 2 + (h)) * HTB)
#define PG8_SB(b, h) ((4 + (b) * 2 + (h)) * HTB)
#define PG8_STAGE(bufoff, gbase, voff) do { _Pragma("unroll") for (int _i = 0; _i < 2; ++_i) \
        __builtin_amdgcn_global_load_lds((const unsigned*)((const char*)(gbase) + (voff)[_i]), (PG8_LAS unsigned*)(lds + (bufoff) + ldsw + _i * 8192), 16, 0, 0); } while (0)
#define PG8_LDA(dst, b, h) do { _Pragma("unroll") for (int m = 0; m < 4; ++m) _Pragma("unroll") for (int k = 0; k < 2; ++k) dst[m][k] = *(const PG8_LAS bf16x8*)(lds + PG8_SA(b, h) + aoff + m * 2048 + k * 1024); } while (0)
#define PG8_LDB(dst, b, h) do { _Pragma("unroll") for (int n = 0; n < 2; ++n) _Pragma("unroll") for (int k = 0; k < 2; ++k) dst[n][k] = *(const PG8_LAS bf16x8*)(lds + PG8_SB(b, h) + boff + n * 2048 + k * 1024); } while (0)
#define PG8_MMA(ai, bj, At, Bt) do { __builtin_amdgcn_s_setprio(1); _Pragma("unroll") for (int m = 0; m < 4; ++m) _Pragma("unroll") for (int n = 0; n < 2; ++n) _Pragma("unroll") for (int k = 0; k < 2; ++k) \
        acc[ai][bj][m][n] = __builtin_amdgcn_mfma_f32_16x16x32_bf16(Bt[n][k], At[m][k], acc[ai][bj][m][n], 0, 0, 0); __builtin_amdgcn_s_setprio(0); } while (0)
#define PG8_WAIT_V(n) asm volatile("s_waitcnt vmcnt(" #n ")" ::: "memory")
#define PG8_WAIT_L(n) asm volatile("s_waitcnt lgkmcnt(" #n ")" ::: "memory")
#define PG8_BAR __builtin_amdgcn_s_barrier()
#define PG8_SCHED __builtin_amdgcn_sched_barrier(0)
    Unit cur, nxt; int ui = 0;
    if (!S.next(0, cur)) return;
    f32x4 acc[2][2][4][2];
#pragma unroll
    for (int a = 0; a < 2; ++a)
#pragma unroll
        for (int b = 0; b < 2; ++b)
#pragma unroll
            for (int m = 0; m < 4; ++m)
#pragma unroll
                for (int n = 0; n < 2; ++n) acc[a][b][m][n] = (f32x4){0.f, 0.f, 0.f, 0.f};
    bf16x8 At[4][2], B0[2][2], B1[2][2];
    const char* cA = (const char*)g.A + (size_t)cur.pm * tstep; const char* cB = (const char*)g.Bt + (size_t)cur.pn * tstep;
    S.a_ready(cur);
    if constexpr (SP2) {
        PG8_STAGE(PG8_SB(0, 0), cB, voffB); PG8_STAGE(PG8_SB(0, 1), cB + hstep, voffB); PG8_STAGE(PG8_SA(0, 0), cA, voffA); PG8_STAGE(PG8_SA(0, 1), cA + hstep, voffA);
        if (wr == 1) PG8_BAR;
        PG8_WAIT_V(2); PG8_BAR;
        PG8_STAGE(PG8_SB(1, 0), cB + kstep, voffB); PG8_STAGE(PG8_SA(1, 0), cA + kstep, voffA); PG8_STAGE(PG8_SB(1, 1), cB + hstep + kstep, voffB);
        PG8_WAIT_V(6); PG8_BAR;
    } else {
        PG8_STAGE(PG8_SB(0, 0), cB, voffB); PG8_STAGE(PG8_SA(0, 0), cA, voffA); PG8_STAGE(PG8_SB(0, 1), cB + hstep, voffB); PG8_STAGE(PG8_SA(0, 1), cA + hstep, voffA);
        if (wr == 1) PG8_BAR;
        PG8_WAIT_V(4); PG8_BAR;
        PG8_STAGE(PG8_SB(1, 0), cB + kstep, voffB); PG8_STAGE(PG8_SA(1, 0), cA + kstep, voffA); PG8_STAGE(PG8_SB(1, 1), cB + hstep + kstep, voffB);
        PG8_WAIT_V(6); PG8_BAR;
    }
    for (;;) {
        const bool has_next = S.next(ui + 1, nxt);
        const char* nA = has_next ? (const char*)g.A + (size_t)nxt.pm * tstep : cA; const char* nB = has_next ? (const char*)g.Bt + (size_t)nxt.pn * tstep : cB;
        for (int t = 0; t < nt; t += 2) {
            const bool last = (t == nt - 2);
            const char* a1 = cA + (size_t)(t + 1) * kstep;
            const char* a2 = last ? nA : cA + (size_t)(t + 2) * kstep; const char* b2 = last ? nB : cB + (size_t)(t + 2) * kstep;
            const char* a3 = a2 + kstep; const char* b3 = b2 + kstep;
            if (last && has_next) S.a_ready(nxt);
            if constexpr (SP2) {
            PG8_LDB(B0, 0, 0); PG8_LDB(B1, 0, 1); PG8_SCHED; PG8_LDA(At, 0, 0); PG8_STAGE(PG8_SA(1, 1), a1 + hstep, voffA);
            PG8_WAIT_V(8); PG8_WAIT_L(0); PG8_BAR; PG8_MMA(0, 0, At, B0); PG8_MMA(0, 1, At, B1); PG8_BAR; PG8_SCHED;
            PG8_LDA(At, 0, 1); PG8_STAGE(PG8_SB(0, 0), b2, voffB); PG8_STAGE(PG8_SB(0, 1), b2 + hstep, voffB); PG8_STAGE(PG8_SA(0, 0), a2, voffA);
            PG8_WAIT_V(8); PG8_WAIT_L(0); PG8_BAR; PG8_MMA(1, 0, At, B0); PG8_MMA(1, 1, At, B1); PG8_BAR; PG8_SCHED;
            PG8_LDB(B0, 1, 0); PG8_LDB(B1, 1, 1); PG8_SCHED; PG8_LDA(At, 1, 0); PG8_STAGE(PG8_SA(0, 1), a2 + hstep, voffA);
            PG8_WAIT_V(8); PG8_WAIT_L(0); PG8_BAR; PG8_MMA(0, 0, At, B0); PG8_MMA(0, 1, At, B1); PG8_BAR; PG8_SCHED;
            PG8_LDA(At, 1, 1); PG8_STAGE(PG8_SB(1, 0), b3, voffB); PG8_STAGE(PG8_SB(1, 1), b3 + hstep, voffB); PG8_STAGE(PG8_SA(1, 0), a3, voffA);
            PG8_WAIT_V(8); PG8_WAIT_L(0); PG8_BAR; PG8_MMA(1, 0, At, B0); PG8_MMA(1, 1, At, B1); PG8_BAR; PG8_SCHED;
            } else {
            PG8_LDB(B0, 0, 0); PG8_SCHED; PG8_LDA(At, 0, 0); PG8_STAGE(PG8_SA(1, 1), a1 + hstep, voffA);
            PG8_WAIT_L(8); PG8_BAR; PG8_WAIT_L(0); PG8_MMA(0, 0, At, B0); PG8_BAR; PG8_SCHED;
            PG8_LDB(B1, 0, 1); PG8_STAGE(PG8_SB(0, 0), b2, voffB);
            PG8_BAR; PG8_WAIT_L(0); PG8_MMA(0, 1, At, B1); PG8_BAR;
            PG8_LDA(At, 0, 1); PG8_STAGE(PG8_SA(0, 0), a2, voffA);
            PG8_BAR; PG8_WAIT_L(0); PG8_MMA(1, 0, At, B0); PG8_BAR; PG8_SCHED;
            PG8_STAGE(PG8_SB(0, 1), b2 + hstep, voffB);
            PG8_WAIT_V(6); PG8_BAR; PG8_MMA(1, 1, At, B1); PG8_BAR;
            PG8_LDB(B0, 1, 0); PG8_SCHED; PG8_LDA(At, 1, 0); PG8_STAGE(PG8_SA(0, 1), a2 + hstep, voffA);
            PG8_WAIT_L(8); PG8_BAR; PG8_WAIT_L(0); PG8_MMA(0, 0, At, B0); PG8_BAR; PG8_SCHED;
            PG8_LDB(B1, 1, 1); PG8_STAGE(PG8_SB(1, 0), b3, voffB);
            PG8_BAR; PG8_WAIT_L(0); PG8_MMA(0, 1, At, B1); PG8_BAR;
            PG8_LDA(At, 1, 1); PG8_STAGE(PG8_SA(1, 0), a3, voffA);
            PG8_BAR; PG8_WAIT_L(0); PG8_MMA(1, 0, At, B0); PG8_BAR; PG8_SCHED;
            PG8_STAGE(PG8_SB(1, 1), b3 + hstep, voffB);
            PG8_WAIT_V(6); PG8_BAR; PG8_MMA(1, 1, At, B1); PG8_BAR;
            }
        }
        if constexpr (ALIGN_EPI) { if (wr == 0) PG8_BAR; }
        if constexpr (!Epi::AFTER_DRAIN) { E(acc, cur, wr, wc, fr, fq); S.done(cur); }
        if (!has_next) break;
#pragma unroll
        for (int a = 0; a < 2; ++a)
#pragma unroll
            for (int b = 0; b < 2; ++b)
#pragma unroll
                for (int m = 0; m < 4; ++m)
#pragma unroll
                    for (int n = 0; n < 2; ++n) acc[a][b][m][n] = (f32x4){0.f, 0.f, 0.f, 0.f};
        cur = nxt; cA = nA; cB = nB; ++ui;
        if constexpr (ALIGN_EPI) { if (wr == 1) PG8_BAR; }
    }
    PG8_WAIT_V(0);
    if constexpr (!ALIGN_EPI) { if (wr == 0) PG8_BAR; }
    PG8_BAR;
    if constexpr (Epi::AFTER_DRAIN) { E.fused(acc, cur, wr, wc, fr, fq, lds, wid, lane); S.done(cur); }
#undef PG8_SA
#undef PG8_SB
#undef PG8_STAGE
#undef PG8_LDA
#undef PG8_LDB
#undef PG8_MMA
#undef PG8_WAIT_V
#undef PG8_WAIT_L
#undef PG8_BAR
#undef PG8_SCHED
}
}


#include <hip/hip_bf16.h>
#include <cmath>
namespace attn_body {
using bf16=__hip_bfloat16;
using bf16x8=__attribute__((ext_vector_type(8)))short;
using s16x4=__attribute__((ext_vector_type(4)))short;
using f32x16=__attribute__((ext_vector_type(16)))float;
using u32x4=__attribute__((ext_vector_type(4)))unsigned;
constexpr int SEQ=2048,D=64,QP=512,KVP=64,OP=1024,KVROWS=2112;
constexpr int NW=8,QBLK=32,QB=QBLK*NW,KVBLK=64,NQB=SEQ/QB,NT=KVROWS/KVBLK;
constexpr int ATTN_UNIT_ROWS=QB;
__device__ __forceinline__ int crow(int r,int hi){return (r&3)+8*(r>>2)+4*hi;}
#define SBAR() __builtin_amdgcn_sched_barrier(0)
__device__ __forceinline__ void tmask(f32x16&p0,f32x16&p1){
  const float NEG=-INFINITY;
  #pragma unroll
  for(int r=8;r<16;++r)p0[r]=NEG;
  #pragma unroll
  for(int r=0;r<16;++r)p1[r]=NEG;
}

constexpr int NSLOT=3, SLOTB=8192;
constexpr int LDS_K=0, LDS_V=NSLOT*SLOTB, LDS_WS=2*NSLOT*SLOTB, LDS_OST=LDS_WS+NW*64*4, LDS_BYTES=LDS_OST+NW*4096;
constexpr float C2=0.125f*1.4426950408889634f;
__device__ __forceinline__ void glds16(const void*gsrc,unsigned lds_dst){unsigned keep;
  asm volatile("s_mov_b32 %0, m0\n\ts_mov_b32 m0, %2\n\ts_nop 0\n\tglobal_load_lds_dwordx4 %1, off\n\ts_mov_b32 m0, %0":"=&s"(keep):"v"(gsrc),"s"(lds_dst):"memory");}
__device__ __forceinline__ float max3f(float a,float b,float c){float r;asm("v_max3_f32 %0, %1, %2, %3":"=v"(r):"v"(a),"v"(b),"v"(c));return r;}
__device__ __forceinline__ float max2f(float a,float b){float r;asm("v_max_f32_e32 %0, %1, %2":"=v"(r):"v"(a),"v"(b));return r;}
__device__ __forceinline__ float fadd_s(float a,float b){float r;asm("v_add_f32_e32 %0, %1, %2":"=v"(r):"v"(a),"v"(b));return r;}
__device__ __forceinline__ float fsub_s(float a,float b){float r;asm("v_sub_f32_e32 %0, %1, %2":"=v"(r):"v"(a),"v"(b));return r;}
typedef float f32x2_t __attribute__((ext_vector_type(2))); typedef float f32x4_t __attribute__((ext_vector_type(4))); typedef __bf16 bf16x2_t __attribute__((ext_vector_type(2)));
__device__ __forceinline__ unsigned cvtpk_s(float lo,float hi){f32x2_t v={lo,hi};bf16x2_t b=__builtin_convertvector(v,bf16x2_t);return __builtin_bit_cast(unsigned,b);}
#define WAIT_BAR(N) asm volatile("s_waitcnt vmcnt(" #N ") lgkmcnt(0)\n\ts_barrier":::"memory")

__device__ __forceinline__ void qkt(f32x16&p0,f32x16&p1,const char*Kslot,const bf16x8*qr,const f32x16&negm,int r32,int hi){
  const char*kb=Kslot+hi*1024+r32*16;
  #pragma unroll
  for(int d0=0;d0<4;++d0){
    const bf16x8 b0=*reinterpret_cast<const bf16x8*>(kb+d0*2048);
    const bf16x8 b1=*reinterpret_cast<const bf16x8*>(kb+d0*2048+512);
    if(d0==0){p0=__builtin_amdgcn_mfma_f32_32x32x16_bf16(b0,qr[0],negm,0,0,0);p1=__builtin_amdgcn_mfma_f32_32x32x16_bf16(b1,qr[0],negm,0,0,0);}
    else{p0=__builtin_amdgcn_mfma_f32_32x32x16_bf16(b0,qr[d0],p0,0,0,0);p1=__builtin_amdgcn_mfma_f32_32x32x16_bf16(b1,qr[d0],p1,0,0,0);}}
}
typedef __attribute__((address_space(3))) const char* lds_cptr;
typedef short v4i16_t __attribute__((ext_vector_type(4)));
__device__ __forceinline__ void kload8(bf16x8*kf,lds_cptr kp){
  kf[0]=*(const __attribute__((address_space(3))) bf16x8*)(kp);      kf[1]=*(const __attribute__((address_space(3))) bf16x8*)(kp+512);
  kf[2]=*(const __attribute__((address_space(3))) bf16x8*)(kp+2048); kf[3]=*(const __attribute__((address_space(3))) bf16x8*)(kp+2560);
  kf[4]=*(const __attribute__((address_space(3))) bf16x8*)(kp+4096); kf[5]=*(const __attribute__((address_space(3))) bf16x8*)(kp+4608);
  kf[6]=*(const __attribute__((address_space(3))) bf16x8*)(kp+6144); kf[7]=*(const __attribute__((address_space(3))) bf16x8*)(kp+6656);
}
__device__ __forceinline__ void kload2(bf16x8*kf,lds_cptr kp,int j){ kf[2*j]=*(const __attribute__((address_space(3))) bf16x8*)(kp+j*2048); kf[2*j+1]=*(const __attribute__((address_space(3))) bf16x8*)(kp+j*2048+512); }
__device__ __forceinline__ s16x4 vtr(lds_cptr p){ return __builtin_bit_cast(s16x4,__builtin_amdgcn_ds_read_tr16_b64_v4i16((__attribute__((address_space(3))) v4i16_t*)p)); }
__device__ __forceinline__ float rowmax(const f32x16&p0,const f32x16&p1){
  float a=max3f(p0[0],p0[1],p1[0]),b=max3f(p0[2],p0[3],p1[1]);a=max3f(a,p1[2],p1[3]);
  #pragma unroll
  for(int r=4;r<16;r+=4){a=max3f(a,p0[r],p0[r+1]);b=max3f(b,p0[r+2],p0[r+3]);a=max3f(a,p1[r],p1[r+1]);b=max3f(b,p1[r+2],p1[r+3]);}
  const float m=max2f(a,b);
  auto rr=__builtin_amdgcn_permlane32_swap(__float_as_uint(m),__float_as_uint(m),false,false);
  return max2f(__uint_as_float(rr[0]),__uint_as_float(rr[1]));
}
__device__ __forceinline__ void pv(f32x16*o,int vb,bf16x8 pa0,bf16x8 pa1,bf16x8 pa2,bf16x8 pa3){
  #pragma unroll
  for(int d0=0;d0<2;++d0){s16x4 lo[4],hi[4];
    #pragma unroll
    for(int ks=0;ks<4;++ks){
      asm volatile("ds_read_b64_tr_b16 %0,%1 offset:%c2":"=&v"(lo[ks]):"v"(vb),"i"(d0*4096+ks*1024):"memory");
      asm volatile("ds_read_b64_tr_b16 %0,%1 offset:%c2":"=&v"(hi[ks]):"v"(vb),"i"(d0*4096+ks*1024+512):"memory");}
    asm volatile("s_waitcnt lgkmcnt(0)":::"memory");SBAR();
    #define PK(k) (bf16x8){lo[k][0],lo[k][1],lo[k][2],lo[k][3],hi[k][0],hi[k][1],hi[k][2],hi[k][3]}
    o[d0]=__builtin_amdgcn_mfma_f32_32x32x16_bf16(pa0,PK(0),o[d0],0,0,0);
    o[d0]=__builtin_amdgcn_mfma_f32_32x32x16_bf16(pa1,PK(1),o[d0],0,0,0);
    o[d0]=__builtin_amdgcn_mfma_f32_32x32x16_bf16(pa2,PK(2),o[d0],0,0,0);
    o[d0]=__builtin_amdgcn_mfma_f32_32x32x16_bf16(pa3,PK(3),o[d0],0,0,0);
    #undef PK
  }
}

#ifndef ATTN_STORE16
#define ATTN_STORE16(p,v) (*(u32x4*)(p)=(v))
#endif
template<int THRL> __device__ __forceinline__ void attn_unit(int b,int h,int qb,const bf16*Q,const bf16*__restrict__ K,const bf16*__restrict__ V,bf16*O,const float*__restrict__ gain,char*shm){
  const int tid=threadIdx.x,lane=tid&63,r32=lane&31,hi=lane>>5; const int wid=__builtin_amdgcn_readfirstlane(tid>>6);
  const long rowbase=(long)b*SEQ; const int q0=qb*QB;
  const bf16*Qw=Q+(rowbase+q0+wid*QBLK)*QP+h*D;
  const bf16*Kh=K+(long)(b*2+(h>>2))*KVROWS*KVP,*Vh=V+(long)(b*2+(h>>2))*KVROWS*KVP;
  const unsigned lds0=(unsigned)(uintptr_t)shm;
  float*wsf=(float*)(shm+LDS_WS)+wid*64;
  const bf16*ksrc=Kh+(long)lane*KVP+wid*8;
  const bf16*vsrc=Vh+(long)(16*(wid&3)+(lane>>2))*KVP+(wid>>2)*32+(lane&3)*8;
  const unsigned kdst=lds0+LDS_K+wid*1024, vdst=lds0+LDS_V+wid*1024;
  #define DMA_K(t,slot) glds16(ksrc+(long)(t)*KVBLK*KVP,(unsigned)__builtin_amdgcn_readfirstlane(kdst+(slot)))
  #define DMA_V(t,slot) glds16(vsrc+(long)(t)*KVBLK*KVP,(unsigned)__builtin_amdgcn_readfirstlane(vdst+(slot)))
  const int vb0=(int)(lds0+LDS_V)+((lane>>4)&1)*32+(lane&3)*8+(4*hi+((lane&15)>>2))*64;
  const char*Kbase=shm+LDS_K; bf16x8 kf[8];
  const lds_cptr shm3=(lds_cptr)shm; const lds_cptr kp0=shm3+LDS_K+hi*1024+r32*16; const lds_cptr vp0=shm3+LDS_V+((lane>>4)&1)*32+(lane&3)*8+(4*hi+((lane&15)>>2))*64;
  DMA_K(0,0);DMA_V(0,0);DMA_K(1,SLOTB);
  bf16x8 qr[4];
  #pragma unroll
  for(int d0=0;d0<4;++d0)qr[d0]=*reinterpret_cast<const bf16x8*>(&Qw[(long)r32*QP+d0*16+hi*8]);
  float mhat=0.f,l_reg=0.f;f32x16 o[2];o[0]=f32x16{};o[1]=f32x16{};f32x16 negm=f32x16{};asm volatile("":"+v"(negm));
  #define CMASK(P0,P1,t) do{}while(0)
  bool resc=false;
  #define START(P0,P1) do{ const float rm=rowmax(P0,P1); resc=false; \
    { const float dl=rm; mhat=fadd_s(mhat,dl); \
      _Pragma("unroll") for(int r=0;r<16;++r){P0[r]=fsub_s(P0[r],dl);P1[r]=fsub_s(P1[r],dl);} \
      _Pragma("unroll") for(int r=0;r<16;++r)negm[r]=-mhat; asm volatile("":"+v"(negm)); } \
    _Pragma("unroll") for(int r=0;r<16;++r)P0[r]=__builtin_amdgcn_exp2f(P0[r]); }while(0)
  #define RESC() do{ if(resc){ asm volatile("s_waitcnt lgkmcnt(0)":::"memory"); \
      _Pragma("unroll") for(int d_=0;d_<2;++d_) _Pragma("unroll") for(int r=0;r<16;++r)o[d_][r]*=wsf[crow(r,hi)]; } }while(0)
  f32x16 pA0,pA1,pB0,pB1;
  int sl_prev=0,sl_cur=0,sl_next=SLOTB;
  #define ROT() do{sl_prev=sl_cur;sl_cur=sl_next;sl_next=(sl_next==(NSLOT-1)*SLOTB)?0:sl_next+SLOTB;}while(0)
  DMA_K(2,2*SLOTB);
  WAIT_BAR(3);
  qkt(pA0,pA1,Kbase,qr,negm,r32,hi);asm volatile("s_nop 15\n\ts_nop 7":"+v"(pA0),"+v"(pA1));CMASK(pA0,pA1,0);
  START(pA0,pA1);
  _Pragma("unroll") for(int r=0;r<16;++r)pA1[r]=__builtin_amdgcn_exp2f(pA1[r]);
  WAIT_BAR(0);
  DMA_K(3,0);DMA_V(1,SLOTB);
  ROT();
  kload8(kf,kp0+sl_cur);
  WAIT_BAR(2);
  s16x4 vlo[8],vhi[8]; u32x4 pw0,pw1,pw2,pw3;
  #define PKW(P,B) cvtpk_s(P[B],P[B+1])
  #define PAF(k) __builtin_bit_cast(bf16x8,pw##k)
  #define VFR(i) (bf16x8){vlo[i][0],vlo[i][1],vlo[i][2],vlo[i][3],vhi[i][0],vhi[i][1],vhi[i][2],vhi[i][3]}
  #define PIN(x) asm volatile("":"+v"(x))
  #define MX3(a,b,c) __builtin_fmaxf(__builtin_fmaxf((a),(b)),(c))
  #define GAPA(MF,A0,A1,A2,A3,W0,W1,PW) do{ MF; sacc+=A0; sacc+=A1; sacc+=A2; sacc+=A3; PIN(sacc); W0; W1; PIN(PW); SBAR(); }while(0)
  #define EX(v) __builtin_amdgcn_exp2f(v)
  #define GAPB(MF,X,B) do{ MF; X[B]=EX(X[B]); X[B+1]=EX(X[B+1]); X[B+2]=EX(X[B+2]); X[B+3]=EX(X[B+3]); PIN(X); SBAR(); }while(0)
  #define VRD(i) do{ vlo[i]=vtr(vp_+(((i)>>2)*4096+((i)&3)*1024)); vhi[i]=vtr(vp_+(((i)>>2)*4096+((i)&3)*1024+512)); }while(0)
  #define KRD(G,j) do{ if(G){ kload2(kf,kp0+sl_next,j); SBAR(); } }while(0)
  #define STEP(C0,C1,P0,P1,t,GK,GV,GL) do{ SBAR(); \
    const lds_cptr vp_=vp0+sl_prev; \
    VRD(0); SBAR(); float sacc=(P0[0]+P0[1]); \
    GAPA(C0=__builtin_amdgcn_mfma_f32_32x32x16_bf16(kf[0],qr[0],negm,0,0,0), P0[2],P0[3],P0[4],P0[5],     pw0[0]=PKW(P0,0), pw0[1]=PKW(P0,2), pw0); \
    VRD(4); SBAR(); GAPA(C1=__builtin_amdgcn_mfma_f32_32x32x16_bf16(kf[1],qr[0],negm,0,0,0), P0[6],P0[7],P0[8],P0[9],     pw0[2]=PKW(P0,4), pw0[3]=PKW(P0,6), pw0); \
    VRD(1); SBAR(); GAPA(C0=__builtin_amdgcn_mfma_f32_32x32x16_bf16(kf[2],qr[1],C0,0,0,0),   P0[10],P0[11],P0[12],P0[13], pw1[0]=PKW(P0,8), pw1[1]=PKW(P0,10), pw1); \
    VRD(5); SBAR(); GAPA(C1=__builtin_amdgcn_mfma_f32_32x32x16_bf16(kf[3],qr[1],C1,0,0,0),   P0[14],P0[15],P1[0],P1[1],   pw1[2]=PKW(P0,12),pw1[3]=PKW(P0,14), pw1); \
    VRD(2); SBAR(); GAPA(C0=__builtin_amdgcn_mfma_f32_32x32x16_bf16(kf[4],qr[2],C0,0,0,0),   P1[2],P1[3],P1[4],P1[5],     pw2[0]=PKW(P1,0), pw2[1]=PKW(P1,2), pw2); \
    VRD(6); SBAR(); GAPA(C1=__builtin_amdgcn_mfma_f32_32x32x16_bf16(kf[5],qr[2],C1,0,0,0),   P1[6],P1[7],P1[8],P1[9],     pw2[2]=PKW(P1,4), pw2[3]=PKW(P1,6), pw2); \
    VRD(3); SBAR(); GAPA(C0=__builtin_amdgcn_mfma_f32_32x32x16_bf16(kf[6],qr[3],C0,0,0,0),   P1[10],P1[11],P1[12],P1[13], pw3[0]=PKW(P1,8), pw3[1]=PKW(P1,10), pw3); \
    VRD(7); SBAR(); GAPA(C1=__builtin_amdgcn_mfma_f32_32x32x16_bf16(kf[7],qr[3],C1,0,0,0),   P1[14],P1[15],0.f,0.f,       pw3[2]=PKW(P1,12),pw3[3]=PKW(P1,14), pw3); \
    l_reg+=sacc; \
    if(GK){DMA_K((t)+3,sl_cur);} if(GV){DMA_V((t)+1,sl_next);} \
    CMASK(C0,C1,t); \
    { float a=MX3(C0[0],C0[1],C1[0]),b=MX3(C0[2],C0[3],C1[1]); a=MX3(a,C1[2],C1[3]); \
      _Pragma("unroll") for(int r=4;r<16;r+=4){a=MX3(a,C0[r],C0[r+1]);b=MX3(b,C0[r+2],C0[r+3]);a=MX3(a,C1[r],C1[r+1]);b=MX3(b,C1[r+2],C1[r+3]);} \
      float rm=__builtin_fmaxf(a,b); { auto rr=__builtin_amdgcn_permlane32_swap(__float_as_uint(rm),__float_as_uint(rm),false,false); rm=__builtin_fmaxf(__uint_as_float(rr[0]),__uint_as_float(rr[1])); } \
      resc=false; \
      if(__builtin_expect(__any(rm>(float)THRL),0)){ const float dl=__builtin_fmaxf(rm,0.f); mhat+=dl; \
        _Pragma("unroll") for(int r=0;r<16;++r){C0[r]-=dl;C1[r]-=dl;} \
        _Pragma("unroll") for(int r=0;r<16;++r)negm[r]=-mhat; asm volatile("":"+v"(negm)); \
        const float f=__builtin_amdgcn_exp2f(-dl); l_reg*=f; if(hi==0)wsf[r32]=f; resc=true; } } \
    SBAR(); \
    GAPB(o[0]=__builtin_amdgcn_mfma_f32_32x32x16_bf16(PAF(0),VFR(0),o[0],0,0,0), C0,0); \
    GAPB(o[1]=__builtin_amdgcn_mfma_f32_32x32x16_bf16(PAF(0),VFR(4),o[1],0,0,0), C0,4); \
    KRD(GL,0); GAPB(o[0]=__builtin_amdgcn_mfma_f32_32x32x16_bf16(PAF(1),VFR(1),o[0],0,0,0), C0,8); \
    KRD(GL,1); GAPB(o[1]=__builtin_amdgcn_mfma_f32_32x32x16_bf16(PAF(1),VFR(5),o[1],0,0,0), C0,12); \
    KRD(GL,2); GAPB(o[0]=__builtin_amdgcn_mfma_f32_32x32x16_bf16(PAF(2),VFR(2),o[0],0,0,0), C1,0); \
    KRD(GL,3); GAPB(o[1]=__builtin_amdgcn_mfma_f32_32x32x16_bf16(PAF(2),VFR(6),o[1],0,0,0), C1,4); \
    GAPB(o[0]=__builtin_amdgcn_mfma_f32_32x32x16_bf16(PAF(3),VFR(3),o[0],0,0,0), C1,8); \
    GAPB(o[1]=__builtin_amdgcn_mfma_f32_32x32x16_bf16(PAF(3),VFR(7),o[1],0,0,0), C1,12); \
    }while(0)
  int t=1;
  #undef CMASK
  #define CMASK(P0,P1,t) do{}while(0)
  for(;t+5<NT;t+=2){
    STEP(pB0,pB1,pA0,pA1,t,true,true,true);     WAIT_BAR(2); RESC(); ROT();
    STEP(pA0,pA1,pB0,pB1,t+1,true,true,true);   WAIT_BAR(2); RESC(); ROT();
  }
  #undef CMASK
  #define CMASK(P0,P1,t) do{ if((t)==NT-1)tmask(P0,P1); }while(0)
  #define ENDW(tt) do{ if((tt)+3<NT){WAIT_BAR(2);} else if((tt)+2<NT){WAIT_BAR(1);} else {WAIT_BAR(0);} }while(0)
  for(;t+1<NT;t+=2){
    STEP(pB0,pB1,pA0,pA1,t,(t+3<NT),(t+1<NT),(t+1<NT));       ENDW(t);   RESC(); ROT();
    STEP(pA0,pA1,pB0,pB1,t+1,(t+4<NT),(t+2<NT),(t+2<NT));     ENDW(t+1); RESC(); ROT();
  }
  static_assert((NT&1)==1&&NT>=7,"odd tile count: the pair loops end on tile NT-1 (scores in buffer A)");
  { float sacc=pA0[0]+pA0[1]; _Pragma("unroll") for(int r=2;r<16;++r)sacc+=pA0[r]; _Pragma("unroll") for(int r=0;r<16;++r)sacc+=pA1[r]; l_reg+=sacc;
    pw0=(u32x4){PKW(pA0,0),PKW(pA0,2),PKW(pA0,4),PKW(pA0,6)};pw1=(u32x4){PKW(pA0,8),PKW(pA0,10),PKW(pA0,12),PKW(pA0,14)};pw2=(u32x4){PKW(pA1,0),PKW(pA1,2),PKW(pA1,4),PKW(pA1,6)};pw3=(u32x4){PKW(pA1,8),PKW(pA1,10),PKW(pA1,12),PKW(pA1,14)};
    SBAR(); pv(o,vb0+sl_prev,PAF(0),PAF(1),PAF(2),PAF(3)); }
  #undef PKW
  #undef PAF
  #undef VFR
  #undef PIN
  #undef MX3
  #undef GAPA
  #undef GAPB
  #undef EX
  #undef VRD
  #undef KRD
  #undef STEP
  #undef ENDW
  {auto rr=__builtin_amdgcn_permlane32_swap(__float_as_uint(l_reg),__float_as_uint(l_reg),false,false);l_reg=__uint_as_float(rr[0])+__uint_as_float(rr[1]);}
  if(hi==0)wsf[32+r32]=l_reg;asm volatile("s_waitcnt lgkmcnt(0)":::"memory");
  float rli[16];
  #pragma unroll
  for(int r=0;r<16;++r)rli[r]=__builtin_amdgcn_rcpf(wsf[32+crow(r,hi)]);
  bf16*Ow=O+(rowbase+q0+wid*QBLK)*OP+h*D;
  { bf16*stg=(bf16*)(shm+LDS_OST)+wid*2048;
    #pragma unroll
    for(int r=0;r<16;++r){const int orow=crow(r,hi);
      #pragma unroll
      for(int d0=0;d0<2;++d0)stg[orow*64+d0*32+r32]=__float2bfloat16(o[d0][r]*rli[r]);}
    asm volatile("s_waitcnt lgkmcnt(0)":::"memory");
    #pragma unroll
    for(int i=0;i<4;++i){const int row=i*8+(lane>>3),ch=lane&7; const u32x4 v=*(const u32x4*)(stg+row*64+ch*8);
      float f[8]; f[0]=__uint_as_float(v.x<<16);f[1]=__uint_as_float(v.x&0xffff0000u);f[2]=__uint_as_float(v.y<<16);f[3]=__uint_as_float(v.y&0xffff0000u);
      f[4]=__uint_as_float(v.z<<16);f[5]=__uint_as_float(v.z&0xffff0000u);f[6]=__uint_as_float(v.w<<16);f[7]=__uint_as_float(v.w&0xffff0000u);
      float ss=0.f; _Pragma("unroll") for(int j=0;j<8;++j)ss+=f[j]*f[j];
      ss+=__shfl_xor(ss,1);ss+=__shfl_xor(ss,2);ss+=__shfl_xor(ss,4);
      const float rs=1.0f/sqrtf(ss*(1.0f/64.0f)+1e-6f); const f32x4_t g0=*(const f32x4_t*)(gain+h*D+ch*8),g1=*(const f32x4_t*)(gain+h*D+ch*8+4);
      u32x4 w; w[0]=cvtpk_s(f[0]*rs*g0[0],f[1]*rs*g0[1]);w[1]=cvtpk_s(f[2]*rs*g0[2],f[3]*rs*g0[3]);w[2]=cvtpk_s(f[4]*rs*g1[0],f[5]*rs*g1[1]);w[3]=cvtpk_s(f[6]*rs*g1[2],f[7]*rs*g1[3]);
      ATTN_STORE16(Ow+(long)row*OP+ch*8,w);} }
  asm volatile("s_waitcnt lgkmcnt(0)\n\ts_barrier":::"memory");
  #undef DMA_K
  #undef DMA_V
  #undef CMASK
  #undef START
  #undef RESC
  #undef ROT
}
constexpr int ATTN_LDS_BYTES=LDS_BYTES;
struct AttnTensors { const bf16* Q; const bf16* K; const bf16* V; bf16* O; const float* gain; };
struct AttnUnit { int b; int h; int qb; };
struct StaticOrder {
  int vcu;
  __device__ __forceinline__ explicit StaticOrder(int grid_,int block):vcu((grid_%8==0)?(block%8)*(grid_/8)+block/8:block),grid(grid_){}
  int grid;
  __device__ __forceinline__ bool next(int i,AttnUnit&u)const{ const int n=i*grid+vcu,pair=n>>5; if(pair>=48)return false; const int s=n&31; u.b=pair>>1; u.h=4*(pair&1)+(s>>3); u.qb=s&7; return true; }
};
template<class Sched,class Side,int THRL=8> __device__ __forceinline__ void attn_phase(char*lds,const AttnTensors&T,const Sched&S,int kside,const Side&side){
  AttnUnit u; int i=0;
  for(;i<kside&&S.next(i,u);++i){ attn_unit<THRL>(u.b,u.h,u.qb,T.Q,T.K,T.V,T.O,T.gain,lds); }
  side();
  for(;S.next(i,u);++i){ attn_unit<THRL>(u.b,u.h,u.qb,T.Q,T.K,T.V,T.O,T.gain,lds); }
}
#undef SBAR
#undef WAIT_BAR
}

typedef __attribute__((address_space(1))) unsigned gu32;
#define XB_TMO      128
#define XB_XCNT(j)  (256  + 64 * (j))
#define XB_XSUB(j)  (1280 + 64 * (j))
#define XB_XGEN(j)  (2304 + 64 * (j))
#define XB_TOP      3328
#define XB_TOPGEN   3392
#define XCD_BAR_WORDS 3456
#define XB_SPIN_CAP (1u << 18)

__device__ __forceinline__ unsigned xb_ld(unsigned* p)              { return __hip_atomic_load(p, __ATOMIC_RELAXED, __HIP_MEMORY_SCOPE_AGENT); }
__device__ __forceinline__ unsigned xb_add(unsigned* p, unsigned v) { return __hip_atomic_fetch_add(p, v, __ATOMIC_RELAXED, __HIP_MEMORY_SCOPE_AGENT); }
__device__ __forceinline__ unsigned xb_xcc_id() { return (unsigned)__builtin_amdgcn_s_getreg((3 << 11) | 20) & 0xFu; }
#define XB_SPIN(cond, bar) do { unsigned _sp = 0; while (cond) { __builtin_amdgcn_s_sleep(1); \
    if ((++_sp & 255u) == 0u) { if (xb_ld(&(bar)[XB_TMO])) break; if (_sp > XB_SPIN_CAP) { atomicAdd(&(bar)[XB_TMO], 1u); break; } } } } while (0)

struct XcdBarrier {
    unsigned* bar; unsigned x;
    volatile LAS unsigned* st;
};

__device__ __forceinline__ XcdBarrier xcd_barrier_post(unsigned* bar, volatile LAS unsigned* st) {
    XcdBarrier b; b.bar = bar; b.x = xb_xcc_id(); b.st = st;
    if (threadIdx.x == 0) (void)xb_add(&bar[XB_XCNT(b.x)], 1u);
    return b;
}
__device__ __forceinline__ void xcd_barrier_complete(unsigned* bar, unsigned x, unsigned& nloc, unsigned& nx) {
    const unsigned G = gridDim.x * gridDim.y * gridDim.z;
    unsigned sum, cnt, mine, sp = 0u;
    for (;;) {
        sum = 0u; cnt = 0u; mine = 0u;
#pragma unroll
        for (unsigned j = 0; j < 16; ++j) { const unsigned c = xb_ld(&bar[XB_XCNT(j)]); sum += c; cnt += (c > 0u) ? 1u : 0u; mine = (j == x) ? c : mine; }
        if (sum == G) break;
        __builtin_amdgcn_s_sleep(1);
        if ((++sp & 255u) == 0u) { if (xb_ld(&bar[XB_TMO])) break; if (sp > XB_SPIN_CAP) { atomicAdd(&bar[XB_TMO], 1u); break; } }
    }
    nloc = mine > 0u ? mine : 1u; nx = cnt > 0u ? cnt : 1u;
}

__device__ __forceinline__ void xcd_barrier(const XcdBarrier& b) {
    asm volatile("s_waitcnt vmcnt(0)" ::: "memory");
    __syncthreads();
    if (threadIdx.x == 0) {
        unsigned* bar = b.bar;
        __builtin_amdgcn_s_waitcnt(0);
        unsigned nloc = b.st[0], nx = b.st[1];
        if (nloc == 0u) { xcd_barrier_complete(bar, b.x, nloc, nx); b.st[0] = nloc; b.st[1] = nx; }
        const unsigned old = xb_add(&bar[XB_XSUB(b.x)], 1u);
        const unsigned gen = old / nloc;
        if (old + 1u == (gen + 1u) * nloc) {
            __builtin_amdgcn_fence(__ATOMIC_RELEASE, "agent");
            asm volatile("s_waitcnt vmcnt(0)" ::: "memory");
            const unsigned og = xb_add(&bar[XB_TOP], 1u);
            const unsigned tg = og / nx;
            if (og + 1u == (tg + 1u) * nx) xb_add(&bar[XB_TOPGEN], 1u);
            else XB_SPIN(xb_ld(&bar[XB_TOPGEN]) == tg, bar);
            __builtin_amdgcn_fence(__ATOMIC_ACQUIRE, "agent");
            xb_add(&bar[XB_XGEN(b.x)], 1u);
            asm volatile("s_waitcnt vmcnt(0)" ::: "memory");
        } else {
            XB_SPIN(xb_ld(&bar[XB_XGEN(b.x)]) == gen, bar);
            __builtin_amdgcn_fence(__ATOMIC_ACQUIRE, "agent");
            asm volatile("s_waitcnt vmcnt(0)" ::: "memory");
        }
    }
    __syncthreads();
}


__global__ void __launch_bounds__(NTHR, 2) enc_fwd(Args a) {
    extern __shared__ __attribute__((aligned(16))) unsigned char lds[];
    cg::grid_group grid = cg::this_grid();
    const int tid = threadIdx.x, lane = tid & 63, wave = __builtin_amdgcn_readfirstlane(tid >> 6);
    const int G = gridDim.x, gw = blockIdx.x * NWAVES + wave, NGW = G * NWAVES;
    const int lo = a.ph_lo, hi = a.ph_hi;
    volatile LAS unsigned* MISC = (volatile LAS unsigned*)((LAS unsigned char*)lds + LDS_BYTES - 64);
    if (tid < 16) MISC[tid] = 0u;
    __syncthreads();
    (void)xcd_barrier_post((unsigned*)(a.ws + WS_CTL) + 4096, MISC);
#define IN(k) (lo <= (k) && (k) < hi)
#ifndef PROBE_X2
#define PROBE_X2 -1
#endif
#define REP(k) for (int rep_ = 0; rep_ < ((k) == PROBE_X2 ? 2 : 1); ++rep_)
#define SEAM(k) do { if (IN(k) && IN((k) + 1)) { if (lo > 1000) grid.sync();   { XcdBarrier bar_; bar_.bar = (unsigned*)(a.ws + WS_CTL) + 4096; bar_.x = xb_xcc_id(); bar_.st = MISC; xcd_barrier(bar_); } } } while (0)
    if (IN(0)) REP(0) { p0_prologue(a, lds, tid, lane, wave); } SEAM(0);
    if (IN(1)) REP(1) { pg8::Gemm g{(const bf16_t*)(a.ws + WS_XA), (const bf16_t*)(a.ws + WS_WIN), NTOK, INW, DM}; pg8::StaticOrder S; S.init(NTOK, INW, G, (int)blockIdx.x);
        pg8::EpiInProj E{(bf16_t*)(a.ws + WS_Z), (bf16_t*)(a.ws + WS_Q), (bf16_t*)(a.ws + WS_KB), (bf16_t*)(a.ws + WS_VB), (const float*)(a.ws + WS_ROPE), a.qg, a.kg};
        kv_meta_rows(a, lane, gw, NGW);
        pg8::gemm_phase<pg8::EpiInProj, pg8::StaticOrder, true, true>((LAS unsigned char*)lds, g, S, E); } SEAM(1);
    if (IN(3)) REP(3) { const attn_body::AttnTensors AT{(const attn_body::bf16*)(a.ws + WS_Q), (const attn_body::bf16*)(a.ws + WS_KB), (const attn_body::bf16*)(a.ws + WS_VB), (attn_body::bf16*)(a.ws + WS_XA) + 512, a.attn_g};
        const attn_body::StaticOrder S(G, (int)blockIdx.x);
        auto side = [&]() { p2_pass(a, lane, gw, NGW);
            table_fp4<false>(a.pu, a.ws + WS_UT, (float*)(a.ws + WS_USC), a.g_ffn, gw, NGW, lane);
            table_fp4<true>(a.pv, a.ws + WS_UT + 4 * SLICE4, (float*)(a.ws + WS_VSC), nullptr, gw, NGW, lane); __syncthreads(); };
        attn_body::attn_phase<attn_body::StaticOrder>((char*)lds, AT, S, (int)((blockIdx.x >> 3) * 6) >> 5, side); } SEAM(3);
    if (IN(4)) REP(4) { pg8::Gemm g{(const bf16_t*)(a.ws + WS_XA), (const bf16_t*)(a.ws + WS_WOUT), NTOK, DM, DM}; pg8::StaticOrder S; S.init(NTOK, DM, G, (int)blockIdx.x);
        pg8::EpiResidNorm E{a.xp, a.xs, a.out, NBP * SEQ, (bf16_t*)(a.ws + WS_HB), a.ws + WS_X8, (float*)(a.ws + WS_SS), X8SCALE};
        pg8::gemm_phase<pg8::EpiResidNorm, pg8::StaticOrder, true, true>((LAS unsigned char*)lds, g, S, E); } SEAM(4);
    if (IN(6)) REP(6) { pg8::Gemm g{(const bf16_t*)(a.ws + WS_HB), (const bf16_t*)(a.ws + WS_WQ), NTOK, PQ, DM}; pg8::StaticOrder S; S.init(NTOK, PQ, G, (int)blockIdx.x);
        pg8::EpiBf16Rs E{(bf16_t*)(a.ws + WS_QP), PQ, (const float*)(a.ws + WS_SS)};
        pg8::gemm_phase<pg8::EpiBf16Rs, pg8::StaticOrder, true, true>((LAS unsigned char*)lds, g, S, E); } SEAM(6);
    if (IN(7)) REP(7) { p7_topk(a, lds, tid, lane, wave); __syncthreads(); } SEAM(7);
    if (IN(8)) REP(8) { p8a_u(a, lane, wave); } SEAM(8);
    if (IN(9)) REP(9) { p8c_combine(a, lds, tid); __syncthreads(); } SEAM(9);
    if (IN(10)) REP(10) { p8b_v(a, lds, lane, wave, rep_ == ((10 == PROBE_X2) ? 1 : 0)); }
#undef IN
#undef SEAM
}

extern "C" void kernel_launch(void* const* d_in, const int* in_sizes, int n_in, void* d_out, int out_size, void* d_ws, size_t ws_size, hipStream_t stream) {
    static int grid = 0;
    if (grid == 0) {
        if (n_in != 16 || out_size != NTOK * DM || ws_size < WS_END) { fprintf(stderr, "kernel_launch: unexpected shapes (n_in %d out %d ws %zu)\n", n_in, out_size, ws_size); grid = -1; return; }
        int dev = 0, cus = 0, per_cu = 0;
        (void)hipGetDevice(&dev); (void)hipDeviceGetAttribute(&cus, hipDeviceAttributeMultiprocessorCount, dev);
        (void)hipFuncSetAttribute((const void*)enc_fwd, hipFuncAttributeMaxDynamicSharedMemorySize, LDS_BYTES);
        (void)hipOccupancyMaxActiveBlocksPerMultiprocessor(&per_cu, (const void*)enc_fwd, NTHR, LDS_BYTES);
        if (per_cu < 1) { fprintf(stderr, "kernel_launch: occupancy query says %d blocks/CU\n", per_cu); per_cu = 1; }
        (void)hipGetLastError();
        grid = cus * 1;
    }
    if (grid < 0) return;
    (void)hipMemsetAsync((char*)d_ws + WS_CTL, 0, 64 * 1024, stream);
    Args a{};
    a.xp = (const float*)d_in[0]; a.xs = (const float*)d_in[1]; a.meta = (const float*)d_in[2]; a.g_mix = (const float*)d_in[3]; a.w_in = (const float*)d_in[4];
    a.conv_w = (const float*)d_in[5]; a.qg = (const float*)d_in[6]; a.kg = (const float*)d_in[7]; a.conv_g = (const float*)d_in[8]; a.attn_g = (const float*)d_in[9];
    a.w_out = (const float*)d_in[10]; a.g_ffn = (const float*)d_in[11]; a.wq = (const float*)d_in[12]; a.subk = (const float*)d_in[13]; a.pu = (const float*)d_in[14]; a.pv = (const float*)d_in[15];
    a.out = (float*)d_out; a.ws = (unsigned char*)d_ws;
    constexpr int NL = MK_N_LAUNCHES;
    for (int li = 0; li < NL; ++li) {
        a.ph_lo = (NL == 1) ? 0 : li; a.ph_hi = (NL == 1) ? NPHASE : li + 1;
        void* args[] = {&a};
        hipError_t e = hipLaunchCooperativeKernel((const void*)enc_fwd, dim3(grid), dim3(NTHR), args, LDS_BYTES, stream);
        if (e != hipSuccess) { fprintf(stderr, "kernel_launch: launch %d failed: %s\n", li, hipGetErrorString(e)); break; }
    }
}
```

```cpp
#include <hip/hip_runtime.h>
#include <hip/hip_cooperative_groups.h>
#include <cstdint>
#include <cstdio>
namespace cg = cooperative_groups;

#ifndef MK_N_LAUNCHES
#define MK_N_LAUNCHES 1
#endif

typedef unsigned short bf16_t;
typedef short bf16x8 __attribute__((ext_vector_type(8)));
typedef float f32x4 __attribute__((ext_vector_type(4)));
typedef unsigned u32x4 __attribute__((ext_vector_type(4)));
typedef unsigned u32x2 __attribute__((ext_vector_type(2)));
#define LAS __attribute__((address_space(3)))

constexpr int NB = 24, NBP = 16, SEQ = 2048, DM = 1024, NTOK = NB * SEQ;
constexpr int NMETA = 16, INW = 2304, KROWS = 2112;
constexpr int NKEYS = SEQ + NMETA;
constexpr int PQ = 2048;
constexpr float EPS = 1e-6f;
constexpr float C2 = 0.125f * 1.4426950408889634f;
constexpr int NWAVES = 8, NTHR = 512;
constexpr int LDS_BYTES = 163840;
constexpr int NPHASE = 11;

constexpr size_t MiB = 1u << 20;
constexpr size_t WS_CTL = 0;
constexpr size_t WS_WIN = 1 * MiB;
constexpr size_t WS_WOUT = 6 * MiB;
constexpr size_t WS_WQ = 8 * MiB;
constexpr size_t WS_SUBK = 12 * MiB;
constexpr size_t WS_ZMETA = 12 * MiB + 512 * 1024;
constexpr size_t WS_ROPE = WS_ZMETA + 256 * 1024;
constexpr size_t WS_UT = 13 * MiB;
constexpr size_t WS_USC = 29 * MiB, WS_VSC = WS_USC + 64 * 1024;
constexpr size_t WS_SS = WS_USC + 256 * 1024;
constexpr size_t SLICE4 = (size_t)16384 * 128;
constexpr size_t WS_XA = 32 * MiB;
constexpr size_t WS_EI = WS_XA, WS_GT = WS_XA + 12 * MiB;
constexpr size_t WS_Z = 128 * MiB;
constexpr size_t WS_HB = WS_Z;
constexpr size_t WS_QP = WS_Z + 96 * MiB;
constexpr size_t WS_PB = WS_QP;
constexpr size_t WS_AB = WS_PB + (size_t)4 * 49152 * 128 * 4;
constexpr size_t WS_Q = 416 * MiB;
constexpr size_t WS_X8 = WS_Q;
constexpr size_t WS_KB = 464 * MiB;
constexpr size_t WS_VB = 477 * MiB;
constexpr size_t WS_END = 490 * MiB;
constexpr float X8SCALE = 8.0f;
constexpr float A8SCALE = 256.0f;

struct Args {
    const float* xp; const float* xs; const float* meta; const float* g_mix; const float* w_in; const float* conv_w;
    const float* qg; const float* kg; const float* conv_g; const float* attn_g; const float* w_out; const float* g_ffn;
    const float* wq; const float* subk; const float* pu; const float* pv;
    float* out; unsigned char* ws; int ph_lo, ph_hi;
};

__device__ __forceinline__ unsigned f2bf(float f) { unsigned u = __builtin_bit_cast(unsigned, f); return (u + 0x7fffu + ((u >> 16) & 1u)) >> 16; }
typedef float f32x2_pk __attribute__((ext_vector_type(2))); typedef __bf16 bf16x2_pk __attribute__((ext_vector_type(2)));
__device__ __forceinline__ unsigned pk2(float lo, float hi) { const f32x2_pk v = {lo, hi}; const bf16x2_pk b = __builtin_convertvector(v, bf16x2_pk); return __builtin_bit_cast(unsigned, b); }
__device__ __forceinline__ float bflo(unsigned w) { return __builtin_bit_cast(float, w << 16); }
__device__ __forceinline__ float bfhi(unsigned w) { return __builtin_bit_cast(float, w & 0xffff0000u); }
__device__ __forceinline__ float bf2f(bf16_t h) { return __builtin_bit_cast(float, (unsigned)h << 16); }
__device__ __forceinline__ void unpack8(u32x4 w, float* f) {
    f[0] = bflo(w.x); f[1] = bfhi(w.x); f[2] = bflo(w.y); f[3] = bfhi(w.y); f[4] = bflo(w.z); f[5] = bfhi(w.z); f[6] = bflo(w.w); f[7] = bfhi(w.w);
}
__device__ __forceinline__ u32x4 pack8(const float* f) { u32x4 w; w.x = pk2(f[0], f[1]); w.y = pk2(f[2], f[3]); w.z = pk2(f[4], f[5]); w.w = pk2(f[6], f[7]); return w; }
__device__ __forceinline__ float wave_sum(float v) {
#pragma unroll
    for (int o = 1; o < 64; o <<= 1) v += __shfl_xor(v, o);
    return v;
}
__device__ __forceinline__ float wave_max(float v) {
#pragma unroll
    for (int o = 1; o < 64; o <<= 1) v = fmaxf(v, __shfl_xor(v, o));
    return v;
}
__device__ __forceinline__ const float* xrow_ptr(const Args& a, int r) { return r < NBP * SEQ ? a.xp + (size_t)r * DM : a.xs + (size_t)(r - NBP * SEQ) * DM; }

__device__ __forceinline__ int permin(int n  ) {
    if (n >= 512 && n < 1536) { const int hc = (n - 512) >> 9, c = (n - 512) & 511; return 512 + (c >> 7) * 256 + hc * 128 + (c & 127); }
    if (n >= 1536 && n < 2048) { const int c = n - 1536, hh = c >> 6, half = (c >> 5) & 1; return 1536 + 256 * (hh >> 2) + 128 * half + 32 * (hh & 3) + (c & 31); }
    if (n >= 2048) { const int c = n - 2048, s = c >> 6, half = (c >> 5) & 1; return 2048 + 128 * half + 32 * s + (c & 31); }
    return n; }
__device__ __forceinline__ void p0_transpose_item(const float* W, int K, int N, bf16_t* WT, float* scr, int item, int lane, const float* gk = nullptr  , bool dperm = false) {
    const int nblk = N / 32, kb = item / nblk, nb = item % nblk, k0 = 64 * kb, n0 = 32 * nb, nd0 = dperm ? permin(n0) : n0;
#pragma unroll 8
    for (int i = 0; i < 32; ++i) { const int kk = 2 * i + (lane >> 5); scr[kk * 33 + (lane & 31)] = W[(size_t)(k0 + kk) * N + n0 + (lane & 31)] * (gk ? gk[k0 + kk] : 1.0f); }
    asm volatile("s_waitcnt lgkmcnt(0)" ::: "memory");
    const int c = lane & 7;
#pragma unroll
    for (int j = 0; j < 4; ++j) { const int n = (lane >> 3) + 8 * j; const float* s = scr + (8 * c) * 33 + n;
        u32x4 o; o.x = pk2(s[0 * 33], s[1 * 33]); o.y = pk2(s[2 * 33], s[3 * 33]); o.z = pk2(s[4 * 33], s[5 * 33]); o.w = pk2(s[6 * 33], s[7 * 33]);
        *(u32x4*)(WT + (size_t)(nd0 + n) * K + k0 + 8 * c) = o; }
    asm volatile("s_waitcnt lgkmcnt(0)" ::: "memory");
}
__device__ __forceinline__ void cast_region(const float* src, bf16_t* dst, size_t n, size_t gtid, size_t nthreads) {
    for (size_t i = gtid * 8; i < n; i += nthreads * 8) {
        const f32x4 a = *(const f32x4*)(src + i), b = *(const f32x4*)(src + i + 4);
        u32x4 o; o.x = pk2(a.x, a.y); o.y = pk2(a.z, a.w); o.z = pk2(b.x, b.y); o.w = pk2(b.z, b.w);
        *(u32x4*)(dst + i) = o;
    }
}
template <bool PERM64> __device__ __forceinline__ void table_fp4(const float* src, unsigned char* dst, float* scale, const float* gcol  , int gw, int NGW, int lane) {
    f32x4 v[4], vn[4], g[4];
#pragma unroll
    for (int j = 0; j < 4; ++j) g[j] = gcol ? *(const f32x4*)(gcol + lane * 16 + 4 * j) : (f32x4){1.f, 1.f, 1.f, 1.f};
    if (gw < 16384) {
#pragma unroll
        for (int j = 0; j < 4; ++j) v[j] = __builtin_nontemporal_load((const f32x4*)(src + (size_t)gw * DM + lane * 16 + 4 * j)); }
    for (int row = gw; row < 16384; row += NGW) {
        { const int rn = row + NGW < 16384 ? row + NGW : row;
#pragma unroll
          for (int j = 0; j < 4; ++j) vn[j] = __builtin_nontemporal_load((const f32x4*)(src + (size_t)rn * DM + lane * 16 + 4 * j)); }
        float m = 0.f;
#pragma unroll
        for (int j = 0; j < 4; ++j) { v[j] = v[j] * g[j]; m = fmaxf(fmaxf(m, fmaxf(fabsf(v[j].x), fabsf(v[j].y))), fmaxf(fabsf(v[j].z), fabsf(v[j].w))); }
        m = wave_max(m);
        const float s = fmaxf(m, 1e-30f) * (1.0f / 6.0f), inv = 1.0f / s;
        unsigned char* rowp = dst + (size_t)(lane >> 4) * SLICE4 + (size_t)row * 128;
        if (!PERM64) {
            unsigned w0 = 0u, w1 = 0u;
            w0 = __builtin_amdgcn_cvt_scalef32_pk_fp4_f32(w0, v[0].x * inv, v[0].y * inv, 1.0f, 0); w0 = __builtin_amdgcn_cvt_scalef32_pk_fp4_f32(w0, v[0].z * inv, v[0].w * inv, 1.0f, 1);
            w0 = __builtin_amdgcn_cvt_scalef32_pk_fp4_f32(w0, v[1].x * inv, v[1].y * inv, 1.0f, 2); w0 = __builtin_amdgcn_cvt_scalef32_pk_fp4_f32(w0, v[1].z * inv, v[1].w * inv, 1.0f, 3);
            w1 = __builtin_amdgcn_cvt_scalef32_pk_fp4_f32(w1, v[2].x * inv, v[2].y * inv, 1.0f, 0); w1 = __builtin_amdgcn_cvt_scalef32_pk_fp4_f32(w1, v[2].z * inv, v[2].w * inv, 1.0f, 1);
            w1 = __builtin_amdgcn_cvt_scalef32_pk_fp4_f32(w1, v[3].x * inv, v[3].y * inv, 1.0f, 2); w1 = __builtin_amdgcn_cvt_scalef32_pk_fp4_f32(w1, v[3].z * inv, v[3].w * inv, 1.0f, 3);
            *(u32x2*)(rowp + (lane & 15) * 8) = (u32x2){w0, w1};
        } else {
            unsigned char* gp = rowp + ((lane & 15) >> 2) * 32 + (lane & 3) * 2;
#pragma unroll
            for (int m = 0; m < 4; ++m) { unsigned wm = 0u;
                wm = __builtin_amdgcn_cvt_scalef32_pk_fp4_f32(wm, v[0][m] * inv, v[1][m] * inv, 1.0f, 0); wm = __builtin_amdgcn_cvt_scalef32_pk_fp4_f32(wm, v[2][m] * inv, v[3][m] * inv, 1.0f, 1);
                *(unsigned short*)(gp + 8 * m) = (unsigned short)wm; }
        }
        if (lane == 0) scale[row] = s;
#pragma unroll
        for (int j = 0; j < 4; ++j) v[j] = vn[j];
    }
}
__device__ __forceinline__ void p0_prologue(const Args& a, unsigned char* lds, int tid, int lane, int wave) {
    const int G = gridDim.x, gw = blockIdx.x * NWAVES + wave, NGW = G * NWAVES;
    float* ldsf = (float*)lds;
    if (blockIdx.x < INW / 64) {
        float* xm = ldsf;
        float* red = ldsf + 16 * 1024;
#pragma unroll
        for (int rr = 0; rr < 2; ++rr) { const int r = 2 * wave + rr; f32x4 v[4]; float ss = 0.f;
#pragma unroll
            for (int j = 0; j < 4; ++j) { v[j] = *(const f32x4*)(a.meta + (size_t)r * DM + (lane + 64 * j) * 4); ss += v[j].x * v[j].x + v[j].y * v[j].y + v[j].z * v[j].z + v[j].w * v[j].w; }
            const float rstd = 1.0f / sqrtf(wave_sum(ss) * (1.0f / DM) + EPS);
#pragma unroll
            for (int j = 0; j < 4; ++j) { const int c = (lane + 64 * j) * 4; const f32x4 g = *(const f32x4*)(a.g_mix + c); *(f32x4*)(xm + r * 1024 + c) = v[j] * rstd * g; }
        }
        __syncthreads();
        const int n0 = blockIdx.x * 64, k0 = wave * 128;
        float acc[16];
#pragma unroll
        for (int r = 0; r < 16; ++r) acc[r] = 0.f;
        for (int kb = k0; kb < k0 + 128; kb += 16) { float wv[16];
#pragma unroll
            for (int q = 0; q < 16; ++q) wv[q] = a.w_in[(size_t)(kb + q) * INW + n0 + lane];
#pragma unroll
            for (int q = 0; q < 16; ++q)
#pragma unroll
                for (int r = 0; r < 16; ++r) acc[r] += xm[r * 1024 + kb + q] * wv[q]; }
#pragma unroll
        for (int r = 0; r < 16; ++r) red[(wave * 16 + r) * 64 + lane] = acc[r];
        __syncthreads();
        float* zmeta = (float*)(a.ws + WS_ZMETA);
        for (int o = tid; o < 1024; o += NTHR) { const int r = o >> 6, c = o & 63; float s = 0.f;
#pragma unroll
            for (int w = 0; w < 8; ++w) s += red[(w * 16 + r) * 64 + c];
            zmeta[r * INW + n0 + c] = s; }
        __syncthreads();
    }
    if (blockIdx.x == INW / 64) {
        float* rope = (float*)(a.ws + WS_ROPE);
        for (int i = tid; i < 64 * 16; i += NTHR) { const int pos = i >> 4, f = i & 15;
            const float freq = exp2f(-(float)f * (13.287712379549449f / 16.0f)); const float rev = (float)pos * freq * 0.15915494309189535f; const float fr = rev - floorf(rev);
            rope[2 * i] = __builtin_amdgcn_cosf(fr); rope[2 * i + 1] = __builtin_amdgcn_sinf(fr); }
    }
    if ((int)blockIdx.x > INW / 64 || G <= INW / 64 + 1) {
        float* scr = ldsf + wave * (64 * 33);
        constexpr int I_IN = (DM / 64) * (INW / 32), I_OUT = (DM / 64) * (DM / 32), I_WQ = (DM / 64) * (PQ / 32);
        const int first = (G <= INW / 64 + 1) ? 0 : INW / 64 + 1, nw = (G - first) * NWAVES;
        for (int it = ((int)blockIdx.x - first) * NWAVES + wave; it < I_IN + I_OUT + I_WQ; it += nw) {
            int r = it;
            if (r < I_IN) { p0_transpose_item(a.w_in, DM, INW, (bf16_t*)(a.ws + WS_WIN), scr, r, lane, nullptr, true); continue; } r -= I_IN;
            if (r < I_OUT) { p0_transpose_item(a.w_out, DM, DM, (bf16_t*)(a.ws + WS_WOUT), scr, r, lane); continue; } r -= I_OUT;
            p0_transpose_item(a.wq, DM, PQ, (bf16_t*)(a.ws + WS_WQ), scr, r, lane, a.g_ffn);
        }
    }
    {
        const size_t gtid = (size_t)blockIdx.x * NTHR + tid, nth = (size_t)G * NTHR;
        cast_region(a.subk, (bf16_t*)(a.ws + WS_SUBK), (size_t)16 * 128 * 128, gtid, nth);
        for (size_t i = gtid; i < (size_t)NTOK; i += nth) ((float*)(a.ws + WS_SS))[i] = 0.f;
    }
    {
        bf16_t* XA = (bf16_t*)(a.ws + WS_XA);
        f32x4 g[4], v[4], vn[4];
#pragma unroll
        for (int j = 0; j < 4; ++j) g[j] = *(const f32x4*)(a.g_mix + (lane + 64 * j) * 4);
        if (gw < NTOK) { const float* xr = xrow_ptr(a, gw);
#pragma unroll
            for (int j = 0; j < 4; ++j) v[j] = __builtin_nontemporal_load((const f32x4*)(xr + (lane + 64 * j) * 4)); }
        for (int r = gw; r < NTOK; r += NGW) {
            { const float* xn = xrow_ptr(a, r + NGW < NTOK ? r + NGW : r);
#pragma unroll
              for (int j = 0; j < 4; ++j) vn[j] = __builtin_nontemporal_load((const f32x4*)(xn + (lane + 64 * j) * 4)); }
            float ss = 0.f;
#pragma unroll
            for (int j = 0; j < 4; ++j) ss += v[j].x * v[j].x + v[j].y * v[j].y + v[j].z * v[j].z + v[j].w * v[j].w;
            const float rstd = 1.0f / sqrtf(wave_sum(ss) * (1.0f / DM) + EPS);
#pragma unroll
            for (int j = 0; j < 4; ++j) { const int c = (lane + 64 * j) * 4; const f32x4 o = v[j] * rstd * g[j];
                u32x2 w; w.x = pk2(o.x, o.y); w.y = pk2(o.z, o.w); *(u32x2*)(XA + (size_t)r * DM + c) = w; }
#pragma unroll
            for (int j = 0; j < 4; ++j) v[j] = vn[j];
        }
    }
}

constexpr int ZW = 1024;
struct P2In { u32x4 w[4]; };
__device__ __forceinline__ void p2_load(P2In& in, const bf16_t* ZB, int r, int lane) {
    const int t = r & 2047, c0 = lane * 8; const bf16_t* zr = ZB + (size_t)r * ZW;
    const bf16_t* zp = (t > 0) ? zr - ZW : zr; const bf16_t* zn = (t < SEQ - 1) ? zr + ZW : zr;
    in.w[0] = *(const u32x4*)(zr + c0); in.w[1] = *(const u32x4*)(zr + 512 + c0); in.w[2] = *(const u32x4*)(zp + 512 + c0); in.w[3] = *(const u32x4*)(zn + 512 + c0);
}
__device__ __forceinline__ void p2_pass(const Args& a, int lane, int gw, int NGW) {
    const bf16_t* ZB = (const bf16_t*)(a.ws + WS_Z); const float* zmeta = (const float*)(a.ws + WS_ZMETA);
    bf16_t* XA = (bf16_t*)(a.ws + WS_XA);
    const int c0 = lane * 8;
    float cw0[8], cw1[8], cw2[8], cgn[8];
#pragma unroll
    for (int j = 0; j < 8; ++j) { cw0[j] = a.conv_w[c0 + j]; cw1[j] = a.conv_w[512 + c0 + j]; cw2[j] = a.conv_w[1024 + c0 + j]; cgn[j] = a.conv_g[c0 + j]; }
    P2In cur, nxt, nx2;
    if (gw < NTOK) { p2_load(cur, ZB, gw, lane); p2_load(nxt, ZB, gw + NGW < NTOK ? gw + NGW : gw, lane); }
    for (int it = gw; it < NTOK; it += NGW) {
        {
            const int r = it, t = r & 2047;
            { const int rn = it + 2 * NGW < NTOK ? it + 2 * NGW : it; p2_load(nx2, ZB, rn, lane); }
            float gb[8], uc[8], up[8], un[8];
            unpack8(cur.w[0], gb); unpack8(cur.w[1], uc); unpack8(cur.w[2], up);
            if (t == 0) {
#pragma unroll
                for (int j = 0; j < 8; ++j) up[j] = zmeta[15 * INW + 512 + c0 + j] * zmeta[15 * INW + 1024 + c0 + j]; }
            unpack8(cur.w[3], un);
#pragma unroll
            for (int j = 0; j < 8; ++j) un[j] = (t < SEQ - 1) ? un[j] : 0.f;
            float y[8], ss = 0.f;
#pragma unroll
            for (int j = 0; j < 8; ++j) { y[j] = gb[j] * (up[j] * cw0[j] + uc[j] * cw1[j] + un[j] * cw2[j]); ss += y[j] * y[j]; }
            ss += __shfl_xor(ss, 1); ss += __shfl_xor(ss, 2); ss += __shfl_xor(ss, 4);
            const float rstd = 1.0f / sqrtf(ss * (1.0f / 64.0f) + EPS);
#pragma unroll
            for (int j = 0; j < 8; ++j) y[j] = y[j] * rstd * cgn[j];
            *(u32x4*)(XA + (size_t)r * DM + c0) = pack8(y);
            cur = nxt; nxt = nx2;
        }
    }
}
__device__ __forceinline__ void kv_meta_rows(const Args& a, int lane, int gw, int NGW) {
    const float* zmeta = (const float*)(a.ws + WS_ZMETA); bf16_t* KB = (bf16_t*)(a.ws + WS_KB); bf16_t* VB = (bf16_t*)(a.ws + WS_VB);
    const int i = lane & 7;
    for (int it = NTOK + gw; it < NTOK + NB * 64; it += NGW) {
        {
            const int it2 = it - NTOK, b = it2 >> 6, j64 = it2 & 63; const int l16 = lane & 15, g = l16 >> 3;
            float k[8], v[8];
            if (j64 < NMETA) {
                const float* zm = zmeta + j64 * INW; float ss = 0.f;
#pragma unroll
                for (int j = 0; j < 8; ++j) { k[j] = zm[2048 + l16 * 8 + j]; v[j] = zm[2176 + l16 * 8 + j]; ss += k[j] * k[j]; }
                ss += __shfl_xor(ss, 1); ss += __shfl_xor(ss, 2); ss += __shfl_xor(ss, 4);
                const float rstd = 1.0f / sqrtf(ss * (1.0f / 64.0f) + EPS);
#pragma unroll
                for (int j = 0; j < 8; ++j) k[j] = k[j] * rstd * a.kg[i * 8 + j];
            } else {
#pragma unroll
                for (int j = 0; j < 8; ++j) { k[j] = 0.f; v[j] = 0.f; }
            }
            const size_t krow = ((size_t)(b * 2 + g) * KROWS + SEQ + j64) * 64 + i * 8;
            if (lane < 16) *(u32x4*)(KB + krow) = pack8(k);
            else if (lane < 32) *(u32x4*)(VB + krow) = pack8(v);
        }
    }
}

typedef float f32x16 __attribute__((ext_vector_type(16)));
__device__ __forceinline__ void ce_desc(float& a, float& b) { float h, l; asm("v_max_f32_e32 %0, %1, %2" : "=v"(h) : "v"(a), "v"(b)); asm("v_min_f32_e32 %0, %1, %2" : "=v"(l) : "v"(a), "v"(b)); a = h; b = l; }
__device__ __forceinline__ float vmaxf(float a, float b) { float h; asm("v_max_f32_e32 %0, %1, %2" : "=v"(h) : "v"(a), "v"(b)); return h; }
template <int N> __device__ __forceinline__ void bitonic_sort_desc(float* v) {
#pragma unroll
    for (int k = 2; k <= N; k <<= 1)
#pragma unroll
        for (int j = k >> 1; j > 0; j >>= 1)
#pragma unroll
            for (int i = 0; i < N; ++i) { const int l = i ^ j; if (l > i) { if ((i & k) == 0) ce_desc(v[i], v[l]); else ce_desc(v[l], v[i]); } }
}
__device__ __forceinline__ void sort16_desc(float* v) {
    ce_desc(v[0], v[13]); ce_desc(v[1], v[12]); ce_desc(v[2], v[15]); ce_desc(v[3], v[14]); ce_desc(v[4], v[8]); ce_desc(v[5], v[6]); ce_desc(v[7], v[11]); ce_desc(v[9], v[10]);
    ce_desc(v[0], v[5]); ce_desc(v[1], v[7]); ce_desc(v[2], v[9]); ce_desc(v[3], v[4]); ce_desc(v[6], v[13]); ce_desc(v[8], v[14]); ce_desc(v[10], v[15]); ce_desc(v[11], v[12]);
    ce_desc(v[0], v[1]); ce_desc(v[2], v[3]); ce_desc(v[4], v[5]); ce_desc(v[6], v[8]); ce_desc(v[7], v[9]); ce_desc(v[10], v[11]); ce_desc(v[12], v[13]); ce_desc(v[14], v[15]);
    ce_desc(v[0], v[2]); ce_desc(v[1], v[3]); ce_desc(v[4], v[10]); ce_desc(v[5], v[11]); ce_desc(v[6], v[7]); ce_desc(v[8], v[9]); ce_desc(v[12], v[14]); ce_desc(v[13], v[15]);
    ce_desc(v[1], v[2]); ce_desc(v[3], v[12]); ce_desc(v[4], v[6]); ce_desc(v[5], v[7]); ce_desc(v[8], v[10]); ce_desc(v[9], v[11]); ce_desc(v[13], v[14]);
    ce_desc(v[1], v[4]); ce_desc(v[2], v[6]); ce_desc(v[5], v[8]); ce_desc(v[7], v[10]); ce_desc(v[9], v[13]); ce_desc(v[11], v[14]);
    ce_desc(v[2], v[4]); ce_desc(v[3], v[6]); ce_desc(v[9], v[12]); ce_desc(v[11], v[13]);
    ce_desc(v[3], v[5]); ce_desc(v[6], v[8]); ce_desc(v[7], v[9]); ce_desc(v[10], v[12]);
    ce_desc(v[3], v[4]); ce_desc(v[5], v[6]); ce_desc(v[7], v[8]); ce_desc(v[9], v[10]); ce_desc(v[11], v[12]);
    ce_desc(v[6], v[7]); ce_desc(v[8], v[9]);
}
template <int N> __device__ __forceinline__ void bitonic_merge_desc(float* v) {
#pragma unroll
    for (int j = N >> 1; j > 0; j >>= 1)
#pragma unroll
        for (int i = 0; i < N; ++i) { const int l = i ^ j; if (l > i) ce_desc(v[i], v[l]); }
}
__device__ __forceinline__ void merge_top16(float* x, const float* y) {
#pragma unroll
    for (int i = 0; i < 16; ++i) x[i] = vmaxf(x[i], y[15 - i]);
    bitonic_merge_desc<16>(x);
}
__device__ __forceinline__ void insert16(float* t, float x) {
#pragma unroll
    for (int k = 0; k < 16; ++k) ce_desc(t[k], x);
}
constexpr int SK_ROW = 272, SK_MAT = 128 * SK_ROW;
__device__ __forceinline__ void p7_half(const bf16_t* qrow  , const LAS unsigned char* skl  , int hi4, float* T) {
    f32x16 acc[4];
#pragma unroll
    for (int nb = 0; nb < 4; ++nb)
#pragma unroll
        for (int r = 0; r < 16; ++r) acc[nb][r] = 0.f;
    bf16x8 bq[8];
#pragma unroll
    for (int ks = 0; ks < 8; ++ks) bq[ks] = *(const bf16x8*)(qrow + ks * 16);
#pragma unroll
    for (int ks = 0; ks < 8; ++ks) {
#pragma unroll
        for (int nb = 0; nb < 4; ++nb) { const bf16x8 ak = *(const LAS bf16x8*)(skl + nb * 32 * SK_ROW + ks * 32); acc[nb] = __builtin_amdgcn_mfma_f32_32x32x16_bf16(ak, bq[ks], acc[nb], 0, 0, 0); }
        if (ks & 1) __builtin_amdgcn_sched_barrier(0);
    }
    float L[16];
#pragma unroll
    for (int nb = 0; nb < 4; ++nb) {
        float v[16];
#pragma unroll
        for (int r = 0; r < 16; ++r) { const float sc = acc[nb][r]; v[r] = __uint_as_float((__float_as_uint(sc) & ~127u) | (unsigned)(nb * 16 + r)); }
        sort16_desc(v);
        if (nb == 0) {
#pragma unroll
            for (int r = 0; r < 16; ++r) L[r] = v[r];
        } else merge_top16(L, v);
    }
#pragma unroll
    for (int r = 0; r < 16; ++r) { const unsigned w = __builtin_bit_cast(unsigned, L[r]); T[r] = __builtin_bit_cast(float, w + (w & 0x3Cu) + (unsigned)hi4); }
}
__device__ __forceinline__ unsigned pick_byte(unsigned p0, unsigned p1, unsigned p2, unsigned p3, unsigned i) {
    const unsigned sel = (i & 7u) | 0x0c0c0c00u;
    const unsigned lo = __builtin_amdgcn_perm(p1, p0, sel), hi = __builtin_amdgcn_perm(p3, p2, sel);
    return (i & 8u) ? hi : lo;
}
__device__ __forceinline__ void p7_topk(const Args& a, unsigned char* lds, int tid, int lane, int wave) {
    const bf16_t* QP = (const bf16_t*)(a.ws + WS_QP); const bf16_t* SUBK = (const bf16_t*)(a.ws + WS_SUBK);
    unsigned short* EIDX = (unsigned short*)(a.ws + WS_EI); float* GATE = (float*)(a.ws + WS_GT); const float* SSQ = (const float*)(a.ws + WS_SS);
    const int r32 = lane & 31, hi = lane >> 5;
    const int hp = blockIdx.x & 3, grp = blockIdx.x >> 2, ngrp = gridDim.x >> 2;
    { const u32x4* src = (const u32x4*)(SUBK + (size_t)hp * 4 * 128 * 128);
      for (int i = tid; i < 4 * 128 * 16; i += NTHR) { const int row = i >> 4, ch = i & 15; *(LAS u32x4*)((LAS unsigned char*)lds + row * SK_ROW + ch * 16) = src[i]; } }
    __syncthreads();
    const LAS unsigned char* skl = (const LAS unsigned char*)lds + r32 * SK_ROW + 16 * hi;
    for (int blk = grp * NWAVES + wave; blk < NTOK / 32; blk += ngrp * NWAVES) {
        const int tok = blk * 32 + r32;
        const float rs_l2e = 1.4426950408889634f / sqrtf(SSQ[tok] * (1.0f / DM) + EPS);
        float M0[16], M1[16];
        {
            float B0[16], B1[16];
            p7_half(QP + (size_t)tok * PQ + (2 * hp) * 256 + 8 * hi, skl + 0 * SK_MAT, 4 * hi, M0);
            p7_half(QP + (size_t)tok * PQ + (2 * hp) * 256 + 128 + 8 * hi, skl + 1 * SK_MAT, 4 * hi, M1);
            p7_half(QP + (size_t)tok * PQ + (2 * hp + 1) * 256 + 8 * hi, skl + 2 * SK_MAT, 4 * hi, B0);
            p7_half(QP + (size_t)tok * PQ + (2 * hp + 1) * 256 + 128 + 8 * hi, skl + 3 * SK_MAT, 4 * hi, B1);
#pragma unroll
            for (int i = 0; i < 16; ++i) {
                const auto r0 = __builtin_amdgcn_permlane32_swap(__builtin_bit_cast(unsigned, M0[i]), __builtin_bit_cast(unsigned, B0[i]), false, false);
                const unsigned a0 = r0[0], b0 = r0[1]; M0[i] = __builtin_bit_cast(float, a0); B0[i] = __builtin_bit_cast(float, b0);
                const auto r1 = __builtin_amdgcn_permlane32_swap(__builtin_bit_cast(unsigned, M1[i]), __builtin_bit_cast(unsigned, B1[i]), false, false);
                const unsigned a1 = r1[0], b1 = r1[1]; M1[i] = __builtin_bit_cast(float, a1); B1[i] = __builtin_bit_cast(float, b1); }
            merge_top16(M0, B0); merge_top16(M1, B1);
        }
        const int h = 2 * hp + hi;
#define CAND(i, j) __builtin_bit_cast(float, (__builtin_bit_cast(unsigned, M0[i] + M1[j]) & ~255u) | (unsigned)((i) * 16 + (j)))
        float tc[16], l2[16], l3[16];
#pragma unroll
        for (int j = 0; j < 16; ++j) tc[j] = CAND(0, j);
#pragma unroll
        for (int j = 0; j < 8; ++j) { l2[j] = CAND(1, j); l2[8 + j] = CAND(15 - j, 0); }
        bitonic_merge_desc<16>(l2);
        merge_top16(tc, l2);
        l3[0] = CAND(2, 0); l3[1] = CAND(2, 1); l3[2] = CAND(2, 2); l3[3] = CAND(2, 3); l3[4] = CAND(2, 4); l3[5] = CAND(3, 0); l3[6] = CAND(3, 1); l3[7] = CAND(3, 2); l3[8] = CAND(3, 3);
        l3[9] = CAND(4, 0); l3[10] = CAND(4, 1); l3[11] = CAND(4, 2); l3[12] = CAND(5, 0); l3[13] = CAND(5, 1); l3[14] = CAND(6, 0); l3[15] = CAND(6, 1);
        sort16_desc(l3);
        merge_top16(tc, l3);
        insert16(tc, CAND(7, 0)); insert16(tc, CAND(7, 1));
#undef CAND
#define PK4(M, q) ((__builtin_bit_cast(unsigned, M[4 * (q)]) & 127u) | ((__builtin_bit_cast(unsigned, M[4 * (q) + 1]) & 127u) << 8) | ((__builtin_bit_cast(unsigned, M[4 * (q) + 2]) & 127u) << 16) | ((__builtin_bit_cast(unsigned, M[4 * (q) + 3]) & 127u) << 24))
        const unsigned a0 = PK4(M0, 0), a1 = PK4(M0, 1), a2 = PK4(M0, 2), a3 = PK4(M0, 3), b0 = PK4(M1, 0), b1 = PK4(M1, 1), b2 = PK4(M1, 2), b3 = PK4(M1, 3);
#undef PK4
        float e[16], sum = 0.f;
#pragma unroll
        for (int k = 0; k < 16; ++k) { e[k] = exp2f((tc[k] - tc[0]) * rs_l2e); sum += e[k]; }
        const float inv = 1.0f / sum;
        int eo[16];
#pragma unroll
        for (int k = 0; k < 16; ++k) { const unsigned code = __builtin_bit_cast(unsigned, tc[k]) & 255u; eo[k] = (int)(pick_byte(a0, a1, a2, a3, code >> 4) * 128u + pick_byte(b0, b1, b2, b3, code & 15u)); e[k] *= inv; }
        unsigned short* ep = EIDX + ((size_t)tok * 8 + h) * 16; float* gp = GATE + ((size_t)tok * 8 + h) * 16;
#pragma unroll
        for (int k = 0; k < 16; k += 8) { u32x4 pk; pk.x = (unsigned)eo[k] | ((unsigned)eo[k + 1] << 16); pk.y = (unsigned)eo[k + 2] | ((unsigned)eo[k + 3] << 16); pk.z = (unsigned)eo[k + 4] | ((unsigned)eo[k + 5] << 16); pk.w = (unsigned)eo[k + 6] | ((unsigned)eo[k + 7] << 16); *(u32x4*)(ep + k) = pk; }
#pragma unroll
        for (int k = 0; k < 16; k += 4) *(f32x4*)(gp + k) = (f32x4){e[k], e[k + 1], e[k + 2], e[k + 3]};
    }
}

typedef _Float16 h2_t __attribute__((ext_vector_type(2)));
typedef float f32x2 __attribute__((ext_vector_type(2)));
__device__ __forceinline__ float dot32_fp4(u32x4 w, const h2_t* xh) {
    float acc = 0.f;
#pragma unroll
    for (int d = 0; d < 4; ++d) {
        const unsigned wd = w[d];
        acc = __builtin_amdgcn_fdot2(__builtin_amdgcn_cvt_scalef32_pk_f16_fp4(wd, 1.0f, 0), xh[4 * d], acc, false);
        acc = __builtin_amdgcn_fdot2(__builtin_amdgcn_cvt_scalef32_pk_f16_fp4(wd, 1.0f, 1), xh[4 * d + 1], acc, false);
        acc = __builtin_amdgcn_fdot2(__builtin_amdgcn_cvt_scalef32_pk_f16_fp4(wd, 1.0f, 2), xh[4 * d + 2], acc, false);
        acc = __builtin_amdgcn_fdot2(__builtin_amdgcn_cvt_scalef32_pk_f16_fp4(wd, 1.0f, 3), xh[4 * d + 3], acc, false);
    }
    return acc;
}
typedef int i32x4 __attribute__((ext_vector_type(4)));
struct PMeta { unsigned p[8]; };
#define GAS __attribute__((address_space(1)))
template <class T> __device__ __forceinline__ GAS T* sgpr_ptr(T* p) { asm volatile("" : "+s"(p)); return (GAS T*)p; }
__device__ __forceinline__ void pm_load(PMeta& m, const unsigned short* EIDX, int t  , int seg) {
    const GAS unsigned char* rb = sgpr_ptr((const unsigned char*)(EIDX + (size_t)t * 128)); const unsigned lo = (unsigned)seg * 32u;
#pragma unroll
    for (int q = 0; q < 2; ++q) { const u32x4 ev = __builtin_nontemporal_load((const GAS u32x4*)(rb + (lo + q * 16u))); m.p[4 * q] = ev.x; m.p[4 * q + 1] = ev.y; m.p[4 * q + 2] = ev.z; m.p[4 * q + 3] = ev.w; }
}
#define SCHED_FENCE() __builtin_amdgcn_sched_barrier(0)
__device__ __forceinline__ void rows16_load(u32x4 (&w)[16], const unsigned char* Tbase, unsigned lane_off, const PMeta& m) {
#pragma unroll
    for (int j = 0; j < 16; ++j) { const unsigned pw = m.p[j >> 1]; const unsigned e = (j & 1) ? (pw >> 16) : (pw & 0xffffu); w[j] = *(const u32x4*)(Tbase + (e * 128u + lane_off)); }
}
#define PEER_GEOM() const int s4 = blockIdx.x & 3, th = (blockIdx.x >> 2) & 1, wq = (blockIdx.x >> 3) * NWAVES + wave, NWQ = (gridDim.x >> 3) * NWAVES, t_beg = th * (NTOK / 2) + wq, t_end = (th + 1) * (NTOK / 2)
#define TCL(t) ((t) < t_end ? (t) : t_end - 1)
typedef int v8i_t __attribute__((ext_vector_type(8)));
struct UTok { u32x4 A[8][2]; u32x4 B[2][2]; };
__device__ __forceinline__ void u_issue(UTok& T, const unsigned char* Ts  , const unsigned char* x8row  , unsigned idlo, unsigned idhi, int lane) {
    const int r16 = lane >> 2; const unsigned c16 = (unsigned)(lane & 3) * 16u; const unsigned q16 = (unsigned)(lane >> 4) * 16u;
#pragma unroll
    for (int h = 0; h < 8; ++h) { const unsigned e = (unsigned)__shfl((int)(h < 4 ? idlo : idhi), (h & 3) * 16 + r16);
#pragma unroll
        for (int ks = 0; ks < 2; ++ks) T.A[h][ks] = *(const u32x4*)(Ts + (e * 128u + 64u * ks + c16)); }
#pragma unroll
    for (int ks = 0; ks < 2; ++ks)
#pragma unroll
        for (int hf = 0; hf < 2; ++hf) T.B[ks][hf] = __builtin_nontemporal_load((const GAS u32x4*)(sgpr_ptr(x8row) + (128u * ks + 64u * hf + q16)));
}
__device__ __forceinline__ void u_compute(const UTok& T, int lane, float* dst  ) {
    f32x4 acc[8];
#pragma unroll
    for (int h = 0; h < 8; ++h) {
        acc[h] = (f32x4){0.f, 0.f, 0.f, 0.f};
#pragma unroll
        for (int ks = 0; ks < 2; ++ks) {
            const int src = (4 * (lane & 15) + (lane >> 4)) * 4;
            const v8i_t av = {__builtin_amdgcn_ds_bpermute(src, (int)T.A[h][ks].x), __builtin_amdgcn_ds_bpermute(src, (int)T.A[h][ks].y), __builtin_amdgcn_ds_bpermute(src, (int)T.A[h][ks].z), __builtin_amdgcn_ds_bpermute(src, (int)T.A[h][ks].w), 0, 0, 0, 0};
            const v8i_t bv = {(int)T.B[ks][0].x, (int)T.B[ks][0].y, (int)T.B[ks][0].z, (int)T.B[ks][0].w, (int)T.B[ks][1].x, (int)T.B[ks][1].y, (int)T.B[ks][1].z, (int)T.B[ks][1].w};
            acc[h] = __builtin_amdgcn_mfma_scale_f32_16x16x128_f8f6f4(av, bv, acc[h], 4  , 0  , 0, 0x7F7F7F7F, 0, 0x7F7F7F7F);
        }
    }
    const int j16 = lane & 15; f32x4 r = acc[0];
#pragma unroll
    for (int h = 1; h < 8; ++h) r = (j16 == h) ? acc[h] : r;
    if (j16 < 8) __builtin_nontemporal_store(r, (GAS f32x4*)(sgpr_ptr((unsigned char*)dst) + (unsigned)(j16 * 16 + (lane >> 4) * 4) * 4u));
}
__device__ __forceinline__ void p8a_u(const Args& a, int lane, int wave) {
    const unsigned short* EIDX = (const unsigned short*)(a.ws + WS_EI); float* PB = (float*)(a.ws + WS_PB);
    PEER_GEOM();
    const unsigned char* Ts = a.ws + WS_UT + (size_t)s4 * SLICE4; const unsigned char* x8 = a.ws + WS_X8 + s4 * 256;
    float* pb = PB + (size_t)s4 * NTOK * 128;
#define IDLOAD(lo, hi, t) do { const GAS unsigned short* ip_ = sgpr_ptr(EIDX + (size_t)(t) * 128); lo = ip_[lane]; hi = ip_[64 + lane]; } while (0)
    UTok TA, TB; unsigned ia0, ia1, ib0, ib1;
    IDLOAD(ia0, ia1, TCL(t_beg)); IDLOAD(ib0, ib1, TCL(t_beg + NWQ));
    u_issue(TA, Ts, x8 + (size_t)TCL(t_beg) * DM, ia0, ia1, lane);
    IDLOAD(ia0, ia1, TCL(t_beg + 2 * NWQ));
    for (int t = t_beg; t < t_end; t += 2 * NWQ) {
        SCHED_FENCE();
        u_issue(TB, Ts, x8 + (size_t)TCL(t + NWQ) * DM, ib0, ib1, lane); IDLOAD(ib0, ib1, TCL(t + 3 * NWQ));
        SCHED_FENCE();
        u_compute(TA, lane, pb + (size_t)t * 128);
        SCHED_FENCE();
        u_issue(TA, Ts, x8 + (size_t)TCL(t + 2 * NWQ) * DM, ia0, ia1, lane); IDLOAD(ia0, ia1, TCL(t + 4 * NWQ));
        SCHED_FENCE();
        if (t + NWQ < t_end) u_compute(TB, lane, pb + (size_t)(t + NWQ) * 128);
    }
#undef IDLOAD
}
__device__ __forceinline__ void p8c_combine(const Args& a, unsigned char* lds, int tid) {
    const float* PB = (const float*)(a.ws + WS_PB); unsigned* AB = (unsigned*)(a.ws + WS_AB); const float* GATE = (const float*)(a.ws + WS_GT); const float* SS = (const float*)(a.ws + WS_SS);
    const unsigned short* EIDX = (const unsigned short*)(a.ws + WS_EI); const float* su = (const float*)(a.ws + WS_USC); const float* sv = (const float*)(a.ws + WS_VSC);
    const size_t n4 = (size_t)NTOK * 128 / 4, nth = (size_t)gridDim.x * NTHR;
    LAS float* su_l = (LAS float*)lds; LAS float* sv_l = su_l + 16384;
    for (int i = tid; i < 16384 / 4; i += NTHR) { *(LAS f32x4*)(su_l + 4 * i) = *(const f32x4*)(su + 4 * i); *(LAS f32x4*)(sv_l + 4 * i) = *(const f32x4*)(sv + 4 * i); }
    __syncthreads();
    float calib;
    { unsigned a1 = 0u; a1 = __builtin_amdgcn_cvt_scalef32_pk_fp4_f32(a1, 1.0f, 1.0f, 1.0f, 0); a1 = __builtin_amdgcn_cvt_scalef32_pk_fp4_f32(a1, 1.0f, 1.0f, 1.0f, 1);
      a1 = __builtin_amdgcn_cvt_scalef32_pk_fp4_f32(a1, 1.0f, 1.0f, 1.0f, 2); a1 = __builtin_amdgcn_cvt_scalef32_pk_fp4_f32(a1, 1.0f, 1.0f, 1.0f, 3);
      unsigned b1 = (unsigned)__builtin_amdgcn_cvt_pk_fp8_f32(1.0f, 1.0f, 0, false); b1 = (unsigned)__builtin_amdgcn_cvt_pk_fp8_f32(1.0f, 1.0f, (int)b1, true);
      const v8i_t av = {(int)a1, (int)a1, (int)a1, (int)a1, 0, 0, 0, 0}, bv = {(int)b1, (int)b1, (int)b1, (int)b1, (int)b1, (int)b1, (int)b1, (int)b1};
      const f32x4 c = __builtin_amdgcn_mfma_scale_f32_16x16x128_f8f6f4(av, bv, (f32x4){0.f, 0.f, 0.f, 0.f}, 4, 0, 0, 0x7F7F7F7F, 0, 0x7F7F7F7F);
      calib = 128.0f / c[0] * (1.0f / X8SCALE); }
    for (size_t i = (size_t)blockIdx.x * NTHR + tid; i < n4; i += nth) {
        f32x4 d = __builtin_nontemporal_load((const f32x4*)PB + i);
#pragma unroll
        for (int s2 = 1; s2 < 4; ++s2) d += __builtin_nontemporal_load((const f32x4*)PB + (size_t)s2 * n4 + i);
        const f32x4 g = __builtin_nontemporal_load((const f32x4*)GATE + i); const u32x2 ew = __builtin_nontemporal_load((const u32x2*)EIDX + i);
        const unsigned e[4] = {ew.x & 0xffffu, ew.x >> 16, ew.y & 0xffffu, ew.y >> 16}; float o[4];
        const float cr = calib / sqrtf(SS[i >> 5] * (1.0f / DM) + EPS);
#pragma unroll
        for (int j = 0; j < 4; ++j) { const float z = d[j] * su_l[e[j]] * cr; o[j] = 0.5f * z * (1.0f + erff(z * 0.70710678118654752f)) * g[j] * sv_l[e[j]]; }
        unsigned w8 = (unsigned)__builtin_amdgcn_cvt_pk_fp8_f32(o[0] * A8SCALE, o[1] * A8SCALE, 0, false); w8 = (unsigned)__builtin_amdgcn_cvt_pk_fp8_f32(o[2] * A8SCALE, o[3] * A8SCALE, (int)w8, true); AB[i] = w8;
    }
}
typedef int v2i_t __attribute__((ext_vector_type(2)));
constexpr int VROW = 144, VIMG = 128 * VROW;
struct VRec { u32x4 a8[2]; u32x2 h; };
__device__ __forceinline__ void v_token(const u32x4 (&w)[16], const VRec& rc, LAS unsigned char* vl  , float oscale, int lane, float* dst  , bool do_store) {
    const int seg = lane >> 3, c8 = lane & 7, i16 = lane & 15, q = lane >> 4;
#pragma unroll
    for (int j = 0; j < 16; ++j) *(LAS u32x4*)(vl + (seg * 16 + j) * VROW + c8 * 16) = w[j];
    asm volatile("s_waitcnt lgkmcnt(0)" ::: "memory");
    const v8i_t av = {(int)rc.a8[0].x, (int)rc.a8[0].y, (int)rc.a8[0].z, (int)rc.a8[0].w, (int)rc.a8[1].x, (int)rc.a8[1].y, (int)rc.a8[1].z, (int)rc.a8[1].w};
    const LAS unsigned char* rp = vl + (32 * q + i16) * VROW;
    float val[4] = {0.f, 0.f, 0.f, 0.f};
#pragma unroll
    for (int cb = 0; cb < 16; ++cb) {
        const v2i_t r1 = __builtin_amdgcn_ds_read_tr4_b64_v2i32((LAS v2i_t*)(rp + cb * 8)), r2 = __builtin_amdgcn_ds_read_tr4_b64_v2i32((LAS v2i_t*)(rp + 16 * VROW + cb * 8));
        const v8i_t bv = {r1.x, r1.y, r2.x, r2.y, 0, 0, 0, 0};
        const f32x4 acc = __builtin_amdgcn_mfma_scale_f32_16x16x128_f8f6f4(av, bv, (f32x4){0.f, 0.f, 0.f, 0.f}, 0  , 4  , 0, 0x7F7F7F7F, 0, 0x7F7F7F7F);
        const float a0 = acc[0]; val[cb & 3] = (q == (cb >> 2)) ? a0 : val[cb & 3];
    }
    asm volatile("s_waitcnt lgkmcnt(0)" ::: "memory");
    if (do_store) {
        *(GAS f32x4*)(sgpr_ptr((unsigned char*)dst) + (unsigned)lane * 16u) = (f32x4){bflo(rc.h.x) + val[0] * oscale, bfhi(rc.h.x) + val[1] * oscale, bflo(rc.h.y) + val[2] * oscale, bfhi(rc.h.y) + val[3] * oscale};
    } else asm volatile("" :: "v"(val[0]), "v"(val[1]), "v"(val[2]), "v"(val[3]));
}
__device__ __forceinline__ void p8b_v(const Args& a, unsigned char* lds, int lane, int wave, bool do_store) {
    const unsigned short* EIDX = (const unsigned short*)(a.ws + WS_EI); const unsigned char* AB = a.ws + WS_AB; const bf16_t* HB = (const bf16_t*)(a.ws + WS_HB);
    PEER_GEOM();
    const int seg = lane >> 3, c8 = lane & 7, q = lane >> 4;
    const unsigned char* Ts = a.ws + WS_UT + (size_t)(4 + s4) * SLICE4; const unsigned loff = c8 * 16;
    LAS unsigned char* vl = (LAS unsigned char*)lds + wave * VIMG;
    float oscale;
    { unsigned a1 = 0u; a1 = __builtin_amdgcn_cvt_scalef32_pk_fp4_f32(a1, 1.0f, 1.0f, 1.0f, 0); a1 = __builtin_amdgcn_cvt_scalef32_pk_fp4_f32(a1, 1.0f, 1.0f, 1.0f, 1);
      a1 = __builtin_amdgcn_cvt_scalef32_pk_fp4_f32(a1, 1.0f, 1.0f, 1.0f, 2); a1 = __builtin_amdgcn_cvt_scalef32_pk_fp4_f32(a1, 1.0f, 1.0f, 1.0f, 3);
      unsigned b1 = (unsigned)__builtin_amdgcn_cvt_pk_fp8_f32(1.0f, 1.0f, 0, false); b1 = (unsigned)__builtin_amdgcn_cvt_pk_fp8_f32(1.0f, 1.0f, (int)b1, true);
      const v8i_t av = {(int)b1, (int)b1, (int)b1, (int)b1, (int)b1, (int)b1, (int)b1, (int)b1}, bv = {(int)a1, (int)a1, (int)a1, (int)a1, 0, 0, 0, 0};
      const f32x4 c = __builtin_amdgcn_mfma_scale_f32_16x16x128_f8f6f4(av, bv, (f32x4){0.f, 0.f, 0.f, 0.f}, 0, 4, 0, 0x7F7F7F7F, 0, 0x7F7F7F7F);
      oscale = 128.0f / c[0] * (1.0f / A8SCALE); }
    const unsigned aoff = (unsigned)q * 16u, hoff = (unsigned)(s4 * 256 + 4 * lane) * 2u;
#define REC_LOAD(R, t) do { const GAS unsigned char* ab_ = sgpr_ptr(AB + (size_t)(t) * 128); R.a8[0] = __builtin_nontemporal_load((const GAS u32x4*)(ab_ + aoff)); R.a8[1] = __builtin_nontemporal_load((const GAS u32x4*)(ab_ + (64u + aoff))); \
        R.h = __builtin_nontemporal_load((const GAS u32x2*)(sgpr_ptr((const unsigned char*)(HB + (size_t)(t) * DM)) + hoff)); } while (0)
    PMeta mA, mB; u32x4 wA[16], wB[16]; VRec rA, rB;
    pm_load(mA, EIDX, TCL(t_beg), seg); pm_load(mB, EIDX, TCL(t_beg + NWQ), seg);
    rows16_load(wA, Ts, loff, mA); REC_LOAD(rA, TCL(t_beg));
    pm_load(mA, EIDX, TCL(t_beg + 2 * NWQ), seg);
    for (int t = t_beg; t < t_end; t += 2 * NWQ) {
        SCHED_FENCE();
        rows16_load(wB, Ts, loff, mB); REC_LOAD(rB, TCL(t + NWQ)); pm_load(mB, EIDX, TCL(t + 3 * NWQ), seg);
        SCHED_FENCE();
        v_token(wA, rA, vl, oscale, lane, a.out + (size_t)t * DM + s4 * 256, do_store);
        SCHED_FENCE();
        rows16_load(wA, Ts, loff, mA); REC_LOAD(rA, TCL(t + 2 * NWQ)); pm_load(mA, EIDX, TCL(t + 4 * NWQ), seg);
        SCHED_FENCE();
        if (t + NWQ < t_end) v_token(wB, rB, vl, oscale, lane, a.out + (size_t)(t + NWQ) * DM + s4 * 256, do_store);
    }
#undef REC_LOAD
#undef TCL
#undef PEER_GEOM
}

namespace pg8 {
#define PG8_LAS __attribute__((address_space(3)))
typedef unsigned short bf16_t;
typedef short bf16x8 __attribute__((ext_vector_type(8)));
typedef float f32x4 __attribute__((ext_vector_type(4)));
typedef unsigned u32x4 __attribute__((ext_vector_type(4)));
constexpr int BM = 256, BK = 64, HALF = 128, HTB = HALF * BK * 2  , STAGE_BYTES = 8 * HTB, NXCD = 8, WGM = 8;

__host__ __device__ __forceinline__ int lds_byte(int r, int c) { const int st = (r >> 4) * 2 + (c >> 5), rr = r & 15, cc = c & 31, ob = rr * 64 + cc * 2; return st * 1024 + (ob ^ (((ob >> 9) & 1) << 5)); }
__host__ __device__ __forceinline__ void stage_rc(int b, int& R, int& C) { const int st = b / 1024, sb = b % 1024, swz = sb ^ (((sb >> 9) & 1) << 5); R = (st >> 1) * 16 + swz / 64; C = (st & 1) * 32 + (swz % 64) / 2; }
__host__ __device__ __forceinline__ int perm32(int rho) { const int n = rho >> 4, i = rho & 15; return 8 * (i >> 2) + 4 * n + (i & 3); }

struct Unit { int pm, pn; };
struct Gemm { const bf16_t* A; const bf16_t* Bt; int M, N, K; };

struct StaticOrder {
    int nM, nN, nwg, G, c;
    __host__ __device__ void init(int M, int N, int G_, int c_) { nM = M / BM; nN = N / BM; nwg = nM * nN; G = G_; c = c_; }
    __host__ __device__ bool next(int i, Unit& u) const {
        const long L = (long)i * G + c; if (L >= nwg) return false;
        int wgid = (int)L; { const int q = nwg / NXCD, r = nwg % NXCD, xcd = wgid % NXCD, off = wgid / NXCD; wgid = (xcd < r ? xcd * (q + 1) : r * (q + 1) + (xcd - r) * q) + off; }
        const int nig = WGM * nN, gid = wgid / nig, fm = gid * WGM, gsz = (nM - fm) < WGM ? (nM - fm) : WGM;
        u.pm = fm + ((wgid % nig) % gsz); u.pn = (wgid % nig) / gsz; return true;
    }
    __device__ __forceinline__ void a_ready(const Unit&) const {}
    __device__ __forceinline__ void done(const Unit&) const {}
};


__device__ __forceinline__ unsigned cvt_pk_bf16(float lo, float hi) { unsigned r; asm volatile("v_cvt_pk_bf16_f32 %0, %1, %2" : "=v"(r) : "v"(lo), "v"(hi)); return r; }
struct EpiInProj {
    static constexpr bool PERM = true, AFTER_DRAIN = false;
    bf16_t* O; bf16_t* QB; bf16_t* KB; bf16_t* VB; const float* rope; const float* qg; const float* kg;
    template <bool NORM> __device__ __forceinline__ void head_row(f32x4 a00, f32x4 a01, f32x4 a10, f32x4 a11, const float* g0, const float* g1, int t, int fq, bf16_t* dst  ) const {
        float x0[8] = {a00[0], a00[1], a00[2], a00[3], a01[0], a01[1], a01[2], a01[3]}, x1[8] = {a10[0], a10[1], a10[2], a10[3], a11[0], a11[1], a11[2], a11[3]};
        if (NORM) {
            float ss = 0.f;
#pragma unroll
            for (int e = 0; e < 8; ++e) ss += x0[e] * x0[e] + x1[e] * x1[e];
            ss += __shfl_xor(ss, 16); ss += __shfl_xor(ss, 32);
            const float rstd = 1.0f / sqrtf(ss * (1.0f / 64.0f) + 1e-6f);
            const float* r0 = rope + (((t >> 6) * 16 + (fq & 1) * 8) * 2); const float* r1 = rope + (((t & 63) * 16 + (fq & 1) * 8) * 2);
            f32x4 c0[4], c1[4];
#pragma unroll
            for (int q4 = 0; q4 < 4; ++q4) { c0[q4] = *(const f32x4*)(r0 + 4 * q4); c1[q4] = *(const f32x4*)(r1 + 4 * q4); }
#pragma unroll
            for (int e = 0; e < 8; ++e) { x0[e] *= rstd * g0[e]; x1[e] *= rstd * g1[e]; }
#pragma unroll
            for (int e = 0; e < 8; ++e) { const float o0 = __shfl_xor(x0[e], 32), o1 = __shfl_xor(x1[e], 32);
                const float cs0 = c0[e >> 1][(e & 1) * 2], sn0 = c0[e >> 1][(e & 1) * 2 + 1], cs1 = c1[e >> 1][(e & 1) * 2], sn1 = c1[e >> 1][(e & 1) * 2 + 1];
                x0[e] = (fq & 2) ? x0[e] * cs0 + o0 * sn0 : x0[e] * cs0 - o0 * sn0; x1[e] = (fq & 2) ? x1[e] * cs1 + o1 * sn1 : x1[e] * cs1 - o1 * sn1; }
        }
        u32x4 w; w.x = cvt_pk_bf16(x0[0], x0[1]); w.y = cvt_pk_bf16(x0[2], x0[3]); w.z = cvt_pk_bf16(x0[4], x0[5]); w.w = cvt_pk_bf16(x0[6], x0[7]); *(u32x4*)dst = w;
        w.x = cvt_pk_bf16(x1[0], x1[1]); w.y = cvt_pk_bf16(x1[2], x1[3]); w.z = cvt_pk_bf16(x1[4], x1[5]); w.w = cvt_pk_bf16(x1[6], x1[7]); *(u32x4*)(dst + 32) = w;
    }
    __device__ __forceinline__ void operator()(const f32x4 (&acc)[2][2][4][2], const Unit& u, int wr, int wc, int fr, int fq) const {
        const int row0 = u.pm * BM + wr * 64 + fr, pn = u.pn;
        if (pn < 2) {
            const int col0 = 256 * pn + wc * 32 + 8 * fq;
#pragma unroll
            for (int ai = 0; ai < 2; ++ai)
#pragma unroll
                for (int m = 0; m < 4; ++m) { bf16_t* rowp = O + (size_t)(row0 + ai * HALF + m * 16) * 1024 + col0;
#pragma unroll
                    for (int bj = 0; bj < 2; ++bj) { const f32x4 v0 = acc[ai][bj][m][0], v1 = acc[ai][bj][m][1];
                        u32x4 w; w.x = cvt_pk_bf16(v0[0], v0[1]); w.y = cvt_pk_bf16(v0[2], v0[3]); w.z = cvt_pk_bf16(v1[0], v1[1]); w.w = cvt_pk_bf16(v1[2], v1[3]);
                        *(u32x4*)(rowp + bj * HALF) = w; } }
        } else if (pn < 6) {
            const int col0 = 512 + 128 * (pn - 2) + wc * 32 + 8 * fq;
#pragma unroll
            for (int ai = 0; ai < 2; ++ai)
#pragma unroll
                for (int m = 0; m < 4; ++m) { const f32x4 v0 = acc[ai][0][m][0] * acc[ai][1][m][0], v1 = acc[ai][0][m][1] * acc[ai][1][m][1];
                    u32x4 w; w.x = cvt_pk_bf16(v0[0], v0[1]); w.y = cvt_pk_bf16(v0[2], v0[3]); w.z = cvt_pk_bf16(v1[0], v1[1]); w.w = cvt_pk_bf16(v1[2], v1[3]);
                    *(u32x4*)(O + (size_t)(row0 + ai * HALF + m * 16) * 1024 + col0) = w; }
        } else if (pn < 8) {
            float g0[8], g1[8];
#pragma unroll
            for (int e = 0; e < 8; ++e) { g0[e] = qg[8 * fq + e] * C2; g1[e] = qg[32 + 8 * fq + e] * C2; }
            const int hh = 4 * (pn - 6) + wc;
#pragma unroll
            for (int ai = 0; ai < 2; ++ai)
#pragma unroll
                for (int m = 0; m < 4; ++m) { const int r = row0 + ai * HALF + m * 16;
                    head_row<true>(acc[ai][0][m][0], acc[ai][0][m][1], acc[ai][1][m][0], acc[ai][1][m][1], g0, g1, r & 2047, fq, QB + (size_t)r * 512 + hh * 64 + 8 * fq); }
        } else {
            float g0[8], g1[8];
#pragma unroll
            for (int e = 0; e < 8; ++e) { g0[e] = kg[8 * fq + e]; g1[e] = kg[32 + 8 * fq + e]; }
            const int g = wc & 1;
#pragma unroll
            for (int ai = 0; ai < 2; ++ai)
#pragma unroll
                for (int m = 0; m < 4; ++m) { const int r = row0 + ai * HALF + m * 16, b = r >> 11, t = r & 2047; const size_t krow = ((size_t)(b * 2 + g) * KROWS + t) * 64 + 8 * fq;
                    if (wc < 2) head_row<true>(acc[ai][0][m][0], acc[ai][0][m][1], acc[ai][1][m][0], acc[ai][1][m][1], g0, g1, t, fq, KB + krow);
                    else head_row<false>(acc[ai][0][m][0], acc[ai][0][m][1], acc[ai][1][m][0], acc[ai][1][m][1], g0, g1, t, fq, VB + krow); }
        }
    }
};
struct EpiBf16 {
    static constexpr bool PERM = true, AFTER_DRAIN = false;
    bf16_t* O; int ldc;
    __device__ __forceinline__ void operator()(const f32x4 (&acc)[2][2][4][2], const Unit& u, int wr, int wc, int fr, int fq) const {
        const int row0 = u.pm * BM + wr * 64 + fr; const int col0 = u.pn * BM + wc * 32 + 8 * fq;
#pragma unroll
        for (int ai = 0; ai < 2; ++ai)
#pragma unroll
            for (int m = 0; m < 4; ++m) { bf16_t* rowp = O + (size_t)(row0 + ai * HALF + m * 16) * ldc + col0;
#pragma unroll
                for (int bj = 0; bj < 2; ++bj) { const f32x4 v0 = acc[ai][bj][m][0], v1 = acc[ai][bj][m][1];
                    u32x4 w; w.x = cvt_pk_bf16(v0[0], v0[1]); w.y = cvt_pk_bf16(v0[2], v0[3]); w.z = cvt_pk_bf16(v1[0], v1[1]); w.w = cvt_pk_bf16(v1[2], v1[3]);
                    *(u32x4*)(rowp + bj * HALF) = w; } }
    }
};
struct EpiResidNorm {
    static constexpr bool PERM = true, AFTER_DRAIN = false;
    const float* xp; const float* xs; float* out; int split_row; bf16_t* hb; unsigned char* h8; float* ss; float x8scale;
    __device__ __forceinline__ const float* xrow(int r, int col0) const { return (r < split_row ? xp + (size_t)r * 1024 : xs + (size_t)(r - split_row) * 1024) + col0; }
    __device__ __forceinline__ void operator()(const f32x4 (&acc)[2][2][4][2], const Unit& u, int wr, int wc, int fr, int fq) const {
        const int col0 = u.pn * BM + wc * 32 + 8 * fq, rbase = u.pm * BM + wr * 64 + fr;
        f32x4 xv[4][2][2];
#pragma unroll
        for (int m = 0; m < 4; ++m) { const float* xr = xrow(rbase + m * 16, col0);
#pragma unroll
            for (int bj = 0; bj < 2; ++bj) { xv[m][bj][0] = *(const f32x4*)(xr + bj * HALF); xv[m][bj][1] = *(const f32x4*)(xr + bj * HALF + 4); } }
#pragma unroll
        for (int ai = 0; ai < 2; ++ai)
#pragma unroll
            for (int m = 0; m < 4; ++m) { const int r = rbase + ai * HALF + m * 16;
                bf16_t* brow = hb + (size_t)r * 1024 + col0; unsigned char* qrow = h8 + (size_t)r * 1024 + col0; float s = 0.f;
                f32x4 h[2][2];
#pragma unroll
                for (int bj = 0; bj < 2; ++bj) { h[bj][0] = xv[m][bj][0] + acc[ai][bj][m][0]; h[bj][1] = xv[m][bj][1] + acc[ai][bj][m][1]; }
                if (ai == 0) { const float* xr = xrow(r + HALF, col0);
#pragma unroll
                    for (int bj = 0; bj < 2; ++bj) { xv[m][bj][0] = *(const f32x4*)(xr + bj * HALF); xv[m][bj][1] = *(const f32x4*)(xr + bj * HALF + 4); } }
#pragma unroll
                for (int bj = 0; bj < 2; ++bj) { const f32x4 h0 = h[bj][0], h1 = h[bj][1];
                    u32x4 wb; wb.x = cvt_pk_bf16(h0[0], h0[1]); wb.y = cvt_pk_bf16(h0[2], h0[3]); wb.z = cvt_pk_bf16(h1[0], h1[1]); wb.w = cvt_pk_bf16(h1[2], h1[3]); *(u32x4*)(brow + bj * HALF) = wb;
                    unsigned w0 = (unsigned)__builtin_amdgcn_cvt_pk_fp8_f32(h0[0] * x8scale, h0[1] * x8scale, 0, false); w0 = (unsigned)__builtin_amdgcn_cvt_pk_fp8_f32(h0[2] * x8scale, h0[3] * x8scale, (int)w0, true);
                    unsigned w1 = (unsigned)__builtin_amdgcn_cvt_pk_fp8_f32(h1[0] * x8scale, h1[1] * x8scale, 0, false); w1 = (unsigned)__builtin_amdgcn_cvt_pk_fp8_f32(h1[2] * x8scale, h1[3] * x8scale, (int)w1, true);
                    *(u32x2*)(qrow + bj * HALF) = (u32x2){w0, w1};
                    s += ((h0[0] * h0[0] + h0[1] * h0[1]) + (h0[2] * h0[2] + h0[3] * h0[3])) + ((h1[0] * h1[0] + h1[1] * h1[1]) + (h1[2] * h1[2] + h1[3] * h1[3])); }
                s += __shfl_xor(s, 16); s += __shfl_xor(s, 32);
                if (fq == 0) atomicAdd(ss + r, s); }
    }
};
struct EpiResid {
    static constexpr bool PERM = false, AFTER_DRAIN = false;
    const float* xp; const float* xs; float* out; int split_row;
    __device__ __forceinline__ void operator()(const f32x4 (&acc)[2][2][4][2], const Unit& u, int wr, int wc, int fr, int fq) const {
        const int col0 = u.pn * BM + wc * 32 + 4 * fq;
#pragma unroll
        for (int ai = 0; ai < 2; ++ai)
#pragma unroll
            for (int m = 0; m < 4; ++m) { const int r = u.pm * BM + ai * HALF + wr * 64 + m * 16 + fr;
                const float* xr = (r < split_row ? xp + (size_t)r * 1024 : xs + (size_t)(r - split_row) * 1024) + col0; float* orow = out + (size_t)r * 1024 + col0;
#pragma unroll
                for (int bj = 0; bj < 2; ++bj)
#pragma unroll
                    for (int n = 0; n < 2; ++n) { const f32x4 bs = *(const f32x4*)(xr + bj * HALF + n * 16); *(f32x4*)(orow + bj * HALF + n * 16) = bs + acc[ai][bj][m][n]; } }
    }
};

template <class Epi, class Sched, bool ALIGN_EPI = false, bool SP2 = false>
__device__ __forceinline__ void gemm_phase(PG8_LAS unsigned char* lds, const Gemm g, const Sched& S, const Epi& E) {
    const int tid = threadIdx.x, wid = __builtin_amdgcn_readfirstlane(tid >> 6), lane = tid & 63, wr = wid >> 2, wc = wid & 3, fr = lane & 15, fq = lane >> 4;
    const int K = g.K, nt = K / BK;
    unsigned voffA[2], voffB[2];
#pragma unroll
    for (int i = 0; i < 2; ++i) { int R, C; stage_rc(tid * 16 + i * 8192, R, C); const int Rb = Epi::PERM ? ((R & ~31) + perm32(R & 31)) : R;
        voffA[i] = (unsigned)(R * K + C) * 2u; voffB[i] = (unsigned)(Rb * K + C) * 2u; }
    const size_t kstep = (size_t)(BK * 2);
    const size_t hstep = (size_t)HALF * K * 2;
    const size_t tstep = 2 * hstep;
    const unsigned ldsw = (unsigned)wid * 1024u;
    const int aoff = lds_byte(wr * 64 + fr, fq * 8), boff = lds_byte(wc * 32 + fr, fq * 8);
#define PG8_SA(b, h) (((b) * 2 + (h)) * HTB)
#define PG8_SB(b, h) ((4 + (b) * 2 + (h)) * HTB)
#define PG8_STAGE(bufoff, gbase, voff) do { _Pragma("unroll") for (int _i = 0; _i < 2; ++_i) \
        __builtin_amdgcn_global_load_lds((const unsigned*)((const char*)(gbase) + (voff)[_i]), (PG8_LAS unsigned*)(lds + (bufoff) + ldsw + _i * 8192), 16, 0, 0); } while (0)
#define PG8_LDA(dst, b, h) do { _Pragma("unroll") for (int m = 0; m < 4; ++m) _Pragma("unroll") for (int k = 0; k < 2; ++k) dst[m][k] = *(const PG8_LAS bf16x8*)(lds + PG8_SA(b, h) + aoff + m * 2048 + k * 1024); } while (0)
#define PG8_LDB(dst, b, h) do { _Pragma("unroll") for (int n = 0; n < 2; ++n) _Pragma("unroll") for (int k = 0; k < 2; ++k) dst[n][k] = *(const PG8_LAS bf16x8*)(lds + PG8_SB(b, h) + boff + n * 2048 + k * 1024); } while (0)
#define PG8_MMA(ai, bj, At, Bt) do { __builtin_amdgcn_s_setprio(1); _Pragma("unroll") for (int m = 0; m < 4; ++m) _Pragma("unroll") for (int n = 0; n < 2; ++n) _Pragma("unroll") for (int k = 0; k < 2; ++k) \
        acc[ai][bj][m][n] = __builtin_amdgcn_mfma_f32_16x16x32_bf16(Bt[n][k], At[m][k], acc[ai][bj][m][n], 0, 0, 0); __builtin_amdgcn_s_setprio(0); } while (0)
#define PG8_WAIT_V(n) asm volatile("s_waitcnt vmcnt(" #n ")" ::: "memory")
#define PG8_WAIT_L(n) asm volatile("s_waitcnt lgkmcnt(" #n ")" ::: "memory")
#define PG8_BAR __builtin_amdgcn_s_barrier()
#define PG8_SCHED __builtin_amdgcn_sched_barrier(0)
    Unit cur, nxt; int ui = 0;
    if (!S.next(0, cur)) return;
    f32x4 acc[2][2][4][2];
#pragma unroll
    for (int a = 0; a < 2; ++a)
#pragma unroll
        for (int b = 0; b < 2; ++b)
#pragma unroll
            for (int m = 0; m < 4; ++m)
#pragma unroll
                for (int n = 0; n < 2; ++n) acc[a][b][m][n] = (f32x4){0.f, 0.f, 0.f, 0.f};
    bf16x8 At[4][2], B0[2][2], B1[2][2];
    const char* cA = (const char*)g.A + (size_t)cur.pm * tstep; const char* cB = (const char*)g.Bt + (size_t)cur.pn * tstep;
    S.a_ready(cur);
    if constexpr (SP2) {
        PG8_STAGE(PG8_SB(0, 0), cB, voffB); PG8_STAGE(PG8_SB(0, 1), cB + hstep, voffB); PG8_STAGE(PG8_SA(0, 0), cA, voffA); PG8_STAGE(PG8_SA(0, 1), cA + hstep, voffA);
        if (wr == 1) PG8_BAR;
        PG8_WAIT_V(2); PG8_BAR;
        PG8_STAGE(PG8_SB(1, 0), cB + kstep, voffB); PG8_STAGE(PG8_SA(1, 0), cA + kstep, voffA); PG8_STAGE(PG8_SB(1, 1), cB + hstep + kstep, voffB);
        PG8_WAIT_V(6); PG8_BAR;
    } else {
        PG8_STAGE(PG8_SB(0, 0), cB, voffB); PG8_STAGE(PG8_SA(0, 0), cA, voffA); PG8_STAGE(PG8_SB(0, 1), cB + hstep, voffB); PG8_STAGE(PG8_SA(0, 1), cA + hstep, voffA);
        if (wr == 1) PG8_BAR;
        PG8_WAIT_V(4); PG8_BAR;
        PG8_STAGE(PG8_SB(1, 0), cB + kstep, voffB); PG8_STAGE(PG8_SA(1, 0), cA + kstep, voffA); PG8_STAGE(PG8_SB(1, 1), cB + hstep + kstep, voffB);
        PG8_WAIT_V(6); PG8_BAR;
    }
    for (;;) {
        const bool has_next = S.next(ui + 1, nxt);
        const char* nA = has_next ? (const char*)g.A + (size_t)nxt.pm * tstep : cA; const char* nB = has_next ? (const char*)g.Bt + (size_t)nxt.pn * tstep : cB;
        for (int t = 0; t < nt; t += 2) {
            const bool last = (t == nt - 2);
            const char* a1 = cA + (size_t)(t + 1) * kstep;
            const char* a2 = last ? nA : cA + (size_t)(t + 2) * kstep; const char* b2 = last ? nB : cB + (size_t)(t + 2) * kstep;
            const char* a3 = a2 + kstep; const char* b3 = b2 + kstep;
            if (last && has_next) S.a_ready(nxt);
            if constexpr (SP2) {
            PG8_LDB(B0, 0, 0); PG8_LDB(B1, 0, 1); PG8_SCHED; PG8_LDA(At, 0, 0); PG8_STAGE(PG8_SA(1, 1), a1 + hstep, voffA);
            PG8_WAIT_V(8); PG8_WAIT_L(0); PG8_BAR; PG8_MMA(0, 0, At, B0); PG8_MMA(0, 1, At, B1); PG8_BAR; PG8_SCHED;
            PG8_LDA(At, 0, 1); PG8_STAGE(PG8_SB(0, 0), b2, voffB); PG8_STAGE(PG8_SB(0, 1), b2 + hstep, voffB); PG8_STAGE(PG8_SA(0, 0), a2, voffA);
            PG8_WAIT_V(8); PG8_WAIT_L(0); PG8_BAR; PG8_MMA(1, 0, At, B0); PG8_MMA(1, 1, At, B1); PG8_BAR; PG8_SCHED;
            PG8_LDB(B0, 1, 0); PG8_LDB(B1, 1, 1); PG8_SCHED; PG8_LDA(At, 1, 0); PG8_STAGE(PG8_SA(0, 1), a2 + hstep, voffA);
            PG8_WAIT_V(8); PG8_WAIT_L(0); PG8_BAR; PG8_MMA(0, 0, At, B0); PG8_MMA(0, 1, At, B1); PG8_BAR; PG8_SCHED;
            PG8_LDA(At, 1, 1); PG8_STAGE(PG8_SB(1, 0), b3, voffB); PG8_STAGE(PG8_SB(1, 1), b3 + hstep, voffB); PG8_STAGE(PG8_SA(1, 0), a3, voffA);
            PG8_WAIT_V(8); PG8_WAIT_L(0); PG8_BAR; PG8_MMA(1, 0, At, B0); PG8_MMA(1, 1, At, B1); PG8_BAR; PG8_SCHED;
            } else {
            PG8_LDB(B0, 0, 0); PG8_SCHED; PG8_LDA(At, 0, 0); PG8_STAGE(PG8_SA(1, 1), a1 + hstep, voffA);
            PG8_WAIT_L(8); PG8_BAR; PG8_WAIT_L(0); PG8_MMA(0, 0, At, B0); PG8_BAR; PG8_SCHED;
            PG8_LDB(B1, 0, 1); PG8_STAGE(PG8_SB(0, 0), b2, voffB);
            PG8_BAR; PG8_WAIT_L(0); PG8_MMA(0, 1, At, B1); PG8_BAR;
            PG8_LDA(At, 0, 1); PG8_STAGE(PG8_SA(0, 0), a2, voffA);
            PG8_BAR; PG8_WAIT_L(0); PG8_MMA(1, 0, At, B0); PG8_BAR; PG8_SCHED;
            PG8_STAGE(PG8_SB(0, 1), b2 + hstep, voffB);
            PG8_WAIT_V(6); PG8_BAR; PG8_MMA(1, 1, At, B1); PG8_BAR;
            PG8_LDB(B0, 1, 0); PG8_SCHED; PG8_LDA(At, 1, 0); PG8_STAGE(PG8_SA(0, 1), a2 + hstep, voffA);
            PG8_WAIT_L(8); PG8_BAR; PG8_WAIT_L(0); PG8_MMA(0, 0, At, B0); PG8_BAR; PG8_SCHED;
            PG8_LDB(B1, 1, 1); PG8_STAGE(PG8_SB(1, 0), b3, voffB);
            PG8_BAR; PG8_WAIT_L(0); PG8_MMA(0, 1, At, B1); PG8_BAR;
            PG8_LDA(At, 1, 1); PG8_STAGE(PG8_SA(1, 0), a3, voffA);
            PG8_BAR; PG8_WAIT_L(0); PG8_MMA(1, 0, At, B0); PG8_BAR; PG8_SCHED;
            PG8_STAGE(PG8_SB(1, 1), b3 + hstep, voffB);
            PG8_WAIT_V(6); PG8_BAR; PG8_MMA(1, 1, At, B1); PG8_BAR;
            }
        }
        if constexpr (ALIGN_EPI) { if (wr == 0) PG8_BAR; }
        if constexpr (!Epi::AFTER_DRAIN) { E(acc, cur, wr, wc, fr, fq); S.done(cur); }
        if (!has_next) break;
#pragma unroll
        for (int a = 0; a < 2; ++a)
#pragma unroll
            for (int b = 0; b < 2; ++b)
#pragma unroll
                for (int m = 0; m < 4; ++m)
#pragma unroll
                    for (int n = 0; n < 2; ++n) acc[a][b][m][n] = (f32x4){0.f, 0.f, 0.f, 0.f};
        cur = nxt; cA = nA; cB = nB; ++ui;
        if constexpr (ALIGN_EPI) { if (wr == 1) PG8_BAR; }
    }
    PG8_WAIT_V(0);
    if constexpr (!ALIGN_EPI) { if (wr == 0) PG8_BAR; }
    PG8_BAR;
    if constexpr (Epi::AFTER_DRAIN) { E.fused(acc, cur, wr, wc, fr, fq, lds, wid, lane); S.done(cur); }
#undef PG8_SA
#undef PG8_SB
#undef PG8_STAGE
#undef PG8_LDA
#undef PG8_LDB
#undef PG8_MMA
#undef PG8_WAIT_V
#undef PG8_WAIT_L
#undef PG8_BAR
#undef PG8_SCHED
}
}


#include <hip/hip_bf16.h>
#include <cmath>
namespace attn_body {
using bf16=__hip_bfloat16;
using bf16x8=__attribute__((ext_vector_type(8)))short;
using s16x4=__attribute__((ext_vector_type(4)))short;
using f32x16=__attribute__((ext_vector_type(16)))float;
using u32x4=__attribute__((ext_vector_type(4)))unsigned;
constexpr int SEQ=2048,D=64,QP=512,KVP=64,OP=1024,KVROWS=2112;
constexpr int NW=8,QBLK=32,QB=QBLK*NW,KVBLK=64,NQB=SEQ/QB,NT=KVROWS/KVBLK;
constexpr int ATTN_UNIT_ROWS=QB;
__device__ __forceinline__ int crow(int r,int hi){return (r&3)+8*(r>>2)+4*hi;}
#define SBAR() __builtin_amdgcn_sched_barrier(0)
__device__ __forceinline__ void tmask(f32x16&p0,f32x16&p1){
  const float NEG=-INFINITY;
  #pragma unroll
  for(int r=8;r<16;++r)p0[r]=NEG;
  #pragma unroll
  for(int r=0;r<16;++r)p1[r]=NEG;
}

constexpr int NSLOT=3, SLOTB=8192;
constexpr int LDS_K=0, LDS_V=NSLOT*SLOTB, LDS_WS=2*NSLOT*SLOTB, LDS_OST=LDS_WS+NW*64*4, LDS_BYTES=LDS_OST+NW*4096;
constexpr float C2=0.125f*1.4426950408889634f;
__device__ __forceinline__ void glds16(const void*gsrc,unsigned lds_dst){unsigned keep;
  asm volatile("s_mov_b32 %0, m0\n\ts_mov_b32 m0, %2\n\ts_nop 0\n\tglobal_load_lds_dwordx4 %1, off\n\ts_mov_b32 m0, %0":"=&s"(keep):"v"(gsrc),"s"(lds_dst):"memory");}
__device__ __forceinline__ float max3f(float a,float b,float c){float r;asm("v_max3_f32 %0, %1, %2, %3":"=v"(r):"v"(a),"v"(b),"v"(c));return r;}
__device__ __forceinline__ float max2f(float a,float b){float r;asm("v_max_f32_e32 %0, %1, %2":"=v"(r):"v"(a),"v"(b));return r;}
__device__ __forceinline__ float fadd_s(float a,float b){float r;asm("v_add_f32_e32 %0, %1, %2":"=v"(r):"v"(a),"v"(b));return r;}
__device__ __forceinline__ float fsub_s(float a,float b){float r;asm("v_sub_f32_e32 %0, %1, %2":"=v"(r):"v"(a),"v"(b));return r;}
typedef float f32x2_t __attribute__((ext_vector_type(2))); typedef float f32x4_t __attribute__((ext_vector_type(4))); typedef __bf16 bf16x2_t __attribute__((ext_vector_type(2)));
__device__ __forceinline__ unsigned cvtpk_s(float lo,float hi){f32x2_t v={lo,hi};bf16x2_t b=__builtin_convertvector(v,bf16x2_t);return __builtin_bit_cast(unsigned,b);}
#define WAIT_BAR(N) asm volatile("s_waitcnt vmcnt(" #N ") lgkmcnt(0)\n\ts_barrier":::"memory")

__device__ __forceinline__ void qkt(f32x16&p0,f32x16&p1,const char*Kslot,const bf16x8*qr,const f32x16&negm,int r32,int hi){
  const char*kb=Kslot+hi*1024+r32*16;
  #pragma unroll
  for(int d0=0;d0<4;++d0){
    const bf16x8 b0=*reinterpret_cast<const bf16x8*>(kb+d0*2048);
    const bf16x8 b1=*reinterpret_cast<const bf16x8*>(kb+d0*2048+512);
    if(d0==0){p0=__builtin_amdgcn_mfma_f32_32x32x16_bf16(b0,qr[0],negm,0,0,0);p1=__builtin_amdgcn_mfma_f32_32x32x16_bf16(b1,qr[0],negm,0,0,0);}
    else{p0=__builtin_amdgcn_mfma_f32_32x32x16_bf16(b0,qr[d0],p0,0,0,0);p1=__builtin_amdgcn_mfma_f32_32x32x16_bf16(b1,qr[d0],p1,0,0,0);}}
}
typedef __attribute__((address_space(3))) const char* lds_cptr;
typedef short v4i16_t __attribute__((ext_vector_type(4)));
__device__ __forceinline__ void kload8(bf16x8*kf,lds_cptr kp){
  kf[0]=*(const __attribute__((address_space(3))) bf16x8*)(kp);      kf[1]=*(const __attribute__((address_space(3))) bf16x8*)(kp+512);
  kf[2]=*(const __attribute__((address_space(3))) bf16x8*)(kp+2048); kf[3]=*(const __attribute__((address_space(3))) bf16x8*)(kp+2560);
  kf[4]=*(const __attribute__((address_space(3))) bf16x8*)(kp+4096); kf[5]=*(const __attribute__((address_space(3))) bf16x8*)(kp+4608);
  kf[6]=*(const __attribute__((address_space(3))) bf16x8*)(kp+6144); kf[7]=*(const __attribute__((address_space(3))) bf16x8*)(kp+6656);
}
__device__ __forceinline__ void kload2(bf16x8*kf,lds_cptr kp,int j){ kf[2*j]=*(const __attribute__((address_space(3))) bf16x8*)(kp+j*2048); kf[2*j+1]=*(const __attribute__((address_space(3))) bf16x8*)(kp+j*2048+512); }
__device__ __forceinline__ s16x4 vtr(lds_cptr p){ return __builtin_bit_cast(s16x4,__builtin_amdgcn_ds_read_tr16_b64_v4i16((__attribute__((address_space(3))) v4i16_t*)p)); }
__device__ __forceinline__ float rowmax(const f32x16&p0,const f32x16&p1){
  float a=max3f(p0[0],p0[1],p1[0]),b=max3f(p0[2],p0[3],p1[1]);a=max3f(a,p1[2],p1[3]);
  #pragma unroll
  for(int r=4;r<16;r+=4){a=max3f(a,p0[r],p0[r+1]);b=max3f(b,p0[r+2],p0[r+3]);a=max3f(a,p1[r],p1[r+1]);b=max3f(b,p1[r+2],p1[r+3]);}
  const float m=max2f(a,b);
  auto rr=__builtin_amdgcn_permlane32_swap(__float_as_uint(m),__float_as_uint(m),false,false);
  return max2f(__uint_as_float(rr[0]),__uint_as_float(rr[1]));
}
__device__ __forceinline__ void pv(f32x16*o,int vb,bf16x8 pa0,bf16x8 pa1,bf16x8 pa2,bf16x8 pa3){
  #pragma unroll
  for(int d0=0;d0<2;++d0){s16x4 lo[4],hi[4];
    #pragma unroll
    for(int ks=0;ks<4;++ks){
      asm volatile("ds_read_b64_tr_b16 %0,%1 offset:%c2":"=&v"(lo[ks]):"v"(vb),"i"(d0*4096+ks*1024):"memory");
      asm volatile("ds_read_b64_tr_b16 %0,%1 offset:%c2":"=&v"(hi[ks]):"v"(vb),"i"(d0*4096+ks*1024+512):"memory");}
    asm volatile("s_waitcnt lgkmcnt(0)":::"memory");SBAR();
    #define PK(k) (bf16x8){lo[k][0],lo[k][1],lo[k][2],lo[k][3],hi[k][0],hi[k][1],hi[k][2],hi[k][3]}
    o[d0]=__builtin_amdgcn_mfma_f32_32x32x16_bf16(pa0,PK(0),o[d0],0,0,0);
    o[d0]=__builtin_amdgcn_mfma_f32_32x32x16_bf16(pa1,PK(1),o[d0],0,0,0);
    o[d0]=__builtin_amdgcn_mfma_f32_32x32x16_bf16(pa2,PK(2),o[d0],0,0,0);
    o[d0]=__builtin_amdgcn_mfma_f32_32x32x16_bf16(pa3,PK(3),o[d0],0,0,0);
    #undef PK
  }
}

#ifndef ATTN_STORE16
#define ATTN_STORE16(p,v) (*(u32x4*)(p)=(v))
#endif
template<int THRL> __device__ __forceinline__ void attn_unit(int b,int h,int qb,const bf16*Q,const bf16*__restrict__ K,const bf16*__restrict__ V,bf16*O,const float*__restrict__ gain,char*shm){
  const int tid=threadIdx.x,lane=tid&63,r32=lane&31,hi=lane>>5; const int wid=__builtin_amdgcn_readfirstlane(tid>>6);
  const long rowbase=(long)b*SEQ; const int q0=qb*QB;
  const bf16*Qw=Q+(rowbase+q0+wid*QBLK)*QP+h*D;
  const bf16*Kh=K+(long)(b*2+(h>>2))*KVROWS*KVP,*Vh=V+(long)(b*2+(h>>2))*KVROWS*KVP;
  const unsigned lds0=(unsigned)(uintptr_t)shm;
  float*wsf=(float*)(shm+LDS_WS)+wid*64;
  const bf16*ksrc=Kh+(long)lane*KVP+wid*8;
  const bf16*vsrc=Vh+(long)(16*(wid&3)+(lane>>2))*KVP+(wid>>2)*32+(lane&3)*8;
  const unsigned kdst=lds0+LDS_K+wid*1024, vdst=lds0+LDS_V+wid*1024;
  #define DMA_K(t,slot) glds16(ksrc+(long)(t)*KVBLK*KVP,(unsigned)__builtin_amdgcn_readfirstlane(kdst+(slot)))
  #define DMA_V(t,slot) glds16(vsrc+(long)(t)*KVBLK*KVP,(unsigned)__builtin_amdgcn_readfirstlane(vdst+(slot)))
  const int vb0=(int)(lds0+LDS_V)+((lane>>4)&1)*32+(lane&3)*8+(4*hi+((lane&15)>>2))*64;
  const char*Kbase=shm+LDS_K; bf16x8 kf[8];
  const lds_cptr shm3=(lds_cptr)shm; const lds_cptr kp0=shm3+LDS_K+hi*1024+r32*16; const lds_cptr vp0=shm3+LDS_V+((lane>>4)&1)*32+(lane&3)*8+(4*hi+((lane&15)>>2))*64;
  DMA_K(0,0);DMA_V(0,0);DMA_K(1,SLOTB);
  bf16x8 qr[4];
  #pragma unroll
  for(int d0=0;d0<4;++d0)qr[d0]=*reinterpret_cast<const bf16x8*>(&Qw[(long)r32*QP+d0*16+hi*8]);
  float mhat=0.f,l_reg=0.f;f32x16 o[2];o[0]=f32x16{};o[1]=f32x16{};f32x16 negm=f32x16{};asm volatile("":"+v"(negm));
  #define CMASK(P0,P1,t) do{}while(0)
  bool resc=false;
  #define START(P0,P1) do{ const float rm=rowmax(P0,P1); resc=false; \
    { const float dl=rm; mhat=fadd_s(mhat,dl); \
      _Pragma("unroll") for(int r=0;r<16;++r){P0[r]=fsub_s(P0[r],dl);P1[r]=fsub_s(P1[r],dl);} \
      _Pragma("unroll") for(int r=0;r<16;++r)negm[r]=-mhat; asm volatile("":"+v"(negm)); } \
    _Pragma("unroll") for(int r=0;r<16;++r)P0[r]=__builtin_amdgcn_exp2f(P0[r]); }while(0)
  #define RESC() do{ if(resc){ asm volatile("s_waitcnt lgkmcnt(0)":::"memory"); \
      _Pragma("unroll") for(int d_=0;d_<2;++d_) _Pragma("unroll") for(int r=0;r<16;++r)o[d_][r]*=wsf[crow(r,hi)]; } }while(0)
  f32x16 pA0,pA1,pB0,pB1;
  int sl_prev=0,sl_cur=0,sl_next=SLOTB;
  #define ROT() do{sl_prev=sl_cur;sl_cur=sl_next;sl_next=(sl_next==(NSLOT-1)*SLOTB)?0:sl_next+SLOTB;}while(0)
  DMA_K(2,2*SLOTB);
  WAIT_BAR(3);
  qkt(pA0,pA1,Kbase,qr,negm,r32,hi);asm volatile("s_nop 15\n\ts_nop 7":"+v"(pA0),"+v"(pA1));CMASK(pA0,pA1,0);
  START(pA0,pA1);
  _Pragma("unroll") for(int r=0;r<16;++r)pA1[r]=__builtin_amdgcn_exp2f(pA1[r]);
  WAIT_BAR(0);
  DMA_K(3,0);DMA_V(1,SLOTB);
  ROT();
  kload8(kf,kp0+sl_cur);
  WAIT_BAR(2);
  s16x4 vlo[8],vhi[8]; u32x4 pw0,pw1,pw2,pw3;
  #define PKW(P,B) cvtpk_s(P[B],P[B+1])
  #define PAF(k) __builtin_bit_cast(bf16x8,pw##k)
  #define VFR(i) (bf16x8){vlo[i][0],vlo[i][1],vlo[i][2],vlo[i][3],vhi[i][0],vhi[i][1],vhi[i][2],vhi[i][3]}
  #define PIN(x) asm volatile("":"+v"(x))
  #define MX3(a,b,c) __builtin_fmaxf(__builtin_fmaxf((a),(b)),(c))
  #define GAPA(MF,A0,A1,A2,A3,W0,W1,PW) do{ MF; sacc+=A0; sacc+=A1; sacc+=A2; sacc+=A3; PIN(sacc); W0; W1; PIN(PW); SBAR(); }while(0)
  #define EX(v) __builtin_amdgcn_exp2f(v)
  #define GAPB(MF,X,B) do{ MF; X[B]=EX(X[B]); X[B+1]=EX(X[B+1]); X[B+2]=EX(X[B+2]); X[B+3]=EX(X[B+3]); PIN(X); SBAR(); }while(0)
  #define VRD(i) do{ vlo[i]=vtr(vp_+(((i)>>2)*4096+((i)&3)*1024)); vhi[i]=vtr(vp_+(((i)>>2)*4096+((i)&3)*1024+512)); }while(0)
  #define KRD(G,j) do{ if(G){ kload2(kf,kp0+sl_next,j); SBAR(); } }while(0)
  #define STEP(C0,C1,P0,P1,t,GK,GV,GL) do{ SBAR(); \
    const lds_cptr vp_=vp0+sl_prev; \
    VRD(0); SBAR(); float sacc=(P0[0]+P0[1]); \
    GAPA(C0=__builtin_amdgcn_mfma_f32_32x32x16_bf16(kf[0],qr[0],negm,0,0,0), P0[2],P0[3],P0[4],P0[5],     pw0[0]=PKW(P0,0), pw0[1]=PKW(P0,2), pw0); \
    VRD(4); SBAR(); GAPA(C1=__builtin_amdgcn_mfma_f32_32x32x16_bf16(kf[1],qr[0],negm,0,0,0), P0[6],P0[7],P0[8],P0[9],     pw0[2]=PKW(P0,4), pw0[3]=PKW(P0,6), pw0); \
    VRD(1); SBAR(); GAPA(C0=__builtin_amdgcn_mfma_f32_32x32x16_bf16(kf[2],qr[1],C0,0,0,0),   P0[10],P0[11],P0[12],P0[13], pw1[0]=PKW(P0,8), pw1[1]=PKW(P0,10), pw1); \
    VRD(5); SBAR(); GAPA(C1=__builtin_amdgcn_mfma_f32_32x32x16_bf16(kf[3],qr[1],C1,0,0,0),   P0[14],P0[15],P1[0],P1[1],   pw1[2]=PKW(P0,12),pw1[3]=PKW(P0,14), pw1); \
    VRD(2); SBAR(); GAPA(C0=__builtin_amdgcn_mfma_f32_32x32x16_bf16(kf[4],qr[2],C0,0,0,0),   P1[2],P1[3],P1[4],P1[5],     pw2[0]=PKW(P1,0), pw2[1]=PKW(P1,2), pw2); \
    VRD(6); SBAR(); GAPA(C1=__builtin_amdgcn_mfma_f32_32x32x16_bf16(kf[5],qr[2],C1,0,0,0),   P1[6],P1[7],P1[8],P1[9],     pw2[2]=PKW(P1,4), pw2[3]=PKW(P1,6), pw2); \
    VRD(3); SBAR(); GAPA(C0=__builtin_amdgcn_mfma_f32_32x32x16_bf16(kf[6],qr[3],C0,0,0,0),   P1[10],P1[11],P1[12],P1[13], pw3[0]=PKW(P1,8), pw3[1]=PKW(P1,10), pw3); \
    VRD(7); SBAR(); GAPA(C1=__builtin_amdgcn_mfma_f32_32x32x16_bf16(kf[7],qr[3],C1,0,0,0),   P1[14],P1[15],0.f,0.f,       pw3[2]=PKW(P1,12),pw3[3]=PKW(P1,14), pw3); \
    l_reg+=sacc; \
    if(GK){DMA_K((t)+3,sl_cur);} if(GV){DMA_V((t)+1,sl_next);} \
    CMASK(C0,C1,t); \
    { float a=MX3(C0[0],C0[1],C1[0]),b=MX3(C0[2],C0[3],C1[1]); a=MX3(a,C1[2],C1[3]); \
      _Pragma("unroll") for(int r=4;r<16;r+=4){a=MX3(a,C0[r],C0[r+1]);b=MX3(b,C0[r+2],C0[r+3]);a=MX3(a,C1[r],C1[r+1]);b=MX3(b,C1[r+2],C1[r+3]);} \
      float rm=__builtin_fmaxf(a,b); { auto rr=__builtin_amdgcn_permlane32_swap(__float_as_uint(rm),__float_as_uint(rm),false,false); rm=__builtin_fmaxf(__uint_as_float(rr[0]),__uint_as_float(rr[1])); } \
      resc=false; \
      if(__builtin_expect(__any(rm>(float)THRL),0)){ const float dl=__builtin_fmaxf(rm,0.f); mhat+=dl; \
        _Pragma("unroll") for(int r=0;r<16;++r){C0[r]-=dl;C1[r]-=dl;} \
        _Pragma("unroll") for(int r=0;r<16;++r)negm[r]=-mhat; asm volatile("":"+v"(negm)); \
        const float f=__builtin_amdgcn_exp2f(-dl); l_reg*=f; if(hi==0)wsf[r32]=f; resc=true; } } \
    SBAR(); \
    GAPB(o[0]=__builtin_amdgcn_mfma_f32_32x32x16_bf16(PAF(0),VFR(0),o[0],0,0,0), C0,0); \
    GAPB(o[1]=__builtin_amdgcn_mfma_f32_32x32x16_bf16(PAF(0),VFR(4),o[1],0,0,0), C0,4); \
    KRD(GL,0); GAPB(o[0]=__builtin_amdgcn_mfma_f32_32x32x16_bf16(PAF(1),VFR(1),o[0],0,0,0), C0,8); \
    KRD(GL,1); GAPB(o[1]=__builtin_amdgcn_mfma_f32_32x32x16_bf16(PAF(1),VFR(5),o[1],0,0,0), C0,12); \
    KRD(GL,2); GAPB(o[0]=__builtin_amdgcn_mfma_f32_32x32x16_bf16(PAF(2),VFR(2),o[0],0,0,0), C1,0); \
    KRD(GL,3); GAPB(o[1]=__builtin_amdgcn_mfma_f32_32x32x16_bf16(PAF(2),VFR(6),o[1],0,0,0), C1,4); \
    GAPB(o[0]=__builtin_amdgcn_mfma_f32_32x32x16_bf16(PAF(3),VFR(3),o[0],0,0,0), C1,8); \
    GAPB(o[1]=__builtin_amdgcn_mfma_f32_32x32x16_bf16(PAF(3),VFR(7),o[1],0,0,0), C1,12); \
    }while(0)
  int t=1;
  #undef CMASK
  #define CMASK(P0,P1,t) do{}while(0)
  for(;t+5<NT;t+=2){
    STEP(pB0,pB1,pA0,pA1,t,true,true,true);     WAIT_BAR(2); RESC(); ROT();
    STEP(pA0,pA1,pB0,pB1,t+1,true,true,true);   WAIT_BAR(2); RESC(); ROT();
  }
  #undef CMASK
  #define CMASK(P0,P1,t) do{ if((t)==NT-1)tmask(P0,P1); }while(0)
  #define ENDW(tt) do{ if((tt)+3<NT){WAIT_BAR(2);} else if((tt)+2<NT){WAIT_BAR(1);} else {WAIT_BAR(0);} }while(0)
  for(;t+1<NT;t+=2){
    STEP(pB0,pB1,pA0,pA1,t,(t+3<NT),(t+1<NT),(t+1<NT));       ENDW(t);   RESC(); ROT();
    STEP(pA0,pA1,pB0,pB1,t+1,(t+4<NT),(t+2<NT),(t+2<NT));     ENDW(t+1); RESC(); ROT();
  }
  static_assert((NT&1)==1&&NT>=7,"odd tile count: the pair loops end on tile NT-1 (scores in buffer A)");
  { float sacc=pA0[0]+pA0[1]; _Pragma("unroll") for(int r=2;r<16;++r)sacc+=pA0[r]; _Pragma("unroll") for(int r=0;r<16;++r)sacc+=pA1[r]; l_reg+=sacc;
    pw0=(u32x4){PKW(pA0,0),PKW(pA0,2),PKW(pA0,4),PKW(pA0,6)};pw1=(u32x4){PKW(pA0,8),PKW(pA0,10),PKW(pA0,12),PKW(pA0,14)};pw2=(u32x4){PKW(pA1,0),PKW(pA1,2),PKW(pA1,4),PKW(pA1,6)};pw3=(u32x4){PKW(pA1,8),PKW(pA1,10),PKW(pA1,12),PKW(pA1,14)};
    SBAR(); pv(o,vb0+sl_prev,PAF(0),PAF(1),PAF(2),PAF(3)); }
  #undef PKW
  #undef PAF
  #undef VFR
  #undef PIN
  #undef MX3
  #undef GAPA
  #undef GAPB
  #undef EX
  #undef VRD
  #undef KRD
  #undef STEP
  #undef ENDW
  {auto rr=__builtin_amdgcn_permlane32_swap(__float_as_uint(l_reg),__float_as_uint(l_reg),false,false);l_reg=__uint_as_float(rr[0])+__uint_as_float(rr[1]);}
  if(hi==0)wsf[32+r32]=l_reg;asm volatile("s_waitcnt lgkmcnt(0)":::"memory");
  float rli[16];
  #pragma unroll
  for(int r=0;r<16;++r)rli[r]=__builtin_amdgcn_rcpf(wsf[32+crow(r,hi)]);
  bf16*Ow=O+(rowbase+q0+wid*QBLK)*OP+h*D;
  { bf16*stg=(bf16*)(shm+LDS_OST)+wid*2048;
    #pragma unroll
    for(int r=0;r<16;++r){const int orow=crow(r,hi);
      #pragma unroll
      for(int d0=0;d0<2;++d0)stg[orow*64+d0*32+r32]=__float2bfloat16(o[d0][r]*rli[r]);}
    asm volatile("s_waitcnt lgkmcnt(0)":::"memory");
    #pragma unroll
    for(int i=0;i<4;++i){const int row=i*8+(lane>>3),ch=lane&7; const u32x4 v=*(const u32x4*)(stg+row*64+ch*8);
      float f[8]; f[0]=__uint_as_float(v.x<<16);f[1]=__uint_as_float(v.x&0xffff0000u);f[2]=__uint_as_float(v.y<<16);f[3]=__uint_as_float(v.y&0xffff0000u);
      f[4]=__uint_as_float(v.z<<16);f[5]=__uint_as_float(v.z&0xffff0000u);f[6]=__uint_as_float(v.w<<16);f[7]=__uint_as_float(v.w&0xffff0000u);
      float ss=0.f; _Pragma("unroll") for(int j=0;j<8;++j)ss+=f[j]*f[j];
      ss+=__shfl_xor(ss,1);ss+=__shfl_xor(ss,2);ss+=__shfl_xor(ss,4);
      const float rs=1.0f/sqrtf(ss*(1.0f/64.0f)+1e-6f); const f32x4_t g0=*(const f32x4_t*)(gain+h*D+ch*8),g1=*(const f32x4_t*)(gain+h*D+ch*8+4);
      u32x4 w; w[0]=cvtpk_s(f[0]*rs*g0[0],f[1]*rs*g0[1]);w[1]=cvtpk_s(f[2]*rs*g0[2],f[3]*rs*g0[3]);w[2]=cvtpk_s(f[4]*rs*g1[0],f[5]*rs*g1[1]);w[3]=cvtpk_s(f[6]*rs*g1[2],f[7]*rs*g1[3]);
      ATTN_STORE16(Ow+(long)row*OP+ch*8,w);} }
  asm volatile("s_waitcnt lgkmcnt(0)\n\ts_barrier":::"memory");
  #undef DMA_K
  #undef DMA_V
  #undef CMASK
  #undef START
  #undef RESC
  #undef ROT
}
constexpr int ATTN_LDS_BYTES=LDS_BYTES;
struct AttnTensors { const bf16* Q; const bf16* K; const bf16* V; bf16* O; const float* gain; };
struct AttnUnit { int b; int h; int qb; };
struct StaticOrder {
  int vcu;
  __device__ __forceinline__ explicit StaticOrder(int grid_,int block):vcu((grid_%8==0)?(block%8)*(grid_/8)+block/8:block),grid(grid_){}
  int grid;
  __device__ __forceinline__ bool next(int i,AttnUnit&u)const{ const int n=i*grid+vcu,pair=n>>5; if(pair>=48)return false; const int s=n&31; u.b=pair>>1; u.h=4*(pair&1)+(s>>3); u.qb=s&7; return true; }
};
template<class Sched,class Side,int THRL=8> __device__ __forceinline__ void attn_phase(char*lds,const AttnTensors&T,const Sched&S,int kside,const Side&side){
  AttnUnit u; int i=0;
  for(;i<kside&&S.next(i,u);++i){ attn_unit<THRL>(u.b,u.h,u.qb,T.Q,T.K,T.V,T.O,T.gain,lds); }
  side();
  for(;S.next(i,u);++i){ attn_unit<THRL>(u.b,u.h,u.qb,T.Q,T.K,T.V,T.O,T.gain,lds); }
}
#undef SBAR
#undef WAIT_BAR
}

typedef __attribute__((address_space(1))) unsigned gu32;
#define XB_TMO      128
#define XB_XCNT(j)  (256  + 64 * (j))
#define XB_XSUB(j)  (1280 + 64 * (j))
#define XB_XGEN(j)  (2304 + 64 * (j))
#define XB_TOP      3328
#define XB_TOPGEN   3392
#define XCD_BAR_WORDS 3456
#define XB_SPIN_CAP (1u << 18)

__device__ __forceinline__ unsigned xb_ld(unsigned* p)              { return __hip_atomic_load(p, __ATOMIC_RELAXED, __HIP_MEMORY_SCOPE_AGENT); }
__device__ __forceinline__ unsigned xb_add(unsigned* p, unsigned v) { return __hip_atomic_fetch_add(p, v, __ATOMIC_RELAXED, __HIP_MEMORY_SCOPE_AGENT); }
__device__ __forceinline__ unsigned xb_xcc_id() { return (unsigned)__builtin_amdgcn_s_getreg((3 << 11) | 20) & 0xFu; }
#define XB_SPIN(cond, bar) do { unsigned _sp = 0; while (cond) { __builtin_amdgcn_s_sleep(1); \
    if ((++_sp & 255u) == 0u) { if (xb_ld(&(bar)[XB_TMO])) break; if (_sp > XB_SPIN_CAP) { atomicAdd(&(bar)[XB_TMO], 1u); break; } } } } while (0)

struct XcdBarrier {
    unsigned* bar; unsigned x;
    volatile LAS unsigned* st;
};

__device__ __forceinline__ XcdBarrier xcd_barrier_post(unsigned* bar, volatile LAS unsigned* st) {
    XcdBarrier b; b.bar = bar; b.x = xb_xcc_id(); b.st = st;
    if (threadIdx.x == 0) (void)xb_add(&bar[XB_XCNT(b.x)], 1u);
    return b;
}
__device__ __forceinline__ void xcd_barrier_complete(unsigned* bar, unsigned x, unsigned& nloc, unsigned& nx) {
    const unsigned G = gridDim.x * gridDim.y * gridDim.z;
    unsigned sum, cnt, mine, sp = 0u;
    for (;;) {
        sum = 0u; cnt = 0u; mine = 0u;
#pragma unroll
        for (unsigned j = 0; j < 16; ++j) { const unsigned c = xb_ld(&bar[XB_XCNT(j)]); sum += c; cnt += (c > 0u) ? 1u : 0u; mine = (j == x) ? c : mine; }
        if (sum == G) break;
        __builtin_amdgcn_s_sleep(1);
        if ((++sp & 255u) == 0u) { if (xb_ld(&bar[XB_TMO])) break; if (sp > XB_SPIN_CAP) { atomicAdd(&bar[XB_TMO], 1u); break; } }
    }
    nloc = mine > 0u ? mine : 1u; nx = cnt > 0u ? cnt : 1u;
}

__device__ __forceinline__ void xcd_barrier(const XcdBarrier& b) {
    asm volatile("s_waitcnt vmcnt(0)" ::: "memory");
    __syncthreads();
    if (threadIdx.x == 0) {
        unsigned* bar = b.bar;
        __builtin_amdgcn_s_waitcnt(0);
        unsigned nloc = b.st[0], nx = b.st[1];
        if (nloc == 0u) { xcd_barrier_complete(bar, b.x, nloc, nx); b.st[0] = nloc; b.st[1] = nx; }
        const unsigned old = xb_add(&bar[XB_XSUB(b.x)], 1u);
        const unsigned gen = old / nloc;
        if (old + 1u == (gen + 1u) * nloc) {
            __builtin_amdgcn_fence(__ATOMIC_RELEASE, "agent");
            asm volatile("s_waitcnt vmcnt(0)" ::: "memory");
            const unsigned og = xb_add(&bar[XB_TOP], 1u);
            const unsigned tg = og / nx;
            if (og + 1u == (tg + 1u) * nx) xb_add(&bar[XB_TOPGEN], 1u);
            else XB_SPIN(xb_ld(&bar[XB_TOPGEN]) == tg, bar);
            __builtin_amdgcn_fence(__ATOMIC_ACQUIRE, "agent");
            xb_add(&bar[XB_XGEN(b.x)], 1u);
            asm volatile("s_waitcnt vmcnt(0)" ::: "memory");
        } else {
            XB_SPIN(xb_ld(&bar[XB_XGEN(b.x)]) == gen, bar);
            __builtin_amdgcn_fence(__ATOMIC_ACQUIRE, "agent");
            asm volatile("s_waitcnt vmcnt(0)" ::: "memory");
        }
    }
    __syncthreads();
}


__global__ void __launch_bounds__(NTHR, 2) enc_fwd(Args a) {
    extern __shared__ __attribute__((aligned(16))) unsigned char lds[];
    cg::grid_group grid = cg::this_grid();
    const int tid = threadIdx.x, lane = tid & 63, wave = __builtin_amdgcn_readfirstlane(tid >> 6);
    const int G = gridDim.x, gw = blockIdx.x * NWAVES + wave, NGW = G * NWAVES;
    const int lo = a.ph_lo, hi = a.ph_hi;
    volatile LAS unsigned* MISC = (volatile LAS unsigned*)((LAS unsigned char*)lds + LDS_BYTES - 64);
    if (tid < 16) MISC[tid] = 0u;
    __syncthreads();
    (void)xcd_barrier_post((unsigned*)(a.ws + WS_CTL) + 4096, MISC);
#define IN(k) (lo <= (k) && (k) < hi)
#ifndef PROBE_X2
#define PROBE_X2 -1
#endif
#define REP(k) for (int rep_ = 0; rep_ < ((k) == PROBE_X2 ? 2 : 1); ++rep_)
#define SEAM(k) do { if (IN(k) && IN((k) + 1)) { if (lo > 1000) grid.sync();   { XcdBarrier bar_; bar_.bar = (unsigned*)(a.ws + WS_CTL) + 4096; bar_.x = xb_xcc_id(); bar_.st = MISC; xcd_barrier(bar_); } } } while (0)
    if (IN(0)) REP(0) { p0_prologue(a, lds, tid, lane, wave); } SEAM(0);
    if (IN(1)) REP(1) { pg8::Gemm g{(const bf16_t*)(a.ws + WS_XA), (const bf16_t*)(a.ws + WS_WIN), NTOK, INW, DM}; pg8::StaticOrder S; S.init(NTOK, INW, G, (int)blockIdx.x);
        pg8::EpiInProj E{(bf16_t*)(a.ws + WS_Z), (bf16_t*)(a.ws + WS_Q), (bf16_t*)(a.ws + WS_KB), (bf16_t*)(a.ws + WS_VB), (const float*)(a.ws + WS_ROPE), a.qg, a.kg};
        kv_meta_rows(a, lane, gw, NGW);
        pg8::gemm_phase<pg8::EpiInProj, pg8::StaticOrder, true, true>((LAS unsigned char*)lds, g, S, E); } SEAM(1);
    if (IN(3)) REP(3) { const attn_body::AttnTensors AT{(const attn_body::bf16*)(a.ws + WS_Q), (const attn_body::bf16*)(a.ws + WS_KB), (const attn_body::bf16*)(a.ws + WS_VB), (attn_body::bf16*)(a.ws + WS_XA) + 512, a.attn_g};
        const attn_body::StaticOrder S(G, (int)blockIdx.x);
        auto side = [&]() { p2_pass(a, lane, gw, NGW);
            table_fp4<false>(a.pu, a.ws + WS_UT, (float*)(a.ws + WS_USC), a.g_ffn, gw, NGW, lane);
            table_fp4<true>(a.pv, a.ws + WS_UT + 4 * SLICE4, (float*)(a.ws + WS_VSC), nullptr, gw, NGW, lane); __syncthreads(); };
        attn_body::attn_phase<attn_body::StaticOrder>((char*)lds, AT, S, (int)((blockIdx.x >> 3) * 6) >> 5, side); } SEAM(3);
    if (IN(4)) REP(4) { pg8::Gemm g{(const bf16_t*)(a.ws + WS_XA), (const bf16_t*)(a.ws + WS_WOUT), NTOK, DM, DM}; pg8::StaticOrder S; S.init(NTOK, DM, G, (int)blockIdx.x);
        pg8::EpiResidNorm E{a.xp, a.xs, a.out, NBP * SEQ, (bf16_t*)(a.ws + WS_HB), a.ws + WS_X8, (float*)(a.ws + WS_SS), X8SCALE};
        pg8::gemm_phase<pg8::EpiResidNorm, pg8::StaticOrder, true, true>((LAS unsigned char*)lds, g, S, E); } SEAM(4);
    if (IN(6)) REP(6) { pg8::Gemm g{(const bf16_t*)(a.ws + WS_HB), (const bf16_t*)(a.ws + WS_WQ), NTOK, PQ, DM}; pg8::StaticOrder S; S.init(NTOK, PQ, G, (int)blockIdx.x);
        pg8::EpiBf16 E{(bf16_t*)(a.ws + WS_QP), PQ};
        pg8::gemm_phase<pg8::EpiBf16, pg8::StaticOrder, true, true>((LAS unsigned char*)lds, g, S, E); } SEAM(6);
    if (IN(7)) REP(7) { p7_topk(a, lds, tid, lane, wave); __syncthreads(); } SEAM(7);
    if (IN(8)) REP(8) { p8a_u(a, lane, wave); } SEAM(8);
    if (IN(9)) REP(9) { p8c_combine(a, lds, tid); __syncthreads(); } SEAM(9);
    if (IN(10)) REP(10) { p8b_v(a, lds, lane, wave, rep_ == ((10 == PROBE_X2) ? 1 : 0)); }
#undef IN
#undef SEAM
}

extern "C" void kernel_launch(void* const* d_in, const int* in_sizes, int n_in, void* d_out, int out_size, void* d_ws, size_t ws_size, hipStream_t stream) {
    static int grid = 0;
    if (grid == 0) {
        if (n_in != 16 || out_size != NTOK * DM || ws_size < WS_END) { fprintf(stderr, "kernel_launch: unexpected shapes (n_in %d out %d ws %zu)\n", n_in, out_size, ws_size); grid = -1; return; }
        int dev = 0, cus = 0, per_cu = 0;
        (void)hipGetDevice(&dev); (void)hipDeviceGetAttribute(&cus, hipDeviceAttributeMultiprocessorCount, dev);
        (void)hipFuncSetAttribute((const void*)enc_fwd, hipFuncAttributeMaxDynamicSharedMemorySize, LDS_BYTES);
        (void)hipOccupancyMaxActiveBlocksPerMultiprocessor(&per_cu, (const void*)enc_fwd, NTHR, LDS_BYTES);
        if (per_cu < 1) { fprintf(stderr, "kernel_launch: occupancy query says %d blocks/CU\n", per_cu); per_cu = 1; }
        (void)hipGetLastError();
        grid = cus * 1;
    }
    if (grid < 0) return;
    (void)hipMemsetAsync((char*)d_ws + WS_CTL, 0, 64 * 1024, stream);
    Args a{};
    a.xp = (const float*)d_in[0]; a.xs = (const float*)d_in[1]; a.meta = (const float*)d_in[2]; a.g_mix = (const float*)d_in[3]; a.w_in = (const float*)d_in[4];
    a.conv_w = (const float*)d_in[5]; a.qg = (const float*)d_in[6]; a.kg = (const float*)d_in[7]; a.conv_g = (const float*)d_in[8]; a.attn_g = (const float*)d_in[9];
    a.w_out = (const float*)d_in[10]; a.g_ffn = (const float*)d_in[11]; a.wq = (const float*)d_in[12]; a.subk = (const float*)d_in[13]; a.pu = (const float*)d_in[14]; a.pv = (const float*)d_in[15];
    a.out = (float*)d_out; a.ws = (unsigned char*)d_ws;
    constexpr int NL = MK_N_LAUNCHES;
    for (int li = 0; li < NL; ++li) {
        a.ph_lo = (NL == 1) ? 0 : li; a.ph_hi = (NL == 1) ? NPHASE : li + 1;
        void* args[] = {&a};
        hipError_t e = hipLaunchCooperativeKernel((const void*)enc_fwd, dim3(grid), dim3(NTHR), args, LDS_BYTES, stream);
        if (e != hipSuccess) { fprintf(stderr, "kernel_launch: launch %d failed: %s\n", li, hipGetErrorString(e)); break; }
    }
}
```

```cpp
#include <hip/hip_runtime.h>
#include <hip/hip_cooperative_groups.h>
#include <cstdint>
#include <cstdio>
namespace cg = cooperative_groups;

#ifndef MK_N_LAUNCHES
#define MK_N_LAUNCHES 1
#endif

typedef unsigned short bf16_t;
typedef short bf16x8 __attribute__((ext_vector_type(8)));
typedef float f32x4 __attribute__((ext_vector_type(4)));
typedef unsigned u32x4 __attribute__((ext_vector_type(4)));
typedef unsigned u32x2 __attribute__((ext_vector_type(2)));
#define LAS __attribute__((address_space(3)))

constexpr int NB = 24, NBP = 16, SEQ = 2048, DM = 1024, NTOK = NB * SEQ;
constexpr int NMETA = 16, INW = 2304, KROWS = 2112;
constexpr int NKEYS = SEQ + NMETA;
constexpr int PQ = 2048;
constexpr float EPS = 1e-6f;
constexpr float C2 = 0.125f * 1.4426950408889634f;
constexpr int NWAVES = 8, NTHR = 512;
constexpr int LDS_BYTES = 163840;
constexpr int NPHASE = 11;

constexpr size_t MiB = 1u << 20;
constexpr size_t WS_CTL = 0;
constexpr size_t WS_WIN = 1 * MiB;
constexpr size_t WS_WOUT = 6 * MiB;
constexpr size_t WS_WQ = 8 * MiB;
constexpr size_t WS_SUBK = 12 * MiB;
constexpr size_t WS_ZMETA = 12 * MiB + 512 * 1024;
constexpr size_t WS_ROPE = WS_ZMETA + 256 * 1024;
constexpr size_t WS_UT = 13 * MiB;
constexpr size_t WS_USC = 29 * MiB, WS_VSC = WS_USC + 64 * 1024;
constexpr size_t WS_SS = WS_USC + 256 * 1024;
constexpr size_t SLICE4 = (size_t)16384 * 128;
constexpr size_t WS_XA = 32 * MiB;
constexpr size_t WS_EI = WS_XA, WS_GT = WS_XA + 12 * MiB;
constexpr size_t WS_Z = 128 * MiB;
constexpr size_t WS_HB = WS_Z;
constexpr size_t WS_QP = WS_Z + 96 * MiB;
constexpr size_t WS_PB = WS_QP;
constexpr size_t WS_AB = WS_PB + (size_t)4 * 49152 * 128 * 4;
constexpr size_t WS_Q = 416 * MiB;
constexpr size_t WS_X8 = WS_Q;
constexpr size_t WS_KB = 464 * MiB;
constexpr size_t WS_VB = 477 * MiB;
constexpr size_t WS_END = 490 * MiB;
constexpr float X8SCALE = 8.0f;
constexpr float WQSCALE = 64.0f;
constexpr float A8SCALE = 256.0f;

struct Args {
    const float* xp; const float* xs; const float* meta; const float* g_mix; const float* w_in; const float* conv_w;
    const float* qg; const float* kg; const float* conv_g; const float* attn_g; const float* w_out; const float* g_ffn;
    const float* wq; const float* subk; const float* pu; const float* pv;
    float* out; unsigned char* ws; int ph_lo, ph_hi;
};

__device__ __forceinline__ unsigned f2bf(float f) { unsigned u = __builtin_bit_cast(unsigned, f); return (u + 0x7fffu + ((u >> 16) & 1u)) >> 16; }
typedef float f32x2_pk __attribute__((ext_vector_type(2))); typedef __bf16 bf16x2_pk __attribute__((ext_vector_type(2)));
__device__ __forceinline__ unsigned pk2(float lo, float hi) { const f32x2_pk v = {lo, hi}; const bf16x2_pk b = __builtin_convertvector(v, bf16x2_pk); return __builtin_bit_cast(unsigned, b); }
__device__ __forceinline__ float bflo(unsigned w) { return __builtin_bit_cast(float, w << 16); }
__device__ __forceinline__ float bfhi(unsigned w) { return __builtin_bit_cast(float, w & 0xffff0000u); }
__device__ __forceinline__ float bf2f(bf16_t h) { return __builtin_bit_cast(float, (unsigned)h << 16); }
__device__ __forceinline__ void unpack8(u32x4 w, float* f) {
    f[0] = bflo(w.x); f[1] = bfhi(w.x); f[2] = bflo(w.y); f[3] = bfhi(w.y); f[4] = bflo(w.z); f[5] = bfhi(w.z); f[6] = bflo(w.w); f[7] = bfhi(w.w);
}
__device__ __forceinline__ u32x4 pack8(const float* f) { u32x4 w; w.x = pk2(f[0], f[1]); w.y = pk2(f[2], f[3]); w.z = pk2(f[4], f[5]); w.w = pk2(f[6], f[7]); return w; }
__device__ __forceinline__ float wave_sum(float v) {
#pragma unroll
    for (int o = 1; o < 64; o <<= 1) v += __shfl_xor(v, o);
    return v;
}
__device__ __forceinline__ float wave_max(float v) {
#pragma unroll
    for (int o = 1; o < 64; o <<= 1) v = fmaxf(v, __shfl_xor(v, o));
    return v;
}
__device__ __forceinline__ const float* xrow_ptr(const Args& a, int r) { return r < NBP * SEQ ? a.xp + (size_t)r * DM : a.xs + (size_t)(r - NBP * SEQ) * DM; }

__device__ __forceinline__ int permin(int n  ) {
    if (n >= 512 && n < 1536) { const int hc = (n - 512) >> 9, c = (n - 512) & 511; return 512 + (c >> 7) * 256 + hc * 128 + (c & 127); }
    if (n >= 1536 && n < 2048) { const int c = n - 1536, hh = c >> 6, half = (c >> 5) & 1; return 1536 + 256 * (hh >> 2) + 128 * half + 32 * (hh & 3) + (c & 31); }
    if (n >= 2048) { const int c = n - 2048, s = c >> 6, half = (c >> 5) & 1; return 2048 + 128 * half + 32 * s + (c & 31); }
    return n; }
__device__ __forceinline__ void p0_transpose_item(const float* W, int K, int N, bf16_t* WT, float* scr, int item, int lane, const float* gk = nullptr  , bool dperm = false) {
    const int nblk = N / 32, kb = item / nblk, nb = item % nblk, k0 = 64 * kb, n0 = 32 * nb, nd0 = dperm ? permin(n0) : n0;
#pragma unroll 8
    for (int i = 0; i < 32; ++i) { const int kk = 2 * i + (lane >> 5); scr[kk * 33 + (lane & 31)] = W[(size_t)(k0 + kk) * N + n0 + (lane & 31)] * (gk ? gk[k0 + kk] : 1.0f); }
    asm volatile("s_waitcnt lgkmcnt(0)" ::: "memory");
    const int c = lane & 7;
#pragma unroll
    for (int j = 0; j < 4; ++j) { const int n = (lane >> 3) + 8 * j; const float* s = scr + (8 * c) * 33 + n;
        u32x4 o; o.x = pk2(s[0 * 33], s[1 * 33]); o.y = pk2(s[2 * 33], s[3 * 33]); o.z = pk2(s[4 * 33], s[5 * 33]); o.w = pk2(s[6 * 33], s[7 * 33]);
        *(u32x4*)(WT + (size_t)(nd0 + n) * K + k0 + 8 * c) = o; }
    asm volatile("s_waitcnt lgkmcnt(0)" ::: "memory");
}
__device__ __forceinline__ void p0_transpose_item_fp8(const float* W, int K, int N, unsigned char* WT, float* scr, int item, int lane, const float* gk, float wscale) {
    const int nblk = N / 32, kb = item / nblk, nb = item % nblk, k0 = 64 * kb, n0 = 32 * nb;
#pragma unroll 8
    for (int i = 0; i < 32; ++i) { const int kk = 2 * i + (lane >> 5); scr[kk * 33 + (lane & 31)] = W[(size_t)(k0 + kk) * N + n0 + (lane & 31)] * (gk[k0 + kk] * wscale); }
    asm volatile("s_waitcnt lgkmcnt(0)" ::: "memory");
    const int c = lane & 7;
#pragma unroll
    for (int j = 0; j < 4; ++j) { const int n = (lane >> 3) + 8 * j; const float* s = scr + (8 * c) * 33 + n;
        unsigned w0 = (unsigned)__builtin_amdgcn_cvt_pk_fp8_f32(s[0 * 33], s[1 * 33], 0, false); w0 = (unsigned)__builtin_amdgcn_cvt_pk_fp8_f32(s[2 * 33], s[3 * 33], (int)w0, true);
        unsigned w1 = (unsigned)__builtin_amdgcn_cvt_pk_fp8_f32(s[4 * 33], s[5 * 33], 0, false); w1 = (unsigned)__builtin_amdgcn_cvt_pk_fp8_f32(s[6 * 33], s[7 * 33], (int)w1, true);
        *(u32x2*)(WT + (size_t)(n0 + n) * K + k0 + 8 * c) = (u32x2){w0, w1}; }
    asm volatile("s_waitcnt lgkmcnt(0)" ::: "memory");
}
__device__ __forceinline__ void cast_region(const float* src, bf16_t* dst, size_t n, size_t gtid, size_t nthreads) {
    for (size_t i = gtid * 8; i < n; i += nthreads * 8) {
        const f32x4 a = *(const f32x4*)(src + i), b = *(const f32x4*)(src + i + 4);
        u32x4 o; o.x = pk2(a.x, a.y); o.y = pk2(a.z, a.w); o.z = pk2(b.x, b.y); o.w = pk2(b.z, b.w);
        *(u32x4*)(dst + i) = o;
    }
}
template <bool PERM64> __device__ __forceinline__ void table_fp4(const float* src, unsigned char* dst, float* scale, const float* gcol  , int gw, int NGW, int lane) {
    f32x4 v[4], vn[4], g[4];
#pragma unroll
    for (int j = 0; j < 4; ++j) g[j] = gcol ? *(const f32x4*)(gcol + lane * 16 + 4 * j) : (f32x4){1.f, 1.f, 1.f, 1.f};
    if (gw < 16384) {
#pragma unroll
        for (int j = 0; j < 4; ++j) v[j] = __builtin_nontemporal_load((const f32x4*)(src + (size_t)gw * DM + lane * 16 + 4 * j)); }
    for (int row = gw; row < 16384; row += NGW) {
        { const int rn = row + NGW < 16384 ? row + NGW : row;
#pragma unroll
          for (int j = 0; j < 4; ++j) vn[j] = __builtin_nontemporal_load((const f32x4*)(src + (size_t)rn * DM + lane * 16 + 4 * j)); }
        float m = 0.f;
#pragma unroll
        for (int j = 0; j < 4; ++j) { v[j] = v[j] * g[j]; m = fmaxf(fmaxf(m, fmaxf(fabsf(v[j].x), fabsf(v[j].y))), fmaxf(fabsf(v[j].z), fabsf(v[j].w))); }
        m = wave_max(m);
        const float s = fmaxf(m, 1e-30f) * (1.0f / 6.0f), inv = 1.0f / s;
        unsigned char* rowp = dst + (size_t)(lane >> 4) * SLICE4 + (size_t)row * 128;
        if (!PERM64) {
            unsigned w0 = 0u, w1 = 0u;
            w0 = __builtin_amdgcn_cvt_scalef32_pk_fp4_f32(w0, v[0].x * inv, v[0].y * inv, 1.0f, 0); w0 = __builtin_amdgcn_cvt_scalef32_pk_fp4_f32(w0, v[0].z * inv, v[0].w * inv, 1.0f, 1);
            w0 = __builtin_amdgcn_cvt_scalef32_pk_fp4_f32(w0, v[1].x * inv, v[1].y * inv, 1.0f, 2); w0 = __builtin_amdgcn_cvt_scalef32_pk_fp4_f32(w0, v[1].z * inv, v[1].w * inv, 1.0f, 3);
            w1 = __builtin_amdgcn_cvt_scalef32_pk_fp4_f32(w1, v[2].x * inv, v[2].y * inv, 1.0f, 0); w1 = __builtin_amdgcn_cvt_scalef32_pk_fp4_f32(w1, v[2].z * inv, v[2].w * inv, 1.0f, 1);
            w1 = __builtin_amdgcn_cvt_scalef32_pk_fp4_f32(w1, v[3].x * inv, v[3].y * inv, 1.0f, 2); w1 = __builtin_amdgcn_cvt_scalef32_pk_fp4_f32(w1, v[3].z * inv, v[3].w * inv, 1.0f, 3);
            *(u32x2*)(rowp + (lane & 15) * 8) = (u32x2){w0, w1};
        } else {
            unsigned char* gp = rowp + ((lane & 15) >> 2) * 32 + (lane & 3) * 2;
#pragma unroll
            for (int m = 0; m < 4; ++m) { unsigned wm = 0u;
                wm = __builtin_amdgcn_cvt_scalef32_pk_fp4_f32(wm, v[0][m] * inv, v[1][m] * inv, 1.0f, 0); wm = __builtin_amdgcn_cvt_scalef32_pk_fp4_f32(wm, v[2][m] * inv, v[3][m] * inv, 1.0f, 1);
                *(unsigned short*)(gp + 8 * m) = (unsigned short)wm; }
        }
        if (lane == 0) scale[row] = s;
#pragma unroll
        for (int j = 0; j < 4; ++j) v[j] = vn[j];
    }
}
__device__ __forceinline__ void p0_prologue(const Args& a, unsigned char* lds, int tid, int lane, int wave) {
    const int G = gridDim.x, gw = blockIdx.x * NWAVES + wave, NGW = G * NWAVES;
    float* ldsf = (float*)lds;
    if (blockIdx.x < INW / 64) {
        float* xm = ldsf;
        float* red = ldsf + 16 * 1024;
#pragma unroll
        for (int rr = 0; rr < 2; ++rr) { const int r = 2 * wave + rr; f32x4 v[4]; float ss = 0.f;
#pragma unroll
            for (int j = 0; j < 4; ++j) { v[j] = *(const f32x4*)(a.meta + (size_t)r * DM + (lane + 64 * j) * 4); ss += v[j].x * v[j].x + v[j].y * v[j].y + v[j].z * v[j].z + v[j].w * v[j].w; }
            const float rstd = 1.0f / sqrtf(wave_sum(ss) * (1.0f / DM) + EPS);
#pragma unroll
            for (int j = 0; j < 4; ++j) { const int c = (lane + 64 * j) * 4; const f32x4 g = *(const f32x4*)(a.g_mix + c); *(f32x4*)(xm + r * 1024 + c) = v[j] * rstd * g; }
        }
        __syncthreads();
        const int n0 = blockIdx.x * 64, k0 = wave * 128;
        float acc[16];
#pragma unroll
        for (int r = 0; r < 16; ++r) acc[r] = 0.f;
        for (int kb = k0; kb < k0 + 128; kb += 16) { float wv[16];
#pragma unroll
            for (int q = 0; q < 16; ++q) wv[q] = a.w_in[(size_t)(kb + q) * INW + n0 + lane];
#pragma unroll
            for (int q = 0; q < 16; ++q)
#pragma unroll
                for (int r = 0; r < 16; ++r) acc[r] += xm[r * 1024 + kb + q] * wv[q]; }
#pragma unroll
        for (int r = 0; r < 16; ++r) red[(wave * 16 + r) * 64 + lane] = acc[r];
        __syncthreads();
        float* zmeta = (float*)(a.ws + WS_ZMETA);
        for (int o = tid; o < 1024; o += NTHR) { const int r = o >> 6, c = o & 63; float s = 0.f;
#pragma unroll
            for (int w = 0; w < 8; ++w) s += red[(w * 16 + r) * 64 + c];
            zmeta[r * INW + n0 + c] = s; }
        __syncthreads();
    }
    if (blockIdx.x == INW / 64) {
        float* rope = (float*)(a.ws + WS_ROPE);
        for (int i = tid; i < 64 * 16; i += NTHR) { const int pos = i >> 4, f = i & 15;
            const float freq = exp2f(-(float)f * (13.287712379549449f / 16.0f)); const float rev = (float)pos * freq * 0.15915494309189535f; const float fr = rev - floorf(rev);
            rope[2 * i] = __builtin_amdgcn_cosf(fr); rope[2 * i + 1] = __builtin_amdgcn_sinf(fr); }
    }
    if ((int)blockIdx.x > INW / 64 || G <= INW / 64 + 1) {
        float* scr = ldsf + wave * (64 * 33);
        constexpr int I_IN = (DM / 64) * (INW / 32), I_OUT = (DM / 64) * (DM / 32), I_WQ = (DM / 64) * (PQ / 32);
        const int first = (G <= INW / 64 + 1) ? 0 : INW / 64 + 1, nw = (G - first) * NWAVES;
        for (int it = ((int)blockIdx.x - first) * NWAVES + wave; it < I_IN + I_OUT + I_WQ; it += nw) {
            int r = it;
            if (r < I_IN) { p0_transpose_item(a.w_in, DM, INW, (bf16_t*)(a.ws + WS_WIN), scr, r, lane, nullptr, true); continue; } r -= I_IN;
            if (r < I_OUT) { p0_transpose_item(a.w_out, DM, DM, (bf16_t*)(a.ws + WS_WOUT), scr, r, lane); continue; } r -= I_OUT;
            p0_transpose_item_fp8(a.wq, DM, PQ, a.ws + WS_WQ, scr, r, lane, a.g_ffn, WQSCALE);
        }
    }
    {
        const size_t gtid = (size_t)blockIdx.x * NTHR + tid, nth = (size_t)G * NTHR;
        cast_region(a.subk, (bf16_t*)(a.ws + WS_SUBK), (size_t)16 * 128 * 128, gtid, nth);
        for (size_t i = gtid; i < (size_t)NTOK; i += nth) ((float*)(a.ws + WS_SS))[i] = 0.f;
    }
    {
        bf16_t* XA = (bf16_t*)(a.ws + WS_XA);
        f32x4 g[4], v[4], vn[4];
#pragma unroll
        for (int j = 0; j < 4; ++j) g[j] = *(const f32x4*)(a.g_mix + (lane + 64 * j) * 4);
        if (gw < NTOK) { const float* xr = xrow_ptr(a, gw);
#pragma unroll
            for (int j = 0; j < 4; ++j) v[j] = __builtin_nontemporal_load((const f32x4*)(xr + (lane + 64 * j) * 4)); }
        for (int r = gw; r < NTOK; r += NGW) {
            { const float* xn = xrow_ptr(a, r + NGW < NTOK ? r + NGW : r);
#pragma unroll
              for (int j = 0; j < 4; ++j) vn[j] = __builtin_nontemporal_load((const f32x4*)(xn + (lane + 64 * j) * 4)); }
            float ss = 0.f;
#pragma unroll
            for (int j = 0; j < 4; ++j) ss += v[j].x * v[j].x + v[j].y * v[j].y + v[j].z * v[j].z + v[j].w * v[j].w;
            const float rstd = 1.0f / sqrtf(wave_sum(ss) * (1.0f / DM) + EPS);
#pragma unroll
            for (int j = 0; j < 4; ++j) { const int c = (lane + 64 * j) * 4; const f32x4 o = v[j] * rstd * g[j];
                u32x2 w; w.x = pk2(o.x, o.y); w.y = pk2(o.z, o.w); *(u32x2*)(XA + (size_t)r * DM + c) = w; }
#pragma unroll
            for (int j = 0; j < 4; ++j) v[j] = vn[j];
        }
    }
}

constexpr int ZW = 1024;
struct P2In { u32x4 w[4]; };
__device__ __forceinline__ void p2_load(P2In& in, const bf16_t* ZB, int r, int lane) {
    const int t = r & 2047, c0 = lane * 8; const bf16_t* zr = ZB + (size_t)r * ZW;
    const bf16_t* zp = (t > 0) ? zr - ZW : zr; const bf16_t* zn = (t < SEQ - 1) ? zr + ZW : zr;
    in.w[0] = *(const u32x4*)(zr + c0); in.w[1] = *(const u32x4*)(zr + 512 + c0); in.w[2] = *(const u32x4*)(zp + 512 + c0); in.w[3] = *(const u32x4*)(zn + 512 + c0);
}
__device__ __forceinline__ void p2_pass(const Args& a, int lane, int gw, int NGW) {
    const bf16_t* ZB = (const bf16_t*)(a.ws + WS_Z); const float* zmeta = (const float*)(a.ws + WS_ZMETA);
    bf16_t* XA = (bf16_t*)(a.ws + WS_XA);
    const int c0 = lane * 8;
    float cw0[8], cw1[8], cw2[8], cgn[8];
#pragma unroll
    for (int j = 0; j < 8; ++j) { cw0[j] = a.conv_w[c0 + j]; cw1[j] = a.conv_w[512 + c0 + j]; cw2[j] = a.conv_w[1024 + c0 + j]; cgn[j] = a.conv_g[c0 + j]; }
    P2In cur, nxt, nx2;
    if (gw < NTOK) { p2_load(cur, ZB, gw, lane); p2_load(nxt, ZB, gw + NGW < NTOK ? gw + NGW : gw, lane); }
    for (int it = gw; it < NTOK; it += NGW) {
        {
            const int r = it, t = r & 2047;
            { const int rn = it + 2 * NGW < NTOK ? it + 2 * NGW : it; p2_load(nx2, ZB, rn, lane); }
            float gb[8], uc[8], up[8], un[8];
            unpack8(cur.w[0], gb); unpack8(cur.w[1], uc); unpack8(cur.w[2], up);
            if (t == 0) {
#pragma unroll
                for (int j = 0; j < 8; ++j) up[j] = zmeta[15 * INW + 512 + c0 + j] * zmeta[15 * INW + 1024 + c0 + j]; }
            unpack8(cur.w[3], un);
#pragma unroll
            for (int j = 0; j < 8; ++j) un[j] = (t < SEQ - 1) ? un[j] : 0.f;
            float y[8], ss = 0.f;
#pragma unroll
            for (int j = 0; j < 8; ++j) { y[j] = gb[j] * (up[j] * cw0[j] + uc[j] * cw1[j] + un[j] * cw2[j]); ss += y[j] * y[j]; }
            ss += __shfl_xor(ss, 1); ss += __shfl_xor(ss, 2); ss += __shfl_xor(ss, 4);
            const float rstd = 1.0f / sqrtf(ss * (1.0f / 64.0f) + EPS);
#pragma unroll
            for (int j = 0; j < 8; ++j) y[j] = y[j] * rstd * cgn[j];
            *(u32x4*)(XA + (size_t)r * DM + c0) = pack8(y);
            cur = nxt; nxt = nx2;
        }
    }
}
__device__ __forceinline__ void kv_meta_rows(const Args& a, int lane, int gw, int NGW) {
    const float* zmeta = (const float*)(a.ws + WS_ZMETA); bf16_t* KB = (bf16_t*)(a.ws + WS_KB); bf16_t* VB = (bf16_t*)(a.ws + WS_VB);
    const int i = lane & 7;
    for (int it = NTOK + gw; it < NTOK + NB * 64; it += NGW) {
        {
            const int it2 = it - NTOK, b = it2 >> 6, j64 = it2 & 63; const int l16 = lane & 15, g = l16 >> 3;
            float k[8], v[8];
            if (j64 < NMETA) {
                const float* zm = zmeta + j64 * INW; float ss = 0.f;
#pragma unroll
                for (int j = 0; j < 8; ++j) { k[j] = zm[2048 + l16 * 8 + j]; v[j] = zm[2176 + l16 * 8 + j]; ss += k[j] * k[j]; }
                ss += __shfl_xor(ss, 1); ss += __shfl_xor(ss, 2); ss += __shfl_xor(ss, 4);
                const float rstd = 1.0f / sqrtf(ss * (1.0f / 64.0f) + EPS);
#pragma unroll
                for (int j = 0; j < 8; ++j) k[j] = k[j] * rstd * a.kg[i * 8 + j];
            } else {
#pragma unroll
                for (int j = 0; j < 8; ++j) { k[j] = 0.f; v[j] = 0.f; }
            }
            const size_t krow = ((size_t)(b * 2 + g) * KROWS + SEQ + j64) * 64 + i * 8;
            if (lane < 16) *(u32x4*)(KB + krow) = pack8(k);
            else if (lane < 32) *(u32x4*)(VB + krow) = pack8(v);
        }
    }
}

typedef float f32x16 __attribute__((ext_vector_type(16)));
__device__ __forceinline__ void ce_desc(float& a, float& b) { float h, l; asm("v_max_f32_e32 %0, %1, %2" : "=v"(h) : "v"(a), "v"(b)); asm("v_min_f32_e32 %0, %1, %2" : "=v"(l) : "v"(a), "v"(b)); a = h; b = l; }
__device__ __forceinline__ float vmaxf(float a, float b) { float h; asm("v_max_f32_e32 %0, %1, %2" : "=v"(h) : "v"(a), "v"(b)); return h; }
template <int N> __device__ __forceinline__ void bitonic_sort_desc(float* v) {
#pragma unroll
    for (int k = 2; k <= N; k <<= 1)
#pragma unroll
        for (int j = k >> 1; j > 0; j >>= 1)
#pragma unroll
            for (int i = 0; i < N; ++i) { const int l = i ^ j; if (l > i) { if ((i & k) == 0) ce_desc(v[i], v[l]); else ce_desc(v[l], v[i]); } }
}
__device__ __forceinline__ void sort16_desc(float* v) {
    ce_desc(v[0], v[13]); ce_desc(v[1], v[12]); ce_desc(v[2], v[15]); ce_desc(v[3], v[14]); ce_desc(v[4], v[8]); ce_desc(v[5], v[6]); ce_desc(v[7], v[11]); ce_desc(v[9], v[10]);
    ce_desc(v[0], v[5]); ce_desc(v[1], v[7]); ce_desc(v[2], v[9]); ce_desc(v[3], v[4]); ce_desc(v[6], v[13]); ce_desc(v[8], v[14]); ce_desc(v[10], v[15]); ce_desc(v[11], v[12]);
    ce_desc(v[0], v[1]); ce_desc(v[2], v[3]); ce_desc(v[4], v[5]); ce_desc(v[6], v[8]); ce_desc(v[7], v[9]); ce_desc(v[10], v[11]); ce_desc(v[12], v[13]); ce_desc(v[14], v[15]);
    ce_desc(v[0], v[2]); ce_desc(v[1], v[3]); ce_desc(v[4], v[10]); ce_desc(v[5], v[11]); ce_desc(v[6], v[7]); ce_desc(v[8], v[9]); ce_desc(v[12], v[14]); ce_desc(v[13], v[15]);
    ce_desc(v[1], v[2]); ce_desc(v[3], v[12]); ce_desc(v[4], v[6]); ce_desc(v[5], v[7]); ce_desc(v[8], v[10]); ce_desc(v[9], v[11]); ce_desc(v[13], v[14]);
    ce_desc(v[1], v[4]); ce_desc(v[2], v[6]); ce_desc(v[5], v[8]); ce_desc(v[7], v[10]); ce_desc(v[9], v[13]); ce_desc(v[11], v[14]);
    ce_desc(v[2], v[4]); ce_desc(v[3], v[6]); ce_desc(v[9], v[12]); ce_desc(v[11], v[13]);
    ce_desc(v[3], v[5]); ce_desc(v[6], v[8]); ce_desc(v[7], v[9]); ce_desc(v[10], v[12]);
    ce_desc(v[3], v[4]); ce_desc(v[5], v[6]); ce_desc(v[7], v[8]); ce_desc(v[9], v[10]); ce_desc(v[11], v[12]);
    ce_desc(v[6], v[7]); ce_desc(v[8], v[9]);
}
template <int N> __device__ __forceinline__ void bitonic_merge_desc(float* v) {
#pragma unroll
    for (int j = N >> 1; j > 0; j >>= 1)
#pragma unroll
        for (int i = 0; i < N; ++i) { const int l = i ^ j; if (l > i) ce_desc(v[i], v[l]); }
}
__device__ __forceinline__ void merge_top16(float* x, const float* y) {
#pragma unroll
    for (int i = 0; i < 16; ++i) x[i] = vmaxf(x[i], y[15 - i]);
    bitonic_merge_desc<16>(x);
}
__device__ __forceinline__ void insert16(float* t, float x) {
#pragma unroll
    for (int k = 0; k < 16; ++k) ce_desc(t[k], x);
}
constexpr int SK_ROW = 272, SK_MAT = 128 * SK_ROW;
__device__ __forceinline__ void p7_half(const bf16_t* qrow  , const LAS unsigned char* skl  , int hi4, float* T) {
    f32x16 acc[4];
#pragma unroll
    for (int nb = 0; nb < 4; ++nb)
#pragma unroll
        for (int r = 0; r < 16; ++r) acc[nb][r] = 0.f;
    bf16x8 bq[8];
#pragma unroll
    for (int ks = 0; ks < 8; ++ks) bq[ks] = *(const bf16x8*)(qrow + ks * 16);
#pragma unroll
    for (int ks = 0; ks < 8; ++ks) {
#pragma unroll
        for (int nb = 0; nb < 4; ++nb) { const bf16x8 ak = *(const LAS bf16x8*)(skl + nb * 32 * SK_ROW + ks * 32); acc[nb] = __builtin_amdgcn_mfma_f32_32x32x16_bf16(ak, bq[ks], acc[nb], 0, 0, 0); }
        if (ks & 1) __builtin_amdgcn_sched_barrier(0);
    }
    float L[16];
#pragma unroll
    for (int nb = 0; nb < 4; ++nb) {
        float v[16];
#pragma unroll
        for (int r = 0; r < 16; ++r) { const float sc = acc[nb][r]; v[r] = __uint_as_float((__float_as_uint(sc) & ~127u) | (unsigned)(nb * 16 + r)); }
        sort16_desc(v);
        if (nb == 0) {
#pragma unroll
            for (int r = 0; r < 16; ++r) L[r] = v[r];
        } else merge_top16(L, v);
    }
#pragma unroll
    for (int r = 0; r < 16; ++r) { const unsigned w = __builtin_bit_cast(unsigned, L[r]); T[r] = __builtin_bit_cast(float, w + (w & 0x3Cu) + (unsigned)hi4); }
}
__device__ __forceinline__ unsigned pick_byte(unsigned p0, unsigned p1, unsigned p2, unsigned p3, unsigned i) {
    const unsigned sel = (i & 7u) | 0x0c0c0c00u;
    const unsigned lo = __builtin_amdgcn_perm(p1, p0, sel), hi = __builtin_amdgcn_perm(p3, p2, sel);
    return (i & 8u) ? hi : lo;
}
__device__ __forceinline__ void p7_topk(const Args& a, unsigned char* lds, int tid, int lane, int wave) {
    const bf16_t* QP = (const bf16_t*)(a.ws + WS_QP); const bf16_t* SUBK = (const bf16_t*)(a.ws + WS_SUBK);
    unsigned short* EIDX = (unsigned short*)(a.ws + WS_EI); float* GATE = (float*)(a.ws + WS_GT); const float* SSQ = (const float*)(a.ws + WS_SS);
    const int r32 = lane & 31, hi = lane >> 5;
    const int hp = blockIdx.x & 3, grp = blockIdx.x >> 2, ngrp = gridDim.x >> 2;
    { const u32x4* src = (const u32x4*)(SUBK + (size_t)hp * 4 * 128 * 128);
      for (int i = tid; i < 4 * 128 * 16; i += NTHR) { const int row = i >> 4, ch = i & 15; *(LAS u32x4*)((LAS unsigned char*)lds + row * SK_ROW + ch * 16) = src[i]; } }
    __syncthreads();
    const LAS unsigned char* skl = (const LAS unsigned char*)lds + r32 * SK_ROW + 16 * hi;
    for (int blk = grp * NWAVES + wave; blk < NTOK / 32; blk += ngrp * NWAVES) {
        const int tok = blk * 32 + r32;
        const float rs_l2e = 1.4426950408889634f / sqrtf(SSQ[tok] * (1.0f / DM) + EPS);
        float M0[16], M1[16];
        {
            float B0[16], B1[16];
            p7_half(QP + (size_t)tok * PQ + (2 * hp) * 256 + 8 * hi, skl + 0 * SK_MAT, 4 * hi, M0);
            p7_half(QP + (size_t)tok * PQ + (2 * hp) * 256 + 128 + 8 * hi, skl + 1 * SK_MAT, 4 * hi, M1);
            p7_half(QP + (size_t)tok * PQ + (2 * hp + 1) * 256 + 8 * hi, skl + 2 * SK_MAT, 4 * hi, B0);
            p7_half(QP + (size_t)tok * PQ + (2 * hp + 1) * 256 + 128 + 8 * hi, skl + 3 * SK_MAT, 4 * hi, B1);
#pragma unroll
            for (int i = 0; i < 16; ++i) {
                const auto r0 = __builtin_amdgcn_permlane32_swap(__builtin_bit_cast(unsigned, M0[i]), __builtin_bit_cast(unsigned, B0[i]), false, false);
                const unsigned a0 = r0[0], b0 = r0[1]; M0[i] = __builtin_bit_cast(float, a0); B0[i] = __builtin_bit_cast(float, b0);
                const auto r1 = __builtin_amdgcn_permlane32_swap(__builtin_bit_cast(unsigned, M1[i]), __builtin_bit_cast(unsigned, B1[i]), false, false);
                const unsigned a1 = r1[0], b1 = r1[1]; M1[i] = __builtin_bit_cast(float, a1); B1[i] = __builtin_bit_cast(float, b1); }
            merge_top16(M0, B0); merge_top16(M1, B1);
        }
        const int h = 2 * hp + hi;
#define CAND(i, j) __builtin_bit_cast(float, (__builtin_bit_cast(unsigned, M0[i] + M1[j]) & ~255u) | (unsigned)((i) * 16 + (j)))
        float tc[16], l2[16], l3[16];
#pragma unroll
        for (int j = 0; j < 16; ++j) tc[j] = CAND(0, j);
#pragma unroll
        for (int j = 0; j < 8; ++j) { l2[j] = CAND(1, j); l2[8 + j] = CAND(15 - j, 0); }
        bitonic_merge_desc<16>(l2);
        merge_top16(tc, l2);
        l3[0] = CAND(2, 0); l3[1] = CAND(2, 1); l3[2] = CAND(2, 2); l3[3] = CAND(2, 3); l3[4] = CAND(2, 4); l3[5] = CAND(3, 0); l3[6] = CAND(3, 1); l3[7] = CAND(3, 2); l3[8] = CAND(3, 3);
        l3[9] = CAND(4, 0); l3[10] = CAND(4, 1); l3[11] = CAND(4, 2); l3[12] = CAND(5, 0); l3[13] = CAND(5, 1); l3[14] = CAND(6, 0); l3[15] = CAND(6, 1);
        sort16_desc(l3);
        merge_top16(tc, l3);
        insert16(tc, CAND(7, 0)); insert16(tc, CAND(7, 1));
#undef CAND
#define PK4(M, q) ((__builtin_bit_cast(unsigned, M[4 * (q)]) & 127u) | ((__builtin_bit_cast(unsigned, M[4 * (q) + 1]) & 127u) << 8) | ((__builtin_bit_cast(unsigned, M[4 * (q) + 2]) & 127u) << 16) | ((__builtin_bit_cast(unsigned, M[4 * (q) + 3]) & 127u) << 24))
        const unsigned a0 = PK4(M0, 0), a1 = PK4(M0, 1), a2 = PK4(M0, 2), a3 = PK4(M0, 3), b0 = PK4(M1, 0), b1 = PK4(M1, 1), b2 = PK4(M1, 2), b3 = PK4(M1, 3);
#undef PK4
        float e[16], sum = 0.f;
#pragma unroll
        for (int k = 0; k < 16; ++k) { e[k] = exp2f((tc[k] - tc[0]) * rs_l2e); sum += e[k]; }
        const float inv = 1.0f / sum;
        int eo[16];
#pragma unroll
        for (int k = 0; k < 16; ++k) { const unsigned code = __builtin_bit_cast(unsigned, tc[k]) & 255u; eo[k] = (int)(pick_byte(a0, a1, a2, a3, code >> 4) * 128u + pick_byte(b0, b1, b2, b3, code & 15u)); e[k] *= inv; }
        unsigned short* ep = EIDX + ((size_t)tok * 8 + h) * 16; float* gp = GATE + ((size_t)tok * 8 + h) * 16;
#pragma unroll
        for (int k = 0; k < 16; k += 8) { u32x4 pk; pk.x = (unsigned)eo[k] | ((unsigned)eo[k + 1] << 16); pk.y = (unsigned)eo[k + 2] | ((unsigned)eo[k + 3] << 16); pk.z = (unsigned)eo[k + 4] | ((unsigned)eo[k + 5] << 16); pk.w = (unsigned)eo[k + 6] | ((unsigned)eo[k + 7] << 16); *(u32x4*)(ep + k) = pk; }
#pragma unroll
        for (int k = 0; k < 16; k += 4) *(f32x4*)(gp + k) = (f32x4){e[k], e[k + 1], e[k + 2], e[k + 3]};
    }
}

typedef _Float16 h2_t __attribute__((ext_vector_type(2)));
typedef float f32x2 __attribute__((ext_vector_type(2)));
__device__ __forceinline__ float dot32_fp4(u32x4 w, const h2_t* xh) {
    float acc = 0.f;
#pragma unroll
    for (int d = 0; d < 4; ++d) {
        const unsigned wd = w[d];
        acc = __builtin_amdgcn_fdot2(__builtin_amdgcn_cvt_scalef32_pk_f16_fp4(wd, 1.0f, 0), xh[4 * d], acc, false);
        acc = __builtin_amdgcn_fdot2(__builtin_amdgcn_cvt_scalef32_pk_f16_fp4(wd, 1.0f, 1), xh[4 * d + 1], acc, false);
        acc = __builtin_amdgcn_fdot2(__builtin_amdgcn_cvt_scalef32_pk_f16_fp4(wd, 1.0f, 2), xh[4 * d + 2], acc, false);
        acc = __builtin_amdgcn_fdot2(__builtin_amdgcn_cvt_scalef32_pk_f16_fp4(wd, 1.0f, 3), xh[4 * d + 3], acc, false);
    }
    return acc;
}
typedef int i32x4 __attribute__((ext_vector_type(4)));
struct PMeta { unsigned p[8]; };
#define GAS __attribute__((address_space(1)))
template <class T> __device__ __forceinline__ GAS T* sgpr_ptr(T* p) { asm volatile("" : "+s"(p)); return (GAS T*)p; }
__device__ __forceinline__ void pm_load(PMeta& m, const unsigned short* EIDX, int t  , int seg) {
    const GAS unsigned char* rb = sgpr_ptr((const unsigned char*)(EIDX + (size_t)t * 128)); const unsigned lo = (unsigned)seg * 32u;
#pragma unroll
    for (int q = 0; q < 2; ++q) { const u32x4 ev = __builtin_nontemporal_load((const GAS u32x4*)(rb + (lo + q * 16u))); m.p[4 * q] = ev.x; m.p[4 * q + 1] = ev.y; m.p[4 * q + 2] = ev.z; m.p[4 * q + 3] = ev.w; }
}
#define SCHED_FENCE() __builtin_amdgcn_sched_barrier(0)
__device__ __forceinline__ void rows16_load(u32x4 (&w)[16], const unsigned char* Tbase, unsigned lane_off, const PMeta& m) {
#pragma unroll
    for (int j = 0; j < 16; ++j) { const unsigned pw = m.p[j >> 1]; const unsigned e = (j & 1) ? (pw >> 16) : (pw & 0xffffu); w[j] = *(const u32x4*)(Tbase + (e * 128u + lane_off)); }
}
#define PEER_GEOM() const int s4 = blockIdx.x & 3, th = (blockIdx.x >> 2) & 1, wq = (blockIdx.x >> 3) * NWAVES + wave, NWQ = (gridDim.x >> 3) * NWAVES, t_beg = th * (NTOK / 2) + wq, t_end = (th + 1) * (NTOK / 2)
#define TCL(t) ((t) < t_end ? (t) : t_end - 1)
typedef int v8i_t __attribute__((ext_vector_type(8)));
struct UTok { u32x4 A[8][2]; u32x4 B[2][2]; };
__device__ __forceinline__ void u_issue(UTok& T, const unsigned char* Ts  , const unsigned char* x8row  , unsigned idlo, unsigned idhi, int lane) {
    const int r16 = lane >> 2; const unsigned c16 = (unsigned)(lane & 3) * 16u; const unsigned q16 = (unsigned)(lane >> 4) * 16u;
#pragma unroll
    for (int h = 0; h < 8; ++h) { const unsigned e = (unsigned)__shfl((int)(h < 4 ? idlo : idhi), (h & 3) * 16 + r16);
#pragma unroll
        for (int ks = 0; ks < 2; ++ks) T.A[h][ks] = *(const u32x4*)(Ts + (e * 128u + 64u * ks + c16)); }
#pragma unroll
    for (int ks = 0; ks < 2; ++ks)
#pragma unroll
        for (int hf = 0; hf < 2; ++hf) T.B[ks][hf] = __builtin_nontemporal_load((const GAS u32x4*)(sgpr_ptr(x8row) + (128u * ks + 64u * hf + q16)));
}
__device__ __forceinline__ void u_compute(const UTok& T, int lane, float* dst  ) {
    f32x4 acc[8];
#pragma unroll
    for (int h = 0; h < 8; ++h) {
        acc[h] = (f32x4){0.f, 0.f, 0.f, 0.f};
#pragma unroll
        for (int ks = 0; ks < 2; ++ks) {
            const int src = (4 * (lane & 15) + (lane >> 4)) * 4;
            const v8i_t av = {__builtin_amdgcn_ds_bpermute(src, (int)T.A[h][ks].x), __builtin_amdgcn_ds_bpermute(src, (int)T.A[h][ks].y), __builtin_amdgcn_ds_bpermute(src, (int)T.A[h][ks].z), __builtin_amdgcn_ds_bpermute(src, (int)T.A[h][ks].w), 0, 0, 0, 0};
            const v8i_t bv = {(int)T.B[ks][0].x, (int)T.B[ks][0].y, (int)T.B[ks][0].z, (int)T.B[ks][0].w, (int)T.B[ks][1].x, (int)T.B[ks][1].y, (int)T.B[ks][1].z, (int)T.B[ks][1].w};
            acc[h] = __builtin_amdgcn_mfma_scale_f32_16x16x128_f8f6f4(av, bv, acc[h], 4  , 0  , 0, 0x7F7F7F7F, 0, 0x7F7F7F7F);
        }
    }
    const int j16 = lane & 15; f32x4 r = acc[0];
#pragma unroll
    for (int h = 1; h < 8; ++h) r = (j16 == h) ? acc[h] : r;
    if (j16 < 8) __builtin_nontemporal_store(r, (GAS f32x4*)(sgpr_ptr((unsigned char*)dst) + (unsigned)(j16 * 16 + (lane >> 4) * 4) * 4u));
}
__device__ __forceinline__ void p8a_u(const Args& a, int lane, int wave) {
    const unsigned short* EIDX = (const unsigned short*)(a.ws + WS_EI); float* PB = (float*)(a.ws + WS_PB);
    PEER_GEOM();
    const unsigned char* Ts = a.ws + WS_UT + (size_t)s4 * SLICE4; const unsigned char* x8 = a.ws + WS_X8 + s4 * 256;
    float* pb = PB + (size_t)s4 * NTOK * 128;
#define IDLOAD(lo, hi, t) do { const GAS unsigned short* ip_ = sgpr_ptr(EIDX + (size_t)(t) * 128); lo = ip_[lane]; hi = ip_[64 + lane]; } while (0)
    UTok TA, TB; unsigned ia0, ia1, ib0, ib1;
    IDLOAD(ia0, ia1, TCL(t_beg)); IDLOAD(ib0, ib1, TCL(t_beg + NWQ));
    u_issue(TA, Ts, x8 + (size_t)TCL(t_beg) * DM, ia0, ia1, lane);
    IDLOAD(ia0, ia1, TCL(t_beg + 2 * NWQ));
    for (int t = t_beg; t < t_end; t += 2 * NWQ) {
        SCHED_FENCE();
        u_issue(TB, Ts, x8 + (size_t)TCL(t + NWQ) * DM, ib0, ib1, lane); IDLOAD(ib0, ib1, TCL(t + 3 * NWQ));
        SCHED_FENCE();
        u_compute(TA, lane, pb + (size_t)t * 128);
        SCHED_FENCE();
        u_issue(TA, Ts, x8 + (size_t)TCL(t + 2 * NWQ) * DM, ia0, ia1, lane); IDLOAD(ia0, ia1, TCL(t + 4 * NWQ));
        SCHED_FENCE();
        if (t + NWQ < t_end) u_compute(TB, lane, pb + (size_t)(t + NWQ) * 128);
    }
#undef IDLOAD
}
__device__ __forceinline__ void p8c_combine(const Args& a, unsigned char* lds, int tid) {
    const float* PB = (const float*)(a.ws + WS_PB); unsigned* AB = (unsigned*)(a.ws + WS_AB); const float* GATE = (const float*)(a.ws + WS_GT); const float* SS = (const float*)(a.ws + WS_SS);
    const unsigned short* EIDX = (const unsigned short*)(a.ws + WS_EI); const float* su = (const float*)(a.ws + WS_USC); const float* sv = (const float*)(a.ws + WS_VSC);
    const size_t n4 = (size_t)NTOK * 128 / 4, nth = (size_t)gridDim.x * NTHR;
    LAS float* su_l = (LAS float*)lds; LAS float* sv_l = su_l + 16384;
    for (int i = tid; i < 16384 / 4; i += NTHR) { *(LAS f32x4*)(su_l + 4 * i) = *(const f32x4*)(su + 4 * i); *(LAS f32x4*)(sv_l + 4 * i) = *(const f32x4*)(sv + 4 * i); }
    __syncthreads();
    float calib;
    { unsigned a1 = 0u; a1 = __builtin_amdgcn_cvt_scalef32_pk_fp4_f32(a1, 1.0f, 1.0f, 1.0f, 0); a1 = __builtin_amdgcn_cvt_scalef32_pk_fp4_f32(a1, 1.0f, 1.0f, 1.0f, 1);
      a1 = __builtin_amdgcn_cvt_scalef32_pk_fp4_f32(a1, 1.0f, 1.0f, 1.0f, 2); a1 = __builtin_amdgcn_cvt_scalef32_pk_fp4_f32(a1, 1.0f, 1.0f, 1.0f, 3);
      unsigned b1 = (unsigned)__builtin_amdgcn_cvt_pk_fp8_f32(1.0f, 1.0f, 0, false); b1 = (unsigned)__builtin_amdgcn_cvt_pk_fp8_f32(1.0f, 1.0f, (int)b1, true);
      const v8i_t av = {(int)a1, (int)a1, (int)a1, (int)a1, 0, 0, 0, 0}, bv = {(int)b1, (int)b1, (int)b1, (int)b1, (int)b1, (int)b1, (int)b1, (int)b1};
      const f32x4 c = __builtin_amdgcn_mfma_scale_f32_16x16x128_f8f6f4(av, bv, (f32x4){0.f, 0.f, 0.f, 0.f}, 4, 0, 0, 0x7F7F7F7F, 0, 0x7F7F7F7F);
      calib = 128.0f / c[0] * (1.0f / X8SCALE); }
    for (size_t i = (size_t)blockIdx.x * NTHR + tid; i < n4; i += nth) {
        f32x4 d = __builtin_nontemporal_load((const f32x4*)PB + i);
#pragma unroll
        for (int s2 = 1; s2 < 4; ++s2) d += __builtin_nontemporal_load((const f32x4*)PB + (size_t)s2 * n4 + i);
        const f32x4 g = __builtin_nontemporal_load((const f32x4*)GATE + i); const u32x2 ew = __builtin_nontemporal_load((const u32x2*)EIDX + i);
        const unsigned e[4] = {ew.x & 0xffffu, ew.x >> 16, ew.y & 0xffffu, ew.y >> 16}; float o[4];
        const float cr = calib / sqrtf(SS[i >> 5] * (1.0f / DM) + EPS);
#pragma unroll
        for (int j = 0; j < 4; ++j) { const float z = d[j] * su_l[e[j]] * cr; o[j] = 0.5f * z * (1.0f + erff(z * 0.70710678118654752f)) * g[j] * sv_l[e[j]]; }
        unsigned w8 = (unsigned)__builtin_amdgcn_cvt_pk_fp8_f32(o[0] * A8SCALE, o[1] * A8SCALE, 0, false); w8 = (unsigned)__builtin_amdgcn_cvt_pk_fp8_f32(o[2] * A8SCALE, o[3] * A8SCALE, (int)w8, true); AB[i] = w8;
    }
}
typedef int v2i_t __attribute__((ext_vector_type(2)));
constexpr int VROW = 144, VIMG = 128 * VROW;
struct VRec { u32x4 a8[2]; u32x2 h; };
__device__ __forceinline__ void v_token(const u32x4 (&w)[16], const VRec& rc, LAS unsigned char* vl  , float oscale, int lane, float* dst  , bool do_store) {
    const int seg = lane >> 3, c8 = lane & 7, i16 = lane & 15, q = lane >> 4;
#pragma unroll
    for (int j = 0; j < 16; ++j) *(LAS u32x4*)(vl + (seg * 16 + j) * VROW + c8 * 16) = w[j];
    asm volatile("s_waitcnt lgkmcnt(0)" ::: "memory");
    const v8i_t av = {(int)rc.a8[0].x, (int)rc.a8[0].y, (int)rc.a8[0].z, (int)rc.a8[0].w, (int)rc.a8[1].x, (int)rc.a8[1].y, (int)rc.a8[1].z, (int)rc.a8[1].w};
    const LAS unsigned char* rp = vl + (32 * q + i16) * VROW;
    float val[4] = {0.f, 0.f, 0.f, 0.f};
#pragma unroll
    for (int cb = 0; cb < 16; ++cb) {
        const v2i_t r1 = __builtin_amdgcn_ds_read_tr4_b64_v2i32((LAS v2i_t*)(rp + cb * 8)), r2 = __builtin_amdgcn_ds_read_tr4_b64_v2i32((LAS v2i_t*)(rp + 16 * VROW + cb * 8));
        const v8i_t bv = {r1.x, r1.y, r2.x, r2.y, 0, 0, 0, 0};
        const f32x4 acc = __builtin_amdgcn_mfma_scale_f32_16x16x128_f8f6f4(av, bv, (f32x4){0.f, 0.f, 0.f, 0.f}, 0  , 4  , 0, 0x7F7F7F7F, 0, 0x7F7F7F7F);
        const float a0 = acc[0]; val[cb & 3] = (q == (cb >> 2)) ? a0 : val[cb & 3];
    }
    asm volatile("s_waitcnt lgkmcnt(0)" ::: "memory");
    if (do_store) {
        *(GAS f32x4*)(sgpr_ptr((unsigned char*)dst) + (unsigned)lane * 16u) = (f32x4){bflo(rc.h.x) + val[0] * oscale, bfhi(rc.h.x) + val[1] * oscale, bflo(rc.h.y) + val[2] * oscale, bfhi(rc.h.y) + val[3] * oscale};
    } else asm volatile("" :: "v"(val[0]), "v"(val[1]), "v"(val[2]), "v"(val[3]));
}
__device__ __forceinline__ void p8b_v(const Args& a, unsigned char* lds, int lane, int wave, bool do_store) {
    const unsigned short* EIDX = (const unsigned short*)(a.ws + WS_EI); const unsigned char* AB = a.ws + WS_AB; const bf16_t* HB = (const bf16_t*)(a.ws + WS_HB);
    PEER_GEOM();
    const int seg = lane >> 3, c8 = lane & 7, q = lane >> 4;
    const unsigned char* Ts = a.ws + WS_UT + (size_t)(4 + s4) * SLICE4; const unsigned loff = c8 * 16;
    LAS unsigned char* vl = (LAS unsigned char*)lds + wave * VIMG;
    float oscale;
    { unsigned a1 = 0u; a1 = __builtin_amdgcn_cvt_scalef32_pk_fp4_f32(a1, 1.0f, 1.0f, 1.0f, 0); a1 = __builtin_amdgcn_cvt_scalef32_pk_fp4_f32(a1, 1.0f, 1.0f, 1.0f, 1);
      a1 = __builtin_amdgcn_cvt_scalef32_pk_fp4_f32(a1, 1.0f, 1.0f, 1.0f, 2); a1 = __builtin_amdgcn_cvt_scalef32_pk_fp4_f32(a1, 1.0f, 1.0f, 1.0f, 3);
      unsigned b1 = (unsigned)__builtin_amdgcn_cvt_pk_fp8_f32(1.0f, 1.0f, 0, false); b1 = (unsigned)__builtin_amdgcn_cvt_pk_fp8_f32(1.0f, 1.0f, (int)b1, true);
      const v8i_t av = {(int)b1, (int)b1, (int)b1, (int)b1, (int)b1, (int)b1, (int)b1, (int)b1}, bv = {(int)a1, (int)a1, (int)a1, (int)a1, 0, 0, 0, 0};
      const f32x4 c = __builtin_amdgcn_mfma_scale_f32_16x16x128_f8f6f4(av, bv, (f32x4){0.f, 0.f, 0.f, 0.f}, 0, 4, 0, 0x7F7F7F7F, 0, 0x7F7F7F7F);
      oscale = 128.0f / c[0] * (1.0f / A8SCALE); }
    const unsigned aoff = (unsigned)q * 16u, hoff = (unsigned)(s4 * 256 + 4 * lane) * 2u;
#define REC_LOAD(R, t) do { const GAS unsigned char* ab_ = sgpr_ptr(AB + (size_t)(t) * 128); R.a8[0] = __builtin_nontemporal_load((const GAS u32x4*)(ab_ + aoff)); R.a8[1] = __builtin_nontemporal_load((const GAS u32x4*)(ab_ + (64u + aoff))); \
        R.h = __builtin_nontemporal_load((const GAS u32x2*)(sgpr_ptr((const unsigned char*)(HB + (size_t)(t) * DM)) + hoff)); } while (0)
    PMeta mA, mB; u32x4 wA[16], wB[16]; VRec rA, rB;
    pm_load(mA, EIDX, TCL(t_beg), seg); pm_load(mB, EIDX, TCL(t_beg + NWQ), seg);
    rows16_load(wA, Ts, loff, mA); REC_LOAD(rA, TCL(t_beg));
    pm_load(mA, EIDX, TCL(t_beg + 2 * NWQ), seg);
    for (int t = t_beg; t < t_end; t += 2 * NWQ) {
        SCHED_FENCE();
        rows16_load(wB, Ts, loff, mB); REC_LOAD(rB, TCL(t + NWQ)); pm_load(mB, EIDX, TCL(t + 3 * NWQ), seg);
        SCHED_FENCE();
        v_token(wA, rA, vl, oscale, lane, a.out + (size_t)t * DM + s4 * 256, do_store);
        SCHED_FENCE();
        rows16_load(wA, Ts, loff, mA); REC_LOAD(rA, TCL(t + 2 * NWQ)); pm_load(mA, EIDX, TCL(t + 4 * NWQ), seg);
        SCHED_FENCE();
        if (t + NWQ < t_end) v_token(wB, rB, vl, oscale, lane, a.out + (size_t)(t + NWQ) * DM + s4 * 256, do_store);
    }
#undef REC_LOAD
#undef TCL
#undef PEER_GEOM
}

namespace pg8 {
#define PG8_LAS __attribute__((address_space(3)))
typedef unsigned short bf16_t;
typedef short bf16x8 __attribute__((ext_vector_type(8)));
typedef float f32x4 __attribute__((ext_vector_type(4)));
typedef unsigned u32x4 __attribute__((ext_vector_type(4)));
typedef int v4i_t __attribute__((ext_vector_type(4))); typedef int v8i_t __attribute__((ext_vector_type(8)));
constexpr int BM = 256, BK = 64, HALF = 128, HTB = HALF * BK * 2  , STAGE_BYTES = 8 * HTB, NXCD = 8, WGM = 8;

__host__ __device__ __forceinline__ int lds_byte(int r, int c) { const int st = (r >> 4) * 2 + (c >> 5), rr = r & 15, cc = c & 31, ob = rr * 64 + cc * 2; return st * 1024 + (ob ^ (((ob >> 9) & 1) << 5)); }
__host__ __device__ __forceinline__ void stage_rc(int b, int& R, int& C) { const int st = b / 1024, sb = b % 1024, swz = sb ^ (((sb >> 9) & 1) << 5); R = (st >> 1) * 16 + swz / 64; C = (st & 1) * 32 + (swz % 64) / 2; }
__host__ __device__ __forceinline__ int perm32(int rho) { const int n = rho >> 4, i = rho & 15; return 8 * (i >> 2) + 4 * n + (i & 3); }

struct Unit { int pm, pn; };
struct Gemm { const bf16_t* A; const bf16_t* Bt; int M, N, K; };

struct StaticOrder {
    int nM, nN, nwg, G, c;
    __host__ __device__ void init(int M, int N, int G_, int c_) { nM = M / BM; nN = N / BM; nwg = nM * nN; G = G_; c = c_; }
    __host__ __device__ bool next(int i, Unit& u) const {
        const long L = (long)i * G + c; if (L >= nwg) return false;
        int wgid = (int)L; { const int q = nwg / NXCD, r = nwg % NXCD, xcd = wgid % NXCD, off = wgid / NXCD; wgid = (xcd < r ? xcd * (q + 1) : r * (q + 1) + (xcd - r) * q) + off; }
        const int nig = WGM * nN, gid = wgid / nig, fm = gid * WGM, gsz = (nM - fm) < WGM ? (nM - fm) : WGM;
        u.pm = fm + ((wgid % nig) % gsz); u.pn = (wgid % nig) / gsz; return true;
    }
    __device__ __forceinline__ void a_ready(const Unit&) const {}
    __device__ __forceinline__ void done(const Unit&) const {}
};


__device__ __forceinline__ unsigned cvt_pk_bf16(float lo, float hi) { unsigned r; asm volatile("v_cvt_pk_bf16_f32 %0, %1, %2" : "=v"(r) : "v"(lo), "v"(hi)); return r; }
struct EpiInProj {
    static constexpr bool PERM = true, AFTER_DRAIN = false;
    bf16_t* O; bf16_t* QB; bf16_t* KB; bf16_t* VB; const float* rope; const float* qg; const float* kg;
    template <bool NORM> __device__ __forceinline__ void head_row(f32x4 a00, f32x4 a01, f32x4 a10, f32x4 a11, const float* g0, const float* g1, int t, int fq, bf16_t* dst  ) const {
        float x0[8] = {a00[0], a00[1], a00[2], a00[3], a01[0], a01[1], a01[2], a01[3]}, x1[8] = {a10[0], a10[1], a10[2], a10[3], a11[0], a11[1], a11[2], a11[3]};
        if (NORM) {
            float ss = 0.f;
#pragma unroll
            for (int e = 0; e < 8; ++e) ss += x0[e] * x0[e] + x1[e] * x1[e];
            ss += __shfl_xor(ss, 16); ss += __shfl_xor(ss, 32);
            const float rstd = 1.0f / sqrtf(ss * (1.0f / 64.0f) + 1e-6f);
            const float* r0 = rope + (((t >> 6) * 16 + (fq & 1) * 8) * 2); const float* r1 = rope + (((t & 63) * 16 + (fq & 1) * 8) * 2);
            f32x4 c0[4], c1[4];
#pragma unroll
            for (int q4 = 0; q4 < 4; ++q4) { c0[q4] = *(const f32x4*)(r0 + 4 * q4); c1[q4] = *(const f32x4*)(r1 + 4 * q4); }
#pragma unroll
            for (int e = 0; e < 8; ++e) { x0[e] *= rstd * g0[e]; x1[e] *= rstd * g1[e]; }
#pragma unroll
            for (int e = 0; e < 8; ++e) { const float o0 = __shfl_xor(x0[e], 32), o1 = __shfl_xor(x1[e], 32);
                const float cs0 = c0[e >> 1][(e & 1) * 2], sn0 = c0[e >> 1][(e & 1) * 2 + 1], cs1 = c1[e >> 1][(e & 1) * 2], sn1 = c1[e >> 1][(e & 1) * 2 + 1];
                x0[e] = (fq & 2) ? x0[e] * cs0 + o0 * sn0 : x0[e] * cs0 - o0 * sn0; x1[e] = (fq & 2) ? x1[e] * cs1 + o1 * sn1 : x1[e] * cs1 - o1 * sn1; }
        }
        u32x4 w; w.x = cvt_pk_bf16(x0[0], x0[1]); w.y = cvt_pk_bf16(x0[2], x0[3]); w.z = cvt_pk_bf16(x0[4], x0[5]); w.w = cvt_pk_bf16(x0[6], x0[7]); *(u32x4*)dst = w;
        w.x = cvt_pk_bf16(x1[0], x1[1]); w.y = cvt_pk_bf16(x1[2], x1[3]); w.z = cvt_pk_bf16(x1[4], x1[5]); w.w = cvt_pk_bf16(x1[6], x1[7]); *(u32x4*)(dst + 32) = w;
    }
    __device__ __forceinline__ void operator()(const f32x4 (&acc)[2][2][4][2], const Unit& u, int wr, int wc, int fr, int fq) const {
        const int row0 = u.pm * BM + wr * 64 + fr, pn = u.pn;
        if (pn < 2) {
            const int col0 = 256 * pn + wc * 32 + 8 * fq;
#pragma unroll
            for (int ai = 0; ai < 2; ++ai)
#pragma unroll
                for (int m = 0; m < 4; ++m) { bf16_t* rowp = O + (size_t)(row0 + ai * HALF + m * 16) * 1024 + col0;
#pragma unroll
                    for (int bj = 0; bj < 2; ++bj) { const f32x4 v0 = acc[ai][bj][m][0], v1 = acc[ai][bj][m][1];
                        u32x4 w; w.x = cvt_pk_bf16(v0[0], v0[1]); w.y = cvt_pk_bf16(v0[2], v0[3]); w.z = cvt_pk_bf16(v1[0], v1[1]); w.w = cvt_pk_bf16(v1[2], v1[3]);
                        *(u32x4*)(rowp + bj * HALF) = w; } }
        } else if (pn < 6) {
            const int col0 = 512 + 128 * (pn - 2) + wc * 32 + 8 * fq;
#pragma unroll
            for (int ai = 0; ai < 2; ++ai)
#pragma unroll
                for (int m = 0; m < 4; ++m) { const f32x4 v0 = acc[ai][0][m][0] * acc[ai][1][m][0], v1 = acc[ai][0][m][1] * acc[ai][1][m][1];
                    u32x4 w; w.x = cvt_pk_bf16(v0[0], v0[1]); w.y = cvt_pk_bf16(v0[2], v0[3]); w.z = cvt_pk_bf16(v1[0], v1[1]); w.w = cvt_pk_bf16(v1[2], v1[3]);
                    *(u32x4*)(O + (size_t)(row0 + ai * HALF + m * 16) * 1024 + col0) = w; }
        } else if (pn < 8) {
            float g0[8], g1[8];
#pragma unroll
            for (int e = 0; e < 8; ++e) { g0[e] = qg[8 * fq + e] * C2; g1[e] = qg[32 + 8 * fq + e] * C2; }
            const int hh = 4 * (pn - 6) + wc;
#pragma unroll
            for (int ai = 0; ai < 2; ++ai)
#pragma unroll
                for (int m = 0; m < 4; ++m) { const int r = row0 + ai * HALF + m * 16;
                    head_row<true>(acc[ai][0][m][0], acc[ai][0][m][1], acc[ai][1][m][0], acc[ai][1][m][1], g0, g1, r & 2047, fq, QB + (size_t)r * 512 + hh * 64 + 8 * fq); }
        } else {
            float g0[8], g1[8];
#pragma unroll
            for (int e = 0; e < 8; ++e) { g0[e] = kg[8 * fq + e]; g1[e] = kg[32 + 8 * fq + e]; }
            const int g = wc & 1;
#pragma unroll
            for (int ai = 0; ai < 2; ++ai)
#pragma unroll
                for (int m = 0; m < 4; ++m) { const int r = row0 + ai * HALF + m * 16, b = r >> 11, t = r & 2047; const size_t krow = ((size_t)(b * 2 + g) * KROWS + t) * 64 + 8 * fq;
                    if (wc < 2) head_row<true>(acc[ai][0][m][0], acc[ai][0][m][1], acc[ai][1][m][0], acc[ai][1][m][1], g0, g1, t, fq, KB + krow);
                    else head_row<false>(acc[ai][0][m][0], acc[ai][0][m][1], acc[ai][1][m][0], acc[ai][1][m][1], g0, g1, t, fq, VB + krow); }
        }
    }
};
struct EpiBf16 {
    static constexpr bool PERM = true, AFTER_DRAIN = false;
    bf16_t* O; int ldc; float scale;
    __device__ __forceinline__ void operator()(const f32x4 (&acc)[2][2][4][2], const Unit& u, int wr, int wc, int fr, int fq) const {
        const int row0 = u.pm * BM + wr * 64 + fr; const int col0 = u.pn * BM + wc * 32 + 8 * fq;
#pragma unroll
        for (int ai = 0; ai < 2; ++ai)
#pragma unroll
            for (int m = 0; m < 4; ++m) { bf16_t* rowp = O + (size_t)(row0 + ai * HALF + m * 16) * ldc + col0;
#pragma unroll
                for (int bj = 0; bj < 2; ++bj) { const f32x4 v0 = acc[ai][bj][m][0] * scale, v1 = acc[ai][bj][m][1] * scale;
                    u32x4 w; w.x = cvt_pk_bf16(v0[0], v0[1]); w.y = cvt_pk_bf16(v0[2], v0[3]); w.z = cvt_pk_bf16(v1[0], v1[1]); w.w = cvt_pk_bf16(v1[2], v1[3]);
                    *(u32x4*)(rowp + bj * HALF) = w; } }
    }
};
struct EpiResidNorm {
    static constexpr bool PERM = true, AFTER_DRAIN = false;
    const float* xp; const float* xs; float* out; int split_row; bf16_t* hb; unsigned char* h8; float* ss; float x8scale;
    __device__ __forceinline__ const float* xrow(int r, int col0) const { return (r < split_row ? xp + (size_t)r * 1024 : xs + (size_t)(r - split_row) * 1024) + col0; }
    __device__ __forceinline__ void operator()(const f32x4 (&acc)[2][2][4][2], const Unit& u, int wr, int wc, int fr, int fq) const {
        const int col0 = u.pn * BM + wc * 32 + 8 * fq, rbase = u.pm * BM + wr * 64 + fr;
        f32x4 xv[4][2][2];
#pragma unroll
        for (int m = 0; m < 4; ++m) { const float* xr = xrow(rbase + m * 16, col0);
#pragma unroll
            for (int bj = 0; bj < 2; ++bj) { xv[m][bj][0] = *(const f32x4*)(xr + bj * HALF); xv[m][bj][1] = *(const f32x4*)(xr + bj * HALF + 4); } }
#pragma unroll
        for (int ai = 0; ai < 2; ++ai)
#pragma unroll
            for (int m = 0; m < 4; ++m) { const int r = rbase + ai * HALF + m * 16;
                bf16_t* brow = hb + (size_t)r * 1024 + col0; unsigned char* qrow = h8 + (size_t)r * 1024 + col0; float s = 0.f;
                f32x4 h[2][2];
#pragma unroll
                for (int bj = 0; bj < 2; ++bj) { h[bj][0] = xv[m][bj][0] + acc[ai][bj][m][0]; h[bj][1] = xv[m][bj][1] + acc[ai][bj][m][1]; }
                if (ai == 0) { const float* xr = xrow(r + HALF, col0);
#pragma unroll
                    for (int bj = 0; bj < 2; ++bj) { xv[m][bj][0] = *(const f32x4*)(xr + bj * HALF); xv[m][bj][1] = *(const f32x4*)(xr + bj * HALF + 4); } }
#pragma unroll
                for (int bj = 0; bj < 2; ++bj) { const f32x4 h0 = h[bj][0], h1 = h[bj][1];
                    u32x4 wb; wb.x = cvt_pk_bf16(h0[0], h0[1]); wb.y = cvt_pk_bf16(h0[2], h0[3]); wb.z = cvt_pk_bf16(h1[0], h1[1]); wb.w = cvt_pk_bf16(h1[2], h1[3]); *(u32x4*)(brow + bj * HALF) = wb;
                    unsigned w0 = (unsigned)__builtin_amdgcn_cvt_pk_fp8_f32(h0[0] * x8scale, h0[1] * x8scale, 0, false); w0 = (unsigned)__builtin_amdgcn_cvt_pk_fp8_f32(h0[2] * x8scale, h0[3] * x8scale, (int)w0, true);
                    unsigned w1 = (unsigned)__builtin_amdgcn_cvt_pk_fp8_f32(h1[0] * x8scale, h1[1] * x8scale, 0, false); w1 = (unsigned)__builtin_amdgcn_cvt_pk_fp8_f32(h1[2] * x8scale, h1[3] * x8scale, (int)w1, true);
                    *(u32x2*)(qrow + bj * HALF) = (u32x2){w0, w1};
                    s += ((h0[0] * h0[0] + h0[1] * h0[1]) + (h0[2] * h0[2] + h0[3] * h0[3])) + ((h1[0] * h1[0] + h1[1] * h1[1]) + (h1[2] * h1[2] + h1[3] * h1[3])); }
                s += __shfl_xor(s, 16); s += __shfl_xor(s, 32);
                if (fq == 0) atomicAdd(ss + r, s); }
    }
};
struct EpiResid {
    static constexpr bool PERM = false, AFTER_DRAIN = false;
    const float* xp; const float* xs; float* out; int split_row;
    __device__ __forceinline__ void operator()(const f32x4 (&acc)[2][2][4][2], const Unit& u, int wr, int wc, int fr, int fq) const {
        const int col0 = u.pn * BM + wc * 32 + 4 * fq;
#pragma unroll
        for (int ai = 0; ai < 2; ++ai)
#pragma unroll
            for (int m = 0; m < 4; ++m) { const int r = u.pm * BM + ai * HALF + wr * 64 + m * 16 + fr;
                const float* xr = (r < split_row ? xp + (size_t)r * 1024 : xs + (size_t)(r - split_row) * 1024) + col0; float* orow = out + (size_t)r * 1024 + col0;
#pragma unroll
                for (int bj = 0; bj < 2; ++bj)
#pragma unroll
                    for (int n = 0; n < 2; ++n) { const f32x4 bs = *(const f32x4*)(xr + bj * HALF + n * 16); *(f32x4*)(orow + bj * HALF + n * 16) = bs + acc[ai][bj][m][n]; } }
    }
};

template <class Epi, class Sched, bool ALIGN_EPI = false, bool SP2 = false, bool FP8 = false>
__device__ __forceinline__ void gemm_phase(PG8_LAS unsigned char* lds, const Gemm g, const Sched& S, const Epi& E) {
    const int tid = threadIdx.x, wid = __builtin_amdgcn_readfirstlane(tid >> 6), lane = tid & 63, wr = wid >> 2, wc = wid & 3, fr = lane & 15, fq = lane >> 4;
    const int K = g.K, nt = K / BK;
    unsigned voffA[2], voffB[2];
#pragma unroll
    for (int i = 0; i < 2; ++i) { int R, C; stage_rc(tid * 16 + i * 8192, R, C); const int Rb = Epi::PERM ? ((R & ~31) + perm32(R & 31)) : R;
        voffA[i] = (unsigned)(R * K + C) * 2u; voffB[i] = (unsigned)(Rb * K + C) * 2u; }
    const size_t kstep = (size_t)(BK * 2);
    const size_t hstep = (size_t)HALF * K * 2;
    const size_t tstep = 2 * hstep;
    const unsigned ldsw = (unsigned)wid * 1024u;
    const int aoff = lds_byte(wr * 64 + fr, fq * 8), boff = lds_byte(wc * 32 + fr, fq * 8);
#define PG8_SA(b, h) (((b) * 2 + (h)) * HTB)
#define PG8_SB(b, h) ((4 + (b) * 2 + (h)) * HTB)
#define PG8_STAGE(bufoff, gbase, voff) do { _Pragma("unroll") for (int _i = 0; _i < 2; ++_i) \
        __builtin_amdgcn_global_load_lds((const unsigned*)((const char*)(gbase) + (voff)[_i]), (PG8_LAS unsigned*)(lds + (bufoff) + ldsw + _i * 8192), 16, 0, 0); } while (0)
#define PG8_LDA(dst, b, h) do { if constexpr (FP8) { _Pragma("unroll") for (int m = 0; m < 4; ++m) dst##8[m] = __builtin_shufflevector(*(const PG8_LAS v4i_t*)(lds + PG8_SA(b, h) + aoff + m * 2048), *(const PG8_LAS v4i_t*)(lds + PG8_SA(b, h) + aoff + m * 2048 + 1024), 0, 1, 2, 3, 4, 5, 6, 7); } \
        else { _Pragma("unroll") for (int m = 0; m < 4; ++m) _Pragma("unroll") for (int k = 0; k < 2; ++k) dst[m][k] = *(const PG8_LAS bf16x8*)(lds + PG8_SA(b, h) + aoff + m * 2048 + k * 1024); } } while (0)
#define PG8_LDB(dst, b, h) do { if constexpr (FP8) { _Pragma("unroll") for (int n = 0; n < 2; ++n) dst##8[n] = __builtin_shufflevector(*(const PG8_LAS v4i_t*)(lds + PG8_SB(b, h) + boff + n * 2048), *(const PG8_LAS v4i_t*)(lds + PG8_SB(b, h) + boff + n * 2048 + 1024), 0, 1, 2, 3, 4, 5, 6, 7); } \
        else { _Pragma("unroll") for (int n = 0; n < 2; ++n) _Pragma("unroll") for (int k = 0; k < 2; ++k) dst[n][k] = *(const PG8_LAS bf16x8*)(lds + PG8_SB(b, h) + boff + n * 2048 + k * 1024); } } while (0)
#define PG8_MMA(ai, bj, At, Bt) do { __builtin_amdgcn_s_setprio(1); _Pragma("unroll") for (int m = 0; m < 4; ++m) _Pragma("unroll") for (int n = 0; n < 2; ++n) { \
        if constexpr (FP8) { asm volatile("v_mfma_scale_f32_16x16x128_f8f6f4 %0, %1, %2, %0, %3, %3 op_sel_hi:[0,0,0]" : "+v"(acc[ai][bj][m][n]) : "v"(Bt##8[n]), "v"(At##8[m]), "v"(mfma_one)); } \
        else { _Pragma("unroll") for (int k = 0; k < 2; ++k) acc[ai][bj][m][n] = __builtin_amdgcn_mfma_f32_16x16x32_bf16(Bt[n][k], At[m][k], acc[ai][bj][m][n], 0, 0, 0); } } __builtin_amdgcn_s_setprio(0); } while (0)
#define PG8_WAIT_V(n) asm volatile("s_waitcnt vmcnt(" #n ")" ::: "memory")
#define PG8_WAIT_L(n) asm volatile("s_waitcnt lgkmcnt(" #n ")" ::: "memory")
#define PG8_BAR __builtin_amdgcn_s_barrier()
#define PG8_SCHED __builtin_amdgcn_sched_barrier(0)
    Unit cur, nxt; int ui = 0;
    if (!S.next(0, cur)) return;
    f32x4 acc[2][2][4][2];
#pragma unroll
    for (int a = 0; a < 2; ++a)
#pragma unroll
        for (int b = 0; b < 2; ++b)
#pragma unroll
            for (int m = 0; m < 4; ++m)
#pragma unroll
                for (int n = 0; n < 2; ++n) acc[a][b][m][n] = (f32x4){0.f, 0.f, 0.f, 0.f};
    const int mfma_one = 0x7F7F7F7F;
    bf16x8 At[4][2], B0[2][2], B1[2][2]; v8i_t At8[4], B08[2], B18[2];
    const char* cA = (const char*)g.A + (size_t)cur.pm * tstep; const char* cB = (const char*)g.Bt + (size_t)cur.pn * tstep;
    S.a_ready(cur);
    if constexpr (SP2) {
        PG8_STAGE(PG8_SB(0, 0), cB, voffB); PG8_STAGE(PG8_SB(0, 1), cB + hstep, voffB); PG8_STAGE(PG8_SA(0, 0), cA, voffA); PG8_STAGE(PG8_SA(0, 1), cA + hstep, voffA);
        if (wr == 1) PG8_BAR;
        PG8_WAIT_V(2); PG8_BAR;
        PG8_STAGE(PG8_SB(1, 0), cB + kstep, voffB); PG8_STAGE(PG8_SA(1, 0), cA + kstep, voffA); PG8_STAGE(PG8_SB(1, 1), cB + hstep + kstep, voffB);
        PG8_WAIT_V(6); PG8_BAR;
    } else {
        PG8_STAGE(PG8_SB(0, 0), cB, voffB); PG8_STAGE(PG8_SA(0, 0), cA, voffA); PG8_STAGE(PG8_SB(0, 1), cB + hstep, voffB); PG8_STAGE(PG8_SA(0, 1), cA + hstep, voffA);
        if (wr == 1) PG8_BAR;
        PG8_WAIT_V(4); PG8_BAR;
        PG8_STAGE(PG8_SB(1, 0), cB + kstep, voffB); PG8_STAGE(PG8_SA(1, 0), cA + kstep, voffA); PG8_STAGE(PG8_SB(1, 1), cB + hstep + kstep, voffB);
        PG8_WAIT_V(6); PG8_BAR;
    }
    for (;;) {
        const bool has_next = S.next(ui + 1, nxt);
        const char* nA = has_next ? (const char*)g.A + (size_t)nxt.pm * tstep : cA; const char* nB = has_next ? (const char*)g.Bt + (size_t)nxt.pn * tstep : cB;
#pragma nounroll
        for (int t = 0; t < nt; t += 2) {
            const bool last = (t == nt - 2);
            const char* a1 = cA + (size_t)(t + 1) * kstep;
            const char* a2 = last ? nA : cA + (size_t)(t + 2) * kstep; const char* b2 = last ? nB : cB + (size_t)(t + 2) * kstep;
            const char* a3 = a2 + kstep; const char* b3 = b2 + kstep;
            if (last && has_next) S.a_ready(nxt);
            if constexpr (SP2) {
            PG8_LDB(B0, 0, 0); PG8_LDB(B1, 0, 1); PG8_SCHED; PG8_LDA(At, 0, 0); PG8_STAGE(PG8_SA(1, 1), a1 + hstep, voffA);
            PG8_WAIT_V(8); PG8_WAIT_L(0); PG8_BAR; PG8_MMA(0, 0, At, B0); PG8_MMA(0, 1, At, B1); PG8_BAR; PG8_SCHED;
            PG8_LDA(At, 0, 1); PG8_STAGE(PG8_SB(0, 0), b2, voffB); PG8_STAGE(PG8_SB(0, 1), b2 + hstep, voffB); PG8_STAGE(PG8_SA(0, 0), a2, voffA);
            PG8_WAIT_V(8); PG8_WAIT_L(0); PG8_BAR; PG8_MMA(1, 0, At, B0); PG8_MMA(1, 1, At, B1); PG8_BAR; PG8_SCHED;
            PG8_LDB(B0, 1, 0); PG8_LDB(B1, 1, 1); PG8_SCHED; PG8_LDA(At, 1, 0); PG8_STAGE(PG8_SA(0, 1), a2 + hstep, voffA);
            PG8_WAIT_V(8); PG8_WAIT_L(0); PG8_BAR; PG8_MMA(0, 0, At, B0); PG8_MMA(0, 1, At, B1); PG8_BAR; PG8_SCHED;
            PG8_LDA(At, 1, 1); PG8_STAGE(PG8_SB(1, 0), b3, voffB); PG8_STAGE(PG8_SB(1, 1), b3 + hstep, voffB); PG8_STAGE(PG8_SA(1, 0), a3, voffA);
            PG8_WAIT_V(8); PG8_WAIT_L(0); PG8_BAR; PG8_MMA(1, 0, At, B0); PG8_MMA(1, 1, At, B1); PG8_BAR; PG8_SCHED;
            } else {
            PG8_LDB(B0, 0, 0); PG8_SCHED; PG8_LDA(At, 0, 0); PG8_STAGE(PG8_SA(1, 1), a1 + hstep, voffA);
            PG8_WAIT_L(8); PG8_BAR; PG8_WAIT_L(0); PG8_MMA(0, 0, At, B0); PG8_BAR; PG8_SCHED;
            PG8_LDB(B1, 0, 1); PG8_STAGE(PG8_SB(0, 0), b2, voffB);
            PG8_BAR; PG8_WAIT_L(0); PG8_MMA(0, 1, At, B1); PG8_BAR;
            PG8_LDA(At, 0, 1); PG8_STAGE(PG8_SA(0, 0), a2, voffA);
            PG8_BAR; PG8_WAIT_L(0); PG8_MMA(1, 0, At, B0); PG8_BAR; PG8_SCHED;
            PG8_STAGE(PG8_SB(0, 1), b2 + hstep, voffB);
            PG8_WAIT_V(6); PG8_BAR; PG8_MMA(1, 1, At, B1); PG8_BAR;
            PG8_LDB(B0, 1, 0); PG8_SCHED; PG8_LDA(At, 1, 0); PG8_STAGE(PG8_SA(0, 1), a2 + hstep, voffA);
            PG8_WAIT_L(8); PG8_BAR; PG8_WAIT_L(0); PG8_MMA(0, 0, At, B0); PG8_BAR; PG8_SCHED;
            PG8_LDB(B1, 1, 1); PG8_STAGE(PG8_SB(1, 0), b3, voffB);
            PG8_BAR; PG8_WAIT_L(0); PG8_MMA(0, 1, At, B1); PG8_BAR;
            PG8_LDA(At, 1, 1); PG8_STAGE(PG8_SA(1, 0), a3, voffA);
            PG8_BAR; PG8_WAIT_L(0); PG8_MMA(1, 0, At, B0); PG8_BAR; PG8_SCHED;
            PG8_STAGE(PG8_SB(1, 1), b3 + hstep, voffB);
            PG8_WAIT_V(6); PG8_BAR; PG8_MMA(1, 1, At, B1); PG8_BAR;
            }
        }
        if constexpr (ALIGN_EPI) { if (wr == 0) PG8_BAR; }
        if constexpr (FP8) asm volatile("s_nop 15\n\ts_nop 15" ::: "memory");
        if constexpr (!Epi::AFTER_DRAIN) { E(acc, cur, wr, wc, fr, fq); S.done(cur); }
        if (!has_next) break;
#pragma unroll
        for (int a = 0; a < 2; ++a)
#pragma unroll
            for (int b = 0; b < 2; ++b)
#pragma unroll
                for (int m = 0; m < 4; ++m)
#pragma unroll
                    for (int n = 0; n < 2; ++n) acc[a][b][m][n] = (f32x4){0.f, 0.f, 0.f, 0.f};
        if constexpr (FP8) asm volatile("s_nop 7" ::: "memory");
        cur = nxt; cA = nA; cB = nB; ++ui;
        if constexpr (ALIGN_EPI) { if (wr == 1) PG8_BAR; }
    }
    PG8_WAIT_V(0);
    if constexpr (!ALIGN_EPI) { if (wr == 0) PG8_BAR; }
    PG8_BAR;
    if constexpr (Epi::AFTER_DRAIN) { E.fused(acc, cur, wr, wc, fr, fq, lds, wid, lane); S.done(cur); }
#undef PG8_SA
#undef PG8_SB
#undef PG8_STAGE
#undef PG8_LDA
#undef PG8_LDB
#undef PG8_MMA
#undef PG8_WAIT_V
#undef PG8_WAIT_L
#undef PG8_BAR
#undef PG8_SCHED
}
}


#include <hip/hip_bf16.h>
#include <cmath>
namespace attn_body {
using bf16=__hip_bfloat16;
using bf16x8=__attribute__((ext_vector_type(8)))short;
using s16x4=__attribute__((ext_vector_type(4)))short;
using f32x16=__attribute__((ext_vector_type(16)))float;
using u32x4=__attribute__((ext_vector_type(4)))unsigned;
constexpr int SEQ=2048,D=64,QP=512,KVP=64,OP=1024,KVROWS=2112;
constexpr int NW=8,QBLK=32,QB=QBLK*NW,KVBLK=64,NQB=SEQ/QB,NT=KVROWS/KVBLK;
constexpr int ATTN_UNIT_ROWS=QB;
__device__ __forceinline__ int crow(int r,int hi){return (r&3)+8*(r>>2)+4*hi;}
#define SBAR() __builtin_amdgcn_sched_barrier(0)
__device__ __forceinline__ void tmask(f32x16&p0,f32x16&p1){
  const float NEG=-INFINITY;
  #pragma unroll
  for(int r=8;r<16;++r)p0[r]=NEG;
  #pragma unroll
  for(int r=0;r<16;++r)p1[r]=NEG;
}

constexpr int NSLOT=3, SLOTB=8192;
constexpr int LDS_K=0, LDS_V=NSLOT*SLOTB, LDS_WS=2*NSLOT*SLOTB, LDS_OST=LDS_WS+NW*64*4, LDS_BYTES=LDS_OST+NW*4096;
constexpr float C2=0.125f*1.4426950408889634f;
__device__ __forceinline__ void glds16(const void*gsrc,unsigned lds_dst){unsigned keep;
  asm volatile("s_mov_b32 %0, m0\n\ts_mov_b32 m0, %2\n\ts_nop 0\n\tglobal_load_lds_dwordx4 %1, off\n\ts_mov_b32 m0, %0":"=&s"(keep):"v"(gsrc),"s"(lds_dst):"memory");}
__device__ __forceinline__ float max3f(float a,float b,float c){float r;asm("v_max3_f32 %0, %1, %2, %3":"=v"(r):"v"(a),"v"(b),"v"(c));return r;}
__device__ __forceinline__ float max2f(float a,float b){float r;asm("v_max_f32_e32 %0, %1, %2":"=v"(r):"v"(a),"v"(b));return r;}
__device__ __forceinline__ float fadd_s(float a,float b){float r;asm("v_add_f32_e32 %0, %1, %2":"=v"(r):"v"(a),"v"(b));return r;}
__device__ __forceinline__ float fsub_s(float a,float b){float r;asm("v_sub_f32_e32 %0, %1, %2":"=v"(r):"v"(a),"v"(b));return r;}
typedef float f32x2_t __attribute__((ext_vector_type(2))); typedef float f32x4_t __attribute__((ext_vector_type(4))); typedef __bf16 bf16x2_t __attribute__((ext_vector_type(2)));
__device__ __forceinline__ unsigned cvtpk_s(float lo,float hi){f32x2_t v={lo,hi};bf16x2_t b=__builtin_convertvector(v,bf16x2_t);return __builtin_bit_cast(unsigned,b);}
#define WAIT_BAR(N) asm volatile("s_waitcnt vmcnt(" #N ") lgkmcnt(0)\n\ts_barrier":::"memory")

__device__ __forceinline__ void qkt(f32x16&p0,f32x16&p1,const char*Kslot,const bf16x8*qr,const f32x16&negm,int r32,int hi){
  const char*kb=Kslot+hi*1024+r32*16;
  #pragma unroll
  for(int d0=0;d0<4;++d0){
    const bf16x8 b0=*reinterpret_cast<const bf16x8*>(kb+d0*2048);
    const bf16x8 b1=*reinterpret_cast<const bf16x8*>(kb+d0*2048+512);
    if(d0==0){p0=__builtin_amdgcn_mfma_f32_32x32x16_bf16(b0,qr[0],negm,0,0,0);p1=__builtin_amdgcn_mfma_f32_32x32x16_bf16(b1,qr[0],negm,0,0,0);}
    else{p0=__builtin_amdgcn_mfma_f32_32x32x16_bf16(b0,qr[d0],p0,0,0,0);p1=__builtin_amdgcn_mfma_f32_32x32x16_bf16(b1,qr[d0],p1,0,0,0);}}
}
typedef __attribute__((address_space(3))) const char* lds_cptr;
typedef short v4i16_t __attribute__((ext_vector_type(4)));
__device__ __forceinline__ void kload8(bf16x8*kf,lds_cptr kp){
  kf[0]=*(const __attribute__((address_space(3))) bf16x8*)(kp);      kf[1]=*(const __attribute__((address_space(3))) bf16x8*)(kp+512);
  kf[2]=*(const __attribute__((address_space(3))) bf16x8*)(kp+2048); kf[3]=*(const __attribute__((address_space(3))) bf16x8*)(kp+2560);
  kf[4]=*(const __attribute__((address_space(3))) bf16x8*)(kp+4096); kf[5]=*(const __attribute__((address_space(3))) bf16x8*)(kp+4608);
  kf[6]=*(const __attribute__((address_space(3))) bf16x8*)(kp+6144); kf[7]=*(const __attribute__((address_space(3))) bf16x8*)(kp+6656);
}
__device__ __forceinline__ void kload2(bf16x8*kf,lds_cptr kp,int j){ kf[2*j]=*(const __attribute__((address_space(3))) bf16x8*)(kp+j*2048); kf[2*j+1]=*(const __attribute__((address_space(3))) bf16x8*)(kp+j*2048+512); }
__device__ __forceinline__ s16x4 vtr(lds_cptr p){ return __builtin_bit_cast(s16x4,__builtin_amdgcn_ds_read_tr16_b64_v4i16((__attribute__((address_space(3))) v4i16_t*)p)); }
__device__ __forceinline__ float rowmax(const f32x16&p0,const f32x16&p1){
  float a=max3f(p0[0],p0[1],p1[0]),b=max3f(p0[2],p0[3],p1[1]);a=max3f(a,p1[2],p1[3]);
  #pragma unroll
  for(int r=4;r<16;r+=4){a=max3f(a,p0[r],p0[r+1]);b=max3f(b,p0[r+2],p0[r+3]);a=max3f(a,p1[r],p1[r+1]);b=max3f(b,p1[r+2],p1[r+3]);}
  const float m=max2f(a,b);
  auto rr=__builtin_amdgcn_permlane32_swap(__float_as_uint(m),__float_as_uint(m),false,false);
  return max2f(__uint_as_float(rr[0]),__uint_as_float(rr[1]));
}
__device__ __forceinline__ void pv(f32x16*o,int vb,bf16x8 pa0,bf16x8 pa1,bf16x8 pa2,bf16x8 pa3){
  #pragma unroll
  for(int d0=0;d0<2;++d0){s16x4 lo[4],hi[4];
    #pragma unroll
    for(int ks=0;ks<4;++ks){
      asm volatile("ds_read_b64_tr_b16 %0,%1 offset:%c2":"=&v"(lo[ks]):"v"(vb),"i"(d0*4096+ks*1024):"memory");
      asm volatile("ds_read_b64_tr_b16 %0,%1 offset:%c2":"=&v"(hi[ks]):"v"(vb),"i"(d0*4096+ks*1024+512):"memory");}
    asm volatile("s_waitcnt lgkmcnt(0)":::"memory");SBAR();
    #define PK(k) (bf16x8){lo[k][0],lo[k][1],lo[k][2],lo[k][3],hi[k][0],hi[k][1],hi[k][2],hi[k][3]}
    o[d0]=__builtin_amdgcn_mfma_f32_32x32x16_bf16(pa0,PK(0),o[d0],0,0,0);
    o[d0]=__builtin_amdgcn_mfma_f32_32x32x16_bf16(pa1,PK(1),o[d0],0,0,0);
    o[d0]=__builtin_amdgcn_mfma_f32_32x32x16_bf16(pa2,PK(2),o[d0],0,0,0);
    o[d0]=__builtin_amdgcn_mfma_f32_32x32x16_bf16(pa3,PK(3),o[d0],0,0,0);
    #undef PK
  }
}

#ifndef ATTN_STORE16
#define ATTN_STORE16(p,v) (*(u32x4*)(p)=(v))
#endif
template<int THRL> __device__ __forceinline__ void attn_unit(int b,int h,int qb,const bf16*Q,const bf16*__restrict__ K,const bf16*__restrict__ V,bf16*O,const float*__restrict__ gain,char*shm){
  const int tid=threadIdx.x,lane=tid&63,r32=lane&31,hi=lane>>5; const int wid=__builtin_amdgcn_readfirstlane(tid>>6);
  const long rowbase=(long)b*SEQ; const int q0=qb*QB;
  const bf16*Qw=Q+(rowbase+q0+wid*QBLK)*QP+h*D;
  const bf16*Kh=K+(long)(b*2+(h>>2))*KVROWS*KVP,*Vh=V+(long)(b*2+(h>>2))*KVROWS*KVP;
  const unsigned lds0=(unsigned)(uintptr_t)shm;
  float*wsf=(float*)(shm+LDS_WS)+wid*64;
  const bf16*ksrc=Kh+(long)lane*KVP+wid*8;
  const bf16*vsrc=Vh+(long)(16*(wid&3)+(lane>>2))*KVP+(wid>>2)*32+(lane&3)*8;
  const unsigned kdst=lds0+LDS_K+wid*1024, vdst=lds0+LDS_V+wid*1024;
  #define DMA_K(t,slot) glds16(ksrc+(long)(t)*KVBLK*KVP,(unsigned)__builtin_amdgcn_readfirstlane(kdst+(slot)))
  #define DMA_V(t,slot) glds16(vsrc+(long)(t)*KVBLK*KVP,(unsigned)__builtin_amdgcn_readfirstlane(vdst+(slot)))
  const int vb0=(int)(lds0+LDS_V)+((lane>>4)&1)*32+(lane&3)*8+(4*hi+((lane&15)>>2))*64;
  const char*Kbase=shm+LDS_K; bf16x8 kf[8];
  const lds_cptr shm3=(lds_cptr)shm; const lds_cptr kp0=shm3+LDS_K+hi*1024+r32*16; const lds_cptr vp0=shm3+LDS_V+((lane>>4)&1)*32+(lane&3)*8+(4*hi+((lane&15)>>2))*64;
  DMA_K(0,0);DMA_V(0,0);DMA_K(1,SLOTB);
  bf16x8 qr[4];
  #pragma unroll
  for(int d0=0;d0<4;++d0)qr[d0]=*reinterpret_cast<const bf16x8*>(&Qw[(long)r32*QP+d0*16+hi*8]);
  float mhat=0.f,l_reg=0.f;f32x16 o[2];o[0]=f32x16{};o[1]=f32x16{};f32x16 negm=f32x16{};asm volatile("":"+v"(negm));
  #define CMASK(P0,P1,t) do{}while(0)
  bool resc=false;
  #define START(P0,P1) do{ const float rm=rowmax(P0,P1); resc=false; \
    { const float dl=rm; mhat=fadd_s(mhat,dl); \
      _Pragma("unroll") for(int r=0;r<16;++r){P0[r]=fsub_s(P0[r],dl);P1[r]=fsub_s(P1[r],dl);} \
      _Pragma("unroll") for(int r=0;r<16;++r)negm[r]=-mhat; asm volatile("":"+v"(negm)); } \
    _Pragma("unroll") for(int r=0;r<16;++r)P0[r]=__builtin_amdgcn_exp2f(P0[r]); }while(0)
  #define RESC() do{ if(resc){ asm volatile("s_waitcnt lgkmcnt(0)":::"memory"); \
      _Pragma("unroll") for(int d_=0;d_<2;++d_) _Pragma("unroll") for(int r=0;r<16;++r)o[d_][r]*=wsf[crow(r,hi)]; } }while(0)
  f32x16 pA0,pA1,pB0,pB1;
  int sl_prev=0,sl_cur=0,sl_next=SLOTB;
  #define ROT() do{sl_prev=sl_cur;sl_cur=sl_next;sl_next=(sl_next==(NSLOT-1)*SLOTB)?0:sl_next+SLOTB;}while(0)
  DMA_K(2,2*SLOTB);
  WAIT_BAR(3);
  qkt(pA0,pA1,Kbase,qr,negm,r32,hi);asm volatile("s_nop 15\n\ts_nop 7":"+v"(pA0),"+v"(pA1));CMASK(pA0,pA1,0);
  START(pA0,pA1);
  _Pragma("unroll") for(int r=0;r<16;++r)pA1[r]=__builtin_amdgcn_exp2f(pA1[r]);
  WAIT_BAR(0);
  DMA_K(3,0);DMA_V(1,SLOTB);
  ROT();
  kload8(kf,kp0+sl_cur);
  WAIT_BAR(2);
  s16x4 vlo[8],vhi[8]; u32x4 pw0,pw1,pw2,pw3;
  #define PKW(P,B) cvtpk_s(P[B],P[B+1])
  #define PAF(k) __builtin_bit_cast(bf16x8,pw##k)
  #define VFR(i) (bf16x8){vlo[i][0],vlo[i][1],vlo[i][2],vlo[i][3],vhi[i][0],vhi[i][1],vhi[i][2],vhi[i][3]}
  #define PIN(x) asm volatile("":"+v"(x))
  #define MX3(a,b,c) __builtin_fmaxf(__builtin_fmaxf((a),(b)),(c))
  #define GAPA(MF,A0,A1,A2,A3,W0,W1,PW) do{ MF; sacc+=A0; sacc+=A1; sacc+=A2; sacc+=A3; PIN(sacc); W0; W1; PIN(PW); SBAR(); }while(0)
  #define EX(v) __builtin_amdgcn_exp2f(v)
  #define GAPB(MF,X,B) do{ MF; X[B]=EX(X[B]); X[B+1]=EX(X[B+1]); X[B+2]=EX(X[B+2]); X[B+3]=EX(X[B+3]); PIN(X); SBAR(); }while(0)
  #define VRD(i) do{ vlo[i]=vtr(vp_+(((i)>>2)*4096+((i)&3)*1024)); vhi[i]=vtr(vp_+(((i)>>2)*4096+((i)&3)*1024+512)); }while(0)
  #define KRD(G,j) do{ if(G){ kload2(kf,kp0+sl_next,j); SBAR(); } }while(0)
  #define STEP(C0,C1,P0,P1,t,GK,GV,GL) do{ SBAR(); \
    const lds_cptr vp_=vp0+sl_prev; \
    VRD(0); SBAR(); float sacc=(P0[0]+P0[1]); \
    GAPA(C0=__builtin_amdgcn_mfma_f32_32x32x16_bf16(kf[0],qr[0],negm,0,0,0), P0[2],P0[3],P0[4],P0[5],     pw0[0]=PKW(P0,0), pw0[1]=PKW(P0,2), pw0); \
    VRD(4); SBAR(); GAPA(C1=__builtin_amdgcn_mfma_f32_32x32x16_bf16(kf[1],qr[0],negm,0,0,0), P0[6],P0[7],P0[8],P0[9],     pw0[2]=PKW(P0,4), pw0[3]=PKW(P0,6), pw0); \
    VRD(1); SBAR(); GAPA(C0=__builtin_amdgcn_mfma_f32_32x32x16_bf16(kf[2],qr[1],C0,0,0,0),   P0[10],P0[11],P0[12],P0[13], pw1[0]=PKW(P0,8), pw1[1]=PKW(P0,10), pw1); \
    VRD(5); SBAR(); GAPA(C1=__builtin_amdgcn_mfma_f32_32x32x16_bf16(kf[3],qr[1],C1,0,0,0),   P0[14],P0[15],P1[0],P1[1],   pw1[2]=PKW(P0,12),pw1[3]=PKW(P0,14), pw1); \
    VRD(2); SBAR(); GAPA(C0=__builtin_amdgcn_mfma_f32_32x32x16_bf16(kf[4],qr[2],C0,0,0,0),   P1[2],P1[3],P1[4],P1[5],     pw2[0]=PKW(P1,0), pw2[1]=PKW(P1,2), pw2); \
    VRD(6); SBAR(); GAPA(C1=__builtin_amdgcn_mfma_f32_32x32x16_bf16(kf[5],qr[2],C1,0,0,0),   P1[6],P1[7],P1[8],P1[9],     pw2[2]=PKW(P1,4), pw2[3]=PKW(P1,6), pw2); \
    VRD(3); SBAR(); GAPA(C0=__builtin_amdgcn_mfma_f32_32x32x16_bf16(kf[6],qr[3],C0,0,0,0),   P1[10],P1[11],P1[12],P1[13], pw3[0]=PKW(P1,8), pw3[1]=PKW(P1,10), pw3); \
    VRD(7); SBAR(); GAPA(C1=__builtin_amdgcn_mfma_f32_32x32x16_bf16(kf[7],qr[3],C1,0,0,0),   P1[14],P1[15],0.f,0.f,       pw3[2]=PKW(P1,12),pw3[3]=PKW(P1,14), pw3); \
    l_reg+=sacc; \
    if(GK){DMA_K((t)+3,sl_cur);} if(GV){DMA_V((t)+1,sl_next);} \
    CMASK(C0,C1,t); \
    { float a=MX3(C0[0],C0[1],C1[0]),b=MX3(C0[2],C0[3],C1[1]); a=MX3(a,C1[2],C1[3]); \
      _Pragma("unroll") for(int r=4;r<16;r+=4){a=MX3(a,C0[r],C0[r+1]);b=MX3(b,C0[r+2],C0[r+3]);a=MX3(a,C1[r],C1[r+1]);b=MX3(b,C1[r+2],C1[r+3]);} \
      float rm=__builtin_fmaxf(a,b); { auto rr=__builtin_amdgcn_permlane32_swap(__float_as_uint(rm),__float_as_uint(rm),false,false); rm=__builtin_fmaxf(__uint_as_float(rr[0]),__uint_as_float(rr[1])); } \
      resc=false; \
      if(__builtin_expect(__any(rm>(float)THRL),0)){ const float dl=__builtin_fmaxf(rm,0.f); mhat+=dl; \
        _Pragma("unroll") for(int r=0;r<16;++r){C0[r]-=dl;C1[r]-=dl;} \
        _Pragma("unroll") for(int r=0;r<16;++r)negm[r]=-mhat; asm volatile("":"+v"(negm)); \
        const float f=__builtin_amdgcn_exp2f(-dl); l_reg*=f; if(hi==0)wsf[r32]=f; resc=true; } } \
    SBAR(); \
    GAPB(o[0]=__builtin_amdgcn_mfma_f32_32x32x16_bf16(PAF(0),VFR(0),o[0],0,0,0), C0,0); \
    GAPB(o[1]=__builtin_amdgcn_mfma_f32_32x32x16_bf16(PAF(0),VFR(4),o[1],0,0,0), C0,4); \
    KRD(GL,0); GAPB(o[0]=__builtin_amdgcn_mfma_f32_32x32x16_bf16(PAF(1),VFR(1),o[0],0,0,0), C0,8); \
    KRD(GL,1); GAPB(o[1]=__builtin_amdgcn_mfma_f32_32x32x16_bf16(PAF(1),VFR(5),o[1],0,0,0), C0,12); \
    KRD(GL,2); GAPB(o[0]=__builtin_amdgcn_mfma_f32_32x32x16_bf16(PAF(2),VFR(2),o[0],0,0,0), C1,0); \
    KRD(GL,3); GAPB(o[1]=__builtin_amdgcn_mfma_f32_32x32x16_bf16(PAF(2),VFR(6),o[1],0,0,0), C1,4); \
    GAPB(o[0]=__builtin_amdgcn_mfma_f32_32x32x16_bf16(PAF(3),VFR(3),o[0],0,0,0), C1,8); \
    GAPB(o[1]=__builtin_amdgcn_mfma_f32_32x32x16_bf16(PAF(3),VFR(7),o[1],0,0,0), C1,12); \
    }while(0)
  int t=1;
  #undef CMASK
  #define CMASK(P0,P1,t) do{}while(0)
  for(;t+5<NT;t+=2){
    STEP(pB0,pB1,pA0,pA1,t,true,true,true);     WAIT_BAR(2); RESC(); ROT();
    STEP(pA0,pA1,pB0,pB1,t+1,true,true,true);   WAIT_BAR(2); RESC(); ROT();
  }
  #undef CMASK
  #define CMASK(P0,P1,t) do{ if((t)==NT-1)tmask(P0,P1); }while(0)
  #define ENDW(tt) do{ if((tt)+3<NT){WAIT_BAR(2);} else if((tt)+2<NT){WAIT_BAR(1);} else {WAIT_BAR(0);} }while(0)
  for(;t+1<NT;t+=2){
    STEP(pB0,pB1,pA0,pA1,t,(t+3<NT),(t+1<NT),(t+1<NT));       ENDW(t);   RESC(); ROT();
    STEP(pA0,pA1,pB0,pB1,t+1,(t+4<NT),(t+2<NT),(t+2<NT));     ENDW(t+1); RESC(); ROT();
  }
  static_assert((NT&1)==1&&NT>=7,"odd tile count: the pair loops end on tile NT-1 (scores in buffer A)");
  { float sacc=pA0[0]+pA0[1]; _Pragma("unroll") for(int r=2;r<16;++r)sacc+=pA0[r]; _Pragma("unroll") for(int r=0;r<16;++r)sacc+=pA1[r]; l_reg+=sacc;
    pw0=(u32x4){PKW(pA0,0),PKW(pA0,2),PKW(pA0,4),PKW(pA0,6)};pw1=(u32x4){PKW(pA0,8),PKW(pA0,10),PKW(pA0,12),PKW(pA0,14)};pw2=(u32x4){PKW(pA1,0),PKW(pA1,2),PKW(pA1,4),PKW(pA1,6)};pw3=(u32x4){PKW(pA1,8),PKW(pA1,10),PKW(pA1,12),PKW(pA1,14)};
    SBAR(); pv(o,vb0+sl_prev,PAF(0),PAF(1),PAF(2),PAF(3)); }
  #undef PKW
  #undef PAF
  #undef VFR
  #undef PIN
  #undef MX3
  #undef GAPA
  #undef GAPB
  #undef EX
  #undef VRD
  #undef KRD
  #undef STEP
  #undef ENDW
  {auto rr=__builtin_amdgcn_permlane32_swap(__float_as_uint(l_reg),__float_as_uint(l_reg),false,false);l_reg=__uint_as_float(rr[0])+__uint_as_float(rr[1]);}
  if(hi==0)wsf[32+r32]=l_reg;asm volatile("s_waitcnt lgkmcnt(0)":::"memory");
  float rli[16];
  #pragma unroll
  for(int r=0;r<16;++r)rli[r]=__builtin_amdgcn_rcpf(wsf[32+crow(r,hi)]);
  bf16*Ow=O+(rowbase+q0+wid*QBLK)*OP+h*D;
  { bf16*stg=(bf16*)(shm+LDS_OST)+wid*2048;
    #pragma unroll
    for(int r=0;r<16;++r){const int orow=crow(r,hi);
      #pragma unroll
      for(int d0=0;d0<2;++d0)stg[orow*64+d0*32+r32]=__float2bfloat16(o[d0][r]*rli[r]);}
    asm volatile("s_waitcnt lgkmcnt(0)":::"memory");
    #pragma unroll
    for(int i=0;i<4;++i){const int row=i*8+(lane>>3),ch=lane&7; const u32x4 v=*(const u32x4*)(stg+row*64+ch*8);
      float f[8]; f[0]=__uint_as_float(v.x<<16);f[1]=__uint_as_float(v.x&0xffff0000u);f[2]=__uint_as_float(v.y<<16);f[3]=__uint_as_float(v.y&0xffff0000u);
      f[4]=__uint_as_float(v.z<<16);f[5]=__uint_as_float(v.z&0xffff0000u);f[6]=__uint_as_float(v.w<<16);f[7]=__uint_as_float(v.w&0xffff0000u);
      float ss=0.f; _Pragma("unroll") for(int j=0;j<8;++j)ss+=f[j]*f[j];
      ss+=__shfl_xor(ss,1);ss+=__shfl_xor(ss,2);ss+=__shfl_xor(ss,4);
      const float rs=1.0f/sqrtf(ss*(1.0f/64.0f)+1e-6f); const f32x4_t g0=*(const f32x4_t*)(gain+h*D+ch*8),g1=*(const f32x4_t*)(gain+h*D+ch*8+4);
      u32x4 w; w[0]=cvtpk_s(f[0]*rs*g0[0],f[1]*rs*g0[1]);w[1]=cvtpk_s(f[2]*rs*g0[2],f[3]*rs*g0[3]);w[2]=cvtpk_s(f[4]*rs*g1[0],f[5]*rs*g1[1]);w[3]=cvtpk_s(f[6]*rs*g1[2],f[7]*rs*g1[3]);
      ATTN_STORE16(Ow+(long)row*OP+ch*8,w);} }
  asm volatile("s_waitcnt lgkmcnt(0)\n\ts_barrier":::"memory");
  #undef DMA_K
  #undef DMA_V
  #undef CMASK
  #undef START
  #undef RESC
  #undef ROT
}
constexpr int ATTN_LDS_BYTES=LDS_BYTES;
struct AttnTensors { const bf16* Q; const bf16* K; const bf16* V; bf16* O; const float* gain; };
struct AttnUnit { int b; int h; int qb; };
struct StaticOrder {
  int vcu;
  __device__ __forceinline__ explicit StaticOrder(int grid_,int block):vcu((grid_%8==0)?(block%8)*(grid_/8)+block/8:block),grid(grid_){}
  int grid;
  __device__ __forceinline__ bool next(int i,AttnUnit&u)const{ const int n=i*grid+vcu,pair=n>>5; if(pair>=48)return false; const int s=n&31; u.b=pair>>1; u.h=4*(pair&1)+(s>>3); u.qb=s&7; return true; }
};
template<class Sched,class Side,int THRL=8> __device__ __forceinline__ void attn_phase(char*lds,const AttnTensors&T,const Sched&S,int kside,const Side&side){
  AttnUnit u; int i=0;
  for(;i<kside&&S.next(i,u);++i){ attn_unit<THRL>(u.b,u.h,u.qb,T.Q,T.K,T.V,T.O,T.gain,lds); }
  side();
  for(;S.next(i,u);++i){ attn_unit<THRL>(u.b,u.h,u.qb,T.Q,T.K,T.V,T.O,T.gain,lds); }
}
#undef SBAR
#undef WAIT_BAR
}

typedef __attribute__((address_space(1))) unsigned gu32;
#define XB_TMO      128
#define XB_XCNT(j)  (256  + 64 * (j))
#define XB_XSUB(j)  (1280 + 64 * (j))
#define XB_XGEN(j)  (2304 + 64 * (j))
#define XB_TOP      3328
#define XB_TOPGEN   3392
#define XCD_BAR_WORDS 3456
#define XB_SPIN_CAP (1u << 18)

__device__ __forceinline__ unsigned xb_ld(unsigned* p)              { return __hip_atomic_load(p, __ATOMIC_RELAXED, __HIP_MEMORY_SCOPE_AGENT); }
__device__ __forceinline__ unsigned xb_add(unsigned* p, unsigned v) { return __hip_atomic_fetch_add(p, v, __ATOMIC_RELAXED, __HIP_MEMORY_SCOPE_AGENT); }
__device__ __forceinline__ unsigned xb_xcc_id() { return (unsigned)__builtin_amdgcn_s_getreg((3 << 11) | 20) & 0xFu; }
#define XB_SPIN(cond, bar) do { unsigned _sp = 0; while (cond) { __builtin_amdgcn_s_sleep(1); \
    if ((++_sp & 255u) == 0u) { if (xb_ld(&(bar)[XB_TMO])) break; if (_sp > XB_SPIN_CAP) { atomicAdd(&(bar)[XB_TMO], 1u); break; } } } } while (0)

struct XcdBarrier {
    unsigned* bar; unsigned x;
    volatile LAS unsigned* st;
};

__device__ __forceinline__ XcdBarrier xcd_barrier_post(unsigned* bar, volatile LAS unsigned* st) {
    XcdBarrier b; b.bar = bar; b.x = xb_xcc_id(); b.st = st;
    if (threadIdx.x == 0) (void)xb_add(&bar[XB_XCNT(b.x)], 1u);
    return b;
}
__device__ __forceinline__ void xcd_barrier_complete(unsigned* bar, unsigned x, unsigned& nloc, unsigned& nx) {
    const unsigned G = gridDim.x * gridDim.y * gridDim.z;
    unsigned sum, cnt, mine, sp = 0u;
    for (;;) {
        sum = 0u; cnt = 0u; mine = 0u;
#pragma unroll
        for (unsigned j = 0; j < 16; ++j) { const unsigned c = xb_ld(&bar[XB_XCNT(j)]); sum += c; cnt += (c > 0u) ? 1u : 0u; mine = (j == x) ? c : mine; }
        if (sum == G) break;
        __builtin_amdgcn_s_sleep(1);
        if ((++sp & 255u) == 0u) { if (xb_ld(&bar[XB_TMO])) break; if (sp > XB_SPIN_CAP) { atomicAdd(&bar[XB_TMO], 1u); break; } }
    }
    nloc = mine > 0u ? mine : 1u; nx = cnt > 0u ? cnt : 1u;
}

__device__ __forceinline__ void xcd_barrier(const XcdBarrier& b) {
    asm volatile("s_waitcnt vmcnt(0)" ::: "memory");
    __syncthreads();
    if (threadIdx.x == 0) {
        unsigned* bar = b.bar;
        __builtin_amdgcn_s_waitcnt(0);
        unsigned nloc = b.st[0], nx = b.st[1];
        if (nloc == 0u) { xcd_barrier_complete(bar, b.x, nloc, nx); b.st[0] = nloc; b.st[1] = nx; }
        const unsigned old = xb_add(&bar[XB_XSUB(b.x)], 1u);
        const unsigned gen = old / nloc;
        if (old + 1u == (gen + 1u) * nloc) {
            __builtin_amdgcn_fence(__ATOMIC_RELEASE, "agent");
            asm volatile("s_waitcnt vmcnt(0)" ::: "memory");
            const unsigned og = xb_add(&bar[XB_TOP], 1u);
            const unsigned tg = og / nx;
            if (og + 1u == (tg + 1u) * nx) xb_add(&bar[XB_TOPGEN], 1u);
            else XB_SPIN(xb_ld(&bar[XB_TOPGEN]) == tg, bar);
            __builtin_amdgcn_fence(__ATOMIC_ACQUIRE, "agent");
            xb_add(&bar[XB_XGEN(b.x)], 1u);
            asm volatile("s_waitcnt vmcnt(0)" ::: "memory");
        } else {
            XB_SPIN(xb_ld(&bar[XB_XGEN(b.x)]) == gen, bar);
            __builtin_amdgcn_fence(__ATOMIC_ACQUIRE, "agent");
            asm volatile("s_waitcnt vmcnt(0)" ::: "memory");
        }
    }
    __syncthreads();
}


__global__ void __launch_bounds__(NTHR, 2) enc_fwd(Args a) {
    extern __shared__ __attribute__((aligned(16))) unsigned char lds[];
    cg::grid_group grid = cg::this_grid();
    const int tid = threadIdx.x, lane = tid & 63, wave = __builtin_amdgcn_readfirstlane(tid >> 6);
    const int G = gridDim.x, gw = blockIdx.x * NWAVES + wave, NGW = G * NWAVES;
    const int lo = a.ph_lo, hi = a.ph_hi;
    volatile LAS unsigned* MISC = (volatile LAS unsigned*)((LAS unsigned char*)lds + LDS_BYTES - 64);
    if (tid < 16) MISC[tid] = 0u;
    __syncthreads();
    (void)xcd_barrier_post((unsigned*)(a.ws + WS_CTL) + 4096, MISC);
#define IN(k) (lo <= (k) && (k) < hi)
#ifndef PROBE_X2
#define PROBE_X2 -1
#endif
#define REP(k) for (int rep_ = 0; rep_ < ((k) == PROBE_X2 ? 2 : 1); ++rep_)
#define SEAM(k) do { if (IN(k) && IN((k) + 1)) { if (lo > 1000) grid.sync();   { XcdBarrier bar_; bar_.bar = (unsigned*)(a.ws + WS_CTL) + 4096; bar_.x = xb_xcc_id(); bar_.st = MISC; xcd_barrier(bar_); } } } while (0)
    if (IN(0)) REP(0) { p0_prologue(a, lds, tid, lane, wave); } SEAM(0);
    if (IN(1)) REP(1) { pg8::Gemm g{(const bf16_t*)(a.ws + WS_XA), (const bf16_t*)(a.ws + WS_WIN), NTOK, INW, DM}; pg8::StaticOrder S; S.init(NTOK, INW, G, (int)blockIdx.x);
        pg8::EpiInProj E{(bf16_t*)(a.ws + WS_Z), (bf16_t*)(a.ws + WS_Q), (bf16_t*)(a.ws + WS_KB), (bf16_t*)(a.ws + WS_VB), (const float*)(a.ws + WS_ROPE), a.qg, a.kg};
        kv_meta_rows(a, lane, gw, NGW);
        pg8::gemm_phase<pg8::EpiInProj, pg8::StaticOrder, true, true>((LAS unsigned char*)lds, g, S, E); } SEAM(1);
    if (IN(3)) REP(3) { const attn_body::AttnTensors AT{(const attn_body::bf16*)(a.ws + WS_Q), (const attn_body::bf16*)(a.ws + WS_KB), (const attn_body::bf16*)(a.ws + WS_VB), (attn_body::bf16*)(a.ws + WS_XA) + 512, a.attn_g};
        const attn_body::StaticOrder S(G, (int)blockIdx.x);
        auto side = [&]() { p2_pass(a, lane, gw, NGW);
            table_fp4<false>(a.pu, a.ws + WS_UT, (float*)(a.ws + WS_USC), a.g_ffn, gw, NGW, lane);
            table_fp4<true>(a.pv, a.ws + WS_UT + 4 * SLICE4, (float*)(a.ws + WS_VSC), nullptr, gw, NGW, lane); __syncthreads(); };
        attn_body::attn_phase<attn_body::StaticOrder>((char*)lds, AT, S, (int)((blockIdx.x >> 3) * 6) >> 5, side); } SEAM(3);
    if (IN(4)) REP(4) { pg8::Gemm g{(const bf16_t*)(a.ws + WS_XA), (const bf16_t*)(a.ws + WS_WOUT), NTOK, DM, DM}; pg8::StaticOrder S; S.init(NTOK, DM, G, (int)blockIdx.x);
        pg8::EpiResidNorm E{a.xp, a.xs, a.out, NBP * SEQ, (bf16_t*)(a.ws + WS_HB), a.ws + WS_X8, (float*)(a.ws + WS_SS), X8SCALE};
        pg8::gemm_phase<pg8::EpiResidNorm, pg8::StaticOrder, true, true>((LAS unsigned char*)lds, g, S, E); } SEAM(4);
    if (IN(6)) REP(6) { pg8::Gemm g{(const bf16_t*)(a.ws + WS_X8), (const bf16_t*)(a.ws + WS_WQ), NTOK, PQ, DM / 2}; pg8::StaticOrder S; S.init(NTOK, PQ, G, (int)blockIdx.x);
        pg8::EpiBf16 E{(bf16_t*)(a.ws + WS_QP), PQ, 1.0f / (X8SCALE * WQSCALE)};
        pg8::gemm_phase<pg8::EpiBf16, pg8::StaticOrder, true, true, true>((LAS unsigned char*)lds, g, S, E); } SEAM(6);
    if (IN(7)) REP(7) { p7_topk(a, lds, tid, lane, wave); __syncthreads(); } SEAM(7);
    if (IN(8)) REP(8) { p8a_u(a, lane, wave); } SEAM(8);
    if (IN(9)) REP(9) { p8c_combine(a, lds, tid); __syncthreads(); } SEAM(9);
    if (IN(10)) REP(10) { p8b_v(a, lds, lane, wave, rep_ == ((10 == PROBE_X2) ? 1 : 0)); }
#undef IN
#undef SEAM
}

extern "C" void kernel_launch(void* const* d_in, const int* in_sizes, int n_in, void* d_out, int out_size, void* d_ws, size_t ws_size, hipStream_t stream) {
    static int grid = 0;
    if (grid == 0) {
        if (n_in != 16 || out_size != NTOK * DM || ws_size < WS_END) { fprintf(stderr, "kernel_launch: unexpected shapes (n_in %d out %d ws %zu)\n", n_in, out_size, ws_size); grid = -1; return; }
        int dev = 0, cus = 0, per_cu = 0;
        (void)hipGetDevice(&dev); (void)hipDeviceGetAttribute(&cus, hipDeviceAttributeMultiprocessorCount, dev);
        (void)hipFuncSetAttribute((const void*)enc_fwd, hipFuncAttributeMaxDynamicSharedMemorySize, LDS_BYTES);
        (void)hipOccupancyMaxActiveBlocksPerMultiprocessor(&per_cu, (const void*)enc_fwd, NTHR, LDS_BYTES);
        if (per_cu < 1) { fprintf(stderr, "kernel_launch: occupancy query says %d blocks/CU\n", per_cu); per_cu = 1; }
        (void)hipGetLastError();
        grid = cus * 1;
    }
    if (grid < 0) return;
    (void)hipMemsetAsync((char*)d_ws + WS_CTL, 0, 64 * 1024, stream);
    Args a{};
    a.xp = (const float*)d_in[0]; a.xs = (const float*)d_in[1]; a.meta = (const float*)d_in[2]; a.g_mix = (const float*)d_in[3]; a.w_in = (const float*)d_in[4];
    a.conv_w = (const float*)d_in[5]; a.qg = (const float*)d_in[6]; a.kg = (const float*)d_in[7]; a.conv_g = (const float*)d_in[8]; a.attn_g = (const float*)d_in[9];
    a.w_out = (const float*)d_in[10]; a.g_ffn = (const float*)d_in[11]; a.wq = (const float*)d_in[12]; a.subk = (const float*)d_in[13]; a.pu = (const float*)d_in[14]; a.pv = (const float*)d_in[15];
    a.out = (float*)d_out; a.ws = (unsigned char*)d_ws;
    constexpr int NL = MK_N_LAUNCHES;
    for (int li = 0; li < NL; ++li) {
        a.ph_lo = (NL == 1) ? 0 : li; a.ph_hi = (NL == 1) ? NPHASE : li + 1;
        void* args[] = {&a};
        hipError_t e = hipLaunchCooperativeKernel((const void*)enc_fwd, dim3(grid), dim3(NTHR), args, LDS_BYTES, stream);
        if (e != hipSuccess) { fprintf(stderr, "kernel_launch: launch %d failed: %s\n", li, hipGetErrorString(e)); break; }
    }
}
```

```cpp
#include <hip/hip_runtime.h>
#include <hip/hip_cooperative_groups.h>
#include <cstdint>
#include <cstdio>
namespace cg = cooperative_groups;

#ifndef MK_N_LAUNCHES
#define MK_N_LAUNCHES 1
#endif

typedef unsigned short bf16_t;
typedef short bf16x8 __attribute__((ext_vector_type(8)));
typedef float f32x4 __attribute__((ext_vector_type(4)));
typedef unsigned u32x4 __attribute__((ext_vector_type(4)));
typedef unsigned u32x2 __attribute__((ext_vector_type(2)));
#define LAS __attribute__((address_space(3)))

constexpr int NB = 24, NBP = 16, SEQ = 2048, DM = 1024, NTOK = NB * SEQ;
constexpr int NMETA = 16, INW = 2304, KROWS = 2112;
constexpr int NKEYS = SEQ + NMETA;
constexpr int PQ = 2048;
constexpr float EPS = 1e-6f;
constexpr float C2 = 0.125f * 1.4426950408889634f;
constexpr int NWAVES = 8, NTHR = 512;
constexpr int LDS_BYTES = 163840;
constexpr int NPHASE = 11;

constexpr size_t MiB = 1u << 20;
constexpr size_t WS_CTL = 0;
constexpr size_t WS_WIN = 1 * MiB;
constexpr size_t WS_WOUT = 6 * MiB;
constexpr size_t WS_WQ = 8 * MiB;
constexpr size_t WS_SUBK = 12 * MiB;
constexpr size_t WS_ZMETA = 12 * MiB + 512 * 1024;
constexpr size_t WS_ROPE = WS_ZMETA + 256 * 1024;
constexpr size_t WS_UT = 13 * MiB;
constexpr size_t WS_USC = 29 * MiB, WS_VSC = WS_USC + 64 * 1024;
constexpr size_t WS_SS = WS_USC + 256 * 1024;
constexpr size_t SLICE4 = (size_t)16384 * 128;
constexpr size_t WS_XA = 32 * MiB;
constexpr size_t WS_EI = WS_XA, WS_GT = WS_XA + 12 * MiB;
constexpr size_t WS_Z = 128 * MiB;
constexpr size_t WS_HB = WS_Z;
constexpr size_t WS_QP = WS_Z + 96 * MiB;
constexpr size_t WS_PB = WS_QP;
constexpr size_t WS_AB = WS_PB + (size_t)4 * 49152 * 128 * 4;
constexpr size_t WS_Q = 416 * MiB;
constexpr size_t WS_X8 = WS_Q;
constexpr size_t WS_KB = 464 * MiB;
constexpr size_t WS_VB = 477 * MiB;
constexpr size_t WS_END = 490 * MiB;
constexpr float X8SCALE = 8.0f;
constexpr float WQSCALE = 64.0f;
constexpr float A8SCALE = 256.0f;

struct Args {
    const float* xp; const float* xs; const float* meta; const float* g_mix; const float* w_in; const float* conv_w;
    const float* qg; const float* kg; const float* conv_g; const float* attn_g; const float* w_out; const float* g_ffn;
    const float* wq; const float* subk; const float* pu; const float* pv;
    float* out; unsigned char* ws; int ph_lo, ph_hi;
};

__device__ __forceinline__ unsigned f2bf(float f) { unsigned u = __builtin_bit_cast(unsigned, f); return (u + 0x7fffu + ((u >> 16) & 1u)) >> 16; }
typedef float f32x2_pk __attribute__((ext_vector_type(2))); typedef __bf16 bf16x2_pk __attribute__((ext_vector_type(2)));
__device__ __forceinline__ unsigned pk2(float lo, float hi) { const f32x2_pk v = {lo, hi}; const bf16x2_pk b = __builtin_convertvector(v, bf16x2_pk); return __builtin_bit_cast(unsigned, b); }
__device__ __forceinline__ float bflo(unsigned w) { return __builtin_bit_cast(float, w << 16); }
__device__ __forceinline__ float bfhi(unsigned w) { return __builtin_bit_cast(float, w & 0xffff0000u); }
__device__ __forceinline__ float bf2f(bf16_t h) { return __builtin_bit_cast(float, (unsigned)h << 16); }
__device__ __forceinline__ void unpack8(u32x4 w, float* f) {
    f[0] = bflo(w.x); f[1] = bfhi(w.x); f[2] = bflo(w.y); f[3] = bfhi(w.y); f[4] = bflo(w.z); f[5] = bfhi(w.z); f[6] = bflo(w.w); f[7] = bfhi(w.w);
}
__device__ __forceinline__ u32x4 pack8(const float* f) { u32x4 w; w.x = pk2(f[0], f[1]); w.y = pk2(f[2], f[3]); w.z = pk2(f[4], f[5]); w.w = pk2(f[6], f[7]); return w; }
__device__ __forceinline__ float wave_sum(float v) {
#pragma unroll
    for (int o = 1; o < 64; o <<= 1) v += __shfl_xor(v, o);
    return v;
}
__device__ __forceinline__ float wave_max(float v) {
#pragma unroll
    for (int o = 1; o < 64; o <<= 1) v = fmaxf(v, __shfl_xor(v, o));
    return v;
}
__device__ __forceinline__ const float* xrow_ptr(const Args& a, int r) { return r < NBP * SEQ ? a.xp + (size_t)r * DM : a.xs + (size_t)(r - NBP * SEQ) * DM; }

__device__ __forceinline__ int permin(int n  ) {
    if (n >= 512 && n < 1536) { const int hc = (n - 512) >> 9, c = (n - 512) & 511; return 512 + (c >> 7) * 256 + hc * 128 + (c & 127); }
    if (n >= 1536 && n < 2048) { const int c = n - 1536, hh = c >> 6, half = (c >> 5) & 1; return 1536 + 256 * (hh >> 2) + 128 * half + 32 * (hh & 3) + (c & 31); }
    if (n >= 2048) { const int c = n - 2048, s = c >> 6, half = (c >> 5) & 1; return 2048 + 128 * half + 32 * s + (c & 31); }
    return n; }
__device__ __forceinline__ void p0_transpose_item(const float* W, int K, int N, bf16_t* WT, float* scr, int item, int lane, const float* gk = nullptr  , bool dperm = false) {
    const int nblk = N / 32, kb = item / nblk, nb = item % nblk, k0 = 64 * kb, n0 = 32 * nb, nd0 = dperm ? permin(n0) : n0;
#pragma unroll 8
    for (int i = 0; i < 32; ++i) { const int kk = 2 * i + (lane >> 5); scr[kk * 33 + (lane & 31)] = W[(size_t)(k0 + kk) * N + n0 + (lane & 31)] * (gk ? gk[k0 + kk] : 1.0f); }
    asm volatile("s_waitcnt lgkmcnt(0)" ::: "memory");
    const int c = lane & 7;
#pragma unroll
    for (int j = 0; j < 4; ++j) { const int n = (lane >> 3) + 8 * j; const float* s = scr + (8 * c) * 33 + n;
        u32x4 o; o.x = pk2(s[0 * 33], s[1 * 33]); o.y = pk2(s[2 * 33], s[3 * 33]); o.z = pk2(s[4 * 33], s[5 * 33]); o.w = pk2(s[6 * 33], s[7 * 33]);
        *(u32x4*)(WT + (size_t)(nd0 + n) * K + k0 + 8 * c) = o; }
    asm volatile("s_waitcnt lgkmcnt(0)" ::: "memory");
}
__device__ __forceinline__ void p0_transpose_item_fp8(const float* W, int K, int N, unsigned char* WT, float* scr, int item, int lane, const float* gk, float wscale) {
    const int nblk = N / 32, kb = item / nblk, nb = item % nblk, k0 = 64 * kb, n0 = 32 * nb;
#pragma unroll 8
    for (int i = 0; i < 32; ++i) { const int kk = 2 * i + (lane >> 5); scr[kk * 33 + (lane & 31)] = W[(size_t)(k0 + kk) * N + n0 + (lane & 31)] * (gk[k0 + kk] * wscale); }
    asm volatile("s_waitcnt lgkmcnt(0)" ::: "memory");
    const int c = lane & 7;
#pragma unroll
    for (int j = 0; j < 4; ++j) { const int n = (lane >> 3) + 8 * j; const float* s = scr + (8 * c) * 33 + n;
        unsigned w0 = (unsigned)__builtin_amdgcn_cvt_pk_fp8_f32(s[0 * 33], s[1 * 33], 0, false); w0 = (unsigned)__builtin_amdgcn_cvt_pk_fp8_f32(s[2 * 33], s[3 * 33], (int)w0, true);
        unsigned w1 = (unsigned)__builtin_amdgcn_cvt_pk_fp8_f32(s[4 * 33], s[5 * 33], 0, false); w1 = (unsigned)__builtin_amdgcn_cvt_pk_fp8_f32(s[6 * 33], s[7 * 33], (int)w1, true);
        *(u32x2*)(WT + (size_t)(n0 + n) * K + k0 + 8 * c) = (u32x2){w0, w1}; }
    asm volatile("s_waitcnt lgkmcnt(0)" ::: "memory");
}
__device__ __forceinline__ void cast_region(const float* src, bf16_t* dst, size_t n, size_t gtid, size_t nthreads) {
    for (size_t i = gtid * 8; i < n; i += nthreads * 8) {
        const f32x4 a = *(const f32x4*)(src + i), b = *(const f32x4*)(src + i + 4);
        u32x4 o; o.x = pk2(a.x, a.y); o.y = pk2(a.z, a.w); o.z = pk2(b.x, b.y); o.w = pk2(b.z, b.w);
        *(u32x4*)(dst + i) = o;
    }
}
template <bool PERM64> __device__ __forceinline__ void table_fp4(const float* src, unsigned char* dst, float* scale, const float* gcol  , int gw, int NGW, int lane) {
    f32x4 v[4], vn[4], g[4];
#pragma unroll
    for (int j = 0; j < 4; ++j) g[j] = gcol ? *(const f32x4*)(gcol + lane * 16 + 4 * j) : (f32x4){1.f, 1.f, 1.f, 1.f};
    if (gw < 16384) {
#pragma unroll
        for (int j = 0; j < 4; ++j) v[j] = __builtin_nontemporal_load((const f32x4*)(src + (size_t)gw * DM + lane * 16 + 4 * j)); }
    for (int row = gw; row < 16384; row += NGW) {
        { const int rn = row + NGW < 16384 ? row + NGW : row;
#pragma unroll
          for (int j = 0; j < 4; ++j) vn[j] = __builtin_nontemporal_load((const f32x4*)(src + (size_t)rn * DM + lane * 16 + 4 * j)); }
        float m = 0.f;
#pragma unroll
        for (int j = 0; j < 4; ++j) { v[j] = v[j] * g[j]; m = fmaxf(fmaxf(m, fmaxf(fabsf(v[j].x), fabsf(v[j].y))), fmaxf(fabsf(v[j].z), fabsf(v[j].w))); }
        m = wave_max(m);
        const float s = fmaxf(m, 1e-30f) * (1.0f / 6.0f), inv = 1.0f / s;
        unsigned char* rowp = dst + (size_t)(lane >> 4) * SLICE4 + (size_t)row * 128;
        if (!PERM64) {
            unsigned w0 = 0u, w1 = 0u;
            w0 = __builtin_amdgcn_cvt_scalef32_pk_fp4_f32(w0, v[0].x * inv, v[0].y * inv, 1.0f, 0); w0 = __builtin_amdgcn_cvt_scalef32_pk_fp4_f32(w0, v[0].z * inv, v[0].w * inv, 1.0f, 1);
            w0 = __builtin_amdgcn_cvt_scalef32_pk_fp4_f32(w0, v[1].x * inv, v[1].y * inv, 1.0f, 2); w0 = __builtin_amdgcn_cvt_scalef32_pk_fp4_f32(w0, v[1].z * inv, v[1].w * inv, 1.0f, 3);
            w1 = __builtin_amdgcn_cvt_scalef32_pk_fp4_f32(w1, v[2].x * inv, v[2].y * inv, 1.0f, 0); w1 = __builtin_amdgcn_cvt_scalef32_pk_fp4_f32(w1, v[2].z * inv, v[2].w * inv, 1.0f, 1);
            w1 = __builtin_amdgcn_cvt_scalef32_pk_fp4_f32(w1, v[3].x * inv, v[3].y * inv, 1.0f, 2); w1 = __builtin_amdgcn_cvt_scalef32_pk_fp4_f32(w1, v[3].z * inv, v[3].w * inv, 1.0f, 3);
            *(u32x2*)(rowp + (lane & 15) * 8) = (u32x2){w0, w1};
        } else {
            unsigned char* gp = rowp + ((lane & 15) >> 2) * 32 + (lane & 3) * 2;
#pragma unroll
            for (int m = 0; m < 4; ++m) { unsigned wm = 0u;
                wm = __builtin_amdgcn_cvt_scalef32_pk_fp4_f32(wm, v[0][m] * inv, v[1][m] * inv, 1.0f, 0); wm = __builtin_amdgcn_cvt_scalef32_pk_fp4_f32(wm, v[2][m] * inv, v[3][m] * inv, 1.0f, 1);
                *(unsigned short*)(gp + 8 * m) = (unsigned short)wm; }
        }
        if (lane == 0) scale[row] = s;
#pragma unroll
        for (int j = 0; j < 4; ++j) v[j] = vn[j];
    }
}
__device__ __forceinline__ void p0_prologue(const Args& a, unsigned char* lds, int tid, int lane, int wave) {
    const int G = gridDim.x, gw = blockIdx.x * NWAVES + wave, NGW = G * NWAVES;
    float* ldsf = (float*)lds;
    if (blockIdx.x < INW / 64) {
        float* xm = ldsf;
        float* red = ldsf + 16 * 1024;
#pragma unroll
        for (int rr = 0; rr < 2; ++rr) { const int r = 2 * wave + rr; f32x4 v[4]; float ss = 0.f;
#pragma unroll
            for (int j = 0; j < 4; ++j) { v[j] = *(const f32x4*)(a.meta + (size_t)r * DM + (lane + 64 * j) * 4); ss += v[j].x * v[j].x + v[j].y * v[j].y + v[j].z * v[j].z + v[j].w * v[j].w; }
            const float rstd = 1.0f / sqrtf(wave_sum(ss) * (1.0f / DM) + EPS);
#pragma unroll
            for (int j = 0; j < 4; ++j) { const int c = (lane + 64 * j) * 4; const f32x4 g = *(const f32x4*)(a.g_mix + c); *(f32x4*)(xm + r * 1024 + c) = v[j] * rstd * g; }
        }
        __syncthreads();
        const int n0 = blockIdx.x * 64, k0 = wave * 128;
        float acc[16];
#pragma unroll
        for (int r = 0; r < 16; ++r) acc[r] = 0.f;
        for (int kb = k0; kb < k0 + 128; kb += 16) { float wv[16];
#pragma unroll
            for (int q = 0; q < 16; ++q) wv[q] = a.w_in[(size_t)(kb + q) * INW + n0 + lane];
#pragma unroll
            for (int q = 0; q < 16; ++q)
#pragma unroll
                for (int r = 0; r < 16; ++r) acc[r] += xm[r * 1024 + kb + q] * wv[q]; }
#pragma unroll
        for (int r = 0; r < 16; ++r) red[(wave * 16 + r) * 64 + lane] = acc[r];
        __syncthreads();
        float* zmeta = (float*)(a.ws + WS_ZMETA);
        for (int o = tid; o < 1024; o += NTHR) { const int r = o >> 6, c = o & 63; float s = 0.f;
#pragma unroll
            for (int w = 0; w < 8; ++w) s += red[(w * 16 + r) * 64 + c];
            zmeta[r * INW + n0 + c] = s; }
        __syncthreads();
    }
    if (blockIdx.x == INW / 64) {
        float* rope = (float*)(a.ws + WS_ROPE);
        for (int i = tid; i < 64 * 16; i += NTHR) { const int pos = i >> 4, f = i & 15;
            const float freq = exp2f(-(float)f * (13.287712379549449f / 16.0f)); const float rev = (float)pos * freq * 0.15915494309189535f; const float fr = rev - floorf(rev);
            rope[2 * i] = __builtin_amdgcn_cosf(fr); rope[2 * i + 1] = __builtin_amdgcn_sinf(fr); }
    }
    if ((int)blockIdx.x > INW / 64 || G <= INW / 64 + 1) {
        float* scr = ldsf + wave * (64 * 33);
        constexpr int I_IN = (DM / 64) * (INW / 32), I_OUT = (DM / 64) * (DM / 32), I_WQ = (DM / 64) * (PQ / 32);
        const int first = (G <= INW / 64 + 1) ? 0 : INW / 64 + 1, nw = (G - first) * NWAVES;
        for (int it = ((int)blockIdx.x - first) * NWAVES + wave; it < I_IN + I_OUT + I_WQ; it += nw) {
            int r = it;
            if (r < I_IN) { p0_transpose_item(a.w_in, DM, INW, (bf16_t*)(a.ws + WS_WIN), scr, r, lane, nullptr, true); continue; } r -= I_IN;
            if (r < I_OUT) { p0_transpose_item(a.w_out, DM, DM, (bf16_t*)(a.ws + WS_WOUT), scr, r, lane); continue; } r -= I_OUT;
            p0_transpose_item_fp8(a.wq, DM, PQ, a.ws + WS_WQ, scr, r, lane, a.g_ffn, WQSCALE);
        }
    }
    {
        const size_t gtid = (size_t)blockIdx.x * NTHR + tid, nth = (size_t)G * NTHR;
        cast_region(a.subk, (bf16_t*)(a.ws + WS_SUBK), (size_t)16 * 128 * 128, gtid, nth);
        for (size_t i = gtid; i < (size_t)NTOK; i += nth) ((float*)(a.ws + WS_SS))[i] = 0.f;
    }
    {
        bf16_t* XA = (bf16_t*)(a.ws + WS_XA);
        f32x4 g[4], v[4], vn[4];
#pragma unroll
        for (int j = 0; j < 4; ++j) g[j] = *(const f32x4*)(a.g_mix + (lane + 64 * j) * 4);
        if (gw < NTOK) { const float* xr = xrow_ptr(a, gw);
#pragma unroll
            for (int j = 0; j < 4; ++j) v[j] = __builtin_nontemporal_load((const f32x4*)(xr + (lane + 64 * j) * 4)); }
        for (int r = gw; r < NTOK; r += NGW) {
            { const float* xn = xrow_ptr(a, r + NGW < NTOK ? r + NGW : r);
#pragma unroll
              for (int j = 0; j < 4; ++j) vn[j] = __builtin_nontemporal_load((const f32x4*)(xn + (lane + 64 * j) * 4)); }
            float ss = 0.f;
#pragma unroll
            for (int j = 0; j < 4; ++j) ss += v[j].x * v[j].x + v[j].y * v[j].y + v[j].z * v[j].z + v[j].w * v[j].w;
            const float rstd = 1.0f / sqrtf(wave_sum(ss) * (1.0f / DM) + EPS);
#pragma unroll
            for (int j = 0; j < 4; ++j) { const int c = (lane + 64 * j) * 4; const f32x4 o = v[j] * rstd * g[j];
                u32x2 w; w.x = pk2(o.x, o.y); w.y = pk2(o.z, o.w); *(u32x2*)(XA + (size_t)r * DM + c) = w; }
#pragma unroll
            for (int j = 0; j < 4; ++j) v[j] = vn[j];
        }
    }
}

constexpr int ZW = 1024;
struct P2In { u32x4 w[4]; };
__device__ __forceinline__ void p2_load(P2In& in, const bf16_t* ZB, int r, int lane) {
    const int t = r & 2047, c0 = lane * 8; const bf16_t* zr = ZB + (size_t)r * ZW;
    const bf16_t* zp = (t > 0) ? zr - ZW : zr; const bf16_t* zn = (t < SEQ - 1) ? zr + ZW : zr;
    in.w[0] = *(const u32x4*)(zr + c0); in.w[1] = *(const u32x4*)(zr + 512 + c0); in.w[2] = *(const u32x4*)(zp + 512 + c0); in.w[3] = *(const u32x4*)(zn + 512 + c0);
}
__device__ __forceinline__ void p2_pass(const Args& a, int lane, int gw, int NGW) {
    const bf16_t* ZB = (const bf16_t*)(a.ws + WS_Z); const float* zmeta = (const float*)(a.ws + WS_ZMETA);
    bf16_t* XA = (bf16_t*)(a.ws + WS_XA);
    const int c0 = lane * 8;
    float cw0[8], cw1[8], cw2[8], cgn[8];
#pragma unroll
    for (int j = 0; j < 8; ++j) { cw0[j] = a.conv_w[c0 + j]; cw1[j] = a.conv_w[512 + c0 + j]; cw2[j] = a.conv_w[1024 + c0 + j]; cgn[j] = a.conv_g[c0 + j]; }
    P2In cur, nxt, nx2;
    if (gw < NTOK) { p2_load(cur, ZB, gw, lane); p2_load(nxt, ZB, gw + NGW < NTOK ? gw + NGW : gw, lane); }
    for (int it = gw; it < NTOK; it += NGW) {
        {
            const int r = it, t = r & 2047;
            { const int rn = it + 2 * NGW < NTOK ? it + 2 * NGW : it; p2_load(nx2, ZB, rn, lane); }
            float gb[8], uc[8], up[8], un[8];
            unpack8(cur.w[0], gb); unpack8(cur.w[1], uc); unpack8(cur.w[2], up);
            if (t == 0) {
#pragma unroll
                for (int j = 0; j < 8; ++j) up[j] = zmeta[15 * INW + 512 + c0 + j] * zmeta[15 * INW + 1024 + c0 + j]; }
            unpack8(cur.w[3], un);
#pragma unroll
            for (int j = 0; j < 8; ++j) un[j] = (t < SEQ - 1) ? un[j] : 0.f;
            float y[8], ss = 0.f;
#pragma unroll
            for (int j = 0; j < 8; ++j) { y[j] = gb[j] * (up[j] * cw0[j] + uc[j] * cw1[j] + un[j] * cw2[j]); ss += y[j] * y[j]; }
            ss += __shfl_xor(ss, 1); ss += __shfl_xor(ss, 2); ss += __shfl_xor(ss, 4);
            const float rstd = 1.0f / sqrtf(ss * (1.0f / 64.0f) + EPS);
#pragma unroll
            for (int j = 0; j < 8; ++j) y[j] = y[j] * rstd * cgn[j];
            *(u32x4*)(XA + (size_t)r * DM + c0) = pack8(y);
            cur = nxt; nxt = nx2;
        }
    }
}
__device__ __forceinline__ void kv_meta_rows(const Args& a, int lane, int gw, int NGW) {
    const float* zmeta = (const float*)(a.ws + WS_ZMETA); bf16_t* KB = (bf16_t*)(a.ws + WS_KB); bf16_t* VB = (bf16_t*)(a.ws + WS_VB);
    const int i = lane & 7;
    for (int it = NTOK + gw; it < NTOK + NB * 64; it += NGW) {
        {
            const int it2 = it - NTOK, b = it2 >> 6, j64 = it2 & 63; const int l16 = lane & 15, g = l16 >> 3;
            float k[8], v[8];
            if (j64 < NMETA) {
                const float* zm = zmeta + j64 * INW; float ss = 0.f;
#pragma unroll
                for (int j = 0; j < 8; ++j) { k[j] = zm[2048 + l16 * 8 + j]; v[j] = zm[2176 + l16 * 8 + j]; ss += k[j] * k[j]; }
                ss += __shfl_xor(ss, 1); ss += __shfl_xor(ss, 2); ss += __shfl_xor(ss, 4);
                const float rstd = 1.0f / sqrtf(ss * (1.0f / 64.0f) + EPS);
#pragma unroll
                for (int j = 0; j < 8; ++j) k[j] = k[j] * rstd * a.kg[i * 8 + j];
            } else {
#pragma unroll
                for (int j = 0; j < 8; ++j) { k[j] = 0.f; v[j] = 0.f; }
            }
            const size_t krow = ((size_t)(b * 2 + g) * KROWS + SEQ + j64) * 64 + i * 8;
            if (lane < 16) *(u32x4*)(KB + krow) = pack8(k);
            else if (lane < 32) *(u32x4*)(VB + krow) = pack8(v);
        }
    }
}

typedef float f32x16 __attribute__((ext_vector_type(16)));
__device__ __forceinline__ void ce_desc(float& a, float& b) { float h, l; asm("v_max_f32_e32 %0, %1, %2" : "=v"(h) : "v"(a), "v"(b)); asm("v_min_f32_e32 %0, %1, %2" : "=v"(l) : "v"(a), "v"(b)); a = h; b = l; }
__device__ __forceinline__ float vmaxf(float a, float b) { float h; asm("v_max_f32_e32 %0, %1, %2" : "=v"(h) : "v"(a), "v"(b)); return h; }
template <int N> __device__ __forceinline__ void bitonic_sort_desc(float* v) {
#pragma unroll
    for (int k = 2; k <= N; k <<= 1)
#pragma unroll
        for (int j = k >> 1; j > 0; j >>= 1)
#pragma unroll
            for (int i = 0; i < N; ++i) { const int l = i ^ j; if (l > i) { if ((i & k) == 0) ce_desc(v[i], v[l]); else ce_desc(v[l], v[i]); } }
}
__device__ __forceinline__ void sort16_desc(float* v) {
    ce_desc(v[0], v[13]); ce_desc(v[1], v[12]); ce_desc(v[2], v[15]); ce_desc(v[3], v[14]); ce_desc(v[4], v[8]); ce_desc(v[5], v[6]); ce_desc(v[7], v[11]); ce_desc(v[9], v[10]);
    ce_desc(v[0], v[5]); ce_desc(v[1], v[7]); ce_desc(v[2], v[9]); ce_desc(v[3], v[4]); ce_desc(v[6], v[13]); ce_desc(v[8], v[14]); ce_desc(v[10], v[15]); ce_desc(v[11], v[12]);
    ce_desc(v[0], v[1]); ce_desc(v[2], v[3]); ce_desc(v[4], v[5]); ce_desc(v[6], v[8]); ce_desc(v[7], v[9]); ce_desc(v[10], v[11]); ce_desc(v[12], v[13]); ce_desc(v[14], v[15]);
    ce_desc(v[0], v[2]); ce_desc(v[1], v[3]); ce_desc(v[4], v[10]); ce_desc(v[5], v[11]); ce_desc(v[6], v[7]); ce_desc(v[8], v[9]); ce_desc(v[12], v[14]); ce_desc(v[13], v[15]);
    ce_desc(v[1], v[2]); ce_desc(v[3], v[12]); ce_desc(v[4], v[6]); ce_desc(v[5], v[7]); ce_desc(v[8], v[10]); ce_desc(v[9], v[11]); ce_desc(v[13], v[14]);
    ce_desc(v[1], v[4]); ce_desc(v[2], v[6]); ce_desc(v[5], v[8]); ce_desc(v[7], v[10]); ce_desc(v[9], v[13]); ce_desc(v[11], v[14]);
    ce_desc(v[2], v[4]); ce_desc(v[3], v[6]); ce_desc(v[9], v[12]); ce_desc(v[11], v[13]);
    ce_desc(v[3], v[5]); ce_desc(v[6], v[8]); ce_desc(v[7], v[9]); ce_desc(v[10], v[12]);
    ce_desc(v[3], v[4]); ce_desc(v[5], v[6]); ce_desc(v[7], v[8]); ce_desc(v[9], v[10]); ce_desc(v[11], v[12]);
    ce_desc(v[6], v[7]); ce_desc(v[8], v[9]);
}
template <int N> __device__ __forceinline__ void bitonic_merge_desc(float* v) {
#pragma unroll
    for (int j = N >> 1; j > 0; j >>= 1)
#pragma unroll
        for (int i = 0; i < N; ++i) { const int l = i ^ j; if (l > i) ce_desc(v[i], v[l]); }
}
__device__ __forceinline__ void merge_top16(float* x, const float* y) {
#pragma unroll
    for (int i = 0; i < 16; ++i) x[i] = vmaxf(x[i], y[15 - i]);
    bitonic_merge_desc<16>(x);
}
__device__ __forceinline__ void insert16(float* t, float x) {
#pragma unroll
    for (int k = 0; k < 16; ++k) ce_desc(t[k], x);
}
constexpr int SK_ROW = 272, SK_MAT = 128 * SK_ROW;
__device__ __forceinline__ void p7_half(const bf16_t* qrow  , const LAS unsigned char* skl  , int hi4, float* T) {
    f32x16 acc[4];
#pragma unroll
    for (int nb = 0; nb < 4; ++nb)
#pragma unroll
        for (int r = 0; r < 16; ++r) acc[nb][r] = 0.f;
    bf16x8 bq[8];
#pragma unroll
    for (int ks = 0; ks < 8; ++ks) bq[ks] = *(const bf16x8*)(qrow + ks * 16);
#pragma unroll
    for (int ks = 0; ks < 8; ++ks) {
#pragma unroll
        for (int nb = 0; nb < 4; ++nb) { const bf16x8 ak = *(const LAS bf16x8*)(skl + nb * 32 * SK_ROW + ks * 32); acc[nb] = __builtin_amdgcn_mfma_f32_32x32x16_bf16(ak, bq[ks], acc[nb], 0, 0, 0); }
        if (ks & 1) __builtin_amdgcn_sched_barrier(0);
    }
    float L[16];
#pragma unroll
    for (int nb = 0; nb < 4; ++nb) {
        float v[16];
#pragma unroll
        for (int r = 0; r < 16; ++r) { const float sc = acc[nb][r]; v[r] = __uint_as_float((__float_as_uint(sc) & ~127u) | (unsigned)(nb * 16 + r)); }
        sort16_desc(v);
        if (nb == 0) {
#pragma unroll
            for (int r = 0; r < 16; ++r) L[r] = v[r];
        } else merge_top16(L, v);
    }
#pragma unroll
    for (int r = 0; r < 16; ++r) { const unsigned w = __builtin_bit_cast(unsigned, L[r]); T[r] = __builtin_bit_cast(float, w + (w & 0x3Cu) + (unsigned)hi4); }
}
__device__ __forceinline__ unsigned pick_byte(unsigned p0, unsigned p1, unsigned p2, unsigned p3, unsigned i) {
    const unsigned sel = (i & 7u) | 0x0c0c0c00u;
    const unsigned lo = __builtin_amdgcn_perm(p1, p0, sel), hi = __builtin_amdgcn_perm(p3, p2, sel);
    return (i & 8u) ? hi : lo;
}
__device__ __forceinline__ void p7_topk(const Args& a, unsigned char* lds, int tid, int lane, int wave) {
    const bf16_t* QP = (const bf16_t*)(a.ws + WS_QP); const bf16_t* SUBK = (const bf16_t*)(a.ws + WS_SUBK);
    unsigned short* EIDX = (unsigned short*)(a.ws + WS_EI); float* GATE = (float*)(a.ws + WS_GT); const float* SSQ = (const float*)(a.ws + WS_SS);
    const int r32 = lane & 31, hi = lane >> 5;
    const int hp = blockIdx.x & 3, grp = blockIdx.x >> 2, ngrp = gridDim.x >> 2;
    { const u32x4* src = (const u32x4*)(SUBK + (size_t)hp * 4 * 128 * 128);
      for (int i = tid; i < 4 * 128 * 16; i += NTHR) { const int row = i >> 4, ch = i & 15; *(LAS u32x4*)((LAS unsigned char*)lds + row * SK_ROW + ch * 16) = src[i]; } }
    __syncthreads();
    const LAS unsigned char* skl = (const LAS unsigned char*)lds + r32 * SK_ROW + 16 * hi;
    for (int blk = grp * NWAVES + wave; blk < NTOK / 32; blk += ngrp * NWAVES) {
        const int tok = blk * 32 + r32;
        const float rs_l2e = 1.4426950408889634f / sqrtf(SSQ[tok] * (1.0f / DM) + EPS);
        float M0[16], M1[16];
        {
            float B0[16], B1[16];
            p7_half(QP + (size_t)tok * PQ + (2 * hp) * 256 + 8 * hi, skl + 0 * SK_MAT, 4 * hi, M0);
            p7_half(QP + (size_t)tok * PQ + (2 * hp) * 256 + 128 + 8 * hi, skl + 1 * SK_MAT, 4 * hi, M1);
            p7_half(QP + (size_t)tok * PQ + (2 * hp + 1) * 256 + 8 * hi, skl + 2 * SK_MAT, 4 * hi, B0);
            p7_half(QP + (size_t)tok * PQ + (2 * hp + 1) * 256 + 128 + 8 * hi, skl + 3 * SK_MAT, 4 * hi, B1);
#pragma unroll
            for (int i = 0; i < 16; ++i) {
                const auto r0 = __builtin_amdgcn_permlane32_swap(__builtin_bit_cast(unsigned, M0[i]), __builtin_bit_cast(unsigned, B0[i]), false, false);
                const unsigned a0 = r0[0], b0 = r0[1]; M0[i] = __builtin_bit_cast(float, a0); B0[i] = __builtin_bit_cast(float, b0);
                const auto r1 = __builtin_amdgcn_permlane32_swap(__builtin_bit_cast(unsigned, M1[i]), __builtin_bit_cast(unsigned, B1[i]), false, false);
                const unsigned a1 = r1[0], b1 = r1[1]; M1[i] = __builtin_bit_cast(float, a1); B1[i] = __builtin_bit_cast(float, b1); }
            merge_top16(M0, B0); merge_top16(M1, B1);
        }
        const int h = 2 * hp + hi;
#define CAND(i, j) __builtin_bit_cast(float, (__builtin_bit_cast(unsigned, M0[i] + M1[j]) & ~255u) | (unsigned)((i) * 16 + (j)))
        float tc[16], l2[16], l3[16];
#pragma unroll
        for (int j = 0; j < 16; ++j) tc[j] = CAND(0, j);
#pragma unroll
        for (int j = 0; j < 8; ++j) { l2[j] = CAND(1, j); l2[8 + j] = CAND(15 - j, 0); }
        bitonic_merge_desc<16>(l2);
        merge_top16(tc, l2);
        l3[0] = CAND(2, 0); l3[1] = CAND(2, 1); l3[2] = CAND(2, 2); l3[3] = CAND(2, 3); l3[4] = CAND(2, 4); l3[5] = CAND(3, 0); l3[6] = CAND(3, 1); l3[7] = CAND(3, 2); l3[8] = CAND(3, 3);
        l3[9] = CAND(4, 0); l3[10] = CAND(4, 1); l3[11] = CAND(4, 2); l3[12] = CAND(5, 0); l3[13] = CAND(5, 1); l3[14] = CAND(6, 0); l3[15] = CAND(6, 1);
        sort16_desc(l3);
        merge_top16(tc, l3);
        insert16(tc, CAND(7, 0)); insert16(tc, CAND(7, 1));
#undef CAND
#define PK4(M, q) ((__builtin_bit_cast(unsigned, M[4 * (q)]) & 127u) | ((__builtin_bit_cast(unsigned, M[4 * (q) + 1]) & 127u) << 8) | ((__builtin_bit_cast(unsigned, M[4 * (q) + 2]) & 127u) << 16) | ((__builtin_bit_cast(unsigned, M[4 * (q) + 3]) & 127u) << 24))
        const unsigned a0 = PK4(M0, 0), a1 = PK4(M0, 1), a2 = PK4(M0, 2), a3 = PK4(M0, 3), b0 = PK4(M1, 0), b1 = PK4(M1, 1), b2 = PK4(M1, 2), b3 = PK4(M1, 3);
#undef PK4
        float e[16], sum = 0.f;
#pragma unroll
        for (int k = 0; k < 16; ++k) { e[k] = exp2f((tc[k] - tc[0]) * rs_l2e); sum += e[k]; }
        const float inv = 1.0f / sum;
        int eo[16];
#pragma unroll
        for (int k = 0; k < 16; ++k) { const unsigned code = __builtin_bit_cast(unsigned, tc[k]) & 255u; eo[k] = (int)(pick_byte(a0, a1, a2, a3, code >> 4) * 128u + pick_byte(b0, b1, b2, b3, code & 15u)); e[k] *= inv; }
        unsigned short* ep = EIDX + ((size_t)tok * 8 + h) * 16; float* gp = GATE + ((size_t)tok * 8 + h) * 16;
#pragma unroll
        for (int k = 0; k < 16; k += 8) { u32x4 pk; pk.x = (unsigned)eo[k] | ((unsigned)eo[k + 1] << 16); pk.y = (unsigned)eo[k + 2] | ((unsigned)eo[k + 3] << 16); pk.z = (unsigned)eo[k + 4] | ((unsigned)eo[k + 5] << 16); pk.w = (unsigned)eo[k + 6] | ((unsigned)eo[k + 7] << 16); *(u32x4*)(ep + k) = pk; }
#pragma unroll
        for (int k = 0; k < 16; k += 4) *(f32x4*)(gp + k) = (f32x4){e[k], e[k + 1], e[k + 2], e[k + 3]};
    }
}

typedef _Float16 h2_t __attribute__((ext_vector_type(2)));
typedef float f32x2 __attribute__((ext_vector_type(2)));
__device__ __forceinline__ float dot32_fp4(u32x4 w, const h2_t* xh) {
    float acc = 0.f;
#pragma unroll
    for (int d = 0; d < 4; ++d) {
        const unsigned wd = w[d];
        acc = __builtin_amdgcn_fdot2(__builtin_amdgcn_cvt_scalef32_pk_f16_fp4(wd, 1.0f, 0), xh[4 * d], acc, false);
        acc = __builtin_amdgcn_fdot2(__builtin_amdgcn_cvt_scalef32_pk_f16_fp4(wd, 1.0f, 1), xh[4 * d + 1], acc, false);
        acc = __builtin_amdgcn_fdot2(__builtin_amdgcn_cvt_scalef32_pk_f16_fp4(wd, 1.0f, 2), xh[4 * d + 2], acc, false);
        acc = __builtin_amdgcn_fdot2(__builtin_amdgcn_cvt_scalef32_pk_f16_fp4(wd, 1.0f, 3), xh[4 * d + 3], acc, false);
    }
    return acc;
}
typedef int i32x4 __attribute__((ext_vector_type(4)));
struct PMeta { unsigned p[8]; };
#define GAS __attribute__((address_space(1)))
template <class T> __device__ __forceinline__ GAS T* sgpr_ptr(T* p) { asm volatile("" : "+s"(p)); return (GAS T*)p; }
__device__ __forceinline__ void pm_load(PMeta& m, const unsigned short* EIDX, int t  , int seg) {
    const GAS unsigned char* rb = sgpr_ptr((const unsigned char*)(EIDX + (size_t)t * 128)); const unsigned lo = (unsigned)seg * 32u;
#pragma unroll
    for (int q = 0; q < 2; ++q) { const u32x4 ev = __builtin_nontemporal_load((const GAS u32x4*)(rb + (lo + q * 16u))); m.p[4 * q] = ev.x; m.p[4 * q + 1] = ev.y; m.p[4 * q + 2] = ev.z; m.p[4 * q + 3] = ev.w; }
}
#define SCHED_FENCE() __builtin_amdgcn_sched_barrier(0)
__device__ __forceinline__ void rows16_load(u32x4 (&w)[16], const unsigned char* Tbase, unsigned lane_off, const PMeta& m) {
#pragma unroll
    for (int j = 0; j < 16; ++j) { const unsigned pw = m.p[j >> 1]; const unsigned e = (j & 1) ? (pw >> 16) : (pw & 0xffffu); w[j] = *(const u32x4*)(Tbase + (e * 128u + lane_off)); }
}
#define PEER_GEOM() const int s4 = blockIdx.x & 3, th = (blockIdx.x >> 2) & 1, wq = (blockIdx.x >> 3) * NWAVES + wave, NWQ = (gridDim.x >> 3) * NWAVES, t_beg = th * (NTOK / 2) + wq, t_end = (th + 1) * (NTOK / 2)
#define TCL(t) ((t) < t_end ? (t) : t_end - 1)
typedef int v8i_t __attribute__((ext_vector_type(8)));
struct UTok { u32x4 A[8][2]; u32x4 B[2][2]; };
__device__ __forceinline__ void u_issue(UTok& T, const unsigned char* Ts  , const unsigned char* x8row  , unsigned idlo, unsigned idhi, int lane) {
    const int r16 = lane >> 2; const unsigned c16 = (unsigned)(lane & 3) * 16u; const unsigned q16 = (unsigned)(lane >> 4) * 16u;
#pragma unroll
    for (int h = 0; h < 8; ++h) { const unsigned e = (unsigned)__shfl((int)(h < 4 ? idlo : idhi), (h & 3) * 16 + r16);
#pragma unroll
        for (int ks = 0; ks < 2; ++ks) T.A[h][ks] = *(const u32x4*)(Ts + (e * 128u + 64u * ks + c16)); }
#pragma unroll
    for (int ks = 0; ks < 2; ++ks)
#pragma unroll
        for (int hf = 0; hf < 2; ++hf) T.B[ks][hf] = __builtin_nontemporal_load((const GAS u32x4*)(sgpr_ptr(x8row) + (128u * ks + 64u * hf + q16)));
}
__device__ __forceinline__ void u_compute(const UTok& T, int lane, float* dst  ) {
    f32x4 acc[8];
#pragma unroll
    for (int h = 0; h < 8; ++h) {
        acc[h] = (f32x4){0.f, 0.f, 0.f, 0.f};
#pragma unroll
        for (int ks = 0; ks < 2; ++ks) {
            const int src = (4 * (lane & 15) + (lane >> 4)) * 4;
            const v8i_t av = {__builtin_amdgcn_ds_bpermute(src, (int)T.A[h][ks].x), __builtin_amdgcn_ds_bpermute(src, (int)T.A[h][ks].y), __builtin_amdgcn_ds_bpermute(src, (int)T.A[h][ks].z), __builtin_amdgcn_ds_bpermute(src, (int)T.A[h][ks].w), 0, 0, 0, 0};
            const v8i_t bv = {(int)T.B[ks][0].x, (int)T.B[ks][0].y, (int)T.B[ks][0].z, (int)T.B[ks][0].w, (int)T.B[ks][1].x, (int)T.B[ks][1].y, (int)T.B[ks][1].z, (int)T.B[ks][1].w};
            acc[h] = __builtin_amdgcn_mfma_scale_f32_16x16x128_f8f6f4(av, bv, acc[h], 4  , 0  , 0, 0x7F7F7F7F, 0, 0x7F7F7F7F);
        }
    }
    const int j16 = lane & 15; f32x4 r = acc[0];
#pragma unroll
    for (int h = 1; h < 8; ++h) r = (j16 == h) ? acc[h] : r;
    if (j16 < 8) __builtin_nontemporal_store(r, (GAS f32x4*)(sgpr_ptr((unsigned char*)dst) + (unsigned)(j16 * 16 + (lane >> 4) * 4) * 4u));
}
__device__ __forceinline__ void p8a_u(const Args& a, int lane, int wave) {
    const unsigned short* EIDX = (const unsigned short*)(a.ws + WS_EI); float* PB = (float*)(a.ws + WS_PB);
    PEER_GEOM();
    const unsigned char* Ts = a.ws + WS_UT + (size_t)s4 * SLICE4; const unsigned char* x8 = a.ws + WS_X8 + s4 * 256;
    float* pb = PB + (size_t)s4 * NTOK * 128;
#define IDLOAD(lo, hi, t) do { const GAS unsigned short* ip_ = sgpr_ptr(EIDX + (size_t)(t) * 128); lo = ip_[lane]; hi = ip_[64 + lane]; } while (0)
    UTok TA, TB; unsigned ia0, ia1, ib0, ib1;
    IDLOAD(ia0, ia1, TCL(t_beg)); IDLOAD(ib0, ib1, TCL(t_beg + NWQ));
    u_issue(TA, Ts, x8 + (size_t)TCL(t_beg) * DM, ia0, ia1, lane);
    IDLOAD(ia0, ia1, TCL(t_beg + 2 * NWQ));
    for (int t = t_beg; t < t_end; t += 2 * NWQ) {
        SCHED_FENCE();
        u_issue(TB, Ts, x8 + (size_t)TCL(t + NWQ) * DM, ib0, ib1, lane); IDLOAD(ib0, ib1, TCL(t + 3 * NWQ));
        SCHED_FENCE();
        u_compute(TA, lane, pb + (size_t)t * 128);
        SCHED_FENCE();
        u_issue(TA, Ts, x8 + (size_t)TCL(t + 2 * NWQ) * DM, ia0, ia1, lane); IDLOAD(ia0, ia1, TCL(t + 4 * NWQ));
        SCHED_FENCE();
        if (t + NWQ < t_end) u_compute(TB, lane, pb + (size_t)(t + NWQ) * 128);
    }
#undef IDLOAD
}
__device__ __forceinline__ void p8c_combine(const Args& a, unsigned char* lds, int tid) {
    const float* PB = (const float*)(a.ws + WS_PB); unsigned* AB = (unsigned*)(a.ws + WS_AB); const float* GATE = (const float*)(a.ws + WS_GT); const float* SS = (const float*)(a.ws + WS_SS);
    const unsigned short* EIDX = (const unsigned short*)(a.ws + WS_EI); const float* su = (const float*)(a.ws + WS_USC); const float* sv = (const float*)(a.ws + WS_VSC);
    const size_t n4 = (size_t)NTOK * 128 / 4, nth = (size_t)gridDim.x * NTHR;
    LAS float* su_l = (LAS float*)lds; LAS float* sv_l = su_l + 16384;
    for (int i = tid; i < 16384 / 4; i += NTHR) { *(LAS f32x4*)(su_l + 4 * i) = *(const f32x4*)(su + 4 * i); *(LAS f32x4*)(sv_l + 4 * i) = *(const f32x4*)(sv + 4 * i); }
    __syncthreads();
    float calib;
    { unsigned a1 = 0u; a1 = __builtin_amdgcn_cvt_scalef32_pk_fp4_f32(a1, 1.0f, 1.0f, 1.0f, 0); a1 = __builtin_amdgcn_cvt_scalef32_pk_fp4_f32(a1, 1.0f, 1.0f, 1.0f, 1);
      a1 = __builtin_amdgcn_cvt_scalef32_pk_fp4_f32(a1, 1.0f, 1.0f, 1.0f, 2); a1 = __builtin_amdgcn_cvt_scalef32_pk_fp4_f32(a1, 1.0f, 1.0f, 1.0f, 3);
      unsigned b1 = (unsigned)__builtin_amdgcn_cvt_pk_fp8_f32(1.0f, 1.0f, 0, false); b1 = (unsigned)__builtin_amdgcn_cvt_pk_fp8_f32(1.0f, 1.0f, (int)b1, true);
      const v8i_t av = {(int)a1, (int)a1, (int)a1, (int)a1, 0, 0, 0, 0}, bv = {(int)b1, (int)b1, (int)b1, (int)b1, (int)b1, (int)b1, (int)b1, (int)b1};
      const f32x4 c = __builtin_amdgcn_mfma_scale_f32_16x16x128_f8f6f4(av, bv, (f32x4){0.f, 0.f, 0.f, 0.f}, 4, 0, 0, 0x7F7F7F7F, 0, 0x7F7F7F7F);
      calib = 128.0f / c[0] * (1.0f / X8SCALE); }
    for (size_t i = (size_t)blockIdx.x * NTHR + tid; i < n4; i += nth) {
        f32x4 d = __builtin_nontemporal_load((const f32x4*)PB + i);
#pragma unroll
        for (int s2 = 1; s2 < 4; ++s2) d += __builtin_nontemporal_load((const f32x4*)PB + (size_t)s2 * n4 + i);
        const f32x4 g = __builtin_nontemporal_load((const f32x4*)GATE + i); const u32x2 ew = __builtin_nontemporal_load((const u32x2*)EIDX + i);
        const unsigned e[4] = {ew.x & 0xffffu, ew.x >> 16, ew.y & 0xffffu, ew.y >> 16}; float o[4];
        const float cr = calib / sqrtf(SS[i >> 5] * (1.0f / DM) + EPS);
#pragma unroll
        for (int j = 0; j < 4; ++j) { const float z = d[j] * su_l[e[j]] * cr; o[j] = 0.5f * z * (1.0f + erff(z * 0.70710678118654752f)) * g[j] * sv_l[e[j]]; }
        unsigned w8 = (unsigned)__builtin_amdgcn_cvt_pk_fp8_f32(o[0] * A8SCALE, o[1] * A8SCALE, 0, false); w8 = (unsigned)__builtin_amdgcn_cvt_pk_fp8_f32(o[2] * A8SCALE, o[3] * A8SCALE, (int)w8, true); AB[i] = w8;
    }
}
typedef int v2i_t __attribute__((ext_vector_type(2)));
constexpr int VROW = 144, VIMG = 128 * VROW;
struct VRec { u32x4 a8[2]; u32x2 h; };
__device__ __forceinline__ void v_token(const u32x4 (&w)[16], const VRec& rc, LAS unsigned char* vl  , float oscale, int lane, float* dst  , bool do_store) {
    const int seg = lane >> 3, c8 = lane & 7, i16 = lane & 15, q = lane >> 4;
#pragma unroll
    for (int j = 0; j < 16; ++j) *(LAS u32x4*)(vl + (seg * 16 + j) * VROW + c8 * 16) = w[j];
    asm volatile("s_waitcnt lgkmcnt(0)" ::: "memory");
    const v8i_t av = {(int)rc.a8[0].x, (int)rc.a8[0].y, (int)rc.a8[0].z, (int)rc.a8[0].w, (int)rc.a8[1].x, (int)rc.a8[1].y, (int)rc.a8[1].z, (int)rc.a8[1].w};
    const LAS unsigned char* rp = vl + (32 * q + i16) * VROW;
    float val[4] = {0.f, 0.f, 0.f, 0.f};
#pragma unroll
    for (int cb = 0; cb < 16; ++cb) {
        const v2i_t r1 = __builtin_amdgcn_ds_read_tr4_b64_v2i32((LAS v2i_t*)(rp + cb * 8)), r2 = __builtin_amdgcn_ds_read_tr4_b64_v2i32((LAS v2i_t*)(rp + 16 * VROW + cb * 8));
        const v8i_t bv = {r1.x, r1.y, r2.x, r2.y, 0, 0, 0, 0};
        const f32x4 acc = __builtin_amdgcn_mfma_scale_f32_16x16x128_f8f6f4(av, bv, (f32x4){0.f, 0.f, 0.f, 0.f}, 0  , 4  , 0, 0x7F7F7F7F, 0, 0x7F7F7F7F);
        const float a0 = acc[0]; val[cb & 3] = (q == (cb >> 2)) ? a0 : val[cb & 3];
    }
    asm volatile("s_waitcnt lgkmcnt(0)" ::: "memory");
    if (do_store) {
        *(GAS f32x4*)(sgpr_ptr((unsigned char*)dst) + (unsigned)lane * 16u) = (f32x4){bflo(rc.h.x) + val[0] * oscale, bfhi(rc.h.x) + val[1] * oscale, bflo(rc.h.y) + val[2] * oscale, bfhi(rc.h.y) + val[3] * oscale};
    } else asm volatile("" :: "v"(val[0]), "v"(val[1]), "v"(val[2]), "v"(val[3]));
}
__device__ __forceinline__ void p8b_v(const Args& a, unsigned char* lds, int lane, int wave, bool do_store) {
    const unsigned short* EIDX = (const unsigned short*)(a.ws + WS_EI); const unsigned char* AB = a.ws + WS_AB; const bf16_t* HB = (const bf16_t*)(a.ws + WS_HB);
    PEER_GEOM();
    const int seg = lane >> 3, c8 = lane & 7, q = lane >> 4;
    const unsigned char* Ts = a.ws + WS_UT + (size_t)(4 + s4) * SLICE4; const unsigned loff = c8 * 16;
    LAS unsigned char* vl = (LAS unsigned char*)lds + wave * VIMG;
    float oscale;
    { unsigned a1 = 0u; a1 = __builtin_amdgcn_cvt_scalef32_pk_fp4_f32(a1, 1.0f, 1.0f, 1.0f, 0); a1 = __builtin_amdgcn_cvt_scalef32_pk_fp4_f32(a1, 1.0f, 1.0f, 1.0f, 1);
      a1 = __builtin_amdgcn_cvt_scalef32_pk_fp4_f32(a1, 1.0f, 1.0f, 1.0f, 2); a1 = __builtin_amdgcn_cvt_scalef32_pk_fp4_f32(a1, 1.0f, 1.0f, 1.0f, 3);
      unsigned b1 = (unsigned)__builtin_amdgcn_cvt_pk_fp8_f32(1.0f, 1.0f, 0, false); b1 = (unsigned)__builtin_amdgcn_cvt_pk_fp8_f32(1.0f, 1.0f, (int)b1, true);
      const v8i_t av = {(int)b1, (int)b1, (int)b1, (int)b1, (int)b1, (int)b1, (int)b1, (int)b1}, bv = {(int)a1, (int)a1, (int)a1, (int)a1, 0, 0, 0, 0};
      const f32x4 c = __builtin_amdgcn_mfma_scale_f32_16x16x128_f8f6f4(av, bv, (f32x4){0.f, 0.f, 0.f, 0.f}, 0, 4, 0, 0x7F7F7F7F, 0, 0x7F7F7F7F);
      oscale = 128.0f / c[0] * (1.0f / A8SCALE); }
    const unsigned aoff = (unsigned)q * 16u, hoff = (unsigned)(s4 * 256 + 4 * lane) * 2u;
#define REC_LOAD(R, t) do { const GAS unsigned char* ab_ = sgpr_ptr(AB + (size_t)(t) * 128); R.a8[0] = __builtin_nontemporal_load((const GAS u32x4*)(ab_ + aoff)); R.a8[1] = __builtin_nontemporal_load((const GAS u32x4*)(ab_ + (64u + aoff))); \
        R.h = __builtin_nontemporal_load((const GAS u32x2*)(sgpr_ptr((const unsigned char*)(HB + (size_t)(t) * DM)) + hoff)); } while (0)
    PMeta mA, mB; u32x4 wA[16], wB[16]; VRec rA, rB;
    pm_load(mA, EIDX, TCL(t_beg), seg); pm_load(mB, EIDX, TCL(t_beg + NWQ), seg);
    rows16_load(wA, Ts, loff, mA); REC_LOAD(rA, TCL(t_beg));
    pm_load(mA, EIDX, TCL(t_beg + 2 * NWQ), seg);
    for (int t = t_beg; t < t_end; t += 2 * NWQ) {
        SCHED_FENCE();
        rows16_load(wB, Ts, loff, mB); REC_LOAD(rB, TCL(t + NWQ)); pm_load(mB, EIDX, TCL(t + 3 * NWQ), seg);
        SCHED_FENCE();
        v_token(wA, rA, vl, oscale, lane, a.out + (size_t)t * DM + s4 * 256, do_store);
        SCHED_FENCE();
        rows16_load(wA, Ts, loff, mA); REC_LOAD(rA, TCL(t + 2 * NWQ)); pm_load(mA, EIDX, TCL(t + 4 * NWQ), seg);
        SCHED_FENCE();
        if (t + NWQ < t_end) v_token(wB, rB, vl, oscale, lane, a.out + (size_t)(t + NWQ) * DM + s4 * 256, do_store);
    }
#undef REC_LOAD
#undef TCL
#undef PEER_GEOM
}

namespace pg8 {
#define PG8_LAS __attribute__((address_space(3)))
typedef unsigned short bf16_t;
typedef short bf16x8 __attribute__((ext_vector_type(8)));
typedef float f32x4 __attribute__((ext_vector_type(4)));
typedef unsigned u32x4 __attribute__((ext_vector_type(4)));
typedef int v4i_t __attribute__((ext_vector_type(4))); typedef int v8i_t __attribute__((ext_vector_type(8)));
constexpr int BM = 256, BK = 64, HALF = 128, HTB = HALF * BK * 2  , STAGE_BYTES = 8 * HTB, NXCD = 8, WGM = 8;

__host__ __device__ __forceinline__ int lds_byte(int r, int c) { const int st = (r >> 4) * 2 + (c >> 5), rr = r & 15, cc = c & 31, ob = rr * 64 + cc * 2; return st * 1024 + (ob ^ (((ob >> 9) & 1) << 5)); }
__host__ __device__ __forceinline__ void stage_rc(int b, int& R, int& C) { const int st = b / 1024, sb = b % 1024, swz = sb ^ (((sb >> 9) & 1) << 5); R = (st >> 1) * 16 + swz / 64; C = (st & 1) * 32 + (swz % 64) / 2; }
__host__ __device__ __forceinline__ int perm32(int rho) { const int n = rho >> 4, i = rho & 15; return 8 * (i >> 2) + 4 * n + (i & 3); }

struct Unit { int pm, pn; };
struct Gemm { const bf16_t* A; const bf16_t* Bt; int M, N, K; };

struct StaticOrder {
    int nM, nN, nwg, G, c;
    __host__ __device__ void init(int M, int N, int G_, int c_) { nM = M / BM; nN = N / BM; nwg = nM * nN; G = G_; c = c_; }
    __host__ __device__ bool next(int i, Unit& u) const {
        const long L = (long)i * G + c; if (L >= nwg) return false;
        int wgid = (int)L; { const int q = nwg / NXCD, r = nwg % NXCD, xcd = wgid % NXCD, off = wgid / NXCD; wgid = (xcd < r ? xcd * (q + 1) : r * (q + 1) + (xcd - r) * q) + off; }
        const int nig = WGM * nN, gid = wgid / nig, fm = gid * WGM, gsz = (nM - fm) < WGM ? (nM - fm) : WGM;
        u.pm = fm + ((wgid % nig) % gsz); u.pn = (wgid % nig) / gsz; return true;
    }
    __device__ __forceinline__ void a_ready(const Unit&) const {}
    __device__ __forceinline__ void done(const Unit&) const {}
};


__device__ __forceinline__ unsigned cvt_pk_bf16(float lo, float hi) { unsigned r; asm volatile("v_cvt_pk_bf16_f32 %0, %1, %2" : "=v"(r) : "v"(lo), "v"(hi)); return r; }
struct EpiInProj {
    static constexpr bool PERM = true, AFTER_DRAIN = false;
    bf16_t* O; bf16_t* QB; bf16_t* KB; bf16_t* VB; const float* rope; const float* qg; const float* kg;
    template <bool NORM> __device__ __forceinline__ void head_row(f32x4 a00, f32x4 a01, f32x4 a10, f32x4 a11, const float* g0, const float* g1, int t, int fq, bf16_t* dst  ) const {
        float x0[8] = {a00[0], a00[1], a00[2], a00[3], a01[0], a01[1], a01[2], a01[3]}, x1[8] = {a10[0], a10[1], a10[2], a10[3], a11[0], a11[1], a11[2], a11[3]};
        if (NORM) {
            float ss = 0.f;
#pragma unroll
            for (int e = 0; e < 8; ++e) ss += x0[e] * x0[e] + x1[e] * x1[e];
            ss += __shfl_xor(ss, 16); ss += __shfl_xor(ss, 32);
            const float rstd = 1.0f / sqrtf(ss * (1.0f / 64.0f) + 1e-6f);
            const float* r0 = rope + (((t >> 6) * 16 + (fq & 1) * 8) * 2); const float* r1 = rope + (((t & 63) * 16 + (fq & 1) * 8) * 2);
            f32x4 c0[4], c1[4];
#pragma unroll
            for (int q4 = 0; q4 < 4; ++q4) { c0[q4] = *(const f32x4*)(r0 + 4 * q4); c1[q4] = *(const f32x4*)(r1 + 4 * q4); }
#pragma unroll
            for (int e = 0; e < 8; ++e) { x0[e] *= rstd * g0[e]; x1[e] *= rstd * g1[e]; }
#pragma unroll
            for (int e = 0; e < 8; ++e) { const float o0 = __shfl_xor(x0[e], 32), o1 = __shfl_xor(x1[e], 32);
                const float cs0 = c0[e >> 1][(e & 1) * 2], sn0 = c0[e >> 1][(e & 1) * 2 + 1], cs1 = c1[e >> 1][(e & 1) * 2], sn1 = c1[e >> 1][(e & 1) * 2 + 1];
                x0[e] = (fq & 2) ? x0[e] * cs0 + o0 * sn0 : x0[e] * cs0 - o0 * sn0; x1[e] = (fq & 2) ? x1[e] * cs1 + o1 * sn1 : x1[e] * cs1 - o1 * sn1; }
        }
        u32x4 w; w.x = cvt_pk_bf16(x0[0], x0[1]); w.y = cvt_pk_bf16(x0[2], x0[3]); w.z = cvt_pk_bf16(x0[4], x0[5]); w.w = cvt_pk_bf16(x0[6], x0[7]); *(u32x4*)dst = w;
        w.x = cvt_pk_bf16(x1[0], x1[1]); w.y = cvt_pk_bf16(x1[2], x1[3]); w.z = cvt_pk_bf16(x1[4], x1[5]); w.w = cvt_pk_bf16(x1[6], x1[7]); *(u32x4*)(dst + 32) = w;
    }
    __device__ __forceinline__ void operator()(const f32x4 (&acc)[2][2][4][2], const Unit& u, int wr, int wc, int fr, int fq) const {
        const int row0 = u.pm * BM + wr * 64 + fr, pn = u.pn;
        if (pn < 2) {
            const int col0 = 256 * pn + wc * 32 + 8 * fq;
#pragma unroll
            for (int ai = 0; ai < 2; ++ai)
#pragma unroll
                for (int m = 0; m < 4; ++m) { bf16_t* rowp = O + (size_t)(row0 + ai * HALF + m * 16) * 1024 + col0;
#pragma unroll
                    for (int bj = 0; bj < 2; ++bj) { const f32x4 v0 = acc[ai][bj][m][0], v1 = acc[ai][bj][m][1];
                        u32x4 w; w.x = cvt_pk_bf16(v0[0], v0[1]); w.y = cvt_pk_bf16(v0[2], v0[3]); w.z = cvt_pk_bf16(v1[0], v1[1]); w.w = cvt_pk_bf16(v1[2], v1[3]);
                        *(u32x4*)(rowp + bj * HALF) = w; } }
        } else if (pn < 6) {
            const int col0 = 512 + 128 * (pn - 2) + wc * 32 + 8 * fq;
#pragma unroll
            for (int ai = 0; ai < 2; ++ai)
#pragma unroll
                for (int m = 0; m < 4; ++m) { const f32x4 v0 = acc[ai][0][m][0] * acc[ai][1][m][0], v1 = acc[ai][0][m][1] * acc[ai][1][m][1];
                    u32x4 w; w.x = cvt_pk_bf16(v0[0], v0[1]); w.y = cvt_pk_bf16(v0[2], v0[3]); w.z = cvt_pk_bf16(v1[0], v1[1]); w.w = cvt_pk_bf16(v1[2], v1[3]);
                    *(u32x4*)(O + (size_t)(row0 + ai * HALF + m * 16) * 1024 + col0) = w; }
        } else if (pn < 8) {
            float g0[8], g1[8];
#pragma unroll
            for (int e = 0; e < 8; ++e) { g0[e] = qg[8 * fq + e] * C2; g1[e] = qg[32 + 8 * fq + e] * C2; }
            const int hh = 4 * (pn - 6) + wc;
#pragma unroll
            for (int ai = 0; ai < 2; ++ai)
#pragma unroll
                for (int m = 0; m < 4; ++m) { const int r = row0 + ai * HALF + m * 16;
                    head_row<true>(acc[ai][0][m][0], acc[ai][0][m][1], acc[ai][1][m][0], acc[ai][1][m][1], g0, g1, r & 2047, fq, QB + (size_t)r * 512 + hh * 64 + 8 * fq); }
        } else {
            float g0[8], g1[8];
#pragma unroll
            for (int e = 0; e < 8; ++e) { g0[e] = kg[8 * fq + e]; g1[e] = kg[32 + 8 * fq + e]; }
            const int g = wc & 1;
#pragma unroll
            for (int ai = 0; ai < 2; ++ai)
#pragma unroll
                for (int m = 0; m < 4; ++m) { const int r = row0 + ai * HALF + m * 16, b = r >> 11, t = r & 2047; const size_t krow = ((size_t)(b * 2 + g) * KROWS + t) * 64 + 8 * fq;
                    if (wc < 2) head_row<true>(acc[ai][0][m][0], acc[ai][0][m][1], acc[ai][1][m][0], acc[ai][1][m][1], g0, g1, t, fq, KB + krow);
                    else head_row<false>(acc[ai][0][m][0], acc[ai][0][m][1], acc[ai][1][m][0], acc[ai][1][m][1], g0, g1, t, fq, VB + krow); }
        }
    }
};
struct EpiBf16 {
    static constexpr bool PERM = true, AFTER_DRAIN = false;
    bf16_t* O; int ldc; float scale;
    __device__ __forceinline__ void operator()(const f32x4 (&acc)[2][2][4][2], const Unit& u, int wr, int wc, int fr, int fq) const {
        const int row0 = u.pm * BM + wr * 64 + fr; const int col0 = u.pn * BM + wc * 32 + 8 * fq;
#pragma unroll
        for (int ai = 0; ai < 2; ++ai)
#pragma unroll
            for (int m = 0; m < 4; ++m) { bf16_t* rowp = O + (size_t)(row0 + ai * HALF + m * 16) * ldc + col0;
#pragma unroll
                for (int bj = 0; bj < 2; ++bj) { const f32x4 v0 = acc[ai][bj][m][0] * scale, v1 = acc[ai][bj][m][1] * scale;
                    u32x4 w; w.x = cvt_pk_bf16(v0[0], v0[1]); w.y = cvt_pk_bf16(v0[2], v0[3]); w.z = cvt_pk_bf16(v1[0], v1[1]); w.w = cvt_pk_bf16(v1[2], v1[3]);
                    *(u32x4*)(rowp + bj * HALF) = w; } }
    }
};
struct EpiResidNorm {
    static constexpr bool PERM = true, AFTER_DRAIN = false;
    const float* xp; const float* xs; float* out; int split_row; bf16_t* hb; unsigned char* h8; float* ss; float x8scale;
    __device__ __forceinline__ const float* xrow(int r, int col0) const { return (r < split_row ? xp + (size_t)r * 1024 : xs + (size_t)(r - split_row) * 1024) + col0; }
    __device__ __forceinline__ void operator()(const f32x4 (&acc)[2][2][4][2], const Unit& u, int wr, int wc, int fr, int fq) const {
        const int col0 = u.pn * BM + wc * 32 + 8 * fq, rbase = u.pm * BM + wr * 64 + fr;
        f32x4 xv[4][2][2];
#pragma unroll
        for (int m = 0; m < 4; ++m) { const float* xr = xrow(rbase + m * 16, col0);
#pragma unroll
            for (int bj = 0; bj < 2; ++bj) { xv[m][bj][0] = *(const f32x4*)(xr + bj * HALF); xv[m][bj][1] = *(const f32x4*)(xr + bj * HALF + 4); } }
#pragma unroll
        for (int ai = 0; ai < 2; ++ai)
#pragma unroll
            for (int m = 0; m < 4; ++m) { const int r = rbase + ai * HALF + m * 16;
                bf16_t* brow = hb + (size_t)r * 1024 + col0; unsigned char* qrow = h8 + (size_t)r * 1024 + col0; float s = 0.f;
                f32x4 h[2][2];
#pragma unroll
                for (int bj = 0; bj < 2; ++bj) { h[bj][0] = xv[m][bj][0] + acc[ai][bj][m][0]; h[bj][1] = xv[m][bj][1] + acc[ai][bj][m][1]; }
                if (ai == 0) { const float* xr = xrow(r + HALF, col0);
#pragma unroll
                    for (int bj = 0; bj < 2; ++bj) { xv[m][bj][0] = *(const f32x4*)(xr + bj * HALF); xv[m][bj][1] = *(const f32x4*)(xr + bj * HALF + 4); } }
#pragma unroll
                for (int bj = 0; bj < 2; ++bj) { const f32x4 h0 = h[bj][0], h1 = h[bj][1];
                    u32x4 wb; wb.x = cvt_pk_bf16(h0[0], h0[1]); wb.y = cvt_pk_bf16(h0[2], h0[3]); wb.z = cvt_pk_bf16(h1[0], h1[1]); wb.w = cvt_pk_bf16(h1[2], h1[3]); *(u32x4*)(brow + bj * HALF) = wb;
                    unsigned w0 = (unsigned)__builtin_amdgcn_cvt_pk_fp8_f32(h0[0] * x8scale, h0[1] * x8scale, 0, false); w0 = (unsigned)__builtin_amdgcn_cvt_pk_fp8_f32(h0[2] * x8scale, h0[3] * x8scale, (int)w0, true);
                    unsigned w1 = (unsigned)__builtin_amdgcn_cvt_pk_fp8_f32(h1[0] * x8scale, h1[1] * x8scale, 0, false); w1 = (unsigned)__builtin_amdgcn_cvt_pk_fp8_f32(h1[2] * x8scale, h1[3] * x8scale, (int)w1, true);
                    *(u32x2*)(qrow + bj * HALF) = (u32x2){w0, w1};
                    s += ((h0[0] * h0[0] + h0[1] * h0[1]) + (h0[2] * h0[2] + h0[3] * h0[3])) + ((h1[0] * h1[0] + h1[1] * h1[1]) + (h1[2] * h1[2] + h1[3] * h1[3])); }
                s += __shfl_xor(s, 16); s += __shfl_xor(s, 32);
                if (fq == 0) atomicAdd(ss + r, s); }
    }
};
struct EpiResid {
    static constexpr bool PERM = false, AFTER_DRAIN = false;
    const float* xp; const float* xs; float* out; int split_row;
    __device__ __forceinline__ void operator()(const f32x4 (&acc)[2][2][4][2], const Unit& u, int wr, int wc, int fr, int fq) const {
        const int col0 = u.pn * BM + wc * 32 + 4 * fq;
#pragma unroll
        for (int ai = 0; ai < 2; ++ai)
#pragma unroll
            for (int m = 0; m < 4; ++m) { const int r = u.pm * BM + ai * HALF + wr * 64 + m * 16 + fr;
                const float* xr = (r < split_row ? xp + (size_t)r * 1024 : xs + (size_t)(r - split_row) * 1024) + col0; float* orow = out + (size_t)r * 1024 + col0;
#pragma unroll
                for (int bj = 0; bj < 2; ++bj)
#pragma unroll
                    for (int n = 0; n < 2; ++n) { const f32x4 bs = *(const f32x4*)(xr + bj * HALF + n * 16); *(f32x4*)(orow + bj * HALF + n * 16) = bs + acc[ai][bj][m][n]; } }
    }
};

template <class Epi, class Sched, bool ALIGN_EPI = false, bool SP2 = false, bool FP8 = false>
__device__ __forceinline__ void gemm_phase(PG8_LAS unsigned char* lds, const Gemm g, const Sched& S, const Epi& E) {
    const int tid = threadIdx.x, wid = __builtin_amdgcn_readfirstlane(tid >> 6), lane = tid & 63, wr = wid >> 2, wc = wid & 3, fr = lane & 15, fq = lane >> 4;
    const int K = g.K, nt = K / BK;
    unsigned voffA[2], voffB[2];
#pragma unroll
    for (int i = 0; i < 2; ++i) { int R, C; stage_rc(tid * 16 + i * 8192, R, C); const int Rb = Epi::PERM ? ((R & ~31) + perm32(R & 31)) : R;
        voffA[i] = (unsigned)(R * K + C) * 2u; voffB[i] = (unsigned)(Rb * K + C) * 2u; }
    const size_t kstep = (size_t)(BK * 2);
    const size_t hstep = (size_t)HALF * K * 2;
    const size_t tstep = 2 * hstep;
    const unsigned ldsw = (unsigned)wid * 1024u;
    const int aoff = lds_byte(wr * 64 + fr, fq * 8), boff = lds_byte(wc * 32 + fr, fq * 8);
#define PG8_SA(b, h) (((b) * 2 + (h)) * HTB)
#define PG8_SB(b, h) ((4 + (b) * 2 + (h)) * HTB)
#define PG8_STAGE(bufoff, gbase, voff) do { _Pragma("unroll") for (int _i = 0; _i < 2; ++_i) \
        __builtin_amdgcn_global_load_lds((const unsigned*)((const char*)(gbase) + (voff)[_i]), (PG8_LAS unsigned*)(lds + (bufoff) + ldsw + _i * 8192), 16, 0, 0); } while (0)
#define PG8_LDA(dst, b, h) do { if constexpr (FP8) { _Pragma("unroll") for (int m = 0; m < 4; ++m) dst##8[m] = __builtin_shufflevector(*(const PG8_LAS v4i_t*)(lds + PG8_SA(b, h) + aoff + m * 2048), *(const PG8_LAS v4i_t*)(lds + PG8_SA(b, h) + aoff + m * 2048 + 1024), 0, 1, 2, 3, 4, 5, 6, 7); } \
        else { _Pragma("unroll") for (int m = 0; m < 4; ++m) _Pragma("unroll") for (int k = 0; k < 2; ++k) dst[m][k] = *(const PG8_LAS bf16x8*)(lds + PG8_SA(b, h) + aoff + m * 2048 + k * 1024); } } while (0)
#define PG8_LDB(dst, b, h) do { if constexpr (FP8) { _Pragma("unroll") for (int n = 0; n < 2; ++n) dst##8[n] = __builtin_shufflevector(*(const PG8_LAS v4i_t*)(lds + PG8_SB(b, h) + boff + n * 2048), *(const PG8_LAS v4i_t*)(lds + PG8_SB(b, h) + boff + n * 2048 + 1024), 0, 1, 2, 3, 4, 5, 6, 7); } \
        else { _Pragma("unroll") for (int n = 0; n < 2; ++n) _Pragma("unroll") for (int k = 0; k < 2; ++k) dst[n][k] = *(const PG8_LAS bf16x8*)(lds + PG8_SB(b, h) + boff + n * 2048 + k * 1024); } } while (0)
#define PG8_MMA(ai, bj, At, Bt) do { __builtin_amdgcn_s_setprio(1); _Pragma("unroll") for (int m = 0; m < 4; ++m) _Pragma("unroll") for (int n = 0; n < 2; ++n) { \
        if constexpr (FP8) { asm volatile("v_mfma_scale_f32_16x16x128_f8f6f4 %0, %1, %2, %0, %3, %3 op_sel_hi:[0,0,0]" : "+v"(acc[ai][bj][m][n]) : "v"(Bt##8[n]), "v"(At##8[m]), "v"(mfma_one)); } \
        else { _Pragma("unroll") for (int k = 0; k < 2; ++k) acc[ai][bj][m][n] = __builtin_amdgcn_mfma_f32_16x16x32_bf16(Bt[n][k], At[m][k], acc[ai][bj][m][n], 0, 0, 0); } } __builtin_amdgcn_s_setprio(0); } while (0)
#define PG8_WAIT_V(n) asm volatile("s_waitcnt vmcnt(" #n ")" ::: "memory")
#define PG8_WAIT_L(n) asm volatile("s_waitcnt lgkmcnt(" #n ")" ::: "memory")
#define PG8_BAR __builtin_amdgcn_s_barrier()
#define PG8_SCHED __builtin_amdgcn_sched_barrier(0)
    Unit cur, nxt; int ui = 0;
    if (!S.next(0, cur)) return;
    f32x4 acc[2][2][4][2];
#pragma unroll
    for (int a = 0; a < 2; ++a)
#pragma unroll
        for (int b = 0; b < 2; ++b)
#pragma unroll
            for (int m = 0; m < 4; ++m)
#pragma unroll
                for (int n = 0; n < 2; ++n) acc[a][b][m][n] = (f32x4){0.f, 0.f, 0.f, 0.f};
    const int mfma_one = 0x7F7F7F7F;
    bf16x8 At[4][2], B0[2][2], B1[2][2]; v8i_t At8[4], B08[2], B18[2];
    const char* cA = (const char*)g.A + (size_t)cur.pm * tstep; const char* cB = (const char*)g.Bt + (size_t)cur.pn * tstep;
    S.a_ready(cur);
    if constexpr (SP2) {
        PG8_STAGE(PG8_SB(0, 0), cB, voffB); PG8_STAGE(PG8_SB(0, 1), cB + hstep, voffB); PG8_STAGE(PG8_SA(0, 0), cA, voffA); PG8_STAGE(PG8_SA(0, 1), cA + hstep, voffA);
        if (wr == 1) PG8_BAR;
        PG8_WAIT_V(2); PG8_BAR;
        PG8_STAGE(PG8_SB(1, 0), cB + kstep, voffB); PG8_STAGE(PG8_SA(1, 0), cA + kstep, voffA); PG8_STAGE(PG8_SB(1, 1), cB + hstep + kstep, voffB);
        PG8_WAIT_V(6); PG8_BAR;
    } else {
        PG8_STAGE(PG8_SB(0, 0), cB, voffB); PG8_STAGE(PG8_SA(0, 0), cA, voffA); PG8_STAGE(PG8_SB(0, 1), cB + hstep, voffB); PG8_STAGE(PG8_SA(0, 1), cA + hstep, voffA);
        if (wr == 1) PG8_BAR;
        PG8_WAIT_V(4); PG8_BAR;
        PG8_STAGE(PG8_SB(1, 0), cB + kstep, voffB); PG8_STAGE(PG8_SA(1, 0), cA + kstep, voffA); PG8_STAGE(PG8_SB(1, 1), cB + hstep + kstep, voffB);
        PG8_WAIT_V(6); PG8_BAR;
    }
    for (;;) {
        const bool has_next = S.next(ui + 1, nxt);
        const char* nA = has_next ? (const char*)g.A + (size_t)nxt.pm * tstep : cA; const char* nB = has_next ? (const char*)g.Bt + (size_t)nxt.pn * tstep : cB;
#pragma nounroll
        for (int t = 0; t < nt; t += 2) {
            const bool last = (t == nt - 2);
            const char* a1 = cA + (size_t)(t + 1) * kstep;
            const char* a2 = last ? nA : cA + (size_t)(t + 2) * kstep; const char* b2 = last ? nB : cB + (size_t)(t + 2) * kstep;
            const char* a3 = a2 + kstep; const char* b3 = b2 + kstep;
            if (last && has_next) S.a_ready(nxt);
            if constexpr (SP2) {
            PG8_LDB(B0, 0, 0); PG8_LDB(B1, 0, 1); PG8_SCHED; PG8_LDA(At, 0, 0); PG8_STAGE(PG8_SA(1, 1), a1 + hstep, voffA);
            PG8_WAIT_V(8); PG8_WAIT_L(0); PG8_BAR; PG8_MMA(0, 0, At, B0); PG8_MMA(0, 1, At, B1); PG8_BAR; PG8_SCHED;
            PG8_LDA(At, 0, 1); PG8_STAGE(PG8_SB(0, 0), b2, voffB); PG8_STAGE(PG8_SB(0, 1), b2 + hstep, voffB); PG8_STAGE(PG8_SA(0, 0), a2, voffA);
            PG8_WAIT_V(8); PG8_WAIT_L(0); PG8_BAR; PG8_MMA(1, 0, At, B0); PG8_MMA(1, 1, At, B1); PG8_BAR; PG8_SCHED;
            PG8_LDB(B0, 1, 0); PG8_LDB(B1, 1, 1); PG8_SCHED; PG8_LDA(At, 1, 0); PG8_STAGE(PG8_SA(0, 1), a2 + hstep, voffA);
            PG8_WAIT_V(8); PG8_WAIT_L(0); PG8_BAR; PG8_MMA(0, 0, At, B0); PG8_MMA(0, 1, At, B1); PG8_BAR; PG8_SCHED;
            PG8_LDA(At, 1, 1); PG8_STAGE(PG8_SB(1, 0), b3, voffB); PG8_STAGE(PG8_SB(1, 1), b3 + hstep, voffB); PG8_STAGE(PG8_SA(1, 0), a3, voffA);
            PG8_WAIT_V(8); PG8_WAIT_L(0); PG8_BAR; PG8_MMA(1, 0, At, B0); PG8_MMA(1, 1, At, B1); PG8_BAR; PG8_SCHED;
            } else {
            PG8_LDB(B0, 0, 0); PG8_SCHED; PG8_LDA(At, 0, 0); PG8_STAGE(PG8_SA(1, 1), a1 + hstep, voffA);
            PG8_WAIT_L(8); PG8_BAR; PG8_WAIT_L(0); PG8_MMA(0, 0, At, B0); PG8_BAR; PG8_SCHED;
            PG8_LDB(B1, 0, 1); PG8_STAGE(PG8_SB(0, 0), b2, voffB);
            PG8_BAR; PG8_WAIT_L(0); PG8_MMA(0, 1, At, B1); PG8_BAR;
            PG8_LDA(At, 0, 1); PG8_STAGE(PG8_SA(0, 0), a2, voffA);
            PG8_BAR; PG8_WAIT_L(0); PG8_MMA(1, 0, At, B0); PG8_BAR; PG8_SCHED;
            PG8_STAGE(PG8_SB(0, 1), b2 + hstep, voffB);
            PG8_WAIT_V(6); PG8_BAR; PG8_MMA(1, 1, At, B1); PG8_BAR;
            PG8_LDB(B0, 1, 0); PG8_SCHED; PG8_LDA(At, 1, 0); PG8_STAGE(PG8_SA(0, 1), a2 + hstep, voffA);
            PG8_WAIT_L(8); PG8_BAR; PG8_WAIT_L(0); PG8_MMA(0, 0, At, B0); PG8_BAR; PG8_SCHED;
            PG8_LDB(B1, 1, 1); PG8_STAGE(PG8_SB(1, 0), b3, voffB);
            PG8_BAR; PG8_WAIT_L(0); PG8_MMA(0, 1, At, B1); PG8_BAR;
            PG8_LDA(At, 1, 1); PG8_STAGE(PG8_SA(1, 0), a3, voffA);
            PG8_BAR; PG8_WAIT_L(0); PG8_MMA(1, 0, At, B0); PG8_BAR; PG8_SCHED;
            PG8_STAGE(PG8_SB(1, 1), b3 + hstep, voffB);
            PG8_WAIT_V(6); PG8_BAR; PG8_MMA(1, 1, At, B1); PG8_BAR;
            }
        }
        if constexpr (ALIGN_EPI) { if (wr == 0) PG8_BAR; }
        if constexpr (FP8) asm volatile("s_nop 15\n\ts_nop 15" ::: "memory");
        if constexpr (!Epi::AFTER_DRAIN) { E(acc, cur, wr, wc, fr, fq); S.done(cur); }
        if (!has_next) break;
#pragma unroll
        for (int a = 0; a < 2; ++a)
#pragma unroll
            for (int b = 0; b < 2; ++b)
#pragma unroll
                for (int m = 0; m < 4; ++m)
#pragma unroll
                    for (int n = 0; n < 2; ++n) acc[a][b][m][n] = (f32x4){0.f, 0.f, 0.f, 0.f};
        if constexpr (FP8) asm volatile("s_nop 7" ::: "memory");
        cur = nxt; cA = nA; cB = nB; ++ui;
        if constexpr (ALIGN_EPI) { if (wr == 1) PG8_BAR; }
    }
    PG8_WAIT_V(0);
    if constexpr (!ALIGN_EPI) { if (wr == 0) PG8_BAR; }
    PG8_BAR;
    if constexpr (Epi::AFTER_DRAIN) { E.fused(acc, cur, wr, wc, fr, fq, lds, wid, lane); S.done(cur); }
#undef PG8_SA
#undef PG8_SB
#undef PG8_STAGE
#undef PG8_LDA
#undef PG8_LDB
#undef PG8_MMA
#undef PG8_WAIT_V
#undef PG8_WAIT_L
#undef PG8_BAR
#undef PG8_SCHED
}
}


#include <hip/hip_bf16.h>
#include <cmath>
namespace attn_body {
using bf16=__hip_bfloat16;
using bf16x8=__attribute__((ext_vector_type(8)))short;
using s16x4=__attribute__((ext_vector_type(4)))short;
using f32x16=__attribute__((ext_vector_type(16)))float;
using u32x4=__attribute__((ext_vector_type(4)))unsigned;
constexpr int SEQ=2048,D=64,QP=512,KVP=64,OP=1024,KVROWS=2112;
constexpr int NW=8,QBLK=32,QB=QBLK*NW,KVBLK=64,NQB=SEQ/QB,NT=KVROWS/KVBLK;
constexpr int ATTN_UNIT_ROWS=QB;
__device__ __forceinline__ int crow(int r,int hi){return (r&3)+8*(r>>2)+4*hi;}
#define SBAR() __builtin_amdgcn_sched_barrier(0)
__device__ __forceinline__ void tmask(f32x16&p0,f32x16&p1){
  const float NEG=-INFINITY;
  #pragma unroll
  for(int r=8;r<16;++r)p0[r]=NEG;
  #pragma unroll
  for(int r=0;r<16;++r)p1[r]=NEG;
}

constexpr int NSLOT=3, SLOTB=8192;
constexpr int LDS_K=0, LDS_V=NSLOT*SLOTB, LDS_WS=2*NSLOT*SLOTB, LDS_OST=LDS_WS+NW*64*4, LDS_BYTES=LDS_OST+NW*4096;
constexpr float C2=0.125f*1.4426950408889634f;
__device__ __forceinline__ void glds16(const void*gsrc,unsigned lds_dst){unsigned keep;
  asm volatile("s_mov_b32 %0, m0\n\ts_mov_b32 m0, %2\n\ts_nop 0\n\tglobal_load_lds_dwordx4 %1, off\n\ts_mov_b32 m0, %0":"=&s"(keep):"v"(gsrc),"s"(lds_dst):"memory");}
__device__ __forceinline__ float max3f(float a,float b,float c){float r;asm("v_max3_f32 %0, %1, %2, %3":"=v"(r):"v"(a),"v"(b),"v"(c));return r;}
__device__ __forceinline__ float max2f(float a,float b){float r;asm("v_max_f32_e32 %0, %1, %2":"=v"(r):"v"(a),"v"(b));return r;}
__device__ __forceinline__ float fadd_s(float a,float b){float r;asm("v_add_f32_e32 %0, %1, %2":"=v"(r):"v"(a),"v"(b));return r;}
__device__ __forceinline__ float fsub_s(float a,float b){float r;asm("v_sub_f32_e32 %0, %1, %2":"=v"(r):"v"(a),"v"(b));return r;}
typedef float f32x2_t __attribute__((ext_vector_type(2))); typedef float f32x4_t __attribute__((ext_vector_type(4))); typedef __bf16 bf16x2_t __attribute__((ext_vector_type(2)));
__device__ __forceinline__ unsigned cvtpk_s(float lo,float hi){f32x2_t v={lo,hi};bf16x2_t b=__builtin_convertvector(v,bf16x2_t);return __builtin_bit_cast(unsigned,b);}
#define WAIT_BAR(N) asm volatile("s_waitcnt vmcnt(" #N ") lgkmcnt(0)\n\ts_barrier":::"memory")

__device__ __forceinline__ void qkt(f32x16&p0,f32x16&p1,const char*Kslot,const bf16x8*qr,const f32x16&negm,int r32,int hi){
  const char*kb=Kslot+hi*1024+r32*16;
  #pragma unroll
  for(int d0=0;d0<4;++d0){
    const bf16x8 b0=*reinterpret_cast<const bf16x8*>(kb+d0*2048);
    const bf16x8 b1=*reinterpret_cast<const bf16x8*>(kb+d0*2048+512);
    if(d0==0){p0=__builtin_amdgcn_mfma_f32_32x32x16_bf16(b0,qr[0],negm,0,0,0);p1=__builtin_amdgcn_mfma_f32_32x32x16_bf16(b1,qr[0],negm,0,0,0);}
    else{p0=__builtin_amdgcn_mfma_f32_32x32x16_bf16(b0,qr[d0],p0,0,0,0);p1=__builtin_amdgcn_mfma_f32_32x32x16_bf16(b1,qr[d0],p1,0,0,0);}}
}
typedef __attribute__((address_space(3))) const char* lds_cptr;
typedef short v4i16_t __attribute__((ext_vector_type(4)));
__device__ __forceinline__ void kload8(bf16x8*kf,lds_cptr kp){
  kf[0]=*(const __attribute__((address_space(3))) bf16x8*)(kp);      kf[1]=*(const __attribute__((address_space(3))) bf16x8*)(kp+512);
  kf[2]=*(const __attribute__((address_space(3))) bf16x8*)(kp+2048); kf[3]=*(const __attribute__((address_space(3))) bf16x8*)(kp+2560);
  kf[4]=*(const __attribute__((address_space(3))) bf16x8*)(kp+4096); kf[5]=*(const __attribute__((address_space(3))) bf16x8*)(kp+4608);
  kf[6]=*(const __attribute__((address_space(3))) bf16x8*)(kp+6144); kf[7]=*(const __attribute__((address_space(3))) bf16x8*)(kp+6656);
}
__device__ __forceinline__ void kload2(bf16x8*kf,lds_cptr kp,int j){ kf[2*j]=*(const __attribute__((address_space(3))) bf16x8*)(kp+j*2048); kf[2*j+1]=*(const __attribute__((address_space(3))) bf16x8*)(kp+j*2048+512); }
__device__ __forceinline__ s16x4 vtr(lds_cptr p){ return __builtin_bit_cast(s16x4,__builtin_amdgcn_ds_read_tr16_b64_v4i16((__attribute__((address_space(3))) v4i16_t*)p)); }
__device__ __forceinline__ float rowmax(const f32x16&p0,const f32x16&p1){
  float a=max3f(p0[0],p0[1],p1[0]),b=max3f(p0[2],p0[3],p1[1]);a=max3f(a,p1[2],p1[3]);
  #pragma unroll
  for(int r=4;r<16;r+=4){a=max3f(a,p0[r],p0[r+1]);b=max3f(b,p0[r+2],p0[r+3]);a=max3f(a,p1[r],p1[r+1]);b=max3f(b,p1[r+2],p1[r+3]);}
  const float m=max2f(a,b);
  auto rr=__builtin_amdgcn_permlane32_swap(__float_as_uint(m),__float_as_uint(m),false,false);
  return max2f(__uint_as_float(rr[0]),__uint_as_float(rr[1]));
}
__device__ __forceinline__ void pv(f32x16*o,int vb,bf16x8 pa0,bf16x8 pa1,bf16x8 pa2,bf16x8 pa3){
  #pragma unroll
  for(int d0=0;d0<2;++d0){s16x4 lo[4],hi[4];
    #pragma unroll
    for(int ks=0;ks<4;++ks){
      asm volatile("ds_read_b64_tr_b16 %0,%1 offset:%c2":"=&v"(lo[ks]):"v"(vb),"i"(d0*4096+ks*1024):"memory");
      asm volatile("ds_read_b64_tr_b16 %0,%1 offset:%c2":"=&v"(hi[ks]):"v"(vb),"i"(d0*4096+ks*1024+512):"memory");}
    asm volatile("s_waitcnt lgkmcnt(0)":::"memory");SBAR();
    #define PK(k) (bf16x8){lo[k][0],lo[k][1],lo[k][2],lo[k][3],hi[k][0],hi[k][1],hi[k][2],hi[k][3]}
    o[d0]=__builtin_amdgcn_mfma_f32_32x32x16_bf16(pa0,PK(0),o[d0],0,0,0);
    o[d0]=__builtin_amdgcn_mfma_f32_32x32x16_bf16(pa1,PK(1),o[d0],0,0,0);
    o[d0]=__builtin_amdgcn_mfma_f32_32x32x16_bf16(pa2,PK(2),o[d0],0,0,0);
    o[d0]=__builtin_amdgcn_mfma_f32_32x32x16_bf16(pa3,PK(3),o[d0],0,0,0);
    #undef PK
  }
}

#ifndef ATTN_STORE16
#define ATTN_STORE16(p,v) (*(u32x4*)(p)=(v))
#endif
template<int THRL> __device__ __forceinline__ void attn_unit(int b,int h,int qb,const bf16*Q,const bf16*__restrict__ K,const bf16*__restrict__ V,bf16*O,const float*__restrict__ gain,char*shm){
  const int tid=threadIdx.x,lane=tid&63,r32=lane&31,hi=lane>>5; const int wid=__builtin_amdgcn_readfirstlane(tid>>6);
  const long rowbase=(long)b*SEQ; const int q0=qb*QB;
  const bf16*Qw=Q+(rowbase+q0+wid*QBLK)*QP+h*D;
  const bf16*Kh=K+(long)(b*2+(h>>2))*KVROWS*KVP,*Vh=V+(long)(b*2+(h>>2))*KVROWS*KVP;
  const unsigned lds0=(unsigned)(uintptr_t)shm;
  float*wsf=(float*)(shm+LDS_WS)+wid*64;
  const bf16*ksrc=Kh+(long)lane*KVP+wid*8;
  const bf16*vsrc=Vh+(long)(16*(wid&3)+(lane>>2))*KVP+(wid>>2)*32+(lane&3)*8;
  const unsigned kdst=lds0+LDS_K+wid*1024, vdst=lds0+LDS_V+wid*1024;
  #define DMA_K(t,slot) glds16(ksrc+(long)(t)*KVBLK*KVP,(unsigned)__builtin_amdgcn_readfirstlane(kdst+(slot)))
  #define DMA_V(t,slot) glds16(vsrc+(long)(t)*KVBLK*KVP,(unsigned)__builtin_amdgcn_readfirstlane(vdst+(slot)))
  const int vb0=(int)(lds0+LDS_V)+((lane>>4)&1)*32+(lane&3)*8+(4*hi+((lane&15)>>2))*64;
  const char*Kbase=shm+LDS_K; bf16x8 kf[8];
  const lds_cptr shm3=(lds_cptr)shm; const lds_cptr kp0=shm3+LDS_K+hi*1024+r32*16; const lds_cptr vp0=shm3+LDS_V+((lane>>4)&1)*32+(lane&3)*8+(4*hi+((lane&15)>>2))*64;
  DMA_K(0,0);DMA_V(0,0);DMA_K(1,SLOTB);
  bf16x8 qr[4];
  #pragma unroll
  for(int d0=0;d0<4;++d0)qr[d0]=*reinterpret_cast<const bf16x8*>(&Qw[(long)r32*QP+d0*16+hi*8]);
  float mhat=0.f,l_reg=0.f;f32x16 o[2];o[0]=f32x16{};o[1]=f32x16{};f32x16 negm=f32x16{};asm volatile("":"+v"(negm));
  #define CMASK(P0,P1,t) do{}while(0)
  bool resc=false;
  #define START(P0,P1) do{ const float rm=rowmax(P0,P1); resc=false; \
    { const float dl=rm; mhat=fadd_s(mhat,dl); \
      _Pragma("unroll") for(int r=0;r<16;++r){P0[r]=fsub_s(P0[r],dl);P1[r]=fsub_s(P1[r],dl);} \
      _Pragma("unroll") for(int r=0;r<16;++r)negm[r]=-mhat; asm volatile("":"+v"(negm)); } \
    _Pragma("unroll") for(int r=0;r<16;++r)P0[r]=__builtin_amdgcn_exp2f(P0[r]); }while(0)
  #define RESC() do{ if(resc){ asm volatile("s_waitcnt lgkmcnt(0)":::"memory"); \
      _Pragma("unroll") for(int d_=0;d_<2;++d_) _Pragma("unroll") for(int r=0;r<16;++r)o[d_][r]*=wsf[crow(r,hi)]; } }while(0)
  f32x16 pA0,pA1,pB0,pB1;
  int sl_prev=0,sl_cur=0,sl_next=SLOTB;
  #define ROT() do{sl_prev=sl_cur;sl_cur=sl_next;sl_next=(sl_next==(NSLOT-1)*SLOTB)?0:sl_next+SLOTB;}while(0)
  DMA_K(2,2*SLOTB);
  WAIT_BAR(3);
  qkt(pA0,pA1,Kbase,qr,negm,r32,hi);asm volatile("s_nop 15\n\ts_nop 7":"+v"(pA0),"+v"(pA1));CMASK(pA0,pA1,0);
  START(pA0,pA1);
  _Pragma("unroll") for(int r=0;r<16;++r)pA1[r]=__builtin_amdgcn_exp2f(pA1[r]);
  WAIT_BAR(0);
  DMA_K(3,0);DMA_V(1,SLOTB);
  ROT();
  kload8(kf,kp0+sl_cur);
  WAIT_BAR(2);
  s16x4 vlo[8],vhi[8]; u32x4 pw0,pw1,pw2,pw3;
  #define PKW(P,B) cvtpk_s(P[B],P[B+1])
  #define PAF(k) __builtin_bit_cast(bf16x8,pw##k)
  #define VFR(i) (bf16x8){vlo[i][0],vlo[i][1],vlo[i][2],vlo[i][3],vhi[i][0],vhi[i][1],vhi[i][2],vhi[i][3]}
  #define PIN(x) asm volatile("":"+v"(x))
  #define MX3(a,b,c) __builtin_fmaxf(__builtin_fmaxf((a),(b)),(c))
  #define GAPA(MF,A0,A1,A2,A3,W0,W1,PW) do{ MF; sacc+=A0; sacc+=A1; sacc+=A2; sacc+=A3; PIN(sacc); W0; W1; PIN(PW); SBAR(); }while(0)
  #define EX(v) __builtin_amdgcn_exp2f(v)
  #define GAPB(MF,X,B) do{ MF; X[B]=EX(X[B]); X[B+1]=EX(X[B+1]); X[B+2]=EX(X[B+2]); X[B+3]=EX(X[B+3]); PIN(X); SBAR(); }while(0)
  #define VRD(i) do{ vlo[i]=vtr(vp_+(((i)>>2)*4096+((i)&3)*1024)); vhi[i]=vtr(vp_+(((i)>>2)*4096+((i)&3)*1024+512)); }while(0)
  #define KRD(G,j) do{ if(G){ kload2(kf,kp0+sl_next,j); SBAR(); } }while(0)
  #define STEP(C0,C1,P0,P1,t,GK,GV,GL) do{ SBAR(); \
    const lds_cptr vp_=vp0+sl_prev; \
    VRD(0); SBAR(); float sacc=(P0[0]+P0[1]); \
    GAPA(C0=__builtin_amdgcn_mfma_f32_32x32x16_bf16(kf[0],qr[0],negm,0,0,0), P0[2],P0[3],P0[4],P0[5],     pw0[0]=PKW(P0,0), pw0[1]=PKW(P0,2), pw0); \
    VRD(4); SBAR(); GAPA(C1=__builtin_amdgcn_mfma_f32_32x32x16_bf16(kf[1],qr[0],negm,0,0,0), P0[6],P0[7],P0[8],P0[9],     pw0[2]=PKW(P0,4), pw0[3]=PKW(P0,6), pw0); \
    VRD(1); SBAR(); GAPA(C0=__builtin_amdgcn_mfma_f32_32x32x16_bf16(kf[2],qr[1],C0,0,0,0),   P0[10],P0[11],P0[12],P0[13], pw1[0]=PKW(P0,8), pw1[1]=PKW(P0,10), pw1); \
    VRD(5); SBAR(); GAPA(C1=__builtin_amdgcn_mfma_f32_32x32x16_bf16(kf[3],qr[1],C1,0,0,0),   P0[14],P0[15],P1[0],P1[1],   pw1[2]=PKW(P0,12),pw1[3]=PKW(P0,14), pw1); \
    VRD(2); SBAR(); GAPA(C0=__builtin_amdgcn_mfma_f32_32x32x16_bf16(kf[4],qr[2],C0,0,0,0),   P1[2],P1[3],P1[4],P1[5],     pw2[0]=PKW(P1,0), pw2[1]=PKW(P1,2), pw2); \
    VRD(6); SBAR(); GAPA(C1=__builtin_amdgcn_mfma_f32_32x32x16_bf16(kf[5],qr[2],C1,0,0,0),   P1[6],P1[7],P1[8],P1[9],     pw2[2]=PKW(P1,4), pw2[3]=PKW(P1,6), pw2); \
    VRD(3); SBAR(); GAPA(C0=__builtin_amdgcn_mfma_f32_32x32x16_bf16(kf[6],qr[3],C0,0,0,0),   P1[10],P1[11],P1[12],P1[13], pw3[0]=PKW(P1,8), pw3[1]=PKW(P1,10), pw3); \
    VRD(7); SBAR(); GAPA(C1=__builtin_amdgcn_mfma_f32_32x32x16_bf16(kf[7],qr[3],C1,0,0,0),   P1[14],P1[15],0.f,0.f,       pw3[2]=PKW(P1,12),pw3[3]=PKW(P1,14), pw3); \
    l_reg+=sacc; \
    if(GK){DMA_K((t)+3,sl_cur);} if(GV){DMA_V((t)+1,sl_next);} \
    CMASK(C0,C1,t); \
    { float a=MX3(C0[0],C0[1],C1[0]),b=MX3(C0[2],C0[3],C1[1]); a=MX3(a,C1[2],C1[3]); \
      _Pragma("unroll") for(int r=4;r<16;r+=4){a=MX3(a,C0[r],C0[r+1]);b=MX3(b,C0[r+2],C0[r+3]);a=MX3(a,C1[r],C1[r+1]);b=MX3(b,C1[r+2],C1[r+3]);} \
      float rm=__builtin_fmaxf(a,b); { auto rr=__builtin_amdgcn_permlane32_swap(__float_as_uint(rm),__float_as_uint(rm),false,false); rm=__builtin_fmaxf(__uint_as_float(rr[0]),__uint_as_float(rr[1])); } \
      resc=false; \
      if(__builtin_expect(__any(rm>(float)THRL),0)){ const float dl=__builtin_fmaxf(rm,0.f); mhat+=dl; \
        _Pragma("unroll") for(int r=0;r<16;++r){C0[r]-=dl;C1[r]-=dl;} \
        _Pragma("unroll") for(int r=0;r<16;++r)negm[r]=-mhat; asm volatile("":"+v"(negm)); \
        const float f=__builtin_amdgcn_exp2f(-dl); l_reg*=f; if(hi==0)wsf[r32]=f; resc=true; } } \
    SBAR(); \
    GAPB(o[0]=__builtin_amdgcn_mfma_f32_32x32x16_bf16(PAF(0),VFR(0),o[0],0,0,0), C0,0); \
    GAPB(o[1]=__builtin_amdgcn_mfma_f32_32x32x16_bf16(PAF(0),VFR(4),o[1],0,0,0), C0,4); \
    KRD(GL,0); GAPB(o[0]=__builtin_amdgcn_mfma_f32_32x32x16_bf16(PAF(1),VFR(1),o[0],0,0,0), C0,8); \
    KRD(GL,1); GAPB(o[1]=__builtin_amdgcn_mfma_f32_32x32x16_bf16(PAF(1),VFR(5),o[1],0,0,0), C0,12); \
    KRD(GL,2); GAPB(o[0]=__builtin_amdgcn_mfma_f32_32x32x16_bf16(PAF(2),VFR(2),o[0],0,0,0), C1,0); \
    KRD(GL,3); GAPB(o[1]=__builtin_amdgcn_mfma_f32_32x32x16_bf16(PAF(2),VFR(6),o[1],0,0,0), C1,4); \
    GAPB(o[0]=__builtin_amdgcn_mfma_f32_32x32x16_bf16(PAF(3),VFR(3),o[0],0,0,0), C1,8); \
    GAPB(o[1]=__builtin_amdgcn_mfma_f32_32x32x16_bf16(PAF(3),VFR(7),o[1],0,0,0), C1,12); \
    }while(0)
  int t=1;
  #undef CMASK
  #define CMASK(P0,P1,t) do{}while(0)
  for(;t+5<NT;t+=2){
    STEP(pB0,pB1,pA0,pA1,t,true,true,true);     WAIT_BAR(2); RESC(); ROT();
    STEP(pA0,pA1,pB0,pB1,t+1,true,true,true);   WAIT_BAR(2); RESC(); ROT();
  }
  #undef CMASK
  #define CMASK(P0,P1,t) do{ if((t)==NT-1)tmask(P0,P1); }while(0)
  #define ENDW(tt) do{ if((tt)+3<NT){WAIT_BAR(2);} else if((tt)+2<NT){WAIT_BAR(1);} else {WAIT_BAR(0);} }while(0)
  for(;t+1<NT;t+=2){
    STEP(pB0,pB1,pA0,pA1,t,(t+3<NT),(t+1<NT),(t+1<NT));       ENDW(t);   RESC(); ROT();
    STEP(pA0,pA1,pB0,pB1,t+1,(t+4<NT),(t+2<NT),(t+2<NT));     ENDW(t+1); RESC(); ROT();
  }
  static_assert((NT&1)==1&&NT>=7,"odd tile count: the pair loops end on tile NT-1 (scores in buffer A)");
  { float sacc=pA0[0]+pA0[1]; _Pragma("unroll") for(int r=2;r<16;++r)sacc+=pA0[r]; _Pragma("unroll") for(int r=0;r<16;++r)sacc+=pA1[r]; l_reg+=sacc;
    pw0=(u32x4){PKW(pA0,0),PKW(pA0,2),PKW(pA0,4),PKW(pA0,6)};pw1=(u32x4){PKW(pA0,8),PKW(pA0,10),PKW(pA0,12),PKW(pA0,14)};pw2=(u32x4){PKW(pA1,0),PKW(pA1,2),PKW(pA1,4),PKW(pA1,6)};pw3=(u32x4){PKW(pA1,8),PKW(pA1,10),PKW(pA1,12),PKW(pA1,14)};
    SBAR(); pv(o,vb0+sl_prev,PAF(0),PAF(1),PAF(2),PAF(3)); }
  #undef PKW
  #undef PAF
  #undef VFR
  #undef PIN
  #undef MX3
  #undef GAPA
  #undef GAPB
  #undef EX
  #undef VRD
  #undef KRD
  #undef STEP
  #undef ENDW
  {auto rr=__builtin_amdgcn_permlane32_swap(__float_as_uint(l_reg),__float_as_uint(l_reg),false,false);l_reg=__uint_as_float(rr[0])+__uint_as_float(rr[1]);}
  if(hi==0)wsf[32+r32]=l_reg;asm volatile("s_waitcnt lgkmcnt(0)":::"memory");
  float rli[16];
  #pragma unroll
  for(int r=0;r<16;++r)rli[r]=__builtin_amdgcn_rcpf(wsf[32+crow(r,hi)]);
  bf16*Ow=O+(rowbase+q0+wid*QBLK)*OP+h*D;
  { bf16*stg=(bf16*)(shm+LDS_OST)+wid*2048;
    #pragma unroll
    for(int r=0;r<16;++r){const int orow=crow(r,hi);
      #pragma unroll
      for(int d0=0;d0<2;++d0)stg[orow*64+d0*32+r32]=__float2bfloat16(o[d0][r]*rli[r]);}
    asm volatile("s_waitcnt lgkmcnt(0)":::"memory");
    #pragma unroll
    for(int i=0;i<4;++i){const int row=i*8+(lane>>3),ch=lane&7; const u32x4 v=*(const u32x4*)(stg+row*64+ch*8);
      float f[8]; f[0]=__uint_as_float(v.x<<16);f[1]=__uint_as_float(v.x&0xffff0000u);f[2]=__uint_as_float(v.y<<16);f[3]=__uint_as_float(v.y&0xffff0000u);
      f[4]=__uint_as_float(v.z<<16);f[5]=__uint_as_float(v.z&0xffff0000u);f[6]=__uint_as_float(v.w<<16);f[7]=__uint_as_float(v.w&0xffff0000u);
      float ss=0.f; _Pragma("unroll") for(int j=0;j<8;++j)ss+=f[j]*f[j];
      ss+=__shfl_xor(ss,1);ss+=__shfl_xor(ss,2);ss+=__shfl_xor(ss,4);
      const float rs=1.0f/sqrtf(ss*(1.0f/64.0f)+1e-6f); const f32x4_t g0=*(const f32x4_t*)(gain+h*D+ch*8),g1=*(const f32x4_t*)(gain+h*D+ch*8+4);
      u32x4 w; w[0]=cvtpk_s(f[0]*rs*g0[0],f[1]*rs*g0[1]);w[1]=cvtpk_s(f[2]*rs*g0[2],f[3]*rs*g0[3]);w[2]=cvtpk_s(f[4]*rs*g1[0],f[5]*rs*g1[1]);w[3]=cvtpk_s(f[6]*rs*g1[2],f[7]*rs*g1[3]);
      ATTN_STORE16(Ow+(long)row*OP+ch*8,w);} }
  asm volatile("s_waitcnt lgkmcnt(0)\n\ts_barrier":::"memory");
  #undef DMA_K
  #undef DMA_V
  #undef CMASK
  #undef START
  #undef RESC
  #undef ROT
}
constexpr int ATTN_LDS_BYTES=LDS_BYTES;
struct AttnTensors { const bf16* Q; const bf16* K; const bf16* V; bf16* O; const float* gain; };
struct AttnUnit { int b; int h; int qb; };
struct StaticOrder {
  int vcu;
  __device__ __forceinline__ explicit StaticOrder(int grid_,int block):vcu((grid_%8==0)?(block%8)*(grid_/8)+block/8:block),grid(grid_){}
  int grid;
  __device__ __forceinline__ bool next(int i,AttnUnit&u)const{ const int n=i*grid+vcu,pair=n>>5; if(pair>=48)return false; const int s=n&31; u.b=pair>>1; u.h=4*(pair&1)+(s>>3); u.qb=s&7; return true; }
};
template<class Sched,class Side,int THRL=8> __device__ __forceinline__ void attn_phase(char*lds,const AttnTensors&T,const Sched&S,int kside,const Side&side){
  AttnUnit u; int i=0;
  for(;i<kside&&S.next(i,u);++i){ attn_unit<THRL>(u.b,u.h,u.qb,T.Q,T.K,T.V,T.O,T.gain,lds); }
  side();
  for(;S.next(i,u);++i){ attn_unit<THRL>(u.b,u.h,u.qb,T.Q,T.K,T.V,T.O,T.gain,lds); }
}
#undef SBAR
#undef WAIT_BAR
}

typedef __attribute__((address_space(1))) unsigned gu32;
#define XB_TMO      128
#define XB_XCNT(j)  (256  + 64 * (j))
#define XB_XSUB(j)  (1280 + 64 * (j))
#define XB_XGEN(j)  (2304 + 64 * (j))
#define XB_TOP      3328
#define XB_TOPGEN   3392
#define XCD_BAR_WORDS 3456
#define XB_SPIN_CAP (1u << 18)

__device__ __forceinline__ unsigned xb_ld(unsigned* p)              { return __hip_atomic_load(p, __ATOMIC_RELAXED, __HIP_MEMORY_SCOPE_AGENT); }
__device__ __forceinline__ unsigned xb_add(unsigned* p, unsigned v) { return __hip_atomic_fetch_add(p, v, __ATOMIC_RELAXED, __HIP_MEMORY_SCOPE_AGENT); }
__device__ __forceinline__ unsigned xb_xcc_id() { return (unsigned)__builtin_amdgcn_s_getreg((3 << 11) | 20) & 0xFu; }
#define XB_SPIN(cond, bar) do { unsigned _sp = 0; while (cond) { __builtin_amdgcn_s_sleep(1); \
    if ((++_sp & 255u) == 0u) { if (xb_ld(&(bar)[XB_TMO])) break; if (_sp > XB_SPIN_CAP) { atomicAdd(&(bar)[XB_TMO], 1u); break; } } } } while (0)

struct XcdBarrier {
    unsigned* bar; unsigned x;
    volatile LAS unsigned* st;
};

__device__ __forceinline__ XcdBarrier xcd_barrier_post(unsigned* bar, volatile LAS unsigned* st) {
    XcdBarrier b; b.bar = bar; b.x = xb_xcc_id(); b.st = st;
    if (threadIdx.x == 0) (void)xb_add(&bar[XB_XCNT(b.x)], 1u);
    return b;
}
__device__ __forceinline__ void xcd_barrier_complete(unsigned* bar, unsigned x, unsigned& nloc, unsigned& nx) {
    const unsigned G = gridDim.x * gridDim.y * gridDim.z;
    unsigned sum, cnt, mine, sp = 0u;
    for (;;) {
        sum = 0u; cnt = 0u; mine = 0u;
#pragma unroll
        for (unsigned j = 0; j < 16; ++j) { const unsigned c = xb_ld(&bar[XB_XCNT(j)]); sum += c; cnt += (c > 0u) ? 1u : 0u; mine = (j == x) ? c : mine; }
        if (sum == G) break;
        __builtin_amdgcn_s_sleep(1);
        if ((++sp & 255u) == 0u) { if (xb_ld(&bar[XB_TMO])) break; if (sp > XB_SPIN_CAP) { atomicAdd(&bar[XB_TMO], 1u); break; } }
    }
    nloc = mine > 0u ? mine : 1u; nx = cnt > 0u ? cnt : 1u;
}

__device__ __forceinline__ void xcd_barrier(const XcdBarrier& b) {
    asm volatile("s_waitcnt vmcnt(0)" ::: "memory");
    __syncthreads();
    if (threadIdx.x == 0) {
        unsigned* bar = b.bar;
        __builtin_amdgcn_s_waitcnt(0);
        unsigned nloc = b.st[0], nx = b.st[1];
        if (nloc == 0u) { xcd_barrier_complete(bar, b.x, nloc, nx); b.st[0] = nloc; b.st[1] = nx; }
        const unsigned old = xb_add(&bar[XB_XSUB(b.x)], 1u);
        const unsigned gen = old / nloc;
        if (old + 1u == (gen + 1u) * nloc) {
            __builtin_amdgcn_fence(__ATOMIC_RELEASE, "agent");
            asm volatile("s_waitcnt vmcnt(0)" ::: "memory");
            const unsigned og = xb_add(&bar[XB_TOP], 1u);
            const unsigned tg = og / nx;
            if (og + 1u == (tg + 1u) * nx) xb_add(&bar[XB_TOPGEN], 1u);
            else XB_SPIN(xb_ld(&bar[XB_TOPGEN]) == tg, bar);
            __builtin_amdgcn_fence(__ATOMIC_ACQUIRE, "agent");
            xb_add(&bar[XB_XGEN(b.x)], 1u);
            asm volatile("s_waitcnt vmcnt(0)" ::: "memory");
        } else {
            XB_SPIN(xb_ld(&bar[XB_XGEN(b.x)]) == gen, bar);
            __builtin_amdgcn_fence(__ATOMIC_ACQUIRE, "agent");
            asm volatile("s_waitcnt vmcnt(0)" ::: "memory");
        }
    }
    __syncthreads();
}


__global__ void __launch_bounds__(NTHR, 2) enc_fwd(Args a) {
    extern __shared__ __attribute__((aligned(16))) unsigned char lds[];
    cg::grid_group grid = cg::this_grid();
    const int tid = threadIdx.x, lane = tid & 63, wave = __builtin_amdgcn_readfirstlane(tid >> 6);
    const int G = gridDim.x, gw = blockIdx.x * NWAVES + wave, NGW = G * NWAVES;
    const int lo = a.ph_lo, hi = a.ph_hi;
    volatile LAS unsigned* MISC = (volatile LAS unsigned*)((LAS unsigned char*)lds + LDS_BYTES - 64);
    if (tid < 16) MISC[tid] = 0u;
    __syncthreads();
    (void)xcd_barrier_post((unsigned*)(a.ws + WS_CTL) + 4096, MISC);
#define IN(k) (lo <= (k) && (k) < hi)
#ifndef PROBE_X2
#define PROBE_X2 -1
#endif
#define REP(k) for (int rep_ = 0; rep_ < ((k) == PROBE_X2 ? 2 : 1); ++rep_)
#define SEAM(k) do { if (IN(k) && IN((k) + 1)) { if (lo > 1000) grid.sync();   { XcdBarrier bar_; bar_.bar = (unsigned*)(a.ws + WS_CTL) + 4096; bar_.x = xb_xcc_id(); bar_.st = MISC; xcd_barrier(bar_); } } } while (0)
    if (IN(0)) REP(0) { p0_prologue(a, lds, tid, lane, wave); } SEAM(0);
    if (IN(1)) REP(1) { pg8::Gemm g{(const bf16_t*)(a.ws + WS_XA), (const bf16_t*)(a.ws + WS_WIN), NTOK, INW, DM}; pg8::StaticOrder S; S.init(NTOK, INW, G, (int)blockIdx.x);
        pg8::EpiInProj E{(bf16_t*)(a.ws + WS_Z), (bf16_t*)(a.ws + WS_Q), (bf16_t*)(a.ws + WS_KB), (bf16_t*)(a.ws + WS_VB), (const float*)(a.ws + WS_ROPE), a.qg, a.kg};
        kv_meta_rows(a, lane, gw, NGW);
        pg8::gemm_phase<pg8::EpiInProj, pg8::StaticOrder, true, true>((LAS unsigned char*)lds, g, S, E); } SEAM(1);
    if (IN(3)) REP(3) { const attn_body::AttnTensors AT{(const attn_body::bf16*)(a.ws + WS_Q), (const attn_body::bf16*)(a.ws + WS_KB), (const attn_body::bf16*)(a.ws + WS_VB), (attn_body::bf16*)(a.ws + WS_XA) + 512, a.attn_g};
        const attn_body::StaticOrder S(G, (int)blockIdx.x);
        auto side = [&]() { p2_pass(a, lane, gw, NGW);
            __syncthreads(); };
        attn_body::attn_phase<attn_body::StaticOrder>((char*)lds, AT, S, (int)((blockIdx.x >> 3) * 6) >> 5, side); } SEAM(3);
    if (IN(4)) REP(4) { pg8::Gemm g{(const bf16_t*)(a.ws + WS_XA), (const bf16_t*)(a.ws + WS_WOUT), NTOK, DM, DM}; pg8::StaticOrder S; S.init(NTOK, DM, G, (int)blockIdx.x);
        pg8::EpiResidNorm E{a.xp, a.xs, a.out, NBP * SEQ, (bf16_t*)(a.ws + WS_HB), a.ws + WS_X8, (float*)(a.ws + WS_SS), X8SCALE};
        pg8::gemm_phase<pg8::EpiResidNorm, pg8::StaticOrder, true, true>((LAS unsigned char*)lds, g, S, E); } SEAM(4);
    if (IN(6)) REP(6) { pg8::Gemm g{(const bf16_t*)(a.ws + WS_X8), (const bf16_t*)(a.ws + WS_WQ), NTOK, PQ, DM / 2}; pg8::StaticOrder S; S.init(NTOK, PQ, G, (int)blockIdx.x);
        pg8::EpiBf16 E{(bf16_t*)(a.ws + WS_QP), PQ, 1.0f / (X8SCALE * WQSCALE)};
        pg8::gemm_phase<pg8::EpiBf16, pg8::StaticOrder, true, true, true>((LAS unsigned char*)lds, g, S, E); } SEAM(6);
    if (IN(7)) REP(7) { p7_topk(a, lds, tid, lane, wave);
        table_fp4<false>(a.pu, a.ws + WS_UT, (float*)(a.ws + WS_USC), a.g_ffn, gw, NGW, lane);
        table_fp4<true>(a.pv, a.ws + WS_UT + 4 * SLICE4, (float*)(a.ws + WS_VSC), nullptr, gw, NGW, lane);
        __syncthreads(); } SEAM(7);
    if (IN(8)) REP(8) { p8a_u(a, lane, wave); } SEAM(8);
    if (IN(9)) REP(9) { p8c_combine(a, lds, tid); __syncthreads(); } SEAM(9);
    if (IN(10)) REP(10) { p8b_v(a, lds, lane, wave, rep_ == ((10 == PROBE_X2) ? 1 : 0)); }
#undef IN
#undef SEAM
}

extern "C" void kernel_launch(void* const* d_in, const int* in_sizes, int n_in, void* d_out, int out_size, void* d_ws, size_t ws_size, hipStream_t stream) {
    static int grid = 0;
    if (grid == 0) {
        if (n_in != 16 || out_size != NTOK * DM || ws_size < WS_END) { fprintf(stderr, "kernel_launch: unexpected shapes (n_in %d out %d ws %zu)\n", n_in, out_size, ws_size); grid = -1; return; }
        int dev = 0, cus = 0, per_cu = 0;
        (void)hipGetDevice(&dev); (void)hipDeviceGetAttribute(&cus, hipDeviceAttributeMultiprocessorCount, dev);
        (void)hipFuncSetAttribute((const void*)enc_fwd, hipFuncAttributeMaxDynamicSharedMemorySize, LDS_BYTES);
        (void)hipOccupancyMaxActiveBlocksPerMultiprocessor(&per_cu, (const void*)enc_fwd, NTHR, LDS_BYTES);
        if (per_cu < 1) { fprintf(stderr, "kernel_launch: occupancy query says %d blocks/CU\n", per_cu); per_cu = 1; }
        (void)hipGetLastError();
        grid = cus * 1;
    }
    if (grid < 0) return;
    (void)hipMemsetAsync((char*)d_ws + WS_CTL, 0, 64 * 1024, stream);
    Args a{};
    a.xp = (const float*)d_in[0]; a.xs = (const float*)d_in[1]; a.meta = (const float*)d_in[2]; a.g_mix = (const float*)d_in[3]; a.w_in = (const float*)d_in[4];
    a.conv_w = (const float*)d_in[5]; a.qg = (const float*)d_in[6]; a.kg = (const float*)d_in[7]; a.conv_g = (const float*)d_in[8]; a.attn_g = (const float*)d_in[9];
    a.w_out = (const float*)d_in[10]; a.g_ffn = (const float*)d_in[11]; a.wq = (const float*)d_in[12]; a.subk = (const float*)d_in[13]; a.pu = (const float*)d_in[14]; a.pv = (const float*)d_in[15];
    a.out = (float*)d_out; a.ws = (unsigned char*)d_ws;
    constexpr int NL = MK_N_LAUNCHES;
    for (int li = 0; li < NL; ++li) {
        a.ph_lo = (NL == 1) ? 0 : li; a.ph_hi = (NL == 1) ? NPHASE : li + 1;
        void* args[] = {&a};
        hipError_t e = hipLaunchCooperativeKernel((const void*)enc_fwd, dim3(grid), dim3(NTHR), args, LDS_BYTES, stream);
        if (e != hipSuccess) { fprintf(stderr, "kernel_launch: launch %d failed: %s\n", li, hipGetErrorString(e)); break; }
    }
}
```

```cpp
#include <hip/hip_runtime.h>
#include <hip/hip_cooperative_groups.h>
#include <cstdint>
#include <cstdio>
namespace cg = cooperative_groups;

#ifndef MK_N_LAUNCHES
#define MK_N_LAUNCHES 1
#endif

typedef unsigned short bf16_t;
typedef short bf16x8 __attribute__((ext_vector_type(8)));
typedef float f32x4 __attribute__((ext_vector_type(4)));
typedef unsigned u32x4 __attribute__((ext_vector_type(4)));
typedef unsigned u32x2 __attribute__((ext_vector_type(2)));
#define LAS __attribute__((address_space(3)))

constexpr int NB = 24, NBP = 16, SEQ = 2048, DM = 1024, NTOK = NB * SEQ;
constexpr int NMETA = 16, INW = 2304, KROWS = 2112;
constexpr int NKEYS = SEQ + NMETA;
constexpr int PQ = 2048;
constexpr float EPS = 1e-6f;
constexpr float C2 = 0.125f * 1.4426950408889634f;
constexpr int NWAVES = 8, NTHR = 512;
constexpr int LDS_BYTES = 163840;
constexpr int NPHASE = 11;

constexpr size_t MiB = 1u << 20;
constexpr size_t WS_CTL = 0;
constexpr size_t WS_WIN = 1 * MiB;
constexpr size_t WS_WOUT = 6 * MiB;
constexpr size_t WS_WQ = 8 * MiB;
constexpr size_t WS_SUBK = 12 * MiB;
constexpr size_t WS_ZMETA = 12 * MiB + 512 * 1024;
constexpr size_t WS_ROPE = WS_ZMETA + 256 * 1024;
constexpr size_t WS_UT = 13 * MiB;
constexpr size_t WS_USC = 29 * MiB, WS_VSC = WS_USC + 64 * 1024;
constexpr size_t WS_SS = WS_USC + 256 * 1024;
constexpr size_t SLICE4 = (size_t)16384 * 128;
constexpr size_t WS_XA = 32 * MiB;
constexpr size_t WS_EI = WS_XA, WS_GT = WS_XA + 12 * MiB;
constexpr size_t WS_Z = 128 * MiB;
constexpr size_t WS_HB = WS_Z;
constexpr size_t WS_QP = WS_Z + 96 * MiB;
constexpr size_t WS_PB = WS_QP;
constexpr size_t WS_AB = WS_PB + (size_t)4 * 49152 * 128 * 4;
constexpr size_t WS_Q = 416 * MiB;
constexpr size_t WS_X8 = WS_Q;
constexpr size_t WS_KB = 464 * MiB;
constexpr size_t WS_VB = 477 * MiB;
constexpr size_t WS_END = 490 * MiB;
constexpr float X8SCALE = 8.0f;
constexpr float WQSCALE = 64.0f;
constexpr float A8SCALE = 256.0f;

struct Args {
    const float* xp; const float* xs; const float* meta; const float* g_mix; const float* w_in; const float* conv_w;
    const float* qg; const float* kg; const float* conv_g; const float* attn_g; const float* w_out; const float* g_ffn;
    const float* wq; const float* subk; const float* pu; const float* pv;
    float* out; unsigned char* ws; int ph_lo, ph_hi;
};

__device__ __forceinline__ unsigned f2bf(float f) { unsigned u = __builtin_bit_cast(unsigned, f); return (u + 0x7fffu + ((u >> 16) & 1u)) >> 16; }
typedef float f32x2_pk __attribute__((ext_vector_type(2))); typedef __bf16 bf16x2_pk __attribute__((ext_vector_type(2)));
__device__ __forceinline__ unsigned pk2(float lo, float hi) { const f32x2_pk v = {lo, hi}; const bf16x2_pk b = __builtin_convertvector(v, bf16x2_pk); return __builtin_bit_cast(unsigned, b); }
__device__ __forceinline__ float bflo(unsigned w) { return __builtin_bit_cast(float, w << 16); }
__device__ __forceinline__ float bfhi(unsigned w) { return __builtin_bit_cast(float, w & 0xffff0000u); }
__device__ __forceinline__ float bf2f(bf16_t h) { return __builtin_bit_cast(float, (unsigned)h << 16); }
__device__ __forceinline__ void unpack8(u32x4 w, float* f) {
    f[0] = bflo(w.x); f[1] = bfhi(w.x); f[2] = bflo(w.y); f[3] = bfhi(w.y); f[4] = bflo(w.z); f[5] = bfhi(w.z); f[6] = bflo(w.w); f[7] = bfhi(w.w);
}
__device__ __forceinline__ u32x4 pack8(const float* f) { u32x4 w; w.x = pk2(f[0], f[1]); w.y = pk2(f[2], f[3]); w.z = pk2(f[4], f[5]); w.w = pk2(f[6], f[7]); return w; }
__device__ __forceinline__ float wave_sum(float v) {
#pragma unroll
    for (int o = 1; o < 64; o <<= 1) v += __shfl_xor(v, o);
    return v;
}
__device__ __forceinline__ float wave_max(float v) {
#pragma unroll
    for (int o = 1; o < 64; o <<= 1) v = fmaxf(v, __shfl_xor(v, o));
    return v;
}
__device__ __forceinline__ const float* xrow_ptr(const Args& a, int r) { return r < NBP * SEQ ? a.xp + (size_t)r * DM : a.xs + (size_t)(r - NBP * SEQ) * DM; }

__device__ __forceinline__ int permin(int n  ) {
    if (n >= 512 && n < 1536) { const int hc = (n - 512) >> 9, c = (n - 512) & 511; return 512 + (c >> 7) * 256 + hc * 128 + (c & 127); }
    if (n >= 1536 && n < 2048) { const int c = n - 1536, hh = c >> 6, half = (c >> 5) & 1; return 1536 + 256 * (hh >> 2) + 128 * half + 32 * (hh & 3) + (c & 31); }
    if (n >= 2048) { const int c = n - 2048, s = c >> 6, half = (c >> 5) & 1; return 2048 + 128 * half + 32 * s + (c & 31); }
    return n; }
__device__ __forceinline__ void p0_transpose_item(const float* W, int K, int N, bf16_t* WT, float* scr, int item, int lane, const float* gk = nullptr  , bool dperm = false) {
    const int nblk = N / 32, kb = item / nblk, nb = item % nblk, k0 = 64 * kb, n0 = 32 * nb, nd0 = dperm ? permin(n0) : n0;
#pragma unroll 8
    for (int i = 0; i < 32; ++i) { const int kk = 2 * i + (lane >> 5); scr[kk * 33 + (lane & 31)] = W[(size_t)(k0 + kk) * N + n0 + (lane & 31)] * (gk ? gk[k0 + kk] : 1.0f); }
    asm volatile("s_waitcnt lgkmcnt(0)" ::: "memory");
    const int c = lane & 7;
#pragma unroll
    for (int j = 0; j < 4; ++j) { const int n = (lane >> 3) + 8 * j; const float* s = scr + (8 * c) * 33 + n;
        u32x4 o; o.x = pk2(s[0 * 33], s[1 * 33]); o.y = pk2(s[2 * 33], s[3 * 33]); o.z = pk2(s[4 * 33], s[5 * 33]); o.w = pk2(s[6 * 33], s[7 * 33]);
        *(u32x4*)(WT + (size_t)(nd0 + n) * K + k0 + 8 * c) = o; }
    asm volatile("s_waitcnt lgkmcnt(0)" ::: "memory");
}
__device__ __forceinline__ void p0_transpose_item_fp8(const float* W, int K, int N, unsigned char* WT, float* scr, int item, int lane, const float* gk, float wscale) {
    const int nblk = N / 32, kb = item / nblk, nb = item % nblk, k0 = 64 * kb, n0 = 32 * nb;
#pragma unroll 8
    for (int i = 0; i < 32; ++i) { const int kk = 2 * i + (lane >> 5); scr[kk * 33 + (lane & 31)] = W[(size_t)(k0 + kk) * N + n0 + (lane & 31)] * (gk[k0 + kk] * wscale); }
    asm volatile("s_waitcnt lgkmcnt(0)" ::: "memory");
    const int c = lane & 7;
#pragma unroll
    for (int j = 0; j < 4; ++j) { const int n = (lane >> 3) + 8 * j; const float* s = scr + (8 * c) * 33 + n;
        unsigned w0 = (unsigned)__builtin_amdgcn_cvt_pk_fp8_f32(s[0 * 33], s[1 * 33], 0, false); w0 = (unsigned)__builtin_amdgcn_cvt_pk_fp8_f32(s[2 * 33], s[3 * 33], (int)w0, true);
        unsigned w1 = (unsigned)__builtin_amdgcn_cvt_pk_fp8_f32(s[4 * 33], s[5 * 33], 0, false); w1 = (unsigned)__builtin_amdgcn_cvt_pk_fp8_f32(s[6 * 33], s[7 * 33], (int)w1, true);
        *(u32x2*)(WT + (size_t)(n0 + n) * K + k0 + 8 * c) = (u32x2){w0, w1}; }
    asm volatile("s_waitcnt lgkmcnt(0)" ::: "memory");
}
__device__ __forceinline__ void cast_region(const float* src, bf16_t* dst, size_t n, size_t gtid, size_t nthreads) {
    for (size_t i = gtid * 8; i < n; i += nthreads * 8) {
        const f32x4 a = *(const f32x4*)(src + i), b = *(const f32x4*)(src + i + 4);
        u32x4 o; o.x = pk2(a.x, a.y); o.y = pk2(a.z, a.w); o.z = pk2(b.x, b.y); o.w = pk2(b.z, b.w);
        *(u32x4*)(dst + i) = o;
    }
}
template <bool PERM64> __device__ __forceinline__ void table_fp4(const float* src, unsigned char* dst, float* scale, const float* gcol  , int gw, int NGW, int lane) {
    f32x4 v[4], vn[4], g[4];
#pragma unroll
    for (int j = 0; j < 4; ++j) g[j] = gcol ? *(const f32x4*)(gcol + lane * 16 + 4 * j) : (f32x4){1.f, 1.f, 1.f, 1.f};
    if (gw < 16384) {
#pragma unroll
        for (int j = 0; j < 4; ++j) v[j] = __builtin_nontemporal_load((const f32x4*)(src + (size_t)gw * DM + lane * 16 + 4 * j)); }
    for (int row = gw; row < 16384; row += NGW) {
        { const int rn = row + NGW < 16384 ? row + NGW : row;
#pragma unroll
          for (int j = 0; j < 4; ++j) vn[j] = __builtin_nontemporal_load((const f32x4*)(src + (size_t)rn * DM + lane * 16 + 4 * j)); }
        float m = 0.f;
#pragma unroll
        for (int j = 0; j < 4; ++j) { v[j] = v[j] * g[j]; m = fmaxf(fmaxf(m, fmaxf(fabsf(v[j].x), fabsf(v[j].y))), fmaxf(fabsf(v[j].z), fabsf(v[j].w))); }
        m = wave_max(m);
        const float s = fmaxf(m, 1e-30f) * (1.0f / 6.0f), inv = 1.0f / s;
        unsigned char* rowp = dst + (size_t)(lane >> 4) * SLICE4 + (size_t)row * 128;
        if (!PERM64) {
            unsigned w0 = 0u, w1 = 0u;
            w0 = __builtin_amdgcn_cvt_scalef32_pk_fp4_f32(w0, v[0].x * inv, v[0].y * inv, 1.0f, 0); w0 = __builtin_amdgcn_cvt_scalef32_pk_fp4_f32(w0, v[0].z * inv, v[0].w * inv, 1.0f, 1);
            w0 = __builtin_amdgcn_cvt_scalef32_pk_fp4_f32(w0, v[1].x * inv, v[1].y * inv, 1.0f, 2); w0 = __builtin_amdgcn_cvt_scalef32_pk_fp4_f32(w0, v[1].z * inv, v[1].w * inv, 1.0f, 3);
            w1 = __builtin_amdgcn_cvt_scalef32_pk_fp4_f32(w1, v[2].x * inv, v[2].y * inv, 1.0f, 0); w1 = __builtin_amdgcn_cvt_scalef32_pk_fp4_f32(w1, v[2].z * inv, v[2].w * inv, 1.0f, 1);
            w1 = __builtin_amdgcn_cvt_scalef32_pk_fp4_f32(w1, v[3].x * inv, v[3].y * inv, 1.0f, 2); w1 = __builtin_amdgcn_cvt_scalef32_pk_fp4_f32(w1, v[3].z * inv, v[3].w * inv, 1.0f, 3);
            *(u32x2*)(rowp + (lane & 15) * 8) = (u32x2){w0, w1};
        } else {
            unsigned char* gp = rowp + ((lane & 15) >> 2) * 32 + (lane & 3) * 2;
#pragma unroll
            for (int m = 0; m < 4; ++m) { unsigned wm = 0u;
                wm = __builtin_amdgcn_cvt_scalef32_pk_fp4_f32(wm, v[0][m] * inv, v[1][m] * inv, 1.0f, 0); wm = __builtin_amdgcn_cvt_scalef32_pk_fp4_f32(wm, v[2][m] * inv, v[3][m] * inv, 1.0f, 1);
                *(unsigned short*)(gp + 8 * m) = (unsigned short)wm; }
        }
        if (lane == 0) scale[row] = s;
#pragma unroll
        for (int j = 0; j < 4; ++j) v[j] = vn[j];
    }
}
__device__ __forceinline__ void p0_prologue(const Args& a, unsigned char* lds, int tid, int lane, int wave) {
    const int G = gridDim.x, gw = blockIdx.x * NWAVES + wave, NGW = G * NWAVES;
    float* ldsf = (float*)lds;
    if (blockIdx.x < INW / 64) {
        float* xm = ldsf;
        float* red = ldsf + 16 * 1024;
#pragma unroll
        for (int rr = 0; rr < 2; ++rr) { const int r = 2 * wave + rr; f32x4 v[4]; float ss = 0.f;
#pragma unroll
            for (int j = 0; j < 4; ++j) { v[j] = *(const f32x4*)(a.meta + (size_t)r * DM + (lane + 64 * j) * 4); ss += v[j].x * v[j].x + v[j].y * v[j].y + v[j].z * v[j].z + v[j].w * v[j].w; }
            const float rstd = 1.0f / sqrtf(wave_sum(ss) * (1.0f / DM) + EPS);
#pragma unroll
            for (int j = 0; j < 4; ++j) { const int c = (lane + 64 * j) * 4; const f32x4 g = *(const f32x4*)(a.g_mix + c); *(f32x4*)(xm + r * 1024 + c) = v[j] * rstd * g; }
        }
        __syncthreads();
        const int n0 = blockIdx.x * 64, k0 = wave * 128;
        float acc[16];
#pragma unroll
        for (int r = 0; r < 16; ++r) acc[r] = 0.f;
        for (int kb = k0; kb < k0 + 128; kb += 16) { float wv[16];
#pragma unroll
            for (int q = 0; q < 16; ++q) wv[q] = a.w_in[(size_t)(kb + q) * INW + n0 + lane];
#pragma unroll
            for (int q = 0; q < 16; ++q)
#pragma unroll
                for (int r = 0; r < 16; ++r) acc[r] += xm[r * 1024 + kb + q] * wv[q]; }
#pragma unroll
        for (int r = 0; r < 16; ++r) red[(wave * 16 + r) * 64 + lane] = acc[r];
        __syncthreads();
        float* zmeta = (float*)(a.ws + WS_ZMETA);
        for (int o = tid; o < 1024; o += NTHR) { const int r = o >> 6, c = o & 63; float s = 0.f;
#pragma unroll
            for (int w = 0; w < 8; ++w) s += red[(w * 16 + r) * 64 + c];
            zmeta[r * INW + n0 + c] = s; }
        __syncthreads();
    }
    if (blockIdx.x == INW / 64) {
        float* rope = (float*)(a.ws + WS_ROPE);
        for (int i = tid; i < 64 * 16; i += NTHR) { const int pos = i >> 4, f = i & 15;
            const float freq = exp2f(-(float)f * (13.287712379549449f / 16.0f)); const float rev = (float)pos * freq * 0.15915494309189535f; const float fr = rev - floorf(rev);
            rope[2 * i] = __builtin_amdgcn_cosf(fr); rope[2 * i + 1] = __builtin_amdgcn_sinf(fr); }
    }
    if ((int)blockIdx.x > INW / 64 || G <= INW / 64 + 1) {
        float* scr = ldsf + wave * (64 * 33);
        constexpr int I_IN = (DM / 64) * (INW / 32), I_OUT = (DM / 64) * (DM / 32), I_WQ = (DM / 64) * (PQ / 32);
        const int first = (G <= INW / 64 + 1) ? 0 : INW / 64 + 1, nw = (G - first) * NWAVES;
        for (int it = ((int)blockIdx.x - first) * NWAVES + wave; it < I_IN + I_OUT + I_WQ; it += nw) {
            int r = it;
            if (r < I_IN) { p0_transpose_item(a.w_in, DM, INW, (bf16_t*)(a.ws + WS_WIN), scr, r, lane, nullptr, true); continue; } r -= I_IN;
            if (r < I_OUT) { p0_transpose_item(a.w_out, DM, DM, (bf16_t*)(a.ws + WS_WOUT), scr, r, lane); continue; } r -= I_OUT;
            p0_transpose_item_fp8(a.wq, DM, PQ, a.ws + WS_WQ, scr, r, lane, a.g_ffn, WQSCALE);
        }
    }
    {
        const size_t gtid = (size_t)blockIdx.x * NTHR + tid, nth = (size_t)G * NTHR;
        cast_region(a.subk, (bf16_t*)(a.ws + WS_SUBK), (size_t)16 * 128 * 128, gtid, nth);
        for (size_t i = gtid; i < (size_t)NTOK; i += nth) ((float*)(a.ws + WS_SS))[i] = 0.f;
    }
    {
        bf16_t* XA = (bf16_t*)(a.ws + WS_XA);
        f32x4 g[4], v[4], vn[4];
#pragma unroll
        for (int j = 0; j < 4; ++j) g[j] = *(const f32x4*)(a.g_mix + (lane + 64 * j) * 4);
        if (gw < NTOK) { const float* xr = xrow_ptr(a, gw);
#pragma unroll
            for (int j = 0; j < 4; ++j) v[j] = __builtin_nontemporal_load((const f32x4*)(xr + (lane + 64 * j) * 4)); }
        for (int r = gw; r < NTOK; r += NGW) {
            { const float* xn = xrow_ptr(a, r + NGW < NTOK ? r + NGW : r);
#pragma unroll
              for (int j = 0; j < 4; ++j) vn[j] = __builtin_nontemporal_load((const f32x4*)(xn + (lane + 64 * j) * 4)); }
            float ss = 0.f;
#pragma unroll
            for (int j = 0; j < 4; ++j) ss += v[j].x * v[j].x + v[j].y * v[j].y + v[j].z * v[j].z + v[j].w * v[j].w;
            const float rstd = 1.0f / sqrtf(wave_sum(ss) * (1.0f / DM) + EPS);
#pragma unroll
            for (int j = 0; j < 4; ++j) { const int c = (lane + 64 * j) * 4; const f32x4 o = v[j] * rstd * g[j];
                u32x2 w; w.x = pk2(o.x, o.y); w.y = pk2(o.z, o.w); *(u32x2*)(XA + (size_t)r * DM + c) = w; }
#pragma unroll
            for (int j = 0; j < 4; ++j) v[j] = vn[j];
        }
    }
}

constexpr int ZW = 1024;
struct P2In { u32x4 w[4]; };
__device__ __forceinline__ void p2_load(P2In& in, const bf16_t* ZB, int r, int lane) {
    const int t = r & 2047, c0 = lane * 8; const bf16_t* zr = ZB + (size_t)r * ZW;
    const bf16_t* zp = (t > 0) ? zr - ZW : zr; const bf16_t* zn = (t < SEQ - 1) ? zr + ZW : zr;
    in.w[0] = *(const u32x4*)(zr + c0); in.w[1] = *(const u32x4*)(zr + 512 + c0); in.w[2] = *(const u32x4*)(zp + 512 + c0); in.w[3] = *(const u32x4*)(zn + 512 + c0);
}
__device__ __forceinline__ void p2_pass(const Args& a, int lane, int gw, int NGW) {
    const bf16_t* ZB = (const bf16_t*)(a.ws + WS_Z); const float* zmeta = (const float*)(a.ws + WS_ZMETA);
    bf16_t* XA = (bf16_t*)(a.ws + WS_XA);
    const int c0 = lane * 8;
    float cw0[8], cw1[8], cw2[8], cgn[8];
#pragma unroll
    for (int j = 0; j < 8; ++j) { cw0[j] = a.conv_w[c0 + j]; cw1[j] = a.conv_w[512 + c0 + j]; cw2[j] = a.conv_w[1024 + c0 + j]; cgn[j] = a.conv_g[c0 + j]; }
    P2In cur, nxt, nx2;
    if (gw < NTOK) { p2_load(cur, ZB, gw, lane); p2_load(nxt, ZB, gw + NGW < NTOK ? gw + NGW : gw, lane); }
    for (int it = gw; it < NTOK; it += NGW) {
        {
            const int r = it, t = r & 2047;
            { const int rn = it + 2 * NGW < NTOK ? it + 2 * NGW : it; p2_load(nx2, ZB, rn, lane); }
            float gb[8], uc[8], up[8], un[8];
            unpack8(cur.w[0], gb); unpack8(cur.w[1], uc); unpack8(cur.w[2], up);
            if (t == 0) {
#pragma unroll
                for (int j = 0; j < 8; ++j) up[j] = zmeta[15 * INW + 512 + c0 + j] * zmeta[15 * INW + 1024 + c0 + j]; }
            unpack8(cur.w[3], un);
#pragma unroll
            for (int j = 0; j < 8; ++j) un[j] = (t < SEQ - 1) ? un[j] : 0.f;
            float y[8], ss = 0.f;
#pragma unroll
            for (int j = 0; j < 8; ++j) { y[j] = gb[j] * (up[j] * cw0[j] + uc[j] * cw1[j] + un[j] * cw2[j]); ss += y[j] * y[j]; }
            ss += __shfl_xor(ss, 1); ss += __shfl_xor(ss, 2); ss += __shfl_xor(ss, 4);
            const float rstd = 1.0f / sqrtf(ss * (1.0f / 64.0f) + EPS);
#pragma unroll
            for (int j = 0; j < 8; ++j) y[j] = y[j] * rstd * cgn[j];
            *(u32x4*)(XA + (size_t)r * DM + c0) = pack8(y);
            cur = nxt; nxt = nx2;
        }
    }
}
__device__ __forceinline__ void kv_meta_rows(const Args& a, int lane, int gw, int NGW) {
    const float* zmeta = (const float*)(a.ws + WS_ZMETA); bf16_t* KB = (bf16_t*)(a.ws + WS_KB); bf16_t* VB = (bf16_t*)(a.ws + WS_VB);
    const int i = lane & 7;
    for (int it = NTOK + gw; it < NTOK + NB * 64; it += NGW) {
        {
            const int it2 = it - NTOK, b = it2 >> 6, j64 = it2 & 63; const int l16 = lane & 15, g = l16 >> 3;
            float k[8], v[8];
            if (j64 < NMETA) {
                const float* zm = zmeta + j64 * INW; float ss = 0.f;
#pragma unroll
                for (int j = 0; j < 8; ++j) { k[j] = zm[2048 + l16 * 8 + j]; v[j] = zm[2176 + l16 * 8 + j]; ss += k[j] * k[j]; }
                ss += __shfl_xor(ss, 1); ss += __shfl_xor(ss, 2); ss += __shfl_xor(ss, 4);
                const float rstd = 1.0f / sqrtf(ss * (1.0f / 64.0f) + EPS);
#pragma unroll
                for (int j = 0; j < 8; ++j) k[j] = k[j] * rstd * a.kg[i * 8 + j];
            } else {
#pragma unroll
                for (int j = 0; j < 8; ++j) { k[j] = 0.f; v[j] = 0.f; }
            }
            const size_t krow = ((size_t)(b * 2 + g) * KROWS + SEQ + j64) * 64 + i * 8;
            if (lane < 16) *(u32x4*)(KB + krow) = pack8(k);
            else if (lane < 32) *(u32x4*)(VB + krow) = pack8(v);
        }
    }
}

typedef float f32x16 __attribute__((ext_vector_type(16)));
__device__ __forceinline__ void ce_desc(float& a, float& b) { float h, l; asm("v_max_f32_e32 %0, %1, %2" : "=v"(h) : "v"(a), "v"(b)); asm("v_min_f32_e32 %0, %1, %2" : "=v"(l) : "v"(a), "v"(b)); a = h; b = l; }
__device__ __forceinline__ float vmaxf(float a, float b) { float h; asm("v_max_f32_e32 %0, %1, %2" : "=v"(h) : "v"(a), "v"(b)); return h; }
template <int N> __device__ __forceinline__ void bitonic_sort_desc(float* v) {
#pragma unroll
    for (int k = 2; k <= N; k <<= 1)
#pragma unroll
        for (int j = k >> 1; j > 0; j >>= 1)
#pragma unroll
            for (int i = 0; i < N; ++i) { const int l = i ^ j; if (l > i) { if ((i & k) == 0) ce_desc(v[i], v[l]); else ce_desc(v[l], v[i]); } }
}
__device__ __forceinline__ void sort16_desc(float* v) {
    ce_desc(v[0], v[13]); ce_desc(v[1], v[12]); ce_desc(v[2], v[15]); ce_desc(v[3], v[14]); ce_desc(v[4], v[8]); ce_desc(v[5], v[6]); ce_desc(v[7], v[11]); ce_desc(v[9], v[10]);
    ce_desc(v[0], v[5]); ce_desc(v[1], v[7]); ce_desc(v[2], v[9]); ce_desc(v[3], v[4]); ce_desc(v[6], v[13]); ce_desc(v[8], v[14]); ce_desc(v[10], v[15]); ce_desc(v[11], v[12]);
    ce_desc(v[0], v[1]); ce_desc(v[2], v[3]); ce_desc(v[4], v[5]); ce_desc(v[6], v[8]); ce_desc(v[7], v[9]); ce_desc(v[10], v[11]); ce_desc(v[12], v[13]); ce_desc(v[14], v[15]);
    ce_desc(v[0], v[2]); ce_desc(v[1], v[3]); ce_desc(v[4], v[10]); ce_desc(v[5], v[11]); ce_desc(v[6], v[7]); ce_desc(v[8], v[9]); ce_desc(v[12], v[14]); ce_desc(v[13], v[15]);
    ce_desc(v[1], v[2]); ce_desc(v[3], v[12]); ce_desc(v[4], v[6]); ce_desc(v[5], v[7]); ce_desc(v[8], v[10]); ce_desc(v[9], v[11]); ce_desc(v[13], v[14]);
    ce_desc(v[1], v[4]); ce_desc(v[2], v[6]); ce_desc(v[5], v[8]); ce_desc(v[7], v[10]); ce_desc(v[9], v[13]); ce_desc(v[11], v[14]);
    ce_desc(v[2], v[4]); ce_desc(v[3], v[6]); ce_desc(v[9], v[12]); ce_desc(v[11], v[13]);
    ce_desc(v[3], v[5]); ce_desc(v[6], v[8]); ce_desc(v[7], v[9]); ce_desc(v[10], v[12]);
    ce_desc(v[3], v[4]); ce_desc(v[5], v[6]); ce_desc(v[7], v[8]); ce_desc(v[9], v[10]); ce_desc(v[11], v[12]);
    ce_desc(v[6], v[7]); ce_desc(v[8], v[9]);
}
template <int N> __device__ __forceinline__ void bitonic_merge_desc(float* v) {
#pragma unroll
    for (int j = N >> 1; j > 0; j >>= 1)
#pragma unroll
        for (int i = 0; i < N; ++i) { const int l = i ^ j; if (l > i) ce_desc(v[i], v[l]); }
}
__device__ __forceinline__ void merge_top16(float* x, const float* y) {
#pragma unroll
    for (int i = 0; i < 16; ++i) x[i] = vmaxf(x[i], y[15 - i]);
    bitonic_merge_desc<16>(x);
}
__device__ __forceinline__ void insert16(float* t, float x) {
#pragma unroll
    for (int k = 0; k < 16; ++k) ce_desc(t[k], x);
}
constexpr int SK_ROW = 272, SK_MAT = 128 * SK_ROW;
__device__ __forceinline__ void p7_half(const bf16_t* qrow  , const LAS unsigned char* skl  , int hi4, float* T) {
    f32x16 acc[4];
#pragma unroll
    for (int nb = 0; nb < 4; ++nb)
#pragma unroll
        for (int r = 0; r < 16; ++r) acc[nb][r] = 0.f;
    bf16x8 bq[8];
#pragma unroll
    for (int ks = 0; ks < 8; ++ks) bq[ks] = *(const bf16x8*)(qrow + ks * 16);
#pragma unroll
    for (int ks = 0; ks < 8; ++ks) {
#pragma unroll
        for (int nb = 0; nb < 4; ++nb) { const bf16x8 ak = *(const LAS bf16x8*)(skl + nb * 32 * SK_ROW + ks * 32); acc[nb] = __builtin_amdgcn_mfma_f32_32x32x16_bf16(ak, bq[ks], acc[nb], 0, 0, 0); }
        if (ks & 1) __builtin_amdgcn_sched_barrier(0);
    }
    float L[16];
#pragma unroll
    for (int nb = 0; nb < 4; ++nb) {
        float v[16];
#pragma unroll
        for (int r = 0; r < 16; ++r) { const float sc = acc[nb][r]; v[r] = __uint_as_float((__float_as_uint(sc) & ~127u) | (unsigned)(nb * 16 + r)); }
        sort16_desc(v);
        if (nb == 0) {
#pragma unroll
            for (int r = 0; r < 16; ++r) L[r] = v[r];
        } else merge_top16(L, v);
    }
#pragma unroll
    for (int r = 0; r < 16; ++r) { const unsigned w = __builtin_bit_cast(unsigned, L[r]); T[r] = __builtin_bit_cast(float, w + (w & 0x3Cu) + (unsigned)hi4); }
}
__device__ __forceinline__ unsigned pick_byte(unsigned p0, unsigned p1, unsigned p2, unsigned p3, unsigned i) {
    const unsigned sel = (i & 7u) | 0x0c0c0c00u;
    const unsigned lo = __builtin_amdgcn_perm(p1, p0, sel), hi = __builtin_amdgcn_perm(p3, p2, sel);
    return (i & 8u) ? hi : lo;
}
__device__ __forceinline__ void p7_topk(const Args& a, unsigned char* lds, int tid, int lane, int wave) {
    const bf16_t* QP = (const bf16_t*)(a.ws + WS_QP); const bf16_t* SUBK = (const bf16_t*)(a.ws + WS_SUBK);
    unsigned short* EIDX = (unsigned short*)(a.ws + WS_EI); float* GATE = (float*)(a.ws + WS_GT); const float* SSQ = (const float*)(a.ws + WS_SS);
    const int r32 = lane & 31, hi = lane >> 5;
    const int hp = blockIdx.x & 3, grp = blockIdx.x >> 2, ngrp = gridDim.x >> 2;
    { const u32x4* src = (const u32x4*)(SUBK + (size_t)hp * 4 * 128 * 128);
      for (int i = tid; i < 4 * 128 * 16; i += NTHR) { const int row = i >> 4, ch = i & 15; *(LAS u32x4*)((LAS unsigned char*)lds + row * SK_ROW + ch * 16) = src[i]; } }
    __syncthreads();
    const LAS unsigned char* skl = (const LAS unsigned char*)lds + r32 * SK_ROW + 16 * hi;
    for (int blk = grp * NWAVES + wave; blk < NTOK / 32; blk += ngrp * NWAVES) {
        const int tok = blk * 32 + r32;
        const float rs_l2e = 1.4426950408889634f / sqrtf(SSQ[tok] * (1.0f / DM) + EPS);
        float M0[16], M1[16];
        {
            float B0[16], B1[16];
            p7_half(QP + (size_t)tok * PQ + (2 * hp) * 256 + 8 * hi, skl + 0 * SK_MAT, 4 * hi, M0);
            p7_half(QP + (size_t)tok * PQ + (2 * hp) * 256 + 128 + 8 * hi, skl + 1 * SK_MAT, 4 * hi, M1);
            p7_half(QP + (size_t)tok * PQ + (2 * hp + 1) * 256 + 8 * hi, skl + 2 * SK_MAT, 4 * hi, B0);
            p7_half(QP + (size_t)tok * PQ + (2 * hp + 1) * 256 + 128 + 8 * hi, skl + 3 * SK_MAT, 4 * hi, B1);
#pragma unroll
            for (int i = 0; i < 16; ++i) {
                const auto r0 = __builtin_amdgcn_permlane32_swap(__builtin_bit_cast(unsigned, M0[i]), __builtin_bit_cast(unsigned, B0[i]), false, false);
                const unsigned a0 = r0[0], b0 = r0[1]; M0[i] = __builtin_bit_cast(float, a0); B0[i] = __builtin_bit_cast(float, b0);
                const auto r1 = __builtin_amdgcn_permlane32_swap(__builtin_bit_cast(unsigned, M1[i]), __builtin_bit_cast(unsigned, B1[i]), false, false);
                const unsigned a1 = r1[0], b1 = r1[1]; M1[i] = __builtin_bit_cast(float, a1); B1[i] = __builtin_bit_cast(float, b1); }
            merge_top16(M0, B0); merge_top16(M1, B1);
        }
        const int h = 2 * hp + hi;
#define CAND(i, j) __builtin_bit_cast(float, (__builtin_bit_cast(unsigned, M0[i] + M1[j]) & ~255u) | (unsigned)((i) * 16 + (j)))
        float tc[16], l2[16], l3[16];
#pragma unroll
        for (int j = 0; j < 16; ++j) tc[j] = CAND(0, j);
#pragma unroll
        for (int j = 0; j < 8; ++j) { l2[j] = CAND(1, j); l2[8 + j] = CAND(15 - j, 0); }
        bitonic_merge_desc<16>(l2);
        merge_top16(tc, l2);
        l3[0] = CAND(2, 0); l3[1] = CAND(2, 1); l3[2] = CAND(2, 2); l3[3] = CAND(2, 3); l3[4] = CAND(2, 4); l3[5] = CAND(3, 0); l3[6] = CAND(3, 1); l3[7] = CAND(3, 2); l3[8] = CAND(3, 3);
        l3[9] = CAND(4, 0); l3[10] = CAND(4, 1); l3[11] = CAND(4, 2); l3[12] = CAND(5, 0); l3[13] = CAND(5, 1); l3[14] = CAND(6, 0); l3[15] = CAND(6, 1);
        sort16_desc(l3);
        merge_top16(tc, l3);
        insert16(tc, CAND(7, 0)); insert16(tc, CAND(7, 1));
#undef CAND
#define PK4(M, q) ((__builtin_bit_cast(unsigned, M[4 * (q)]) & 127u) | ((__builtin_bit_cast(unsigned, M[4 * (q) + 1]) & 127u) << 8) | ((__builtin_bit_cast(unsigned, M[4 * (q) + 2]) & 127u) << 16) | ((__builtin_bit_cast(unsigned, M[4 * (q) + 3]) & 127u) << 24))
        const unsigned a0 = PK4(M0, 0), a1 = PK4(M0, 1), a2 = PK4(M0, 2), a3 = PK4(M0, 3), b0 = PK4(M1, 0), b1 = PK4(M1, 1), b2 = PK4(M1, 2), b3 = PK4(M1, 3);
#undef PK4
        float e[16], sum = 0.f;
#pragma unroll
        for (int k = 0; k < 16; ++k) { e[k] = exp2f((tc[k] - tc[0]) * rs_l2e); sum += e[k]; }
        const float inv = 1.0f / sum;
        int eo[16];
#pragma unroll
        for (int k = 0; k < 16; ++k) { const unsigned code = __builtin_bit_cast(unsigned, tc[k]) & 255u; eo[k] = (int)(pick_byte(a0, a1, a2, a3, code >> 4) * 128u + pick_byte(b0, b1, b2, b3, code & 15u)); e[k] *= inv; }
        unsigned short* ep = EIDX + ((size_t)tok * 8 + h) * 16; float* gp = GATE + ((size_t)tok * 8 + h) * 16;
#pragma unroll
        for (int k = 0; k < 16; k += 8) { u32x4 pk; pk.x = (unsigned)eo[k] | ((unsigned)eo[k + 1] << 16); pk.y = (unsigned)eo[k + 2] | ((unsigned)eo[k + 3] << 16); pk.z = (unsigned)eo[k + 4] | ((unsigned)eo[k + 5] << 16); pk.w = (unsigned)eo[k + 6] | ((unsigned)eo[k + 7] << 16); *(u32x4*)(ep + k) = pk; }
#pragma unroll
        for (int k = 0; k < 16; k += 4) *(f32x4*)(gp + k) = (f32x4){e[k], e[k + 1], e[k + 2], e[k + 3]};
    }
}

typedef _Float16 h2_t __attribute__((ext_vector_type(2)));
typedef float f32x2 __attribute__((ext_vector_type(2)));
__device__ __forceinline__ float dot32_fp4(u32x4 w, const h2_t* xh) {
    float acc = 0.f;
#pragma unroll
    for (int d = 0; d < 4; ++d) {
        const unsigned wd = w[d];
        acc = __builtin_amdgcn_fdot2(__builtin_amdgcn_cvt_scalef32_pk_f16_fp4(wd, 1.0f, 0), xh[4 * d], acc, false);
        acc = __builtin_amdgcn_fdot2(__builtin_amdgcn_cvt_scalef32_pk_f16_fp4(wd, 1.0f, 1), xh[4 * d + 1], acc, false);
        acc = __builtin_amdgcn_fdot2(__builtin_amdgcn_cvt_scalef32_pk_f16_fp4(wd, 1.0f, 2), xh[4 * d + 2], acc, false);
        acc = __builtin_amdgcn_fdot2(__builtin_amdgcn_cvt_scalef32_pk_f16_fp4(wd, 1.0f, 3), xh[4 * d + 3], acc, false);
    }
    return acc;
}
typedef int i32x4 __attribute__((ext_vector_type(4)));
struct PMeta { unsigned p[8]; };
#define GAS __attribute__((address_space(1)))
template <class T> __device__ __forceinline__ GAS T* sgpr_ptr(T* p) { asm volatile("" : "+s"(p)); return (GAS T*)p; }
__device__ __forceinline__ void pm_load(PMeta& m, const unsigned short* EIDX, int t  , int seg) {
    const GAS unsigned char* rb = sgpr_ptr((const unsigned char*)(EIDX + (size_t)t * 128)); const unsigned lo = (unsigned)seg * 32u;
#pragma unroll
    for (int q = 0; q < 2; ++q) { const u32x4 ev = __builtin_nontemporal_load((const GAS u32x4*)(rb + (lo + q * 16u))); m.p[4 * q] = ev.x; m.p[4 * q + 1] = ev.y; m.p[4 * q + 2] = ev.z; m.p[4 * q + 3] = ev.w; }
}
#define SCHED_FENCE() __builtin_amdgcn_sched_barrier(0)
__device__ __forceinline__ void rows16_load(u32x4 (&w)[16], const unsigned char* Tbase, unsigned lane_off, const PMeta& m) {
#pragma unroll
    for (int j = 0; j < 16; ++j) { const unsigned pw = m.p[j >> 1]; const unsigned e = (j & 1) ? (pw >> 16) : (pw & 0xffffu); w[j] = *(const u32x4*)(Tbase + (e * 128u + lane_off)); }
}
#define PEER_GEOM() const int s4 = blockIdx.x & 3, th = (blockIdx.x >> 2) & 1, wq = (blockIdx.x >> 3) * NWAVES + wave, NWQ = (gridDim.x >> 3) * NWAVES, t_beg = th * (NTOK / 2) + wq, t_end = (th + 1) * (NTOK / 2)
#define TCL(t) ((t) < t_end ? (t) : t_end - 1)
typedef int v8i_t __attribute__((ext_vector_type(8)));
struct UTok { u32x4 A[8][2]; u32x4 B[2][2]; };
__device__ __forceinline__ void u_issue(UTok& T, const unsigned char* Ts  , const unsigned char* x8row  , unsigned idlo, unsigned idhi, int lane) {
    const int r16 = lane >> 2; const unsigned c16 = (unsigned)(lane & 3) * 16u; const unsigned q16 = (unsigned)(lane >> 4) * 16u;
#pragma unroll
    for (int h = 0; h < 8; ++h) { const unsigned e = (unsigned)__shfl((int)(h < 4 ? idlo : idhi), (h & 3) * 16 + r16);
#pragma unroll
        for (int ks = 0; ks < 2; ++ks) T.A[h][ks] = *(const u32x4*)(Ts + (e * 128u + 64u * ks + c16)); }
#pragma unroll
    for (int ks = 0; ks < 2; ++ks)
#pragma unroll
        for (int hf = 0; hf < 2; ++hf) T.B[ks][hf] = __builtin_nontemporal_load((const GAS u32x4*)(sgpr_ptr(x8row) + (128u * ks + 64u * hf + q16)));
}
__device__ __forceinline__ void u_compute(const UTok& T, int lane, bf16_t* dst  ) {
    f32x4 acc[8];
#pragma unroll
    for (int h = 0; h < 8; ++h) {
        acc[h] = (f32x4){0.f, 0.f, 0.f, 0.f};
#pragma unroll
        for (int ks = 0; ks < 2; ++ks) {
            const int src = (4 * (lane & 15) + (lane >> 4)) * 4;
            const v8i_t av = {__builtin_amdgcn_ds_bpermute(src, (int)T.A[h][ks].x), __builtin_amdgcn_ds_bpermute(src, (int)T.A[h][ks].y), __builtin_amdgcn_ds_bpermute(src, (int)T.A[h][ks].z), __builtin_amdgcn_ds_bpermute(src, (int)T.A[h][ks].w), 0, 0, 0, 0};
            const v8i_t bv = {(int)T.B[ks][0].x, (int)T.B[ks][0].y, (int)T.B[ks][0].z, (int)T.B[ks][0].w, (int)T.B[ks][1].x, (int)T.B[ks][1].y, (int)T.B[ks][1].z, (int)T.B[ks][1].w};
            acc[h] = __builtin_amdgcn_mfma_scale_f32_16x16x128_f8f6f4(av, bv, acc[h], 4  , 0  , 0, 0x7F7F7F7F, 0, 0x7F7F7F7F);
        }
    }
    const int j16 = lane & 15; f32x4 r = acc[0];
#pragma unroll
    for (int h = 1; h < 8; ++h) r = (j16 == h) ? acc[h] : r;
    if (j16 < 8) __builtin_nontemporal_store((u32x2){pk2(r[0], r[1]), pk2(r[2], r[3])}, (GAS u32x2*)(sgpr_ptr((unsigned char*)dst) + (unsigned)(j16 * 16 + (lane >> 4) * 4) * 2u));
}
__device__ __forceinline__ void p8a_u(const Args& a, int lane, int wave) {
    const unsigned short* EIDX = (const unsigned short*)(a.ws + WS_EI); bf16_t* PB = (bf16_t*)(a.ws + WS_PB);
    PEER_GEOM();
    const unsigned char* Ts = a.ws + WS_UT + (size_t)s4 * SLICE4; const unsigned char* x8 = a.ws + WS_X8 + s4 * 256;
    bf16_t* pb = PB + (size_t)s4 * NTOK * 128;
#define IDLOAD(lo, hi, t) do { const GAS unsigned short* ip_ = sgpr_ptr(EIDX + (size_t)(t) * 128); lo = ip_[lane]; hi = ip_[64 + lane]; } while (0)
    UTok TA, TB; unsigned ia0, ia1, ib0, ib1;
    IDLOAD(ia0, ia1, TCL(t_beg)); IDLOAD(ib0, ib1, TCL(t_beg + NWQ));
    u_issue(TA, Ts, x8 + (size_t)TCL(t_beg) * DM, ia0, ia1, lane);
    IDLOAD(ia0, ia1, TCL(t_beg + 2 * NWQ));
    for (int t = t_beg; t < t_end; t += 2 * NWQ) {
        SCHED_FENCE();
        u_issue(TB, Ts, x8 + (size_t)TCL(t + NWQ) * DM, ib0, ib1, lane); IDLOAD(ib0, ib1, TCL(t + 3 * NWQ));
        SCHED_FENCE();
        u_compute(TA, lane, pb + (size_t)t * 128);
        SCHED_FENCE();
        u_issue(TA, Ts, x8 + (size_t)TCL(t + 2 * NWQ) * DM, ia0, ia1, lane); IDLOAD(ia0, ia1, TCL(t + 4 * NWQ));
        SCHED_FENCE();
        if (t + NWQ < t_end) u_compute(TB, lane, pb + (size_t)(t + NWQ) * 128);
    }
#undef IDLOAD
}
__device__ __forceinline__ void p8c_combine(const Args& a, unsigned char* lds, int tid) {
    const u32x2* PB = (const u32x2*)(a.ws + WS_PB); unsigned* AB = (unsigned*)(a.ws + WS_AB); const float* GATE = (const float*)(a.ws + WS_GT); const float* SS = (const float*)(a.ws + WS_SS);
    const unsigned short* EIDX = (const unsigned short*)(a.ws + WS_EI); const float* su = (const float*)(a.ws + WS_USC); const float* sv = (const float*)(a.ws + WS_VSC);
    const size_t n4 = (size_t)NTOK * 128 / 4, nth = (size_t)gridDim.x * NTHR;
    LAS float* su_l = (LAS float*)lds; LAS float* sv_l = su_l + 16384;
    for (int i = tid; i < 16384 / 4; i += NTHR) { *(LAS f32x4*)(su_l + 4 * i) = *(const f32x4*)(su + 4 * i); *(LAS f32x4*)(sv_l + 4 * i) = *(const f32x4*)(sv + 4 * i); }
    __syncthreads();
    float calib;
    { unsigned a1 = 0u; a1 = __builtin_amdgcn_cvt_scalef32_pk_fp4_f32(a1, 1.0f, 1.0f, 1.0f, 0); a1 = __builtin_amdgcn_cvt_scalef32_pk_fp4_f32(a1, 1.0f, 1.0f, 1.0f, 1);
      a1 = __builtin_amdgcn_cvt_scalef32_pk_fp4_f32(a1, 1.0f, 1.0f, 1.0f, 2); a1 = __builtin_amdgcn_cvt_scalef32_pk_fp4_f32(a1, 1.0f, 1.0f, 1.0f, 3);
      unsigned b1 = (unsigned)__builtin_amdgcn_cvt_pk_fp8_f32(1.0f, 1.0f, 0, false); b1 = (unsigned)__builtin_amdgcn_cvt_pk_fp8_f32(1.0f, 1.0f, (int)b1, true);
      const v8i_t av = {(int)a1, (int)a1, (int)a1, (int)a1, 0, 0, 0, 0}, bv = {(int)b1, (int)b1, (int)b1, (int)b1, (int)b1, (int)b1, (int)b1, (int)b1};
      const f32x4 c = __builtin_amdgcn_mfma_scale_f32_16x16x128_f8f6f4(av, bv, (f32x4){0.f, 0.f, 0.f, 0.f}, 4, 0, 0, 0x7F7F7F7F, 0, 0x7F7F7F7F);
      calib = 128.0f / c[0] * (1.0f / X8SCALE); }
    for (size_t i = (size_t)blockIdx.x * NTHR + tid; i < n4; i += nth) {
        f32x4 d = {0.f, 0.f, 0.f, 0.f};
#pragma unroll
        for (int s2 = 0; s2 < 4; ++s2) { const u32x2 p = __builtin_nontemporal_load(PB + (size_t)s2 * n4 + i); d += (f32x4){bflo(p.x), bfhi(p.x), bflo(p.y), bfhi(p.y)}; }
        const f32x4 g = __builtin_nontemporal_load((const f32x4*)GATE + i); const u32x2 ew = __builtin_nontemporal_load((const u32x2*)EIDX + i);
        const unsigned e[4] = {ew.x & 0xffffu, ew.x >> 16, ew.y & 0xffffu, ew.y >> 16}; float o[4];
        const float cr = calib / sqrtf(SS[i >> 5] * (1.0f / DM) + EPS);
#pragma unroll
        for (int j = 0; j < 4; ++j) { const float z = d[j] * su_l[e[j]] * cr; o[j] = 0.5f * z * (1.0f + erff(z * 0.70710678118654752f)) * g[j] * sv_l[e[j]]; }
        unsigned w8 = (unsigned)__builtin_amdgcn_cvt_pk_fp8_f32(o[0] * A8SCALE, o[1] * A8SCALE, 0, false); w8 = (unsigned)__builtin_amdgcn_cvt_pk_fp8_f32(o[2] * A8SCALE, o[3] * A8SCALE, (int)w8, true); AB[i] = w8;
    }
}
typedef int v2i_t __attribute__((ext_vector_type(2)));
constexpr int VROW = 144, VIMG = 128 * VROW;
struct VRec { u32x4 a8[2]; u32x2 h; };
__device__ __forceinline__ void v_token(const u32x4 (&w)[16], const VRec& rc, LAS unsigned char* vl  , float oscale, int lane, float* dst  , bool do_store) {
    const int seg = lane >> 3, c8 = lane & 7, i16 = lane & 15, q = lane >> 4;
#pragma unroll
    for (int j = 0; j < 16; ++j) *(LAS u32x4*)(vl + (seg * 16 + j) * VROW + c8 * 16) = w[j];
    asm volatile("s_waitcnt lgkmcnt(0)" ::: "memory");
    const v8i_t av = {(int)rc.a8[0].x, (int)rc.a8[0].y, (int)rc.a8[0].z, (int)rc.a8[0].w, (int)rc.a8[1].x, (int)rc.a8[1].y, (int)rc.a8[1].z, (int)rc.a8[1].w};
    const LAS unsigned char* rp = vl + (32 * q + i16) * VROW;
    float val[4] = {0.f, 0.f, 0.f, 0.f};
#pragma unroll
    for (int cb = 0; cb < 16; ++cb) {
        const v2i_t r1 = __builtin_amdgcn_ds_read_tr4_b64_v2i32((LAS v2i_t*)(rp + cb * 8)), r2 = __builtin_amdgcn_ds_read_tr4_b64_v2i32((LAS v2i_t*)(rp + 16 * VROW + cb * 8));
        const v8i_t bv = {r1.x, r1.y, r2.x, r2.y, 0, 0, 0, 0};
        const f32x4 acc = __builtin_amdgcn_mfma_scale_f32_16x16x128_f8f6f4(av, bv, (f32x4){0.f, 0.f, 0.f, 0.f}, 0  , 4  , 0, 0x7F7F7F7F, 0, 0x7F7F7F7F);
        const float a0 = acc[0]; val[cb & 3] = (q == (cb >> 2)) ? a0 : val[cb & 3];
    }
    asm volatile("s_waitcnt lgkmcnt(0)" ::: "memory");
    if (do_store) {
        *(GAS f32x4*)(sgpr_ptr((unsigned char*)dst) + (unsigned)lane * 16u) = (f32x4){bflo(rc.h.x) + val[0] * oscale, bfhi(rc.h.x) + val[1] * oscale, bflo(rc.h.y) + val[2] * oscale, bfhi(rc.h.y) + val[3] * oscale};
    } else asm volatile("" :: "v"(val[0]), "v"(val[1]), "v"(val[2]), "v"(val[3]));
}
__device__ __forceinline__ void p8b_v(const Args& a, unsigned char* lds, int lane, int wave, bool do_store) {
    const unsigned short* EIDX = (const unsigned short*)(a.ws + WS_EI); const unsigned char* AB = a.ws + WS_AB; const bf16_t* HB = (const bf16_t*)(a.ws + WS_HB);
    PEER_GEOM();
    const int seg = lane >> 3, c8 = lane & 7, q = lane >> 4;
    const unsigned char* Ts = a.ws + WS_UT + (size_t)(4 + s4) * SLICE4; const unsigned loff = c8 * 16;
    LAS unsigned char* vl = (LAS unsigned char*)lds + wave * VIMG;
    float oscale;
    { unsigned a1 = 0u; a1 = __builtin_amdgcn_cvt_scalef32_pk_fp4_f32(a1, 1.0f, 1.0f, 1.0f, 0); a1 = __builtin_amdgcn_cvt_scalef32_pk_fp4_f32(a1, 1.0f, 1.0f, 1.0f, 1);
      a1 = __builtin_amdgcn_cvt_scalef32_pk_fp4_f32(a1, 1.0f, 1.0f, 1.0f, 2); a1 = __builtin_amdgcn_cvt_scalef32_pk_fp4_f32(a1, 1.0f, 1.0f, 1.0f, 3);
      unsigned b1 = (unsigned)__builtin_amdgcn_cvt_pk_fp8_f32(1.0f, 1.0f, 0, false); b1 = (unsigned)__builtin_amdgcn_cvt_pk_fp8_f32(1.0f, 1.0f, (int)b1, true);
      const v8i_t av = {(int)b1, (int)b1, (int)b1, (int)b1, (int)b1, (int)b1, (int)b1, (int)b1}, bv = {(int)a1, (int)a1, (int)a1, (int)a1, 0, 0, 0, 0};
      const f32x4 c = __builtin_amdgcn_mfma_scale_f32_16x16x128_f8f6f4(av, bv, (f32x4){0.f, 0.f, 0.f, 0.f}, 0, 4, 0, 0x7F7F7F7F, 0, 0x7F7F7F7F);
      oscale = 128.0f / c[0] * (1.0f / A8SCALE); }
    const unsigned aoff = (unsigned)q * 16u, hoff = (unsigned)(s4 * 256 + 4 * lane) * 2u;
#define REC_LOAD(R, t) do { const GAS unsigned char* ab_ = sgpr_ptr(AB + (size_t)(t) * 128); R.a8[0] = __builtin_nontemporal_load((const GAS u32x4*)(ab_ + aoff)); R.a8[1] = __builtin_nontemporal_load((const GAS u32x4*)(ab_ + (64u + aoff))); \
        R.h = __builtin_nontemporal_load((const GAS u32x2*)(sgpr_ptr((const unsigned char*)(HB + (size_t)(t) * DM)) + hoff)); } while (0)
    PMeta mA, mB; u32x4 wA[16], wB[16]; VRec rA, rB;
    pm_load(mA, EIDX, TCL(t_beg), seg); pm_load(mB, EIDX, TCL(t_beg + NWQ), seg);
    rows16_load(wA, Ts, loff, mA); REC_LOAD(rA, TCL(t_beg));
    pm_load(mA, EIDX, TCL(t_beg + 2 * NWQ), seg);
    for (int t = t_beg; t < t_end; t += 2 * NWQ) {
        SCHED_FENCE();
        rows16_load(wB, Ts, loff, mB); REC_LOAD(rB, TCL(t + NWQ)); pm_load(mB, EIDX, TCL(t + 3 * NWQ), seg);
        SCHED_FENCE();
        v_token(wA, rA, vl, oscale, lane, a.out + (size_t)t * DM + s4 * 256, do_store);
        SCHED_FENCE();
        rows16_load(wA, Ts, loff, mA); REC_LOAD(rA, TCL(t + 2 * NWQ)); pm_load(mA, EIDX, TCL(t + 4 * NWQ), seg);
        SCHED_FENCE();
        if (t + NWQ < t_end) v_token(wB, rB, vl, oscale, lane, a.out + (size_t)(t + NWQ) * DM + s4 * 256, do_store);
    }
#undef REC_LOAD
#undef TCL
#undef PEER_GEOM
}

namespace pg8 {
#define PG8_LAS __attribute__((address_space(3)))
typedef unsigned short bf16_t;
typedef short bf16x8 __attribute__((ext_vector_type(8)));
typedef float f32x4 __attribute__((ext_vector_type(4)));
typedef unsigned u32x4 __attribute__((ext_vector_type(4)));
typedef int v4i_t __attribute__((ext_vector_type(4))); typedef int v8i_t __attribute__((ext_vector_type(8)));
constexpr int BM = 256, BK = 64, HALF = 128, HTB = HALF * BK * 2  , STAGE_BYTES = 8 * HTB, NXCD = 8, WGM = 8;

__host__ __device__ __forceinline__ int lds_byte(int r, int c) { const int st = (r >> 4) * 2 + (c >> 5), rr = r & 15, cc = c & 31, ob = rr * 64 + cc * 2; return st * 1024 + (ob ^ (((ob >> 9) & 1) << 5)); }
__host__ __device__ __forceinline__ void stage_rc(int b, int& R, int& C) { const int st = b / 1024, sb = b % 1024, swz = sb ^ (((sb >> 9) & 1) << 5); R = (st >> 1) * 16 + swz / 64; C = (st & 1) * 32 + (swz % 64) / 2; }
__host__ __device__ __forceinline__ int perm32(int rho) { const int n = rho >> 4, i = rho & 15; return 8 * (i >> 2) + 4 * n + (i & 3); }

struct Unit { int pm, pn; };
struct Gemm { const bf16_t* A; const bf16_t* Bt; int M, N, K; };

struct StaticOrder {
    int nM, nN, nwg, G, c;
    __host__ __device__ void init(int M, int N, int G_, int c_) { nM = M / BM; nN = N / BM; nwg = nM * nN; G = G_; c = c_; }
    __host__ __device__ bool next(int i, Unit& u) const {
        const long L = (long)i * G + c; if (L >= nwg) return false;
        int wgid = (int)L; { const int q = nwg / NXCD, r = nwg % NXCD, xcd = wgid % NXCD, off = wgid / NXCD; wgid = (xcd < r ? xcd * (q + 1) : r * (q + 1) + (xcd - r) * q) + off; }
        const int nig = WGM * nN, gid = wgid / nig, fm = gid * WGM, gsz = (nM - fm) < WGM ? (nM - fm) : WGM;
        u.pm = fm + ((wgid % nig) % gsz); u.pn = (wgid % nig) / gsz; return true;
    }
    __device__ __forceinline__ void a_ready(const Unit&) const {}
    __device__ __forceinline__ void done(const Unit&) const {}
};


__device__ __forceinline__ unsigned cvt_pk_bf16(float lo, float hi) { unsigned r; asm volatile("v_cvt_pk_bf16_f32 %0, %1, %2" : "=v"(r) : "v"(lo), "v"(hi)); return r; }
struct EpiInProj {
    static constexpr bool PERM = true, AFTER_DRAIN = false;
    bf16_t* O; bf16_t* QB; bf16_t* KB; bf16_t* VB; const float* rope; const float* qg; const float* kg;
    template <bool NORM> __device__ __forceinline__ void head_row(f32x4 a00, f32x4 a01, f32x4 a10, f32x4 a11, const float* g0, const float* g1, int t, int fq, bf16_t* dst  ) const {
        float x0[8] = {a00[0], a00[1], a00[2], a00[3], a01[0], a01[1], a01[2], a01[3]}, x1[8] = {a10[0], a10[1], a10[2], a10[3], a11[0], a11[1], a11[2], a11[3]};
        if (NORM) {
            float ss = 0.f;
#pragma unroll
            for (int e = 0; e < 8; ++e) ss += x0[e] * x0[e] + x1[e] * x1[e];
            ss += __shfl_xor(ss, 16); ss += __shfl_xor(ss, 32);
            const float rstd = 1.0f / sqrtf(ss * (1.0f / 64.0f) + 1e-6f);
            const float* r0 = rope + (((t >> 6) * 16 + (fq & 1) * 8) * 2); const float* r1 = rope + (((t & 63) * 16 + (fq & 1) * 8) * 2);
            f32x4 c0[4], c1[4];
#pragma unroll
            for (int q4 = 0; q4 < 4; ++q4) { c0[q4] = *(const f32x4*)(r0 + 4 * q4); c1[q4] = *(const f32x4*)(r1 + 4 * q4); }
#pragma unroll
            for (int e = 0; e < 8; ++e) { x0[e] *= rstd * g0[e]; x1[e] *= rstd * g1[e]; }
#pragma unroll
            for (int e = 0; e < 8; ++e) { const float o0 = __shfl_xor(x0[e], 32), o1 = __shfl_xor(x1[e], 32);
                const float cs0 = c0[e >> 1][(e & 1) * 2], sn0 = c0[e >> 1][(e & 1) * 2 + 1], cs1 = c1[e >> 1][(e & 1) * 2], sn1 = c1[e >> 1][(e & 1) * 2 + 1];
                x0[e] = (fq & 2) ? x0[e] * cs0 + o0 * sn0 : x0[e] * cs0 - o0 * sn0; x1[e] = (fq & 2) ? x1[e] * cs1 + o1 * sn1 : x1[e] * cs1 - o1 * sn1; }
        }
        u32x4 w; w.x = cvt_pk_bf16(x0[0], x0[1]); w.y = cvt_pk_bf16(x0[2], x0[3]); w.z = cvt_pk_bf16(x0[4], x0[5]); w.w = cvt_pk_bf16(x0[6], x0[7]); *(u32x4*)dst = w;
        w.x = cvt_pk_bf16(x1[0], x1[1]); w.y = cvt_pk_bf16(x1[2], x1[3]); w.z = cvt_pk_bf16(x1[4], x1[5]); w.w = cvt_pk_bf16(x1[6], x1[7]); *(u32x4*)(dst + 32) = w;
    }
    __device__ __forceinline__ void operator()(const f32x4 (&acc)[2][2][4][2], const Unit& u, int wr, int wc, int fr, int fq) const {
        const int row0 = u.pm * BM + wr * 64 + fr, pn = u.pn;
        if (pn < 2) {
            const int col0 = 256 * pn + wc * 32 + 8 * fq;
#pragma unroll
            for (int ai = 0; ai < 2; ++ai)
#pragma unroll
                for (int m = 0; m < 4; ++m) { bf16_t* rowp = O + (size_t)(row0 + ai * HALF + m * 16) * 1024 + col0;
#pragma unroll
                    for (int bj = 0; bj < 2; ++bj) { const f32x4 v0 = acc[ai][bj][m][0], v1 = acc[ai][bj][m][1];
                        u32x4 w; w.x = cvt_pk_bf16(v0[0], v0[1]); w.y = cvt_pk_bf16(v0[2], v0[3]); w.z = cvt_pk_bf16(v1[0], v1[1]); w.w = cvt_pk_bf16(v1[2], v1[3]);
                        *(u32x4*)(rowp + bj * HALF) = w; } }
        } else if (pn < 6) {
            const int col0 = 512 + 128 * (pn - 2) + wc * 32 + 8 * fq;
#pragma unroll
            for (int ai = 0; ai < 2; ++ai)
#pragma unroll
                for (int m = 0; m < 4; ++m) { const f32x4 v0 = acc[ai][0][m][0] * acc[ai][1][m][0], v1 = acc[ai][0][m][1] * acc[ai][1][m][1];
                    u32x4 w; w.x = cvt_pk_bf16(v0[0], v0[1]); w.y = cvt_pk_bf16(v0[2], v0[3]); w.z = cvt_pk_bf16(v1[0], v1[1]); w.w = cvt_pk_bf16(v1[2], v1[3]);
                    *(u32x4*)(O + (size_t)(row0 + ai * HALF + m * 16) * 1024 + col0) = w; }
        } else if (pn < 8) {
            float g0[8], g1[8];
#pragma unroll
            for (int e = 0; e < 8; ++e) { g0[e] = qg[8 * fq + e] * C2; g1[e] = qg[32 + 8 * fq + e] * C2; }
            const int hh = 4 * (pn - 6) + wc;
#pragma unroll
            for (int ai = 0; ai < 2; ++ai)
#pragma unroll
                for (int m = 0; m < 4; ++m) { const int r = row0 + ai * HALF + m * 16;
                    head_row<true>(acc[ai][0][m][0], acc[ai][0][m][1], acc[ai][1][m][0], acc[ai][1][m][1], g0, g1, r & 2047, fq, QB + (size_t)r * 512 + hh * 64 + 8 * fq); }
        } else {
            float g0[8], g1[8];
#pragma unroll
            for (int e = 0; e < 8; ++e) { g0[e] = kg[8 * fq + e]; g1[e] = kg[32 + 8 * fq + e]; }
            const int g = wc & 1;
#pragma unroll
            for (int ai = 0; ai < 2; ++ai)
#pragma unroll
                for (int m = 0; m < 4; ++m) { const int r = row0 + ai * HALF + m * 16, b = r >> 11, t = r & 2047; const size_t krow = ((size_t)(b * 2 + g) * KROWS + t) * 64 + 8 * fq;
                    if (wc < 2) head_row<true>(acc[ai][0][m][0], acc[ai][0][m][1], acc[ai][1][m][0], acc[ai][1][m][1], g0, g1, t, fq, KB + krow);
                    else head_row<false>(acc[ai][0][m][0], acc[ai][0][m][1], acc[ai][1][m][0], acc[ai][1][m][1], g0, g1, t, fq, VB + krow); }
        }
    }
};
struct EpiBf16 {
    static constexpr bool PERM = true, AFTER_DRAIN = false;
    bf16_t* O; int ldc; float scale;
    __device__ __forceinline__ void operator()(const f32x4 (&acc)[2][2][4][2], const Unit& u, int wr, int wc, int fr, int fq) const {
        const int row0 = u.pm * BM + wr * 64 + fr; const int col0 = u.pn * BM + wc * 32 + 8 * fq;
#pragma unroll
        for (int ai = 0; ai < 2; ++ai)
#pragma unroll
            for (int m = 0; m < 4; ++m) { bf16_t* rowp = O + (size_t)(row0 + ai * HALF + m * 16) * ldc + col0;
#pragma unroll
                for (int bj = 0; bj < 2; ++bj) { const f32x4 v0 = acc[ai][bj][m][0] * scale, v1 = acc[ai][bj][m][1] * scale;
                    u32x4 w; w.x = cvt_pk_bf16(v0[0], v0[1]); w.y = cvt_pk_bf16(v0[2], v0[3]); w.z = cvt_pk_bf16(v1[0], v1[1]); w.w = cvt_pk_bf16(v1[2], v1[3]);
                    *(u32x4*)(rowp + bj * HALF) = w; } }
    }
};
struct EpiResidNorm {
    static constexpr bool PERM = true, AFTER_DRAIN = false;
    const float* xp; const float* xs; float* out; int split_row; bf16_t* hb; unsigned char* h8; float* ss; float x8scale;
    __device__ __forceinline__ const float* xrow(int r, int col0) const { return (r < split_row ? xp + (size_t)r * 1024 : xs + (size_t)(r - split_row) * 1024) + col0; }
    __device__ __forceinline__ void operator()(const f32x4 (&acc)[2][2][4][2], const Unit& u, int wr, int wc, int fr, int fq) const {
        const int col0 = u.pn * BM + wc * 32 + 8 * fq, rbase = u.pm * BM + wr * 64 + fr;
        f32x4 xv[4][2][2];
#pragma unroll
        for (int m = 0; m < 4; ++m) { const float* xr = xrow(rbase + m * 16, col0);
#pragma unroll
            for (int bj = 0; bj < 2; ++bj) { xv[m][bj][0] = *(const f32x4*)(xr + bj * HALF); xv[m][bj][1] = *(const f32x4*)(xr + bj * HALF + 4); } }
#pragma unroll
        for (int ai = 0; ai < 2; ++ai)
#pragma unroll
            for (int m = 0; m < 4; ++m) { const int r = rbase + ai * HALF + m * 16;
                bf16_t* brow = hb + (size_t)r * 1024 + col0; unsigned char* qrow = h8 + (size_t)r * 1024 + col0; float s = 0.f;
                f32x4 h[2][2];
#pragma unroll
                for (int bj = 0; bj < 2; ++bj) { h[bj][0] = xv[m][bj][0] + acc[ai][bj][m][0]; h[bj][1] = xv[m][bj][1] + acc[ai][bj][m][1]; }
                if (ai == 0) { const float* xr = xrow(r + HALF, col0);
#pragma unroll
                    for (int bj = 0; bj < 2; ++bj) { xv[m][bj][0] = *(const f32x4*)(xr + bj * HALF); xv[m][bj][1] = *(const f32x4*)(xr + bj * HALF + 4); } }
#pragma unroll
                for (int bj = 0; bj < 2; ++bj) { const f32x4 h0 = h[bj][0], h1 = h[bj][1];
                    u32x4 wb; wb.x = cvt_pk_bf16(h0[0], h0[1]); wb.y = cvt_pk_bf16(h0[2], h0[3]); wb.z = cvt_pk_bf16(h1[0], h1[1]); wb.w = cvt_pk_bf16(h1[2], h1[3]); *(u32x4*)(brow + bj * HALF) = wb;
                    unsigned w0 = (unsigned)__builtin_amdgcn_cvt_pk_fp8_f32(h0[0] * x8scale, h0[1] * x8scale, 0, false); w0 = (unsigned)__builtin_amdgcn_cvt_pk_fp8_f32(h0[2] * x8scale, h0[3] * x8scale, (int)w0, true);
                    unsigned w1 = (unsigned)__builtin_amdgcn_cvt_pk_fp8_f32(h1[0] * x8scale, h1[1] * x8scale, 0, false); w1 = (unsigned)__builtin_amdgcn_cvt_pk_fp8_f32(h1[2] * x8scale, h1[3] * x8scale, (int)w1, true);
                    *(u32x2*)(qrow + bj * HALF) = (u32x2){w0, w1};
                    s += ((h0[0] * h0[0] + h0[1] * h0[1]) + (h0[2] * h0[2] + h0[3] * h0[3])) + ((h1[0] * h1[0] + h1[1] * h1[1]) + (h1[2] * h1[2] + h1[3] * h1[3])); }
                s += __shfl_xor(s, 16); s += __shfl_xor(s, 32);
                if (fq == 0) atomicAdd(ss + r, s); }
    }
};
struct EpiResid {
    static constexpr bool PERM = false, AFTER_DRAIN = false;
    const float* xp; const float* xs; float* out; int split_row;
    __device__ __forceinline__ void operator()(const f32x4 (&acc)[2][2][4][2], const Unit& u, int wr, int wc, int fr, int fq) const {
        const int col0 = u.pn * BM + wc * 32 + 4 * fq;
#pragma unroll
        for (int ai = 0; ai < 2; ++ai)
#pragma unroll
            for (int m = 0; m < 4; ++m) { const int r = u.pm * BM + ai * HALF + wr * 64 + m * 16 + fr;
                const float* xr = (r < split_row ? xp + (size_t)r * 1024 : xs + (size_t)(r - split_row) * 1024) + col0; float* orow = out + (size_t)r * 1024 + col0;
#pragma unroll
                for (int bj = 0; bj < 2; ++bj)
#pragma unroll
                    for (int n = 0; n < 2; ++n) { const f32x4 bs = *(const f32x4*)(xr + bj * HALF + n * 16); *(f32x4*)(orow + bj * HALF + n * 16) = bs + acc[ai][bj][m][n]; } }
    }
};

template <class Epi, class Sched, bool ALIGN_EPI = false, bool SP2 = false, bool FP8 = false>
__device__ __forceinline__ void gemm_phase(PG8_LAS unsigned char* lds, const Gemm g, const Sched& S, const Epi& E) {
    const int tid = threadIdx.x, wid = __builtin_amdgcn_readfirstlane(tid >> 6), lane = tid & 63, wr = wid >> 2, wc = wid & 3, fr = lane & 15, fq = lane >> 4;
    const int K = g.K, nt = K / BK;
    unsigned voffA[2], voffB[2];
#pragma unroll
    for (int i = 0; i < 2; ++i) { int R, C; stage_rc(tid * 16 + i * 8192, R, C); const int Rb = Epi::PERM ? ((R & ~31) + perm32(R & 31)) : R;
        voffA[i] = (unsigned)(R * K + C) * 2u; voffB[i] = (unsigned)(Rb * K + C) * 2u; }
    const size_t kstep = (size_t)(BK * 2);
    const size_t hstep = (size_t)HALF * K * 2;
    const size_t tstep = 2 * hstep;
    const unsigned ldsw = (unsigned)wid * 1024u;
    const int aoff = lds_byte(wr * 64 + fr, fq * 8), boff = lds_byte(wc * 32 + fr, fq * 8);
#define PG8_SA(b, h) (((b) * 2 + (h)) * HTB)
#define PG8_SB(b, h) ((4 + (b) * 2 + (h)) * HTB)
#define PG8_STAGE(bufoff, gbase, voff) do { _Pragma("unroll") for (int _i = 0; _i < 2; ++_i) \
        __builtin_amdgcn_global_load_lds((const unsigned*)((const char*)(gbase) + (voff)[_i]), (PG8_LAS unsigned*)(lds + (bufoff) + ldsw + _i * 8192), 16, 0, 0); } while (0)
#define PG8_LDA(dst, b, h) do { if constexpr (FP8) { _Pragma("unroll") for (int m = 0; m < 4; ++m) dst##8[m] = __builtin_shufflevector(*(const PG8_LAS v4i_t*)(lds + PG8_SA(b, h) + aoff + m * 2048), *(const PG8_LAS v4i_t*)(lds + PG8_SA(b, h) + aoff + m * 2048 + 1024), 0, 1, 2, 3, 4, 5, 6, 7); } \
        else { _Pragma("unroll") for (int m = 0; m < 4; ++m) _Pragma("unroll") for (int k = 0; k < 2; ++k) dst[m][k] = *(const PG8_LAS bf16x8*)(lds + PG8_SA(b, h) + aoff + m * 2048 + k * 1024); } } while (0)
#define PG8_LDB(dst, b, h) do { if constexpr (FP8) { _Pragma("unroll") for (int n = 0; n < 2; ++n) dst##8[n] = __builtin_shufflevector(*(const PG8_LAS v4i_t*)(lds + PG8_SB(b, h) + boff + n * 2048), *(const PG8_LAS v4i_t*)(lds + PG8_SB(b, h) + boff + n * 2048 + 1024), 0, 1, 2, 3, 4, 5, 6, 7); } \
        else { _Pragma("unroll") for (int n = 0; n < 2; ++n) _Pragma("unroll") for (int k = 0; k < 2; ++k) dst[n][k] = *(const PG8_LAS bf16x8*)(lds + PG8_SB(b, h) + boff + n * 2048 + k * 1024); } } while (0)
#define PG8_MMA(ai, bj, At, Bt) do { __builtin_amdgcn_s_setprio(1); _Pragma("unroll") for (int m = 0; m < 4; ++m) _Pragma("unroll") for (int n = 0; n < 2; ++n) { \
        if constexpr (FP8) { asm volatile("v_mfma_scale_f32_16x16x128_f8f6f4 %0, %1, %2, %0, %3, %3 op_sel_hi:[0,0,0]" : "+v"(acc[ai][bj][m][n]) : "v"(Bt##8[n]), "v"(At##8[m]), "v"(mfma_one)); } \
        else { _Pragma("unroll") for (int k = 0; k < 2; ++k) acc[ai][bj][m][n] = __builtin_amdgcn_mfma_f32_16x16x32_bf16(Bt[n][k], At[m][k], acc[ai][bj][m][n], 0, 0, 0); } } __builtin_amdgcn_s_setprio(0); } while (0)
#define PG8_WAIT_V(n) asm volatile("s_waitcnt vmcnt(" #n ")" ::: "memory")
#define PG8_WAIT_L(n) asm volatile("s_waitcnt lgkmcnt(" #n ")" ::: "memory")
#define PG8_BAR __builtin_amdgcn_s_barrier()
#define PG8_SCHED __builtin_amdgcn_sched_barrier(0)
    Unit cur, nxt; int ui = 0;
    if (!S.next(0, cur)) return;
    f32x4 acc[2][2][4][2];
#pragma unroll
    for (int a = 0; a < 2; ++a)
#pragma unroll
        for (int b = 0; b < 2; ++b)
#pragma unroll
            for (int m = 0; m < 4; ++m)
#pragma unroll
                for (int n = 0; n < 2; ++n) acc[a][b][m][n] = (f32x4){0.f, 0.f, 0.f, 0.f};
    const int mfma_one = 0x7F7F7F7F;
    bf16x8 At[4][2], B0[2][2], B1[2][2]; v8i_t At8[4], B08[2], B18[2];
    const char* cA = (const char*)g.A + (size_t)cur.pm * tstep; const char* cB = (const char*)g.Bt + (size_t)cur.pn * tstep;
    S.a_ready(cur);
    if constexpr (SP2) {
        PG8_STAGE(PG8_SB(0, 0), cB, voffB); PG8_STAGE(PG8_SB(0, 1), cB + hstep, voffB); PG8_STAGE(PG8_SA(0, 0), cA, voffA); PG8_STAGE(PG8_SA(0, 1), cA + hstep, voffA);
        if (wr == 1) PG8_BAR;
        PG8_WAIT_V(2); PG8_BAR;
        PG8_STAGE(PG8_SB(1, 0), cB + kstep, voffB); PG8_STAGE(PG8_SA(1, 0), cA + kstep, voffA); PG8_STAGE(PG8_SB(1, 1), cB + hstep + kstep, voffB);
        PG8_WAIT_V(6); PG8_BAR;
    } else {
        PG8_STAGE(PG8_SB(0, 0), cB, voffB); PG8_STAGE(PG8_SA(0, 0), cA, voffA); PG8_STAGE(PG8_SB(0, 1), cB + hstep, voffB); PG8_STAGE(PG8_SA(0, 1), cA + hstep, voffA);
        if (wr == 1) PG8_BAR;
        PG8_WAIT_V(4); PG8_BAR;
        PG8_STAGE(PG8_SB(1, 0), cB + kstep, voffB); PG8_STAGE(PG8_SA(1, 0), cA + kstep, voffA); PG8_STAGE(PG8_SB(1, 1), cB + hstep + kstep, voffB);
        PG8_WAIT_V(6); PG8_BAR;
    }
    for (;;) {
        const bool has_next = S.next(ui + 1, nxt);
        const char* nA = has_next ? (const char*)g.A + (size_t)nxt.pm * tstep : cA; const char* nB = has_next ? (const char*)g.Bt + (size_t)nxt.pn * tstep : cB;
#pragma nounroll
        for (int t = 0; t < nt; t += 2) {
            const bool last = (t == nt - 2);
            const char* a1 = cA + (size_t)(t + 1) * kstep;
            const char* a2 = last ? nA : cA + (size_t)(t + 2) * kstep; const char* b2 = last ? nB : cB + (size_t)(t + 2) * kstep;
            const char* a3 = a2 + kstep; const char* b3 = b2 + kstep;
            if (last && has_next) S.a_ready(nxt);
            if constexpr (SP2) {
            PG8_LDB(B0, 0, 0); PG8_LDB(B1, 0, 1); PG8_SCHED; PG8_LDA(At, 0, 0); PG8_STAGE(PG8_SA(1, 1), a1 + hstep, voffA);
            PG8_WAIT_V(8); PG8_WAIT_L(0); PG8_BAR; PG8_MMA(0, 0, At, B0); PG8_MMA(0, 1, At, B1); PG8_BAR; PG8_SCHED;
            PG8_LDA(At, 0, 1); PG8_STAGE(PG8_SB(0, 0), b2, voffB); PG8_STAGE(PG8_SB(0, 1), b2 + hstep, voffB); PG8_STAGE(PG8_SA(0, 0), a2, voffA);
            PG8_WAIT_V(8); PG8_WAIT_L(0); PG8_BAR; PG8_MMA(1, 0, At, B0); PG8_MMA(1, 1, At, B1); PG8_BAR; PG8_SCHED;
            PG8_LDB(B0, 1, 0); PG8_LDB(B1, 1, 1); PG8_SCHED; PG8_LDA(At, 1, 0); PG8_STAGE(PG8_SA(0, 1), a2 + hstep, voffA);
            PG8_WAIT_V(8); PG8_WAIT_L(0); PG8_BAR; PG8_MMA(0, 0, At, B0); PG8_MMA(0, 1, At, B1); PG8_BAR; PG8_SCHED;
            PG8_LDA(At, 1, 1); PG8_STAGE(PG8_SB(1, 0), b3, voffB); PG8_STAGE(PG8_SB(1, 1), b3 + hstep, voffB); PG8_STAGE(PG8_SA(1, 0), a3, voffA);
            PG8_WAIT_V(8); PG8_WAIT_L(0); PG8_BAR; PG8_MMA(1, 0, At, B0); PG8_MMA(1, 1, At, B1); PG8_BAR; PG8_SCHED;
            } else {
            PG8_LDB(B0, 0, 0); PG8_SCHED; PG8_LDA(At, 0, 0); PG8_STAGE(PG8_SA(1, 1), a1 + hstep, voffA);
            PG8_WAIT_L(8); PG8_BAR; PG8_WAIT_L(0); PG8_MMA(0, 0, At, B0); PG8_BAR; PG8_SCHED;
            PG8_LDB(B1, 0, 1); PG8_STAGE(PG8_SB(0, 0), b2, voffB);
            PG8_BAR; PG8_WAIT_L(0); PG8_MMA(0, 1, At, B1); PG8_BAR;
            PG8_LDA(At, 0, 1); PG8_STAGE(PG8_SA(0, 0), a2, voffA);
            PG8_BAR; PG8_WAIT_L(0); PG8_MMA(1, 0, At, B0); PG8_BAR; PG8_SCHED;
            PG8_STAGE(PG8_SB(0, 1), b2 + hstep, voffB);
            PG8_WAIT_V(6); PG8_BAR; PG8_MMA(1, 1, At, B1); PG8_BAR;
            PG8_LDB(B0, 1, 0); PG8_SCHED; PG8_LDA(At, 1, 0); PG8_STAGE(PG8_SA(0, 1), a2 + hstep, voffA);
            PG8_WAIT_L(8); PG8_BAR; PG8_WAIT_L(0); PG8_MMA(0, 0, At, B0); PG8_BAR; PG8_SCHED;
            PG8_LDB(B1, 1, 1); PG8_STAGE(PG8_SB(1, 0), b3, voffB);
            PG8_BAR; PG8_WAIT_L(0); PG8_MMA(0, 1, At, B1); PG8_BAR;
            PG8_LDA(At, 1, 1); PG8_STAGE(PG8_SA(1, 0), a3, voffA);
            PG8_BAR; PG8_WAIT_L(0); PG8_MMA(1, 0, At, B0); PG8_BAR; PG8_SCHED;
            PG8_STAGE(PG8_SB(1, 1), b3 + hstep, voffB);
            PG8_WAIT_V(6); PG8_BAR; PG8_MMA(1, 1, At, B1); PG8_BAR;
            }
        }
        if constexpr (ALIGN_EPI) { if (wr == 0) PG8_BAR; }
        if constexpr (FP8) asm volatile("s_nop 15\n\ts_nop 15" ::: "memory");
        if constexpr (!Epi::AFTER_DRAIN) { E(acc, cur, wr, wc, fr, fq); S.done(cur); }
        if (!has_next) break;
#pragma unroll
        for (int a = 0; a < 2; ++a)
#pragma unroll
            for (int b = 0; b < 2; ++b)
#pragma unroll
                for (int m = 0; m < 4; ++m)
#pragma unroll
                    for (int n = 0; n < 2; ++n) acc[a][b][m][n] = (f32x4){0.f, 0.f, 0.f, 0.f};
        if constexpr (FP8) asm volatile("s_nop 7" ::: "memory");
        cur = nxt; cA = nA; cB = nB; ++ui;
        if constexpr (ALIGN_EPI) { if (wr == 1) PG8_BAR; }
    }
    PG8_WAIT_V(0);
    if constexpr (!ALIGN_EPI) { if (wr == 0) PG8_BAR; }
    PG8_BAR;
    if constexpr (Epi::AFTER_DRAIN) { E.fused(acc, cur, wr, wc, fr, fq, lds, wid, lane); S.done(cur); }
#undef PG8_SA
#undef PG8_SB
#undef PG8_STAGE
#undef PG8_LDA
#undef PG8_LDB
#undef PG8_MMA
#undef PG8_WAIT_V
#undef PG8_WAIT_L
#undef PG8_BAR
#undef PG8_SCHED
}
}


#include <hip/hip_bf16.h>
#include <cmath>
namespace attn_body {
using bf16=__hip_bfloat16;
using bf16x8=__attribute__((ext_vector_type(8)))short;
using s16x4=__attribute__((ext_vector_type(4)))short;
using f32x16=__attribute__((ext_vector_type(16)))float;
using u32x4=__attribute__((ext_vector_type(4)))unsigned;
constexpr int SEQ=2048,D=64,QP=512,KVP=64,OP=1024,KVROWS=2112;
constexpr int NW=8,QBLK=32,QB=QBLK*NW,KVBLK=64,NQB=SEQ/QB,NT=KVROWS/KVBLK;
constexpr int ATTN_UNIT_ROWS=QB;
__device__ __forceinline__ int crow(int r,int hi){return (r&3)+8*(r>>2)+4*hi;}
#define SBAR() __builtin_amdgcn_sched_barrier(0)
__device__ __forceinline__ void tmask(f32x16&p0,f32x16&p1){
  const float NEG=-INFINITY;
  #pragma unroll
  for(int r=8;r<16;++r)p0[r]=NEG;
  #pragma unroll
  for(int r=0;r<16;++r)p1[r]=NEG;
}

constexpr int NSLOT=3, SLOTB=8192;
constexpr int LDS_K=0, LDS_V=NSLOT*SLOTB, LDS_WS=2*NSLOT*SLOTB, LDS_OST=LDS_WS+NW*64*4, LDS_BYTES=LDS_OST+NW*4096;
constexpr float C2=0.125f*1.4426950408889634f;
__device__ __forceinline__ void glds16(const void*gsrc,unsigned lds_dst){unsigned keep;
  asm volatile("s_mov_b32 %0, m0\n\ts_mov_b32 m0, %2\n\ts_nop 0\n\tglobal_load_lds_dwordx4 %1, off\n\ts_mov_b32 m0, %0":"=&s"(keep):"v"(gsrc),"s"(lds_dst):"memory");}
__device__ __forceinline__ float max3f(float a,float b,float c){float r;asm("v_max3_f32 %0, %1, %2, %3":"=v"(r):"v"(a),"v"(b),"v"(c));return r;}
__device__ __forceinline__ float max2f(float a,float b){float r;asm("v_max_f32_e32 %0, %1, %2":"=v"(r):"v"(a),"v"(b));return r;}
__device__ __forceinline__ float fadd_s(float a,float b){float r;asm("v_add_f32_e32 %0, %1, %2":"=v"(r):"v"(a),"v"(b));return r;}
__device__ __forceinline__ float fsub_s(float a,float b){float r;asm("v_sub_f32_e32 %0, %1, %2":"=v"(r):"v"(a),"v"(b));return r;}
typedef float f32x2_t __attribute__((ext_vector_type(2))); typedef float f32x4_t __attribute__((ext_vector_type(4))); typedef __bf16 bf16x2_t __attribute__((ext_vector_type(2)));
__device__ __forceinline__ unsigned cvtpk_s(float lo,float hi){f32x2_t v={lo,hi};bf16x2_t b=__builtin_convertvector(v,bf16x2_t);return __builtin_bit_cast(unsigned,b);}
#define WAIT_BAR(N) asm volatile("s_waitcnt vmcnt(" #N ") lgkmcnt(0)\n\ts_barrier":::"memory")

__device__ __forceinline__ void qkt(f32x16&p0,f32x16&p1,const char*Kslot,const bf16x8*qr,const f32x16&negm,int r32,int hi){
  const char*kb=Kslot+hi*1024+r32*16;
  #pragma unroll
  for(int d0=0;d0<4;++d0){
    const bf16x8 b0=*reinterpret_cast<const bf16x8*>(kb+d0*2048);
    const bf16x8 b1=*reinterpret_cast<const bf16x8*>(kb+d0*2048+512);
    if(d0==0){p0=__builtin_amdgcn_mfma_f32_32x32x16_bf16(b0,qr[0],negm,0,0,0);p1=__builtin_amdgcn_mfma_f32_32x32x16_bf16(b1,qr[0],negm,0,0,0);}
    else{p0=__builtin_amdgcn_mfma_f32_32x32x16_bf16(b0,qr[d0],p0,0,0,0);p1=__builtin_amdgcn_mfma_f32_32x32x16_bf16(b1,qr[d0],p1,0,0,0);}}
}
typedef __attribute__((address_space(3))) const char* lds_cptr;
typedef short v4i16_t __attribute__((ext_vector_type(4)));
__device__ __forceinline__ void kload8(bf16x8*kf,lds_cptr kp){
  kf[0]=*(const __attribute__((address_space(3))) bf16x8*)(kp);      kf[1]=*(const __attribute__((address_space(3))) bf16x8*)(kp+512);
  kf[2]=*(const __attribute__((address_space(3))) bf16x8*)(kp+2048); kf[3]=*(const __attribute__((address_space(3))) bf16x8*)(kp+2560);
  kf[4]=*(const __attribute__((address_space(3))) bf16x8*)(kp+4096); kf[5]=*(const __attribute__((address_space(3))) bf16x8*)(kp+4608);
  kf[6]=*(const __attribute__((address_space(3))) bf16x8*)(kp+6144); kf[7]=*(const __attribute__((address_space(3))) bf16x8*)(kp+6656);
}
__device__ __forceinline__ void kload2(bf16x8*kf,lds_cptr kp,int j){ kf[2*j]=*(const __attribute__((address_space(3))) bf16x8*)(kp+j*2048); kf[2*j+1]=*(const __attribute__((address_space(3))) bf16x8*)(kp+j*2048+512); }
__device__ __forceinline__ s16x4 vtr(lds_cptr p){ return __builtin_bit_cast(s16x4,__builtin_amdgcn_ds_read_tr16_b64_v4i16((__attribute__((address_space(3))) v4i16_t*)p)); }
__device__ __forceinline__ float rowmax(const f32x16&p0,const f32x16&p1){
  float a=max3f(p0[0],p0[1],p1[0]),b=max3f(p0[2],p0[3],p1[1]);a=max3f(a,p1[2],p1[3]);
  #pragma unroll
  for(int r=4;r<16;r+=4){a=max3f(a,p0[r],p0[r+1]);b=max3f(b,p0[r+2],p0[r+3]);a=max3f(a,p1[r],p1[r+1]);b=max3f(b,p1[r+2],p1[r+3]);}
  const float m=max2f(a,b);
  auto rr=__builtin_amdgcn_permlane32_swap(__float_as_uint(m),__float_as_uint(m),false,false);
  return max2f(__uint_as_float(rr[0]),__uint_as_float(rr[1]));
}
__device__ __forceinline__ void pv(f32x16*o,int vb,bf16x8 pa0,bf16x8 pa1,bf16x8 pa2,bf16x8 pa3){
  #pragma unroll
  for(int d0=0;d0<2;++d0){s16x4 lo[4],hi[4];
    #pragma unroll
    for(int ks=0;ks<4;++ks){
      asm volatile("ds_read_b64_tr_b16 %0,%1 offset:%c2":"=&v"(lo[ks]):"v"(vb),"i"(d0*4096+ks*1024):"memory");
      asm volatile("ds_read_b64_tr_b16 %0,%1 offset:%c2":"=&v"(hi[ks]):"v"(vb),"i"(d0*4096+ks*1024+512):"memory");}
    asm volatile("s_waitcnt lgkmcnt(0)":::"memory");SBAR();
    #define PK(k) (bf16x8){lo[k][0],lo[k][1],lo[k][2],lo[k][3],hi[k][0],hi[k][1],hi[k][2],hi[k][3]}
    o[d0]=__builtin_amdgcn_mfma_f32_32x32x16_bf16(pa0,PK(0),o[d0],0,0,0);
    o[d0]=__builtin_amdgcn_mfma_f32_32x32x16_bf16(pa1,PK(1),o[d0],0,0,0);
    o[d0]=__builtin_amdgcn_mfma_f32_32x32x16_bf16(pa2,PK(2),o[d0],0,0,0);
    o[d0]=__builtin_amdgcn_mfma_f32_32x32x16_bf16(pa3,PK(3),o[d0],0,0,0);
    #undef PK
  }
}

#ifndef ATTN_STORE16
#define ATTN_STORE16(p,v) (*(u32x4*)(p)=(v))
#endif
template<int THRL> __device__ __forceinline__ void attn_unit(int b,int h,int qb,const bf16*Q,const bf16*__restrict__ K,const bf16*__restrict__ V,bf16*O,const float*__restrict__ gain,char*shm){
  const int tid=threadIdx.x,lane=tid&63,r32=lane&31,hi=lane>>5; const int wid=__builtin_amdgcn_readfirstlane(tid>>6);
  const long rowbase=(long)b*SEQ; const int q0=qb*QB;
  const bf16*Qw=Q+(rowbase+q0+wid*QBLK)*QP+h*D;
  const bf16*Kh=K+(long)(b*2+(h>>2))*KVROWS*KVP,*Vh=V+(long)(b*2+(h>>2))*KVROWS*KVP;
  const unsigned lds0=(unsigned)(uintptr_t)shm;
  float*wsf=(float*)(shm+LDS_WS)+wid*64;
  const bf16*ksrc=Kh+(long)lane*KVP+wid*8;
  const bf16*vsrc=Vh+(long)(16*(wid&3)+(lane>>2))*KVP+(wid>>2)*32+(lane&3)*8;
  const unsigned kdst=lds0+LDS_K+wid*1024, vdst=lds0+LDS_V+wid*1024;
  #define DMA_K(t,slot) glds16(ksrc+(long)(t)*KVBLK*KVP,(unsigned)__builtin_amdgcn_readfirstlane(kdst+(slot)))
  #define DMA_V(t,slot) glds16(vsrc+(long)(t)*KVBLK*KVP,(unsigned)__builtin_amdgcn_readfirstlane(vdst+(slot)))
  const int vb0=(int)(lds0+LDS_V)+((lane>>4)&1)*32+(lane&3)*8+(4*hi+((lane&15)>>2))*64;
  const char*Kbase=shm+LDS_K; bf16x8 kf[8];
  const lds_cptr shm3=(lds_cptr)shm; const lds_cptr kp0=shm3+LDS_K+hi*1024+r32*16; const lds_cptr vp0=shm3+LDS_V+((lane>>4)&1)*32+(lane&3)*8+(4*hi+((lane&15)>>2))*64;
  DMA_K(0,0);DMA_V(0,0);DMA_K(1,SLOTB);
  bf16x8 qr[4];
  #pragma unroll
  for(int d0=0;d0<4;++d0)qr[d0]=*reinterpret_cast<const bf16x8*>(&Qw[(long)r32*QP+d0*16+hi*8]);
  float mhat=0.f,l_reg=0.f;f32x16 o[2];o[0]=f32x16{};o[1]=f32x16{};f32x16 negm=f32x16{};asm volatile("":"+v"(negm));
  #define CMASK(P0,P1,t) do{}while(0)
  bool resc=false;
  #define START(P0,P1) do{ const float rm=rowmax(P0,P1); resc=false; \
    { const float dl=rm; mhat=fadd_s(mhat,dl); \
      _Pragma("unroll") for(int r=0;r<16;++r){P0[r]=fsub_s(P0[r],dl);P1[r]=fsub_s(P1[r],dl);} \
      _Pragma("unroll") for(int r=0;r<16;++r)negm[r]=-mhat; asm volatile("":"+v"(negm)); } \
    _Pragma("unroll") for(int r=0;r<16;++r)P0[r]=__builtin_amdgcn_exp2f(P0[r]); }while(0)
  #define RESC() do{ if(resc){ asm volatile("s_waitcnt lgkmcnt(0)":::"memory"); \
      _Pragma("unroll") for(int d_=0;d_<2;++d_) _Pragma("unroll") for(int r=0;r<16;++r)o[d_][r]*=wsf[crow(r,hi)]; } }while(0)
  f32x16 pA0,pA1,pB0,pB1;
  int sl_prev=0,sl_cur=0,sl_next=SLOTB;
  #define ROT() do{sl_prev=sl_cur;sl_cur=sl_next;sl_next=(sl_next==(NSLOT-1)*SLOTB)?0:sl_next+SLOTB;}while(0)
  DMA_K(2,2*SLOTB);
  WAIT_BAR(3);
  qkt(pA0,pA1,Kbase,qr,negm,r32,hi);asm volatile("s_nop 15\n\ts_nop 7":"+v"(pA0),"+v"(pA1));CMASK(pA0,pA1,0);
  START(pA0,pA1);
  _Pragma("unroll") for(int r=0;r<16;++r)pA1[r]=__builtin_amdgcn_exp2f(pA1[r]);
  WAIT_BAR(0);
  DMA_K(3,0);DMA_V(1,SLOTB);
  ROT();
  kload8(kf,kp0+sl_cur);
  WAIT_BAR(2);
  s16x4 vlo[8],vhi[8]; u32x4 pw0,pw1,pw2,pw3;
  #define PKW(P,B) cvtpk_s(P[B],P[B+1])
  #define PAF(k) __builtin_bit_cast(bf16x8,pw##k)
  #define VFR(i) (bf16x8){vlo[i][0],vlo[i][1],vlo[i][2],vlo[i][3],vhi[i][0],vhi[i][1],vhi[i][2],vhi[i][3]}
  #define PIN(x) asm volatile("":"+v"(x))
  #define MX3(a,b,c) __builtin_fmaxf(__builtin_fmaxf((a),(b)),(c))
  #define GAPA(MF,A0,A1,A2,A3,W0,W1,PW) do{ MF; sacc+=A0; sacc+=A1; sacc+=A2; sacc+=A3; PIN(sacc); W0; W1; PIN(PW); SBAR(); }while(0)
  #define EX(v) __builtin_amdgcn_exp2f(v)
  #define GAPB(MF,X,B) do{ MF; X[B]=EX(X[B]); X[B+1]=EX(X[B+1]); X[B+2]=EX(X[B+2]); X[B+3]=EX(X[B+3]); PIN(X); SBAR(); }while(0)
  #define VRD(i) do{ vlo[i]=vtr(vp_+(((i)>>2)*4096+((i)&3)*1024)); vhi[i]=vtr(vp_+(((i)>>2)*4096+((i)&3)*1024+512)); }while(0)
  #define KRD(G,j) do{ if(G){ kload2(kf,kp0+sl_next,j); SBAR(); } }while(0)
  #define STEP(C0,C1,P0,P1,t,GK,GV,GL) do{ SBAR(); \
    const lds_cptr vp_=vp0+sl_prev; \
    VRD(0); SBAR(); float sacc=(P0[0]+P0[1]); \
    GAPA(C0=__builtin_amdgcn_mfma_f32_32x32x16_bf16(kf[0],qr[0],negm,0,0,0), P0[2],P0[3],P0[4],P0[5],     pw0[0]=PKW(P0,0), pw0[1]=PKW(P0,2), pw0); \
    VRD(4); SBAR(); GAPA(C1=__builtin_amdgcn_mfma_f32_32x32x16_bf16(kf[1],qr[0],negm,0,0,0), P0[6],P0[7],P0[8],P0[9],     pw0[2]=PKW(P0,4), pw0[3]=PKW(P0,6), pw0); \
    VRD(1); SBAR(); GAPA(C0=__builtin_amdgcn_mfma_f32_32x32x16_bf16(kf[2],qr[1],C0,0,0,0),   P0[10],P0[11],P0[12],P0[13], pw1[0]=PKW(P0,8), pw1[1]=PKW(P0,10), pw1); \
    VRD(5); SBAR(); GAPA(C1=__builtin_amdgcn_mfma_f32_32x32x16_bf16(kf[3],qr[1],C1,0,0,0),   P0[14],P0[15],P1[0],P1[1],   pw1[2]=PKW(P0,12),pw1[3]=PKW(P0,14), pw1); \
    VRD(2); SBAR(); GAPA(C0=__builtin_amdgcn_mfma_f32_32x32x16_bf16(kf[4],qr[2],C0,0,0,0),   P1[2],P1[3],P1[4],P1[5],     pw2[0]=PKW(P1,0), pw2[1]=PKW(P1,2), pw2); \
    VRD(6); SBAR(); GAPA(C1=__builtin_amdgcn_mfma_f32_32x32x16_bf16(kf[5],qr[2],C1,0,0,0),   P1[6],P1[7],P1[8],P1[9],     pw2[2]=PKW(P1,4), pw2[3]=PKW(P1,6), pw2); \
    VRD(3); SBAR(); GAPA(C0=__builtin_amdgcn_mfma_f32_32x32x16_bf16(kf[6],qr[3],C0,0,0,0),   P1[10],P1[11],P1[12],P1[13], pw3[0]=PKW(P1,8), pw3[1]=PKW(P1,10), pw3); \
    VRD(7); SBAR(); GAPA(C1=__builtin_amdgcn_mfma_f32_32x32x16_bf16(kf[7],qr[3],C1,0,0,0),   P1[14],P1[15],0.f,0.f,       pw3[2]=PKW(P1,12),pw3[3]=PKW(P1,14), pw3); \
    l_reg+=sacc; \
    if(GK){DMA_K((t)+3,sl_cur);} if(GV){DMA_V((t)+1,sl_next);} \
    CMASK(C0,C1,t); \
    { float a=MX3(C0[0],C0[1],C1[0]),b=MX3(C0[2],C0[3],C1[1]); a=MX3(a,C1[2],C1[3]); \
      _Pragma("unroll") for(int r=4;r<16;r+=4){a=MX3(a,C0[r],C0[r+1]);b=MX3(b,C0[r+2],C0[r+3]);a=MX3(a,C1[r],C1[r+1]);b=MX3(b,C1[r+2],C1[r+3]);} \
      float rm=__builtin_fmaxf(a,b); { auto rr=__builtin_amdgcn_permlane32_swap(__float_as_uint(rm),__float_as_uint(rm),false,false); rm=__builtin_fmaxf(__uint_as_float(rr[0]),__uint_as_float(rr[1])); } \
      resc=false; \
      if(__builtin_expect(__any(rm>(float)THRL),0)){ const float dl=__builtin_fmaxf(rm,0.f); mhat+=dl; \
        _Pragma("unroll") for(int r=0;r<16;++r){C0[r]-=dl;C1[r]-=dl;} \
        _Pragma("unroll") for(int r=0;r<16;++r)negm[r]=-mhat; asm volatile("":"+v"(negm)); \
        const float f=__builtin_amdgcn_exp2f(-dl); l_reg*=f; if(hi==0)wsf[r32]=f; resc=true; } } \
    SBAR(); \
    GAPB(o[0]=__builtin_amdgcn_mfma_f32_32x32x16_bf16(PAF(0),VFR(0),o[0],0,0,0), C0,0); \
    GAPB(o[1]=__builtin_amdgcn_mfma_f32_32x32x16_bf16(PAF(0),VFR(4),o[1],0,0,0), C0,4); \
    KRD(GL,0); GAPB(o[0]=__builtin_amdgcn_mfma_f32_32x32x16_bf16(PAF(1),VFR(1),o[0],0,0,0), C0,8); \
    KRD(GL,1); GAPB(o[1]=__builtin_amdgcn_mfma_f32_32x32x16_bf16(PAF(1),VFR(5),o[1],0,0,0), C0,12); \
    KRD(GL,2); GAPB(o[0]=__builtin_amdgcn_mfma_f32_32x32x16_bf16(PAF(2),VFR(2),o[0],0,0,0), C1,0); \
    KRD(GL,3); GAPB(o[1]=__builtin_amdgcn_mfma_f32_32x32x16_bf16(PAF(2),VFR(6),o[1],0,0,0), C1,4); \
    GAPB(o[0]=__builtin_amdgcn_mfma_f32_32x32x16_bf16(PAF(3),VFR(3),o[0],0,0,0), C1,8); \
    GAPB(o[1]=__builtin_amdgcn_mfma_f32_32x32x16_bf16(PAF(3),VFR(7),o[1],0,0,0), C1,12); \
    }while(0)
  int t=1;
  #undef CMASK
  #define CMASK(P0,P1,t) do{}while(0)
  for(;t+5<NT;t+=2){
    STEP(pB0,pB1,pA0,pA1,t,true,true,true);     WAIT_BAR(2); RESC(); ROT();
    STEP(pA0,pA1,pB0,pB1,t+1,true,true,true);   WAIT_BAR(2); RESC(); ROT();
  }
  #undef CMASK
  #define CMASK(P0,P1,t) do{ if((t)==NT-1)tmask(P0,P1); }while(0)
  #define ENDW(tt) do{ if((tt)+3<NT){WAIT_BAR(2);} else if((tt)+2<NT){WAIT_BAR(1);} else {WAIT_BAR(0);} }while(0)
  for(;t+1<NT;t+=2){
    STEP(pB0,pB1,pA0,pA1,t,(t+3<NT),(t+1<NT),(t+1<NT));       ENDW(t);   RESC(); ROT();
    STEP(pA0,pA1,pB0,pB1,t+1,(t+4<NT),(t+2<NT),(t+2<NT));     ENDW(t+1); RESC(); ROT();
  }
  static_assert((NT&1)==1&&NT>=7,"odd tile count: the pair loops end on tile NT-1 (scores in buffer A)");
  { float sacc=pA0[0]+pA0[1]; _Pragma("unroll") for(int r=2;r<16;++r)sacc+=pA0[r]; _Pragma("unroll") for(int r=0;r<16;++r)sacc+=pA1[r]; l_reg+=sacc;
    pw0=(u32x4){PKW(pA0,0),PKW(pA0,2),PKW(pA0,4),PKW(pA0,6)};pw1=(u32x4){PKW(pA0,8),PKW(pA0,10),PKW(pA0,12),PKW(pA0,14)};pw2=(u32x4){PKW(pA1,0),PKW(pA1,2),PKW(pA1,4),PKW(pA1,6)};pw3=(u32x4){PKW(pA1,8),PKW(pA1,10),PKW(pA1,12),PKW(pA1,14)};
    SBAR(); pv(o,vb0+sl_prev,PAF(0),PAF(1),PAF(2),PAF(3)); }
  #undef PKW
  #undef PAF
  #undef VFR
  #undef PIN
  #undef MX3
  #undef GAPA
  #undef GAPB
  #undef EX
  #undef VRD
  #undef KRD
  #undef STEP
  #undef ENDW
  {auto rr=__builtin_amdgcn_permlane32_swap(__float_as_uint(l_reg),__float_as_uint(l_reg),false,false);l_reg=__uint_as_float(rr[0])+__uint_as_float(rr[1]);}
  if(hi==0)wsf[32+r32]=l_reg;asm volatile("s_waitcnt lgkmcnt(0)":::"memory");
  float rli[16];
  #pragma unroll
  for(int r=0;r<16;++r)rli[r]=__builtin_amdgcn_rcpf(wsf[32+crow(r,hi)]);
  bf16*Ow=O+(rowbase+q0+wid*QBLK)*OP+h*D;
  { bf16*stg=(bf16*)(shm+LDS_OST)+wid*2048;
    #pragma unroll
    for(int r=0;r<16;++r){const int orow=crow(r,hi);
      #pragma unroll
      for(int d0=0;d0<2;++d0)stg[orow*64+d0*32+r32]=__float2bfloat16(o[d0][r]*rli[r]);}
    asm volatile("s_waitcnt lgkmcnt(0)":::"memory");
    #pragma unroll
    for(int i=0;i<4;++i){const int row=i*8+(lane>>3),ch=lane&7; const u32x4 v=*(const u32x4*)(stg+row*64+ch*8);
      float f[8]; f[0]=__uint_as_float(v.x<<16);f[1]=__uint_as_float(v.x&0xffff0000u);f[2]=__uint_as_float(v.y<<16);f[3]=__uint_as_float(v.y&0xffff0000u);
      f[4]=__uint_as_float(v.z<<16);f[5]=__uint_as_float(v.z&0xffff0000u);f[6]=__uint_as_float(v.w<<16);f[7]=__uint_as_float(v.w&0xffff0000u);
      float ss=0.f; _Pragma("unroll") for(int j=0;j<8;++j)ss+=f[j]*f[j];
      ss+=__shfl_xor(ss,1);ss+=__shfl_xor(ss,2);ss+=__shfl_xor(ss,4);
      const float rs=1.0f/sqrtf(ss*(1.0f/64.0f)+1e-6f); const f32x4_t g0=*(const f32x4_t*)(gain+h*D+ch*8),g1=*(const f32x4_t*)(gain+h*D+ch*8+4);
      u32x4 w; w[0]=cvtpk_s(f[0]*rs*g0[0],f[1]*rs*g0[1]);w[1]=cvtpk_s(f[2]*rs*g0[2],f[3]*rs*g0[3]);w[2]=cvtpk_s(f[4]*rs*g1[0],f[5]*rs*g1[1]);w[3]=cvtpk_s(f[6]*rs*g1[2],f[7]*rs*g1[3]);
      ATTN_STORE16(Ow+(long)row*OP+ch*8,w);} }
  asm volatile("s_waitcnt lgkmcnt(0)\n\ts_barrier":::"memory");
  #undef DMA_K
  #undef DMA_V
  #undef CMASK
  #undef START
  #undef RESC
  #undef ROT
}
constexpr int ATTN_LDS_BYTES=LDS_BYTES;
struct AttnTensors { const bf16* Q; const bf16* K; const bf16* V; bf16* O; const float* gain; };
struct AttnUnit { int b; int h; int qb; };
struct StaticOrder {
  int vcu;
  __device__ __forceinline__ explicit StaticOrder(int grid_,int block):vcu((grid_%8==0)?(block%8)*(grid_/8)+block/8:block),grid(grid_){}
  int grid;
  __device__ __forceinline__ bool next(int i,AttnUnit&u)const{ const int n=i*grid+vcu,pair=n>>5; if(pair>=48)return false; const int s=n&31; u.b=pair>>1; u.h=4*(pair&1)+(s>>3); u.qb=s&7; return true; }
};
template<class Sched,class Side,int THRL=8> __device__ __forceinline__ void attn_phase(char*lds,const AttnTensors&T,const Sched&S,int kside,const Side&side){
  AttnUnit u; int i=0;
  for(;i<kside&&S.next(i,u);++i){ attn_unit<THRL>(u.b,u.h,u.qb,T.Q,T.K,T.V,T.O,T.gain,lds); }
  side();
  for(;S.next(i,u);++i){ attn_unit<THRL>(u.b,u.h,u.qb,T.Q,T.K,T.V,T.O,T.gain,lds); }
}
#undef SBAR
#undef WAIT_BAR
}

typedef __attribute__((address_space(1))) unsigned gu32;
#define XB_TMO      128
#define XB_XCNT(j)  (256  + 64 * (j))
#define XB_XSUB(j)  (1280 + 64 * (j))
#define XB_XGEN(j)  (2304 + 64 * (j))
#define XB_TOP      3328
#define XB_TOPGEN   3392
#define XCD_BAR_WORDS 3456
#define XB_SPIN_CAP (1u << 18)

__device__ __forceinline__ unsigned xb_ld(unsigned* p)              { return __hip_atomic_load(p, __ATOMIC_RELAXED, __HIP_MEMORY_SCOPE_AGENT); }
__device__ __forceinline__ unsigned xb_add(unsigned* p, unsigned v) { return __hip_atomic_fetch_add(p, v, __ATOMIC_RELAXED, __HIP_MEMORY_SCOPE_AGENT); }
__device__ __forceinline__ unsigned xb_xcc_id() { return (unsigned)__builtin_amdgcn_s_getreg((3 << 11) | 20) & 0xFu; }
#define XB_SPIN(cond, bar) do { unsigned _sp = 0; while (cond) { __builtin_amdgcn_s_sleep(1); \
    if ((++_sp & 255u) == 0u) { if (xb_ld(&(bar)[XB_TMO])) break; if (_sp > XB_SPIN_CAP) { atomicAdd(&(bar)[XB_TMO], 1u); break; } } } } while (0)

struct XcdBarrier {
    unsigned* bar; unsigned x;
    volatile LAS unsigned* st;
};

__device__ __forceinline__ XcdBarrier xcd_barrier_post(unsigned* bar, volatile LAS unsigned* st) {
    XcdBarrier b; b.bar = bar; b.x = xb_xcc_id(); b.st = st;
    if (threadIdx.x == 0) (void)xb_add(&bar[XB_XCNT(b.x)], 1u);
    return b;
}
__device__ __forceinline__ void xcd_barrier_complete(unsigned* bar, unsigned x, unsigned& nloc, unsigned& nx) {
    const unsigned G = gridDim.x * gridDim.y * gridDim.z;
    unsigned sum, cnt, mine, sp = 0u;
    for (;;) {
        sum = 0u; cnt = 0u; mine = 0u;
#pragma unroll
        for (unsigned j = 0; j < 16; ++j) { const unsigned c = xb_ld(&bar[XB_XCNT(j)]); sum += c; cnt += (c > 0u) ? 1u : 0u; mine = (j == x) ? c : mine; }
        if (sum == G) break;
        __builtin_amdgcn_s_sleep(1);
        if ((++sp & 255u) == 0u) { if (xb_ld(&bar[XB_TMO])) break; if (sp > XB_SPIN_CAP) { atomicAdd(&bar[XB_TMO], 1u); break; } }
    }
    nloc = mine > 0u ? mine : 1u; nx = cnt > 0u ? cnt : 1u;
}

__device__ __forceinline__ void xcd_barrier(const XcdBarrier& b) {
    asm volatile("s_waitcnt vmcnt(0)" ::: "memory");
    __syncthreads();
    if (threadIdx.x == 0) {
        unsigned* bar = b.bar;
        __builtin_amdgcn_s_waitcnt(0);
        unsigned nloc = b.st[0], nx = b.st[1];
        if (nloc == 0u) { xcd_barrier_complete(bar, b.x, nloc, nx); b.st[0] = nloc; b.st[1] = nx; }
        const unsigned old = xb_add(&bar[XB_XSUB(b.x)], 1u);
        const unsigned gen = old / nloc;
        if (old + 1u == (gen + 1u) * nloc) {
            __builtin_amdgcn_fence(__ATOMIC_RELEASE, "agent");
            asm volatile("s_waitcnt vmcnt(0)" ::: "memory");
            const unsigned og = xb_add(&bar[XB_TOP], 1u);
            const unsigned tg = og / nx;
            if (og + 1u == (tg + 1u) * nx) xb_add(&bar[XB_TOPGEN], 1u);
            else XB_SPIN(xb_ld(&bar[XB_TOPGEN]) == tg, bar);
            __builtin_amdgcn_fence(__ATOMIC_ACQUIRE, "agent");
            xb_add(&bar[XB_XGEN(b.x)], 1u);
            asm volatile("s_waitcnt vmcnt(0)" ::: "memory");
        } else {
            XB_SPIN(xb_ld(&bar[XB_XGEN(b.x)]) == gen, bar);
            __builtin_amdgcn_fence(__ATOMIC_ACQUIRE, "agent");
            asm volatile("s_waitcnt vmcnt(0)" ::: "memory");
        }
    }
    __syncthreads();
}


__global__ void __launch_bounds__(NTHR, 2) enc_fwd(Args a) {
    extern __shared__ __attribute__((aligned(16))) unsigned char lds[];
    cg::grid_group grid = cg::this_grid();
    const int tid = threadIdx.x, lane = tid & 63, wave = __builtin_amdgcn_readfirstlane(tid >> 6);
    const int G = gridDim.x, gw = blockIdx.x * NWAVES + wave, NGW = G * NWAVES;
    const int lo = a.ph_lo, hi = a.ph_hi;
    volatile LAS unsigned* MISC = (volatile LAS unsigned*)((LAS unsigned char*)lds + LDS_BYTES - 64);
    if (tid < 16) MISC[tid] = 0u;
    __syncthreads();
    (void)xcd_barrier_post((unsigned*)(a.ws + WS_CTL) + 4096, MISC);
#define IN(k) (lo <= (k) && (k) < hi)
#ifndef PROBE_X2
#define PROBE_X2 -1
#endif
#define REP(k) for (int rep_ = 0; rep_ < ((k) == PROBE_X2 ? 2 : 1); ++rep_)
#define SEAM(k) do { if (IN(k) && IN((k) + 1)) { if (lo > 1000) grid.sync();   { XcdBarrier bar_; bar_.bar = (unsigned*)(a.ws + WS_CTL) + 4096; bar_.x = xb_xcc_id(); bar_.st = MISC; xcd_barrier(bar_); } } } while (0)
    if (IN(0)) REP(0) { p0_prologue(a, lds, tid, lane, wave); } SEAM(0);
    if (IN(1)) REP(1) { pg8::Gemm g{(const bf16_t*)(a.ws + WS_XA), (const bf16_t*)(a.ws + WS_WIN), NTOK, INW, DM}; pg8::StaticOrder S; S.init(NTOK, INW, G, (int)blockIdx.x);
        pg8::EpiInProj E{(bf16_t*)(a.ws + WS_Z), (bf16_t*)(a.ws + WS_Q), (bf16_t*)(a.ws + WS_KB), (bf16_t*)(a.ws + WS_VB), (const float*)(a.ws + WS_ROPE), a.qg, a.kg};
        kv_meta_rows(a, lane, gw, NGW);
        pg8::gemm_phase<pg8::EpiInProj, pg8::StaticOrder, true, true>((LAS unsigned char*)lds, g, S, E); } SEAM(1);
    if (IN(3)) REP(3) { const attn_body::AttnTensors AT{(const attn_body::bf16*)(a.ws + WS_Q), (const attn_body::bf16*)(a.ws + WS_KB), (const attn_body::bf16*)(a.ws + WS_VB), (attn_body::bf16*)(a.ws + WS_XA) + 512, a.attn_g};
        const attn_body::StaticOrder S(G, (int)blockIdx.x);
        auto side = [&]() { p2_pass(a, lane, gw, NGW);
            __syncthreads(); };
        attn_body::attn_phase<attn_body::StaticOrder>((char*)lds, AT, S, (int)((blockIdx.x >> 3) * 6) >> 5, side); } SEAM(3);
    if (IN(4)) REP(4) { pg8::Gemm g{(const bf16_t*)(a.ws + WS_XA), (const bf16_t*)(a.ws + WS_WOUT), NTOK, DM, DM}; pg8::StaticOrder S; S.init(NTOK, DM, G, (int)blockIdx.x);
        pg8::EpiResidNorm E{a.xp, a.xs, a.out, NBP * SEQ, (bf16_t*)(a.ws + WS_HB), a.ws + WS_X8, (float*)(a.ws + WS_SS), X8SCALE};
        pg8::gemm_phase<pg8::EpiResidNorm, pg8::StaticOrder, true, true>((LAS unsigned char*)lds, g, S, E); } SEAM(4);
    if (IN(6)) REP(6) { pg8::Gemm g{(const bf16_t*)(a.ws + WS_X8), (const bf16_t*)(a.ws + WS_WQ), NTOK, PQ, DM / 2}; pg8::StaticOrder S; S.init(NTOK, PQ, G, (int)blockIdx.x);
        pg8::EpiBf16 E{(bf16_t*)(a.ws + WS_QP), PQ, 1.0f / (X8SCALE * WQSCALE)};
        pg8::gemm_phase<pg8::EpiBf16, pg8::StaticOrder, true, true, true>((LAS unsigned char*)lds, g, S, E); } SEAM(6);
    if (IN(7)) REP(7) { p7_topk(a, lds, tid, lane, wave);
        table_fp4<false>(a.pu, a.ws + WS_UT, (float*)(a.ws + WS_USC), a.g_ffn, gw, NGW, lane);
        table_fp4<true>(a.pv, a.ws + WS_UT + 4 * SLICE4, (float*)(a.ws + WS_VSC), nullptr, gw, NGW, lane);
        __syncthreads(); } SEAM(7);
    if (IN(8)) REP(8) { p8a_u(a, lane, wave); } SEAM(8);
    if (IN(9)) REP(9) { p8c_combine(a, lds, tid); __syncthreads(); } SEAM(9);
    if (IN(10)) REP(10) { p8b_v(a, lds, lane, wave, rep_ == ((10 == PROBE_X2) ? 1 : 0)); }
#undef IN
#undef SEAM
}

extern "C" void kernel_launch(void* const* d_in, const int* in_sizes, int n_in, void* d_out, int out_size, void* d_ws, size_t ws_size, hipStream_t stream) {
    static int grid = 0;
    if (grid == 0) {
        if (n_in != 16 || out_size != NTOK * DM || ws_size < WS_END) { fprintf(stderr, "kernel_launch: unexpected shapes (n_in %d out %d ws %zu)\n", n_in, out_size, ws_size); grid = -1; return; }
        int dev = 0, cus = 0, per_cu = 0;
        (void)hipGetDevice(&dev); (void)hipDeviceGetAttribute(&cus, hipDeviceAttributeMultiprocessorCount, dev);
        (void)hipFuncSetAttribute((const void*)enc_fwd, hipFuncAttributeMaxDynamicSharedMemorySize, LDS_BYTES);
        (void)hipOccupancyMaxActiveBlocksPerMultiprocessor(&per_cu, (const void*)enc_fwd, NTHR, LDS_BYTES);
        if (per_cu < 1) { fprintf(stderr, "kernel_launch: occupancy query says %d blocks/CU\n", per_cu); per_cu = 1; }
        (void)hipGetLastError();
        grid = cus * 1;
    }
    if (grid < 0) return;
    (void)hipMemsetAsync((char*)d_ws + WS_CTL, 0, 64 * 1024, stream);
    Args a{};
    a.xp = (const float*)d_in[0]; a.xs = (const float*)d_in[1]; a.meta = (const float*)d_in[2]; a.g_mix = (const float*)d_in[3]; a.w_in = (const float*)d_in[4];
    a.conv_w = (const float*)d_in[5]; a.qg = (const float*)d_in[6]; a.kg = (const float*)d_in[7]; a.conv_g = (const float*)d_in[8]; a.attn_g = (const float*)d_in[9];
    a.w_out = (const float*)d_in[10]; a.g_ffn = (const float*)d_in[11]; a.wq = (const float*)d_in[12]; a.subk = (const float*)d_in[13]; a.pu = (const float*)d_in[14]; a.pv = (const float*)d_in[15];
    a.out = (float*)d_out; a.ws = (unsigned char*)d_ws;
    constexpr int NL = MK_N_LAUNCHES;
    for (int li = 0; li < NL; ++li) {
        a.ph_lo = (NL == 1) ? 0 : li; a.ph_hi = (NL == 1) ? NPHASE : li + 1;
        void* args[] = {&a};
        hipError_t e = hipLaunchCooperativeKernel((const void*)enc_fwd, dim3(grid), dim3(NTHR), args, LDS_BYTES, stream);
        if (e != hipSuccess) { fprintf(stderr, "kernel_launch: launch %d failed: %s\n", li, hipGetErrorString(e)); break; }
    }
}
```

```cpp
#include <hip/hip_runtime.h>
#include <hip/hip_cooperative_groups.h>
#include <cstdint>
#include <cstdio>
namespace cg = cooperative_groups;

#ifndef MK_N_LAUNCHES
#define MK_N_LAUNCHES 1
#endif

typedef unsigned short bf16_t;
typedef short bf16x8 __attribute__((ext_vector_type(8)));
typedef float f32x4 __attribute__((ext_vector_type(4)));
typedef unsigned u32x4 __attribute__((ext_vector_type(4)));
typedef unsigned u32x2 __attribute__((ext_vector_type(2)));
#define LAS __attribute__((address_space(3)))

constexpr int NB = 24, NBP = 16, SEQ = 2048, DM = 1024, NTOK = NB * SEQ;
constexpr int NMETA = 16, INW = 2304, KROWS = 2112;
constexpr int NKEYS = SEQ + NMETA;
constexpr int PQ = 2048;
constexpr float EPS = 1e-6f;
constexpr float C2 = 0.125f * 1.4426950408889634f;
constexpr int NWAVES = 8, NTHR = 512;
constexpr int LDS_BYTES = 163840;
constexpr int NPHASE = 11;

constexpr size_t MiB = 1u << 20;
constexpr size_t WS_CTL = 0;
constexpr size_t WS_WIN = 1 * MiB;
constexpr size_t WS_WOUT = 6 * MiB;
constexpr size_t WS_WQ = 8 * MiB;
constexpr size_t WS_SUBK = 12 * MiB;
constexpr size_t WS_ZMETA = 12 * MiB + 512 * 1024;
constexpr size_t WS_ROPE = WS_ZMETA + 256 * 1024;
constexpr size_t WS_UT = 13 * MiB;
constexpr size_t WS_USC = 29 * MiB, WS_VSC = WS_USC + 64 * 1024;
constexpr size_t WS_SS = WS_USC + 256 * 1024;
constexpr size_t SLICE4 = (size_t)16384 * 128;
constexpr size_t WS_XA = 32 * MiB;
constexpr size_t WS_EI = WS_XA, WS_GT = WS_XA + 12 * MiB;
constexpr size_t WS_Z = 128 * MiB;
constexpr size_t WS_HB = WS_Z;
constexpr size_t WS_QP = WS_Z + 96 * MiB;
constexpr size_t WS_PB = WS_QP;
constexpr size_t WS_AB = WS_PB + (size_t)4 * 49152 * 128 * 4;
constexpr size_t WS_Q = 416 * MiB;
constexpr size_t WS_X8 = WS_Q;
constexpr size_t WS_KB = 464 * MiB;
constexpr size_t WS_VB = 477 * MiB;
constexpr size_t WS_END = 490 * MiB;
constexpr float X8SCALE = 8.0f;
constexpr float WQSCALE = 64.0f;
constexpr float A8SCALE = 256.0f;

struct Args {
    const float* xp; const float* xs; const float* meta; const float* g_mix; const float* w_in; const float* conv_w;
    const float* qg; const float* kg; const float* conv_g; const float* attn_g; const float* w_out; const float* g_ffn;
    const float* wq; const float* subk; const float* pu; const float* pv;
    float* out; unsigned char* ws; int ph_lo, ph_hi;
};

__device__ __forceinline__ unsigned f2bf(float f) { unsigned u = __builtin_bit_cast(unsigned, f); return (u + 0x7fffu + ((u >> 16) & 1u)) >> 16; }
typedef float f32x2_pk __attribute__((ext_vector_type(2))); typedef __bf16 bf16x2_pk __attribute__((ext_vector_type(2)));
__device__ __forceinline__ unsigned pk2(float lo, float hi) { const f32x2_pk v = {lo, hi}; const bf16x2_pk b = __builtin_convertvector(v, bf16x2_pk); return __builtin_bit_cast(unsigned, b); }
__device__ __forceinline__ float bflo(unsigned w) { return __builtin_bit_cast(float, w << 16); }
__device__ __forceinline__ float bfhi(unsigned w) { return __builtin_bit_cast(float, w & 0xffff0000u); }
__device__ __forceinline__ float bf2f(bf16_t h) { return __builtin_bit_cast(float, (unsigned)h << 16); }
__device__ __forceinline__ void unpack8(u32x4 w, float* f) {
    f[0] = bflo(w.x); f[1] = bfhi(w.x); f[2] = bflo(w.y); f[3] = bfhi(w.y); f[4] = bflo(w.z); f[5] = bfhi(w.z); f[6] = bflo(w.w); f[7] = bfhi(w.w);
}
__device__ __forceinline__ u32x4 pack8(const float* f) { u32x4 w; w.x = pk2(f[0], f[1]); w.y = pk2(f[2], f[3]); w.z = pk2(f[4], f[5]); w.w = pk2(f[6], f[7]); return w; }
__device__ __forceinline__ float wave_sum(float v) {
#pragma unroll
    for (int o = 1; o < 64; o <<= 1) v += __shfl_xor(v, o);
    return v;
}
__device__ __forceinline__ float wave_max(float v) {
#pragma unroll
    for (int o = 1; o < 64; o <<= 1) v = fmaxf(v, __shfl_xor(v, o));
    return v;
}
__device__ __forceinline__ const float* xrow_ptr(const Args& a, int r) { return r < NBP * SEQ ? a.xp + (size_t)r * DM : a.xs + (size_t)(r - NBP * SEQ) * DM; }

__device__ __forceinline__ int permin(int n  ) {
    if (n >= 512 && n < 1536) { const int hc = (n - 512) >> 9, c = (n - 512) & 511; return 512 + (c >> 7) * 256 + hc * 128 + (c & 127); }
    if (n >= 1536 && n < 2048) { const int c = n - 1536, hh = c >> 6, half = (c >> 5) & 1; return 1536 + 256 * (hh >> 2) + 128 * half + 32 * (hh & 3) + (c & 31); }
    if (n >= 2048) { const int c = n - 2048, s = c >> 6, half = (c >> 5) & 1; return 2048 + 128 * half + 32 * s + (c & 31); }
    return n; }
__device__ __forceinline__ void p0_transpose_item(const float* W, int K, int N, bf16_t* WT, float* scr, int item, int lane, const float* gk = nullptr  , bool dperm = false) {
    const int nblk = N / 32, kb = item / nblk, nb = item % nblk, k0 = 64 * kb, n0 = 32 * nb, nd0 = dperm ? permin(n0) : n0;
#pragma unroll 8
    for (int i = 0; i < 32; ++i) { const int kk = 2 * i + (lane >> 5); scr[kk * 33 + (lane & 31)] = W[(size_t)(k0 + kk) * N + n0 + (lane & 31)] * (gk ? gk[k0 + kk] : 1.0f); }
    asm volatile("s_waitcnt lgkmcnt(0)" ::: "memory");
    const int c = lane & 7;
#pragma unroll
    for (int j = 0; j < 4; ++j) { const int n = (lane >> 3) + 8 * j; const float* s = scr + (8 * c) * 33 + n;
        u32x4 o; o.x = pk2(s[0 * 33], s[1 * 33]); o.y = pk2(s[2 * 33], s[3 * 33]); o.z = pk2(s[4 * 33], s[5 * 33]); o.w = pk2(s[6 * 33], s[7 * 33]);
        *(u32x4*)(WT + (size_t)(nd0 + n) * K + k0 + 8 * c) = o; }
    asm volatile("s_waitcnt lgkmcnt(0)" ::: "memory");
}
__device__ __forceinline__ void p0_transpose_item_fp8(const float* W, int K, int N, unsigned char* WT, float* scr, int item, int lane, const float* gk, float wscale) {
    const int nblk = N / 32, kb = item / nblk, nb = item % nblk, k0 = 64 * kb, n0 = 32 * nb;
#pragma unroll 8
    for (int i = 0; i < 32; ++i) { const int kk = 2 * i + (lane >> 5); scr[kk * 33 + (lane & 31)] = W[(size_t)(k0 + kk) * N + n0 + (lane & 31)] * (gk[k0 + kk] * wscale); }
    asm volatile("s_waitcnt lgkmcnt(0)" ::: "memory");
    const int c = lane & 7;
#pragma unroll
    for (int j = 0; j < 4; ++j) { const int n = (lane >> 3) + 8 * j; const float* s = scr + (8 * c) * 33 + n;
        unsigned w0 = (unsigned)__builtin_amdgcn_cvt_pk_fp8_f32(s[0 * 33], s[1 * 33], 0, false); w0 = (unsigned)__builtin_amdgcn_cvt_pk_fp8_f32(s[2 * 33], s[3 * 33], (int)w0, true);
        unsigned w1 = (unsigned)__builtin_amdgcn_cvt_pk_fp8_f32(s[4 * 33], s[5 * 33], 0, false); w1 = (unsigned)__builtin_amdgcn_cvt_pk_fp8_f32(s[6 * 33], s[7 * 33], (int)w1, true);
        *(u32x2*)(WT + (size_t)(n0 + n) * K + k0 + 8 * c) = (u32x2){w0, w1}; }
    asm volatile("s_waitcnt lgkmcnt(0)" ::: "memory");
}
__device__ __forceinline__ void cast_region(const float* src, bf16_t* dst, size_t n, size_t gtid, size_t nthreads) {
    for (size_t i = gtid * 8; i < n; i += nthreads * 8) {
        const f32x4 a = *(const f32x4*)(src + i), b = *(const f32x4*)(src + i + 4);
        u32x4 o; o.x = pk2(a.x, a.y); o.y = pk2(a.z, a.w); o.z = pk2(b.x, b.y); o.w = pk2(b.z, b.w);
        *(u32x4*)(dst + i) = o;
    }
}
template <bool PERM64> __device__ __forceinline__ void table_fp4(const float* src, unsigned char* dst, float* scale, const float* gcol  , int gw, int NGW, int lane) {
    f32x4 v[4], vn[4], g[4];
#pragma unroll
    for (int j = 0; j < 4; ++j) g[j] = gcol ? *(const f32x4*)(gcol + lane * 16 + 4 * j) : (f32x4){1.f, 1.f, 1.f, 1.f};
    if (gw < 16384) {
#pragma unroll
        for (int j = 0; j < 4; ++j) v[j] = __builtin_nontemporal_load((const f32x4*)(src + (size_t)gw * DM + lane * 16 + 4 * j)); }
    for (int row = gw; row < 16384; row += NGW) {
        { const int rn = row + NGW < 16384 ? row + NGW : row;
#pragma unroll
          for (int j = 0; j < 4; ++j) vn[j] = __builtin_nontemporal_load((const f32x4*)(src + (size_t)rn * DM + lane * 16 + 4 * j)); }
        float m = 0.f;
#pragma unroll
        for (int j = 0; j < 4; ++j) { v[j] = v[j] * g[j]; m = fmaxf(fmaxf(m, fmaxf(fabsf(v[j].x), fabsf(v[j].y))), fmaxf(fabsf(v[j].z), fabsf(v[j].w))); }
        m = wave_max(m);
        const float s = fmaxf(m, 1e-30f) * (1.0f / 6.0f), inv = 1.0f / s;
        unsigned char* rowp = dst + (size_t)(lane >> 4) * SLICE4 + (size_t)row * 128;
        if (!PERM64) {
            unsigned w0 = 0u, w1 = 0u;
            w0 = __builtin_amdgcn_cvt_scalef32_pk_fp4_f32(w0, v[0].x * inv, v[0].y * inv, 1.0f, 0); w0 = __builtin_amdgcn_cvt_scalef32_pk_fp4_f32(w0, v[0].z * inv, v[0].w * inv, 1.0f, 1);
            w0 = __builtin_amdgcn_cvt_scalef32_pk_fp4_f32(w0, v[1].x * inv, v[1].y * inv, 1.0f, 2); w0 = __builtin_amdgcn_cvt_scalef32_pk_fp4_f32(w0, v[1].z * inv, v[1].w * inv, 1.0f, 3);
            w1 = __builtin_amdgcn_cvt_scalef32_pk_fp4_f32(w1, v[2].x * inv, v[2].y * inv, 1.0f, 0); w1 = __builtin_amdgcn_cvt_scalef32_pk_fp4_f32(w1, v[2].z * inv, v[2].w * inv, 1.0f, 1);
            w1 = __builtin_amdgcn_cvt_scalef32_pk_fp4_f32(w1, v[3].x * inv, v[3].y * inv, 1.0f, 2); w1 = __builtin_amdgcn_cvt_scalef32_pk_fp4_f32(w1, v[3].z * inv, v[3].w * inv, 1.0f, 3);
            *(u32x2*)(rowp + (lane & 15) * 8) = (u32x2){w0, w1};
        } else {
            unsigned char* gp = rowp + ((lane & 15) >> 2) * 32 + (lane & 3) * 2;
#pragma unroll
            for (int m = 0; m < 4; ++m) { unsigned wm = 0u;
                wm = __builtin_amdgcn_cvt_scalef32_pk_fp4_f32(wm, v[0][m] * inv, v[1][m] * inv, 1.0f, 0); wm = __builtin_amdgcn_cvt_scalef32_pk_fp4_f32(wm, v[2][m] * inv, v[3][m] * inv, 1.0f, 1);
                *(unsigned short*)(gp + 8 * m) = (unsigned short)wm; }
        }
        if (lane == 0) scale[row] = s;
#pragma unroll
        for (int j = 0; j < 4; ++j) v[j] = vn[j];
    }
}
__device__ __forceinline__ void p0_prologue(const Args& a, unsigned char* lds, int tid, int lane, int wave) {
    const int G = gridDim.x, gw = blockIdx.x * NWAVES + wave, NGW = G * NWAVES;
    float* ldsf = (float*)lds;
    if (blockIdx.x < INW / 64) {
        float* xm = ldsf;
        float* red = ldsf + 16 * 1024;
#pragma unroll
        for (int rr = 0; rr < 2; ++rr) { const int r = 2 * wave + rr; f32x4 v[4]; float ss = 0.f;
#pragma unroll
            for (int j = 0; j < 4; ++j) { v[j] = *(const f32x4*)(a.meta + (size_t)r * DM + (lane + 64 * j) * 4); ss += v[j].x * v[j].x + v[j].y * v[j].y + v[j].z * v[j].z + v[j].w * v[j].w; }
            const float rstd = 1.0f / sqrtf(wave_sum(ss) * (1.0f / DM) + EPS);
#pragma unroll
            for (int j = 0; j < 4; ++j) { const int c = (lane + 64 * j) * 4; const f32x4 g = *(const f32x4*)(a.g_mix + c); *(f32x4*)(xm + r * 1024 + c) = v[j] * rstd * g; }
        }
        __syncthreads();
        const int n0 = blockIdx.x * 64, k0 = wave * 128;
        float acc[16];
#pragma unroll
        for (int r = 0; r < 16; ++r) acc[r] = 0.f;
        for (int kb = k0; kb < k0 + 128; kb += 16) { float wv[16];
#pragma unroll
            for (int q = 0; q < 16; ++q) wv[q] = a.w_in[(size_t)(kb + q) * INW + n0 + lane];
#pragma unroll
            for (int q = 0; q < 16; ++q)
#pragma unroll
                for (int r = 0; r < 16; ++r) acc[r] += xm[r * 1024 + kb + q] * wv[q]; }
#pragma unroll
        for (int r = 0; r < 16; ++r) red[(wave * 16 + r) * 64 + lane] = acc[r];
        __syncthreads();
        float* zmeta = (float*)(a.ws + WS_ZMETA);
        for (int o = tid; o < 1024; o += NTHR) { const int r = o >> 6, c = o & 63; float s = 0.f;
#pragma unroll
            for (int w = 0; w < 8; ++w) s += red[(w * 16 + r) * 64 + c];
            zmeta[r * INW + n0 + c] = s; }
        __syncthreads();
    }
    if (blockIdx.x == INW / 64) {
        float* rope = (float*)(a.ws + WS_ROPE);
        for (int i = tid; i < 64 * 16; i += NTHR) { const int pos = i >> 4, f = i & 15;
            const float freq = exp2f(-(float)f * (13.287712379549449f / 16.0f)); const float rev = (float)pos * freq * 0.15915494309189535f; const float fr = rev - floorf(rev);
            rope[2 * i] = __builtin_amdgcn_cosf(fr); rope[2 * i + 1] = __builtin_amdgcn_sinf(fr); }
    }
    if ((int)blockIdx.x > INW / 64 || G <= INW / 64 + 1) {
        float* scr = ldsf + wave * (64 * 33);
        constexpr int I_IN = (DM / 64) * (INW / 32), I_OUT = (DM / 64) * (DM / 32), I_WQ = (DM / 64) * (PQ / 32);
        const int first = (G <= INW / 64 + 1) ? 0 : INW / 64 + 1, nw = (G - first) * NWAVES;
        for (int it = ((int)blockIdx.x - first) * NWAVES + wave; it < I_IN + I_OUT + I_WQ; it += nw) {
            int r = it;
            if (r < I_IN) { p0_transpose_item(a.w_in, DM, INW, (bf16_t*)(a.ws + WS_WIN), scr, r, lane, nullptr, true); continue; } r -= I_IN;
            if (r < I_OUT) { p0_transpose_item(a.w_out, DM, DM, (bf16_t*)(a.ws + WS_WOUT), scr, r, lane); continue; } r -= I_OUT;
            p0_transpose_item_fp8(a.wq, DM, PQ, a.ws + WS_WQ, scr, r, lane, a.g_ffn, WQSCALE);
        }
    }
    {
        const size_t gtid = (size_t)blockIdx.x * NTHR + tid, nth = (size_t)G * NTHR;
        cast_region(a.subk, (bf16_t*)(a.ws + WS_SUBK), (size_t)16 * 128 * 128, gtid, nth);
        for (size_t i = gtid; i < (size_t)NTOK; i += nth) ((float*)(a.ws + WS_SS))[i] = 0.f;
    }
    {
        bf16_t* XA = (bf16_t*)(a.ws + WS_XA);
        f32x4 g[4], v[4], vn[4];
#pragma unroll
        for (int j = 0; j < 4; ++j) g[j] = *(const f32x4*)(a.g_mix + (lane + 64 * j) * 4);
        if (gw < NTOK) { const float* xr = xrow_ptr(a, gw);
#pragma unroll
            for (int j = 0; j < 4; ++j) v[j] = __builtin_nontemporal_load((const f32x4*)(xr + (lane + 64 * j) * 4)); }
        for (int r = gw; r < NTOK; r += NGW) {
            { const float* xn = xrow_ptr(a, r + NGW < NTOK ? r + NGW : r);
#pragma unroll
              for (int j = 0; j < 4; ++j) vn[j] = __builtin_nontemporal_load((const f32x4*)(xn + (lane + 64 * j) * 4)); }
            float ss = 0.f;
#pragma unroll
            for (int j = 0; j < 4; ++j) ss += v[j].x * v[j].x + v[j].y * v[j].y + v[j].z * v[j].z + v[j].w * v[j].w;
            const float rstd = 1.0f / sqrtf(wave_sum(ss) * (1.0f / DM) + EPS);
#pragma unroll
            for (int j = 0; j < 4; ++j) { const int c = (lane + 64 * j) * 4; const f32x4 o = v[j] * rstd * g[j];
                u32x2 w; w.x = pk2(o.x, o.y); w.y = pk2(o.z, o.w); *(u32x2*)(XA + (size_t)r * DM + c) = w; }
#pragma unroll
            for (int j = 0; j < 4; ++j) v[j] = vn[j];
        }
    }
}

constexpr int ZW = 1024;
struct P2In { u32x4 w[4]; };
__device__ __forceinline__ void p2_load(P2In& in, const bf16_t* ZB, int r, int lane) {
    const int t = r & 2047, c0 = lane * 8; const bf16_t* zr = ZB + (size_t)r * ZW;
    const bf16_t* zp = (t > 0) ? zr - ZW : zr; const bf16_t* zn = (t < SEQ - 1) ? zr + ZW : zr;
    in.w[0] = *(const u32x4*)(zr + c0); in.w[1] = *(const u32x4*)(zr + 512 + c0); in.w[2] = *(const u32x4*)(zp + 512 + c0); in.w[3] = *(const u32x4*)(zn + 512 + c0);
}
__device__ __forceinline__ void p2_pass(const Args& a, int lane, int gw, int NGW) {
    const bf16_t* ZB = (const bf16_t*)(a.ws + WS_Z); const float* zmeta = (const float*)(a.ws + WS_ZMETA);
    bf16_t* XA = (bf16_t*)(a.ws + WS_XA);
    const int c0 = lane * 8;
    float cw0[8], cw1[8], cw2[8], cgn[8];
#pragma unroll
    for (int j = 0; j < 8; ++j) { cw0[j] = a.conv_w[c0 + j]; cw1[j] = a.conv_w[512 + c0 + j]; cw2[j] = a.conv_w[1024 + c0 + j]; cgn[j] = a.conv_g[c0 + j]; }
    P2In cur, nxt, nx2;
    if (gw < NTOK) { p2_load(cur, ZB, gw, lane); p2_load(nxt, ZB, gw + NGW < NTOK ? gw + NGW : gw, lane); }
    for (int it = gw; it < NTOK; it += NGW) {
        {
            const int r = it, t = r & 2047;
            { const int rn = it + 2 * NGW < NTOK ? it + 2 * NGW : it; p2_load(nx2, ZB, rn, lane); }
            float gb[8], uc[8], up[8], un[8];
            unpack8(cur.w[0], gb); unpack8(cur.w[1], uc); unpack8(cur.w[2], up);
            if (t == 0) {
#pragma unroll
                for (int j = 0; j < 8; ++j) up[j] = zmeta[15 * INW + 512 + c0 + j] * zmeta[15 * INW + 1024 + c0 + j]; }
            unpack8(cur.w[3], un);
#pragma unroll
            for (int j = 0; j < 8; ++j) un[j] = (t < SEQ - 1) ? un[j] : 0.f;
            float y[8], ss = 0.f;
#pragma unroll
            for (int j = 0; j < 8; ++j) { y[j] = gb[j] * (up[j] * cw0[j] + uc[j] * cw1[j] + un[j] * cw2[j]); ss += y[j] * y[j]; }
            ss += __shfl_xor(ss, 1); ss += __shfl_xor(ss, 2); ss += __shfl_xor(ss, 4);
            const float rstd = 1.0f / sqrtf(ss * (1.0f / 64.0f) + EPS);
#pragma unroll
            for (int j = 0; j < 8; ++j) y[j] = y[j] * rstd * cgn[j];
            *(u32x4*)(XA + (size_t)r * DM + c0) = pack8(y);
            cur = nxt; nxt = nx2;
        }
    }
}
__device__ __forceinline__ void kv_meta_rows(const Args& a, int lane, int gw, int NGW) {
    const float* zmeta = (const float*)(a.ws + WS_ZMETA); bf16_t* KB = (bf16_t*)(a.ws + WS_KB); bf16_t* VB = (bf16_t*)(a.ws + WS_VB);
    const int i = lane & 7;
    for (int it = NTOK + gw; it < NTOK + NB * 64; it += NGW) {
        {
            const int it2 = it - NTOK, b = it2 >> 6, j64 = it2 & 63; const int l16 = lane & 15, g = l16 >> 3;
            float k[8], v[8];
            if (j64 < NMETA) {
                const float* zm = zmeta + j64 * INW; float ss = 0.f;
#pragma unroll
                for (int j = 0; j < 8; ++j) { k[j] = zm[2048 + l16 * 8 + j]; v[j] = zm[2176 + l16 * 8 + j]; ss += k[j] * k[j]; }
                ss += __shfl_xor(ss, 1); ss += __shfl_xor(ss, 2); ss += __shfl_xor(ss, 4);
                const float rstd = 1.0f / sqrtf(ss * (1.0f / 64.0f) + EPS);
#pragma unroll
                for (int j = 0; j < 8; ++j) k[j] = k[j] * rstd * a.kg[i * 8 + j];
            } else {
#pragma unroll
                for (int j = 0; j < 8; ++j) { k[j] = 0.f; v[j] = 0.f; }
            }
            const size_t krow = ((size_t)(b * 2 + g) * KROWS + SEQ + j64) * 64 + i * 8;
            if (lane < 16) *(u32x4*)(KB + krow) = pack8(k);
            else if (lane < 32) *(u32x4*)(VB + krow) = pack8(v);
        }
    }
}

typedef float f32x16 __attribute__((ext_vector_type(16)));
__device__ __forceinline__ void ce_desc(float& a, float& b) { float h, l; asm("v_max_f32_e32 %0, %1, %2" : "=v"(h) : "v"(a), "v"(b)); asm("v_min_f32_e32 %0, %1, %2" : "=v"(l) : "v"(a), "v"(b)); a = h; b = l; }
__device__ __forceinline__ float vmaxf(float a, float b) { float h; asm("v_max_f32_e32 %0, %1, %2" : "=v"(h) : "v"(a), "v"(b)); return h; }
template <int N> __device__ __forceinline__ void bitonic_sort_desc(float* v) {
#pragma unroll
    for (int k = 2; k <= N; k <<= 1)
#pragma unroll
        for (int j = k >> 1; j > 0; j >>= 1)
#pragma unroll
            for (int i = 0; i < N; ++i) { const int l = i ^ j; if (l > i) { if ((i & k) == 0) ce_desc(v[i], v[l]); else ce_desc(v[l], v[i]); } }
}
__device__ __forceinline__ void sort16_desc(float* v) {
    ce_desc(v[0], v[13]); ce_desc(v[1], v[12]); ce_desc(v[2], v[15]); ce_desc(v[3], v[14]); ce_desc(v[4], v[8]); ce_desc(v[5], v[6]); ce_desc(v[7], v[11]); ce_desc(v[9], v[10]);
    ce_desc(v[0], v[5]); ce_desc(v[1], v[7]); ce_desc(v[2], v[9]); ce_desc(v[3], v[4]); ce_desc(v[6], v[13]); ce_desc(v[8], v[14]); ce_desc(v[10], v[15]); ce_desc(v[11], v[12]);
    ce_desc(v[0], v[1]); ce_desc(v[2], v[3]); ce_desc(v[4], v[5]); ce_desc(v[6], v[8]); ce_desc(v[7], v[9]); ce_desc(v[10], v[11]); ce_desc(v[12], v[13]); ce_desc(v[14], v[15]);
    ce_desc(v[0], v[2]); ce_desc(v[1], v[3]); ce_desc(v[4], v[10]); ce_desc(v[5], v[11]); ce_desc(v[6], v[7]); ce_desc(v[8], v[9]); ce_desc(v[12], v[14]); ce_desc(v[13], v[15]);
    ce_desc(v[1], v[2]); ce_desc(v[3], v[12]); ce_desc(v[4], v[6]); ce_desc(v[5], v[7]); ce_desc(v[8], v[10]); ce_desc(v[9], v[11]); ce_desc(v[13], v[14]);
    ce_desc(v[1], v[4]); ce_desc(v[2], v[6]); ce_desc(v[5], v[8]); ce_desc(v[7], v[10]); ce_desc(v[9], v[13]); ce_desc(v[11], v[14]);
    ce_desc(v[2], v[4]); ce_desc(v[3], v[6]); ce_desc(v[9], v[12]); ce_desc(v[11], v[13]);
    ce_desc(v[3], v[5]); ce_desc(v[6], v[8]); ce_desc(v[7], v[9]); ce_desc(v[10], v[12]);
    ce_desc(v[3], v[4]); ce_desc(v[5], v[6]); ce_desc(v[7], v[8]); ce_desc(v[9], v[10]); ce_desc(v[11], v[12]);
    ce_desc(v[6], v[7]); ce_desc(v[8], v[9]);
}
template <int N> __device__ __forceinline__ void bitonic_merge_desc(float* v) {
#pragma unroll
    for (int j = N >> 1; j > 0; j >>= 1)
#pragma unroll
        for (int i = 0; i < N; ++i) { const int l = i ^ j; if (l > i) ce_desc(v[i], v[l]); }
}
__device__ __forceinline__ void merge_top16(float* x, const float* y) {
#pragma unroll
    for (int i = 0; i < 16; ++i) x[i] = vmaxf(x[i], y[15 - i]);
    bitonic_merge_desc<16>(x);
}
__device__ __forceinline__ void insert16(float* t, float x) {
#pragma unroll
    for (int k = 0; k < 16; ++k) ce_desc(t[k], x);
}
constexpr int SK_ROW = 272, SK_MAT = 128 * SK_ROW;
__device__ __forceinline__ void p7_half(const bf16_t* qrow  , const LAS unsigned char* skl  , int hi4, float* T) {
    f32x16 acc[4];
#pragma unroll
    for (int nb = 0; nb < 4; ++nb)
#pragma unroll
        for (int r = 0; r < 16; ++r) acc[nb][r] = 0.f;
    bf16x8 bq[8];
#pragma unroll
    for (int ks = 0; ks < 8; ++ks) bq[ks] = *(const bf16x8*)(qrow + ks * 16);
#pragma unroll
    for (int ks = 0; ks < 8; ++ks) {
#pragma unroll
        for (int nb = 0; nb < 4; ++nb) { const bf16x8 ak = *(const LAS bf16x8*)(skl + nb * 32 * SK_ROW + ks * 32); acc[nb] = __builtin_amdgcn_mfma_f32_32x32x16_bf16(ak, bq[ks], acc[nb], 0, 0, 0); }
        if (ks & 1) __builtin_amdgcn_sched_barrier(0);
    }
    float L[16];
#pragma unroll
    for (int nb = 0; nb < 4; ++nb) {
        float v[16];
#pragma unroll
        for (int r = 0; r < 16; ++r) { const float sc = acc[nb][r]; v[r] = __uint_as_float((__float_as_uint(sc) & ~127u) | (unsigned)(nb * 16 + r)); }
        sort16_desc(v);
        if (nb == 0) {
#pragma unroll
            for (int r = 0; r < 16; ++r) L[r] = v[r];
        } else merge_top16(L, v);
    }
#pragma unroll
    for (int r = 0; r < 16; ++r) { const unsigned w = __builtin_bit_cast(unsigned, L[r]); T[r] = __builtin_bit_cast(float, w + (w & 0x3Cu) + (unsigned)hi4); }
}
__device__ __forceinline__ unsigned pick_byte(unsigned p0, unsigned p1, unsigned p2, unsigned p3, unsigned i) {
    const unsigned sel = (i & 7u) | 0x0c0c0c00u;
    const unsigned lo = __builtin_amdgcn_perm(p1, p0, sel), hi = __builtin_amdgcn_perm(p3, p2, sel);
    return (i & 8u) ? hi : lo;
}
__device__ __forceinline__ void p7_topk(const Args& a, unsigned char* lds, int tid, int lane, int wave) {
    const bf16_t* QP = (const bf16_t*)(a.ws + WS_QP); const bf16_t* SUBK = (const bf16_t*)(a.ws + WS_SUBK);
    unsigned short* EIDX = (unsigned short*)(a.ws + WS_EI); bf16_t* GATE = (bf16_t*)(a.ws + WS_GT); const float* SSQ = (const float*)(a.ws + WS_SS);
    const int r32 = lane & 31, hi = lane >> 5;
    const int hp = blockIdx.x & 3, grp = blockIdx.x >> 2, ngrp = gridDim.x >> 2;
    { const u32x4* src = (const u32x4*)(SUBK + (size_t)hp * 4 * 128 * 128);
      for (int i = tid; i < 4 * 128 * 16; i += NTHR) { const int row = i >> 4, ch = i & 15; *(LAS u32x4*)((LAS unsigned char*)lds + row * SK_ROW + ch * 16) = src[i]; } }
    __syncthreads();
    const LAS unsigned char* skl = (const LAS unsigned char*)lds + r32 * SK_ROW + 16 * hi;
    for (int blk = grp * NWAVES + wave; blk < NTOK / 32; blk += ngrp * NWAVES) {
        const int tok = blk * 32 + r32;
        const float rs_l2e = 1.4426950408889634f / sqrtf(SSQ[tok] * (1.0f / DM) + EPS);
        float M0[16], M1[16];
        {
            float B0[16], B1[16];
            p7_half(QP + (size_t)tok * PQ + (2 * hp) * 256 + 8 * hi, skl + 0 * SK_MAT, 4 * hi, M0);
            p7_half(QP + (size_t)tok * PQ + (2 * hp) * 256 + 128 + 8 * hi, skl + 1 * SK_MAT, 4 * hi, M1);
            p7_half(QP + (size_t)tok * PQ + (2 * hp + 1) * 256 + 8 * hi, skl + 2 * SK_MAT, 4 * hi, B0);
            p7_half(QP + (size_t)tok * PQ + (2 * hp + 1) * 256 + 128 + 8 * hi, skl + 3 * SK_MAT, 4 * hi, B1);
#pragma unroll
            for (int i = 0; i < 16; ++i) {
                const auto r0 = __builtin_amdgcn_permlane32_swap(__builtin_bit_cast(unsigned, M0[i]), __builtin_bit_cast(unsigned, B0[i]), false, false);
                const unsigned a0 = r0[0], b0 = r0[1]; M0[i] = __builtin_bit_cast(float, a0); B0[i] = __builtin_bit_cast(float, b0);
                const auto r1 = __builtin_amdgcn_permlane32_swap(__builtin_bit_cast(unsigned, M1[i]), __builtin_bit_cast(unsigned, B1[i]), false, false);
                const unsigned a1 = r1[0], b1 = r1[1]; M1[i] = __builtin_bit_cast(float, a1); B1[i] = __builtin_bit_cast(float, b1); }
            merge_top16(M0, B0); merge_top16(M1, B1);
        }
        const int h = 2 * hp + hi;
#define CAND(i, j) __builtin_bit_cast(float, (__builtin_bit_cast(unsigned, M0[i] + M1[j]) & ~255u) | (unsigned)((i) * 16 + (j)))
        float tc[16], l2[16], l3[16];
#pragma unroll
        for (int j = 0; j < 16; ++j) tc[j] = CAND(0, j);
#pragma unroll
        for (int j = 0; j < 8; ++j) { l2[j] = CAND(1, j); l2[8 + j] = CAND(15 - j, 0); }
        bitonic_merge_desc<16>(l2);
        merge_top16(tc, l2);
        l3[0] = CAND(2, 0); l3[1] = CAND(2, 1); l3[2] = CAND(2, 2); l3[3] = CAND(2, 3); l3[4] = CAND(2, 4); l3[5] = CAND(3, 0); l3[6] = CAND(3, 1); l3[7] = CAND(3, 2); l3[8] = CAND(3, 3);
        l3[9] = CAND(4, 0); l3[10] = CAND(4, 1); l3[11] = CAND(4, 2); l3[12] = CAND(5, 0); l3[13] = CAND(5, 1); l3[14] = CAND(6, 0); l3[15] = CAND(6, 1);
        sort16_desc(l3);
        merge_top16(tc, l3);
        insert16(tc, CAND(7, 0)); insert16(tc, CAND(7, 1));
#undef CAND
#define PK4(M, q) ((__builtin_bit_cast(unsigned, M[4 * (q)]) & 127u) | ((__builtin_bit_cast(unsigned, M[4 * (q) + 1]) & 127u) << 8) | ((__builtin_bit_cast(unsigned, M[4 * (q) + 2]) & 127u) << 16) | ((__builtin_bit_cast(unsigned, M[4 * (q) + 3]) & 127u) << 24))
        const unsigned a0 = PK4(M0, 0), a1 = PK4(M0, 1), a2 = PK4(M0, 2), a3 = PK4(M0, 3), b0 = PK4(M1, 0), b1 = PK4(M1, 1), b2 = PK4(M1, 2), b3 = PK4(M1, 3);
#undef PK4
        float e[16], sum = 0.f;
#pragma unroll
        for (int k = 0; k < 16; ++k) { e[k] = exp2f((tc[k] - tc[0]) * rs_l2e); sum += e[k]; }
        const float inv = 1.0f / sum;
        int eo[16];
#pragma unroll
        for (int k = 0; k < 16; ++k) { const unsigned code = __builtin_bit_cast(unsigned, tc[k]) & 255u; eo[k] = (int)(pick_byte(a0, a1, a2, a3, code >> 4) * 128u + pick_byte(b0, b1, b2, b3, code & 15u)); e[k] *= inv; }
        unsigned short* ep = EIDX + ((size_t)tok * 8 + h) * 16; bf16_t* gp = GATE + ((size_t)tok * 8 + h) * 16;
#pragma unroll
        for (int k = 0; k < 16; k += 8) { u32x4 pk; pk.x = (unsigned)eo[k] | ((unsigned)eo[k + 1] << 16); pk.y = (unsigned)eo[k + 2] | ((unsigned)eo[k + 3] << 16); pk.z = (unsigned)eo[k + 4] | ((unsigned)eo[k + 5] << 16); pk.w = (unsigned)eo[k + 6] | ((unsigned)eo[k + 7] << 16); *(u32x4*)(ep + k) = pk; }
#pragma unroll
        for (int k = 0; k < 16; k += 8) *(u32x4*)(gp + k) = (u32x4){pk2(e[k], e[k + 1]), pk2(e[k + 2], e[k + 3]), pk2(e[k + 4], e[k + 5]), pk2(e[k + 6], e[k + 7])};
    }
}

typedef _Float16 h2_t __attribute__((ext_vector_type(2)));
typedef float f32x2 __attribute__((ext_vector_type(2)));
__device__ __forceinline__ float dot32_fp4(u32x4 w, const h2_t* xh) {
    float acc = 0.f;
#pragma unroll
    for (int d = 0; d < 4; ++d) {
        const unsigned wd = w[d];
        acc = __builtin_amdgcn_fdot2(__builtin_amdgcn_cvt_scalef32_pk_f16_fp4(wd, 1.0f, 0), xh[4 * d], acc, false);
        acc = __builtin_amdgcn_fdot2(__builtin_amdgcn_cvt_scalef32_pk_f16_fp4(wd, 1.0f, 1), xh[4 * d + 1], acc, false);
        acc = __builtin_amdgcn_fdot2(__builtin_amdgcn_cvt_scalef32_pk_f16_fp4(wd, 1.0f, 2), xh[4 * d + 2], acc, false);
        acc = __builtin_amdgcn_fdot2(__builtin_amdgcn_cvt_scalef32_pk_f16_fp4(wd, 1.0f, 3), xh[4 * d + 3], acc, false);
    }
    return acc;
}
typedef int i32x4 __attribute__((ext_vector_type(4)));
struct PMeta { unsigned p[8]; };
#define GAS __attribute__((address_space(1)))
template <class T> __device__ __forceinline__ GAS T* sgpr_ptr(T* p) { asm volatile("" : "+s"(p)); return (GAS T*)p; }
__device__ __forceinline__ void pm_load(PMeta& m, const unsigned short* EIDX, int t  , int seg) {
    const GAS unsigned char* rb = sgpr_ptr((const unsigned char*)(EIDX + (size_t)t * 128)); const unsigned lo = (unsigned)seg * 32u;
#pragma unroll
    for (int q = 0; q < 2; ++q) { const u32x4 ev = __builtin_nontemporal_load((const GAS u32x4*)(rb + (lo + q * 16u))); m.p[4 * q] = ev.x; m.p[4 * q + 1] = ev.y; m.p[4 * q + 2] = ev.z; m.p[4 * q + 3] = ev.w; }
}
#define SCHED_FENCE() __builtin_amdgcn_sched_barrier(0)
__device__ __forceinline__ void rows16_load(u32x4 (&w)[16], const unsigned char* Tbase, unsigned lane_off, const PMeta& m) {
#pragma unroll
    for (int j = 0; j < 16; ++j) { const unsigned pw = m.p[j >> 1]; const unsigned e = (j & 1) ? (pw >> 16) : (pw & 0xffffu); w[j] = *(const u32x4*)(Tbase + (e * 128u + lane_off)); }
}
#define PEER_GEOM() const int s4 = blockIdx.x & 3, th = (blockIdx.x >> 2) & 1, wq = (blockIdx.x >> 3) * NWAVES + wave, NWQ = (gridDim.x >> 3) * NWAVES, t_beg = th * (NTOK / 2) + wq, t_end = (th + 1) * (NTOK / 2)
#define TCL(t) ((t) < t_end ? (t) : t_end - 1)
typedef int v8i_t __attribute__((ext_vector_type(8)));
struct UTok { u32x4 A[8][2]; u32x4 B[2][2]; };
__device__ __forceinline__ void u_issue(UTok& T, const unsigned char* Ts  , const unsigned char* x8row  , unsigned idlo, unsigned idhi, int lane) {
    const int r16 = lane >> 2; const unsigned c16 = (unsigned)(lane & 3) * 16u; const unsigned q16 = (unsigned)(lane >> 4) * 16u;
#pragma unroll
    for (int h = 0; h < 8; ++h) { const unsigned e = (unsigned)__shfl((int)(h < 4 ? idlo : idhi), (h & 3) * 16 + r16);
#pragma unroll
        for (int ks = 0; ks < 2; ++ks) T.A[h][ks] = *(const u32x4*)(Ts + (e * 128u + 64u * ks + c16)); }
#pragma unroll
    for (int ks = 0; ks < 2; ++ks)
#pragma unroll
        for (int hf = 0; hf < 2; ++hf) T.B[ks][hf] = __builtin_nontemporal_load((const GAS u32x4*)(sgpr_ptr(x8row) + (128u * ks + 64u * hf + q16)));
}
__device__ __forceinline__ void u_compute(const UTok& T, int lane, bf16_t* dst  ) {
    f32x4 acc[8];
#pragma unroll
    for (int h = 0; h < 8; ++h) {
        acc[h] = (f32x4){0.f, 0.f, 0.f, 0.f};
#pragma unroll
        for (int ks = 0; ks < 2; ++ks) {
            const int src = (4 * (lane & 15) + (lane >> 4)) * 4;
            const v8i_t av = {__builtin_amdgcn_ds_bpermute(src, (int)T.A[h][ks].x), __builtin_amdgcn_ds_bpermute(src, (int)T.A[h][ks].y), __builtin_amdgcn_ds_bpermute(src, (int)T.A[h][ks].z), __builtin_amdgcn_ds_bpermute(src, (int)T.A[h][ks].w), 0, 0, 0, 0};
            const v8i_t bv = {(int)T.B[ks][0].x, (int)T.B[ks][0].y, (int)T.B[ks][0].z, (int)T.B[ks][0].w, (int)T.B[ks][1].x, (int)T.B[ks][1].y, (int)T.B[ks][1].z, (int)T.B[ks][1].w};
            acc[h] = __builtin_amdgcn_mfma_scale_f32_16x16x128_f8f6f4(av, bv, acc[h], 4  , 0  , 0, 0x7F7F7F7F, 0, 0x7F7F7F7F);
        }
    }
    const int j16 = lane & 15; f32x4 r = acc[0];
#pragma unroll
    for (int h = 1; h < 8; ++h) r = (j16 == h) ? acc[h] : r;
    if (j16 < 8) __builtin_nontemporal_store((u32x2){pk2(r[0], r[1]), pk2(r[2], r[3])}, (GAS u32x2*)(sgpr_ptr((unsigned char*)dst) + (unsigned)(j16 * 16 + (lane >> 4) * 4) * 2u));
}
__device__ __forceinline__ void p8a_u(const Args& a, int lane, int wave) {
    const unsigned short* EIDX = (const unsigned short*)(a.ws + WS_EI); bf16_t* PB = (bf16_t*)(a.ws + WS_PB);
    PEER_GEOM();
    const unsigned char* Ts = a.ws + WS_UT + (size_t)s4 * SLICE4; const unsigned char* x8 = a.ws + WS_X8 + s4 * 256;
    bf16_t* pb = PB + (size_t)s4 * NTOK * 128;
#define IDLOAD(lo, hi, t) do { const GAS unsigned short* ip_ = sgpr_ptr(EIDX + (size_t)(t) * 128); lo = ip_[lane]; hi = ip_[64 + lane]; } while (0)
    UTok TA, TB; unsigned ia0, ia1, ib0, ib1;
    IDLOAD(ia0, ia1, TCL(t_beg)); IDLOAD(ib0, ib1, TCL(t_beg + NWQ));
    u_issue(TA, Ts, x8 + (size_t)TCL(t_beg) * DM, ia0, ia1, lane);
    IDLOAD(ia0, ia1, TCL(t_beg + 2 * NWQ));
    for (int t = t_beg; t < t_end; t += 2 * NWQ) {
        SCHED_FENCE();
        u_issue(TB, Ts, x8 + (size_t)TCL(t + NWQ) * DM, ib0, ib1, lane); IDLOAD(ib0, ib1, TCL(t + 3 * NWQ));
        SCHED_FENCE();
        u_compute(TA, lane, pb + (size_t)t * 128);
        SCHED_FENCE();
        u_issue(TA, Ts, x8 + (size_t)TCL(t + 2 * NWQ) * DM, ia0, ia1, lane); IDLOAD(ia0, ia1, TCL(t + 4 * NWQ));
        SCHED_FENCE();
        if (t + NWQ < t_end) u_compute(TB, lane, pb + (size_t)(t + NWQ) * 128);
    }
#undef IDLOAD
}
__device__ __forceinline__ void p8c_combine(const Args& a, unsigned char* lds, int tid) {
    const u32x2* PB = (const u32x2*)(a.ws + WS_PB); unsigned* AB = (unsigned*)(a.ws + WS_AB); const u32x2* GATE = (const u32x2*)(a.ws + WS_GT); const float* SS = (const float*)(a.ws + WS_SS);
    const unsigned short* EIDX = (const unsigned short*)(a.ws + WS_EI); const float* su = (const float*)(a.ws + WS_USC); const float* sv = (const float*)(a.ws + WS_VSC);
    const size_t n4 = (size_t)NTOK * 128 / 4, nth = (size_t)gridDim.x * NTHR;
    LAS float* su_l = (LAS float*)lds; LAS float* sv_l = su_l + 16384;
    for (int i = tid; i < 16384 / 4; i += NTHR) { *(LAS f32x4*)(su_l + 4 * i) = *(const f32x4*)(su + 4 * i); *(LAS f32x4*)(sv_l + 4 * i) = *(const f32x4*)(sv + 4 * i); }
    __syncthreads();
    float calib;
    { unsigned a1 = 0u; a1 = __builtin_amdgcn_cvt_scalef32_pk_fp4_f32(a1, 1.0f, 1.0f, 1.0f, 0); a1 = __builtin_amdgcn_cvt_scalef32_pk_fp4_f32(a1, 1.0f, 1.0f, 1.0f, 1);
      a1 = __builtin_amdgcn_cvt_scalef32_pk_fp4_f32(a1, 1.0f, 1.0f, 1.0f, 2); a1 = __builtin_amdgcn_cvt_scalef32_pk_fp4_f32(a1, 1.0f, 1.0f, 1.0f, 3);
      unsigned b1 = (unsigned)__builtin_amdgcn_cvt_pk_fp8_f32(1.0f, 1.0f, 0, false); b1 = (unsigned)__builtin_amdgcn_cvt_pk_fp8_f32(1.0f, 1.0f, (int)b1, true);
      const v8i_t av = {(int)a1, (int)a1, (int)a1, (int)a1, 0, 0, 0, 0}, bv = {(int)b1, (int)b1, (int)b1, (int)b1, (int)b1, (int)b1, (int)b1, (int)b1};
      const f32x4 c = __builtin_amdgcn_mfma_scale_f32_16x16x128_f8f6f4(av, bv, (f32x4){0.f, 0.f, 0.f, 0.f}, 4, 0, 0, 0x7F7F7F7F, 0, 0x7F7F7F7F);
      calib = 128.0f / c[0] * (1.0f / X8SCALE); }
    for (size_t i = (size_t)blockIdx.x * NTHR + tid; i < n4; i += nth) {
        f32x4 d = {0.f, 0.f, 0.f, 0.f};
#pragma unroll
        for (int s2 = 0; s2 < 4; ++s2) { const u32x2 p = __builtin_nontemporal_load(PB + (size_t)s2 * n4 + i); d += (f32x4){bflo(p.x), bfhi(p.x), bflo(p.y), bfhi(p.y)}; }
        const u32x2 gw2 = __builtin_nontemporal_load(GATE + i); const f32x4 g = {bflo(gw2.x), bfhi(gw2.x), bflo(gw2.y), bfhi(gw2.y)}; const u32x2 ew = __builtin_nontemporal_load((const u32x2*)EIDX + i);
        const unsigned e[4] = {ew.x & 0xffffu, ew.x >> 16, ew.y & 0xffffu, ew.y >> 16}; float o[4];
        const float cr = calib / sqrtf(SS[i >> 5] * (1.0f / DM) + EPS);
#pragma unroll
        for (int j = 0; j < 4; ++j) { const float z = d[j] * su_l[e[j]] * cr; o[j] = 0.5f * z * (1.0f + erff(z * 0.70710678118654752f)) * g[j] * sv_l[e[j]]; }
        unsigned w8 = (unsigned)__builtin_amdgcn_cvt_pk_fp8_f32(o[0] * A8SCALE, o[1] * A8SCALE, 0, false); w8 = (unsigned)__builtin_amdgcn_cvt_pk_fp8_f32(o[2] * A8SCALE, o[3] * A8SCALE, (int)w8, true); AB[i] = w8;
    }
}
typedef int v2i_t __attribute__((ext_vector_type(2)));
constexpr int VROW = 144, VIMG = 128 * VROW;
struct VRec { u32x4 a8[2]; u32x2 h; };
__device__ __forceinline__ void v_token(const u32x4 (&w)[16], const VRec& rc, LAS unsigned char* vl  , float oscale, int lane, float* dst  , bool do_store) {
    const int seg = lane >> 3, c8 = lane & 7, i16 = lane & 15, q = lane >> 4;
#pragma unroll
    for (int j = 0; j < 16; ++j) *(LAS u32x4*)(vl + (seg * 16 + j) * VROW + c8 * 16) = w[j];
    asm volatile("s_waitcnt lgkmcnt(0)" ::: "memory");
    const v8i_t av = {(int)rc.a8[0].x, (int)rc.a8[0].y, (int)rc.a8[0].z, (int)rc.a8[0].w, (int)rc.a8[1].x, (int)rc.a8[1].y, (int)rc.a8[1].z, (int)rc.a8[1].w};
    const LAS unsigned char* rp = vl + (32 * q + i16) * VROW;
    float val[4] = {0.f, 0.f, 0.f, 0.f};
#pragma unroll
    for (int cb = 0; cb < 16; ++cb) {
        const v2i_t r1 = __builtin_amdgcn_ds_read_tr4_b64_v2i32((LAS v2i_t*)(rp + cb * 8)), r2 = __builtin_amdgcn_ds_read_tr4_b64_v2i32((LAS v2i_t*)(rp + 16 * VROW + cb * 8));
        const v8i_t bv = {r1.x, r1.y, r2.x, r2.y, 0, 0, 0, 0};
        const f32x4 acc = __builtin_amdgcn_mfma_scale_f32_16x16x128_f8f6f4(av, bv, (f32x4){0.f, 0.f, 0.f, 0.f}, 0  , 4  , 0, 0x7F7F7F7F, 0, 0x7F7F7F7F);
        const float a0 = acc[0]; val[cb & 3] = (q == (cb >> 2)) ? a0 : val[cb & 3];
    }
    asm volatile("s_waitcnt lgkmcnt(0)" ::: "memory");
    if (do_store) {
        *(GAS f32x4*)(sgpr_ptr((unsigned char*)dst) + (unsigned)lane * 16u) = (f32x4){bflo(rc.h.x) + val[0] * oscale, bfhi(rc.h.x) + val[1] * oscale, bflo(rc.h.y) + val[2] * oscale, bfhi(rc.h.y) + val[3] * oscale};
    } else asm volatile("" :: "v"(val[0]), "v"(val[1]), "v"(val[2]), "v"(val[3]));
}
__device__ __forceinline__ void p8b_v(const Args& a, unsigned char* lds, int lane, int wave, bool do_store) {
    const unsigned short* EIDX = (const unsigned short*)(a.ws + WS_EI); const unsigned char* AB = a.ws + WS_AB; const bf16_t* HB = (const bf16_t*)(a.ws + WS_HB);
    PEER_GEOM();
    const int seg = lane >> 3, c8 = lane & 7, q = lane >> 4;
    const unsigned char* Ts = a.ws + WS_UT + (size_t)(4 + s4) * SLICE4; const unsigned loff = c8 * 16;
    LAS unsigned char* vl = (LAS unsigned char*)lds + wave * VIMG;
    float oscale;
    { unsigned a1 = 0u; a1 = __builtin_amdgcn_cvt_scalef32_pk_fp4_f32(a1, 1.0f, 1.0f, 1.0f, 0); a1 = __builtin_amdgcn_cvt_scalef32_pk_fp4_f32(a1, 1.0f, 1.0f, 1.0f, 1);
      a1 = __builtin_amdgcn_cvt_scalef32_pk_fp4_f32(a1, 1.0f, 1.0f, 1.0f, 2); a1 = __builtin_amdgcn_cvt_scalef32_pk_fp4_f32(a1, 1.0f, 1.0f, 1.0f, 3);
      unsigned b1 = (unsigned)__builtin_amdgcn_cvt_pk_fp8_f32(1.0f, 1.0f, 0, false); b1 = (unsigned)__builtin_amdgcn_cvt_pk_fp8_f32(1.0f, 1.0f, (int)b1, true);
      const v8i_t av = {(int)b1, (int)b1, (int)b1, (int)b1, (int)b1, (int)b1, (int)b1, (int)b1}, bv = {(int)a1, (int)a1, (int)a1, (int)a1, 0, 0, 0, 0};
      const f32x4 c = __builtin_amdgcn_mfma_scale_f32_16x16x128_f8f6f4(av, bv, (f32x4){0.f, 0.f, 0.f, 0.f}, 0, 4, 0, 0x7F7F7F7F, 0, 0x7F7F7F7F);
      oscale = 128.0f / c[0] * (1.0f / A8SCALE); }
    const unsigned aoff = (unsigned)q * 16u, hoff = (unsigned)(s4 * 256 + 4 * lane) * 2u;
#define REC_LOAD(R, t) do { const GAS unsigned char* ab_ = sgpr_ptr(AB + (size_t)(t) * 128); R.a8[0] = __builtin_nontemporal_load((const GAS u32x4*)(ab_ + aoff)); R.a8[1] = __builtin_nontemporal_load((const GAS u32x4*)(ab_ + (64u + aoff))); \
        R.h = __builtin_nontemporal_load((const GAS u32x2*)(sgpr_ptr((const unsigned char*)(HB + (size_t)(t) * DM)) + hoff)); } while (0)
    PMeta mA, mB; u32x4 wA[16], wB[16]; VRec rA, rB;
    pm_load(mA, EIDX, TCL(t_beg), seg); pm_load(mB, EIDX, TCL(t_beg + NWQ), seg);
    rows16_load(wA, Ts, loff, mA); REC_LOAD(rA, TCL(t_beg));
    pm_load(mA, EIDX, TCL(t_beg + 2 * NWQ), seg);
    for (int t = t_beg; t < t_end; t += 2 * NWQ) {
        SCHED_FENCE();
        rows16_load(wB, Ts, loff, mB); REC_LOAD(rB, TCL(t + NWQ)); pm_load(mB, EIDX, TCL(t + 3 * NWQ), seg);
        SCHED_FENCE();
        v_token(wA, rA, vl, oscale, lane, a.out + (size_t)t * DM + s4 * 256, do_store);
        SCHED_FENCE();
        rows16_load(wA, Ts, loff, mA); REC_LOAD(rA, TCL(t + 2 * NWQ)); pm_load(mA, EIDX, TCL(t + 4 * NWQ), seg);
        SCHED_FENCE();
        if (t + NWQ < t_end) v_token(wB, rB, vl, oscale, lane, a.out + (size_t)(t + NWQ) * DM + s4 * 256, do_store);
    }
#undef REC_LOAD
#undef TCL
#undef PEER_GEOM
}

namespace pg8 {
#define PG8_LAS __attribute__((address_space(3)))
typedef unsigned short bf16_t;
typedef short bf16x8 __attribute__((ext_vector_type(8)));
typedef float f32x4 __attribute__((ext_vector_type(4)));
typedef unsigned u32x4 __attribute__((ext_vector_type(4)));
typedef int v4i_t __attribute__((ext_vector_type(4))); typedef int v8i_t __attribute__((ext_vector_type(8)));
constexpr int BM = 256, BK = 64, HALF = 128, HTB = HALF * BK * 2  , STAGE_BYTES = 8 * HTB, NXCD = 8, WGM = 8;

__host__ __device__ __forceinline__ int lds_byte(int r, int c) { const int st = (r >> 4) * 2 + (c >> 5), rr = r & 15, cc = c & 31, ob = rr * 64 + cc * 2; return st * 1024 + (ob ^ (((ob >> 9) & 1) << 5)); }
__host__ __device__ __forceinline__ void stage_rc(int b, int& R, int& C) { const int st = b / 1024, sb = b % 1024, swz = sb ^ (((sb >> 9) & 1) << 5); R = (st >> 1) * 16 + swz / 64; C = (st & 1) * 32 + (swz % 64) / 2; }
__host__ __device__ __forceinline__ int perm32(int rho) { const int n = rho >> 4, i = rho & 15; return 8 * (i >> 2) + 4 * n + (i & 3); }

struct Unit { int pm, pn; };
struct Gemm { const bf16_t* A; const bf16_t* Bt; int M, N, K; };

struct StaticOrder {
    int nM, nN, nwg, G, c;
    __host__ __device__ void init(int M, int N, int G_, int c_) { nM = M / BM; nN = N / BM; nwg = nM * nN; G = G_; c = c_; }
    __host__ __device__ bool next(int i, Unit& u) const {
        const long L = (long)i * G + c; if (L >= nwg) return false;
        int wgid = (int)L; { const int q = nwg / NXCD, r = nwg % NXCD, xcd = wgid % NXCD, off = wgid / NXCD; wgid = (xcd < r ? xcd * (q + 1) : r * (q + 1) + (xcd - r) * q) + off; }
        const int nig = WGM * nN, gid = wgid / nig, fm = gid * WGM, gsz = (nM - fm) < WGM ? (nM - fm) : WGM;
        u.pm = fm + ((wgid % nig) % gsz); u.pn = (wgid % nig) / gsz; return true;
    }
    __device__ __forceinline__ void a_ready(const Unit&) const {}
    __device__ __forceinline__ void done(const Unit&) const {}
};


__device__ __forceinline__ unsigned cvt_pk_bf16(float lo, float hi) { unsigned r; asm volatile("v_cvt_pk_bf16_f32 %0, %1, %2" : "=v"(r) : "v"(lo), "v"(hi)); return r; }
struct EpiInProj {
    static constexpr bool PERM = true, AFTER_DRAIN = false;
    bf16_t* O; bf16_t* QB; bf16_t* KB; bf16_t* VB; const float* rope; const float* qg; const float* kg;
    template <bool NORM> __device__ __forceinline__ void head_row(f32x4 a00, f32x4 a01, f32x4 a10, f32x4 a11, const float* g0, const float* g1, int t, int fq, bf16_t* dst  ) const {
        float x0[8] = {a00[0], a00[1], a00[2], a00[3], a01[0], a01[1], a01[2], a01[3]}, x1[8] = {a10[0], a10[1], a10[2], a10[3], a11[0], a11[1], a11[2], a11[3]};
        if (NORM) {
            float ss = 0.f;
#pragma unroll
            for (int e = 0; e < 8; ++e) ss += x0[e] * x0[e] + x1[e] * x1[e];
            ss += __shfl_xor(ss, 16); ss += __shfl_xor(ss, 32);
            const float rstd = 1.0f / sqrtf(ss * (1.0f / 64.0f) + 1e-6f);
            const float* r0 = rope + (((t >> 6) * 16 + (fq & 1) * 8) * 2); const float* r1 = rope + (((t & 63) * 16 + (fq & 1) * 8) * 2);
            f32x4 c0[4], c1[4];
#pragma unroll
            for (int q4 = 0; q4 < 4; ++q4) { c0[q4] = *(const f32x4*)(r0 + 4 * q4); c1[q4] = *(const f32x4*)(r1 + 4 * q4); }
#pragma unroll
            for (int e = 0; e < 8; ++e) { x0[e] *= rstd * g0[e]; x1[e] *= rstd * g1[e]; }
#pragma unroll
            for (int e = 0; e < 8; ++e) { const float o0 = __shfl_xor(x0[e], 32), o1 = __shfl_xor(x1[e], 32);
                const float cs0 = c0[e >> 1][(e & 1) * 2], sn0 = c0[e >> 1][(e & 1) * 2 + 1], cs1 = c1[e >> 1][(e & 1) * 2], sn1 = c1[e >> 1][(e & 1) * 2 + 1];
                x0[e] = (fq & 2) ? x0[e] * cs0 + o0 * sn0 : x0[e] * cs0 - o0 * sn0; x1[e] = (fq & 2) ? x1[e] * cs1 + o1 * sn1 : x1[e] * cs1 - o1 * sn1; }
        }
        u32x4 w; w.x = cvt_pk_bf16(x0[0], x0[1]); w.y = cvt_pk_bf16(x0[2], x0[3]); w.z = cvt_pk_bf16(x0[4], x0[5]); w.w = cvt_pk_bf16(x0[6], x0[7]); *(u32x4*)dst = w;
        w.x = cvt_pk_bf16(x1[0], x1[1]); w.y = cvt_pk_bf16(x1[2], x1[3]); w.z = cvt_pk_bf16(x1[4], x1[5]); w.w = cvt_pk_bf16(x1[6], x1[7]); *(u32x4*)(dst + 32) = w;
    }
    __device__ __forceinline__ void operator()(const f32x4 (&acc)[2][2][4][2], const Unit& u, int wr, int wc, int fr, int fq) const {
        const int row0 = u.pm * BM + wr * 64 + fr, pn = u.pn;
        if (pn < 2) {
            const int col0 = 256 * pn + wc * 32 + 8 * fq;
#pragma unroll
            for (int ai = 0; ai < 2; ++ai)
#pragma unroll
                for (int m = 0; m < 4; ++m) { bf16_t* rowp = O + (size_t)(row0 + ai * HALF + m * 16) * 1024 + col0;
#pragma unroll
                    for (int bj = 0; bj < 2; ++bj) { const f32x4 v0 = acc[ai][bj][m][0], v1 = acc[ai][bj][m][1];
                        u32x4 w; w.x = cvt_pk_bf16(v0[0], v0[1]); w.y = cvt_pk_bf16(v0[2], v0[3]); w.z = cvt_pk_bf16(v1[0], v1[1]); w.w = cvt_pk_bf16(v1[2], v1[3]);
                        *(u32x4*)(rowp + bj * HALF) = w; } }
        } else if (pn < 6) {
            const int col0 = 512 + 128 * (pn - 2) + wc * 32 + 8 * fq;
#pragma unroll
            for (int ai = 0; ai < 2; ++ai)
#pragma unroll
                for (int m = 0; m < 4; ++m) { const f32x4 v0 = acc[ai][0][m][0] * acc[ai][1][m][0], v1 = acc[ai][0][m][1] * acc[ai][1][m][1];
                    u32x4 w; w.x = cvt_pk_bf16(v0[0], v0[1]); w.y = cvt_pk_bf16(v0[2], v0[3]); w.z = cvt_pk_bf16(v1[0], v1[1]); w.w = cvt_pk_bf16(v1[2], v1[3]);
                    *(u32x4*)(O + (size_t)(row0 + ai * HALF + m * 16) * 1024 + col0) = w; }
        } else if (pn < 8) {
            float g0[8], g1[8];
#pragma unroll
            for (int e = 0; e < 8; ++e) { g0[e] = qg[8 * fq + e] * C2; g1[e] = qg[32 + 8 * fq + e] * C2; }
            const int hh = 4 * (pn - 6) + wc;
#pragma unroll
            for (int ai = 0; ai < 2; ++ai)
#pragma unroll
                for (int m = 0; m < 4; ++m) { const int r = row0 + ai * HALF + m * 16;
                    head_row<true>(acc[ai][0][m][0], acc[ai][0][m][1], acc[ai][1][m][0], acc[ai][1][m][1], g0, g1, r & 2047, fq, QB + (size_t)r * 512 + hh * 64 + 8 * fq); }
        } else {
            float g0[8], g1[8];
#pragma unroll
            for (int e = 0; e < 8; ++e) { g0[e] = kg[8 * fq + e]; g1[e] = kg[32 + 8 * fq + e]; }
            const int g = wc & 1;
#pragma unroll
            for (int ai = 0; ai < 2; ++ai)
#pragma unroll
                for (int m = 0; m < 4; ++m) { const int r = row0 + ai * HALF + m * 16, b = r >> 11, t = r & 2047; const size_t krow = ((size_t)(b * 2 + g) * KROWS + t) * 64 + 8 * fq;
                    if (wc < 2) head_row<true>(acc[ai][0][m][0], acc[ai][0][m][1], acc[ai][1][m][0], acc[ai][1][m][1], g0, g1, t, fq, KB + krow);
                    else head_row<false>(acc[ai][0][m][0], acc[ai][0][m][1], acc[ai][1][m][0], acc[ai][1][m][1], g0, g1, t, fq, VB + krow); }
        }
    }
};
struct EpiBf16 {
    static constexpr bool PERM = true, AFTER_DRAIN = false;
    bf16_t* O; int ldc; float scale;
    __device__ __forceinline__ void operator()(const f32x4 (&acc)[2][2][4][2], const Unit& u, int wr, int wc, int fr, int fq) const {
        const int row0 = u.pm * BM + wr * 64 + fr; const int col0 = u.pn * BM + wc * 32 + 8 * fq;
#pragma unroll
        for (int ai = 0; ai < 2; ++ai)
#pragma unroll
            for (int m = 0; m < 4; ++m) { bf16_t* rowp = O + (size_t)(row0 + ai * HALF + m * 16) * ldc + col0;
#pragma unroll
                for (int bj = 0; bj < 2; ++bj) { const f32x4 v0 = acc[ai][bj][m][0] * scale, v1 = acc[ai][bj][m][1] * scale;
                    u32x4 w; w.x = cvt_pk_bf16(v0[0], v0[1]); w.y = cvt_pk_bf16(v0[2], v0[3]); w.z = cvt_pk_bf16(v1[0], v1[1]); w.w = cvt_pk_bf16(v1[2], v1[3]);
                    *(u32x4*)(rowp + bj * HALF) = w; } }
    }
};
struct EpiResidNorm {
    static constexpr bool PERM = true, AFTER_DRAIN = false;
    const float* xp; const float* xs; float* out; int split_row; bf16_t* hb; unsigned char* h8; float* ss; float x8scale;
    __device__ __forceinline__ const float* xrow(int r, int col0) const { return (r < split_row ? xp + (size_t)r * 1024 : xs + (size_t)(r - split_row) * 1024) + col0; }
    __device__ __forceinline__ void operator()(const f32x4 (&acc)[2][2][4][2], const Unit& u, int wr, int wc, int fr, int fq) const {
        const int col0 = u.pn * BM + wc * 32 + 8 * fq, rbase = u.pm * BM + wr * 64 + fr;
        f32x4 xv[4][2][2];
#pragma unroll
        for (int m = 0; m < 4; ++m) { const float* xr = xrow(rbase + m * 16, col0);
#pragma unroll
            for (int bj = 0; bj < 2; ++bj) { xv[m][bj][0] = *(const f32x4*)(xr + bj * HALF); xv[m][bj][1] = *(const f32x4*)(xr + bj * HALF + 4); } }
#pragma unroll
        for (int ai = 0; ai < 2; ++ai)
#pragma unroll
            for (int m = 0; m < 4; ++m) { const int r = rbase + ai * HALF + m * 16;
                bf16_t* brow = hb + (size_t)r * 1024 + col0; unsigned char* qrow = h8 + (size_t)r * 1024 + col0; float s = 0.f;
                f32x4 h[2][2];
#pragma unroll
                for (int bj = 0; bj < 2; ++bj) { h[bj][0] = xv[m][bj][0] + acc[ai][bj][m][0]; h[bj][1] = xv[m][bj][1] + acc[ai][bj][m][1]; }
                if (ai == 0) { const float* xr = xrow(r + HALF, col0);
#pragma unroll
                    for (int bj = 0; bj < 2; ++bj) { xv[m][bj][0] = *(const f32x4*)(xr + bj * HALF); xv[m][bj][1] = *(const f32x4*)(xr + bj * HALF + 4); } }
#pragma unroll
                for (int bj = 0; bj < 2; ++bj) { const f32x4 h0 = h[bj][0], h1 = h[bj][1];
                    u32x4 wb; wb.x = cvt_pk_bf16(h0[0], h0[1]); wb.y = cvt_pk_bf16(h0[2], h0[3]); wb.z = cvt_pk_bf16(h1[0], h1[1]); wb.w = cvt_pk_bf16(h1[2], h1[3]); *(u32x4*)(brow + bj * HALF) = wb;
                    unsigned w0 = (unsigned)__builtin_amdgcn_cvt_pk_fp8_f32(h0[0] * x8scale, h0[1] * x8scale, 0, false); w0 = (unsigned)__builtin_amdgcn_cvt_pk_fp8_f32(h0[2] * x8scale, h0[3] * x8scale, (int)w0, true);
                    unsigned w1 = (unsigned)__builtin_amdgcn_cvt_pk_fp8_f32(h1[0] * x8scale, h1[1] * x8scale, 0, false); w1 = (unsigned)__builtin_amdgcn_cvt_pk_fp8_f32(h1[2] * x8scale, h1[3] * x8scale, (int)w1, true);
                    *(u32x2*)(qrow + bj * HALF) = (u32x2){w0, w1};
                    s += ((h0[0] * h0[0] + h0[1] * h0[1]) + (h0[2] * h0[2] + h0[3] * h0[3])) + ((h1[0] * h1[0] + h1[1] * h1[1]) + (h1[2] * h1[2] + h1[3] * h1[3])); }
                s += __shfl_xor(s, 16); s += __shfl_xor(s, 32);
                if (fq == 0) atomicAdd(ss + r, s); }
    }
};
struct EpiResid {
    static constexpr bool PERM = false, AFTER_DRAIN = false;
    const float* xp; const float* xs; float* out; int split_row;
    __device__ __forceinline__ void operator()(const f32x4 (&acc)[2][2][4][2], const Unit& u, int wr, int wc, int fr, int fq) const {
        const int col0 = u.pn * BM + wc * 32 + 4 * fq;
#pragma unroll
        for (int ai = 0; ai < 2; ++ai)
#pragma unroll
            for (int m = 0; m < 4; ++m) { const int r = u.pm * BM + ai * HALF + wr * 64 + m * 16 + fr;
                const float* xr = (r < split_row ? xp + (size_t)r * 1024 : xs + (size_t)(r - split_row) * 1024) + col0; float* orow = out + (size_t)r * 1024 + col0;
#pragma unroll
                for (int bj = 0; bj < 2; ++bj)
#pragma unroll
                    for (int n = 0; n < 2; ++n) { const f32x4 bs = *(const f32x4*)(xr + bj * HALF + n * 16); *(f32x4*)(orow + bj * HALF + n * 16) = bs + acc[ai][bj][m][n]; } }
    }
};

template <class Epi, class Sched, bool ALIGN_EPI = false, bool SP2 = false, bool FP8 = false>
__device__ __forceinline__ void gemm_phase(PG8_LAS unsigned char* lds, const Gemm g, const Sched& S, const Epi& E) {
    const int tid = threadIdx.x, wid = __builtin_amdgcn_readfirstlane(tid >> 6), lane = tid & 63, wr = wid >> 2, wc = wid & 3, fr = lane & 15, fq = lane >> 4;
    const int K = g.K, nt = K / BK;
    unsigned voffA[2], voffB[2];
#pragma unroll
    for (int i = 0; i < 2; ++i) { int R, C; stage_rc(tid * 16 + i * 8192, R, C); const int Rb = Epi::PERM ? ((R & ~31) + perm32(R & 31)) : R;
        voffA[i] = (unsigned)(R * K + C) * 2u; voffB[i] = (unsigned)(Rb * K + C) * 2u; }
    const size_t kstep = (size_t)(BK * 2);
    const size_t hstep = (size_t)HALF * K * 2;
    const size_t tstep = 2 * hstep;
    const unsigned ldsw = (unsigned)wid * 1024u;
    const int aoff = lds_byte(wr * 64 + fr, fq * 8), boff = lds_byte(wc * 32 + fr, fq * 8);
#define PG8_SA(b, h) (((b) * 2 + (h)) * HTB)
#define PG8_SB(b, h) ((4 + (b) * 2 + (h)) * HTB)
#define PG8_STAGE(bufoff, gbase, voff) do { _Pragma("unroll") for (int _i = 0; _i < 2; ++_i) \
        __builtin_amdgcn_global_load_lds((const unsigned*)((const char*)(gbase) + (voff)[_i]), (PG8_LAS unsigned*)(lds + (bufoff) + ldsw + _i * 8192), 16, 0, 0); } while (0)
#define PG8_LDA(dst, b, h) do { if constexpr (FP8) { _Pragma("unroll") for (int m = 0; m < 4; ++m) dst##8[m] = __builtin_shufflevector(*(const PG8_LAS v4i_t*)(lds + PG8_SA(b, h) + aoff + m * 2048), *(const PG8_LAS v4i_t*)(lds + PG8_SA(b, h) + aoff + m * 2048 + 1024), 0, 1, 2, 3, 4, 5, 6, 7); } \
        else { _Pragma("unroll") for (int m = 0; m < 4; ++m) _Pragma("unroll") for (int k = 0; k < 2; ++k) dst[m][k] = *(const PG8_LAS bf16x8*)(lds + PG8_SA(b, h) + aoff + m * 2048 + k * 1024); } } while (0)
#define PG8_LDB(dst, b, h) do { if constexpr (FP8) { _Pragma("unroll") for (int n = 0; n < 2; ++n) dst##8[n] = __builtin_shufflevector(*(const PG8_LAS v4i_t*)(lds + PG8_SB(b, h) + boff + n * 2048), *(const PG8_LAS v4i_t*)(lds + PG8_SB(b, h) + boff + n * 2048 + 1024), 0, 1, 2, 3, 4, 5, 6, 7); } \
        else { _Pragma("unroll") for (int n = 0; n < 2; ++n) _Pragma("unroll") for (int k = 0; k < 2; ++k) dst[n][k] = *(const PG8_LAS bf16x8*)(lds + PG8_SB(b, h) + boff + n * 2048 + k * 1024); } } while (0)
#define PG8_MMA(ai, bj, At, Bt) do { __builtin_amdgcn_s_setprio(1); _Pragma("unroll") for (int m = 0; m < 4; ++m) _Pragma("unroll") for (int n = 0; n < 2; ++n) { \
        if constexpr (FP8) { asm volatile("v_mfma_scale_f32_16x16x128_f8f6f4 %0, %1, %2, %0, %3, %3 op_sel_hi:[0,0,0]" : "+v"(acc[ai][bj][m][n]) : "v"(Bt##8[n]), "v"(At##8[m]), "v"(mfma_one)); } \
        else { _Pragma("unroll") for (int k = 0; k < 2; ++k) acc[ai][bj][m][n] = __builtin_amdgcn_mfma_f32_16x16x32_bf16(Bt[n][k], At[m][k], acc[ai][bj][m][n], 0, 0, 0); } } __builtin_amdgcn_s_setprio(0); } while (0)
#define PG8_WAIT_V(n) asm volatile("s_waitcnt vmcnt(" #n ")" ::: "memory")
#define PG8_WAIT_L(n) asm volatile("s_waitcnt lgkmcnt(" #n ")" ::: "memory")
#define PG8_BAR __builtin_amdgcn_s_barrier()
#define PG8_SCHED __builtin_amdgcn_sched_barrier(0)
    Unit cur, nxt; int ui = 0;
    if (!S.next(0, cur)) return;
    f32x4 acc[2][2][4][2];
#pragma unroll
    for (int a = 0; a < 2; ++a)
#pragma unroll
        for (int b = 0; b < 2; ++b)
#pragma unroll
            for (int m = 0; m < 4; ++m)
#pragma unroll
                for (int n = 0; n < 2; ++n) acc[a][b][m][n] = (f32x4){0.f, 0.f, 0.f, 0.f};
    const int mfma_one = 0x7F7F7F7F;
    bf16x8 At[4][2], B0[2][2], B1[2][2]; v8i_t At8[4], B08[2], B18[2];
    const char* cA = (const char*)g.A + (size_t)cur.pm * tstep; const char* cB = (const char*)g.Bt + (size_t)cur.pn * tstep;
    S.a_ready(cur);
    if constexpr (SP2) {
        PG8_STAGE(PG8_SB(0, 0), cB, voffB); PG8_STAGE(PG8_SB(0, 1), cB + hstep, voffB); PG8_STAGE(PG8_SA(0, 0), cA, voffA); PG8_STAGE(PG8_SA(0, 1), cA + hstep, voffA);
        if (wr == 1) PG8_BAR;
        PG8_WAIT_V(2); PG8_BAR;
        PG8_STAGE(PG8_SB(1, 0), cB + kstep, voffB); PG8_STAGE(PG8_SA(1, 0), cA + kstep, voffA); PG8_STAGE(PG8_SB(1, 1), cB + hstep + kstep, voffB);
        PG8_WAIT_V(6); PG8_BAR;
    } else {
        PG8_STAGE(PG8_SB(0, 0), cB, voffB); PG8_STAGE(PG8_SA(0, 0), cA, voffA); PG8_STAGE(PG8_SB(0, 1), cB + hstep, voffB); PG8_STAGE(PG8_SA(0, 1), cA + hstep, voffA);
        if (wr == 1) PG8_BAR;
        PG8_WAIT_V(4); PG8_BAR;
        PG8_STAGE(PG8_SB(1, 0), cB + kstep, voffB); PG8_STAGE(PG8_SA(1, 0), cA + kstep, voffA); PG8_STAGE(PG8_SB(1, 1), cB + hstep + kstep, voffB);
        PG8_WAIT_V(6); PG8_BAR;
    }
    for (;;) {
        const bool has_next = S.next(ui + 1, nxt);
        const char* nA = has_next ? (const char*)g.A + (size_t)nxt.pm * tstep : cA; const char* nB = has_next ? (const char*)g.Bt + (size_t)nxt.pn * tstep : cB;
#pragma nounroll
        for (int t = 0; t < nt; t += 2) {
            const bool last = (t == nt - 2);
            const char* a1 = cA + (size_t)(t + 1) * kstep;
            const char* a2 = last ? nA : cA + (size_t)(t + 2) * kstep; const char* b2 = last ? nB : cB + (size_t)(t + 2) * kstep;
            const char* a3 = a2 + kstep; const char* b3 = b2 + kstep;
            if (last && has_next) S.a_ready(nxt);
            if constexpr (SP2) {
            PG8_LDB(B0, 0, 0); PG8_LDB(B1, 0, 1); PG8_SCHED; PG8_LDA(At, 0, 0); PG8_STAGE(PG8_SA(1, 1), a1 + hstep, voffA);
            PG8_WAIT_V(8); PG8_WAIT_L(0); PG8_BAR; PG8_MMA(0, 0, At, B0); PG8_MMA(0, 1, At, B1); PG8_BAR; PG8_SCHED;
            PG8_LDA(At, 0, 1); PG8_STAGE(PG8_SB(0, 0), b2, voffB); PG8_STAGE(PG8_SB(0, 1), b2 + hstep, voffB); PG8_STAGE(PG8_SA(0, 0), a2, voffA);
            PG8_WAIT_V(8); PG8_WAIT_L(0); PG8_BAR; PG8_MMA(1, 0, At, B0); PG8_MMA(1, 1, At, B1); PG8_BAR; PG8_SCHED;
            PG8_LDB(B0, 1, 0); PG8_LDB(B1, 1, 1); PG8_SCHED; PG8_LDA(At, 1, 0); PG8_STAGE(PG8_SA(0, 1), a2 + hstep, voffA);
            PG8_WAIT_V(8); PG8_WAIT_L(0); PG8_BAR; PG8_MMA(0, 0, At, B0); PG8_MMA(0, 1, At, B1); PG8_BAR; PG8_SCHED;
            PG8_LDA(At, 1, 1); PG8_STAGE(PG8_SB(1, 0), b3, voffB); PG8_STAGE(PG8_SB(1, 1), b3 + hstep, voffB); PG8_STAGE(PG8_SA(1, 0), a3, voffA);
            PG8_WAIT_V(8); PG8_WAIT_L(0); PG8_BAR; PG8_MMA(1, 0, At, B0); PG8_MMA(1, 1, At, B1); PG8_BAR; PG8_SCHED;
            } else {
            PG8_LDB(B0, 0, 0); PG8_SCHED; PG8_LDA(At, 0, 0); PG8_STAGE(PG8_SA(1, 1), a1 + hstep, voffA);
            PG8_WAIT_L(8); PG8_BAR; PG8_WAIT_L(0); PG8_MMA(0, 0, At, B0); PG8_BAR; PG8_SCHED;
            PG8_LDB(B1, 0, 1); PG8_STAGE(PG8_SB(0, 0), b2, voffB);
            PG8_BAR; PG8_WAIT_L(0); PG8_MMA(0, 1, At, B1); PG8_BAR;
            PG8_LDA(At, 0, 1); PG8_STAGE(PG8_SA(0, 0), a2, voffA);
            PG8_BAR; PG8_WAIT_L(0); PG8_MMA(1, 0, At, B0); PG8_BAR; PG8_SCHED;
            PG8_STAGE(PG8_SB(0, 1), b2 + hstep, voffB);
            PG8_WAIT_V(6); PG8_BAR; PG8_MMA(1, 1, At, B1); PG8_BAR;
            PG8_LDB(B0, 1, 0); PG8_SCHED; PG8_LDA(At, 1, 0); PG8_STAGE(PG8_SA(0, 1), a2 + hstep, voffA);
            PG8_WAIT_L(8); PG8_BAR; PG8_WAIT_L(0); PG8_MMA(0, 0, At, B0); PG8_BAR; PG8_SCHED;
            PG8_LDB(B1, 1, 1); PG8_STAGE(PG8_SB(1, 0), b3, voffB);
            PG8_BAR; PG8_WAIT_L(0); PG8_MMA(0, 1, At, B1); PG8_BAR;
            PG8_LDA(At, 1, 1); PG8_STAGE(PG8_SA(1, 0), a3, voffA);
            PG8_BAR; PG8_WAIT_L(0); PG8_MMA(1, 0, At, B0); PG8_BAR; PG8_SCHED;
            PG8_STAGE(PG8_SB(1, 1), b3 + hstep, voffB);
            PG8_WAIT_V(6); PG8_BAR; PG8_MMA(1, 1, At, B1); PG8_BAR;
            }
        }
        if constexpr (ALIGN_EPI) { if (wr == 0) PG8_BAR; }
        if constexpr (FP8) asm volatile("s_nop 15\n\ts_nop 15" ::: "memory");
        if constexpr (!Epi::AFTER_DRAIN) { E(acc, cur, wr, wc, fr, fq); S.done(cur); }
        if (!has_next) break;
#pragma unroll
        for (int a = 0; a < 2; ++a)
#pragma unroll
            for (int b = 0; b < 2; ++b)
#pragma unroll
                for (int m = 0; m < 4; ++m)
#pragma unroll
                    for (int n = 0; n < 2; ++n) acc[a][b][m][n] = (f32x4){0.f, 0.f, 0.f, 0.f};
        if constexpr (FP8) asm volatile("s_nop 7" ::: "memory");
        cur = nxt; cA = nA; cB = nB; ++ui;
        if constexpr (ALIGN_EPI) { if (wr == 1) PG8_BAR; }
    }
    PG8_WAIT_V(0);
    if constexpr (!ALIGN_EPI) { if (wr == 0) PG8_BAR; }
    PG8_BAR;
    if constexpr (Epi::AFTER_DRAIN) { E.fused(acc, cur, wr, wc, fr, fq, lds, wid, lane); S.done(cur); }
#undef PG8_SA
#undef PG8_SB
#undef PG8_STAGE
#undef PG8_LDA
#undef PG8_LDB
#undef PG8_MMA
#undef PG8_WAIT_V
#undef PG8_WAIT_L
#undef PG8_BAR
#undef PG8_SCHED
}
}


#include <hip/hip_bf16.h>
#include <cmath>
namespace attn_body {
using bf16=__hip_bfloat16;
using bf16x8=__attribute__((ext_vector_type(8)))short;
using s16x4=__attribute__((ext_vector_type(4)))short;
using f32x16=__attribute__((ext_vector_type(16)))float;
using u32x4=__attribute__((ext_vector_type(4)))unsigned;
constexpr int SEQ=2048,D=64,QP=512,KVP=64,OP=1024,KVROWS=2112;
constexpr int NW=8,QBLK=32,QB=QBLK*NW,KVBLK=64,NQB=SEQ/QB,NT=KVROWS/KVBLK;
constexpr int ATTN_UNIT_ROWS=QB;
__device__ __forceinline__ int crow(int r,int hi){return (r&3)+8*(r>>2)+4*hi;}
#define SBAR() __builtin_amdgcn_sched_barrier(0)
__device__ __forceinline__ void tmask(f32x16&p0,f32x16&p1){
  const float NEG=-INFINITY;
  #pragma unroll
  for(int r=8;r<16;++r)p0[r]=NEG;
  #pragma unroll
  for(int r=0;r<16;++r)p1[r]=NEG;
}

constexpr int NSLOT=3, SLOTB=8192;
constexpr int LDS_K=0, LDS_V=NSLOT*SLOTB, LDS_WS=2*NSLOT*SLOTB, LDS_OST=LDS_WS+NW*64*4, LDS_BYTES=LDS_OST+NW*4096;
constexpr float C2=0.125f*1.4426950408889634f;
__device__ __forceinline__ void glds16(const void*gsrc,unsigned lds_dst){unsigned keep;
  asm volatile("s_mov_b32 %0, m0\n\ts_mov_b32 m0, %2\n\ts_nop 0\n\tglobal_load_lds_dwordx4 %1, off\n\ts_mov_b32 m0, %0":"=&s"(keep):"v"(gsrc),"s"(lds_dst):"memory");}
__device__ __forceinline__ float max3f(float a,float b,float c){float r;asm("v_max3_f32 %0, %1, %2, %3":"=v"(r):"v"(a),"v"(b),"v"(c));return r;}
__device__ __forceinline__ float max2f(float a,float b){float r;asm("v_max_f32_e32 %0, %1, %2":"=v"(r):"v"(a),"v"(b));return r;}
__device__ __forceinline__ float fadd_s(float a,float b){float r;asm("v_add_f32_e32 %0, %1, %2":"=v"(r):"v"(a),"v"(b));return r;}
__device__ __forceinline__ float fsub_s(float a,float b){float r;asm("v_sub_f32_e32 %0, %1, %2":"=v"(r):"v"(a),"v"(b));return r;}
typedef float f32x2_t __attribute__((ext_vector_type(2))); typedef float f32x4_t __attribute__((ext_vector_type(4))); typedef __bf16 bf16x2_t __attribute__((ext_vector_type(2)));
__device__ __forceinline__ unsigned cvtpk_s(float lo,float hi){f32x2_t v={lo,hi};bf16x2_t b=__builtin_convertvector(v,bf16x2_t);return __builtin_bit_cast(unsigned,b);}
#define WAIT_BAR(N) asm volatile("s_waitcnt vmcnt(" #N ") lgkmcnt(0)\n\ts_barrier":::"memory")

__device__ __forceinline__ void qkt(f32x16&p0,f32x16&p1,const char*Kslot,const bf16x8*qr,const f32x16&negm,int r32,int hi){
  const char*kb=Kslot+hi*1024+r32*16;
  #pragma unroll
  for(int d0=0;d0<4;++d0){
    const bf16x8 b0=*reinterpret_cast<const bf16x8*>(kb+d0*2048);
    const bf16x8 b1=*reinterpret_cast<const bf16x8*>(kb+d0*2048+512);
    if(d0==0){p0=__builtin_amdgcn_mfma_f32_32x32x16_bf16(b0,qr[0],negm,0,0,0);p1=__builtin_amdgcn_mfma_f32_32x32x16_bf16(b1,qr[0],negm,0,0,0);}
    else{p0=__builtin_amdgcn_mfma_f32_32x32x16_bf16(b0,qr[d0],p0,0,0,0);p1=__builtin_amdgcn_mfma_f32_32x32x16_bf16(b1,qr[d0],p1,0,0,0);}}
}
typedef __attribute__((address_space(3))) const char* lds_cptr;
typedef short v4i16_t __attribute__((ext_vector_type(4)));
__device__ __forceinline__ void kload8(bf16x8*kf,lds_cptr kp){
  kf[0]=*(const __attribute__((address_space(3))) bf16x8*)(kp);      kf[1]=*(const __attribute__((address_space(3))) bf16x8*)(kp+512);
  kf[2]=*(const __attribute__((address_space(3))) bf16x8*)(kp+2048); kf[3]=*(const __attribute__((address_space(3))) bf16x8*)(kp+2560);
  kf[4]=*(const __attribute__((address_space(3))) bf16x8*)(kp+4096); kf[5]=*(const __attribute__((address_space(3))) bf16x8*)(kp+4608);
  kf[6]=*(const __attribute__((address_space(3))) bf16x8*)(kp+6144); kf[7]=*(const __attribute__((address_space(3))) bf16x8*)(kp+6656);
}
__device__ __forceinline__ void kload2(bf16x8*kf,lds_cptr kp,int j){ kf[2*j]=*(const __attribute__((address_space(3))) bf16x8*)(kp+j*2048); kf[2*j+1]=*(const __attribute__((address_space(3))) bf16x8*)(kp+j*2048+512); }
__device__ __forceinline__ s16x4 vtr(lds_cptr p){ return __builtin_bit_cast(s16x4,__builtin_amdgcn_ds_read_tr16_b64_v4i16((__attribute__((address_space(3))) v4i16_t*)p)); }
__device__ __forceinline__ float rowmax(const f32x16&p0,const f32x16&p1){
  float a=max3f(p0[0],p0[1],p1[0]),b=max3f(p0[2],p0[3],p1[1]);a=max3f(a,p1[2],p1[3]);
  #pragma unroll
  for(int r=4;r<16;r+=4){a=max3f(a,p0[r],p0[r+1]);b=max3f(b,p0[r+2],p0[r+3]);a=max3f(a,p1[r],p1[r+1]);b=max3f(b,p1[r+2],p1[r+3]);}
  const float m=max2f(a,b);
  auto rr=__builtin_amdgcn_permlane32_swap(__float_as_uint(m),__float_as_uint(m),false,false);
  return max2f(__uint_as_float(rr[0]),__uint_as_float(rr[1]));
}
__device__ __forceinline__ void pv(f32x16*o,int vb,bf16x8 pa0,bf16x8 pa1,bf16x8 pa2,bf16x8 pa3){
  #pragma unroll
  for(int d0=0;d0<2;++d0){s16x4 lo[4],hi[4];
    #pragma unroll
    for(int ks=0;ks<4;++ks){
      asm volatile("ds_read_b64_tr_b16 %0,%1 offset:%c2":"=&v"(lo[ks]):"v"(vb),"i"(d0*4096+ks*1024):"memory");
      asm volatile("ds_read_b64_tr_b16 %0,%1 offset:%c2":"=&v"(hi[ks]):"v"(vb),"i"(d0*4096+ks*1024+512):"memory");}
    asm volatile("s_waitcnt lgkmcnt(0)":::"memory");SBAR();
    #define PK(k) (bf16x8){lo[k][0],lo[k][1],lo[k][2],lo[k][3],hi[k][0],hi[k][1],hi[k][2],hi[k][3]}
    o[d0]=__builtin_amdgcn_mfma_f32_32x32x16_bf16(pa0,PK(0),o[d0],0,0,0);
    o[d0]=__builtin_amdgcn_mfma_f32_32x32x16_bf16(pa1,PK(1),o[d0],0,0,0);
    o[d0]=__builtin_amdgcn_mfma_f32_32x32x16_bf16(pa2,PK(2),o[d0],0,0,0);
    o[d0]=__builtin_amdgcn_mfma_f32_32x32x16_bf16(pa3,PK(3),o[d0],0,0,0);
    #undef PK
  }
}

#ifndef ATTN_STORE16
#define ATTN_STORE16(p,v) (*(u32x4*)(p)=(v))
#endif
template<int THRL> __device__ __forceinline__ void attn_unit(int b,int h,int qb,const bf16*Q,const bf16*__restrict__ K,const bf16*__restrict__ V,bf16*O,const float*__restrict__ gain,char*shm){
  const int tid=threadIdx.x,lane=tid&63,r32=lane&31,hi=lane>>5; const int wid=__builtin_amdgcn_readfirstlane(tid>>6);
  const long rowbase=(long)b*SEQ; const int q0=qb*QB;
  const bf16*Qw=Q+(rowbase+q0+wid*QBLK)*QP+h*D;
  const bf16*Kh=K+(long)(b*2+(h>>2))*KVROWS*KVP,*Vh=V+(long)(b*2+(h>>2))*KVROWS*KVP;
  const unsigned lds0=(unsigned)(uintptr_t)shm;
  float*wsf=(float*)(shm+LDS_WS)+wid*64;
  const bf16*ksrc=Kh+(long)lane*KVP+wid*8;
  const bf16*vsrc=Vh+(long)(16*(wid&3)+(lane>>2))*KVP+(wid>>2)*32+(lane&3)*8;
  const unsigned kdst=lds0+LDS_K+wid*1024, vdst=lds0+LDS_V+wid*1024;
  #define DMA_K(t,slot) glds16(ksrc+(long)(t)*KVBLK*KVP,(unsigned)__builtin_amdgcn_readfirstlane(kdst+(slot)))
  #define DMA_V(t,slot) glds16(vsrc+(long)(t)*KVBLK*KVP,(unsigned)__builtin_amdgcn_readfirstlane(vdst+(slot)))
  const int vb0=(int)(lds0+LDS_V)+((lane>>4)&1)*32+(lane&3)*8+(4*hi+((lane&15)>>2))*64;
  const char*Kbase=shm+LDS_K; bf16x8 kf[8];
  const lds_cptr shm3=(lds_cptr)shm; const lds_cptr kp0=shm3+LDS_K+hi*1024+r32*16; const lds_cptr vp0=shm3+LDS_V+((lane>>4)&1)*32+(lane&3)*8+(4*hi+((lane&15)>>2))*64;
  DMA_K(0,0);DMA_V(0,0);DMA_K(1,SLOTB);
  bf16x8 qr[4];
  #pragma unroll
  for(int d0=0;d0<4;++d0)qr[d0]=*reinterpret_cast<const bf16x8*>(&Qw[(long)r32*QP+d0*16+hi*8]);
  float mhat=0.f,l_reg=0.f;f32x16 o[2];o[0]=f32x16{};o[1]=f32x16{};f32x16 negm=f32x16{};asm volatile("":"+v"(negm));
  #define CMASK(P0,P1,t) do{}while(0)
  bool resc=false;
  #define START(P0,P1) do{ const float rm=rowmax(P0,P1); resc=false; \
    { const float dl=rm; mhat=fadd_s(mhat,dl); \
      _Pragma("unroll") for(int r=0;r<16;++r){P0[r]=fsub_s(P0[r],dl);P1[r]=fsub_s(P1[r],dl);} \
      _Pragma("unroll") for(int r=0;r<16;++r)negm[r]=-mhat; asm volatile("":"+v"(negm)); } \
    _Pragma("unroll") for(int r=0;r<16;++r)P0[r]=__builtin_amdgcn_exp2f(P0[r]); }while(0)
  #define RESC() do{ if(resc){ asm volatile("s_waitcnt lgkmcnt(0)":::"memory"); \
      _Pragma("unroll") for(int d_=0;d_<2;++d_) _Pragma("unroll") for(int r=0;r<16;++r)o[d_][r]*=wsf[crow(r,hi)]; } }while(0)
  f32x16 pA0,pA1,pB0,pB1;
  int sl_prev=0,sl_cur=0,sl_next=SLOTB;
  #define ROT() do{sl_prev=sl_cur;sl_cur=sl_next;sl_next=(sl_next==(NSLOT-1)*SLOTB)?0:sl_next+SLOTB;}while(0)
  DMA_K(2,2*SLOTB);
  WAIT_BAR(3);
  qkt(pA0,pA1,Kbase,qr,negm,r32,hi);asm volatile("s_nop 15\n\ts_nop 7":"+v"(pA0),"+v"(pA1));CMASK(pA0,pA1,0);
  START(pA0,pA1);
  _Pragma("unroll") for(int r=0;r<16;++r)pA1[r]=__builtin_amdgcn_exp2f(pA1[r]);
  WAIT_BAR(0);
  DMA_K(3,0);DMA_V(1,SLOTB);
  ROT();
  kload8(kf,kp0+sl_cur);
  WAIT_BAR(2);
  s16x4 vlo[8],vhi[8]; u32x4 pw0,pw1,pw2,pw3;
  #define PKW(P,B) cvtpk_s(P[B],P[B+1])
  #define PAF(k) __builtin_bit_cast(bf16x8,pw##k)
  #define VFR(i) (bf16x8){vlo[i][0],vlo[i][1],vlo[i][2],vlo[i][3],vhi[i][0],vhi[i][1],vhi[i][2],vhi[i][3]}
  #define PIN(x) asm volatile("":"+v"(x))
  #define MX3(a,b,c) __builtin_fmaxf(__builtin_fmaxf((a),(b)),(c))
  #define GAPA(MF,A0,A1,A2,A3,W0,W1,PW) do{ MF; sacc+=A0; sacc+=A1; sacc+=A2; sacc+=A3; PIN(sacc); W0; W1; PIN(PW); SBAR(); }while(0)
  #define EX(v) __builtin_amdgcn_exp2f(v)
  #define GAPB(MF,X,B) do{ MF; X[B]=EX(X[B]); X[B+1]=EX(X[B+1]); X[B+2]=EX(X[B+2]); X[B+3]=EX(X[B+3]); PIN(X); SBAR(); }while(0)
  #define VRD(i) do{ vlo[i]=vtr(vp_+(((i)>>2)*4096+((i)&3)*1024)); vhi[i]=vtr(vp_+(((i)>>2)*4096+((i)&3)*1024+512)); }while(0)
  #define KRD(G,j) do{ if(G){ kload2(kf,kp0+sl_next,j); SBAR(); } }while(0)
  #define STEP(C0,C1,P0,P1,t,GK,GV,GL) do{ SBAR(); \
    const lds_cptr vp_=vp0+sl_prev; \
    VRD(0); SBAR(); float sacc=(P0[0]+P0[1]); \
    GAPA(C0=__builtin_amdgcn_mfma_f32_32x32x16_bf16(kf[0],qr[0],negm,0,0,0), P0[2],P0[3],P0[4],P0[5],     pw0[0]=PKW(P0,0), pw0[1]=PKW(P0,2), pw0); \
    VRD(4); SBAR(); GAPA(C1=__builtin_amdgcn_mfma_f32_32x32x16_bf16(kf[1],qr[0],negm,0,0,0), P0[6],P0[7],P0[8],P0[9],     pw0[2]=PKW(P0,4), pw0[3]=PKW(P0,6), pw0); \
    VRD(1); SBAR(); GAPA(C0=__builtin_amdgcn_mfma_f32_32x32x16_bf16(kf[2],qr[1],C0,0,0,0),   P0[10],P0[11],P0[12],P0[13], pw1[0]=PKW(P0,8), pw1[1]=PKW(P0,10), pw1); \
    VRD(5); SBAR(); GAPA(C1=__builtin_amdgcn_mfma_f32_32x32x16_bf16(kf[3],qr[1],C1,0,0,0),   P0[14],P0[15],P1[0],P1[1],   pw1[2]=PKW(P0,12),pw1[3]=PKW(P0,14), pw1); \
    VRD(2); SBAR(); GAPA(C0=__builtin_amdgcn_mfma_f32_32x32x16_bf16(kf[4],qr[2],C0,0,0,0),   P1[2],P1[3],P1[4],P1[5],     pw2[0]=PKW(P1,0), pw2[1]=PKW(P1,2), pw2); \
    VRD(6); SBAR(); GAPA(C1=__builtin_amdgcn_mfma_f32_32x32x16_bf16(kf[5],qr[2],C1,0,0,0),   P1[6],P1[7],P1[8],P1[9],     pw2[2]=PKW(P1,4), pw2[3]=PKW(P1,6), pw2); \
    VRD(3); SBAR(); GAPA(C0=__builtin_amdgcn_mfma_f32_32x32x16_bf16(kf[6],qr[3],C0,0,0,0),   P1[10],P1[11],P1[12],P1[13], pw3[0]=PKW(P1,8), pw3[1]=PKW(P1,10), pw3); \
    VRD(7); SBAR(); GAPA(C1=__builtin_amdgcn_mfma_f32_32x32x16_bf16(kf[7],qr[3],C1,0,0,0),   P1[14],P1[15],0.f,0.f,       pw3[2]=PKW(P1,12),pw3[3]=PKW(P1,14), pw3); \
    l_reg+=sacc; \
    if(GK){DMA_K((t)+3,sl_cur);} if(GV){DMA_V((t)+1,sl_next);} \
    CMASK(C0,C1,t); \
    { float a=MX3(C0[0],C0[1],C1[0]),b=MX3(C0[2],C0[3],C1[1]); a=MX3(a,C1[2],C1[3]); \
      _Pragma("unroll") for(int r=4;r<16;r+=4){a=MX3(a,C0[r],C0[r+1]);b=MX3(b,C0[r+2],C0[r+3]);a=MX3(a,C1[r],C1[r+1]);b=MX3(b,C1[r+2],C1[r+3]);} \
      float rm=__builtin_fmaxf(a,b); { auto rr=__builtin_amdgcn_permlane32_swap(__float_as_uint(rm),__float_as_uint(rm),false,false); rm=__builtin_fmaxf(__uint_as_float(rr[0]),__uint_as_float(rr[1])); } \
      resc=false; \
      if(__builtin_expect(__any(rm>(float)THRL),0)){ const float dl=__builtin_fmaxf(rm,0.f); mhat+=dl; \
        _Pragma("unroll") for(int r=0;r<16;++r){C0[r]-=dl;C1[r]-=dl;} \
        _Pragma("unroll") for(int r=0;r<16;++r)negm[r]=-mhat; asm volatile("":"+v"(negm)); \
        const float f=__builtin_amdgcn_exp2f(-dl); l_reg*=f; if(hi==0)wsf[r32]=f; resc=true; } } \
    SBAR(); \
    GAPB(o[0]=__builtin_amdgcn_mfma_f32_32x32x16_bf16(PAF(0),VFR(0),o[0],0,0,0), C0,0); \
    GAPB(o[1]=__builtin_amdgcn_mfma_f32_32x32x16_bf16(PAF(0),VFR(4),o[1],0,0,0), C0,4); \
    KRD(GL,0); GAPB(o[0]=__builtin_amdgcn_mfma_f32_32x32x16_bf16(PAF(1),VFR(1),o[0],0,0,0), C0,8); \
    KRD(GL,1); GAPB(o[1]=__builtin_amdgcn_mfma_f32_32x32x16_bf16(PAF(1),VFR(5),o[1],0,0,0), C0,12); \
    KRD(GL,2); GAPB(o[0]=__builtin_amdgcn_mfma_f32_32x32x16_bf16(PAF(2),VFR(2),o[0],0,0,0), C1,0); \
    KRD(GL,3); GAPB(o[1]=__builtin_amdgcn_mfma_f32_32x32x16_bf16(PAF(2),VFR(6),o[1],0,0,0), C1,4); \
    GAPB(o[0]=__builtin_amdgcn_mfma_f32_32x32x16_bf16(PAF(3),VFR(3),o[0],0,0,0), C1,8); \
    GAPB(o[1]=__builtin_amdgcn_mfma_f32_32x32x16_bf16(PAF(3),VFR(7),o[1],0,0,0), C1,12); \
    }while(0)
  int t=1;
  #undef CMASK
  #define CMASK(P0,P1,t) do{}while(0)
  for(;t+5<NT;t+=2){
    STEP(pB0,pB1,pA0,pA1,t,true,true,true);     WAIT_BAR(2); RESC(); ROT();
    STEP(pA0,pA1,pB0,pB1,t+1,true,true,true);   WAIT_BAR(2); RESC(); ROT();
  }
  #undef CMASK
  #define CMASK(P0,P1,t) do{ if((t)==NT-1)tmask(P0,P1); }while(0)
  #define ENDW(tt) do{ if((tt)+3<NT){WAIT_BAR(2);} else if((tt)+2<NT){WAIT_BAR(1);} else {WAIT_BAR(0);} }while(0)
  for(;t+1<NT;t+=2){
    STEP(pB0,pB1,pA0,pA1,t,(t+3<NT),(t+1<NT),(t+1<NT));       ENDW(t);   RESC(); ROT();
    STEP(pA0,pA1,pB0,pB1,t+1,(t+4<NT),(t+2<NT),(t+2<NT));     ENDW(t+1); RESC(); ROT();
  }
  static_assert((NT&1)==1&&NT>=7,"odd tile count: the pair loops end on tile NT-1 (scores in buffer A)");
  { float sacc=pA0[0]+pA0[1]; _Pragma("unroll") for(int r=2;r<16;++r)sacc+=pA0[r]; _Pragma("unroll") for(int r=0;r<16;++r)sacc+=pA1[r]; l_reg+=sacc;
    pw0=(u32x4){PKW(pA0,0),PKW(pA0,2),PKW(pA0,4),PKW(pA0,6)};pw1=(u32x4){PKW(pA0,8),PKW(pA0,10),PKW(pA0,12),PKW(pA0,14)};pw2=(u32x4){PKW(pA1,0),PKW(pA1,2),PKW(pA1,4),PKW(pA1,6)};pw3=(u32x4){PKW(pA1,8),PKW(pA1,10),PKW(pA1,12),PKW(pA1,14)};
    SBAR(); pv(o,vb0+sl_prev,PAF(0),PAF(1),PAF(2),PAF(3)); }
  #undef PKW
  #undef PAF
  #undef VFR
  #undef PIN
  #undef MX3
  #undef GAPA
  #undef GAPB
  #undef EX
  #undef VRD
  #undef KRD
  #undef STEP
  #undef ENDW
  {auto rr=__builtin_amdgcn_permlane32_swap(__float_as_uint(l_reg),__float_as_uint(l_reg),false,false);l_reg=__uint_as_float(rr[0])+__uint_as_float(rr[1]);}
  if(hi==0)wsf[32+r32]=l_reg;asm volatile("s_waitcnt lgkmcnt(0)":::"memory");
  float rli[16];
  #pragma unroll
  for(int r=0;r<16;++r)rli[r]=__builtin_amdgcn_rcpf(wsf[32+crow(r,hi)]);
  bf16*Ow=O+(rowbase+q0+wid*QBLK)*OP+h*D;
  { bf16*stg=(bf16*)(shm+LDS_OST)+wid*2048;
    #pragma unroll
    for(int r=0;r<16;++r){const int orow=crow(r,hi);
      #pragma unroll
      for(int d0=0;d0<2;++d0)stg[orow*64+d0*32+r32]=__float2bfloat16(o[d0][r]*rli[r]);}
    asm volatile("s_waitcnt lgkmcnt(0)":::"memory");
    #pragma unroll
    for(int i=0;i<4;++i){const int row=i*8+(lane>>3),ch=lane&7; const u32x4 v=*(const u32x4*)(stg+row*64+ch*8);
      float f[8]; f[0]=__uint_as_float(v.x<<16);f[1]=__uint_as_float(v.x&0xffff0000u);f[2]=__uint_as_float(v.y<<16);f[3]=__uint_as_float(v.y&0xffff0000u);
      f[4]=__uint_as_float(v.z<<16);f[5]=__uint_as_float(v.z&0xffff0000u);f[6]=__uint_as_float(v.w<<16);f[7]=__uint_as_float(v.w&0xffff0000u);
      float ss=0.f; _Pragma("unroll") for(int j=0;j<8;++j)ss+=f[j]*f[j];
      ss+=__shfl_xor(ss,1);ss+=__shfl_xor(ss,2);ss+=__shfl_xor(ss,4);
      const float rs=1.0f/sqrtf(ss*(1.0f/64.0f)+1e-6f); const f32x4_t g0=*(const f32x4_t*)(gain+h*D+ch*8),g1=*(const f32x4_t*)(gain+h*D+ch*8+4);
      u32x4 w; w[0]=cvtpk_s(f[0]*rs*g0[0],f[1]*rs*g0[1]);w[1]=cvtpk_s(f[2]*rs*g0[2],f[3]*rs*g0[3]);w[2]=cvtpk_s(f[4]*rs*g1[0],f[5]*rs*g1[1]);w[3]=cvtpk_s(f[6]*rs*g1[2],f[7]*rs*g1[3]);
      ATTN_STORE16(Ow+(long)row*OP+ch*8,w);} }
  asm volatile("s_waitcnt lgkmcnt(0)\n\ts_barrier":::"memory");
  #undef DMA_K
  #undef DMA_V
  #undef CMASK
  #undef START
  #undef RESC
  #undef ROT
}
constexpr int ATTN_LDS_BYTES=LDS_BYTES;
struct AttnTensors { const bf16* Q; const bf16* K; const bf16* V; bf16* O; const float* gain; };
struct AttnUnit { int b; int h; int qb; };
struct StaticOrder {
  int vcu;
  __device__ __forceinline__ explicit StaticOrder(int grid_,int block):vcu((grid_%8==0)?(block%8)*(grid_/8)+block/8:block),grid(grid_){}
  int grid;
  __device__ __forceinline__ bool next(int i,AttnUnit&u)const{ const int n=i*grid+vcu,pair=n>>5; if(pair>=48)return false; const int s=n&31; u.b=pair>>1; u.h=4*(pair&1)+(s>>3); u.qb=s&7; return true; }
};
template<class Sched,class Side,int THRL=8> __device__ __forceinline__ void attn_phase(char*lds,const AttnTensors&T,const Sched&S,int kside,const Side&side){
  AttnUnit u; int i=0;
  for(;i<kside&&S.next(i,u);++i){ attn_unit<THRL>(u.b,u.h,u.qb,T.Q,T.K,T.V,T.O,T.gain,lds); }
  side();
  for(;S.next(i,u);++i){ attn_unit<THRL>(u.b,u.h,u.qb,T.Q,T.K,T.V,T.O,T.gain,lds); }
}
#undef SBAR
#undef WAIT_BAR
}

typedef __attribute__((address_space(1))) unsigned gu32;
#define XB_TMO      128
#define XB_XCNT(j)  (256  + 64 * (j))
#define XB_XSUB(j)  (1280 + 64 * (j))
#define XB_XGEN(j)  (2304 + 64 * (j))
#define XB_TOP      3328
#define XB_TOPGEN   3392
#define XCD_BAR_WORDS 3456
#define XB_SPIN_CAP (1u << 18)

__device__ __forceinline__ unsigned xb_ld(unsigned* p)              { return __hip_atomic_load(p, __ATOMIC_RELAXED, __HIP_MEMORY_SCOPE_AGENT); }
__device__ __forceinline__ unsigned xb_add(unsigned* p, unsigned v) { return __hip_atomic_fetch_add(p, v, __ATOMIC_RELAXED, __HIP_MEMORY_SCOPE_AGENT); }
__device__ __forceinline__ unsigned xb_xcc_id() { return (unsigned)__builtin_amdgcn_s_getreg((3 << 11) | 20) & 0xFu; }
#define XB_SPIN(cond, bar) do { unsigned _sp = 0; while (cond) { __builtin_amdgcn_s_sleep(1); \
    if ((++_sp & 255u) == 0u) { if (xb_ld(&(bar)[XB_TMO])) break; if (_sp > XB_SPIN_CAP) { atomicAdd(&(bar)[XB_TMO], 1u); break; } } } } while (0)

struct XcdBarrier {
    unsigned* bar; unsigned x;
    volatile LAS unsigned* st;
};

__device__ __forceinline__ XcdBarrier xcd_barrier_post(unsigned* bar, volatile LAS unsigned* st) {
    XcdBarrier b; b.bar = bar; b.x = xb_xcc_id(); b.st = st;
    if (threadIdx.x == 0) (void)xb_add(&bar[XB_XCNT(b.x)], 1u);
    return b;
}
__device__ __forceinline__ void xcd_barrier_complete(unsigned* bar, unsigned x, unsigned& nloc, unsigned& nx) {
    const unsigned G = gridDim.x * gridDim.y * gridDim.z;
    unsigned sum, cnt, mine, sp = 0u;
    for (;;) {
        sum = 0u; cnt = 0u; mine = 0u;
#pragma unroll
        for (unsigned j = 0; j < 16; ++j) { const unsigned c = xb_ld(&bar[XB_XCNT(j)]); sum += c; cnt += (c > 0u) ? 1u : 0u; mine = (j == x) ? c : mine; }
        if (sum == G) break;
        __builtin_amdgcn_s_sleep(1);
        if ((++sp & 255u) == 0u) { if (xb_ld(&bar[XB_TMO])) break; if (sp > XB_SPIN_CAP) { atomicAdd(&bar[XB_TMO], 1u); break; } }
    }
    nloc = mine > 0u ? mine : 1u; nx = cnt > 0u ? cnt : 1u;
}

__device__ __forceinline__ void xcd_barrier(const XcdBarrier& b) {
    asm volatile("s_waitcnt vmcnt(0)" ::: "memory");
    __syncthreads();
    if (threadIdx.x == 0) {
        unsigned* bar = b.bar;
        __builtin_amdgcn_s_waitcnt(0);
        unsigned nloc = b.st[0], nx = b.st[1];
        if (nloc == 0u) { xcd_barrier_complete(bar, b.x, nloc, nx); b.st[0] = nloc; b.st[1] = nx; }
        const unsigned old = xb_add(&bar[XB_XSUB(b.x)], 1u);
        const unsigned gen = old / nloc;
        if (old + 1u == (gen + 1u) * nloc) {
            __builtin_amdgcn_fence(__ATOMIC_RELEASE, "agent");
            asm volatile("s_waitcnt vmcnt(0)" ::: "memory");
            const unsigned og = xb_add(&bar[XB_TOP], 1u);
            const unsigned tg = og / nx;
            if (og + 1u == (tg + 1u) * nx) xb_add(&bar[XB_TOPGEN], 1u);
            else XB_SPIN(xb_ld(&bar[XB_TOPGEN]) == tg, bar);
            __builtin_amdgcn_fence(__ATOMIC_ACQUIRE, "agent");
            xb_add(&bar[XB_XGEN(b.x)], 1u);
            asm volatile("s_waitcnt vmcnt(0)" ::: "memory");
        } else {
            XB_SPIN(xb_ld(&bar[XB_XGEN(b.x)]) == gen, bar);
            __builtin_amdgcn_fence(__ATOMIC_ACQUIRE, "agent");
            asm volatile("s_waitcnt vmcnt(0)" ::: "memory");
        }
    }
    __syncthreads();
}


__global__ void __launch_bounds__(NTHR, 2) enc_fwd(Args a) {
    extern __shared__ __attribute__((aligned(16))) unsigned char lds[];
    cg::grid_group grid = cg::this_grid();
    const int tid = threadIdx.x, lane = tid & 63, wave = __builtin_amdgcn_readfirstlane(tid >> 6);
    const int G = gridDim.x, gw = blockIdx.x * NWAVES + wave, NGW = G * NWAVES;
    const int lo = a.ph_lo, hi = a.ph_hi;
    volatile LAS unsigned* MISC = (volatile LAS unsigned*)((LAS unsigned char*)lds + LDS_BYTES - 64);
    if (tid < 16) MISC[tid] = 0u;
    __syncthreads();
    (void)xcd_barrier_post((unsigned*)(a.ws + WS_CTL) + 4096, MISC);
#define IN(k) (lo <= (k) && (k) < hi)
#ifndef PROBE_X2
#define PROBE_X2 -1
#endif
#define REP(k) for (int rep_ = 0; rep_ < ((k) == PROBE_X2 ? 2 : 1); ++rep_)
#define SEAM(k) do { if (IN(k) && IN((k) + 1)) { if (lo > 1000) grid.sync();   { XcdBarrier bar_; bar_.bar = (unsigned*)(a.ws + WS_CTL) + 4096; bar_.x = xb_xcc_id(); bar_.st = MISC; xcd_barrier(bar_); } } } while (0)
    if (IN(0)) REP(0) { p0_prologue(a, lds, tid, lane, wave); } SEAM(0);
    if (IN(1)) REP(1) { pg8::Gemm g{(const bf16_t*)(a.ws + WS_XA), (const bf16_t*)(a.ws + WS_WIN), NTOK, INW, DM}; pg8::StaticOrder S; S.init(NTOK, INW, G, (int)blockIdx.x);
        pg8::EpiInProj E{(bf16_t*)(a.ws + WS_Z), (bf16_t*)(a.ws + WS_Q), (bf16_t*)(a.ws + WS_KB), (bf16_t*)(a.ws + WS_VB), (const float*)(a.ws + WS_ROPE), a.qg, a.kg};
        kv_meta_rows(a, lane, gw, NGW);
        pg8::gemm_phase<pg8::EpiInProj, pg8::StaticOrder, true, true>((LAS unsigned char*)lds, g, S, E); } SEAM(1);
    if (IN(3)) REP(3) { const attn_body::AttnTensors AT{(const attn_body::bf16*)(a.ws + WS_Q), (const attn_body::bf16*)(a.ws + WS_KB), (const attn_body::bf16*)(a.ws + WS_VB), (attn_body::bf16*)(a.ws + WS_XA) + 512, a.attn_g};
        const attn_body::StaticOrder S(G, (int)blockIdx.x);
        auto side = [&]() { p2_pass(a, lane, gw, NGW);
            __syncthreads(); };
        attn_body::attn_phase<attn_body::StaticOrder>((char*)lds, AT, S, (int)((blockIdx.x >> 3) * 6) >> 5, side); } SEAM(3);
    if (IN(4)) REP(4) { pg8::Gemm g{(const bf16_t*)(a.ws + WS_XA), (const bf16_t*)(a.ws + WS_WOUT), NTOK, DM, DM}; pg8::StaticOrder S; S.init(NTOK, DM, G, (int)blockIdx.x);
        pg8::EpiResidNorm E{a.xp, a.xs, a.out, NBP * SEQ, (bf16_t*)(a.ws + WS_HB), a.ws + WS_X8, (float*)(a.ws + WS_SS), X8SCALE};
        pg8::gemm_phase<pg8::EpiResidNorm, pg8::StaticOrder, true, true>((LAS unsigned char*)lds, g, S, E); } SEAM(4);
    if (IN(6)) REP(6) { pg8::Gemm g{(const bf16_t*)(a.ws + WS_X8), (const bf16_t*)(a.ws + WS_WQ), NTOK, PQ, DM / 2}; pg8::StaticOrder S; S.init(NTOK, PQ, G, (int)blockIdx.x);
        pg8::EpiBf16 E{(bf16_t*)(a.ws + WS_QP), PQ, 1.0f / (X8SCALE * WQSCALE)};
        pg8::gemm_phase<pg8::EpiBf16, pg8::StaticOrder, true, true, true>((LAS unsigned char*)lds, g, S, E); } SEAM(6);
    if (IN(7)) REP(7) { p7_topk(a, lds, tid, lane, wave);
        table_fp4<false>(a.pu, a.ws + WS_UT, (float*)(a.ws + WS_USC), a.g_ffn, gw, NGW, lane);
        table_fp4<true>(a.pv, a.ws + WS_UT + 4 * SLICE4, (float*)(a.ws + WS_VSC), nullptr, gw, NGW, lane);
        __syncthreads(); } SEAM(7);
    if (IN(8)) REP(8) { p8a_u(a, lane, wave); } SEAM(8);
    if (IN(9)) REP(9) { p8c_combine(a, lds, tid); __syncthreads(); } SEAM(9);
    if (IN(10)) REP(10) { p8b_v(a, lds, lane, wave, rep_ == ((10 == PROBE_X2) ? 1 : 0)); }
#undef IN
#undef SEAM
}

extern "C" void kernel_launch(void* const* d_in, const int* in_sizes, int n_in, void* d_out, int out_size, void* d_ws, size_t ws_size, hipStream_t stream) {
    static int grid = 0;
    if (grid == 0) {
        if (n_in != 16 || out_size != NTOK * DM || ws_size < WS_END) { fprintf(stderr, "kernel_launch: unexpected shapes (n_in %d out %d ws %zu)\n", n_in, out_size, ws_size); grid = -1; return; }
        int dev = 0, cus = 0, per_cu = 0;
        (void)hipGetDevice(&dev); (void)hipDeviceGetAttribute(&cus, hipDeviceAttributeMultiprocessorCount, dev);
        (void)hipFuncSetAttribute((const void*)enc_fwd, hipFuncAttributeMaxDynamicSharedMemorySize, LDS_BYTES);
        (void)hipOccupancyMaxActiveBlocksPerMultiprocessor(&per_cu, (const void*)enc_fwd, NTHR, LDS_BYTES);
        if (per_cu < 1) { fprintf(stderr, "kernel_launch: occupancy query says %d blocks/CU\n", per_cu); per_cu = 1; }
        (void)hipGetLastError();
        grid = cus * 1;
    }
    if (grid < 0) return;
    (void)hipMemsetAsync((char*)d_ws + WS_CTL, 0, 64 * 1024, stream);
    Args a{};
    a.xp = (const float*)d_in[0]; a.xs = (const float*)d_in[1]; a.meta = (const float*)d_in[2]; a.g_mix = (const float*)d_in[3]; a.w_in = (const float*)d_in[4];
    a.conv_w = (const float*)d_in[5]; a.qg = (const float*)d_in[6]; a.kg = (const float*)d_in[7]; a.conv_g = (const float*)d_in[8]; a.attn_g = (const float*)d_in[9];
    a.w_out = (const float*)d_in[10]; a.g_ffn = (const float*)d_in[11]; a.wq = (const float*)d_in[12]; a.subk = (const float*)d_in[13]; a.pu = (const float*)d_in[14]; a.pv = (const float*)d_in[15];
    a.out = (float*)d_out; a.ws = (unsigned char*)d_ws;
    constexpr int NL = MK_N_LAUNCHES;
    for (int li = 0; li < NL; ++li) {
        a.ph_lo = (NL == 1) ? 0 : li; a.ph_hi = (NL == 1) ? NPHASE : li + 1;
        void* args[] = {&a};
        hipError_t e = hipLaunchCooperativeKernel((const void*)enc_fwd, dim3(grid), dim3(NTHR), args, LDS_BYTES, stream);
        if (e != hipSuccess) { fprintf(stderr, "kernel_launch: launch %d failed: %s\n", li, hipGetErrorString(e)); break; }
    }
}
```

```cpp
#include <hip/hip_runtime.h>
#include <hip/hip_cooperative_groups.h>
#include <cstdint>
#include <cstdio>
namespace cg = cooperative_groups;

#ifndef MK_N_LAUNCHES
#define MK_N_LAUNCHES 1
#endif

typedef unsigned short bf16_t;
typedef short bf16x8 __attribute__((ext_vector_type(8)));
typedef float f32x4 __attribute__((ext_vector_type(4)));
typedef unsigned u32x4 __attribute__((ext_vector_type(4)));
typedef unsigned u32x2 __attribute__((ext_vector_type(2)));
#define LAS __attribute__((address_space(3)))

constexpr int NB = 24, NBP = 16, SEQ = 2048, DM = 1024, NTOK = NB * SEQ;
constexpr int NMETA = 16, INW = 2304, KROWS = 2112;
constexpr int NKEYS = SEQ + NMETA;
constexpr int PQ = 2048;
constexpr float EPS = 1e-6f;
constexpr float C2 = 0.125f * 1.4426950408889634f;
constexpr int NWAVES = 8, NTHR = 512;
constexpr int LDS_BYTES = 163840;
constexpr int NPHASE = 11;

constexpr size_t MiB = 1u << 20;
constexpr size_t WS_CTL = 0;
constexpr size_t WS_WIN = 1 * MiB;
constexpr size_t WS_WOUT = 6 * MiB;
constexpr size_t WS_WQ = 8 * MiB;
constexpr size_t WS_SUBK = 12 * MiB;
constexpr size_t WS_ZMETA = 12 * MiB + 512 * 1024;
constexpr size_t WS_ROPE = WS_ZMETA + 256 * 1024;
constexpr size_t WS_UT = 13 * MiB;
constexpr size_t WS_USC = 29 * MiB, WS_VSC = WS_USC + 64 * 1024;
constexpr size_t WS_SS = WS_USC + 256 * 1024;
constexpr size_t SLICE4 = (size_t)16384 * 128;
constexpr size_t WS_RS1 = WS_SS + 256 * 1024;
constexpr size_t WS_XA = 32 * MiB;
constexpr size_t WS_EI = WS_XA, WS_GT = WS_XA + 12 * MiB;
constexpr size_t WS_Z = 128 * MiB;
constexpr size_t WS_HB = WS_Z;
constexpr size_t WS_QP = WS_Z + 96 * MiB;
constexpr size_t WS_YA = WS_QP;
constexpr size_t WS_PB = WS_QP;
constexpr size_t WS_AB = WS_PB + (size_t)4 * 49152 * 128 * 4;
constexpr size_t WS_Q = 416 * MiB;
constexpr size_t WS_X8 = WS_Q;
constexpr size_t WS_KB = 464 * MiB;
constexpr size_t WS_VB = 477 * MiB;
constexpr size_t WS_END = 490 * MiB;
constexpr float X8SCALE = 8.0f;
constexpr float WQSCALE = 64.0f;
constexpr float A8SCALE = 256.0f;

struct Args {
    const float* xp; const float* xs; const float* meta; const float* g_mix; const float* w_in; const float* conv_w;
    const float* qg; const float* kg; const float* conv_g; const float* attn_g; const float* w_out; const float* g_ffn;
    const float* wq; const float* subk; const float* pu; const float* pv;
    float* out; unsigned char* ws; int ph_lo, ph_hi;
};

__device__ __forceinline__ unsigned f2bf(float f) { unsigned u = __builtin_bit_cast(unsigned, f); return (u + 0x7fffu + ((u >> 16) & 1u)) >> 16; }
typedef float f32x2_pk __attribute__((ext_vector_type(2))); typedef __bf16 bf16x2_pk __attribute__((ext_vector_type(2)));
__device__ __forceinline__ unsigned pk2(float lo, float hi) { const f32x2_pk v = {lo, hi}; const bf16x2_pk b = __builtin_convertvector(v, bf16x2_pk); return __builtin_bit_cast(unsigned, b); }
__device__ __forceinline__ float bflo(unsigned w) { return __builtin_bit_cast(float, w << 16); }
__device__ __forceinline__ float bfhi(unsigned w) { return __builtin_bit_cast(float, w & 0xffff0000u); }
__device__ __forceinline__ float bf2f(bf16_t h) { return __builtin_bit_cast(float, (unsigned)h << 16); }
__device__ __forceinline__ void unpack8(u32x4 w, float* f) {
    f[0] = bflo(w.x); f[1] = bfhi(w.x); f[2] = bflo(w.y); f[3] = bfhi(w.y); f[4] = bflo(w.z); f[5] = bfhi(w.z); f[6] = bflo(w.w); f[7] = bfhi(w.w);
}
__device__ __forceinline__ u32x4 pack8(const float* f) { u32x4 w; w.x = pk2(f[0], f[1]); w.y = pk2(f[2], f[3]); w.z = pk2(f[4], f[5]); w.w = pk2(f[6], f[7]); return w; }
__device__ __forceinline__ float wave_sum(float v) {
#pragma unroll
    for (int o = 1; o < 64; o <<= 1) v += __shfl_xor(v, o);
    return v;
}
__device__ __forceinline__ float wave_max(float v) {
#pragma unroll
    for (int o = 1; o < 64; o <<= 1) v = fmaxf(v, __shfl_xor(v, o));
    return v;
}
__device__ __forceinline__ const float* xrow_ptr(const Args& a, int r) { return r < NBP * SEQ ? a.xp + (size_t)r * DM : a.xs + (size_t)(r - NBP * SEQ) * DM; }

__device__ __forceinline__ int permin(int n  ) {
    if (n >= 512 && n < 1536) { const int hc = (n - 512) >> 9, c = (n - 512) & 511; return 512 + (c >> 7) * 256 + hc * 128 + (c & 127); }
    if (n >= 1536 && n < 2048) { const int c = n - 1536, hh = c >> 6, half = (c >> 5) & 1; return 1536 + 256 * (hh >> 2) + 128 * half + 32 * (hh & 3) + (c & 31); }
    if (n >= 2048) { const int c = n - 2048, s = c >> 6, half = (c >> 5) & 1; return 2048 + 128 * half + 32 * s + (c & 31); }
    return n; }
__device__ __forceinline__ void p0_transpose_item(const float* W, int K, int N, bf16_t* WT, float* scr, int item, int lane, const float* gk = nullptr  , bool dperm = false) {
    const int nblk = N / 32, kb = item / nblk, nb = item % nblk, k0 = 64 * kb, n0 = 32 * nb, nd0 = dperm ? permin(n0) : n0;
#pragma unroll 8
    for (int i = 0; i < 32; ++i) { const int kk = 2 * i + (lane >> 5); scr[kk * 33 + (lane & 31)] = W[(size_t)(k0 + kk) * N + n0 + (lane & 31)] * (gk ? gk[k0 + kk] : 1.0f); }
    asm volatile("s_waitcnt lgkmcnt(0)" ::: "memory");
    const int c = lane & 7;
#pragma unroll
    for (int j = 0; j < 4; ++j) { const int n = (lane >> 3) + 8 * j; const float* s = scr + (8 * c) * 33 + n;
        u32x4 o; o.x = pk2(s[0 * 33], s[1 * 33]); o.y = pk2(s[2 * 33], s[3 * 33]); o.z = pk2(s[4 * 33], s[5 * 33]); o.w = pk2(s[6 * 33], s[7 * 33]);
        *(u32x4*)(WT + (size_t)(nd0 + n) * K + k0 + 8 * c) = o; }
    asm volatile("s_waitcnt lgkmcnt(0)" ::: "memory");
}
__device__ __forceinline__ void p0_transpose_item_fp8(const float* W, int K, int N, unsigned char* WT, float* scr, int item, int lane, const float* gk, float wscale) {
    const int nblk = N / 32, kb = item / nblk, nb = item % nblk, k0 = 64 * kb, n0 = 32 * nb;
#pragma unroll 8
    for (int i = 0; i < 32; ++i) { const int kk = 2 * i + (lane >> 5); scr[kk * 33 + (lane & 31)] = W[(size_t)(k0 + kk) * N + n0 + (lane & 31)] * (gk[k0 + kk] * wscale); }
    asm volatile("s_waitcnt lgkmcnt(0)" ::: "memory");
    const int c = lane & 7;
#pragma unroll
    for (int j = 0; j < 4; ++j) { const int n = (lane >> 3) + 8 * j; const float* s = scr + (8 * c) * 33 + n;
        unsigned w0 = (unsigned)__builtin_amdgcn_cvt_pk_fp8_f32(s[0 * 33], s[1 * 33], 0, false); w0 = (unsigned)__builtin_amdgcn_cvt_pk_fp8_f32(s[2 * 33], s[3 * 33], (int)w0, true);
        unsigned w1 = (unsigned)__builtin_amdgcn_cvt_pk_fp8_f32(s[4 * 33], s[5 * 33], 0, false); w1 = (unsigned)__builtin_amdgcn_cvt_pk_fp8_f32(s[6 * 33], s[7 * 33], (int)w1, true);
        *(u32x2*)(WT + (size_t)(n0 + n) * K + k0 + 8 * c) = (u32x2){w0, w1}; }
    asm volatile("s_waitcnt lgkmcnt(0)" ::: "memory");
}
__device__ __forceinline__ void cast_region(const float* src, bf16_t* dst, size_t n, size_t gtid, size_t nthreads) {
    for (size_t i = gtid * 8; i < n; i += nthreads * 8) {
        const f32x4 a = *(const f32x4*)(src + i), b = *(const f32x4*)(src + i + 4);
        u32x4 o; o.x = pk2(a.x, a.y); o.y = pk2(a.z, a.w); o.z = pk2(b.x, b.y); o.w = pk2(b.z, b.w);
        *(u32x4*)(dst + i) = o;
    }
}
template <bool PERM64> __device__ __forceinline__ void table_fp4(const float* src, unsigned char* dst, float* scale, const float* gcol  , int gw, int NGW, int lane) {
    f32x4 v[4], vn[4], g[4];
#pragma unroll
    for (int j = 0; j < 4; ++j) g[j] = gcol ? *(const f32x4*)(gcol + lane * 16 + 4 * j) : (f32x4){1.f, 1.f, 1.f, 1.f};
    if (gw < 16384) {
#pragma unroll
        for (int j = 0; j < 4; ++j) v[j] = __builtin_nontemporal_load((const f32x4*)(src + (size_t)gw * DM + lane * 16 + 4 * j)); }
    for (int row = gw; row < 16384; row += NGW) {
        { const int rn = row + NGW < 16384 ? row + NGW : row;
#pragma unroll
          for (int j = 0; j < 4; ++j) vn[j] = __builtin_nontemporal_load((const f32x4*)(src + (size_t)rn * DM + lane * 16 + 4 * j)); }
        float m = 0.f;
#pragma unroll
        for (int j = 0; j < 4; ++j) { v[j] = v[j] * g[j]; m = fmaxf(fmaxf(m, fmaxf(fabsf(v[j].x), fabsf(v[j].y))), fmaxf(fabsf(v[j].z), fabsf(v[j].w))); }
        m = wave_max(m);
        const float s = fmaxf(m, 1e-30f) * (1.0f / 6.0f), inv = 1.0f / s;
        unsigned char* rowp = dst + (size_t)(lane >> 4) * SLICE4 + (size_t)row * 128;
        if (!PERM64) {
            unsigned w0 = 0u, w1 = 0u;
            w0 = __builtin_amdgcn_cvt_scalef32_pk_fp4_f32(w0, v[0].x * inv, v[0].y * inv, 1.0f, 0); w0 = __builtin_amdgcn_cvt_scalef32_pk_fp4_f32(w0, v[0].z * inv, v[0].w * inv, 1.0f, 1);
            w0 = __builtin_amdgcn_cvt_scalef32_pk_fp4_f32(w0, v[1].x * inv, v[1].y * inv, 1.0f, 2); w0 = __builtin_amdgcn_cvt_scalef32_pk_fp4_f32(w0, v[1].z * inv, v[1].w * inv, 1.0f, 3);
            w1 = __builtin_amdgcn_cvt_scalef32_pk_fp4_f32(w1, v[2].x * inv, v[2].y * inv, 1.0f, 0); w1 = __builtin_amdgcn_cvt_scalef32_pk_fp4_f32(w1, v[2].z * inv, v[2].w * inv, 1.0f, 1);
            w1 = __builtin_amdgcn_cvt_scalef32_pk_fp4_f32(w1, v[3].x * inv, v[3].y * inv, 1.0f, 2); w1 = __builtin_amdgcn_cvt_scalef32_pk_fp4_f32(w1, v[3].z * inv, v[3].w * inv, 1.0f, 3);
            *(u32x2*)(rowp + (lane & 15) * 8) = (u32x2){w0, w1};
        } else {
            unsigned char* gp = rowp + ((lane & 15) >> 2) * 32 + (lane & 3) * 2;
#pragma unroll
            for (int m = 0; m < 4; ++m) { unsigned wm = 0u;
                wm = __builtin_amdgcn_cvt_scalef32_pk_fp4_f32(wm, v[0][m] * inv, v[1][m] * inv, 1.0f, 0); wm = __builtin_amdgcn_cvt_scalef32_pk_fp4_f32(wm, v[2][m] * inv, v[3][m] * inv, 1.0f, 1);
                *(unsigned short*)(gp + 8 * m) = (unsigned short)wm; }
        }
        if (lane == 0) scale[row] = s;
#pragma unroll
        for (int j = 0; j < 4; ++j) v[j] = vn[j];
    }
}
__device__ __forceinline__ void p0_prologue(const Args& a, unsigned char* lds, int tid, int lane, int wave) {
    const int G = gridDim.x, gw = blockIdx.x * NWAVES + wave, NGW = G * NWAVES;
    float* ldsf = (float*)lds;
    if (blockIdx.x < INW / 64) {
        float* xm = ldsf;
        float* red = ldsf + 16 * 1024;
#pragma unroll
        for (int rr = 0; rr < 2; ++rr) { const int r = 2 * wave + rr; f32x4 v[4]; float ss = 0.f;
#pragma unroll
            for (int j = 0; j < 4; ++j) { v[j] = *(const f32x4*)(a.meta + (size_t)r * DM + (lane + 64 * j) * 4); ss += v[j].x * v[j].x + v[j].y * v[j].y + v[j].z * v[j].z + v[j].w * v[j].w; }
            const float rstd = 1.0f / sqrtf(wave_sum(ss) * (1.0f / DM) + EPS);
#pragma unroll
            for (int j = 0; j < 4; ++j) { const int c = (lane + 64 * j) * 4; const f32x4 g = *(const f32x4*)(a.g_mix + c); *(f32x4*)(xm + r * 1024 + c) = v[j] * rstd * g; }
        }
        __syncthreads();
        const int n0 = blockIdx.x * 64, k0 = wave * 128;
        float acc[16];
#pragma unroll
        for (int r = 0; r < 16; ++r) acc[r] = 0.f;
        for (int kb = k0; kb < k0 + 128; kb += 16) { float wv[16];
#pragma unroll
            for (int q = 0; q < 16; ++q) wv[q] = a.w_in[(size_t)(kb + q) * INW + n0 + lane];
#pragma unroll
            for (int q = 0; q < 16; ++q)
#pragma unroll
                for (int r = 0; r < 16; ++r) acc[r] += xm[r * 1024 + kb + q] * wv[q]; }
#pragma unroll
        for (int r = 0; r < 16; ++r) red[(wave * 16 + r) * 64 + lane] = acc[r];
        __syncthreads();
        float* zmeta = (float*)(a.ws + WS_ZMETA);
        for (int o = tid; o < 1024; o += NTHR) { const int r = o >> 6, c = o & 63; float s = 0.f;
#pragma unroll
            for (int w = 0; w < 8; ++w) s += red[(w * 16 + r) * 64 + c];
            zmeta[r * INW + n0 + c] = s; }
        __syncthreads();
    }
    if (blockIdx.x == INW / 64) {
        float* rope = (float*)(a.ws + WS_ROPE);
        for (int i = tid; i < 64 * 16; i += NTHR) { const int pos = i >> 4, f = i & 15;
            const float freq = exp2f(-(float)f * (13.287712379549449f / 16.0f)); const float rev = (float)pos * freq * 0.15915494309189535f; const float fr = rev - floorf(rev);
            rope[2 * i] = __builtin_amdgcn_cosf(fr); rope[2 * i + 1] = __builtin_amdgcn_sinf(fr); }
    }
    if ((int)blockIdx.x > INW / 64 || G <= INW / 64 + 1) {
        float* scr = ldsf + wave * (64 * 33);
        constexpr int I_IN = (DM / 64) * (INW / 32), I_OUT = (DM / 64) * (DM / 32), I_WQ = (DM / 64) * (PQ / 32);
        const int first = (G <= INW / 64 + 1) ? 0 : INW / 64 + 1, nw = (G - first) * NWAVES;
        for (int it = ((int)blockIdx.x - first) * NWAVES + wave; it < I_IN + I_OUT + I_WQ; it += nw) {
            int r = it;
            if (r < I_IN) { p0_transpose_item(a.w_in, DM, INW, (bf16_t*)(a.ws + WS_WIN), scr, r, lane, a.g_mix, true); continue; } r -= I_IN;
            if (r < I_OUT) { p0_transpose_item(a.w_out, DM, DM, (bf16_t*)(a.ws + WS_WOUT), scr, r, lane); continue; } r -= I_OUT;
            p0_transpose_item_fp8(a.wq, DM, PQ, a.ws + WS_WQ, scr, r, lane, a.g_ffn, WQSCALE);
        }
    }
    {
        const size_t gtid = (size_t)blockIdx.x * NTHR + tid, nth = (size_t)G * NTHR;
        cast_region(a.subk, (bf16_t*)(a.ws + WS_SUBK), (size_t)16 * 128 * 128, gtid, nth);
        for (size_t i = gtid; i < (size_t)NTOK; i += nth) ((float*)(a.ws + WS_SS))[i] = 0.f;
    }
    {
        bf16_t* XA = (bf16_t*)(a.ws + WS_XA); float* RS1 = (float*)(a.ws + WS_RS1);
        f32x4 v[4], vn[4];
        if (gw < NTOK) { const float* xr = xrow_ptr(a, gw);
#pragma unroll
            for (int j = 0; j < 4; ++j) v[j] = __builtin_nontemporal_load((const f32x4*)(xr + (lane + 64 * j) * 4)); }
        for (int r = gw; r < NTOK; r += NGW) {
            { const float* xn = xrow_ptr(a, r + NGW < NTOK ? r + NGW : r);
#pragma unroll
              for (int j = 0; j < 4; ++j) vn[j] = __builtin_nontemporal_load((const f32x4*)(xn + (lane + 64 * j) * 4)); }
            float ss = 0.f;
#pragma unroll
            for (int j = 0; j < 4; ++j) ss += v[j].x * v[j].x + v[j].y * v[j].y + v[j].z * v[j].z + v[j].w * v[j].w;
            const float rstd = 1.0f / sqrtf(wave_sum(ss) * (1.0f / DM) + EPS);
#pragma unroll
            for (int j = 0; j < 4; ++j) { const int c = (lane + 64 * j) * 4; const f32x4 o = v[j] * rstd;
                u32x2 w; w.x = pk2(o.x, o.y); w.y = pk2(o.z, o.w); *(u32x2*)(XA + (size_t)r * DM + c) = w; }
            if (lane == 0) RS1[r] = rstd;
#pragma unroll
            for (int j = 0; j < 4; ++j) v[j] = vn[j];
        }
    }
}

constexpr int ZW = 1024;
struct P2In { u32x4 w[4]; };
__device__ __forceinline__ void p2_load(P2In& in, const bf16_t* ZB, int r, int lane) {
    const int t = r & 2047, c0 = lane * 8; const bf16_t* zr = ZB + (size_t)r * ZW;
    const bf16_t* zp = (t > 0) ? zr - ZW : zr; const bf16_t* zn = (t < SEQ - 1) ? zr + ZW : zr;
    in.w[0] = *(const u32x4*)(zr + c0); in.w[1] = *(const u32x4*)(zr + 512 + c0); in.w[2] = *(const u32x4*)(zp + 512 + c0); in.w[3] = *(const u32x4*)(zn + 512 + c0);
}
__device__ __forceinline__ void p2_pass(const Args& a, int lane, int gw, int NGW) {
    const bf16_t* ZB = (const bf16_t*)(a.ws + WS_Z); const float* zmeta = (const float*)(a.ws + WS_ZMETA);
    bf16_t* XA = (bf16_t*)(a.ws + WS_YA);
    const int c0 = lane * 8;
    float cw0[8], cw1[8], cw2[8], cgn[8];
#pragma unroll
    for (int j = 0; j < 8; ++j) { cw0[j] = a.conv_w[c0 + j]; cw1[j] = a.conv_w[512 + c0 + j]; cw2[j] = a.conv_w[1024 + c0 + j]; cgn[j] = a.conv_g[c0 + j]; }
    P2In cur, nxt, nx2;
    if (gw < NTOK) { p2_load(cur, ZB, gw, lane); p2_load(nxt, ZB, gw + NGW < NTOK ? gw + NGW : gw, lane); }
    for (int it = gw; it < NTOK; it += NGW) {
        {
            const int r = it, t = r & 2047;
            { const int rn = it + 2 * NGW < NTOK ? it + 2 * NGW : it; p2_load(nx2, ZB, rn, lane); }
            float gb[8], uc[8], up[8], un[8];
            unpack8(cur.w[0], gb); unpack8(cur.w[1], uc); unpack8(cur.w[2], up);
            if (t == 0) {
#pragma unroll
                for (int j = 0; j < 8; ++j) up[j] = zmeta[15 * INW + 512 + c0 + j] * zmeta[15 * INW + 1024 + c0 + j]; }
            unpack8(cur.w[3], un);
#pragma unroll
            for (int j = 0; j < 8; ++j) un[j] = (t < SEQ - 1) ? un[j] : 0.f;
            float y[8], ss = 0.f;
#pragma unroll
            for (int j = 0; j < 8; ++j) { y[j] = gb[j] * (up[j] * cw0[j] + uc[j] * cw1[j] + un[j] * cw2[j]); ss += y[j] * y[j]; }
            ss += __shfl_xor(ss, 1); ss += __shfl_xor(ss, 2); ss += __shfl_xor(ss, 4);
            const float rstd = 1.0f / sqrtf(ss * (1.0f / 64.0f) + EPS);
#pragma unroll
            for (int j = 0; j < 8; ++j) y[j] = y[j] * rstd * cgn[j];
            *(u32x4*)(XA + (size_t)r * DM + c0) = pack8(y);
            cur = nxt; nxt = nx2;
        }
    }
}
__device__ __forceinline__ void kv_meta_rows(const Args& a, int lane, int gw, int NGW) {
    const float* zmeta = (const float*)(a.ws + WS_ZMETA); bf16_t* KB = (bf16_t*)(a.ws + WS_KB); bf16_t* VB = (bf16_t*)(a.ws + WS_VB);
    const int i = lane & 7;
    for (int it = NTOK + gw; it < NTOK + NB * 64; it += NGW) {
        {
            const int it2 = it - NTOK, b = it2 >> 6, j64 = it2 & 63; const int l16 = lane & 15, g = l16 >> 3;
            float k[8], v[8];
            if (j64 < NMETA) {
                const float* zm = zmeta + j64 * INW; float ss = 0.f;
#pragma unroll
                for (int j = 0; j < 8; ++j) { k[j] = zm[2048 + l16 * 8 + j]; v[j] = zm[2176 + l16 * 8 + j]; ss += k[j] * k[j]; }
                ss += __shfl_xor(ss, 1); ss += __shfl_xor(ss, 2); ss += __shfl_xor(ss, 4);
                const float rstd = 1.0f / sqrtf(ss * (1.0f / 64.0f) + EPS);
#pragma unroll
                for (int j = 0; j < 8; ++j) k[j] = k[j] * rstd * a.kg[i * 8 + j];
            } else {
#pragma unroll
                for (int j = 0; j < 8; ++j) { k[j] = 0.f; v[j] = 0.f; }
            }
            const size_t krow = ((size_t)(b * 2 + g) * KROWS + SEQ + j64) * 64 + i * 8;
            if (lane < 16) *(u32x4*)(KB + krow) = pack8(k);
            else if (lane < 32) *(u32x4*)(VB + krow) = pack8(v);
        }
    }
}

typedef float f32x16 __attribute__((ext_vector_type(16)));
__device__ __forceinline__ void ce_desc(float& a, float& b) { float h, l; asm("v_max_f32_e32 %0, %1, %2" : "=v"(h) : "v"(a), "v"(b)); asm("v_min_f32_e32 %0, %1, %2" : "=v"(l) : "v"(a), "v"(b)); a = h; b = l; }
__device__ __forceinline__ float vmaxf(float a, float b) { float h; asm("v_max_f32_e32 %0, %1, %2" : "=v"(h) : "v"(a), "v"(b)); return h; }
template <int N> __device__ __forceinline__ void bitonic_sort_desc(float* v) {
#pragma unroll
    for (int k = 2; k <= N; k <<= 1)
#pragma unroll
        for (int j = k >> 1; j > 0; j >>= 1)
#pragma unroll
            for (int i = 0; i < N; ++i) { const int l = i ^ j; if (l > i) { if ((i & k) == 0) ce_desc(v[i], v[l]); else ce_desc(v[l], v[i]); } }
}
__device__ __forceinline__ void sort16_desc(float* v) {
    ce_desc(v[0], v[13]); ce_desc(v[1], v[12]); ce_desc(v[2], v[15]); ce_desc(v[3], v[14]); ce_desc(v[4], v[8]); ce_desc(v[5], v[6]); ce_desc(v[7], v[11]); ce_desc(v[9], v[10]);
    ce_desc(v[0], v[5]); ce_desc(v[1], v[7]); ce_desc(v[2], v[9]); ce_desc(v[3], v[4]); ce_desc(v[6], v[13]); ce_desc(v[8], v[14]); ce_desc(v[10], v[15]); ce_desc(v[11], v[12]);
    ce_desc(v[0], v[1]); ce_desc(v[2], v[3]); ce_desc(v[4], v[5]); ce_desc(v[6], v[8]); ce_desc(v[7], v[9]); ce_desc(v[10], v[11]); ce_desc(v[12], v[13]); ce_desc(v[14], v[15]);
    ce_desc(v[0], v[2]); ce_desc(v[1], v[3]); ce_desc(v[4], v[10]); ce_desc(v[5], v[11]); ce_desc(v[6], v[7]); ce_desc(v[8], v[9]); ce_desc(v[12], v[14]); ce_desc(v[13], v[15]);
    ce_desc(v[1], v[2]); ce_desc(v[3], v[12]); ce_desc(v[4], v[6]); ce_desc(v[5], v[7]); ce_desc(v[8], v[10]); ce_desc(v[9], v[11]); ce_desc(v[13], v[14]);
    ce_desc(v[1], v[4]); ce_desc(v[2], v[6]); ce_desc(v[5], v[8]); ce_desc(v[7], v[10]); ce_desc(v[9], v[13]); ce_desc(v[11], v[14]);
    ce_desc(v[2], v[4]); ce_desc(v[3], v[6]); ce_desc(v[9], v[12]); ce_desc(v[11], v[13]);
    ce_desc(v[3], v[5]); ce_desc(v[6], v[8]); ce_desc(v[7], v[9]); ce_desc(v[10], v[12]);
    ce_desc(v[3], v[4]); ce_desc(v[5], v[6]); ce_desc(v[7], v[8]); ce_desc(v[9], v[10]); ce_desc(v[11], v[12]);
    ce_desc(v[6], v[7]); ce_desc(v[8], v[9]);
}
template <int N> __device__ __forceinline__ void bitonic_merge_desc(float* v) {
#pragma unroll
    for (int j = N >> 1; j > 0; j >>= 1)
#pragma unroll
        for (int i = 0; i < N; ++i) { const int l = i ^ j; if (l > i) ce_desc(v[i], v[l]); }
}
__device__ __forceinline__ void merge_top16(float* x, const float* y) {
#pragma unroll
    for (int i = 0; i < 16; ++i) x[i] = vmaxf(x[i], y[15 - i]);
    bitonic_merge_desc<16>(x);
}
__device__ __forceinline__ void insert16(float* t, float x) {
#pragma unroll
    for (int k = 0; k < 16; ++k) ce_desc(t[k], x);
}
constexpr int SK_ROW = 272, SK_MAT = 128 * SK_ROW;
__device__ __forceinline__ void p7_half(const bf16_t* qrow  , const LAS unsigned char* skl  , int hi4, float* T) {
    f32x16 acc[4];
#pragma unroll
    for (int nb = 0; nb < 4; ++nb)
#pragma unroll
        for (int r = 0; r < 16; ++r) acc[nb][r] = 0.f;
    bf16x8 bq[8];
#pragma unroll
    for (int ks = 0; ks < 8; ++ks) bq[ks] = *(const bf16x8*)(qrow + ks * 16);
#pragma unroll
    for (int ks = 0; ks < 8; ++ks) {
#pragma unroll
        for (int nb = 0; nb < 4; ++nb) { const bf16x8 ak = *(const LAS bf16x8*)(skl + nb * 32 * SK_ROW + ks * 32); acc[nb] = __builtin_amdgcn_mfma_f32_32x32x16_bf16(ak, bq[ks], acc[nb], 0, 0, 0); }
        if (ks & 1) __builtin_amdgcn_sched_barrier(0);
    }
    float L[16];
#pragma unroll
    for (int nb = 0; nb < 4; ++nb) {
        float v[16];
#pragma unroll
        for (int r = 0; r < 16; ++r) { const float sc = acc[nb][r]; v[r] = __uint_as_float((__float_as_uint(sc) & ~127u) | (unsigned)(nb * 16 + r)); }
        sort16_desc(v);
        if (nb == 0) {
#pragma unroll
            for (int r = 0; r < 16; ++r) L[r] = v[r];
        } else merge_top16(L, v);
    }
#pragma unroll
    for (int r = 0; r < 16; ++r) { const unsigned w = __builtin_bit_cast(unsigned, L[r]); T[r] = __builtin_bit_cast(float, w + (w & 0x3Cu) + (unsigned)hi4); }
}
__device__ __forceinline__ unsigned pick_byte(unsigned p0, unsigned p1, unsigned p2, unsigned p3, unsigned i) {
    const unsigned sel = (i & 7u) | 0x0c0c0c00u;
    const unsigned lo = __builtin_amdgcn_perm(p1, p0, sel), hi = __builtin_amdgcn_perm(p3, p2, sel);
    return (i & 8u) ? hi : lo;
}
__device__ __forceinline__ void p7_topk(const Args& a, unsigned char* lds, int tid, int lane, int wave) {
    const bf16_t* QP = (const bf16_t*)(a.ws + WS_QP); const bf16_t* SUBK = (const bf16_t*)(a.ws + WS_SUBK);
    unsigned short* EIDX = (unsigned short*)(a.ws + WS_EI); bf16_t* GATE = (bf16_t*)(a.ws + WS_GT); const float* SSQ = (const float*)(a.ws + WS_SS);
    const int r32 = lane & 31, hi = lane >> 5;
    const int hp = blockIdx.x & 3, grp = blockIdx.x >> 2, ngrp = gridDim.x >> 2;
    { const u32x4* src = (const u32x4*)(SUBK + (size_t)hp * 4 * 128 * 128);
      for (int i = tid; i < 4 * 128 * 16; i += NTHR) { const int row = i >> 4, ch = i & 15; *(LAS u32x4*)((LAS unsigned char*)lds + row * SK_ROW + ch * 16) = src[i]; } }
    __syncthreads();
    const LAS unsigned char* skl = (const LAS unsigned char*)lds + r32 * SK_ROW + 16 * hi;
    for (int blk = grp * NWAVES + wave; blk < NTOK / 32; blk += ngrp * NWAVES) {
        const int tok = blk * 32 + r32;
        const float rs_l2e = 1.4426950408889634f / sqrtf(SSQ[tok] * (1.0f / DM) + EPS);
        float M0[16], M1[16];
        {
            float B0[16], B1[16];
            p7_half(QP + (size_t)tok * PQ + (2 * hp) * 256 + 8 * hi, skl + 0 * SK_MAT, 4 * hi, M0);
            p7_half(QP + (size_t)tok * PQ + (2 * hp) * 256 + 128 + 8 * hi, skl + 1 * SK_MAT, 4 * hi, M1);
            p7_half(QP + (size_t)tok * PQ + (2 * hp + 1) * 256 + 8 * hi, skl + 2 * SK_MAT, 4 * hi, B0);
            p7_half(QP + (size_t)tok * PQ + (2 * hp + 1) * 256 + 128 + 8 * hi, skl + 3 * SK_MAT, 4 * hi, B1);
#pragma unroll
            for (int i = 0; i < 16; ++i) {
                const auto r0 = __builtin_amdgcn_permlane32_swap(__builtin_bit_cast(unsigned, M0[i]), __builtin_bit_cast(unsigned, B0[i]), false, false);
                const unsigned a0 = r0[0], b0 = r0[1]; M0[i] = __builtin_bit_cast(float, a0); B0[i] = __builtin_bit_cast(float, b0);
                const auto r1 = __builtin_amdgcn_permlane32_swap(__builtin_bit_cast(unsigned, M1[i]), __builtin_bit_cast(unsigned, B1[i]), false, false);
                const unsigned a1 = r1[0], b1 = r1[1]; M1[i] = __builtin_bit_cast(float, a1); B1[i] = __builtin_bit_cast(float, b1); }
            merge_top16(M0, B0); merge_top16(M1, B1);
        }
        const int h = 2 * hp + hi;
#define CAND(i, j) __builtin_bit_cast(float, (__builtin_bit_cast(unsigned, M0[i] + M1[j]) & ~255u) | (unsigned)((i) * 16 + (j)))
        float tc[16], l2[16], l3[16];
#pragma unroll
        for (int j = 0; j < 16; ++j) tc[j] = CAND(0, j);
#pragma unroll
        for (int j = 0; j < 8; ++j) { l2[j] = CAND(1, j); l2[8 + j] = CAND(15 - j, 0); }
        bitonic_merge_desc<16>(l2);
        merge_top16(tc, l2);
        l3[0] = CAND(2, 0); l3[1] = CAND(2, 1); l3[2] = CAND(2, 2); l3[3] = CAND(2, 3); l3[4] = CAND(2, 4); l3[5] = CAND(3, 0); l3[6] = CAND(3, 1); l3[7] = CAND(3, 2); l3[8] = CAND(3, 3);
        l3[9] = CAND(4, 0); l3[10] = CAND(4, 1); l3[11] = CAND(4, 2); l3[12] = CAND(5, 0); l3[13] = CAND(5, 1); l3[14] = CAND(6, 0); l3[15] = CAND(6, 1);
        sort16_desc(l3);
        merge_top16(tc, l3);
        insert16(tc, CAND(7, 0)); insert16(tc, CAND(7, 1));
#undef CAND
#define PK4(M, q) ((__builtin_bit_cast(unsigned, M[4 * (q)]) & 127u) | ((__builtin_bit_cast(unsigned, M[4 * (q) + 1]) & 127u) << 8) | ((__builtin_bit_cast(unsigned, M[4 * (q) + 2]) & 127u) << 16) | ((__builtin_bit_cast(unsigned, M[4 * (q) + 3]) & 127u) << 24))
        const unsigned a0 = PK4(M0, 0), a1 = PK4(M0, 1), a2 = PK4(M0, 2), a3 = PK4(M0, 3), b0 = PK4(M1, 0), b1 = PK4(M1, 1), b2 = PK4(M1, 2), b3 = PK4(M1, 3);
#undef PK4
        float e[16], sum = 0.f;
#pragma unroll
        for (int k = 0; k < 16; ++k) { e[k] = exp2f((tc[k] - tc[0]) * rs_l2e); sum += e[k]; }
        const float inv = 1.0f / sum;
        int eo[16];
#pragma unroll
        for (int k = 0; k < 16; ++k) { const unsigned code = __builtin_bit_cast(unsigned, tc[k]) & 255u; eo[k] = (int)(pick_byte(a0, a1, a2, a3, code >> 4) * 128u + pick_byte(b0, b1, b2, b3, code & 15u)); e[k] *= inv; }
        unsigned short* ep = EIDX + ((size_t)tok * 8 + h) * 16; bf16_t* gp = GATE + ((size_t)tok * 8 + h) * 16;
#pragma unroll
        for (int k = 0; k < 16; k += 8) { u32x4 pk; pk.x = (unsigned)eo[k] | ((unsigned)eo[k + 1] << 16); pk.y = (unsigned)eo[k + 2] | ((unsigned)eo[k + 3] << 16); pk.z = (unsigned)eo[k + 4] | ((unsigned)eo[k + 5] << 16); pk.w = (unsigned)eo[k + 6] | ((unsigned)eo[k + 7] << 16); *(u32x4*)(ep + k) = pk; }
#pragma unroll
        for (int k = 0; k < 16; k += 8) *(u32x4*)(gp + k) = (u32x4){pk2(e[k], e[k + 1]), pk2(e[k + 2], e[k + 3]), pk2(e[k + 4], e[k + 5]), pk2(e[k + 6], e[k + 7])};
    }
}

typedef _Float16 h2_t __attribute__((ext_vector_type(2)));
typedef float f32x2 __attribute__((ext_vector_type(2)));
__device__ __forceinline__ float dot32_fp4(u32x4 w, const h2_t* xh) {
    float acc = 0.f;
#pragma unroll
    for (int d = 0; d < 4; ++d) {
        const unsigned wd = w[d];
        acc = __builtin_amdgcn_fdot2(__builtin_amdgcn_cvt_scalef32_pk_f16_fp4(wd, 1.0f, 0), xh[4 * d], acc, false);
        acc = __builtin_amdgcn_fdot2(__builtin_amdgcn_cvt_scalef32_pk_f16_fp4(wd, 1.0f, 1), xh[4 * d + 1], acc, false);
        acc = __builtin_amdgcn_fdot2(__builtin_amdgcn_cvt_scalef32_pk_f16_fp4(wd, 1.0f, 2), xh[4 * d + 2], acc, false);
        acc = __builtin_amdgcn_fdot2(__builtin_amdgcn_cvt_scalef32_pk_f16_fp4(wd, 1.0f, 3), xh[4 * d + 3], acc, false);
    }
    return acc;
}
typedef int i32x4 __attribute__((ext_vector_type(4)));
struct PMeta { unsigned p[8]; };
#define GAS __attribute__((address_space(1)))
template <class T> __device__ __forceinline__ GAS T* sgpr_ptr(T* p) { asm volatile("" : "+s"(p)); return (GAS T*)p; }
__device__ __forceinline__ void pm_load(PMeta& m, const unsigned short* EIDX, int t  , int seg) {
    const GAS unsigned char* rb = sgpr_ptr((const unsigned char*)(EIDX + (size_t)t * 128)); const unsigned lo = (unsigned)seg * 32u;
#pragma unroll
    for (int q = 0; q < 2; ++q) { const u32x4 ev = __builtin_nontemporal_load((const GAS u32x4*)(rb + (lo + q * 16u))); m.p[4 * q] = ev.x; m.p[4 * q + 1] = ev.y; m.p[4 * q + 2] = ev.z; m.p[4 * q + 3] = ev.w; }
}
#define SCHED_FENCE() __builtin_amdgcn_sched_barrier(0)
__device__ __forceinline__ void rows16_load(u32x4 (&w)[16], const unsigned char* Tbase, unsigned lane_off, const PMeta& m) {
#pragma unroll
    for (int j = 0; j < 16; ++j) { const unsigned pw = m.p[j >> 1]; const unsigned e = (j & 1) ? (pw >> 16) : (pw & 0xffffu); w[j] = *(const u32x4*)(Tbase + (e * 128u + lane_off)); }
}
#define PEER_GEOM() const int s4 = blockIdx.x & 3, th = (blockIdx.x >> 2) & 1, wq = (blockIdx.x >> 3) * NWAVES + wave, NWQ = (gridDim.x >> 3) * NWAVES, t_beg = th * (NTOK / 2) + wq, t_end = (th + 1) * (NTOK / 2)
#define TCL(t) ((t) < t_end ? (t) : t_end - 1)
typedef int v8i_t __attribute__((ext_vector_type(8)));
struct UTok { u32x4 A[8][2]; u32x4 B[2][2]; };
__device__ __forceinline__ void u_issue(UTok& T, const unsigned char* Ts  , const unsigned char* x8row  , unsigned idlo, unsigned idhi, int lane) {
    const int r16 = lane >> 2; const unsigned c16 = (unsigned)(lane & 3) * 16u; const unsigned q16 = (unsigned)(lane >> 4) * 16u;
#pragma unroll
    for (int h = 0; h < 8; ++h) { const unsigned e = (unsigned)__shfl((int)(h < 4 ? idlo : idhi), (h & 3) * 16 + r16);
#pragma unroll
        for (int ks = 0; ks < 2; ++ks) T.A[h][ks] = *(const u32x4*)(Ts + (e * 128u + 64u * ks + c16)); }
#pragma unroll
    for (int ks = 0; ks < 2; ++ks)
#pragma unroll
        for (int hf = 0; hf < 2; ++hf) T.B[ks][hf] = __builtin_nontemporal_load((const GAS u32x4*)(sgpr_ptr(x8row) + (128u * ks + 64u * hf + q16)));
}
__device__ __forceinline__ void u_compute(const UTok& T, int lane, bf16_t* dst  ) {
    f32x4 acc[8];
#pragma unroll
    for (int h = 0; h < 8; ++h) {
        acc[h] = (f32x4){0.f, 0.f, 0.f, 0.f};
#pragma unroll
        for (int ks = 0; ks < 2; ++ks) {
            const int src = (4 * (lane & 15) + (lane >> 4)) * 4;
            const v8i_t av = {__builtin_amdgcn_ds_bpermute(src, (int)T.A[h][ks].x), __builtin_amdgcn_ds_bpermute(src, (int)T.A[h][ks].y), __builtin_amdgcn_ds_bpermute(src, (int)T.A[h][ks].z), __builtin_amdgcn_ds_bpermute(src, (int)T.A[h][ks].w), 0, 0, 0, 0};
            const v8i_t bv = {(int)T.B[ks][0].x, (int)T.B[ks][0].y, (int)T.B[ks][0].z, (int)T.B[ks][0].w, (int)T.B[ks][1].x, (int)T.B[ks][1].y, (int)T.B[ks][1].z, (int)T.B[ks][1].w};
            acc[h] = __builtin_amdgcn_mfma_scale_f32_16x16x128_f8f6f4(av, bv, acc[h], 4  , 0  , 0, 0x7F7F7F7F, 0, 0x7F7F7F7F);
        }
    }
    const int j16 = lane & 15; f32x4 r = acc[0];
#pragma unroll
    for (int h = 1; h < 8; ++h) r = (j16 == h) ? acc[h] : r;
    if (j16 < 8) __builtin_nontemporal_store((u32x2){pk2(r[0], r[1]), pk2(r[2], r[3])}, (GAS u32x2*)(sgpr_ptr((unsigned char*)dst) + (unsigned)(j16 * 16 + (lane >> 4) * 4) * 2u));
}
__device__ __forceinline__ void p8a_u(const Args& a, int lane, int wave) {
    const unsigned short* EIDX = (const unsigned short*)(a.ws + WS_EI); bf16_t* PB = (bf16_t*)(a.ws + WS_PB);
    PEER_GEOM();
    const unsigned char* Ts = a.ws + WS_UT + (size_t)s4 * SLICE4; const unsigned char* x8 = a.ws + WS_X8 + s4 * 256;
    bf16_t* pb = PB + (size_t)s4 * NTOK * 128;
#define IDLOAD(lo, hi, t) do { const GAS unsigned short* ip_ = sgpr_ptr(EIDX + (size_t)(t) * 128); lo = ip_[lane]; hi = ip_[64 + lane]; } while (0)
    UTok TA, TB; unsigned ia0, ia1, ib0, ib1;
    IDLOAD(ia0, ia1, TCL(t_beg)); IDLOAD(ib0, ib1, TCL(t_beg + NWQ));
    u_issue(TA, Ts, x8 + (size_t)TCL(t_beg) * DM, ia0, ia1, lane);
    IDLOAD(ia0, ia1, TCL(t_beg + 2 * NWQ));
    for (int t = t_beg; t < t_end; t += 2 * NWQ) {
        SCHED_FENCE();
        u_issue(TB, Ts, x8 + (size_t)TCL(t + NWQ) * DM, ib0, ib1, lane); IDLOAD(ib0, ib1, TCL(t + 3 * NWQ));
        SCHED_FENCE();
        u_compute(TA, lane, pb + (size_t)t * 128);
        SCHED_FENCE();
        u_issue(TA, Ts, x8 + (size_t)TCL(t + 2 * NWQ) * DM, ia0, ia1, lane); IDLOAD(ia0, ia1, TCL(t + 4 * NWQ));
        SCHED_FENCE();
        if (t + NWQ < t_end) u_compute(TB, lane, pb + (size_t)(t + NWQ) * 128);
    }
#undef IDLOAD
}
__device__ __forceinline__ void p8c_combine(const Args& a, unsigned char* lds, int tid) {
    const u32x2* PB = (const u32x2*)(a.ws + WS_PB); unsigned* AB = (unsigned*)(a.ws + WS_AB); const u32x2* GATE = (const u32x2*)(a.ws + WS_GT); const float* SS = (const float*)(a.ws + WS_SS);
    const unsigned short* EIDX = (const unsigned short*)(a.ws + WS_EI); const float* su = (const float*)(a.ws + WS_USC); const float* sv = (const float*)(a.ws + WS_VSC);
    const size_t n4 = (size_t)NTOK * 128 / 4, nth = (size_t)gridDim.x * NTHR;
    LAS float* su_l = (LAS float*)lds; LAS float* sv_l = su_l + 16384;
    for (int i = tid; i < 16384 / 4; i += NTHR) { *(LAS f32x4*)(su_l + 4 * i) = *(const f32x4*)(su + 4 * i); *(LAS f32x4*)(sv_l + 4 * i) = *(const f32x4*)(sv + 4 * i); }
    __syncthreads();
    float calib;
    { unsigned a1 = 0u; a1 = __builtin_amdgcn_cvt_scalef32_pk_fp4_f32(a1, 1.0f, 1.0f, 1.0f, 0); a1 = __builtin_amdgcn_cvt_scalef32_pk_fp4_f32(a1, 1.0f, 1.0f, 1.0f, 1);
      a1 = __builtin_amdgcn_cvt_scalef32_pk_fp4_f32(a1, 1.0f, 1.0f, 1.0f, 2); a1 = __builtin_amdgcn_cvt_scalef32_pk_fp4_f32(a1, 1.0f, 1.0f, 1.0f, 3);
      unsigned b1 = (unsigned)__builtin_amdgcn_cvt_pk_fp8_f32(1.0f, 1.0f, 0, false); b1 = (unsigned)__builtin_amdgcn_cvt_pk_fp8_f32(1.0f, 1.0f, (int)b1, true);
      const v8i_t av = {(int)a1, (int)a1, (int)a1, (int)a1, 0, 0, 0, 0}, bv = {(int)b1, (int)b1, (int)b1, (int)b1, (int)b1, (int)b1, (int)b1, (int)b1};
      const f32x4 c = __builtin_amdgcn_mfma_scale_f32_16x16x128_f8f6f4(av, bv, (f32x4){0.f, 0.f, 0.f, 0.f}, 4, 0, 0, 0x7F7F7F7F, 0, 0x7F7F7F7F);
      calib = 128.0f / c[0] * (1.0f / X8SCALE); }
    for (size_t i = (size_t)blockIdx.x * NTHR + tid; i < n4; i += nth) {
        f32x4 d = {0.f, 0.f, 0.f, 0.f};
#pragma unroll
        for (int s2 = 0; s2 < 4; ++s2) { const u32x2 p = __builtin_nontemporal_load(PB + (size_t)s2 * n4 + i); d += (f32x4){bflo(p.x), bfhi(p.x), bflo(p.y), bfhi(p.y)}; }
        const u32x2 gw2 = __builtin_nontemporal_load(GATE + i); const f32x4 g = {bflo(gw2.x), bfhi(gw2.x), bflo(gw2.y), bfhi(gw2.y)}; const u32x2 ew = __builtin_nontemporal_load((const u32x2*)EIDX + i);
        const unsigned e[4] = {ew.x & 0xffffu, ew.x >> 16, ew.y & 0xffffu, ew.y >> 16}; float o[4];
        const float cr = calib / sqrtf(SS[i >> 5] * (1.0f / DM) + EPS);
#pragma unroll
        for (int j = 0; j < 4; ++j) { const float z = d[j] * su_l[e[j]] * cr; o[j] = 0.5f * z * (1.0f + erff(z * 0.70710678118654752f)) * g[j] * sv_l[e[j]]; }
        unsigned w8 = (unsigned)__builtin_amdgcn_cvt_pk_fp8_f32(o[0] * A8SCALE, o[1] * A8SCALE, 0, false); w8 = (unsigned)__builtin_amdgcn_cvt_pk_fp8_f32(o[2] * A8SCALE, o[3] * A8SCALE, (int)w8, true); AB[i] = w8;
    }
}
typedef int v2i_t __attribute__((ext_vector_type(2)));
constexpr int VROW = 144, VIMG = 128 * VROW;
struct VRec { u32x4 a8[2]; u32x2 h; };
__device__ __forceinline__ void v_token(const u32x4 (&w)[16], const VRec& rc, LAS unsigned char* vl  , float oscale, int lane, float* dst  , bool do_store) {
    const int seg = lane >> 3, c8 = lane & 7, i16 = lane & 15, q = lane >> 4;
#pragma unroll
    for (int j = 0; j < 16; ++j) *(LAS u32x4*)(vl + (seg * 16 + j) * VROW + c8 * 16) = w[j];
    asm volatile("s_waitcnt lgkmcnt(0)" ::: "memory");
    const v8i_t av = {(int)rc.a8[0].x, (int)rc.a8[0].y, (int)rc.a8[0].z, (int)rc.a8[0].w, (int)rc.a8[1].x, (int)rc.a8[1].y, (int)rc.a8[1].z, (int)rc.a8[1].w};
    const LAS unsigned char* rp = vl + (32 * q + i16) * VROW;
    float val[4] = {0.f, 0.f, 0.f, 0.f};
#pragma unroll
    for (int cb = 0; cb < 16; ++cb) {
        const v2i_t r1 = __builtin_amdgcn_ds_read_tr4_b64_v2i32((LAS v2i_t*)(rp + cb * 8)), r2 = __builtin_amdgcn_ds_read_tr4_b64_v2i32((LAS v2i_t*)(rp + 16 * VROW + cb * 8));
        const v8i_t bv = {r1.x, r1.y, r2.x, r2.y, 0, 0, 0, 0};
        const f32x4 acc = __builtin_amdgcn_mfma_scale_f32_16x16x128_f8f6f4(av, bv, (f32x4){0.f, 0.f, 0.f, 0.f}, 0  , 4  , 0, 0x7F7F7F7F, 0, 0x7F7F7F7F);
        const float a0 = acc[0]; val[cb & 3] = (q == (cb >> 2)) ? a0 : val[cb & 3];
    }
    asm volatile("s_waitcnt lgkmcnt(0)" ::: "memory");
    if (do_store) {
        *(GAS f32x4*)(sgpr_ptr((unsigned char*)dst) + (unsigned)lane * 16u) = (f32x4){bflo(rc.h.x) + val[0] * oscale, bfhi(rc.h.x) + val[1] * oscale, bflo(rc.h.y) + val[2] * oscale, bfhi(rc.h.y) + val[3] * oscale};
    } else asm volatile("" :: "v"(val[0]), "v"(val[1]), "v"(val[2]), "v"(val[3]));
}
__device__ __forceinline__ void p8b_v(const Args& a, unsigned char* lds, int lane, int wave, bool do_store) {
    const unsigned short* EIDX = (const unsigned short*)(a.ws + WS_EI); const unsigned char* AB = a.ws + WS_AB; const bf16_t* HB = (const bf16_t*)(a.ws + WS_HB);
    PEER_GEOM();
    const int seg = lane >> 3, c8 = lane & 7, q = lane >> 4;
    const unsigned char* Ts = a.ws + WS_UT + (size_t)(4 + s4) * SLICE4; const unsigned loff = c8 * 16;
    LAS unsigned char* vl = (LAS unsigned char*)lds + wave * VIMG;
    float oscale;
    { unsigned a1 = 0u; a1 = __builtin_amdgcn_cvt_scalef32_pk_fp4_f32(a1, 1.0f, 1.0f, 1.0f, 0); a1 = __builtin_amdgcn_cvt_scalef32_pk_fp4_f32(a1, 1.0f, 1.0f, 1.0f, 1);
      a1 = __builtin_amdgcn_cvt_scalef32_pk_fp4_f32(a1, 1.0f, 1.0f, 1.0f, 2); a1 = __builtin_amdgcn_cvt_scalef32_pk_fp4_f32(a1, 1.0f, 1.0f, 1.0f, 3);
      unsigned b1 = (unsigned)__builtin_amdgcn_cvt_pk_fp8_f32(1.0f, 1.0f, 0, false); b1 = (unsigned)__builtin_amdgcn_cvt_pk_fp8_f32(1.0f, 1.0f, (int)b1, true);
      const v8i_t av = {(int)b1, (int)b1, (int)b1, (int)b1, (int)b1, (int)b1, (int)b1, (int)b1}, bv = {(int)a1, (int)a1, (int)a1, (int)a1, 0, 0, 0, 0};
      const f32x4 c = __builtin_amdgcn_mfma_scale_f32_16x16x128_f8f6f4(av, bv, (f32x4){0.f, 0.f, 0.f, 0.f}, 0, 4, 0, 0x7F7F7F7F, 0, 0x7F7F7F7F);
      oscale = 128.0f / c[0] * (1.0f / A8SCALE); }
    const unsigned aoff = (unsigned)q * 16u, hoff = (unsigned)(s4 * 256 + 4 * lane) * 2u;
#define REC_LOAD(R, t) do { const GAS unsigned char* ab_ = sgpr_ptr(AB + (size_t)(t) * 128); R.a8[0] = __builtin_nontemporal_load((const GAS u32x4*)(ab_ + aoff)); R.a8[1] = __builtin_nontemporal_load((const GAS u32x4*)(ab_ + (64u + aoff))); \
        R.h = __builtin_nontemporal_load((const GAS u32x2*)(sgpr_ptr((const unsigned char*)(HB + (size_t)(t) * DM)) + hoff)); } while (0)
    PMeta mA, mB; u32x4 wA[16], wB[16]; VRec rA, rB;
    pm_load(mA, EIDX, TCL(t_beg), seg); pm_load(mB, EIDX, TCL(t_beg + NWQ), seg);
    rows16_load(wA, Ts, loff, mA); REC_LOAD(rA, TCL(t_beg));
    pm_load(mA, EIDX, TCL(t_beg + 2 * NWQ), seg);
    for (int t = t_beg; t < t_end; t += 2 * NWQ) {
        SCHED_FENCE();
        rows16_load(wB, Ts, loff, mB); REC_LOAD(rB, TCL(t + NWQ)); pm_load(mB, EIDX, TCL(t + 3 * NWQ), seg);
        SCHED_FENCE();
        v_token(wA, rA, vl, oscale, lane, a.out + (size_t)t * DM + s4 * 256, do_store);
        SCHED_FENCE();
        rows16_load(wA, Ts, loff, mA); REC_LOAD(rA, TCL(t + 2 * NWQ)); pm_load(mA, EIDX, TCL(t + 4 * NWQ), seg);
        SCHED_FENCE();
        if (t + NWQ < t_end) v_token(wB, rB, vl, oscale, lane, a.out + (size_t)(t + NWQ) * DM + s4 * 256, do_store);
    }
#undef REC_LOAD
#undef TCL
#undef PEER_GEOM
}

namespace pg8 {
#define PG8_LAS __attribute__((address_space(3)))
typedef unsigned short bf16_t;
typedef short bf16x8 __attribute__((ext_vector_type(8)));
typedef float f32x4 __attribute__((ext_vector_type(4)));
typedef unsigned u32x4 __attribute__((ext_vector_type(4)));
typedef int v4i_t __attribute__((ext_vector_type(4))); typedef int v8i_t __attribute__((ext_vector_type(8)));
constexpr int BM = 256, BK = 64, HALF = 128, HTB = HALF * BK * 2  , STAGE_BYTES = 8 * HTB, NXCD = 8, WGM = 8;

__host__ __device__ __forceinline__ int lds_byte(int r, int c) { const int st = (r >> 4) * 2 + (c >> 5), rr = r & 15, cc = c & 31, ob = rr * 64 + cc * 2; return st * 1024 + (ob ^ (((ob >> 9) & 1) << 5)); }
__host__ __device__ __forceinline__ void stage_rc(int b, int& R, int& C) { const int st = b / 1024, sb = b % 1024, swz = sb ^ (((sb >> 9) & 1) << 5); R = (st >> 1) * 16 + swz / 64; C = (st & 1) * 32 + (swz % 64) / 2; }
__host__ __device__ __forceinline__ int perm32(int rho) { const int n = rho >> 4, i = rho & 15; return 8 * (i >> 2) + 4 * n + (i & 3); }

struct Unit { int pm, pn; };
struct Gemm { const bf16_t* A; const bf16_t* Bt; int M, N, K; };

struct StaticOrder {
    int nM, nN, nwg, G, c;
    __host__ __device__ void init(int M, int N, int G_, int c_) { nM = M / BM; nN = N / BM; nwg = nM * nN; G = G_; c = c_; }
    __host__ __device__ bool next(int i, Unit& u) const {
        const long L = (long)i * G + c; if (L >= nwg) return false;
        int wgid = (int)L; { const int q = nwg / NXCD, r = nwg % NXCD, xcd = wgid % NXCD, off = wgid / NXCD; wgid = (xcd < r ? xcd * (q + 1) : r * (q + 1) + (xcd - r) * q) + off; }
        const int nig = WGM * nN, gid = wgid / nig, fm = gid * WGM, gsz = (nM - fm) < WGM ? (nM - fm) : WGM;
        u.pm = fm + ((wgid % nig) % gsz); u.pn = (wgid % nig) / gsz; return true;
    }
    __device__ __forceinline__ void a_ready(const Unit&) const {}
    __device__ __forceinline__ void done(const Unit&) const {}
};


__device__ __forceinline__ unsigned cvt_pk_bf16(float lo, float hi) { unsigned r; asm volatile("v_cvt_pk_bf16_f32 %0, %1, %2" : "=v"(r) : "v"(lo), "v"(hi)); return r; }
struct EpiInProj {
    static constexpr bool PERM = true, AFTER_DRAIN = false;
    bf16_t* O; bf16_t* QB; bf16_t* KB; bf16_t* VB; const float* rope; const float* qg; const float* kg;
    template <bool NORM> __device__ __forceinline__ void head_row(f32x4 a00, f32x4 a01, f32x4 a10, f32x4 a11, const float* g0, const float* g1, int t, int fq, bf16_t* dst  ) const {
        float x0[8] = {a00[0], a00[1], a00[2], a00[3], a01[0], a01[1], a01[2], a01[3]}, x1[8] = {a10[0], a10[1], a10[2], a10[3], a11[0], a11[1], a11[2], a11[3]};
        if (NORM) {
            float ss = 0.f;
#pragma unroll
            for (int e = 0; e < 8; ++e) ss += x0[e] * x0[e] + x1[e] * x1[e];
            ss += __shfl_xor(ss, 16); ss += __shfl_xor(ss, 32);
            const float rstd = 1.0f / sqrtf(ss * (1.0f / 64.0f) + 1e-6f);
            const float* r0 = rope + (((t >> 6) * 16 + (fq & 1) * 8) * 2); const float* r1 = rope + (((t & 63) * 16 + (fq & 1) * 8) * 2);
            f32x4 c0[4], c1[4];
#pragma unroll
            for (int q4 = 0; q4 < 4; ++q4) { c0[q4] = *(const f32x4*)(r0 + 4 * q4); c1[q4] = *(const f32x4*)(r1 + 4 * q4); }
#pragma unroll
            for (int e = 0; e < 8; ++e) { x0[e] *= rstd * g0[e]; x1[e] *= rstd * g1[e]; }
#pragma unroll
            for (int e = 0; e < 8; ++e) { const float o0 = __shfl_xor(x0[e], 32), o1 = __shfl_xor(x1[e], 32);
                const float cs0 = c0[e >> 1][(e & 1) * 2], sn0 = c0[e >> 1][(e & 1) * 2 + 1], cs1 = c1[e >> 1][(e & 1) * 2], sn1 = c1[e >> 1][(e & 1) * 2 + 1];
                x0[e] = (fq & 2) ? x0[e] * cs0 + o0 * sn0 : x0[e] * cs0 - o0 * sn0; x1[e] = (fq & 2) ? x1[e] * cs1 + o1 * sn1 : x1[e] * cs1 - o1 * sn1; }
        }
        u32x4 w; w.x = cvt_pk_bf16(x0[0], x0[1]); w.y = cvt_pk_bf16(x0[2], x0[3]); w.z = cvt_pk_bf16(x0[4], x0[5]); w.w = cvt_pk_bf16(x0[6], x0[7]); *(u32x4*)dst = w;
        w.x = cvt_pk_bf16(x1[0], x1[1]); w.y = cvt_pk_bf16(x1[2], x1[3]); w.z = cvt_pk_bf16(x1[4], x1[5]); w.w = cvt_pk_bf16(x1[6], x1[7]); *(u32x4*)(dst + 32) = w;
    }
    __device__ __forceinline__ void operator()(const f32x4 (&acc)[2][2][4][2], const Unit& u, int wr, int wc, int fr, int fq) const {
        const int row0 = u.pm * BM + wr * 64 + fr, pn = u.pn;
        if (pn < 2) {
            const int col0 = 256 * pn + wc * 32 + 8 * fq;
#pragma unroll
            for (int ai = 0; ai < 2; ++ai)
#pragma unroll
                for (int m = 0; m < 4; ++m) { bf16_t* rowp = O + (size_t)(row0 + ai * HALF + m * 16) * 1024 + col0;
#pragma unroll
                    for (int bj = 0; bj < 2; ++bj) { const f32x4 v0 = acc[ai][bj][m][0], v1 = acc[ai][bj][m][1];
                        u32x4 w; w.x = cvt_pk_bf16(v0[0], v0[1]); w.y = cvt_pk_bf16(v0[2], v0[3]); w.z = cvt_pk_bf16(v1[0], v1[1]); w.w = cvt_pk_bf16(v1[2], v1[3]);
                        *(u32x4*)(rowp + bj * HALF) = w; } }
        } else if (pn < 6) {
            const int col0 = 512 + 128 * (pn - 2) + wc * 32 + 8 * fq;
#pragma unroll
            for (int ai = 0; ai < 2; ++ai)
#pragma unroll
                for (int m = 0; m < 4; ++m) { const f32x4 v0 = acc[ai][0][m][0] * acc[ai][1][m][0], v1 = acc[ai][0][m][1] * acc[ai][1][m][1];
                    u32x4 w; w.x = cvt_pk_bf16(v0[0], v0[1]); w.y = cvt_pk_bf16(v0[2], v0[3]); w.z = cvt_pk_bf16(v1[0], v1[1]); w.w = cvt_pk_bf16(v1[2], v1[3]);
                    *(u32x4*)(O + (size_t)(row0 + ai * HALF + m * 16) * 1024 + col0) = w; }
        } else if (pn < 8) {
            float g0[8], g1[8];
#pragma unroll
            for (int e = 0; e < 8; ++e) { g0[e] = qg[8 * fq + e] * C2; g1[e] = qg[32 + 8 * fq + e] * C2; }
            const int hh = 4 * (pn - 6) + wc;
#pragma unroll
            for (int ai = 0; ai < 2; ++ai)
#pragma unroll
                for (int m = 0; m < 4; ++m) { const int r = row0 + ai * HALF + m * 16;
                    head_row<true>(acc[ai][0][m][0], acc[ai][0][m][1], acc[ai][1][m][0], acc[ai][1][m][1], g0, g1, r & 2047, fq, QB + (size_t)r * 512 + hh * 64 + 8 * fq); }
        } else {
            float g0[8], g1[8];
#pragma unroll
            for (int e = 0; e < 8; ++e) { g0[e] = kg[8 * fq + e]; g1[e] = kg[32 + 8 * fq + e]; }
            const int g = wc & 1;
#pragma unroll
            for (int ai = 0; ai < 2; ++ai)
#pragma unroll
                for (int m = 0; m < 4; ++m) { const int r = row0 + ai * HALF + m * 16, b = r >> 11, t = r & 2047; const size_t krow = ((size_t)(b * 2 + g) * KROWS + t) * 64 + 8 * fq;
                    if (wc < 2) head_row<true>(acc[ai][0][m][0], acc[ai][0][m][1], acc[ai][1][m][0], acc[ai][1][m][1], g0, g1, t, fq, KB + krow);
                    else head_row<false>(acc[ai][0][m][0], acc[ai][0][m][1], acc[ai][1][m][0], acc[ai][1][m][1], g0, g1, t, fq, VB + krow); }
        }
    }
};
struct EpiBf16 {
    static constexpr bool PERM = true, AFTER_DRAIN = false;
    bf16_t* O; int ldc; float scale;
    __device__ __forceinline__ void operator()(const f32x4 (&acc)[2][2][4][2], const Unit& u, int wr, int wc, int fr, int fq) const {
        const int row0 = u.pm * BM + wr * 64 + fr; const int col0 = u.pn * BM + wc * 32 + 8 * fq;
#pragma unroll
        for (int ai = 0; ai < 2; ++ai)
#pragma unroll
            for (int m = 0; m < 4; ++m) { bf16_t* rowp = O + (size_t)(row0 + ai * HALF + m * 16) * ldc + col0;
#pragma unroll
                for (int bj = 0; bj < 2; ++bj) { const f32x4 v0 = acc[ai][bj][m][0] * scale, v1 = acc[ai][bj][m][1] * scale;
                    u32x4 w; w.x = cvt_pk_bf16(v0[0], v0[1]); w.y = cvt_pk_bf16(v0[2], v0[3]); w.z = cvt_pk_bf16(v1[0], v1[1]); w.w = cvt_pk_bf16(v1[2], v1[3]);
                    *(u32x4*)(rowp + bj * HALF) = w; } }
    }
};
struct EpiResidNorm {
    static constexpr bool PERM = true, AFTER_DRAIN = false;
    const bf16_t* xh; const float* rs1; bf16_t* hb; unsigned char* h8; float* ss; float x8scale;
    __device__ __forceinline__ void operator()(const f32x4 (&acc)[2][2][4][2], const Unit& u, int wr, int wc, int fr, int fq) const {
        const int col0 = u.pn * BM + wc * 32 + 8 * fq, rbase = u.pm * BM + wr * 64 + fr;
        u32x4 xv[4][2]; float ir[2][4];
#pragma unroll
        for (int m = 0; m < 4; ++m) { ir[0][m] = rs1[rbase + m * 16]; ir[1][m] = rs1[rbase + HALF + m * 16];
#pragma unroll
            for (int bj = 0; bj < 2; ++bj) xv[m][bj] = *(const u32x4*)(xh + (size_t)(rbase + m * 16) * 1024 + col0 + bj * HALF); }
#pragma unroll
        for (int ai = 0; ai < 2; ++ai)
#pragma unroll
            for (int m = 0; m < 4; ++m) { const int r = rbase + ai * HALF + m * 16; const float iv = 1.0f / ir[ai][m];
                bf16_t* brow = hb + (size_t)r * 1024 + col0; unsigned char* qrow = h8 + (size_t)r * 1024 + col0; float s = 0.f;
                f32x4 h[2][2];
#pragma unroll
                for (int bj = 0; bj < 2; ++bj) { const u32x4 xw = xv[m][bj];
                    h[bj][0] = (f32x4){bflo(xw.x), bfhi(xw.x), bflo(xw.y), bfhi(xw.y)} * iv + acc[ai][bj][m][0]; h[bj][1] = (f32x4){bflo(xw.z), bfhi(xw.z), bflo(xw.w), bfhi(xw.w)} * iv + acc[ai][bj][m][1]; }
                if (ai == 0) {
#pragma unroll
                    for (int bj = 0; bj < 2; ++bj) xv[m][bj] = *(const u32x4*)(xh + (size_t)(r + HALF) * 1024 + col0 + bj * HALF); }
#pragma unroll
                for (int bj = 0; bj < 2; ++bj) { const f32x4 h0 = h[bj][0], h1 = h[bj][1];
                    u32x4 wb; wb.x = cvt_pk_bf16(h0[0], h0[1]); wb.y = cvt_pk_bf16(h0[2], h0[3]); wb.z = cvt_pk_bf16(h1[0], h1[1]); wb.w = cvt_pk_bf16(h1[2], h1[3]); *(u32x4*)(brow + bj * HALF) = wb;
                    unsigned w0 = (unsigned)__builtin_amdgcn_cvt_pk_fp8_f32(h0[0] * x8scale, h0[1] * x8scale, 0, false); w0 = (unsigned)__builtin_amdgcn_cvt_pk_fp8_f32(h0[2] * x8scale, h0[3] * x8scale, (int)w0, true);
                    unsigned w1 = (unsigned)__builtin_amdgcn_cvt_pk_fp8_f32(h1[0] * x8scale, h1[1] * x8scale, 0, false); w1 = (unsigned)__builtin_amdgcn_cvt_pk_fp8_f32(h1[2] * x8scale, h1[3] * x8scale, (int)w1, true);
                    *(u32x2*)(qrow + bj * HALF) = (u32x2){w0, w1};
                    s += ((h0[0] * h0[0] + h0[1] * h0[1]) + (h0[2] * h0[2] + h0[3] * h0[3])) + ((h1[0] * h1[0] + h1[1] * h1[1]) + (h1[2] * h1[2] + h1[3] * h1[3])); }
                s += __shfl_xor(s, 16); s += __shfl_xor(s, 32);
                if (fq == 0) atomicAdd(ss + r, s); }
    }
};
struct EpiResid {
    static constexpr bool PERM = false, AFTER_DRAIN = false;
    const float* xp; const float* xs; float* out; int split_row;
    __device__ __forceinline__ void operator()(const f32x4 (&acc)[2][2][4][2], const Unit& u, int wr, int wc, int fr, int fq) const {
        const int col0 = u.pn * BM + wc * 32 + 4 * fq;
#pragma unroll
        for (int ai = 0; ai < 2; ++ai)
#pragma unroll
            for (int m = 0; m < 4; ++m) { const int r = u.pm * BM + ai * HALF + wr * 64 + m * 16 + fr;
                const float* xr = (r < split_row ? xp + (size_t)r * 1024 : xs + (size_t)(r - split_row) * 1024) + col0; float* orow = out + (size_t)r * 1024 + col0;
#pragma unroll
                for (int bj = 0; bj < 2; ++bj)
#pragma unroll
                    for (int n = 0; n < 2; ++n) { const f32x4 bs = *(const f32x4*)(xr + bj * HALF + n * 16); *(f32x4*)(orow + bj * HALF + n * 16) = bs + acc[ai][bj][m][n]; } }
    }
};

template <class Epi, class Sched, bool ALIGN_EPI = false, bool SP2 = false, bool FP8 = false>
__device__ __forceinline__ void gemm_phase(PG8_LAS unsigned char* lds, const Gemm g, const Sched& S, const Epi& E) {
    const int tid = threadIdx.x, wid = __builtin_amdgcn_readfirstlane(tid >> 6), lane = tid & 63, wr = wid >> 2, wc = wid & 3, fr = lane & 15, fq = lane >> 4;
    const int K = g.K, nt = K / BK;
    unsigned voffA[2], voffB[2];
#pragma unroll
    for (int i = 0; i < 2; ++i) { int R, C; stage_rc(tid * 16 + i * 8192, R, C); const int Rb = Epi::PERM ? ((R & ~31) + perm32(R & 31)) : R;
        voffA[i] = (unsigned)(R * K + C) * 2u; voffB[i] = (unsigned)(Rb * K + C) * 2u; }
    const size_t kstep = (size_t)(BK * 2);
    const size_t hstep = (size_t)HALF * K * 2;
    const size_t tstep = 2 * hstep;
    const unsigned ldsw = (unsigned)wid * 1024u;
    const int aoff = lds_byte(wr * 64 + fr, fq * 8), boff = lds_byte(wc * 32 + fr, fq * 8);
#define PG8_SA(b, h) (((b) * 2 + (h)) * HTB)
#define PG8_SB(b, h) ((4 + (b) * 2 + (h)) * HTB)
#define PG8_STAGE(bufoff, gbase, voff) do { _Pragma("unroll") for (int _i = 0; _i < 2; ++_i) \
        __builtin_amdgcn_global_load_lds((const unsigned*)((const char*)(gbase) + (voff)[_i]), (PG8_LAS unsigned*)(lds + (bufoff) + ldsw + _i * 8192), 16, 0, 0); } while (0)
#define PG8_LDA(dst, b, h) do { if constexpr (FP8) { _Pragma("unroll") for (int m = 0; m < 4; ++m) dst##8[m] = __builtin_shufflevector(*(const PG8_LAS v4i_t*)(lds + PG8_SA(b, h) + aoff + m * 2048), *(const PG8_LAS v4i_t*)(lds + PG8_SA(b, h) + aoff + m * 2048 + 1024), 0, 1, 2, 3, 4, 5, 6, 7); } \
        else { _Pragma("unroll") for (int m = 0; m < 4; ++m) _Pragma("unroll") for (int k = 0; k < 2; ++k) dst[m][k] = *(const PG8_LAS bf16x8*)(lds + PG8_SA(b, h) + aoff + m * 2048 + k * 1024); } } while (0)
#define PG8_LDB(dst, b, h) do { if constexpr (FP8) { _Pragma("unroll") for (int n = 0; n < 2; ++n) dst##8[n] = __builtin_shufflevector(*(const PG8_LAS v4i_t*)(lds + PG8_SB(b, h) + boff + n * 2048), *(const PG8_LAS v4i_t*)(lds + PG8_SB(b, h) + boff + n * 2048 + 1024), 0, 1, 2, 3, 4, 5, 6, 7); } \
        else { _Pragma("unroll") for (int n = 0; n < 2; ++n) _Pragma("unroll") for (int k = 0; k < 2; ++k) dst[n][k] = *(const PG8_LAS bf16x8*)(lds + PG8_SB(b, h) + boff + n * 2048 + k * 1024); } } while (0)
#define PG8_MMA(ai, bj, At, Bt) do { __builtin_amdgcn_s_setprio(1); _Pragma("unroll") for (int m = 0; m < 4; ++m) _Pragma("unroll") for (int n = 0; n < 2; ++n) { \
        if constexpr (FP8) { asm volatile("v_mfma_scale_f32_16x16x128_f8f6f4 %0, %1, %2, %0, %3, %3 op_sel_hi:[0,0,0]" : "+v"(acc[ai][bj][m][n]) : "v"(Bt##8[n]), "v"(At##8[m]), "v"(mfma_one)); } \
        else { _Pragma("unroll") for (int k = 0; k < 2; ++k) acc[ai][bj][m][n] = __builtin_amdgcn_mfma_f32_16x16x32_bf16(Bt[n][k], At[m][k], acc[ai][bj][m][n], 0, 0, 0); } } __builtin_amdgcn_s_setprio(0); } while (0)
#define PG8_WAIT_V(n) asm volatile("s_waitcnt vmcnt(" #n ")" ::: "memory")
#define PG8_WAIT_L(n) asm volatile("s_waitcnt lgkmcnt(" #n ")" ::: "memory")
#define PG8_BAR __builtin_amdgcn_s_barrier()
#define PG8_SCHED __builtin_amdgcn_sched_barrier(0)
    Unit cur, nxt; int ui = 0;
    if (!S.next(0, cur)) return;
    f32x4 acc[2][2][4][2];
#pragma unroll
    for (int a = 0; a < 2; ++a)
#pragma unroll
        for (int b = 0; b < 2; ++b)
#pragma unroll
            for (int m = 0; m < 4; ++m)
#pragma unroll
                for (int n = 0; n < 2; ++n) acc[a][b][m][n] = (f32x4){0.f, 0.f, 0.f, 0.f};
    const int mfma_one = 0x7F7F7F7F;
    bf16x8 At[4][2], B0[2][2], B1[2][2]; v8i_t At8[4], B08[2], B18[2];
    const char* cA = (const char*)g.A + (size_t)cur.pm * tstep; const char* cB = (const char*)g.Bt + (size_t)cur.pn * tstep;
    S.a_ready(cur);
    if constexpr (SP2) {
        PG8_STAGE(PG8_SB(0, 0), cB, voffB); PG8_STAGE(PG8_SB(0, 1), cB + hstep, voffB); PG8_STAGE(PG8_SA(0, 0), cA, voffA); PG8_STAGE(PG8_SA(0, 1), cA + hstep, voffA);
        if (wr == 1) PG8_BAR;
        PG8_WAIT_V(2); PG8_BAR;
        PG8_STAGE(PG8_SB(1, 0), cB + kstep, voffB); PG8_STAGE(PG8_SA(1, 0), cA + kstep, voffA); PG8_STAGE(PG8_SB(1, 1), cB + hstep + kstep, voffB);
        PG8_WAIT_V(6); PG8_BAR;
    } else {
        PG8_STAGE(PG8_SB(0, 0), cB, voffB); PG8_STAGE(PG8_SA(0, 0), cA, voffA); PG8_STAGE(PG8_SB(0, 1), cB + hstep, voffB); PG8_STAGE(PG8_SA(0, 1), cA + hstep, voffA);
        if (wr == 1) PG8_BAR;
        PG8_WAIT_V(4); PG8_BAR;
        PG8_STAGE(PG8_SB(1, 0), cB + kstep, voffB); PG8_STAGE(PG8_SA(1, 0), cA + kstep, voffA); PG8_STAGE(PG8_SB(1, 1), cB + hstep + kstep, voffB);
        PG8_WAIT_V(6); PG8_BAR;
    }
    for (;;) {
        const bool has_next = S.next(ui + 1, nxt);
        const char* nA = has_next ? (const char*)g.A + (size_t)nxt.pm * tstep : cA; const char* nB = has_next ? (const char*)g.Bt + (size_t)nxt.pn * tstep : cB;
#pragma nounroll
        for (int t = 0; t < nt; t += 2) {
            const bool last = (t == nt - 2);
            const char* a1 = cA + (size_t)(t + 1) * kstep;
            const char* a2 = last ? nA : cA + (size_t)(t + 2) * kstep; const char* b2 = last ? nB : cB + (size_t)(t + 2) * kstep;
            const char* a3 = a2 + kstep; const char* b3 = b2 + kstep;
            if (last && has_next) S.a_ready(nxt);
            if constexpr (SP2) {
            PG8_LDB(B0, 0, 0); PG8_LDB(B1, 0, 1); PG8_SCHED; PG8_LDA(At, 0, 0); PG8_STAGE(PG8_SA(1, 1), a1 + hstep, voffA);
            PG8_WAIT_V(8); PG8_WAIT_L(0); PG8_BAR; PG8_MMA(0, 0, At, B0); PG8_MMA(0, 1, At, B1); PG8_BAR; PG8_SCHED;
            PG8_LDA(At, 0, 1); PG8_STAGE(PG8_SB(0, 0), b2, voffB); PG8_STAGE(PG8_SB(0, 1), b2 + hstep, voffB); PG8_STAGE(PG8_SA(0, 0), a2, voffA);
            PG8_WAIT_V(8); PG8_WAIT_L(0); PG8_BAR; PG8_MMA(1, 0, At, B0); PG8_MMA(1, 1, At, B1); PG8_BAR; PG8_SCHED;
            PG8_LDB(B0, 1, 0); PG8_LDB(B1, 1, 1); PG8_SCHED; PG8_LDA(At, 1, 0); PG8_STAGE(PG8_SA(0, 1), a2 + hstep, voffA);
            PG8_WAIT_V(8); PG8_WAIT_L(0); PG8_BAR; PG8_MMA(0, 0, At, B0); PG8_MMA(0, 1, At, B1); PG8_BAR; PG8_SCHED;
            PG8_LDA(At, 1, 1); PG8_STAGE(PG8_SB(1, 0), b3, voffB); PG8_STAGE(PG8_SB(1, 1), b3 + hstep, voffB); PG8_STAGE(PG8_SA(1, 0), a3, voffA);
            PG8_WAIT_V(8); PG8_WAIT_L(0); PG8_BAR; PG8_MMA(1, 0, At, B0); PG8_MMA(1, 1, At, B1); PG8_BAR; PG8_SCHED;
            } else {
            PG8_LDB(B0, 0, 0); PG8_SCHED; PG8_LDA(At, 0, 0); PG8_STAGE(PG8_SA(1, 1), a1 + hstep, voffA);
            PG8_WAIT_L(8); PG8_BAR; PG8_WAIT_L(0); PG8_MMA(0, 0, At, B0); PG8_BAR; PG8_SCHED;
            PG8_LDB(B1, 0, 1); PG8_STAGE(PG8_SB(0, 0), b2, voffB);
            PG8_BAR; PG8_WAIT_L(0); PG8_MMA(0, 1, At, B1); PG8_BAR;
            PG8_LDA(At, 0, 1); PG8_STAGE(PG8_SA(0, 0), a2, voffA);
            PG8_BAR; PG8_WAIT_L(0); PG8_MMA(1, 0, At, B0); PG8_BAR; PG8_SCHED;
            PG8_STAGE(PG8_SB(0, 1), b2 + hstep, voffB);
            PG8_WAIT_V(6); PG8_BAR; PG8_MMA(1, 1, At, B1); PG8_BAR;
            PG8_LDB(B0, 1, 0); PG8_SCHED; PG8_LDA(At, 1, 0); PG8_STAGE(PG8_SA(0, 1), a2 + hstep, voffA);
            PG8_WAIT_L(8); PG8_BAR; PG8_WAIT_L(0); PG8_MMA(0, 0, At, B0); PG8_BAR; PG8_SCHED;
            PG8_LDB(B1, 1, 1); PG8_STAGE(PG8_SB(1, 0), b3, voffB);
            PG8_BAR; PG8_WAIT_L(0); PG8_MMA(0, 1, At, B1); PG8_BAR;
            PG8_LDA(At, 1, 1); PG8_STAGE(PG8_SA(1, 0), a3, voffA);
            PG8_BAR; PG8_WAIT_L(0); PG8_MMA(1, 0, At, B0); PG8_BAR; PG8_SCHED;
            PG8_STAGE(PG8_SB(1, 1), b3 + hstep, voffB);
            PG8_WAIT_V(6); PG8_BAR; PG8_MMA(1, 1, At, B1); PG8_BAR;
            }
        }
        if constexpr (ALIGN_EPI) { if (wr == 0) PG8_BAR; }
        if constexpr (FP8) asm volatile("s_nop 15\n\ts_nop 15" ::: "memory");
        if constexpr (!Epi::AFTER_DRAIN) { E(acc, cur, wr, wc, fr, fq); S.done(cur); }
        if (!has_next) break;
#pragma unroll
        for (int a = 0; a < 2; ++a)
#pragma unroll
            for (int b = 0; b < 2; ++b)
#pragma unroll
                for (int m = 0; m < 4; ++m)
#pragma unroll
                    for (int n = 0; n < 2; ++n) acc[a][b][m][n] = (f32x4){0.f, 0.f, 0.f, 0.f};
        if constexpr (FP8) asm volatile("s_nop 7" ::: "memory");
        cur = nxt; cA = nA; cB = nB; ++ui;
        if constexpr (ALIGN_EPI) { if (wr == 1) PG8_BAR; }
    }
    PG8_WAIT_V(0);
    if constexpr (!ALIGN_EPI) { if (wr == 0) PG8_BAR; }
    PG8_BAR;
    if constexpr (Epi::AFTER_DRAIN) { E.fused(acc, cur, wr, wc, fr, fq, lds, wid, lane); S.done(cur); }
#undef PG8_SA
#undef PG8_SB
#undef PG8_STAGE
#undef PG8_LDA
#undef PG8_LDB
#undef PG8_MMA
#undef PG8_WAIT_V
#undef PG8_WAIT_L
#undef PG8_BAR
#undef PG8_SCHED
}
}


#include <hip/hip_bf16.h>
#include <cmath>
namespace attn_body {
using bf16=__hip_bfloat16;
using bf16x8=__attribute__((ext_vector_type(8)))short;
using s16x4=__attribute__((ext_vector_type(4)))short;
using f32x16=__attribute__((ext_vector_type(16)))float;
using u32x4=__attribute__((ext_vector_type(4)))unsigned;
constexpr int SEQ=2048,D=64,QP=512,KVP=64,OP=1024,KVROWS=2112;
constexpr int NW=8,QBLK=32,QB=QBLK*NW,KVBLK=64,NQB=SEQ/QB,NT=KVROWS/KVBLK;
constexpr int ATTN_UNIT_ROWS=QB;
__device__ __forceinline__ int crow(int r,int hi){return (r&3)+8*(r>>2)+4*hi;}
#define SBAR() __builtin_amdgcn_sched_barrier(0)
__device__ __forceinline__ void tmask(f32x16&p0,f32x16&p1){
  const float NEG=-INFINITY;
  #pragma unroll
  for(int r=8;r<16;++r)p0[r]=NEG;
  #pragma unroll
  for(int r=0;r<16;++r)p1[r]=NEG;
}

constexpr int NSLOT=3, SLOTB=8192;
constexpr int LDS_K=0, LDS_V=NSLOT*SLOTB, LDS_WS=2*NSLOT*SLOTB, LDS_OST=LDS_WS+NW*64*4, LDS_BYTES=LDS_OST+NW*4096;
constexpr float C2=0.125f*1.4426950408889634f;
__device__ __forceinline__ void glds16(const void*gsrc,unsigned lds_dst){unsigned keep;
  asm volatile("s_mov_b32 %0, m0\n\ts_mov_b32 m0, %2\n\ts_nop 0\n\tglobal_load_lds_dwordx4 %1, off\n\ts_mov_b32 m0, %0":"=&s"(keep):"v"(gsrc),"s"(lds_dst):"memory");}
__device__ __forceinline__ float max3f(float a,float b,float c){float r;asm("v_max3_f32 %0, %1, %2, %3":"=v"(r):"v"(a),"v"(b),"v"(c));return r;}
__device__ __forceinline__ float max2f(float a,float b){float r;asm("v_max_f32_e32 %0, %1, %2":"=v"(r):"v"(a),"v"(b));return r;}
__device__ __forceinline__ float fadd_s(float a,float b){float r;asm("v_add_f32_e32 %0, %1, %2":"=v"(r):"v"(a),"v"(b));return r;}
__device__ __forceinline__ float fsub_s(float a,float b){float r;asm("v_sub_f32_e32 %0, %1, %2":"=v"(r):"v"(a),"v"(b));return r;}
typedef float f32x2_t __attribute__((ext_vector_type(2))); typedef float f32x4_t __attribute__((ext_vector_type(4))); typedef __bf16 bf16x2_t __attribute__((ext_vector_type(2)));
__device__ __forceinline__ unsigned cvtpk_s(float lo,float hi){f32x2_t v={lo,hi};bf16x2_t b=__builtin_convertvector(v,bf16x2_t);return __builtin_bit_cast(unsigned,b);}
#define WAIT_BAR(N) asm volatile("s_waitcnt vmcnt(" #N ") lgkmcnt(0)\n\ts_barrier":::"memory")

__device__ __forceinline__ void qkt(f32x16&p0,f32x16&p1,const char*Kslot,const bf16x8*qr,const f32x16&negm,int r32,int hi){
  const char*kb=Kslot+hi*1024+r32*16;
  #pragma unroll
  for(int d0=0;d0<4;++d0){
    const bf16x8 b0=*reinterpret_cast<const bf16x8*>(kb+d0*2048);
    const bf16x8 b1=*reinterpret_cast<const bf16x8*>(kb+d0*2048+512);
    if(d0==0){p0=__builtin_amdgcn_mfma_f32_32x32x16_bf16(b0,qr[0],negm,0,0,0);p1=__builtin_amdgcn_mfma_f32_32x32x16_bf16(b1,qr[0],negm,0,0,0);}
    else{p0=__builtin_amdgcn_mfma_f32_32x32x16_bf16(b0,qr[d0],p0,0,0,0);p1=__builtin_amdgcn_mfma_f32_32x32x16_bf16(b1,qr[d0],p1,0,0,0);}}
}
typedef __attribute__((address_space(3))) const char* lds_cptr;
typedef short v4i16_t __attribute__((ext_vector_type(4)));
__device__ __forceinline__ void kload8(bf16x8*kf,lds_cptr kp){
  kf[0]=*(const __attribute__((address_space(3))) bf16x8*)(kp);      kf[1]=*(const __attribute__((address_space(3))) bf16x8*)(kp+512);
  kf[2]=*(const __attribute__((address_space(3))) bf16x8*)(kp+2048); kf[3]=*(const __attribute__((address_space(3))) bf16x8*)(kp+2560);
  kf[4]=*(const __attribute__((address_space(3))) bf16x8*)(kp+4096); kf[5]=*(const __attribute__((address_space(3))) bf16x8*)(kp+4608);
  kf[6]=*(const __attribute__((address_space(3))) bf16x8*)(kp+6144); kf[7]=*(const __attribute__((address_space(3))) bf16x8*)(kp+6656);
}
__device__ __forceinline__ void kload2(bf16x8*kf,lds_cptr kp,int j){ kf[2*j]=*(const __attribute__((address_space(3))) bf16x8*)(kp+j*2048); kf[2*j+1]=*(const __attribute__((address_space(3))) bf16x8*)(kp+j*2048+512); }
__device__ __forceinline__ s16x4 vtr(lds_cptr p){ return __builtin_bit_cast(s16x4,__builtin_amdgcn_ds_read_tr16_b64_v4i16((__attribute__((address_space(3))) v4i16_t*)p)); }
__device__ __forceinline__ float rowmax(const f32x16&p0,const f32x16&p1){
  float a=max3f(p0[0],p0[1],p1[0]),b=max3f(p0[2],p0[3],p1[1]);a=max3f(a,p1[2],p1[3]);
  #pragma unroll
  for(int r=4;r<16;r+=4){a=max3f(a,p0[r],p0[r+1]);b=max3f(b,p0[r+2],p0[r+3]);a=max3f(a,p1[r],p1[r+1]);b=max3f(b,p1[r+2],p1[r+3]);}
  const float m=max2f(a,b);
  auto rr=__builtin_amdgcn_permlane32_swap(__float_as_uint(m),__float_as_uint(m),false,false);
  return max2f(__uint_as_float(rr[0]),__uint_as_float(rr[1]));
}
__device__ __forceinline__ void pv(f32x16*o,int vb,bf16x8 pa0,bf16x8 pa1,bf16x8 pa2,bf16x8 pa3){
  #pragma unroll
  for(int d0=0;d0<2;++d0){s16x4 lo[4],hi[4];
    #pragma unroll
    for(int ks=0;ks<4;++ks){
      asm volatile("ds_read_b64_tr_b16 %0,%1 offset:%c2":"=&v"(lo[ks]):"v"(vb),"i"(d0*4096+ks*1024):"memory");
      asm volatile("ds_read_b64_tr_b16 %0,%1 offset:%c2":"=&v"(hi[ks]):"v"(vb),"i"(d0*4096+ks*1024+512):"memory");}
    asm volatile("s_waitcnt lgkmcnt(0)":::"memory");SBAR();
    #define PK(k) (bf16x8){lo[k][0],lo[k][1],lo[k][2],lo[k][3],hi[k][0],hi[k][1],hi[k][2],hi[k][3]}
    o[d0]=__builtin_amdgcn_mfma_f32_32x32x16_bf16(pa0,PK(0),o[d0],0,0,0);
    o[d0]=__builtin_amdgcn_mfma_f32_32x32x16_bf16(pa1,PK(1),o[d0],0,0,0);
    o[d0]=__builtin_amdgcn_mfma_f32_32x32x16_bf16(pa2,PK(2),o[d0],0,0,0);
    o[d0]=__builtin_amdgcn_mfma_f32_32x32x16_bf16(pa3,PK(3),o[d0],0,0,0);
    #undef PK
  }
}

#ifndef ATTN_STORE16
#define ATTN_STORE16(p,v) (*(u32x4*)(p)=(v))
#endif
template<int THRL> __device__ __forceinline__ void attn_unit(int b,int h,int qb,const bf16*Q,const bf16*__restrict__ K,const bf16*__restrict__ V,bf16*O,const float*__restrict__ gain,char*shm){
  const int tid=threadIdx.x,lane=tid&63,r32=lane&31,hi=lane>>5; const int wid=__builtin_amdgcn_readfirstlane(tid>>6);
  const long rowbase=(long)b*SEQ; const int q0=qb*QB;
  const bf16*Qw=Q+(rowbase+q0+wid*QBLK)*QP+h*D;
  const bf16*Kh=K+(long)(b*2+(h>>2))*KVROWS*KVP,*Vh=V+(long)(b*2+(h>>2))*KVROWS*KVP;
  const unsigned lds0=(unsigned)(uintptr_t)shm;
  float*wsf=(float*)(shm+LDS_WS)+wid*64;
  const bf16*ksrc=Kh+(long)lane*KVP+wid*8;
  const bf16*vsrc=Vh+(long)(16*(wid&3)+(lane>>2))*KVP+(wid>>2)*32+(lane&3)*8;
  const unsigned kdst=lds0+LDS_K+wid*1024, vdst=lds0+LDS_V+wid*1024;
  #define DMA_K(t,slot) glds16(ksrc+(long)(t)*KVBLK*KVP,(unsigned)__builtin_amdgcn_readfirstlane(kdst+(slot)))
  #define DMA_V(t,slot) glds16(vsrc+(long)(t)*KVBLK*KVP,(unsigned)__builtin_amdgcn_readfirstlane(vdst+(slot)))
  const int vb0=(int)(lds0+LDS_V)+((lane>>4)&1)*32+(lane&3)*8+(4*hi+((lane&15)>>2))*64;
  const char*Kbase=shm+LDS_K; bf16x8 kf[8];
  const lds_cptr shm3=(lds_cptr)shm; const lds_cptr kp0=shm3+LDS_K+hi*1024+r32*16; const lds_cptr vp0=shm3+LDS_V+((lane>>4)&1)*32+(lane&3)*8+(4*hi+((lane&15)>>2))*64;
  DMA_K(0,0);DMA_V(0,0);DMA_K(1,SLOTB);
  bf16x8 qr[4];
  #pragma unroll
  for(int d0=0;d0<4;++d0)qr[d0]=*reinterpret_cast<const bf16x8*>(&Qw[(long)r32*QP+d0*16+hi*8]);
  float mhat=0.f,l_reg=0.f;f32x16 o[2];o[0]=f32x16{};o[1]=f32x16{};f32x16 negm=f32x16{};asm volatile("":"+v"(negm));
  #define CMASK(P0,P1,t) do{}while(0)
  bool resc=false;
  #define START(P0,P1) do{ const float rm=rowmax(P0,P1); resc=false; \
    { const float dl=rm; mhat=fadd_s(mhat,dl); \
      _Pragma("unroll") for(int r=0;r<16;++r){P0[r]=fsub_s(P0[r],dl);P1[r]=fsub_s(P1[r],dl);} \
      _Pragma("unroll") for(int r=0;r<16;++r)negm[r]=-mhat; asm volatile("":"+v"(negm)); } \
    _Pragma("unroll") for(int r=0;r<16;++r)P0[r]=__builtin_amdgcn_exp2f(P0[r]); }while(0)
  #define RESC() do{ if(resc){ asm volatile("s_waitcnt lgkmcnt(0)":::"memory"); \
      _Pragma("unroll") for(int d_=0;d_<2;++d_) _Pragma("unroll") for(int r=0;r<16;++r)o[d_][r]*=wsf[crow(r,hi)]; } }while(0)
  f32x16 pA0,pA1,pB0,pB1;
  int sl_prev=0,sl_cur=0,sl_next=SLOTB;
  #define ROT() do{sl_prev=sl_cur;sl_cur=sl_next;sl_next=(sl_next==(NSLOT-1)*SLOTB)?0:sl_next+SLOTB;}while(0)
  DMA_K(2,2*SLOTB);
  WAIT_BAR(3);
  qkt(pA0,pA1,Kbase,qr,negm,r32,hi);asm volatile("s_nop 15\n\ts_nop 7":"+v"(pA0),"+v"(pA1));CMASK(pA0,pA1,0);
  START(pA0,pA1);
  _Pragma("unroll") for(int r=0;r<16;++r)pA1[r]=__builtin_amdgcn_exp2f(pA1[r]);
  WAIT_BAR(0);
  DMA_K(3,0);DMA_V(1,SLOTB);
  ROT();
  kload8(kf,kp0+sl_cur);
  WAIT_BAR(2);
  s16x4 vlo[8],vhi[8]; u32x4 pw0,pw1,pw2,pw3;
  #define PKW(P,B) cvtpk_s(P[B],P[B+1])
  #define PAF(k) __builtin_bit_cast(bf16x8,pw##k)
  #define VFR(i) (bf16x8){vlo[i][0],vlo[i][1],vlo[i][2],vlo[i][3],vhi[i][0],vhi[i][1],vhi[i][2],vhi[i][3]}
  #define PIN(x) asm volatile("":"+v"(x))
  #define MX3(a,b,c) __builtin_fmaxf(__builtin_fmaxf((a),(b)),(c))
  #define GAPA(MF,A0,A1,A2,A3,W0,W1,PW) do{ MF; sacc+=A0; sacc+=A1; sacc+=A2; sacc+=A3; PIN(sacc); W0; W1; PIN(PW); SBAR(); }while(0)
  #define EX(v) __builtin_amdgcn_exp2f(v)
  #define GAPB(MF,X,B) do{ MF; X[B]=EX(X[B]); X[B+1]=EX(X[B+1]); X[B+2]=EX(X[B+2]); X[B+3]=EX(X[B+3]); PIN(X); SBAR(); }while(0)
  #define VRD(i) do{ vlo[i]=vtr(vp_+(((i)>>2)*4096+((i)&3)*1024)); vhi[i]=vtr(vp_+(((i)>>2)*4096+((i)&3)*1024+512)); }while(0)
  #define KRD(G,j) do{ if(G){ kload2(kf,kp0+sl_next,j); SBAR(); } }while(0)
  #define STEP(C0,C1,P0,P1,t,GK,GV,GL) do{ SBAR(); \
    const lds_cptr vp_=vp0+sl_prev; \
    VRD(0); SBAR(); float sacc=(P0[0]+P0[1]); \
    GAPA(C0=__builtin_amdgcn_mfma_f32_32x32x16_bf16(kf[0],qr[0],negm,0,0,0), P0[2],P0[3],P0[4],P0[5],     pw0[0]=PKW(P0,0), pw0[1]=PKW(P0,2), pw0); \
    VRD(4); SBAR(); GAPA(C1=__builtin_amdgcn_mfma_f32_32x32x16_bf16(kf[1],qr[0],negm,0,0,0), P0[6],P0[7],P0[8],P0[9],     pw0[2]=PKW(P0,4), pw0[3]=PKW(P0,6), pw0); \
    VRD(1); SBAR(); GAPA(C0=__builtin_amdgcn_mfma_f32_32x32x16_bf16(kf[2],qr[1],C0,0,0,0),   P0[10],P0[11],P0[12],P0[13], pw1[0]=PKW(P0,8), pw1[1]=PKW(P0,10), pw1); \
    VRD(5); SBAR(); GAPA(C1=__builtin_amdgcn_mfma_f32_32x32x16_bf16(kf[3],qr[1],C1,0,0,0),   P0[14],P0[15],P1[0],P1[1],   pw1[2]=PKW(P0,12),pw1[3]=PKW(P0,14), pw1); \
    VRD(2); SBAR(); GAPA(C0=__builtin_amdgcn_mfma_f32_32x32x16_bf16(kf[4],qr[2],C0,0,0,0),   P1[2],P1[3],P1[4],P1[5],     pw2[0]=PKW(P1,0), pw2[1]=PKW(P1,2), pw2); \
    VRD(6); SBAR(); GAPA(C1=__builtin_amdgcn_mfma_f32_32x32x16_bf16(kf[5],qr[2],C1,0,0,0),   P1[6],P1[7],P1[8],P1[9],     pw2[2]=PKW(P1,4), pw2[3]=PKW(P1,6), pw2); \
    VRD(3); SBAR(); GAPA(C0=__builtin_amdgcn_mfma_f32_32x32x16_bf16(kf[6],qr[3],C0,0,0,0),   P1[10],P1[11],P1[12],P1[13], pw3[0]=PKW(P1,8), pw3[1]=PKW(P1,10), pw3); \
    VRD(7); SBAR(); GAPA(C1=__builtin_amdgcn_mfma_f32_32x32x16_bf16(kf[7],qr[3],C1,0,0,0),   P1[14],P1[15],0.f,0.f,       pw3[2]=PKW(P1,12),pw3[3]=PKW(P1,14), pw3); \
    l_reg+=sacc; \
    if(GK){DMA_K((t)+3,sl_cur);} if(GV){DMA_V((t)+1,sl_next);} \
    CMASK(C0,C1,t); \
    { float a=MX3(C0[0],C0[1],C1[0]),b=MX3(C0[2],C0[3],C1[1]); a=MX3(a,C1[2],C1[3]); \
      _Pragma("unroll") for(int r=4;r<16;r+=4){a=MX3(a,C0[r],C0[r+1]);b=MX3(b,C0[r+2],C0[r+3]);a=MX3(a,C1[r],C1[r+1]);b=MX3(b,C1[r+2],C1[r+3]);} \
      float rm=__builtin_fmaxf(a,b); { auto rr=__builtin_amdgcn_permlane32_swap(__float_as_uint(rm),__float_as_uint(rm),false,false); rm=__builtin_fmaxf(__uint_as_float(rr[0]),__uint_as_float(rr[1])); } \
      resc=false; \
      if(__builtin_expect(__any(rm>(float)THRL),0)){ const float dl=__builtin_fmaxf(rm,0.f); mhat+=dl; \
        _Pragma("unroll") for(int r=0;r<16;++r){C0[r]-=dl;C1[r]-=dl;} \
        _Pragma("unroll") for(int r=0;r<16;++r)negm[r]=-mhat; asm volatile("":"+v"(negm)); \
        const float f=__builtin_amdgcn_exp2f(-dl); l_reg*=f; if(hi==0)wsf[r32]=f; resc=true; } } \
    SBAR(); \
    GAPB(o[0]=__builtin_amdgcn_mfma_f32_32x32x16_bf16(PAF(0),VFR(0),o[0],0,0,0), C0,0); \
    GAPB(o[1]=__builtin_amdgcn_mfma_f32_32x32x16_bf16(PAF(0),VFR(4),o[1],0,0,0), C0,4); \
    KRD(GL,0); GAPB(o[0]=__builtin_amdgcn_mfma_f32_32x32x16_bf16(PAF(1),VFR(1),o[0],0,0,0), C0,8); \
    KRD(GL,1); GAPB(o[1]=__builtin_amdgcn_mfma_f32_32x32x16_bf16(PAF(1),VFR(5),o[1],0,0,0), C0,12); \
    KRD(GL,2); GAPB(o[0]=__builtin_amdgcn_mfma_f32_32x32x16_bf16(PAF(2),VFR(2),o[0],0,0,0), C1,0); \
    KRD(GL,3); GAPB(o[1]=__builtin_amdgcn_mfma_f32_32x32x16_bf16(PAF(2),VFR(6),o[1],0,0,0), C1,4); \
    GAPB(o[0]=__builtin_amdgcn_mfma_f32_32x32x16_bf16(PAF(3),VFR(3),o[0],0,0,0), C1,8); \
    GAPB(o[1]=__builtin_amdgcn_mfma_f32_32x32x16_bf16(PAF(3),VFR(7),o[1],0,0,0), C1,12); \
    }while(0)
  int t=1;
  #undef CMASK
  #define CMASK(P0,P1,t) do{}while(0)
  for(;t+5<NT;t+=2){
    STEP(pB0,pB1,pA0,pA1,t,true,true,true);     WAIT_BAR(2); RESC(); ROT();
    STEP(pA0,pA1,pB0,pB1,t+1,true,true,true);   WAIT_BAR(2); RESC(); ROT();
  }
  #undef CMASK
  #define CMASK(P0,P1,t) do{ if((t)==NT-1)tmask(P0,P1); }while(0)
  #define ENDW(tt) do{ if((tt)+3<NT){WAIT_BAR(2);} else if((tt)+2<NT){WAIT_BAR(1);} else {WAIT_BAR(0);} }while(0)
  for(;t+1<NT;t+=2){
    STEP(pB0,pB1,pA0,pA1,t,(t+3<NT),(t+1<NT),(t+1<NT));       ENDW(t);   RESC(); ROT();
    STEP(pA0,pA1,pB0,pB1,t+1,(t+4<NT),(t+2<NT),(t+2<NT));     ENDW(t+1); RESC(); ROT();
  }
  static_assert((NT&1)==1&&NT>=7,"odd tile count: the pair loops end on tile NT-1 (scores in buffer A)");
  { float sacc=pA0[0]+pA0[1]; _Pragma("unroll") for(int r=2;r<16;++r)sacc+=pA0[r]; _Pragma("unroll") for(int r=0;r<16;++r)sacc+=pA1[r]; l_reg+=sacc;
    pw0=(u32x4){PKW(pA0,0),PKW(pA0,2),PKW(pA0,4),PKW(pA0,6)};pw1=(u32x4){PKW(pA0,8),PKW(pA0,10),PKW(pA0,12),PKW(pA0,14)};pw2=(u32x4){PKW(pA1,0),PKW(pA1,2),PKW(pA1,4),PKW(pA1,6)};pw3=(u32x4){PKW(pA1,8),PKW(pA1,10),PKW(pA1,12),PKW(pA1,14)};
    SBAR(); pv(o,vb0+sl_prev,PAF(0),PAF(1),PAF(2),PAF(3)); }
  #undef PKW
  #undef PAF
  #undef VFR
  #undef PIN
  #undef MX3
  #undef GAPA
  #undef GAPB
  #undef EX
  #undef VRD
  #undef KRD
  #undef STEP
  #undef ENDW
  {auto rr=__builtin_amdgcn_permlane32_swap(__float_as_uint(l_reg),__float_as_uint(l_reg),false,false);l_reg=__uint_as_float(rr[0])+__uint_as_float(rr[1]);}
  if(hi==0)wsf[32+r32]=l_reg;asm volatile("s_waitcnt lgkmcnt(0)":::"memory");
  float rli[16];
  #pragma unroll
  for(int r=0;r<16;++r)rli[r]=__builtin_amdgcn_rcpf(wsf[32+crow(r,hi)]);
  bf16*Ow=O+(rowbase+q0+wid*QBLK)*OP+h*D;
  { bf16*stg=(bf16*)(shm+LDS_OST)+wid*2048;
    #pragma unroll
    for(int r=0;r<16;++r){const int orow=crow(r,hi);
      #pragma unroll
      for(int d0=0;d0<2;++d0)stg[orow*64+d0*32+r32]=__float2bfloat16(o[d0][r]*rli[r]);}
    asm volatile("s_waitcnt lgkmcnt(0)":::"memory");
    #pragma unroll
    for(int i=0;i<4;++i){const int row=i*8+(lane>>3),ch=lane&7; const u32x4 v=*(const u32x4*)(stg+row*64+ch*8);
      float f[8]; f[0]=__uint_as_float(v.x<<16);f[1]=__uint_as_float(v.x&0xffff0000u);f[2]=__uint_as_float(v.y<<16);f[3]=__uint_as_float(v.y&0xffff0000u);
      f[4]=__uint_as_float(v.z<<16);f[5]=__uint_as_float(v.z&0xffff0000u);f[6]=__uint_as_float(v.w<<16);f[7]=__uint_as_float(v.w&0xffff0000u);
      float ss=0.f; _Pragma("unroll") for(int j=0;j<8;++j)ss+=f[j]*f[j];
      ss+=__shfl_xor(ss,1);ss+=__shfl_xor(ss,2);ss+=__shfl_xor(ss,4);
      const float rs=1.0f/sqrtf(ss*(1.0f/64.0f)+1e-6f); const f32x4_t g0=*(const f32x4_t*)(gain+h*D+ch*8),g1=*(const f32x4_t*)(gain+h*D+ch*8+4);
      u32x4 w; w[0]=cvtpk_s(f[0]*rs*g0[0],f[1]*rs*g0[1]);w[1]=cvtpk_s(f[2]*rs*g0[2],f[3]*rs*g0[3]);w[2]=cvtpk_s(f[4]*rs*g1[0],f[5]*rs*g1[1]);w[3]=cvtpk_s(f[6]*rs*g1[2],f[7]*rs*g1[3]);
      ATTN_STORE16(Ow+(long)row*OP+ch*8,w);} }
  asm volatile("s_waitcnt lgkmcnt(0)\n\ts_barrier":::"memory");
  #undef DMA_K
  #undef DMA_V
  #undef CMASK
  #undef START
  #undef RESC
  #undef ROT
}
constexpr int ATTN_LDS_BYTES=LDS_BYTES;
struct AttnTensors { const bf16* Q; const bf16* K; const bf16* V; bf16* O; const float* gain; };
struct AttnUnit { int b; int h; int qb; };
struct StaticOrder {
  int vcu;
  __device__ __forceinline__ explicit StaticOrder(int grid_,int block):vcu((grid_%8==0)?(block%8)*(grid_/8)+block/8:block),grid(grid_){}
  int grid;
  __device__ __forceinline__ bool next(int i,AttnUnit&u)const{ const int n=i*grid+vcu,pair=n>>5; if(pair>=48)return false; const int s=n&31; u.b=pair>>1; u.h=4*(pair&1)+(s>>3); u.qb=s&7; return true; }
};
template<class Sched,class Side,int THRL=8> __device__ __forceinline__ void attn_phase(char*lds,const AttnTensors&T,const Sched&S,int kside,const Side&side){
  AttnUnit u; int i=0;
  for(;i<kside&&S.next(i,u);++i){ attn_unit<THRL>(u.b,u.h,u.qb,T.Q,T.K,T.V,T.O,T.gain,lds); }
  side();
  for(;S.next(i,u);++i){ attn_unit<THRL>(u.b,u.h,u.qb,T.Q,T.K,T.V,T.O,T.gain,lds); }
}
#undef SBAR
#undef WAIT_BAR
}

typedef __attribute__((address_space(1))) unsigned gu32;
#define XB_TMO      128
#define XB_XCNT(j)  (256  + 64 * (j))
#define XB_XSUB(j)  (1280 + 64 * (j))
#define XB_XGEN(j)  (2304 + 64 * (j))
#define XB_TOP      3328
#define XB_TOPGEN   3392
#define XCD_BAR_WORDS 3456
#define XB_SPIN_CAP (1u << 18)

__device__ __forceinline__ unsigned xb_ld(unsigned* p)              { return __hip_atomic_load(p, __ATOMIC_RELAXED, __HIP_MEMORY_SCOPE_AGENT); }
__device__ __forceinline__ unsigned xb_add(unsigned* p, unsigned v) { return __hip_atomic_fetch_add(p, v, __ATOMIC_RELAXED, __HIP_MEMORY_SCOPE_AGENT); }
__device__ __forceinline__ unsigned xb_xcc_id() { return (unsigned)__builtin_amdgcn_s_getreg((3 << 11) | 20) & 0xFu; }
#define XB_SPIN(cond, bar) do { unsigned _sp = 0; while (cond) { __builtin_amdgcn_s_sleep(1); \
    if ((++_sp & 255u) == 0u) { if (xb_ld(&(bar)[XB_TMO])) break; if (_sp > XB_SPIN_CAP) { atomicAdd(&(bar)[XB_TMO], 1u); break; } } } } while (0)

struct XcdBarrier {
    unsigned* bar; unsigned x;
    volatile LAS unsigned* st;
};

__device__ __forceinline__ XcdBarrier xcd_barrier_post(unsigned* bar, volatile LAS unsigned* st) {
    XcdBarrier b; b.bar = bar; b.x = xb_xcc_id(); b.st = st;
    if (threadIdx.x == 0) (void)xb_add(&bar[XB_XCNT(b.x)], 1u);
    return b;
}
__device__ __forceinline__ void xcd_barrier_complete(unsigned* bar, unsigned x, unsigned& nloc, unsigned& nx) {
    const unsigned G = gridDim.x * gridDim.y * gridDim.z;
    unsigned sum, cnt, mine, sp = 0u;
    for (;;) {
        sum = 0u; cnt = 0u; mine = 0u;
#pragma unroll
        for (unsigned j = 0; j < 16; ++j) { const unsigned c = xb_ld(&bar[XB_XCNT(j)]); sum += c; cnt += (c > 0u) ? 1u : 0u; mine = (j == x) ? c : mine; }
        if (sum == G) break;
        __builtin_amdgcn_s_sleep(1);
        if ((++sp & 255u) == 0u) { if (xb_ld(&bar[XB_TMO])) break; if (sp > XB_SPIN_CAP) { atomicAdd(&bar[XB_TMO], 1u); break; } }
    }
    nloc = mine > 0u ? mine : 1u; nx = cnt > 0u ? cnt : 1u;
}

__device__ __forceinline__ void xcd_barrier(const XcdBarrier& b) {
    asm volatile("s_waitcnt vmcnt(0)" ::: "memory");
    __syncthreads();
    if (threadIdx.x == 0) {
        unsigned* bar = b.bar;
        __builtin_amdgcn_s_waitcnt(0);
        unsigned nloc = b.st[0], nx = b.st[1];
        if (nloc == 0u) { xcd_barrier_complete(bar, b.x, nloc, nx); b.st[0] = nloc; b.st[1] = nx; }
        const unsigned old = xb_add(&bar[XB_XSUB(b.x)], 1u);
        const unsigned gen = old / nloc;
        if (old + 1u == (gen + 1u) * nloc) {
            __builtin_amdgcn_fence(__ATOMIC_RELEASE, "agent");
            asm volatile("s_waitcnt vmcnt(0)" ::: "memory");
            const unsigned og = xb_add(&bar[XB_TOP], 1u);
            const unsigned tg = og / nx;
            if (og + 1u == (tg + 1u) * nx) xb_add(&bar[XB_TOPGEN], 1u);
            else XB_SPIN(xb_ld(&bar[XB_TOPGEN]) == tg, bar);
            __builtin_amdgcn_fence(__ATOMIC_ACQUIRE, "agent");
            xb_add(&bar[XB_XGEN(b.x)], 1u);
            asm volatile("s_waitcnt vmcnt(0)" ::: "memory");
        } else {
            XB_SPIN(xb_ld(&bar[XB_XGEN(b.x)]) == gen, bar);
            __builtin_amdgcn_fence(__ATOMIC_ACQUIRE, "agent");
            asm volatile("s_waitcnt vmcnt(0)" ::: "memory");
        }
    }
    __syncthreads();
}


__global__ void __launch_bounds__(NTHR, 2) enc_fwd(Args a) {
    extern __shared__ __attribute__((aligned(16))) unsigned char lds[];
    cg::grid_group grid = cg::this_grid();
    const int tid = threadIdx.x, lane = tid & 63, wave = __builtin_amdgcn_readfirstlane(tid >> 6);
    const int G = gridDim.x, gw = blockIdx.x * NWAVES + wave, NGW = G * NWAVES;
    const int lo = a.ph_lo, hi = a.ph_hi;
    volatile LAS unsigned* MISC = (volatile LAS unsigned*)((LAS unsigned char*)lds + LDS_BYTES - 64);
    if (tid < 16) MISC[tid] = 0u;
    __syncthreads();
    (void)xcd_barrier_post((unsigned*)(a.ws + WS_CTL) + 4096, MISC);
#define IN(k) (lo <= (k) && (k) < hi)
#ifndef PROBE_X2
#define PROBE_X2 -1
#endif
#define REP(k) for (int rep_ = 0; rep_ < ((k) == PROBE_X2 ? 2 : 1); ++rep_)
#define SEAM(k) do { if (IN(k) && IN((k) + 1)) { if (lo > 1000) grid.sync();   { XcdBarrier bar_; bar_.bar = (unsigned*)(a.ws + WS_CTL) + 4096; bar_.x = xb_xcc_id(); bar_.st = MISC; xcd_barrier(bar_); } } } while (0)
    if (IN(0)) REP(0) { p0_prologue(a, lds, tid, lane, wave); } SEAM(0);
    if (IN(1)) REP(1) { pg8::Gemm g{(const bf16_t*)(a.ws + WS_XA), (const bf16_t*)(a.ws + WS_WIN), NTOK, INW, DM}; pg8::StaticOrder S; S.init(NTOK, INW, G, (int)blockIdx.x);
        pg8::EpiInProj E{(bf16_t*)(a.ws + WS_Z), (bf16_t*)(a.ws + WS_Q), (bf16_t*)(a.ws + WS_KB), (bf16_t*)(a.ws + WS_VB), (const float*)(a.ws + WS_ROPE), a.qg, a.kg};
        kv_meta_rows(a, lane, gw, NGW);
        pg8::gemm_phase<pg8::EpiInProj, pg8::StaticOrder, true, true>((LAS unsigned char*)lds, g, S, E); } SEAM(1);
    if (IN(3)) REP(3) { const attn_body::AttnTensors AT{(const attn_body::bf16*)(a.ws + WS_Q), (const attn_body::bf16*)(a.ws + WS_KB), (const attn_body::bf16*)(a.ws + WS_VB), (attn_body::bf16*)(a.ws + WS_YA) + 512, a.attn_g};
        const attn_body::StaticOrder S(G, (int)blockIdx.x);
        auto side = [&]() { p2_pass(a, lane, gw, NGW);
            __syncthreads(); };
        attn_body::attn_phase<attn_body::StaticOrder>((char*)lds, AT, S, (int)((blockIdx.x >> 3) * 6) >> 5, side); } SEAM(3);
    if (IN(4)) REP(4) { pg8::Gemm g{(const bf16_t*)(a.ws + WS_YA), (const bf16_t*)(a.ws + WS_WOUT), NTOK, DM, DM}; pg8::StaticOrder S; S.init(NTOK, DM, G, (int)blockIdx.x);
        pg8::EpiResidNorm E{(const bf16_t*)(a.ws + WS_XA), (const float*)(a.ws + WS_RS1), (bf16_t*)(a.ws + WS_HB), a.ws + WS_X8, (float*)(a.ws + WS_SS), X8SCALE};
        pg8::gemm_phase<pg8::EpiResidNorm, pg8::StaticOrder, true, true>((LAS unsigned char*)lds, g, S, E); } SEAM(4);
    if (IN(6)) REP(6) { pg8::Gemm g{(const bf16_t*)(a.ws + WS_X8), (const bf16_t*)(a.ws + WS_WQ), NTOK, PQ, DM / 2}; pg8::StaticOrder S; S.init(NTOK, PQ, G, (int)blockIdx.x);
        pg8::EpiBf16 E{(bf16_t*)(a.ws + WS_QP), PQ, 1.0f / (X8SCALE * WQSCALE)};
        pg8::gemm_phase<pg8::EpiBf16, pg8::StaticOrder, true, true, true>((LAS unsigned char*)lds, g, S, E); } SEAM(6);
    if (IN(7)) REP(7) { p7_topk(a, lds, tid, lane, wave);
        table_fp4<false>(a.pu, a.ws + WS_UT, (float*)(a.ws + WS_USC), a.g_ffn, gw, NGW, lane);
        table_fp4<true>(a.pv, a.ws + WS_UT + 4 * SLICE4, (float*)(a.ws + WS_VSC), nullptr, gw, NGW, lane);
        __syncthreads(); } SEAM(7);
    if (IN(8)) REP(8) { p8a_u(a, lane, wave); } SEAM(8);
    if (IN(9)) REP(9) { p8c_combine(a, lds, tid); __syncthreads(); } SEAM(9);
    if (IN(10)) REP(10) { p8b_v(a, lds, lane, wave, rep_ == ((10 == PROBE_X2) ? 1 : 0)); }
#undef IN
#undef SEAM
}

extern "C" void kernel_launch(void* const* d_in, const int* in_sizes, int n_in, void* d_out, int out_size, void* d_ws, size_t ws_size, hipStream_t stream) {
    static int grid = 0;
    if (grid == 0) {
        if (n_in != 16 || out_size != NTOK * DM || ws_size < WS_END) { fprintf(stderr, "kernel_launch: unexpected shapes (n_in %d out %d ws %zu)\n", n_in, out_size, ws_size); grid = -1; return; }
        int dev = 0, cus = 0, per_cu = 0;
        (void)hipGetDevice(&dev); (void)hipDeviceGetAttribute(&cus, hipDeviceAttributeMultiprocessorCount, dev);
        (void)hipFuncSetAttribute((const void*)enc_fwd, hipFuncAttributeMaxDynamicSharedMemorySize, LDS_BYTES);
        (void)hipOccupancyMaxActiveBlocksPerMultiprocessor(&per_cu, (const void*)enc_fwd, NTHR, LDS_BYTES);
        if (per_cu < 1) { fprintf(stderr, "kernel_launch: occupancy query says %d blocks/CU\n", per_cu); per_cu = 1; }
        (void)hipGetLastError();
        grid = cus * 1;
    }
    if (grid < 0) return;
    (void)hipMemsetAsync((char*)d_ws + WS_CTL, 0, 64 * 1024, stream);
    Args a{};
    a.xp = (const float*)d_in[0]; a.xs = (const float*)d_in[1]; a.meta = (const float*)d_in[2]; a.g_mix = (const float*)d_in[3]; a.w_in = (const float*)d_in[4];
    a.conv_w = (const float*)d_in[5]; a.qg = (const float*)d_in[6]; a.kg = (const float*)d_in[7]; a.conv_g = (const float*)d_in[8]; a.attn_g = (const float*)d_in[9];
    a.w_out = (const float*)d_in[10]; a.g_ffn = (const float*)d_in[11]; a.wq = (const float*)d_in[12]; a.subk = (const float*)d_in[13]; a.pu = (const float*)d_in[14]; a.pv = (const float*)d_in[15];
    a.out = (float*)d_out; a.ws = (unsigned char*)d_ws;
    constexpr int NL = MK_N_LAUNCHES;
    for (int li = 0; li < NL; ++li) {
        a.ph_lo = (NL == 1) ? 0 : li; a.ph_hi = (NL == 1) ? NPHASE : li + 1;
        void* args[] = {&a};
        hipError_t e = hipLaunchCooperativeKernel((const void*)enc_fwd, dim3(grid), dim3(NTHR), args, LDS_BYTES, stream);
        if (e != hipSuccess) { fprintf(stderr, "kernel_launch: launch %d failed: %s\n", li, hipGetErrorString(e)); break; }
    }
}
```

```cpp
#include <hip/hip_runtime.h>
#include <hip/hip_cooperative_groups.h>
#include <cstdint>
#include <cstdio>
namespace cg = cooperative_groups;

#ifndef MK_N_LAUNCHES
#define MK_N_LAUNCHES 1
#endif

typedef unsigned short bf16_t;
typedef short bf16x8 __attribute__((ext_vector_type(8)));
typedef float f32x4 __attribute__((ext_vector_type(4)));
typedef unsigned u32x4 __attribute__((ext_vector_type(4)));
typedef unsigned u32x2 __attribute__((ext_vector_type(2)));
#define LAS __attribute__((address_space(3)))

constexpr int NB = 24, NBP = 16, SEQ = 2048, DM = 1024, NTOK = NB * SEQ;
constexpr int NMETA = 16, INW = 2304, KROWS = 2112;
constexpr int NKEYS = SEQ + NMETA;
constexpr int PQ = 2048;
constexpr float EPS = 1e-6f;
constexpr float C2 = 0.125f * 1.4426950408889634f;
constexpr int NWAVES = 8, NTHR = 512;
constexpr int LDS_BYTES = 163840;
constexpr int NPHASE = 11;

constexpr size_t MiB = 1u << 20;
constexpr size_t WS_CTL = 0;
constexpr size_t WS_WIN = 1 * MiB;
constexpr size_t WS_WOUT = 6 * MiB;
constexpr size_t WS_WQ = 8 * MiB;
constexpr size_t WS_SUBK = 12 * MiB;
constexpr size_t WS_ZMETA = 12 * MiB + 512 * 1024;
constexpr size_t WS_ROPE = WS_ZMETA + 256 * 1024;
constexpr size_t WS_UT = 13 * MiB;
constexpr size_t WS_USC = 29 * MiB, WS_VSC = WS_USC + 64 * 1024;
constexpr size_t WS_SS = WS_USC + 256 * 1024;
constexpr size_t SLICE4 = (size_t)16384 * 128;
constexpr size_t WS_XA = 32 * MiB;
constexpr size_t WS_EI = WS_XA, WS_GT = WS_XA + 12 * MiB;
constexpr size_t WS_Z = 128 * MiB;
constexpr size_t WS_HB = WS_Z;
constexpr size_t WS_QP = WS_Z + 96 * MiB;
constexpr size_t WS_PB = WS_QP;
constexpr size_t WS_AB = WS_PB + (size_t)4 * 49152 * 128 * 4;
constexpr size_t WS_Q = 416 * MiB;
constexpr size_t WS_X8 = WS_Q;
constexpr size_t WS_KB = 464 * MiB;
constexpr size_t WS_VB = 477 * MiB;
constexpr size_t WS_END = 490 * MiB;
constexpr float X8SCALE = 8.0f;
constexpr float WQSCALE = 64.0f;
constexpr float A8SCALE = 256.0f;

struct Args {
    const float* xp; const float* xs; const float* meta; const float* g_mix; const float* w_in; const float* conv_w;
    const float* qg; const float* kg; const float* conv_g; const float* attn_g; const float* w_out; const float* g_ffn;
    const float* wq; const float* subk; const float* pu; const float* pv;
    float* out; unsigned char* ws; int ph_lo, ph_hi;
};

__device__ __forceinline__ unsigned f2bf(float f) { unsigned u = __builtin_bit_cast(unsigned, f); return (u + 0x7fffu + ((u >> 16) & 1u)) >> 16; }
typedef float f32x2_pk __attribute__((ext_vector_type(2))); typedef __bf16 bf16x2_pk __attribute__((ext_vector_type(2)));
__device__ __forceinline__ unsigned pk2(float lo, float hi) { const f32x2_pk v = {lo, hi}; const bf16x2_pk b = __builtin_convertvector(v, bf16x2_pk); return __builtin_bit_cast(unsigned, b); }
__device__ __forceinline__ float bflo(unsigned w) { return __builtin_bit_cast(float, w << 16); }
__device__ __forceinline__ float bfhi(unsigned w) { return __builtin_bit_cast(float, w & 0xffff0000u); }
__device__ __forceinline__ float bf2f(bf16_t h) { return __builtin_bit_cast(float, (unsigned)h << 16); }
__device__ __forceinline__ void unpack8(u32x4 w, float* f) {
    f[0] = bflo(w.x); f[1] = bfhi(w.x); f[2] = bflo(w.y); f[3] = bfhi(w.y); f[4] = bflo(w.z); f[5] = bfhi(w.z); f[6] = bflo(w.w); f[7] = bfhi(w.w);
}
__device__ __forceinline__ u32x4 pack8(const float* f) { u32x4 w; w.x = pk2(f[0], f[1]); w.y = pk2(f[2], f[3]); w.z = pk2(f[4], f[5]); w.w = pk2(f[6], f[7]); return w; }
__device__ __forceinline__ float wave_sum(float v) {
#pragma unroll
    for (int o = 1; o < 64; o <<= 1) v += __shfl_xor(v, o);
    return v;
}
__device__ __forceinline__ float wave_max(float v) {
#pragma unroll
    for (int o = 1; o < 64; o <<= 1) v = fmaxf(v, __shfl_xor(v, o));
    return v;
}
__device__ __forceinline__ const float* xrow_ptr(const Args& a, int r) { return r < NBP * SEQ ? a.xp + (size_t)r * DM : a.xs + (size_t)(r - NBP * SEQ) * DM; }

__device__ __forceinline__ int permin(int n  ) {
    if (n >= 512 && n < 1536) { const int hc = (n - 512) >> 9, c = (n - 512) & 511; return 512 + (c >> 7) * 256 + hc * 128 + (c & 127); }
    if (n >= 1536 && n < 2048) { const int c = n - 1536, hh = c >> 6, half = (c >> 5) & 1; return 1536 + 256 * (hh >> 2) + 128 * half + 32 * (hh & 3) + (c & 31); }
    if (n >= 2048) { const int c = n - 2048, s = c >> 6, half = (c >> 5) & 1; return 2048 + 128 * half + 32 * s + (c & 31); }
    return n; }
__device__ __forceinline__ void p0_transpose_item(const float* W, int K, int N, bf16_t* WT, float* scr, int item, int lane, const float* gk = nullptr  , bool dperm = false) {
    const int nblk = N / 32, kb = item / nblk, nb = item % nblk, k0 = 64 * kb, n0 = 32 * nb, nd0 = dperm ? permin(n0) : n0;
#pragma unroll 8
    for (int i = 0; i < 32; ++i) { const int kk = 2 * i + (lane >> 5); scr[kk * 33 + (lane & 31)] = W[(size_t)(k0 + kk) * N + n0 + (lane & 31)] * (gk ? gk[k0 + kk] : 1.0f); }
    asm volatile("s_waitcnt lgkmcnt(0)" ::: "memory");
    const int c = lane & 7;
#pragma unroll
    for (int j = 0; j < 4; ++j) { const int n = (lane >> 3) + 8 * j; const float* s = scr + (8 * c) * 33 + n;
        u32x4 o; o.x = pk2(s[0 * 33], s[1 * 33]); o.y = pk2(s[2 * 33], s[3 * 33]); o.z = pk2(s[4 * 33], s[5 * 33]); o.w = pk2(s[6 * 33], s[7 * 33]);
        *(u32x4*)(WT + (size_t)(nd0 + n) * K + k0 + 8 * c) = o; }
    asm volatile("s_waitcnt lgkmcnt(0)" ::: "memory");
}
__device__ __forceinline__ void p0_transpose_item_fp8(const float* W, int K, int N, unsigned char* WT, float* scr, int item, int lane, const float* gk, float wscale) {
    const int nblk = N / 32, kb = item / nblk, nb = item % nblk, k0 = 64 * kb, n0 = 32 * nb;
#pragma unroll 8
    for (int i = 0; i < 32; ++i) { const int kk = 2 * i + (lane >> 5); scr[kk * 33 + (lane & 31)] = W[(size_t)(k0 + kk) * N + n0 + (lane & 31)] * (gk[k0 + kk] * wscale); }
    asm volatile("s_waitcnt lgkmcnt(0)" ::: "memory");
    const int c = lane & 7;
#pragma unroll
    for (int j = 0; j < 4; ++j) { const int n = (lane >> 3) + 8 * j; const float* s = scr + (8 * c) * 33 + n;
        unsigned w0 = (unsigned)__builtin_amdgcn_cvt_pk_fp8_f32(s[0 * 33], s[1 * 33], 0, false); w0 = (unsigned)__builtin_amdgcn_cvt_pk_fp8_f32(s[2 * 33], s[3 * 33], (int)w0, true);
        unsigned w1 = (unsigned)__builtin_amdgcn_cvt_pk_fp8_f32(s[4 * 33], s[5 * 33], 0, false); w1 = (unsigned)__builtin_amdgcn_cvt_pk_fp8_f32(s[6 * 33], s[7 * 33], (int)w1, true);
        *(u32x2*)(WT + (size_t)(n0 + n) * K + k0 + 8 * c) = (u32x2){w0, w1}; }
    asm volatile("s_waitcnt lgkmcnt(0)" ::: "memory");
}
__device__ __forceinline__ void cast_region(const float* src, bf16_t* dst, size_t n, size_t gtid, size_t nthreads) {
    for (size_t i = gtid * 8; i < n; i += nthreads * 8) {
        const f32x4 a = *(const f32x4*)(src + i), b = *(const f32x4*)(src + i + 4);
        u32x4 o; o.x = pk2(a.x, a.y); o.y = pk2(a.z, a.w); o.z = pk2(b.x, b.y); o.w = pk2(b.z, b.w);
        *(u32x4*)(dst + i) = o;
    }
}
template <bool PERM64> __device__ __forceinline__ void table_fp4(const float* src, unsigned char* dst, float* scale, const float* gcol  , int gw, int NGW, int lane) {
    f32x4 v[4], vn[4], g[4];
#pragma unroll
    for (int j = 0; j < 4; ++j) g[j] = gcol ? *(const f32x4*)(gcol + lane * 16 + 4 * j) : (f32x4){1.f, 1.f, 1.f, 1.f};
    if (gw < 16384) {
#pragma unroll
        for (int j = 0; j < 4; ++j) v[j] = __builtin_nontemporal_load((const f32x4*)(src + (size_t)gw * DM + lane * 16 + 4 * j)); }
    for (int row = gw; row < 16384; row += NGW) {
        { const int rn = row + NGW < 16384 ? row + NGW : row;
#pragma unroll
          for (int j = 0; j < 4; ++j) vn[j] = __builtin_nontemporal_load((const f32x4*)(src + (size_t)rn * DM + lane * 16 + 4 * j)); }
        float m = 0.f;
#pragma unroll
        for (int j = 0; j < 4; ++j) { v[j] = v[j] * g[j]; m = fmaxf(fmaxf(m, fmaxf(fabsf(v[j].x), fabsf(v[j].y))), fmaxf(fabsf(v[j].z), fabsf(v[j].w))); }
        m = wave_max(m);
        const float s = fmaxf(m, 1e-30f) * (1.0f / 6.0f), inv = 1.0f / s;
        unsigned char* rowp = dst + (size_t)(lane >> 4) * SLICE4 + (size_t)row * 128;
        if (!PERM64) {
            unsigned w0 = 0u, w1 = 0u;
            w0 = __builtin_amdgcn_cvt_scalef32_pk_fp4_f32(w0, v[0].x * inv, v[0].y * inv, 1.0f, 0); w0 = __builtin_amdgcn_cvt_scalef32_pk_fp4_f32(w0, v[0].z * inv, v[0].w * inv, 1.0f, 1);
            w0 = __builtin_amdgcn_cvt_scalef32_pk_fp4_f32(w0, v[1].x * inv, v[1].y * inv, 1.0f, 2); w0 = __builtin_amdgcn_cvt_scalef32_pk_fp4_f32(w0, v[1].z * inv, v[1].w * inv, 1.0f, 3);
            w1 = __builtin_amdgcn_cvt_scalef32_pk_fp4_f32(w1, v[2].x * inv, v[2].y * inv, 1.0f, 0); w1 = __builtin_amdgcn_cvt_scalef32_pk_fp4_f32(w1, v[2].z * inv, v[2].w * inv, 1.0f, 1);
            w1 = __builtin_amdgcn_cvt_scalef32_pk_fp4_f32(w1, v[3].x * inv, v[3].y * inv, 1.0f, 2); w1 = __builtin_amdgcn_cvt_scalef32_pk_fp4_f32(w1, v[3].z * inv, v[3].w * inv, 1.0f, 3);
            *(u32x2*)(rowp + (lane & 15) * 8) = (u32x2){w0, w1};
        } else {
            unsigned char* gp = rowp + ((lane & 15) >> 2) * 32 + (lane & 3) * 2;
#pragma unroll
            for (int m = 0; m < 4; ++m) { unsigned wm = 0u;
                wm = __builtin_amdgcn_cvt_scalef32_pk_fp4_f32(wm, v[0][m] * inv, v[1][m] * inv, 1.0f, 0); wm = __builtin_amdgcn_cvt_scalef32_pk_fp4_f32(wm, v[2][m] * inv, v[3][m] * inv, 1.0f, 1);
                *(unsigned short*)(gp + 8 * m) = (unsigned short)wm; }
        }
        if (lane == 0) scale[row] = s;
#pragma unroll
        for (int j = 0; j < 4; ++j) v[j] = vn[j];
    }
}
__device__ __forceinline__ void p0_prologue(const Args& a, unsigned char* lds, int tid, int lane, int wave) {
    const int G = gridDim.x, gw = blockIdx.x * NWAVES + wave, NGW = G * NWAVES;
    float* ldsf = (float*)lds;
    if (blockIdx.x < INW / 64) {
        float* xm = ldsf;
        float* red = ldsf + 16 * 1024;
#pragma unroll
        for (int rr = 0; rr < 2; ++rr) { const int r = 2 * wave + rr; f32x4 v[4]; float ss = 0.f;
#pragma unroll
            for (int j = 0; j < 4; ++j) { v[j] = *(const f32x4*)(a.meta + (size_t)r * DM + (lane + 64 * j) * 4); ss += v[j].x * v[j].x + v[j].y * v[j].y + v[j].z * v[j].z + v[j].w * v[j].w; }
            const float rstd = 1.0f / sqrtf(wave_sum(ss) * (1.0f / DM) + EPS);
#pragma unroll
            for (int j = 0; j < 4; ++j) { const int c = (lane + 64 * j) * 4; const f32x4 g = *(const f32x4*)(a.g_mix + c); *(f32x4*)(xm + r * 1024 + c) = v[j] * rstd * g; }
        }
        __syncthreads();
        const int n0 = blockIdx.x * 64, k0 = wave * 128;
        float acc[16];
#pragma unroll
        for (int r = 0; r < 16; ++r) acc[r] = 0.f;
        for (int kb = k0; kb < k0 + 128; kb += 16) { float wv[16];
#pragma unroll
            for (int q = 0; q < 16; ++q) wv[q] = a.w_in[(size_t)(kb + q) * INW + n0 + lane];
#pragma unroll
            for (int q = 0; q < 16; ++q)
#pragma unroll
                for (int r = 0; r < 16; ++r) acc[r] += xm[r * 1024 + kb + q] * wv[q]; }
#pragma unroll
        for (int r = 0; r < 16; ++r) red[(wave * 16 + r) * 64 + lane] = acc[r];
        __syncthreads();
        float* zmeta = (float*)(a.ws + WS_ZMETA);
        for (int o = tid; o < 1024; o += NTHR) { const int r = o >> 6, c = o & 63; float s = 0.f;
#pragma unroll
            for (int w = 0; w < 8; ++w) s += red[(w * 16 + r) * 64 + c];
            zmeta[r * INW + n0 + c] = s; }
        __syncthreads();
    }
    if (blockIdx.x == INW / 64) {
        float* rope = (float*)(a.ws + WS_ROPE);
        for (int i = tid; i < 64 * 16; i += NTHR) { const int pos = i >> 4, f = i & 15;
            const float freq = exp2f(-(float)f * (13.287712379549449f / 16.0f)); const float rev = (float)pos * freq * 0.15915494309189535f; const float fr = rev - floorf(rev);
            rope[2 * i] = __builtin_amdgcn_cosf(fr); rope[2 * i + 1] = __builtin_amdgcn_sinf(fr); }
    }
    if ((int)blockIdx.x > INW / 64 || G <= INW / 64 + 1) {
        float* scr = ldsf + wave * (64 * 33);
        constexpr int I_IN = (DM / 64) * (INW / 32), I_OUT = (DM / 64) * (DM / 32), I_WQ = (DM / 64) * (PQ / 32);
        const int first = (G <= INW / 64 + 1) ? 0 : INW / 64 + 1, nw = (G - first) * NWAVES;
        for (int it = ((int)blockIdx.x - first) * NWAVES + wave; it < I_IN + I_OUT + I_WQ; it += nw) {
            int r = it;
            if (r < I_IN) { p0_transpose_item(a.w_in, DM, INW, (bf16_t*)(a.ws + WS_WIN), scr, r, lane, nullptr, true); continue; } r -= I_IN;
            if (r < I_OUT) { p0_transpose_item(a.w_out, DM, DM, (bf16_t*)(a.ws + WS_WOUT), scr, r, lane); continue; } r -= I_OUT;
            p0_transpose_item_fp8(a.wq, DM, PQ, a.ws + WS_WQ, scr, r, lane, a.g_ffn, WQSCALE);
        }
    }
    {
        const size_t gtid = (size_t)blockIdx.x * NTHR + tid, nth = (size_t)G * NTHR;
        cast_region(a.subk, (bf16_t*)(a.ws + WS_SUBK), (size_t)16 * 128 * 128, gtid, nth);
        for (size_t i = gtid; i < (size_t)NTOK; i += nth) ((float*)(a.ws + WS_SS))[i] = 0.f;
    }
    {
        bf16_t* XA = (bf16_t*)(a.ws + WS_XA);
        f32x4 g[4], v[4], vn[4];
#pragma unroll
        for (int j = 0; j < 4; ++j) g[j] = *(const f32x4*)(a.g_mix + (lane + 64 * j) * 4);
        if (gw < NTOK) { const float* xr = xrow_ptr(a, gw);
#pragma unroll
            for (int j = 0; j < 4; ++j) v[j] = __builtin_nontemporal_load((const f32x4*)(xr + (lane + 64 * j) * 4)); }
        for (int r = gw; r < NTOK; r += NGW) {
            { const float* xn = xrow_ptr(a, r + NGW < NTOK ? r + NGW : r);
#pragma unroll
              for (int j = 0; j < 4; ++j) vn[j] = __builtin_nontemporal_load((const f32x4*)(xn + (lane + 64 * j) * 4)); }
            float ss = 0.f;
#pragma unroll
            for (int j = 0; j < 4; ++j) ss += v[j].x * v[j].x + v[j].y * v[j].y + v[j].z * v[j].z + v[j].w * v[j].w;
            const float rstd = 1.0f / sqrtf(wave_sum(ss) * (1.0f / DM) + EPS);
#pragma unroll
            for (int j = 0; j < 4; ++j) { const int c = (lane + 64 * j) * 4; const f32x4 o = v[j] * rstd * g[j];
                u32x2 w; w.x = pk2(o.x, o.y); w.y = pk2(o.z, o.w); *(u32x2*)(XA + (size_t)r * DM + c) = w; }
#pragma unroll
            for (int j = 0; j < 4; ++j) v[j] = vn[j];
        }
    }
}

constexpr int ZW = 1024;
struct P2In { u32x4 w[4]; };
__device__ __forceinline__ void p2_load(P2In& in, const bf16_t* ZB, int r, int lane) {
    const int t = r & 2047, c0 = lane * 8; const bf16_t* zr = ZB + (size_t)r * ZW;
    const bf16_t* zp = (t > 0) ? zr - ZW : zr; const bf16_t* zn = (t < SEQ - 1) ? zr + ZW : zr;
    in.w[0] = *(const u32x4*)(zr + c0); in.w[1] = *(const u32x4*)(zr + 512 + c0); in.w[2] = *(const u32x4*)(zp + 512 + c0); in.w[3] = *(const u32x4*)(zn + 512 + c0);
}
__device__ __forceinline__ void p2_pass(const Args& a, int lane, int gw, int NGW) {
    const bf16_t* ZB = (const bf16_t*)(a.ws + WS_Z); const float* zmeta = (const float*)(a.ws + WS_ZMETA);
    bf16_t* XA = (bf16_t*)(a.ws + WS_XA);
    const int c0 = lane * 8;
    float cw0[8], cw1[8], cw2[8], cgn[8];
#pragma unroll
    for (int j = 0; j < 8; ++j) { cw0[j] = a.conv_w[c0 + j]; cw1[j] = a.conv_w[512 + c0 + j]; cw2[j] = a.conv_w[1024 + c0 + j]; cgn[j] = a.conv_g[c0 + j]; }
    P2In cur, nxt, nx2;
    if (gw < NTOK) { p2_load(cur, ZB, gw, lane); p2_load(nxt, ZB, gw + NGW < NTOK ? gw + NGW : gw, lane); }
    for (int it = gw; it < NTOK; it += NGW) {
        {
            const int r = it, t = r & 2047;
            { const int rn = it + 2 * NGW < NTOK ? it + 2 * NGW : it; p2_load(nx2, ZB, rn, lane); }
            float gb[8], uc[8], up[8], un[8];
            unpack8(cur.w[0], gb); unpack8(cur.w[1], uc); unpack8(cur.w[2], up);
            if (t == 0) {
#pragma unroll
                for (int j = 0; j < 8; ++j) up[j] = zmeta[15 * INW + 512 + c0 + j] * zmeta[15 * INW + 1024 + c0 + j]; }
            unpack8(cur.w[3], un);
#pragma unroll
            for (int j = 0; j < 8; ++j) un[j] = (t < SEQ - 1) ? un[j] : 0.f;
            float y[8], ss = 0.f;
#pragma unroll
            for (int j = 0; j < 8; ++j) { y[j] = gb[j] * (up[j] * cw0[j] + uc[j] * cw1[j] + un[j] * cw2[j]); ss += y[j] * y[j]; }
            ss += __shfl_xor(ss, 1); ss += __shfl_xor(ss, 2); ss += __shfl_xor(ss, 4);
            const float rstd = 1.0f / sqrtf(ss * (1.0f / 64.0f) + EPS);
#pragma unroll
            for (int j = 0; j < 8; ++j) y[j] = y[j] * rstd * cgn[j];
            *(u32x4*)(XA + (size_t)r * DM + c0) = pack8(y);
            cur = nxt; nxt = nx2;
        }
    }
}
__device__ __forceinline__ void kv_meta_rows(const Args& a, int lane, int gw, int NGW) {
    const float* zmeta = (const float*)(a.ws + WS_ZMETA); bf16_t* KB = (bf16_t*)(a.ws + WS_KB); bf16_t* VB = (bf16_t*)(a.ws + WS_VB);
    const int i = lane & 7;
    for (int it = NTOK + gw; it < NTOK + NB * 64; it += NGW) {
        {
            const int it2 = it - NTOK, b = it2 >> 6, j64 = it2 & 63; const int l16 = lane & 15, g = l16 >> 3;
            float k[8], v[8];
            if (j64 < NMETA) {
                const float* zm = zmeta + j64 * INW; float ss = 0.f;
#pragma unroll
                for (int j = 0; j < 8; ++j) { k[j] = zm[2048 + l16 * 8 + j]; v[j] = zm[2176 + l16 * 8 + j]; ss += k[j] * k[j]; }
                ss += __shfl_xor(ss, 1); ss += __shfl_xor(ss, 2); ss += __shfl_xor(ss, 4);
                const float rstd = 1.0f / sqrtf(ss * (1.0f / 64.0f) + EPS);
#pragma unroll
                for (int j = 0; j < 8; ++j) k[j] = k[j] * rstd * a.kg[i * 8 + j];
            } else {
#pragma unroll
                for (int j = 0; j < 8; ++j) { k[j] = 0.f; v[j] = 0.f; }
            }
            const size_t krow = ((size_t)(b * 2 + g) * KROWS + SEQ + j64) * 64 + i * 8;
            if (lane < 16) *(u32x4*)(KB + krow) = pack8(k);
            else if (lane < 32) *(u32x4*)(VB + krow) = pack8(v);
        }
    }
}

typedef float f32x16 __attribute__((ext_vector_type(16)));
__device__ __forceinline__ void ce_desc(float& a, float& b) { float h, l; asm("v_max_f32_e32 %0, %1, %2" : "=v"(h) : "v"(a), "v"(b)); asm("v_min_f32_e32 %0, %1, %2" : "=v"(l) : "v"(a), "v"(b)); a = h; b = l; }
__device__ __forceinline__ float vmaxf(float a, float b) { float h; asm("v_max_f32_e32 %0, %1, %2" : "=v"(h) : "v"(a), "v"(b)); return h; }
template <int N> __device__ __forceinline__ void bitonic_sort_desc(float* v) {
#pragma unroll
    for (int k = 2; k <= N; k <<= 1)
#pragma unroll
        for (int j = k >> 1; j > 0; j >>= 1)
#pragma unroll
            for (int i = 0; i < N; ++i) { const int l = i ^ j; if (l > i) { if ((i & k) == 0) ce_desc(v[i], v[l]); else ce_desc(v[l], v[i]); } }
}
__device__ __forceinline__ void sort16_desc(float* v) {
    ce_desc(v[0], v[13]); ce_desc(v[1], v[12]); ce_desc(v[2], v[15]); ce_desc(v[3], v[14]); ce_desc(v[4], v[8]); ce_desc(v[5], v[6]); ce_desc(v[7], v[11]); ce_desc(v[9], v[10]);
    ce_desc(v[0], v[5]); ce_desc(v[1], v[7]); ce_desc(v[2], v[9]); ce_desc(v[3], v[4]); ce_desc(v[6], v[13]); ce_desc(v[8], v[14]); ce_desc(v[10], v[15]); ce_desc(v[11], v[12]);
    ce_desc(v[0], v[1]); ce_desc(v[2], v[3]); ce_desc(v[4], v[5]); ce_desc(v[6], v[8]); ce_desc(v[7], v[9]); ce_desc(v[10], v[11]); ce_desc(v[12], v[13]); ce_desc(v[14], v[15]);
    ce_desc(v[0], v[2]); ce_desc(v[1], v[3]); ce_desc(v[4], v[10]); ce_desc(v[5], v[11]); ce_desc(v[6], v[7]); ce_desc(v[8], v[9]); ce_desc(v[12], v[14]); ce_desc(v[13], v[15]);
    ce_desc(v[1], v[2]); ce_desc(v[3], v[12]); ce_desc(v[4], v[6]); ce_desc(v[5], v[7]); ce_desc(v[8], v[10]); ce_desc(v[9], v[11]); ce_desc(v[13], v[14]);
    ce_desc(v[1], v[4]); ce_desc(v[2], v[6]); ce_desc(v[5], v[8]); ce_desc(v[7], v[10]); ce_desc(v[9], v[13]); ce_desc(v[11], v[14]);
    ce_desc(v[2], v[4]); ce_desc(v[3], v[6]); ce_desc(v[9], v[12]); ce_desc(v[11], v[13]);
    ce_desc(v[3], v[5]); ce_desc(v[6], v[8]); ce_desc(v[7], v[9]); ce_desc(v[10], v[12]);
    ce_desc(v[3], v[4]); ce_desc(v[5], v[6]); ce_desc(v[7], v[8]); ce_desc(v[9], v[10]); ce_desc(v[11], v[12]);
    ce_desc(v[6], v[7]); ce_desc(v[8], v[9]);
}
template <int N> __device__ __forceinline__ void bitonic_merge_desc(float* v) {
#pragma unroll
    for (int j = N >> 1; j > 0; j >>= 1)
#pragma unroll
        for (int i = 0; i < N; ++i) { const int l = i ^ j; if (l > i) ce_desc(v[i], v[l]); }
}
__device__ __forceinline__ float vmed3f(float a, float b, float c) { float m; asm("v_med3_f32 %0, %1, %2, %3" : "=v"(m) : "v"(a), "v"(b), "v"(c)); return m; }
__device__ __forceinline__ void merge_top16(float* x, const float* y) {
#pragma unroll
    for (int i = 0; i < 8; ++i) { const float a = x[i], b = x[i + 8], c = y[7 - i], d = y[15 - i]; x[i] = vmaxf(a, c); x[i + 8] = vmed3f(a, c, vmaxf(b, d)); }
#pragma unroll
    for (int j = 4; j > 0; j >>= 1)
#pragma unroll
        for (int i = 0; i < 16; ++i) { const int l = i ^ j; if (l > i) ce_desc(x[i], x[l]); }
}
__device__ __forceinline__ void merge_top16_ce(float* x, const float* y) {
#pragma unroll
    for (int i = 0; i < 16; ++i) x[i] = vmaxf(x[i], y[15 - i]);
    bitonic_merge_desc<16>(x);
}
__device__ __forceinline__ void insert16(float* t, float x) {
#pragma unroll
    for (int k = 0; k < 16; ++k) ce_desc(t[k], x);
}
constexpr int SK_ROW = 272, SK_MAT = 128 * SK_ROW;
__device__ __forceinline__ void p7_half(const bf16_t* qrow  , const LAS unsigned char* skl  , int hi4, float* T) {
    f32x16 acc[4];
#pragma unroll
    for (int nb = 0; nb < 4; ++nb)
#pragma unroll
        for (int r = 0; r < 16; ++r) acc[nb][r] = 0.f;
    bf16x8 bq[8];
#pragma unroll
    for (int ks = 0; ks < 8; ++ks) bq[ks] = *(const bf16x8*)(qrow + ks * 16);
#pragma unroll
    for (int ks = 0; ks < 8; ++ks) {
#pragma unroll
        for (int nb = 0; nb < 4; ++nb) { const bf16x8 ak = *(const LAS bf16x8*)(skl + nb * 32 * SK_ROW + ks * 32); acc[nb] = __builtin_amdgcn_mfma_f32_32x32x16_bf16(ak, bq[ks], acc[nb], 0, 0, 0); }
        if (ks & 1) __builtin_amdgcn_sched_barrier(0);
    }
    float L[16];
#pragma unroll
    for (int nb = 0; nb < 4; ++nb) {
        float v[16];
#pragma unroll
        for (int r = 0; r < 16; ++r) { const float sc = acc[nb][r]; v[r] = __uint_as_float((__float_as_uint(sc) & ~127u) | (unsigned)(nb * 32 + (r & 3) + 8 * (r >> 2))); }
        sort16_desc(v);
        if (nb == 0) {
#pragma unroll
            for (int r = 0; r < 16; ++r) L[r] = v[r];
        } else merge_top16(L, v);
    }
#pragma unroll
    for (int r = 0; r < 16; ++r) { const unsigned w = __builtin_bit_cast(unsigned, L[r]); T[r] = __builtin_bit_cast(float, w | (unsigned)hi4); }
}
__device__ __forceinline__ unsigned pick_byte(unsigned p0, unsigned p1, unsigned p2, unsigned p3, unsigned i) {
    const unsigned sel = (i & 7u) | 0x0c0c0c00u;
    const unsigned lo = __builtin_amdgcn_perm(p1, p0, sel), hi = __builtin_amdgcn_perm(p3, p2, sel);
    return (i & 8u) ? hi : lo;
}
__device__ __forceinline__ void p7_topk(const Args& a, unsigned char* lds, int tid, int lane, int wave) {
    const bf16_t* QP = (const bf16_t*)(a.ws + WS_QP); const bf16_t* SUBK = (const bf16_t*)(a.ws + WS_SUBK);
    unsigned short* EIDX = (unsigned short*)(a.ws + WS_EI); bf16_t* GATE = (bf16_t*)(a.ws + WS_GT); const float* SSQ = (const float*)(a.ws + WS_SS);
    const int r32 = lane & 31, hi = lane >> 5;
    const int hp = blockIdx.x & 3, grp = blockIdx.x >> 2, ngrp = gridDim.x >> 2;
    { const u32x4* src = (const u32x4*)(SUBK + (size_t)hp * 4 * 128 * 128);
      for (int i = tid; i < 4 * 128 * 16; i += NTHR) { const int row = i >> 4, ch = i & 15; *(LAS u32x4*)((LAS unsigned char*)lds + row * SK_ROW + ch * 16) = src[i]; } }
    __syncthreads();
    const LAS unsigned char* skl = (const LAS unsigned char*)lds + r32 * SK_ROW + 16 * hi;
    for (int blk = grp * NWAVES + wave; blk < NTOK / 32; blk += ngrp * NWAVES) {
        const int tok = blk * 32 + r32;
        const float rs_l2e = 1.4426950408889634f / sqrtf(SSQ[tok] * (1.0f / DM) + EPS);
        float M0[16], M1[16];
        {
            float B0[16], B1[16];
            p7_half(QP + (size_t)tok * PQ + (2 * hp) * 256 + 8 * hi, skl + 0 * SK_MAT, 4 * hi, M0);
            p7_half(QP + (size_t)tok * PQ + (2 * hp) * 256 + 128 + 8 * hi, skl + 1 * SK_MAT, 4 * hi, M1);
            p7_half(QP + (size_t)tok * PQ + (2 * hp + 1) * 256 + 8 * hi, skl + 2 * SK_MAT, 4 * hi, B0);
            p7_half(QP + (size_t)tok * PQ + (2 * hp + 1) * 256 + 128 + 8 * hi, skl + 3 * SK_MAT, 4 * hi, B1);
#pragma unroll
            for (int i = 0; i < 16; ++i) {
                const auto r0 = __builtin_amdgcn_permlane32_swap(__builtin_bit_cast(unsigned, M0[i]), __builtin_bit_cast(unsigned, B0[i]), false, false);
                const unsigned a0 = r0[0], b0 = r0[1]; M0[i] = __builtin_bit_cast(float, a0); B0[i] = __builtin_bit_cast(float, b0);
                const auto r1 = __builtin_amdgcn_permlane32_swap(__builtin_bit_cast(unsigned, M1[i]), __builtin_bit_cast(unsigned, B1[i]), false, false);
                const unsigned a1 = r1[0], b1 = r1[1]; M1[i] = __builtin_bit_cast(float, a1); B1[i] = __builtin_bit_cast(float, b1); }
            merge_top16(M0, B0); merge_top16(M1, B1);
        }
        const int h = 2 * hp + hi;
#define CAND(i, j) __builtin_bit_cast(float, (__builtin_bit_cast(unsigned, M0[i] + M1[j]) & ~255u) | (unsigned)((i) * 16 + (j)))
        float tc[16], l2[16], l3[16];
#pragma unroll
        for (int j = 0; j < 16; ++j) tc[j] = CAND(0, j);
#pragma unroll
        for (int j = 0; j < 8; ++j) { l2[j] = CAND(1, j); l2[8 + j] = CAND(15 - j, 0); }
        bitonic_merge_desc<16>(l2);
        merge_top16_ce(tc, l2);
        l3[0] = CAND(2, 0); l3[1] = CAND(2, 1); l3[2] = CAND(2, 2); l3[3] = CAND(2, 3); l3[4] = CAND(2, 4); l3[5] = CAND(3, 0); l3[6] = CAND(3, 1); l3[7] = CAND(3, 2); l3[8] = CAND(3, 3);
        l3[9] = CAND(4, 0); l3[10] = CAND(4, 1); l3[11] = CAND(4, 2); l3[12] = CAND(5, 0); l3[13] = CAND(5, 1); l3[14] = CAND(6, 0); l3[15] = CAND(6, 1);
        sort16_desc(l3);
        merge_top16_ce(tc, l3);
        insert16(tc, CAND(7, 0)); insert16(tc, CAND(7, 1));
#undef CAND
#define PK4(M, q) ((__builtin_bit_cast(unsigned, M[4 * (q)]) & 127u) | ((__builtin_bit_cast(unsigned, M[4 * (q) + 1]) & 127u) << 8) | ((__builtin_bit_cast(unsigned, M[4 * (q) + 2]) & 127u) << 16) | ((__builtin_bit_cast(unsigned, M[4 * (q) + 3]) & 127u) << 24))
        const unsigned a0 = PK4(M0, 0), a1 = PK4(M0, 1), a2 = PK4(M0, 2), a3 = PK4(M0, 3), b0 = PK4(M1, 0), b1 = PK4(M1, 1), b2 = PK4(M1, 2), b3 = PK4(M1, 3);
#undef PK4
        float e[16], sum = 0.f;
#pragma unroll
        for (int k = 0; k < 16; ++k) { e[k] = exp2f((tc[k] - tc[0]) * rs_l2e); sum += e[k]; }
        const float inv = 1.0f / sum;
        int eo[16];
#pragma unroll
        for (int k = 0; k < 16; ++k) { const unsigned code = __builtin_bit_cast(unsigned, tc[k]) & 255u; eo[k] = (int)(pick_byte(a0, a1, a2, a3, code >> 4) * 128u + pick_byte(b0, b1, b2, b3, code & 15u)); e[k] *= inv; }
        unsigned short* ep = EIDX + ((size_t)tok * 8 + h) * 16; bf16_t* gp = GATE + ((size_t)tok * 8 + h) * 16;
#pragma unroll
        for (int k = 0; k < 16; k += 8) { u32x4 pk; pk.x = (unsigned)eo[k] | ((unsigned)eo[k + 1] << 16); pk.y = (unsigned)eo[k + 2] | ((unsigned)eo[k + 3] << 16); pk.z = (unsigned)eo[k + 4] | ((unsigned)eo[k + 5] << 16); pk.w = (unsigned)eo[k + 6] | ((unsigned)eo[k + 7] << 16); *(u32x4*)(ep + k) = pk; }
#pragma unroll
        for (int k = 0; k < 16; k += 8) *(u32x4*)(gp + k) = (u32x4){pk2(e[k], e[k + 1]), pk2(e[k + 2], e[k + 3]), pk2(e[k + 4], e[k + 5]), pk2(e[k + 6], e[k + 7])};
    }
}

typedef _Float16 h2_t __attribute__((ext_vector_type(2)));
typedef float f32x2 __attribute__((ext_vector_type(2)));
__device__ __forceinline__ float dot32_fp4(u32x4 w, const h2_t* xh) {
    float acc = 0.f;
#pragma unroll
    for (int d = 0; d < 4; ++d) {
        const unsigned wd = w[d];
        acc = __builtin_amdgcn_fdot2(__builtin_amdgcn_cvt_scalef32_pk_f16_fp4(wd, 1.0f, 0), xh[4 * d], acc, false);
        acc = __builtin_amdgcn_fdot2(__builtin_amdgcn_cvt_scalef32_pk_f16_fp4(wd, 1.0f, 1), xh[4 * d + 1], acc, false);
        acc = __builtin_amdgcn_fdot2(__builtin_amdgcn_cvt_scalef32_pk_f16_fp4(wd, 1.0f, 2), xh[4 * d + 2], acc, false);
        acc = __builtin_amdgcn_fdot2(__builtin_amdgcn_cvt_scalef32_pk_f16_fp4(wd, 1.0f, 3), xh[4 * d + 3], acc, false);
    }
    return acc;
}
typedef int i32x4 __attribute__((ext_vector_type(4)));
struct PMeta { unsigned p[8]; };
#define GAS __attribute__((address_space(1)))
template <class T> __device__ __forceinline__ GAS T* sgpr_ptr(T* p) { asm volatile("" : "+s"(p)); return (GAS T*)p; }
__device__ __forceinline__ void pm_load(PMeta& m, const unsigned short* EIDX, int t  , int seg) {
    const GAS unsigned char* rb = sgpr_ptr((const unsigned char*)(EIDX + (size_t)t * 128)); const unsigned lo = (unsigned)seg * 32u;
#pragma unroll
    for (int q = 0; q < 2; ++q) { const u32x4 ev = __builtin_nontemporal_load((const GAS u32x4*)(rb + (lo + q * 16u))); m.p[4 * q] = ev.x; m.p[4 * q + 1] = ev.y; m.p[4 * q + 2] = ev.z; m.p[4 * q + 3] = ev.w; }
}
#define SCHED_FENCE() __builtin_amdgcn_sched_barrier(0)
__device__ __forceinline__ void rows16_load(u32x4 (&w)[16], const unsigned char* Tbase, unsigned lane_off, const PMeta& m) {
#pragma unroll
    for (int j = 0; j < 16; ++j) { const unsigned pw = m.p[j >> 1]; const unsigned e = (j & 1) ? (pw >> 16) : (pw & 0xffffu); w[j] = *(const u32x4*)(Tbase + (e * 128u + lane_off)); }
}
#define PEER_GEOM() const int s4 = blockIdx.x & 3, th = (blockIdx.x >> 2) & 1, wq = (blockIdx.x >> 3) * NWAVES + wave, NWQ = (gridDim.x >> 3) * NWAVES, t_beg = th * (NTOK / 2) + wq, t_end = (th + 1) * (NTOK / 2)
#define TCL(t) ((t) < t_end ? (t) : t_end - 1)
typedef int v8i_t __attribute__((ext_vector_type(8)));
struct UTok { u32x4 A[8][2]; u32x4 B[2][2]; };
__device__ __forceinline__ void u_issue(UTok& T, const unsigned char* Ts  , const unsigned char* x8row  , unsigned idlo, unsigned idhi, int lane) {
    const int r16 = lane >> 2; const unsigned c16 = (unsigned)(lane & 3) * 16u; const unsigned q16 = (unsigned)(lane >> 4) * 16u;
#pragma unroll
    for (int h = 0; h < 8; ++h) { const unsigned e = (unsigned)__shfl((int)(h < 4 ? idlo : idhi), (h & 3) * 16 + r16);
#pragma unroll
        for (int ks = 0; ks < 2; ++ks) T.A[h][ks] = *(const u32x4*)(Ts + (e * 128u + 64u * ks + c16)); }
#pragma unroll
    for (int ks = 0; ks < 2; ++ks)
#pragma unroll
        for (int hf = 0; hf < 2; ++hf) T.B[ks][hf] = __builtin_nontemporal_load((const GAS u32x4*)(sgpr_ptr(x8row) + (128u * ks + 64u * hf + q16)));
}
__device__ __forceinline__ void u_compute(const UTok& T, int lane, bf16_t* dst  ) {
    f32x4 acc[8];
#pragma unroll
    for (int h = 0; h < 8; ++h) {
        acc[h] = (f32x4){0.f, 0.f, 0.f, 0.f};
#pragma unroll
        for (int ks = 0; ks < 2; ++ks) {
            const int src = (4 * (lane & 15) + (lane >> 4)) * 4;
            const v8i_t av = {__builtin_amdgcn_ds_bpermute(src, (int)T.A[h][ks].x), __builtin_amdgcn_ds_bpermute(src, (int)T.A[h][ks].y), __builtin_amdgcn_ds_bpermute(src, (int)T.A[h][ks].z), __builtin_amdgcn_ds_bpermute(src, (int)T.A[h][ks].w), 0, 0, 0, 0};
            const v8i_t bv = {(int)T.B[ks][0].x, (int)T.B[ks][0].y, (int)T.B[ks][0].z, (int)T.B[ks][0].w, (int)T.B[ks][1].x, (int)T.B[ks][1].y, (int)T.B[ks][1].z, (int)T.B[ks][1].w};
            acc[h] = __builtin_amdgcn_mfma_scale_f32_16x16x128_f8f6f4(av, bv, acc[h], 4  , 0  , 0, 0x7F7F7F7F, 0, 0x7F7F7F7F);
        }
    }
    const int j16 = lane & 15; f32x4 r = acc[0];
#pragma unroll
    for (int h = 1; h < 8; ++h) r = (j16 == h) ? acc[h] : r;
    if (j16 < 8) __builtin_nontemporal_store((u32x2){pk2(r[0], r[1]), pk2(r[2], r[3])}, (GAS u32x2*)(sgpr_ptr((unsigned char*)dst) + (unsigned)(j16 * 16 + (lane >> 4) * 4) * 2u));
}
__device__ __forceinline__ void p8a_u(const Args& a, int lane, int wave) {
    const unsigned short* EIDX = (const unsigned short*)(a.ws + WS_EI); bf16_t* PB = (bf16_t*)(a.ws + WS_PB);
    PEER_GEOM();
    const unsigned char* Ts = a.ws + WS_UT + (size_t)s4 * SLICE4; const unsigned char* x8 = a.ws + WS_X8 + s4 * 256;
    bf16_t* pb = PB + (size_t)s4 * NTOK * 128;
#define IDLOAD(lo, hi, t) do { const GAS unsigned short* ip_ = sgpr_ptr(EIDX + (size_t)(t) * 128); lo = ip_[lane]; hi = ip_[64 + lane]; } while (0)
    UTok TA, TB; unsigned ia0, ia1, ib0, ib1;
    IDLOAD(ia0, ia1, TCL(t_beg)); IDLOAD(ib0, ib1, TCL(t_beg + NWQ));
    u_issue(TA, Ts, x8 + (size_t)TCL(t_beg) * DM, ia0, ia1, lane);
    IDLOAD(ia0, ia1, TCL(t_beg + 2 * NWQ));
    for (int t = t_beg; t < t_end; t += 2 * NWQ) {
        SCHED_FENCE();
        u_issue(TB, Ts, x8 + (size_t)TCL(t + NWQ) * DM, ib0, ib1, lane); IDLOAD(ib0, ib1, TCL(t + 3 * NWQ));
        SCHED_FENCE();
        u_compute(TA, lane, pb + (size_t)t * 128);
        SCHED_FENCE();
        u_issue(TA, Ts, x8 + (size_t)TCL(t + 2 * NWQ) * DM, ia0, ia1, lane); IDLOAD(ia0, ia1, TCL(t + 4 * NWQ));
        SCHED_FENCE();
        if (t + NWQ < t_end) u_compute(TB, lane, pb + (size_t)(t + NWQ) * 128);
    }
#undef IDLOAD
}
__device__ __forceinline__ void p8c_combine(const Args& a, unsigned char* lds, int tid) {
    const u32x2* PB = (const u32x2*)(a.ws + WS_PB); unsigned* AB = (unsigned*)(a.ws + WS_AB); const u32x2* GATE = (const u32x2*)(a.ws + WS_GT); const float* SS = (const float*)(a.ws + WS_SS);
    const unsigned short* EIDX = (const unsigned short*)(a.ws + WS_EI); const float* su = (const float*)(a.ws + WS_USC); const float* sv = (const float*)(a.ws + WS_VSC);
    const size_t n4 = (size_t)NTOK * 128 / 4, nth = (size_t)gridDim.x * NTHR;
    LAS float* su_l = (LAS float*)lds; LAS float* sv_l = su_l + 16384;
    for (int i = tid; i < 16384 / 4; i += NTHR) { *(LAS f32x4*)(su_l + 4 * i) = *(const f32x4*)(su + 4 * i); *(LAS f32x4*)(sv_l + 4 * i) = *(const f32x4*)(sv + 4 * i); }
    __syncthreads();
    float calib;
    { unsigned a1 = 0u; a1 = __builtin_amdgcn_cvt_scalef32_pk_fp4_f32(a1, 1.0f, 1.0f, 1.0f, 0); a1 = __builtin_amdgcn_cvt_scalef32_pk_fp4_f32(a1, 1.0f, 1.0f, 1.0f, 1);
      a1 = __builtin_amdgcn_cvt_scalef32_pk_fp4_f32(a1, 1.0f, 1.0f, 1.0f, 2); a1 = __builtin_amdgcn_cvt_scalef32_pk_fp4_f32(a1, 1.0f, 1.0f, 1.0f, 3);
      unsigned b1 = (unsigned)__builtin_amdgcn_cvt_pk_fp8_f32(1.0f, 1.0f, 0, false); b1 = (unsigned)__builtin_amdgcn_cvt_pk_fp8_f32(1.0f, 1.0f, (int)b1, true);
      const v8i_t av = {(int)a1, (int)a1, (int)a1, (int)a1, 0, 0, 0, 0}, bv = {(int)b1, (int)b1, (int)b1, (int)b1, (int)b1, (int)b1, (int)b1, (int)b1};
      const f32x4 c = __builtin_amdgcn_mfma_scale_f32_16x16x128_f8f6f4(av, bv, (f32x4){0.f, 0.f, 0.f, 0.f}, 4, 0, 0, 0x7F7F7F7F, 0, 0x7F7F7F7F);
      calib = 128.0f / c[0] * (1.0f / X8SCALE); }
    for (size_t i = (size_t)blockIdx.x * NTHR + tid; i < n4; i += nth) {
        f32x4 d = {0.f, 0.f, 0.f, 0.f};
#pragma unroll
        for (int s2 = 0; s2 < 4; ++s2) { const u32x2 p = __builtin_nontemporal_load(PB + (size_t)s2 * n4 + i); d += (f32x4){bflo(p.x), bfhi(p.x), bflo(p.y), bfhi(p.y)}; }
        const u32x2 gw2 = __builtin_nontemporal_load(GATE + i); const f32x4 g = {bflo(gw2.x), bfhi(gw2.x), bflo(gw2.y), bfhi(gw2.y)}; const u32x2 ew = __builtin_nontemporal_load((const u32x2*)EIDX + i);
        const unsigned e[4] = {ew.x & 0xffffu, ew.x >> 16, ew.y & 0xffffu, ew.y >> 16}; float o[4];
        const float cr = calib / sqrtf(SS[i >> 5] * (1.0f / DM) + EPS);
#pragma unroll
        for (int j = 0; j < 4; ++j) { const float z = d[j] * su_l[e[j]] * cr; o[j] = 0.5f * z * (1.0f + erff(z * 0.70710678118654752f)) * g[j] * sv_l[e[j]]; }
        unsigned w8 = (unsigned)__builtin_amdgcn_cvt_pk_fp8_f32(o[0] * A8SCALE, o[1] * A8SCALE, 0, false); w8 = (unsigned)__builtin_amdgcn_cvt_pk_fp8_f32(o[2] * A8SCALE, o[3] * A8SCALE, (int)w8, true); AB[i] = w8;
    }
}
typedef int v2i_t __attribute__((ext_vector_type(2)));
constexpr int VROW = 144, VIMG = 128 * VROW;
struct VRec { u32x4 a8[2]; u32x2 h; };
__device__ __forceinline__ void v_token(const u32x4 (&w)[16], const VRec& rc, LAS unsigned char* vl  , float oscale, int lane, float* dst  , bool do_store) {
    const int seg = lane >> 3, c8 = lane & 7, i16 = lane & 15, q = lane >> 4;
#pragma unroll
    for (int j = 0; j < 16; ++j) *(LAS u32x4*)(vl + (seg * 16 + j) * VROW + c8 * 16) = w[j];
    asm volatile("s_waitcnt lgkmcnt(0)" ::: "memory");
    const v8i_t av = {(int)rc.a8[0].x, (int)rc.a8[0].y, (int)rc.a8[0].z, (int)rc.a8[0].w, (int)rc.a8[1].x, (int)rc.a8[1].y, (int)rc.a8[1].z, (int)rc.a8[1].w};
    const LAS unsigned char* rp = vl + (32 * q + i16) * VROW;
    float val[4] = {0.f, 0.f, 0.f, 0.f};
#pragma unroll
    for (int cb = 0; cb < 16; ++cb) {
        const v2i_t r1 = __builtin_amdgcn_ds_read_tr4_b64_v2i32((LAS v2i_t*)(rp + cb * 8)), r2 = __builtin_amdgcn_ds_read_tr4_b64_v2i32((LAS v2i_t*)(rp + 16 * VROW + cb * 8));
        const v8i_t bv = {r1.x, r1.y, r2.x, r2.y, 0, 0, 0, 0};
        const f32x4 acc = __builtin_amdgcn_mfma_scale_f32_16x16x128_f8f6f4(av, bv, (f32x4){0.f, 0.f, 0.f, 0.f}, 0  , 4  , 0, 0x7F7F7F7F, 0, 0x7F7F7F7F);
        const float a0 = acc[0]; val[cb & 3] = (q == (cb >> 2)) ? a0 : val[cb & 3];
    }
    asm volatile("s_waitcnt lgkmcnt(0)" ::: "memory");
    if (do_store) {
        *(GAS f32x4*)(sgpr_ptr((unsigned char*)dst) + (unsigned)lane * 16u) = (f32x4){bflo(rc.h.x) + val[0] * oscale, bfhi(rc.h.x) + val[1] * oscale, bflo(rc.h.y) + val[2] * oscale, bfhi(rc.h.y) + val[3] * oscale};
    } else asm volatile("" :: "v"(val[0]), "v"(val[1]), "v"(val[2]), "v"(val[3]));
}
__device__ __forceinline__ void p8b_v(const Args& a, unsigned char* lds, int lane, int wave, bool do_store) {
    const unsigned short* EIDX = (const unsigned short*)(a.ws + WS_EI); const unsigned char* AB = a.ws + WS_AB; const bf16_t* HB = (const bf16_t*)(a.ws + WS_HB);
    PEER_GEOM();
    const int seg = lane >> 3, c8 = lane & 7, q = lane >> 4;
    const unsigned char* Ts = a.ws + WS_UT + (size_t)(4 + s4) * SLICE4; const unsigned loff = c8 * 16;
    LAS unsigned char* vl = (LAS unsigned char*)lds + wave * VIMG;
    float oscale;
    { unsigned a1 = 0u; a1 = __builtin_amdgcn_cvt_scalef32_pk_fp4_f32(a1, 1.0f, 1.0f, 1.0f, 0); a1 = __builtin_amdgcn_cvt_scalef32_pk_fp4_f32(a1, 1.0f, 1.0f, 1.0f, 1);
      a1 = __builtin_amdgcn_cvt_scalef32_pk_fp4_f32(a1, 1.0f, 1.0f, 1.0f, 2); a1 = __builtin_amdgcn_cvt_scalef32_pk_fp4_f32(a1, 1.0f, 1.0f, 1.0f, 3);
      unsigned b1 = (unsigned)__builtin_amdgcn_cvt_pk_fp8_f32(1.0f, 1.0f, 0, false); b1 = (unsigned)__builtin_amdgcn_cvt_pk_fp8_f32(1.0f, 1.0f, (int)b1, true);
      const v8i_t av = {(int)b1, (int)b1, (int)b1, (int)b1, (int)b1, (int)b1, (int)b1, (int)b1}, bv = {(int)a1, (int)a1, (int)a1, (int)a1, 0, 0, 0, 0};
      const f32x4 c = __builtin_amdgcn_mfma_scale_f32_16x16x128_f8f6f4(av, bv, (f32x4){0.f, 0.f, 0.f, 0.f}, 0, 4, 0, 0x7F7F7F7F, 0, 0x7F7F7F7F);
      oscale = 128.0f / c[0] * (1.0f / A8SCALE); }
    const unsigned aoff = (unsigned)q * 16u, hoff = (unsigned)(s4 * 256 + 4 * lane) * 2u;
#define REC_LOAD(R, t) do { const GAS unsigned char* ab_ = sgpr_ptr(AB + (size_t)(t) * 128); R.a8[0] = __builtin_nontemporal_load((const GAS u32x4*)(ab_ + aoff)); R.a8[1] = __builtin_nontemporal_load((const GAS u32x4*)(ab_ + (64u + aoff))); \
        R.h = __builtin_nontemporal_load((const GAS u32x2*)(sgpr_ptr((const unsigned char*)(HB + (size_t)(t) * DM)) + hoff)); } while (0)
    PMeta mA, mB; u32x4 wA[16], wB[16]; VRec rA, rB;
    pm_load(mA, EIDX, TCL(t_beg), seg); pm_load(mB, EIDX, TCL(t_beg + NWQ), seg);
    rows16_load(wA, Ts, loff, mA); REC_LOAD(rA, TCL(t_beg));
    pm_load(mA, EIDX, TCL(t_beg + 2 * NWQ), seg);
    for (int t = t_beg; t < t_end; t += 2 * NWQ) {
        SCHED_FENCE();
        rows16_load(wB, Ts, loff, mB); REC_LOAD(rB, TCL(t + NWQ)); pm_load(mB, EIDX, TCL(t + 3 * NWQ), seg);
        SCHED_FENCE();
        v_token(wA, rA, vl, oscale, lane, a.out + (size_t)t * DM + s4 * 256, do_store);
        SCHED_FENCE();
        rows16_load(wA, Ts, loff, mA); REC_LOAD(rA, TCL(t + 2 * NWQ)); pm_load(mA, EIDX, TCL(t + 4 * NWQ), seg);
        SCHED_FENCE();
        if (t + NWQ < t_end) v_token(wB, rB, vl, oscale, lane, a.out + (size_t)(t + NWQ) * DM + s4 * 256, do_store);
    }
#undef REC_LOAD
#undef TCL
#undef PEER_GEOM
}

namespace pg8 {
#define PG8_LAS __attribute__((address_space(3)))
typedef unsigned short bf16_t;
typedef short bf16x8 __attribute__((ext_vector_type(8)));
typedef float f32x4 __attribute__((ext_vector_type(4)));
typedef unsigned u32x4 __attribute__((ext_vector_type(4)));
typedef int v4i_t __attribute__((ext_vector_type(4))); typedef int v8i_t __attribute__((ext_vector_type(8)));
constexpr int BM = 256, BK = 64, HALF = 128, HTB = HALF * BK * 2  , STAGE_BYTES = 8 * HTB, NXCD = 8, WGM = 8;

__host__ __device__ __forceinline__ int lds_byte(int r, int c) { const int st = (r >> 4) * 2 + (c >> 5), rr = r & 15, cc = c & 31, ob = rr * 64 + cc * 2; return st * 1024 + (ob ^ (((ob >> 9) & 1) << 5)); }
__host__ __device__ __forceinline__ void stage_rc(int b, int& R, int& C) { const int st = b / 1024, sb = b % 1024, swz = sb ^ (((sb >> 9) & 1) << 5); R = (st >> 1) * 16 + swz / 64; C = (st & 1) * 32 + (swz % 64) / 2; }
__host__ __device__ __forceinline__ int perm32(int rho) { const int n = rho >> 4, i = rho & 15; return 8 * (i >> 2) + 4 * n + (i & 3); }

struct Unit { int pm, pn; };
struct Gemm { const bf16_t* A; const bf16_t* Bt; int M, N, K; };

struct StaticOrder {
    int nM, nN, nwg, G, c;
    __host__ __device__ void init(int M, int N, int G_, int c_) { nM = M / BM; nN = N / BM; nwg = nM * nN; G = G_; c = c_; }
    __host__ __device__ bool next(int i, Unit& u) const {
        const long L = (long)i * G + c; if (L >= nwg) return false;
        int wgid = (int)L; { const int q = nwg / NXCD, r = nwg % NXCD, xcd = wgid % NXCD, off = wgid / NXCD; wgid = (xcd < r ? xcd * (q + 1) : r * (q + 1) + (xcd - r) * q) + off; }
        const int nig = WGM * nN, gid = wgid / nig, fm = gid * WGM, gsz = (nM - fm) < WGM ? (nM - fm) : WGM;
        u.pm = fm + ((wgid % nig) % gsz); u.pn = (wgid % nig) / gsz; return true;
    }
    __device__ __forceinline__ void a_ready(const Unit&) const {}
    __device__ __forceinline__ void done(const Unit&) const {}
};


__device__ __forceinline__ unsigned cvt_pk_bf16(float lo, float hi) { unsigned r; asm volatile("v_cvt_pk_bf16_f32 %0, %1, %2" : "=v"(r) : "v"(lo), "v"(hi)); return r; }
struct EpiInProj {
    static constexpr bool PERM = true, AFTER_DRAIN = false;
    bf16_t* O; bf16_t* QB; bf16_t* KB; bf16_t* VB; const float* rope; const float* qg; const float* kg;
    template <bool NORM> __device__ __forceinline__ void head_row(f32x4 a00, f32x4 a01, f32x4 a10, f32x4 a11, const float* g0, const float* g1, int t, int fq, bf16_t* dst  ) const {
        float x0[8] = {a00[0], a00[1], a00[2], a00[3], a01[0], a01[1], a01[2], a01[3]}, x1[8] = {a10[0], a10[1], a10[2], a10[3], a11[0], a11[1], a11[2], a11[3]};
        if (NORM) {
            float ss = 0.f;
#pragma unroll
            for (int e = 0; e < 8; ++e) ss += x0[e] * x0[e] + x1[e] * x1[e];
            ss += __shfl_xor(ss, 16); ss += __shfl_xor(ss, 32);
            const float rstd = 1.0f / sqrtf(ss * (1.0f / 64.0f) + 1e-6f);
            const float* r0 = rope + (((t >> 6) * 16 + (fq & 1) * 8) * 2); const float* r1 = rope + (((t & 63) * 16 + (fq & 1) * 8) * 2);
            f32x4 c0[4], c1[4];
#pragma unroll
            for (int q4 = 0; q4 < 4; ++q4) { c0[q4] = *(const f32x4*)(r0 + 4 * q4); c1[q4] = *(const f32x4*)(r1 + 4 * q4); }
#pragma unroll
            for (int e = 0; e < 8; ++e) { x0[e] *= rstd * g0[e]; x1[e] *= rstd * g1[e]; }
#pragma unroll
            for (int e = 0; e < 8; ++e) { const float o0 = __shfl_xor(x0[e], 32), o1 = __shfl_xor(x1[e], 32);
                const float cs0 = c0[e >> 1][(e & 1) * 2], sn0 = c0[e >> 1][(e & 1) * 2 + 1], cs1 = c1[e >> 1][(e & 1) * 2], sn1 = c1[e >> 1][(e & 1) * 2 + 1];
                x0[e] = (fq & 2) ? x0[e] * cs0 + o0 * sn0 : x0[e] * cs0 - o0 * sn0; x1[e] = (fq & 2) ? x1[e] * cs1 + o1 * sn1 : x1[e] * cs1 - o1 * sn1; }
        }
        u32x4 w; w.x = cvt_pk_bf16(x0[0], x0[1]); w.y = cvt_pk_bf16(x0[2], x0[3]); w.z = cvt_pk_bf16(x0[4], x0[5]); w.w = cvt_pk_bf16(x0[6], x0[7]); *(u32x4*)dst = w;
        w.x = cvt_pk_bf16(x1[0], x1[1]); w.y = cvt_pk_bf16(x1[2], x1[3]); w.z = cvt_pk_bf16(x1[4], x1[5]); w.w = cvt_pk_bf16(x1[6], x1[7]); *(u32x4*)(dst + 32) = w;
    }
    __device__ __forceinline__ void operator()(const f32x4 (&acc)[2][2][4][2], const Unit& u, int wr, int wc, int fr, int fq) const {
        const int row0 = u.pm * BM + wr * 64 + fr, pn = u.pn;
        if (pn < 2) {
            const int col0 = 256 * pn + wc * 32 + 8 * fq;
#pragma unroll
            for (int ai = 0; ai < 2; ++ai)
#pragma unroll
                for (int m = 0; m < 4; ++m) { bf16_t* rowp = O + (size_t)(row0 + ai * HALF + m * 16) * 1024 + col0;
#pragma unroll
                    for (int bj = 0; bj < 2; ++bj) { const f32x4 v0 = acc[ai][bj][m][0], v1 = acc[ai][bj][m][1];
                        u32x4 w; w.x = cvt_pk_bf16(v0[0], v0[1]); w.y = cvt_pk_bf16(v0[2], v0[3]); w.z = cvt_pk_bf16(v1[0], v1[1]); w.w = cvt_pk_bf16(v1[2], v1[3]);
                        *(u32x4*)(rowp + bj * HALF) = w; } }
        } else if (pn < 6) {
            const int col0 = 512 + 128 * (pn - 2) + wc * 32 + 8 * fq;
#pragma unroll
            for (int ai = 0; ai < 2; ++ai)
#pragma unroll
                for (int m = 0; m < 4; ++m) { const f32x4 v0 = acc[ai][0][m][0] * acc[ai][1][m][0], v1 = acc[ai][0][m][1] * acc[ai][1][m][1];
                    u32x4 w; w.x = cvt_pk_bf16(v0[0], v0[1]); w.y = cvt_pk_bf16(v0[2], v0[3]); w.z = cvt_pk_bf16(v1[0], v1[1]); w.w = cvt_pk_bf16(v1[2], v1[3]);
                    *(u32x4*)(O + (size_t)(row0 + ai * HALF + m * 16) * 1024 + col0) = w; }
        } else if (pn < 8) {
            float g0[8], g1[8];
#pragma unroll
            for (int e = 0; e < 8; ++e) { g0[e] = qg[8 * fq + e] * C2; g1[e] = qg[32 + 8 * fq + e] * C2; }
            const int hh = 4 * (pn - 6) + wc;
#pragma unroll
            for (int ai = 0; ai < 2; ++ai)
#pragma unroll
                for (int m = 0; m < 4; ++m) { const int r = row0 + ai * HALF + m * 16;
                    head_row<true>(acc[ai][0][m][0], acc[ai][0][m][1], acc[ai][1][m][0], acc[ai][1][m][1], g0, g1, r & 2047, fq, QB + (size_t)r * 512 + hh * 64 + 8 * fq); }
        } else {
            float g0[8], g1[8];
#pragma unroll
            for (int e = 0; e < 8; ++e) { g0[e] = kg[8 * fq + e]; g1[e] = kg[32 + 8 * fq + e]; }
            const int g = wc & 1;
#pragma unroll
            for (int ai = 0; ai < 2; ++ai)
#pragma unroll
                for (int m = 0; m < 4; ++m) { const int r = row0 + ai * HALF + m * 16, b = r >> 11, t = r & 2047; const size_t krow = ((size_t)(b * 2 + g) * KROWS + t) * 64 + 8 * fq;
                    if (wc < 2) head_row<true>(acc[ai][0][m][0], acc[ai][0][m][1], acc[ai][1][m][0], acc[ai][1][m][1], g0, g1, t, fq, KB + krow);
                    else head_row<false>(acc[ai][0][m][0], acc[ai][0][m][1], acc[ai][1][m][0], acc[ai][1][m][1], g0, g1, t, fq, VB + krow); }
        }
    }
};
struct EpiBf16 {
    static constexpr bool PERM = true, AFTER_DRAIN = false;
    bf16_t* O; int ldc; float scale;
    __device__ __forceinline__ void operator()(const f32x4 (&acc)[2][2][4][2], const Unit& u, int wr, int wc, int fr, int fq) const {
        const int row0 = u.pm * BM + wr * 64 + fr; const int col0 = u.pn * BM + wc * 32 + 8 * fq;
#pragma unroll
        for (int ai = 0; ai < 2; ++ai)
#pragma unroll
            for (int m = 0; m < 4; ++m) { bf16_t* rowp = O + (size_t)(row0 + ai * HALF + m * 16) * ldc + col0;
#pragma unroll
                for (int bj = 0; bj < 2; ++bj) { const f32x4 v0 = acc[ai][bj][m][0] * scale, v1 = acc[ai][bj][m][1] * scale;
                    u32x4 w; w.x = cvt_pk_bf16(v0[0], v0[1]); w.y = cvt_pk_bf16(v0[2], v0[3]); w.z = cvt_pk_bf16(v1[0], v1[1]); w.w = cvt_pk_bf16(v1[2], v1[3]);
                    *(u32x4*)(rowp + bj * HALF) = w; } }
    }
};
struct EpiResidNorm {
    static constexpr bool PERM = true, AFTER_DRAIN = false;
    const float* xp; const float* xs; float* out; int split_row; bf16_t* hb; unsigned char* h8; float* ss; float x8scale;
    __device__ __forceinline__ const float* xrow(int r, int col0) const { return (r < split_row ? xp + (size_t)r * 1024 : xs + (size_t)(r - split_row) * 1024) + col0; }
    __device__ __forceinline__ void operator()(const f32x4 (&acc)[2][2][4][2], const Unit& u, int wr, int wc, int fr, int fq) const {
        const int col0 = u.pn * BM + wc * 32 + 8 * fq, rbase = u.pm * BM + wr * 64 + fr;
        f32x4 xv[4][2][2];
#pragma unroll
        for (int m = 0; m < 4; ++m) { const float* xr = xrow(rbase + m * 16, col0);
#pragma unroll
            for (int bj = 0; bj < 2; ++bj) { xv[m][bj][0] = *(const f32x4*)(xr + bj * HALF); xv[m][bj][1] = *(const f32x4*)(xr + bj * HALF + 4); } }
#pragma unroll
        for (int ai = 0; ai < 2; ++ai)
#pragma unroll
            for (int m = 0; m < 4; ++m) { const int r = rbase + ai * HALF + m * 16;
                bf16_t* brow = hb + (size_t)r * 1024 + col0; unsigned char* qrow = h8 + (size_t)r * 1024 + col0; float s = 0.f;
                f32x4 h[2][2];
#pragma unroll
                for (int bj = 0; bj < 2; ++bj) { h[bj][0] = xv[m][bj][0] + acc[ai][bj][m][0]; h[bj][1] = xv[m][bj][1] + acc[ai][bj][m][1]; }
                if (ai == 0) { const float* xr = xrow(r + HALF, col0);
#pragma unroll
                    for (int bj = 0; bj < 2; ++bj) { xv[m][bj][0] = *(const f32x4*)(xr + bj * HALF); xv[m][bj][1] = *(const f32x4*)(xr + bj * HALF + 4); } }
#pragma unroll
                for (int bj = 0; bj < 2; ++bj) { const f32x4 h0 = h[bj][0], h1 = h[bj][1];
                    u32x4 wb; wb.x = cvt_pk_bf16(h0[0], h0[1]); wb.y = cvt_pk_bf16(h0[2], h0[3]); wb.z = cvt_pk_bf16(h1[0], h1[1]); wb.w = cvt_pk_bf16(h1[2], h1[3]); *(u32x4*)(brow + bj * HALF) = wb;
                    unsigned w0 = (unsigned)__builtin_amdgcn_cvt_pk_fp8_f32(h0[0] * x8scale, h0[1] * x8scale, 0, false); w0 = (unsigned)__builtin_amdgcn_cvt_pk_fp8_f32(h0[2] * x8scale, h0[3] * x8scale, (int)w0, true);
                    unsigned w1 = (unsigned)__builtin_amdgcn_cvt_pk_fp8_f32(h1[0] * x8scale, h1[1] * x8scale, 0, false); w1 = (unsigned)__builtin_amdgcn_cvt_pk_fp8_f32(h1[2] * x8scale, h1[3] * x8scale, (int)w1, true);
                    *(u32x2*)(qrow + bj * HALF) = (u32x2){w0, w1};
                    s += ((h0[0] * h0[0] + h0[1] * h0[1]) + (h0[2] * h0[2] + h0[3] * h0[3])) + ((h1[0] * h1[0] + h1[1] * h1[1]) + (h1[2] * h1[2] + h1[3] * h1[3])); }
                s += __shfl_xor(s, 16); s += __shfl_xor(s, 32);
                if (fq == 0) atomicAdd(ss + r, s); }
    }
};
struct EpiResid {
    static constexpr bool PERM = false, AFTER_DRAIN = false;
    const float* xp; const float* xs; float* out; int split_row;
    __device__ __forceinline__ void operator()(const f32x4 (&acc)[2][2][4][2], const Unit& u, int wr, int wc, int fr, int fq) const {
        const int col0 = u.pn * BM + wc * 32 + 4 * fq;
#pragma unroll
        for (int ai = 0; ai < 2; ++ai)
#pragma unroll
            for (int m = 0; m < 4; ++m) { const int r = u.pm * BM + ai * HALF + wr * 64 + m * 16 + fr;
                const float* xr = (r < split_row ? xp + (size_t)r * 1024 : xs + (size_t)(r - split_row) * 1024) + col0; float* orow = out + (size_t)r * 1024 + col0;
#pragma unroll
                for (int bj = 0; bj < 2; ++bj)
#pragma unroll
                    for (int n = 0; n < 2; ++n) { const f32x4 bs = *(const f32x4*)(xr + bj * HALF + n * 16); *(f32x4*)(orow + bj * HALF + n * 16) = bs + acc[ai][bj][m][n]; } }
    }
};

template <class Epi, class Sched, bool ALIGN_EPI = false, bool SP2 = false, bool FP8 = false>
__device__ __forceinline__ void gemm_phase(PG8_LAS unsigned char* lds, const Gemm g, const Sched& S, const Epi& E) {
    const int tid = threadIdx.x, wid = __builtin_amdgcn_readfirstlane(tid >> 6), lane = tid & 63, wr = wid >> 2, wc = wid & 3, fr = lane & 15, fq = lane >> 4;
    const int K = g.K, nt = K / BK;
    unsigned voffA[2], voffB[2];
#pragma unroll
    for (int i = 0; i < 2; ++i) { int R, C; stage_rc(tid * 16 + i * 8192, R, C); const int Rb = Epi::PERM ? ((R & ~31) + perm32(R & 31)) : R;
        voffA[i] = (unsigned)(R * K + C) * 2u; voffB[i] = (unsigned)(Rb * K + C) * 2u; }
    const size_t kstep = (size_t)(BK * 2);
    const size_t hstep = (size_t)HALF * K * 2;
    const size_t tstep = 2 * hstep;
    const unsigned ldsw = (unsigned)wid * 1024u;
    const int aoff = lds_byte(wr * 64 + fr, fq * 8), boff = lds_byte(wc * 32 + fr, fq * 8);
#define PG8_SA(b, h) (((b) * 2 + (h)) * HTB)
#define PG8_SB(b, h) ((4 + (b) * 2 + (h)) * HTB)
#define PG8_STAGE(bufoff, gbase, voff) do { _Pragma("unroll") for (int _i = 0; _i < 2; ++_i) \
        __builtin_amdgcn_global_load_lds((const unsigned*)((const char*)(gbase) + (voff)[_i]), (PG8_LAS unsigned*)(lds + (bufoff) + ldsw + _i * 8192), 16, 0, 0); } while (0)
#define PG8_LDA(dst, b, h) do { if constexpr (FP8) { _Pragma("unroll") for (int m = 0; m < 4; ++m) dst##8[m] = __builtin_shufflevector(*(const PG8_LAS v4i_t*)(lds + PG8_SA(b, h) + aoff + m * 2048), *(const PG8_LAS v4i_t*)(lds + PG8_SA(b, h) + aoff + m * 2048 + 1024), 0, 1, 2, 3, 4, 5, 6, 7); } \
        else { _Pragma("unroll") for (int m = 0; m < 4; ++m) _Pragma("unroll") for (int k = 0; k < 2; ++k) dst[m][k] = *(const PG8_LAS bf16x8*)(lds + PG8_SA(b, h) + aoff + m * 2048 + k * 1024); } } while (0)
#define PG8_LDB(dst, b, h) do { if constexpr (FP8) { _Pragma("unroll") for (int n = 0; n < 2; ++n) dst##8[n] = __builtin_shufflevector(*(const PG8_LAS v4i_t*)(lds + PG8_SB(b, h) + boff + n * 2048), *(const PG8_LAS v4i_t*)(lds + PG8_SB(b, h) + boff + n * 2048 + 1024), 0, 1, 2, 3, 4, 5, 6, 7); } \
        else { _Pragma("unroll") for (int n = 0; n < 2; ++n) _Pragma("unroll") for (int k = 0; k < 2; ++k) dst[n][k] = *(const PG8_LAS bf16x8*)(lds + PG8_SB(b, h) + boff + n * 2048 + k * 1024); } } while (0)
#define PG8_MMA(ai, bj, At, Bt) do { __builtin_amdgcn_s_setprio(1); _Pragma("unroll") for (int m = 0; m < 4; ++m) _Pragma("unroll") for (int n = 0; n < 2; ++n) { \
        if constexpr (FP8) { asm volatile("v_mfma_scale_f32_16x16x128_f8f6f4 %0, %1, %2, %0, %3, %3 op_sel_hi:[0,0,0]" : "+v"(acc[ai][bj][m][n]) : "v"(Bt##8[n]), "v"(At##8[m]), "v"(mfma_one)); } \
        else { _Pragma("unroll") for (int k = 0; k < 2; ++k) acc[ai][bj][m][n] = __builtin_amdgcn_mfma_f32_16x16x32_bf16(Bt[n][k], At[m][k], acc[ai][bj][m][n], 0, 0, 0); } } __builtin_amdgcn_s_setprio(0); } while (0)
#define PG8_WAIT_V(n) asm volatile("s_waitcnt vmcnt(" #n ")" ::: "memory")
#define PG8_WAIT_L(n) asm volatile("s_waitcnt lgkmcnt(" #n ")" ::: "memory")
#define PG8_BAR __builtin_amdgcn_s_barrier()
#define PG8_SCHED __builtin_amdgcn_sched_barrier(0)
    Unit cur, nxt; int ui = 0;
    if (!S.next(0, cur)) return;
    f32x4 acc[2][2][4][2];
#pragma unroll
    for (int a = 0; a < 2; ++a)
#pragma unroll
        for (int b = 0; b < 2; ++b)
#pragma unroll
            for (int m = 0; m < 4; ++m)
#pragma unroll
                for (int n = 0; n < 2; ++n) acc[a][b][m][n] = (f32x4){0.f, 0.f, 0.f, 0.f};
    const int mfma_one = 0x7F7F7F7F;
    bf16x8 At[4][2], B0[2][2], B1[2][2]; v8i_t At8[4], B08[2], B18[2];
    const char* cA = (const char*)g.A + (size_t)cur.pm * tstep; const char* cB = (const char*)g.Bt + (size_t)cur.pn * tstep;
    S.a_ready(cur);
    if constexpr (SP2) {
        PG8_STAGE(PG8_SB(0, 0), cB, voffB); PG8_STAGE(PG8_SB(0, 1), cB + hstep, voffB); PG8_STAGE(PG8_SA(0, 0), cA, voffA); PG8_STAGE(PG8_SA(0, 1), cA + hstep, voffA);
        if (wr == 1) PG8_BAR;
        PG8_WAIT_V(2); PG8_BAR;
        PG8_STAGE(PG8_SB(1, 0), cB + kstep, voffB); PG8_STAGE(PG8_SA(1, 0), cA + kstep, voffA); PG8_STAGE(PG8_SB(1, 1), cB + hstep + kstep, voffB);
        PG8_WAIT_V(6); PG8_BAR;
    } else {
        PG8_STAGE(PG8_SB(0, 0), cB, voffB); PG8_STAGE(PG8_SA(0, 0), cA, voffA); PG8_STAGE(PG8_SB(0, 1), cB + hstep, voffB); PG8_STAGE(PG8_SA(0, 1), cA + hstep, voffA);
        if (wr == 1) PG8_BAR;
        PG8_WAIT_V(4); PG8_BAR;
        PG8_STAGE(PG8_SB(1, 0), cB + kstep, voffB); PG8_STAGE(PG8_SA(1, 0), cA + kstep, voffA); PG8_STAGE(PG8_SB(1, 1), cB + hstep + kstep, voffB);
        PG8_WAIT_V(6); PG8_BAR;
    }
    for (;;) {
        const bool has_next = S.next(ui + 1, nxt);
        const char* nA = has_next ? (const char*)g.A + (size_t)nxt.pm * tstep : cA; const char* nB = has_next ? (const char*)g.Bt + (size_t)nxt.pn * tstep : cB;
#pragma nounroll
        for (int t = 0; t < nt; t += 2) {
            const bool last = (t == nt - 2);
            const char* a1 = cA + (size_t)(t + 1) * kstep;
            const char* a2 = last ? nA : cA + (size_t)(t + 2) * kstep; const char* b2 = last ? nB : cB + (size_t)(t + 2) * kstep;
            const char* a3 = a2 + kstep; const char* b3 = b2 + kstep;
            if (last && has_next) S.a_ready(nxt);
            if constexpr (SP2) {
            PG8_LDB(B0, 0, 0); PG8_LDB(B1, 0, 1); PG8_SCHED; PG8_LDA(At, 0, 0); PG8_STAGE(PG8_SA(1, 1), a1 + hstep, voffA);
            PG8_WAIT_V(8); PG8_WAIT_L(0); PG8_BAR; PG8_MMA(0, 0, At, B0); PG8_MMA(0, 1, At, B1); PG8_BAR; PG8_SCHED;
            PG8_LDA(At, 0, 1); PG8_STAGE(PG8_SB(0, 0), b2, voffB); PG8_STAGE(PG8_SB(0, 1), b2 + hstep, voffB); PG8_STAGE(PG8_SA(0, 0), a2, voffA);
            PG8_WAIT_V(8); PG8_WAIT_L(0); PG8_BAR; PG8_MMA(1, 0, At, B0); PG8_MMA(1, 1, At, B1); PG8_BAR; PG8_SCHED;
            PG8_LDB(B0, 1, 0); PG8_LDB(B1, 1, 1); PG8_SCHED; PG8_LDA(At, 1, 0); PG8_STAGE(PG8_SA(0, 1), a2 + hstep, voffA);
            PG8_WAIT_V(8); PG8_WAIT_L(0); PG8_BAR; PG8_MMA(0, 0, At, B0); PG8_MMA(0, 1, At, B1); PG8_BAR; PG8_SCHED;
            PG8_LDA(At, 1, 1); PG8_STAGE(PG8_SB(1, 0), b3, voffB); PG8_STAGE(PG8_SB(1, 1), b3 + hstep, voffB); PG8_STAGE(PG8_SA(1, 0), a3, voffA);
            PG8_WAIT_V(8); PG8_WAIT_L(0); PG8_BAR; PG8_MMA(1, 0, At, B0); PG8_MMA(1, 1, At, B1); PG8_BAR; PG8_SCHED;
            } else {
            PG8_LDB(B0, 0, 0); PG8_SCHED; PG8_LDA(At, 0, 0); PG8_STAGE(PG8_SA(1, 1), a1 + hstep, voffA);
            PG8_WAIT_L(8); PG8_BAR; PG8_WAIT_L(0); PG8_MMA(0, 0, At, B0); PG8_BAR; PG8_SCHED;
            PG8_LDB(B1, 0, 1); PG8_STAGE(PG8_SB(0, 0), b2, voffB);
            PG8_BAR; PG8_WAIT_L(0); PG8_MMA(0, 1, At, B1); PG8_BAR;
            PG8_LDA(At, 0, 1); PG8_STAGE(PG8_SA(0, 0), a2, voffA);
            PG8_BAR; PG8_WAIT_L(0); PG8_MMA(1, 0, At, B0); PG8_BAR; PG8_SCHED;
            PG8_STAGE(PG8_SB(0, 1), b2 + hstep, voffB);
            PG8_WAIT_V(6); PG8_BAR; PG8_MMA(1, 1, At, B1); PG8_BAR;
            PG8_LDB(B0, 1, 0); PG8_SCHED; PG8_LDA(At, 1, 0); PG8_STAGE(PG8_SA(0, 1), a2 + hstep, voffA);
            PG8_WAIT_L(8); PG8_BAR; PG8_WAIT_L(0); PG8_MMA(0, 0, At, B0); PG8_BAR; PG8_SCHED;
            PG8_LDB(B1, 1, 1); PG8_STAGE(PG8_SB(1, 0), b3, voffB);
            PG8_BAR; PG8_WAIT_L(0); PG8_MMA(0, 1, At, B1); PG8_BAR;
            PG8_LDA(At, 1, 1); PG8_STAGE(PG8_SA(1, 0), a3, voffA);
            PG8_BAR; PG8_WAIT_L(0); PG8_MMA(1, 0, At, B0); PG8_BAR; PG8_SCHED;
            PG8_STAGE(PG8_SB(1, 1), b3 + hstep, voffB);
            PG8_WAIT_V(6); PG8_BAR; PG8_MMA(1, 1, At, B1); PG8_BAR;
            }
        }
        if constexpr (ALIGN_EPI) { if (wr == 0) PG8_BAR; }
        if constexpr (FP8) asm volatile("s_nop 15\n\ts_nop 15" ::: "memory");
        if constexpr (!Epi::AFTER_DRAIN) { E(acc, cur, wr, wc, fr, fq); S.done(cur); }
        if (!has_next) break;
#pragma unroll
        for (int a = 0; a < 2; ++a)
#pragma unroll
            for (int b = 0; b < 2; ++b)
#pragma unroll
                for (int m = 0; m < 4; ++m)
#pragma unroll
                    for (int n = 0; n < 2; ++n) acc[a][b][m][n] = (f32x4){0.f, 0.f, 0.f, 0.f};
        if constexpr (FP8) asm volatile("s_nop 7" ::: "memory");
        cur = nxt; cA = nA; cB = nB; ++ui;
        if constexpr (ALIGN_EPI) { if (wr == 1) PG8_BAR; }
    }
    PG8_WAIT_V(0);
    if constexpr (!ALIGN_EPI) { if (wr == 0) PG8_BAR; }
    PG8_BAR;
    if constexpr (Epi::AFTER_DRAIN) { E.fused(acc, cur, wr, wc, fr, fq, lds, wid, lane); S.done(cur); }
#undef PG8_SA
#undef PG8_SB
#undef PG8_STAGE
#undef PG8_LDA
#undef PG8_LDB
#undef PG8_MMA
#undef PG8_WAIT_V
#undef PG8_WAIT_L
#undef PG8_BAR
#undef PG8_SCHED
}
}


#include <hip/hip_bf16.h>
#include <cmath>
namespace attn_body {
using bf16=__hip_bfloat16;
using bf16x8=__attribute__((ext_vector_type(8)))short;
using s16x4=__attribute__((ext_vector_type(4)))short;
using f32x16=__attribute__((ext_vector_type(16)))float;
using u32x4=__attribute__((ext_vector_type(4)))unsigned;
constexpr int SEQ=2048,D=64,QP=512,KVP=64,OP=1024,KVROWS=2112;
constexpr int NW=8,QBLK=32,QB=QBLK*NW,KVBLK=64,NQB=SEQ/QB,NT=KVROWS/KVBLK;
constexpr int ATTN_UNIT_ROWS=QB;
__device__ __forceinline__ int crow(int r,int hi){return (r&3)+8*(r>>2)+4*hi;}
#define SBAR() __builtin_amdgcn_sched_barrier(0)
__device__ __forceinline__ void tmask(f32x16&p0,f32x16&p1){
  const float NEG=-INFINITY;
  #pragma unroll
  for(int r=8;r<16;++r)p0[r]=NEG;
  #pragma unroll
  for(int r=0;r<16;++r)p1[r]=NEG;
}

constexpr int NSLOT=3, SLOTB=8192;
constexpr int LDS_K=0, LDS_V=NSLOT*SLOTB, LDS_WS=2*NSLOT*SLOTB, LDS_OST=LDS_WS+NW*64*4, LDS_BYTES=LDS_OST+NW*4096;
constexpr float C2=0.125f*1.4426950408889634f;
__device__ __forceinline__ void glds16(const void*gsrc,unsigned lds_dst){unsigned keep;
  asm volatile("s_mov_b32 %0, m0\n\ts_mov_b32 m0, %2\n\ts_nop 0\n\tglobal_load_lds_dwordx4 %1, off\n\ts_mov_b32 m0, %0":"=&s"(keep):"v"(gsrc),"s"(lds_dst):"memory");}
__device__ __forceinline__ float max3f(float a,float b,float c){float r;asm("v_max3_f32 %0, %1, %2, %3":"=v"(r):"v"(a),"v"(b),"v"(c));return r;}
__device__ __forceinline__ float max2f(float a,float b){float r;asm("v_max_f32_e32 %0, %1, %2":"=v"(r):"v"(a),"v"(b));return r;}
__device__ __forceinline__ float fadd_s(float a,float b){float r;asm("v_add_f32_e32 %0, %1, %2":"=v"(r):"v"(a),"v"(b));return r;}
__device__ __forceinline__ float fsub_s(float a,float b){float r;asm("v_sub_f32_e32 %0, %1, %2":"=v"(r):"v"(a),"v"(b));return r;}
typedef float f32x2_t __attribute__((ext_vector_type(2))); typedef float f32x4_t __attribute__((ext_vector_type(4))); typedef __bf16 bf16x2_t __attribute__((ext_vector_type(2)));
__device__ __forceinline__ unsigned cvtpk_s(float lo,float hi){f32x2_t v={lo,hi};bf16x2_t b=__builtin_convertvector(v,bf16x2_t);return __builtin_bit_cast(unsigned,b);}
#define WAIT_BAR(N) asm volatile("s_waitcnt vmcnt(" #N ") lgkmcnt(0)\n\ts_barrier":::"memory")

__device__ __forceinline__ void qkt(f32x16&p0,f32x16&p1,const char*Kslot,const bf16x8*qr,const f32x16&negm,int r32,int hi){
  const char*kb=Kslot+hi*1024+r32*16;
  #pragma unroll
  for(int d0=0;d0<4;++d0){
    const bf16x8 b0=*reinterpret_cast<const bf16x8*>(kb+d0*2048);
    const bf16x8 b1=*reinterpret_cast<const bf16x8*>(kb+d0*2048+512);
    if(d0==0){p0=__builtin_amdgcn_mfma_f32_32x32x16_bf16(b0,qr[0],negm,0,0,0);p1=__builtin_amdgcn_mfma_f32_32x32x16_bf16(b1,qr[0],negm,0,0,0);}
    else{p0=__builtin_amdgcn_mfma_f32_32x32x16_bf16(b0,qr[d0],p0,0,0,0);p1=__builtin_amdgcn_mfma_f32_32x32x16_bf16(b1,qr[d0],p1,0,0,0);}}
}
typedef __attribute__((address_space(3))) const char* lds_cptr;
typedef short v4i16_t __attribute__((ext_vector_type(4)));
__device__ __forceinline__ void kload8(bf16x8*kf,lds_cptr kp){
  kf[0]=*(const __attribute__((address_space(3))) bf16x8*)(kp);      kf[1]=*(const __attribute__((address_space(3))) bf16x8*)(kp+512);
  kf[2]=*(const __attribute__((address_space(3))) bf16x8*)(kp+2048); kf[3]=*(const __attribute__((address_space(3))) bf16x8*)(kp+2560);
  kf[4]=*(const __attribute__((address_space(3))) bf16x8*)(kp+4096); kf[5]=*(const __attribute__((address_space(3))) bf16x8*)(kp+4608);
  kf[6]=*(const __attribute__((address_space(3))) bf16x8*)(kp+6144); kf[7]=*(const __attribute__((address_space(3))) bf16x8*)(kp+6656);
}
__device__ __forceinline__ void kload2(bf16x8*kf,lds_cptr kp,int j){ kf[2*j]=*(const __attribute__((address_space(3))) bf16x8*)(kp+j*2048); kf[2*j+1]=*(const __attribute__((address_space(3))) bf16x8*)(kp+j*2048+512); }
__device__ __forceinline__ s16x4 vtr(lds_cptr p){ return __builtin_bit_cast(s16x4,__builtin_amdgcn_ds_read_tr16_b64_v4i16((__attribute__((address_space(3))) v4i16_t*)p)); }
__device__ __forceinline__ float rowmax(const f32x16&p0,const f32x16&p1){
  float a=max3f(p0[0],p0[1],p1[0]),b=max3f(p0[2],p0[3],p1[1]);a=max3f(a,p1[2],p1[3]);
  #pragma unroll
  for(int r=4;r<16;r+=4){a=max3f(a,p0[r],p0[r+1]);b=max3f(b,p0[r+2],p0[r+3]);a=max3f(a,p1[r],p1[r+1]);b=max3f(b,p1[r+2],p1[r+3]);}
  const float m=max2f(a,b);
  auto rr=__builtin_amdgcn_permlane32_swap(__float_as_uint(m),__float_as_uint(m),false,false);
  return max2f(__uint_as_float(rr[0]),__uint_as_float(rr[1]));
}
__device__ __forceinline__ void pv(f32x16*o,int vb,bf16x8 pa0,bf16x8 pa1,bf16x8 pa2,bf16x8 pa3){
  #pragma unroll
  for(int d0=0;d0<2;++d0){s16x4 lo[4],hi[4];
    #pragma unroll
    for(int ks=0;ks<4;++ks){
      asm volatile("ds_read_b64_tr_b16 %0,%1 offset:%c2":"=&v"(lo[ks]):"v"(vb),"i"(d0*4096+ks*1024):"memory");
      asm volatile("ds_read_b64_tr_b16 %0,%1 offset:%c2":"=&v"(hi[ks]):"v"(vb),"i"(d0*4096+ks*1024+512):"memory");}
    asm volatile("s_waitcnt lgkmcnt(0)":::"memory");SBAR();
    #define PK(k) (bf16x8){lo[k][0],lo[k][1],lo[k][2],lo[k][3],hi[k][0],hi[k][1],hi[k][2],hi[k][3]}
    o[d0]=__builtin_amdgcn_mfma_f32_32x32x16_bf16(pa0,PK(0),o[d0],0,0,0);
    o[d0]=__builtin_amdgcn_mfma_f32_32x32x16_bf16(pa1,PK(1),o[d0],0,0,0);
    o[d0]=__builtin_amdgcn_mfma_f32_32x32x16_bf16(pa2,PK(2),o[d0],0,0,0);
    o[d0]=__builtin_amdgcn_mfma_f32_32x32x16_bf16(pa3,PK(3),o[d0],0,0,0);
    #undef PK
  }
}

#ifndef ATTN_STORE16
#define ATTN_STORE16(p,v) (*(u32x4*)(p)=(v))
#endif
template<int THRL> __device__ __forceinline__ void attn_unit(int b,int h,int qb,const bf16*Q,const bf16*__restrict__ K,const bf16*__restrict__ V,bf16*O,const float*__restrict__ gain,char*shm){
  const int tid=threadIdx.x,lane=tid&63,r32=lane&31,hi=lane>>5; const int wid=__builtin_amdgcn_readfirstlane(tid>>6);
  const long rowbase=(long)b*SEQ; const int q0=qb*QB;
  const bf16*Qw=Q+(rowbase+q0+wid*QBLK)*QP+h*D;
  const bf16*Kh=K+(long)(b*2+(h>>2))*KVROWS*KVP,*Vh=V+(long)(b*2+(h>>2))*KVROWS*KVP;
  const unsigned lds0=(unsigned)(uintptr_t)shm;
  float*wsf=(float*)(shm+LDS_WS)+wid*64;
  const bf16*ksrc=Kh+(long)lane*KVP+wid*8;
  const bf16*vsrc=Vh+(long)(16*(wid&3)+(lane>>2))*KVP+(wid>>2)*32+(lane&3)*8;
  const unsigned kdst=lds0+LDS_K+wid*1024, vdst=lds0+LDS_V+wid*1024;
  #define DMA_K(t,slot) glds16(ksrc+(long)(t)*KVBLK*KVP,(unsigned)__builtin_amdgcn_readfirstlane(kdst+(slot)))
  #define DMA_V(t,slot) glds16(vsrc+(long)(t)*KVBLK*KVP,(unsigned)__builtin_amdgcn_readfirstlane(vdst+(slot)))
  const int vb0=(int)(lds0+LDS_V)+((lane>>4)&1)*32+(lane&3)*8+(4*hi+((lane&15)>>2))*64;
  const char*Kbase=shm+LDS_K; bf16x8 kf[8];
  const lds_cptr shm3=(lds_cptr)shm; const lds_cptr kp0=shm3+LDS_K+hi*1024+r32*16; const lds_cptr vp0=shm3+LDS_V+((lane>>4)&1)*32+(lane&3)*8+(4*hi+((lane&15)>>2))*64;
  DMA_K(0,0);DMA_V(0,0);DMA_K(1,SLOTB);
  bf16x8 qr[4];
  #pragma unroll
  for(int d0=0;d0<4;++d0)qr[d0]=*reinterpret_cast<const bf16x8*>(&Qw[(long)r32*QP+d0*16+hi*8]);
  float mhat=0.f,l_reg=0.f;f32x16 o[2];o[0]=f32x16{};o[1]=f32x16{};f32x16 negm=f32x16{};asm volatile("":"+v"(negm));
  #define CMASK(P0,P1,t) do{}while(0)
  bool resc=false;
  #define START(P0,P1) do{ const float rm=rowmax(P0,P1); resc=false; \
    { const float dl=rm; mhat=fadd_s(mhat,dl); \
      _Pragma("unroll") for(int r=0;r<16;++r){P0[r]=fsub_s(P0[r],dl);P1[r]=fsub_s(P1[r],dl);} \
      _Pragma("unroll") for(int r=0;r<16;++r)negm[r]=-mhat; asm volatile("":"+v"(negm)); } \
    _Pragma("unroll") for(int r=0;r<16;++r)P0[r]=__builtin_amdgcn_exp2f(P0[r]); }while(0)
  #define RESC() do{ if(resc){ asm volatile("s_waitcnt lgkmcnt(0)":::"memory"); \
      _Pragma("unroll") for(int d_=0;d_<2;++d_) _Pragma("unroll") for(int r=0;r<16;++r)o[d_][r]*=wsf[crow(r,hi)]; } }while(0)
  f32x16 pA0,pA1,pB0,pB1;
  int sl_prev=0,sl_cur=0,sl_next=SLOTB;
  #define ROT() do{sl_prev=sl_cur;sl_cur=sl_next;sl_next=(sl_next==(NSLOT-1)*SLOTB)?0:sl_next+SLOTB;}while(0)
  DMA_K(2,2*SLOTB);
  WAIT_BAR(3);
  qkt(pA0,pA1,Kbase,qr,negm,r32,hi);asm volatile("s_nop 15\n\ts_nop 7":"+v"(pA0),"+v"(pA1));CMASK(pA0,pA1,0);
  START(pA0,pA1);
  _Pragma("unroll") for(int r=0;r<16;++r)pA1[r]=__builtin_amdgcn_exp2f(pA1[r]);
  WAIT_BAR(0);
  DMA_K(3,0);DMA_V(1,SLOTB);
  ROT();
  kload8(kf,kp0+sl_cur);
  WAIT_BAR(2);
  s16x4 vlo[8],vhi[8]; u32x4 pw0,pw1,pw2,pw3;
  #define PKW(P,B) cvtpk_s(P[B],P[B+1])
  #define PAF(k) __builtin_bit_cast(bf16x8,pw##k)
  #define VFR(i) (bf16x8){vlo[i][0],vlo[i][1],vlo[i][2],vlo[i][3],vhi[i][0],vhi[i][1],vhi[i][2],vhi[i][3]}
  #define PIN(x) asm volatile("":"+v"(x))
  #define MX3(a,b,c) __builtin_fmaxf(__builtin_fmaxf((a),(b)),(c))
  #define GAPA(MF,A0,A1,A2,A3,W0,W1,PW) do{ MF; sacc+=A0; sacc+=A1; sacc+=A2; sacc+=A3; PIN(sacc); W0; W1; PIN(PW); SBAR(); }while(0)
  #define EX(v) __builtin_amdgcn_exp2f(v)
  #define GAPB(MF,X,B) do{ MF; X[B]=EX(X[B]); X[B+1]=EX(X[B+1]); X[B+2]=EX(X[B+2]); X[B+3]=EX(X[B+3]); PIN(X); SBAR(); }while(0)
  #define VRD(i) do{ vlo[i]=vtr(vp_+(((i)>>2)*4096+((i)&3)*1024)); vhi[i]=vtr(vp_+(((i)>>2)*4096+((i)&3)*1024+512)); }while(0)
  #define KRD(G,j) do{ if(G){ kload2(kf,kp0+sl_next,j); SBAR(); } }while(0)
  #define STEP(C0,C1,P0,P1,t,GK,GV,GL) do{ SBAR(); \
    const lds_cptr vp_=vp0+sl_prev; \
    VRD(0); SBAR(); float sacc=(P0[0]+P0[1]); \
    GAPA(C0=__builtin_amdgcn_mfma_f32_32x32x16_bf16(kf[0],qr[0],negm,0,0,0), P0[2],P0[3],P0[4],P0[5],     pw0[0]=PKW(P0,0), pw0[1]=PKW(P0,2), pw0); \
    VRD(4); SBAR(); GAPA(C1=__builtin_amdgcn_mfma_f32_32x32x16_bf16(kf[1],qr[0],negm,0,0,0), P0[6],P0[7],P0[8],P0[9],     pw0[2]=PKW(P0,4), pw0[3]=PKW(P0,6), pw0); \
    VRD(1); SBAR(); GAPA(C0=__builtin_amdgcn_mfma_f32_32x32x16_bf16(kf[2],qr[1],C0,0,0,0),   P0[10],P0[11],P0[12],P0[13], pw1[0]=PKW(P0,8), pw1[1]=PKW(P0,10), pw1); \
    VRD(5); SBAR(); GAPA(C1=__builtin_amdgcn_mfma_f32_32x32x16_bf16(kf[3],qr[1],C1,0,0,0),   P0[14],P0[15],P1[0],P1[1],   pw1[2]=PKW(P0,12),pw1[3]=PKW(P0,14), pw1); \
    VRD(2); SBAR(); GAPA(C0=__builtin_amdgcn_mfma_f32_32x32x16_bf16(kf[4],qr[2],C0,0,0,0),   P1[2],P1[3],P1[4],P1[5],     pw2[0]=PKW(P1,0), pw2[1]=PKW(P1,2), pw2); \
    VRD(6); SBAR(); GAPA(C1=__builtin_amdgcn_mfma_f32_32x32x16_bf16(kf[5],qr[2],C1,0,0,0),   P1[6],P1[7],P1[8],P1[9],     pw2[2]=PKW(P1,4), pw2[3]=PKW(P1,6), pw2); \
    VRD(3); SBAR(); GAPA(C0=__builtin_amdgcn_mfma_f32_32x32x16_bf16(kf[6],qr[3],C0,0,0,0),   P1[10],P1[11],P1[12],P1[13], pw3[0]=PKW(P1,8), pw3[1]=PKW(P1,10), pw3); \
    VRD(7); SBAR(); GAPA(C1=__builtin_amdgcn_mfma_f32_32x32x16_bf16(kf[7],qr[3],C1,0,0,0),   P1[14],P1[15],0.f,0.f,       pw3[2]=PKW(P1,12),pw3[3]=PKW(P1,14), pw3); \
    l_reg+=sacc; \
    if(GK){DMA_K((t)+3,sl_cur);} if(GV){DMA_V((t)+1,sl_next);} \
    CMASK(C0,C1,t); \
    { float a=MX3(C0[0],C0[1],C1[0]),b=MX3(C0[2],C0[3],C1[1]); a=MX3(a,C1[2],C1[3]); \
      _Pragma("unroll") for(int r=4;r<16;r+=4){a=MX3(a,C0[r],C0[r+1]);b=MX3(b,C0[r+2],C0[r+3]);a=MX3(a,C1[r],C1[r+1]);b=MX3(b,C1[r+2],C1[r+3]);} \
      float rm=__builtin_fmaxf(a,b); { auto rr=__builtin_amdgcn_permlane32_swap(__float_as_uint(rm),__float_as_uint(rm),false,false); rm=__builtin_fmaxf(__uint_as_float(rr[0]),__uint_as_float(rr[1])); } \
      resc=false; \
      if(__builtin_expect(__any(rm>(float)THRL),0)){ const float dl=__builtin_fmaxf(rm,0.f); mhat+=dl; \
        _Pragma("unroll") for(int r=0;r<16;++r){C0[r]-=dl;C1[r]-=dl;} \
        _Pragma("unroll") for(int r=0;r<16;++r)negm[r]=-mhat; asm volatile("":"+v"(negm)); \
        const float f=__builtin_amdgcn_exp2f(-dl); l_reg*=f; if(hi==0)wsf[r32]=f; resc=true; } } \
    SBAR(); \
    GAPB(o[0]=__builtin_amdgcn_mfma_f32_32x32x16_bf16(PAF(0),VFR(0),o[0],0,0,0), C0,0); \
    GAPB(o[1]=__builtin_amdgcn_mfma_f32_32x32x16_bf16(PAF(0),VFR(4),o[1],0,0,0), C0,4); \
    KRD(GL,0); GAPB(o[0]=__builtin_amdgcn_mfma_f32_32x32x16_bf16(PAF(1),VFR(1),o[0],0,0,0), C0,8); \
    KRD(GL,1); GAPB(o[1]=__builtin_amdgcn_mfma_f32_32x32x16_bf16(PAF(1),VFR(5),o[1],0,0,0), C0,12); \
    KRD(GL,2); GAPB(o[0]=__builtin_amdgcn_mfma_f32_32x32x16_bf16(PAF(2),VFR(2),o[0],0,0,0), C1,0); \
    KRD(GL,3); GAPB(o[1]=__builtin_amdgcn_mfma_f32_32x32x16_bf16(PAF(2),VFR(6),o[1],0,0,0), C1,4); \
    GAPB(o[0]=__builtin_amdgcn_mfma_f32_32x32x16_bf16(PAF(3),VFR(3),o[0],0,0,0), C1,8); \
    GAPB(o[1]=__builtin_amdgcn_mfma_f32_32x32x16_bf16(PAF(3),VFR(7),o[1],0,0,0), C1,12); \
    }while(0)
  int t=1;
  #undef CMASK
  #define CMASK(P0,P1,t) do{}while(0)
  for(;t+5<NT;t+=2){
    STEP(pB0,pB1,pA0,pA1,t,true,true,true);     WAIT_BAR(2); RESC(); ROT();
    STEP(pA0,pA1,pB0,pB1,t+1,true,true,true);   WAIT_BAR(2); RESC(); ROT();
  }
  #undef CMASK
  #define CMASK(P0,P1,t) do{ if((t)==NT-1)tmask(P0,P1); }while(0)
  #define ENDW(tt) do{ if((tt)+3<NT){WAIT_BAR(2);} else if((tt)+2<NT){WAIT_BAR(1);} else {WAIT_BAR(0);} }while(0)
  for(;t+1<NT;t+=2){
    STEP(pB0,pB1,pA0,pA1,t,(t+3<NT),(t+1<NT),(t+1<NT));       ENDW(t);   RESC(); ROT();
    STEP(pA0,pA1,pB0,pB1,t+1,(t+4<NT),(t+2<NT),(t+2<NT));     ENDW(t+1); RESC(); ROT();
  }
  static_assert((NT&1)==1&&NT>=7,"odd tile count: the pair loops end on tile NT-1 (scores in buffer A)");
  { float sacc=pA0[0]+pA0[1]; _Pragma("unroll") for(int r=2;r<16;++r)sacc+=pA0[r]; _Pragma("unroll") for(int r=0;r<16;++r)sacc+=pA1[r]; l_reg+=sacc;
    pw0=(u32x4){PKW(pA0,0),PKW(pA0,2),PKW(pA0,4),PKW(pA0,6)};pw1=(u32x4){PKW(pA0,8),PKW(pA0,10),PKW(pA0,12),PKW(pA0,14)};pw2=(u32x4){PKW(pA1,0),PKW(pA1,2),PKW(pA1,4),PKW(pA1,6)};pw3=(u32x4){PKW(pA1,8),PKW(pA1,10),PKW(pA1,12),PKW(pA1,14)};
    SBAR(); pv(o,vb0+sl_prev,PAF(0),PAF(1),PAF(2),PAF(3)); }
  #undef PKW
  #undef PAF
  #undef VFR
  #undef PIN
  #undef MX3
  #undef GAPA
  #undef GAPB
  #undef EX
  #undef VRD
  #undef KRD
  #undef STEP
  #undef ENDW
  {auto rr=__builtin_amdgcn_permlane32_swap(__float_as_uint(l_reg),__float_as_uint(l_reg),false,false);l_reg=__uint_as_float(rr[0])+__uint_as_float(rr[1]);}
  if(hi==0)wsf[32+r32]=l_reg;asm volatile("s_waitcnt lgkmcnt(0)":::"memory");
  float rli[16];
  #pragma unroll
  for(int r=0;r<16;++r)rli[r]=__builtin_amdgcn_rcpf(wsf[32+crow(r,hi)]);
  bf16*Ow=O+(rowbase+q0+wid*QBLK)*OP+h*D;
  { bf16*stg=(bf16*)(shm+LDS_OST)+wid*2048;
    #pragma unroll
    for(int r=0;r<16;++r){const int orow=crow(r,hi);
      #pragma unroll
      for(int d0=0;d0<2;++d0)stg[orow*64+d0*32+r32]=__float2bfloat16(o[d0][r]*rli[r]);}
    asm volatile("s_waitcnt lgkmcnt(0)":::"memory");
    #pragma unroll
    for(int i=0;i<4;++i){const int row=i*8+(lane>>3),ch=lane&7; const u32x4 v=*(const u32x4*)(stg+row*64+ch*8);
      float f[8]; f[0]=__uint_as_float(v.x<<16);f[1]=__uint_as_float(v.x&0xffff0000u);f[2]=__uint_as_float(v.y<<16);f[3]=__uint_as_float(v.y&0xffff0000u);
      f[4]=__uint_as_float(v.z<<16);f[5]=__uint_as_float(v.z&0xffff0000u);f[6]=__uint_as_float(v.w<<16);f[7]=__uint_as_float(v.w&0xffff0000u);
      float ss=0.f; _Pragma("unroll") for(int j=0;j<8;++j)ss+=f[j]*f[j];
      ss+=__shfl_xor(ss,1);ss+=__shfl_xor(ss,2);ss+=__shfl_xor(ss,4);
      const float rs=1.0f/sqrtf(ss*(1.0f/64.0f)+1e-6f); const f32x4_t g0=*(const f32x4_t*)(gain+h*D+ch*8),g1=*(const f32x4_t*)(gain+h*D+ch*8+4);
      u32x4 w; w[0]=cvtpk_s(f[0]*rs*g0[0],f[1]*rs*g0[1]);w[1]=cvtpk_s(f[2]*rs*g0[2],f[3]*rs*g0[3]);w[2]=cvtpk_s(f[4]*rs*g1[0],f[5]*rs*g1[1]);w[3]=cvtpk_s(f[6]*rs*g1[2],f[7]*rs*g1[3]);
      ATTN_STORE16(Ow+(long)row*OP+ch*8,w);} }
  asm volatile("s_waitcnt lgkmcnt(0)\n\ts_barrier":::"memory");
  #undef DMA_K
  #undef DMA_V
  #undef CMASK
  #undef START
  #undef RESC
  #undef ROT
}
constexpr int ATTN_LDS_BYTES=LDS_BYTES;
struct AttnTensors { const bf16* Q; const bf16* K; const bf16* V; bf16* O; const float* gain; };
struct AttnUnit { int b; int h; int qb; };
struct StaticOrder {
  int vcu;
  __device__ __forceinline__ explicit StaticOrder(int grid_,int block):vcu((grid_%8==0)?(block%8)*(grid_/8)+block/8:block),grid(grid_){}
  int grid;
  __device__ __forceinline__ bool next(int i,AttnUnit&u)const{ const int n=i*grid+vcu,pair=n>>5; if(pair>=48)return false; const int s=n&31; u.b=pair>>1; u.h=4*(pair&1)+(s>>3); u.qb=s&7; return true; }
};
template<class Sched,class Side,int THRL=8> __device__ __forceinline__ void attn_phase(char*lds,const AttnTensors&T,const Sched&S,int kside,const Side&side){
  AttnUnit u; int i=0;
  for(;i<kside&&S.next(i,u);++i){ attn_unit<THRL>(u.b,u.h,u.qb,T.Q,T.K,T.V,T.O,T.gain,lds); }
  side();
  for(;S.next(i,u);++i){ attn_unit<THRL>(u.b,u.h,u.qb,T.Q,T.K,T.V,T.O,T.gain,lds); }
}
#undef SBAR
#undef WAIT_BAR
}

typedef __attribute__((address_space(1))) unsigned gu32;
#define XB_TMO      128
#define XB_XCNT(j)  (256  + 64 * (j))
#define XB_XSUB(j)  (1280 + 64 * (j))
#define XB_XGEN(j)  (2304 + 64 * (j))
#define XB_TOP      3328
#define XB_TOPGEN   3392
#define XCD_BAR_WORDS 3456
#define XB_SPIN_CAP (1u << 18)

__device__ __forceinline__ unsigned xb_ld(unsigned* p)              { return __hip_atomic_load(p, __ATOMIC_RELAXED, __HIP_MEMORY_SCOPE_AGENT); }
__device__ __forceinline__ unsigned xb_add(unsigned* p, unsigned v) { return __hip_atomic_fetch_add(p, v, __ATOMIC_RELAXED, __HIP_MEMORY_SCOPE_AGENT); }
__device__ __forceinline__ unsigned xb_xcc_id() { return (unsigned)__builtin_amdgcn_s_getreg((3 << 11) | 20) & 0xFu; }
#define XB_SPIN(cond, bar) do { unsigned _sp = 0; while (cond) { __builtin_amdgcn_s_sleep(1); \
    if ((++_sp & 255u) == 0u) { if (xb_ld(&(bar)[XB_TMO])) break; if (_sp > XB_SPIN_CAP) { atomicAdd(&(bar)[XB_TMO], 1u); break; } } } } while (0)

struct XcdBarrier {
    unsigned* bar; unsigned x;
    volatile LAS unsigned* st;
};

__device__ __forceinline__ XcdBarrier xcd_barrier_post(unsigned* bar, volatile LAS unsigned* st) {
    XcdBarrier b; b.bar = bar; b.x = xb_xcc_id(); b.st = st;
    if (threadIdx.x == 0) (void)xb_add(&bar[XB_XCNT(b.x)], 1u);
    return b;
}
__device__ __forceinline__ void xcd_barrier_complete(unsigned* bar, unsigned x, unsigned& nloc, unsigned& nx) {
    const unsigned G = gridDim.x * gridDim.y * gridDim.z;
    unsigned sum, cnt, mine, sp = 0u;
    for (;;) {
        sum = 0u; cnt = 0u; mine = 0u;
#pragma unroll
        for (unsigned j = 0; j < 16; ++j) { const unsigned c = xb_ld(&bar[XB_XCNT(j)]); sum += c; cnt += (c > 0u) ? 1u : 0u; mine = (j == x) ? c : mine; }
        if (sum == G) break;
        __builtin_amdgcn_s_sleep(1);
        if ((++sp & 255u) == 0u) { if (xb_ld(&bar[XB_TMO])) break; if (sp > XB_SPIN_CAP) { atomicAdd(&bar[XB_TMO], 1u); break; } }
    }
    nloc = mine > 0u ? mine : 1u; nx = cnt > 0u ? cnt : 1u;
}

__device__ __forceinline__ void xcd_barrier(const XcdBarrier& b) {
    asm volatile("s_waitcnt vmcnt(0)" ::: "memory");
    __syncthreads();
    if (threadIdx.x == 0) {
        unsigned* bar = b.bar;
        __builtin_amdgcn_s_waitcnt(0);
        unsigned nloc = b.st[0], nx = b.st[1];
        if (nloc == 0u) { xcd_barrier_complete(bar, b.x, nloc, nx); b.st[0] = nloc; b.st[1] = nx; }
        const unsigned old = xb_add(&bar[XB_XSUB(b.x)], 1u);
        const unsigned gen = old / nloc;
        if (old + 1u == (gen + 1u) * nloc) {
            __builtin_amdgcn_fence(__ATOMIC_RELEASE, "agent");
            asm volatile("s_waitcnt vmcnt(0)" ::: "memory");
            const unsigned og = xb_add(&bar[XB_TOP], 1u);
            const unsigned tg = og / nx;
            if (og + 1u == (tg + 1u) * nx) xb_add(&bar[XB_TOPGEN], 1u);
            else XB_SPIN(xb_ld(&bar[XB_TOPGEN]) == tg, bar);
            __builtin_amdgcn_fence(__ATOMIC_ACQUIRE, "agent");
            xb_add(&bar[XB_XGEN(b.x)], 1u);
            asm volatile("s_waitcnt vmcnt(0)" ::: "memory");
        } else {
            XB_SPIN(xb_ld(&bar[XB_XGEN(b.x)]) == gen, bar);
            __builtin_amdgcn_fence(__ATOMIC_ACQUIRE, "agent");
            asm volatile("s_waitcnt vmcnt(0)" ::: "memory");
        }
    }
    __syncthreads();
}


__global__ void __launch_bounds__(NTHR, 2) enc_fwd(Args a) {
    extern __shared__ __attribute__((aligned(16))) unsigned char lds[];
    cg::grid_group grid = cg::this_grid();
    const int tid = threadIdx.x, lane = tid & 63, wave = __builtin_amdgcn_readfirstlane(tid >> 6);
    const int G = gridDim.x, gw = blockIdx.x * NWAVES + wave, NGW = G * NWAVES;
    const int lo = a.ph_lo, hi = a.ph_hi;
    volatile LAS unsigned* MISC = (volatile LAS unsigned*)((LAS unsigned char*)lds + LDS_BYTES - 64);
    if (tid < 16) MISC[tid] = 0u;
    __syncthreads();
    (void)xcd_barrier_post((unsigned*)(a.ws + WS_CTL) + 4096, MISC);
#define IN(k) (lo <= (k) && (k) < hi)
#ifndef PROBE_X2
#define PROBE_X2 -1
#endif
#define REP(k) for (int rep_ = 0; rep_ < ((k) == PROBE_X2 ? 2 : 1); ++rep_)
#define SEAM(k) do { if (IN(k) && IN((k) + 1)) { if (lo > 1000) grid.sync();   { XcdBarrier bar_; bar_.bar = (unsigned*)(a.ws + WS_CTL) + 4096; bar_.x = xb_xcc_id(); bar_.st = MISC; xcd_barrier(bar_); } } } while (0)
    if (IN(0)) REP(0) { p0_prologue(a, lds, tid, lane, wave); } SEAM(0);
    if (IN(1)) REP(1) { pg8::Gemm g{(const bf16_t*)(a.ws + WS_XA), (const bf16_t*)(a.ws + WS_WIN), NTOK, INW, DM}; pg8::StaticOrder S; S.init(NTOK, INW, G, (int)blockIdx.x);
        pg8::EpiInProj E{(bf16_t*)(a.ws + WS_Z), (bf16_t*)(a.ws + WS_Q), (bf16_t*)(a.ws + WS_KB), (bf16_t*)(a.ws + WS_VB), (const float*)(a.ws + WS_ROPE), a.qg, a.kg};
        kv_meta_rows(a, lane, gw, NGW);
        pg8::gemm_phase<pg8::EpiInProj, pg8::StaticOrder, true, true>((LAS unsigned char*)lds, g, S, E); } SEAM(1);
    if (IN(3)) REP(3) { const attn_body::AttnTensors AT{(const attn_body::bf16*)(a.ws + WS_Q), (const attn_body::bf16*)(a.ws + WS_KB), (const attn_body::bf16*)(a.ws + WS_VB), (attn_body::bf16*)(a.ws + WS_XA) + 512, a.attn_g};
        const attn_body::StaticOrder S(G, (int)blockIdx.x);
        auto side = [&]() { p2_pass(a, lane, gw, NGW);
            __syncthreads(); };
        attn_body::attn_phase<attn_body::StaticOrder>((char*)lds, AT, S, (int)((blockIdx.x >> 3) * 6) >> 5, side); } SEAM(3);
    if (IN(4)) REP(4) { pg8::Gemm g{(const bf16_t*)(a.ws + WS_XA), (const bf16_t*)(a.ws + WS_WOUT), NTOK, DM, DM}; pg8::StaticOrder S; S.init(NTOK, DM, G, (int)blockIdx.x);
        pg8::EpiResidNorm E{a.xp, a.xs, a.out, NBP * SEQ, (bf16_t*)(a.ws + WS_HB), a.ws + WS_X8, (float*)(a.ws + WS_SS), X8SCALE};
        pg8::gemm_phase<pg8::EpiResidNorm, pg8::StaticOrder, true, true>((LAS unsigned char*)lds, g, S, E); } SEAM(4);
    if (IN(6)) REP(6) { pg8::Gemm g{(const bf16_t*)(a.ws + WS_X8), (const bf16_t*)(a.ws + WS_WQ), NTOK, PQ, DM / 2}; pg8::StaticOrder S; S.init(NTOK, PQ, G, (int)blockIdx.x);
        pg8::EpiBf16 E{(bf16_t*)(a.ws + WS_QP), PQ, 1.0f / (X8SCALE * WQSCALE)};
        pg8::gemm_phase<pg8::EpiBf16, pg8::StaticOrder, true, true, true>((LAS unsigned char*)lds, g, S, E); } SEAM(6);
    if (IN(7)) REP(7) { p7_topk(a, lds, tid, lane, wave);
        table_fp4<false>(a.pu, a.ws + WS_UT, (float*)(a.ws + WS_USC), a.g_ffn, gw, NGW, lane);
        table_fp4<true>(a.pv, a.ws + WS_UT + 4 * SLICE4, (float*)(a.ws + WS_VSC), nullptr, gw, NGW, lane);
        __syncthreads(); } SEAM(7);
    if (IN(8)) REP(8) { p8a_u(a, lane, wave); } SEAM(8);
    if (IN(9)) REP(9) { p8c_combine(a, lds, tid); __syncthreads(); } SEAM(9);
    if (IN(10)) REP(10) { p8b_v(a, lds, lane, wave, rep_ == ((10 == PROBE_X2) ? 1 : 0)); }
#undef IN
#undef SEAM
}

extern "C" void kernel_launch(void* const* d_in, const int* in_sizes, int n_in, void* d_out, int out_size, void* d_ws, size_t ws_size, hipStream_t stream) {
    static int grid = 0;
    if (grid == 0) {
        if (n_in != 16 || out_size != NTOK * DM || ws_size < WS_END) { fprintf(stderr, "kernel_launch: unexpected shapes (n_in %d out %d ws %zu)\n", n_in, out_size, ws_size); grid = -1; return; }
        int dev = 0, cus = 0, per_cu = 0;
        (void)hipGetDevice(&dev); (void)hipDeviceGetAttribute(&cus, hipDeviceAttributeMultiprocessorCount, dev);
        (void)hipFuncSetAttribute((const void*)enc_fwd, hipFuncAttributeMaxDynamicSharedMemorySize, LDS_BYTES);
        (void)hipOccupancyMaxActiveBlocksPerMultiprocessor(&per_cu, (const void*)enc_fwd, NTHR, LDS_BYTES);
        if (per_cu < 1) { fprintf(stderr, "kernel_launch: occupancy query says %d blocks/CU\n", per_cu); per_cu = 1; }
        (void)hipGetLastError();
        grid = cus * 1;
    }
    if (grid < 0) return;
    (void)hipMemsetAsync((char*)d_ws + WS_CTL, 0, 64 * 1024, stream);
    Args a{};
    a.xp = (const float*)d_in[0]; a.xs = (const float*)d_in[1]; a.meta = (const float*)d_in[2]; a.g_mix = (const float*)d_in[3]; a.w_in = (const float*)d_in[4];
    a.conv_w = (const float*)d_in[5]; a.qg = (const float*)d_in[6]; a.kg = (const float*)d_in[7]; a.conv_g = (const float*)d_in[8]; a.attn_g = (const float*)d_in[9];
    a.w_out = (const float*)d_in[10]; a.g_ffn = (const float*)d_in[11]; a.wq = (const float*)d_in[12]; a.subk = (const float*)d_in[13]; a.pu = (const float*)d_in[14]; a.pv = (const float*)d_in[15];
    a.out = (float*)d_out; a.ws = (unsigned char*)d_ws;
    constexpr int NL = MK_N_LAUNCHES;
    for (int li = 0; li < NL; ++li) {
        a.ph_lo = (NL == 1) ? 0 : li; a.ph_hi = (NL == 1) ? NPHASE : li + 1;
        void* args[] = {&a};
        hipError_t e = hipLaunchCooperativeKernel((const void*)enc_fwd, dim3(grid), dim3(NTHR), args, LDS_BYTES, stream);
        if (e != hipSuccess) { fprintf(stderr, "kernel_launch: launch %d failed: %s\n", li, hipGetErrorString(e)); break; }
    }
}
```

```cpp
#include <hip/hip_runtime.h>
#include <hip/hip_cooperative_groups.h>
#include <cstdint>
#include <cstdio>
namespace cg = cooperative_groups;

#ifndef MK_N_LAUNCHES
#define MK_N_LAUNCHES 1
#endif

typedef unsigned short bf16_t;
typedef short bf16x8 __attribute__((ext_vector_type(8)));
typedef float f32x4 __attribute__((ext_vector_type(4)));
typedef unsigned u32x4 __attribute__((ext_vector_type(4)));
typedef unsigned u32x2 __attribute__((ext_vector_type(2)));
#define LAS __attribute__((address_space(3)))

constexpr int NB = 24, NBP = 16, SEQ = 2048, DM = 1024, NTOK = NB * SEQ;
constexpr int NMETA = 16, INW = 2304, KROWS = 2112;
constexpr int NKEYS = SEQ + NMETA;
constexpr int PQ = 2048;
constexpr float EPS = 1e-6f;
constexpr float C2 = 0.125f * 1.4426950408889634f;
constexpr int NWAVES = 8, NTHR = 512;
constexpr int LDS_BYTES = 163840;
constexpr int NPHASE = 11;

constexpr size_t MiB = 1u << 20;
constexpr size_t WS_CTL = 0;
constexpr size_t WS_WIN = 1 * MiB;
constexpr size_t WS_WOUT = 6 * MiB;
constexpr size_t WS_WQ = 8 * MiB;
constexpr size_t WS_SUBK = 12 * MiB;
constexpr size_t WS_ZMETA = 12 * MiB + 512 * 1024;
constexpr size_t WS_ROPE = WS_ZMETA + 256 * 1024;
constexpr size_t WS_UT = 13 * MiB;
constexpr size_t WS_USC = 29 * MiB, WS_VSC = WS_USC + 64 * 1024;
constexpr size_t WS_SS = WS_USC + 256 * 1024;
constexpr size_t SLICE4 = (size_t)16384 * 128;
constexpr size_t WS_XA = 32 * MiB;
constexpr size_t WS_EI = WS_XA, WS_GT = WS_XA + 12 * MiB;
constexpr size_t WS_Z = 128 * MiB;
constexpr size_t WS_R8 = WS_Z;
constexpr size_t WS_QP = WS_Z + 96 * MiB;
constexpr size_t WS_PB = WS_QP;
constexpr size_t WS_AB = WS_PB + (size_t)4 * 49152 * 128 * 4;
constexpr size_t WS_Q = 416 * MiB;
constexpr size_t WS_X8 = WS_Q;
constexpr size_t WS_KB = 464 * MiB;
constexpr size_t WS_VB = 477 * MiB;
constexpr size_t WS_END = 490 * MiB;
constexpr float X8SCALE = 8.0f;
constexpr float R8SCALE = 16.0f;
constexpr float WQSCALE = 64.0f;
constexpr float A8SCALE = 256.0f;

struct Args {
    const float* xp; const float* xs; const float* meta; const float* g_mix; const float* w_in; const float* conv_w;
    const float* qg; const float* kg; const float* conv_g; const float* attn_g; const float* w_out; const float* g_ffn;
    const float* wq; const float* subk; const float* pu; const float* pv;
    float* out; unsigned char* ws; int ph_lo, ph_hi;
};

__device__ __forceinline__ unsigned f2bf(float f) { unsigned u = __builtin_bit_cast(unsigned, f); return (u + 0x7fffu + ((u >> 16) & 1u)) >> 16; }
typedef float f32x2_pk __attribute__((ext_vector_type(2))); typedef __bf16 bf16x2_pk __attribute__((ext_vector_type(2)));
__device__ __forceinline__ unsigned pk2(float lo, float hi) { const f32x2_pk v = {lo, hi}; const bf16x2_pk b = __builtin_convertvector(v, bf16x2_pk); return __builtin_bit_cast(unsigned, b); }
__device__ __forceinline__ float bflo(unsigned w) { return __builtin_bit_cast(float, w << 16); }
__device__ __forceinline__ float bfhi(unsigned w) { return __builtin_bit_cast(float, w & 0xffff0000u); }
__device__ __forceinline__ float bf2f(bf16_t h) { return __builtin_bit_cast(float, (unsigned)h << 16); }
__device__ __forceinline__ void unpack8(u32x4 w, float* f) {
    f[0] = bflo(w.x); f[1] = bfhi(w.x); f[2] = bflo(w.y); f[3] = bfhi(w.y); f[4] = bflo(w.z); f[5] = bfhi(w.z); f[6] = bflo(w.w); f[7] = bfhi(w.w);
}
__device__ __forceinline__ u32x4 pack8(const float* f) { u32x4 w; w.x = pk2(f[0], f[1]); w.y = pk2(f[2], f[3]); w.z = pk2(f[4], f[5]); w.w = pk2(f[6], f[7]); return w; }
__device__ __forceinline__ float wave_sum(float v) {
#pragma unroll
    for (int o = 1; o < 64; o <<= 1) v += __shfl_xor(v, o);
    return v;
}
__device__ __forceinline__ float wave_max(float v) {
#pragma unroll
    for (int o = 1; o < 64; o <<= 1) v = fmaxf(v, __shfl_xor(v, o));
    return v;
}
__device__ __forceinline__ const float* xrow_ptr(const Args& a, int r) { return r < NBP * SEQ ? a.xp + (size_t)r * DM : a.xs + (size_t)(r - NBP * SEQ) * DM; }

__device__ __forceinline__ int permin(int n  ) {
    if (n >= 512 && n < 1536) { const int hc = (n - 512) >> 9, c = (n - 512) & 511; return 512 + (c >> 7) * 256 + hc * 128 + (c & 127); }
    if (n >= 1536 && n < 2048) { const int c = n - 1536, hh = c >> 6, half = (c >> 5) & 1; return 1536 + 256 * (hh >> 2) + 128 * half + 32 * (hh & 3) + (c & 31); }
    if (n >= 2048) { const int c = n - 2048, s = c >> 6, half = (c >> 5) & 1; return 2048 + 128 * half + 32 * s + (c & 31); }
    return n; }
__device__ __forceinline__ void p0_transpose_item(const float* W, int K, int N, bf16_t* WT, float* scr, int item, int lane, const float* gk = nullptr  , bool dperm = false) {
    const int nblk = N / 32, kb = item / nblk, nb = item % nblk, k0 = 64 * kb, n0 = 32 * nb, nd0 = dperm ? permin(n0) : n0;
#pragma unroll 8
    for (int i = 0; i < 32; ++i) { const int kk = 2 * i + (lane >> 5); scr[kk * 33 + (lane & 31)] = W[(size_t)(k0 + kk) * N + n0 + (lane & 31)] * (gk ? gk[k0 + kk] : 1.0f); }
    asm volatile("s_waitcnt lgkmcnt(0)" ::: "memory");
    const int c = lane & 7;
#pragma unroll
    for (int j = 0; j < 4; ++j) { const int n = (lane >> 3) + 8 * j; const float* s = scr + (8 * c) * 33 + n;
        u32x4 o; o.x = pk2(s[0 * 33], s[1 * 33]); o.y = pk2(s[2 * 33], s[3 * 33]); o.z = pk2(s[4 * 33], s[5 * 33]); o.w = pk2(s[6 * 33], s[7 * 33]);
        *(u32x4*)(WT + (size_t)(nd0 + n) * K + k0 + 8 * c) = o; }
    asm volatile("s_waitcnt lgkmcnt(0)" ::: "memory");
}
__device__ __forceinline__ void p0_transpose_item_fp8(const float* W, int K, int N, unsigned char* WT, float* scr, int item, int lane, const float* gk, float wscale) {
    const int nblk = N / 32, kb = item / nblk, nb = item % nblk, k0 = 64 * kb, n0 = 32 * nb;
#pragma unroll 8
    for (int i = 0; i < 32; ++i) { const int kk = 2 * i + (lane >> 5); scr[kk * 33 + (lane & 31)] = W[(size_t)(k0 + kk) * N + n0 + (lane & 31)] * (gk[k0 + kk] * wscale); }
    asm volatile("s_waitcnt lgkmcnt(0)" ::: "memory");
    const int c = lane & 7;
#pragma unroll
    for (int j = 0; j < 4; ++j) { const int n = (lane >> 3) + 8 * j; const float* s = scr + (8 * c) * 33 + n;
        unsigned w0 = (unsigned)__builtin_amdgcn_cvt_pk_fp8_f32(s[0 * 33], s[1 * 33], 0, false); w0 = (unsigned)__builtin_amdgcn_cvt_pk_fp8_f32(s[2 * 33], s[3 * 33], (int)w0, true);
        unsigned w1 = (unsigned)__builtin_amdgcn_cvt_pk_fp8_f32(s[4 * 33], s[5 * 33], 0, false); w1 = (unsigned)__builtin_amdgcn_cvt_pk_fp8_f32(s[6 * 33], s[7 * 33], (int)w1, true);
        *(u32x2*)(WT + (size_t)(n0 + n) * K + k0 + 8 * c) = (u32x2){w0, w1}; }
    asm volatile("s_waitcnt lgkmcnt(0)" ::: "memory");
}
__device__ __forceinline__ void cast_region(const float* src, bf16_t* dst, size_t n, size_t gtid, size_t nthreads) {
    for (size_t i = gtid * 8; i < n; i += nthreads * 8) {
        const f32x4 a = *(const f32x4*)(src + i), b = *(const f32x4*)(src + i + 4);
        u32x4 o; o.x = pk2(a.x, a.y); o.y = pk2(a.z, a.w); o.z = pk2(b.x, b.y); o.w = pk2(b.z, b.w);
        *(u32x4*)(dst + i) = o;
    }
}
template <bool PERM64> __device__ __forceinline__ void table_fp4(const float* src, unsigned char* dst, float* scale, const float* gcol  , int gw, int NGW, int lane) {
    f32x4 v[4], vn[4], g[4];
#pragma unroll
    for (int j = 0; j < 4; ++j) g[j] = gcol ? *(const f32x4*)(gcol + lane * 16 + 4 * j) : (f32x4){1.f, 1.f, 1.f, 1.f};
    if (gw < 16384) {
#pragma unroll
        for (int j = 0; j < 4; ++j) v[j] = *(const f32x4*)(src + (size_t)gw * DM + lane * 16 + 4 * j); }
    for (int row = gw; row < 16384; row += NGW) {
        { const int rn = row + NGW < 16384 ? row + NGW : row;
#pragma unroll
          for (int j = 0; j < 4; ++j) vn[j] = *(const f32x4*)(src + (size_t)rn * DM + lane * 16 + 4 * j); }
        float m = 0.f;
#pragma unroll
        for (int j = 0; j < 4; ++j) { v[j] = v[j] * g[j]; m = fmaxf(fmaxf(m, fmaxf(fabsf(v[j].x), fabsf(v[j].y))), fmaxf(fabsf(v[j].z), fabsf(v[j].w))); }
        m = wave_max(m);
        const float s = fmaxf(m, 1e-30f) * (1.0f / 6.0f), inv = 1.0f / s;
        unsigned char* rowp = dst + (size_t)(lane >> 4) * SLICE4 + (size_t)row * 128;
        if (!PERM64) {
            unsigned w0 = 0u, w1 = 0u;
            w0 = __builtin_amdgcn_cvt_scalef32_pk_fp4_f32(w0, v[0].x * inv, v[0].y * inv, 1.0f, 0); w0 = __builtin_amdgcn_cvt_scalef32_pk_fp4_f32(w0, v[0].z * inv, v[0].w * inv, 1.0f, 1);
            w0 = __builtin_amdgcn_cvt_scalef32_pk_fp4_f32(w0, v[1].x * inv, v[1].y * inv, 1.0f, 2); w0 = __builtin_amdgcn_cvt_scalef32_pk_fp4_f32(w0, v[1].z * inv, v[1].w * inv, 1.0f, 3);
            w1 = __builtin_amdgcn_cvt_scalef32_pk_fp4_f32(w1, v[2].x * inv, v[2].y * inv, 1.0f, 0); w1 = __builtin_amdgcn_cvt_scalef32_pk_fp4_f32(w1, v[2].z * inv, v[2].w * inv, 1.0f, 1);
            w1 = __builtin_amdgcn_cvt_scalef32_pk_fp4_f32(w1, v[3].x * inv, v[3].y * inv, 1.0f, 2); w1 = __builtin_amdgcn_cvt_scalef32_pk_fp4_f32(w1, v[3].z * inv, v[3].w * inv, 1.0f, 3);
            *(u32x2*)(rowp + (lane & 15) * 8) = (u32x2){w0, w1};
        } else {
            unsigned wmv[4];
#pragma unroll
            for (int m = 0; m < 4; ++m) { unsigned wm = 0u;
                wm = __builtin_amdgcn_cvt_scalef32_pk_fp4_f32(wm, v[0][m] * inv, v[1][m] * inv, 1.0f, 0); wm = __builtin_amdgcn_cvt_scalef32_pk_fp4_f32(wm, v[2][m] * inv, v[3][m] * inv, 1.0f, 1);
                wmv[m] = wm & 0xffffu; }
            const int me = lane & 3;
            const unsigned P01 = wmv[0] | (wmv[1] << 16), P23 = wmv[2] | (wmv[3] << 16);
#define TFIELD(idx) ((((idx) & 2) ? P23 : P01) >> (16 * ((idx) & 1)) & 0xffffu)
            const unsigned r0 = TFIELD(me);
            const unsigned r1 = (unsigned)__builtin_amdgcn_mov_dpp((int)TFIELD((me + 3) & 3), 0x39, 0xf, 0xf, true);
            const unsigned r2 = (unsigned)__builtin_amdgcn_mov_dpp((int)TFIELD((me + 2) & 3), 0x4E, 0xf, 0xf, true);
            const unsigned r3 = (unsigned)__builtin_amdgcn_mov_dpp((int)TFIELD((me + 1) & 3), 0x93, 0xf, 0xf, true);
#undef TFIELD
            const unsigned Q01 = r0 | (r1 << 16), Q23 = r2 | (r3 << 16), QA = __builtin_amdgcn_alignbyte(Q01, Q23, 2), QB = __builtin_amdgcn_alignbyte(Q23, Q01, 2);
            const unsigned lo = me == 0 ? Q01 : me == 1 ? QA : me == 2 ? Q23 : QB, hi = me == 0 ? Q23 : me == 1 ? QB : me == 2 ? Q01 : QA;
            *(u32x2*)(rowp + ((lane & 15) >> 2) * 32 + 8 * me) = (u32x2){lo, hi};
        }
        if (lane == 0) scale[row] = s;
#pragma unroll
        for (int j = 0; j < 4; ++j) v[j] = vn[j];
    }
}
__device__ __forceinline__ void p0_prologue(const Args& a, unsigned char* lds, int tid, int lane, int wave) {
    const int G = gridDim.x, gw = blockIdx.x * NWAVES + wave, NGW = G * NWAVES;
    float* ldsf = (float*)lds;
    f32x4 v[4];
    if (gw < NTOK) { const float* xr = xrow_ptr(a, gw);
#pragma unroll
        for (int j = 0; j < 4; ++j) v[j] = __builtin_nontemporal_load((const f32x4*)(xr + (lane + 64 * j) * 4)); }
    if (blockIdx.x < INW / 64) {
        float* xm = ldsf;
        float* red = ldsf + 16 * 1024;
#pragma unroll
        for (int rr = 0; rr < 2; ++rr) { const int r = 2 * wave + rr; f32x4 v[4]; float ss = 0.f;
#pragma unroll
            for (int j = 0; j < 4; ++j) { v[j] = *(const f32x4*)(a.meta + (size_t)r * DM + (lane + 64 * j) * 4); ss += v[j].x * v[j].x + v[j].y * v[j].y + v[j].z * v[j].z + v[j].w * v[j].w; }
            const float rstd = 1.0f / sqrtf(wave_sum(ss) * (1.0f / DM) + EPS);
#pragma unroll
            for (int j = 0; j < 4; ++j) { const int c = (lane + 64 * j) * 4; const f32x4 g = *(const f32x4*)(a.g_mix + c); *(f32x4*)(xm + r * 1024 + c) = v[j] * rstd * g; }
        }
        __syncthreads();
        const int n0 = blockIdx.x * 64, k0 = wave * 128;
        float acc[16];
#pragma unroll
        for (int r = 0; r < 16; ++r) acc[r] = 0.f;
        for (int kb = k0; kb < k0 + 128; kb += 16) { float wv[16];
#pragma unroll
            for (int q = 0; q < 16; ++q) wv[q] = a.w_in[(size_t)(kb + q) * INW + n0 + lane];
#pragma unroll
            for (int q = 0; q < 16; ++q)
#pragma unroll
                for (int r = 0; r < 16; ++r) acc[r] += xm[r * 1024 + kb + q] * wv[q]; }
#pragma unroll
        for (int r = 0; r < 16; ++r) red[(wave * 16 + r) * 64 + lane] = acc[r];
        __syncthreads();
        float* zmeta = (float*)(a.ws + WS_ZMETA);
        for (int o = tid; o < 1024; o += NTHR) { const int r = o >> 6, c = o & 63; float s = 0.f;
#pragma unroll
            for (int w = 0; w < 8; ++w) s += red[(w * 16 + r) * 64 + c];
            zmeta[r * INW + n0 + c] = s; }
        __syncthreads();
    }
    if (blockIdx.x == INW / 64) {
        float* rope = (float*)(a.ws + WS_ROPE);
        for (int i = tid; i < 64 * 16; i += NTHR) { const int pos = i >> 4, f = i & 15;
            const float freq = exp2f(-(float)f * (13.287712379549449f / 16.0f)); const float rev = (float)pos * freq * 0.15915494309189535f; const float fr = rev - floorf(rev);
            rope[2 * i] = __builtin_amdgcn_cosf(fr); rope[2 * i + 1] = __builtin_amdgcn_sinf(fr); }
    }
    if ((int)blockIdx.x > INW / 64 || G <= INW / 64 + 1) {
        float* scr = ldsf + wave * (64 * 33);
        constexpr int I_IN = (DM / 64) * (INW / 32), I_OUT = (DM / 64) * (DM / 32), I_WQ = (DM / 64) * (PQ / 32);
        const int first = (G <= INW / 64 + 1) ? 0 : INW / 64 + 1, nw = (G - first) * NWAVES;
        for (int it = ((int)blockIdx.x - first) * NWAVES + wave; it < I_IN + I_OUT + I_WQ; it += nw) {
            int r = it;
            if (r < I_IN) { p0_transpose_item(a.w_in, DM, INW, (bf16_t*)(a.ws + WS_WIN), scr, r, lane, nullptr, true); continue; } r -= I_IN;
            if (r < I_OUT) { p0_transpose_item(a.w_out, DM, DM, (bf16_t*)(a.ws + WS_WOUT), scr, r, lane); continue; } r -= I_OUT;
            p0_transpose_item_fp8(a.wq, DM, PQ, a.ws + WS_WQ, scr, r, lane, a.g_ffn, WQSCALE);
        }
    }
    {
        const size_t gtid = (size_t)blockIdx.x * NTHR + tid, nth = (size_t)G * NTHR;
        cast_region(a.subk, (bf16_t*)(a.ws + WS_SUBK), (size_t)16 * 128 * 128, gtid, nth);
        for (size_t i = gtid; i < (size_t)NTOK; i += nth) ((float*)(a.ws + WS_SS))[i] = 0.f;
    }
    {
        bf16_t* XA = (bf16_t*)(a.ws + WS_XA);
        f32x4 g[4], vn[4];
#pragma unroll
        for (int j = 0; j < 4; ++j) g[j] = *(const f32x4*)(a.g_mix + (lane + 64 * j) * 4);
        for (int r = gw; r < NTOK; r += NGW) {
            { const float* xn = xrow_ptr(a, r + NGW < NTOK ? r + NGW : r);
#pragma unroll
              for (int j = 0; j < 4; ++j) vn[j] = __builtin_nontemporal_load((const f32x4*)(xn + (lane + 64 * j) * 4)); }
            float ss = 0.f;
#pragma unroll
            for (int j = 0; j < 4; ++j) ss += v[j].x * v[j].x + v[j].y * v[j].y + v[j].z * v[j].z + v[j].w * v[j].w;
            const float rstd = 1.0f / sqrtf(wave_sum(ss) * (1.0f / DM) + EPS);
#pragma unroll
            for (int j = 0; j < 4; ++j) { const int c = (lane + 64 * j) * 4; const f32x4 o = v[j] * rstd * g[j];
                u32x2 w; w.x = pk2(o.x, o.y); w.y = pk2(o.z, o.w); *(u32x2*)(XA + (size_t)r * DM + c) = w; }
#pragma unroll
            for (int j = 0; j < 4; ++j) v[j] = vn[j];
        }
    }
}

constexpr int ZW = 1024;
struct P2In { u32x4 w[4]; };
__device__ __forceinline__ void p2_load(P2In& in, const bf16_t* ZB, int r, int lane) {
    const int t = r & 2047, c0 = lane * 8; const bf16_t* zr = ZB + (size_t)r * ZW;
    const bf16_t* zp = (t > 0) ? zr - ZW : zr; const bf16_t* zn = (t < SEQ - 1) ? zr + ZW : zr;
    in.w[0] = *(const u32x4*)(zr + c0); in.w[1] = *(const u32x4*)(zr + 512 + c0); in.w[2] = *(const u32x4*)(zp + 512 + c0); in.w[3] = *(const u32x4*)(zn + 512 + c0);
}
__device__ __forceinline__ void p2_pass(const Args& a, int lane, int gw, int NGW) {
    const bf16_t* ZB = (const bf16_t*)(a.ws + WS_Z); const float* zmeta = (const float*)(a.ws + WS_ZMETA);
    bf16_t* XA = (bf16_t*)(a.ws + WS_XA);
    const int c0 = lane * 8;
    float cw0[8], cw1[8], cw2[8], cgn[8];
#pragma unroll
    for (int j = 0; j < 8; ++j) { cw0[j] = a.conv_w[c0 + j]; cw1[j] = a.conv_w[512 + c0 + j]; cw2[j] = a.conv_w[1024 + c0 + j]; cgn[j] = a.conv_g[c0 + j]; }
    P2In cur, nxt, nx2;
    if (gw < NTOK) { p2_load(cur, ZB, gw, lane); p2_load(nxt, ZB, gw + NGW < NTOK ? gw + NGW : gw, lane); }
    for (int it = gw; it < NTOK; it += NGW) {
        {
            const int r = it, t = r & 2047;
            { const int rn = it + 2 * NGW < NTOK ? it + 2 * NGW : it; p2_load(nx2, ZB, rn, lane); }
            float gb[8], uc[8], up[8], un[8];
            unpack8(cur.w[0], gb); unpack8(cur.w[1], uc); unpack8(cur.w[2], up);
            if (t == 0) {
#pragma unroll
                for (int j = 0; j < 8; ++j) up[j] = zmeta[15 * INW + 512 + c0 + j] * zmeta[15 * INW + 1024 + c0 + j]; }
            unpack8(cur.w[3], un);
#pragma unroll
            for (int j = 0; j < 8; ++j) un[j] = (t < SEQ - 1) ? un[j] : 0.f;
            float y[8], ss = 0.f;
#pragma unroll
            for (int j = 0; j < 8; ++j) { y[j] = gb[j] * (up[j] * cw0[j] + uc[j] * cw1[j] + un[j] * cw2[j]); ss += y[j] * y[j]; }
            ss += __shfl_xor(ss, 1); ss += __shfl_xor(ss, 2); ss += __shfl_xor(ss, 4);
            const float rstd = 1.0f / sqrtf(ss * (1.0f / 64.0f) + EPS);
#pragma unroll
            for (int j = 0; j < 8; ++j) y[j] = y[j] * rstd * cgn[j];
            *(u32x4*)(XA + (size_t)r * DM + c0) = pack8(y);
            cur = nxt; nxt = nx2;
        }
    }
}
__device__ __forceinline__ void kv_meta_rows(const Args& a, int lane, int gw, int NGW) {
    const float* zmeta = (const float*)(a.ws + WS_ZMETA); bf16_t* KB = (bf16_t*)(a.ws + WS_KB); bf16_t* VB = (bf16_t*)(a.ws + WS_VB);
    const int i = lane & 7;
    for (int it = NTOK + gw; it < NTOK + NB * 64; it += NGW) {
        {
            const int it2 = it - NTOK, b = it2 >> 6, j64 = it2 & 63; const int l16 = lane & 15, g = l16 >> 3;
            float k[8], v[8];
            if (j64 < NMETA) {
                const float* zm = zmeta + j64 * INW; float ss = 0.f;
#pragma unroll
                for (int j = 0; j < 8; ++j) { k[j] = zm[2048 + l16 * 8 + j]; v[j] = zm[2176 + l16 * 8 + j]; ss += k[j] * k[j]; }
                ss += __shfl_xor(ss, 1); ss += __shfl_xor(ss, 2); ss += __shfl_xor(ss, 4);
                const float rstd = 1.0f / sqrtf(ss * (1.0f / 64.0f) + EPS);
#pragma unroll
                for (int j = 0; j < 8; ++j) k[j] = k[j] * rstd * a.kg[i * 8 + j];
            } else {
#pragma unroll
                for (int j = 0; j < 8; ++j) { k[j] = 0.f; v[j] = 0.f; }
            }
            const size_t krow = ((size_t)(b * 2 + g) * KROWS + SEQ + j64) * 64 + i * 8;
            if (lane < 16) *(u32x4*)(KB + krow) = pack8(k);
            else if (lane < 32) *(u32x4*)(VB + krow) = pack8(v);
        }
    }
}

typedef float f32x16 __attribute__((ext_vector_type(16)));
__device__ __forceinline__ void ce_desc(float& a, float& b) { float h, l; asm("v_max_f32_e32 %0, %1, %2" : "=v"(h) : "v"(a), "v"(b)); asm("v_min_f32_e32 %0, %1, %2" : "=v"(l) : "v"(a), "v"(b)); a = h; b = l; }
__device__ __forceinline__ float vmaxf(float a, float b) { float h; asm("v_max_f32_e32 %0, %1, %2" : "=v"(h) : "v"(a), "v"(b)); return h; }
template <int N> __device__ __forceinline__ void bitonic_sort_desc(float* v) {
#pragma unroll
    for (int k = 2; k <= N; k <<= 1)
#pragma unroll
        for (int j = k >> 1; j > 0; j >>= 1)
#pragma unroll
            for (int i = 0; i < N; ++i) { const int l = i ^ j; if (l > i) { if ((i & k) == 0) ce_desc(v[i], v[l]); else ce_desc(v[l], v[i]); } }
}
__device__ __forceinline__ void sort16_desc(float* v) {
    ce_desc(v[0], v[13]); ce_desc(v[1], v[12]); ce_desc(v[2], v[15]); ce_desc(v[3], v[14]); ce_desc(v[4], v[8]); ce_desc(v[5], v[6]); ce_desc(v[7], v[11]); ce_desc(v[9], v[10]);
    ce_desc(v[0], v[5]); ce_desc(v[1], v[7]); ce_desc(v[2], v[9]); ce_desc(v[3], v[4]); ce_desc(v[6], v[13]); ce_desc(v[8], v[14]); ce_desc(v[10], v[15]); ce_desc(v[11], v[12]);
    ce_desc(v[0], v[1]); ce_desc(v[2], v[3]); ce_desc(v[4], v[5]); ce_desc(v[6], v[8]); ce_desc(v[7], v[9]); ce_desc(v[10], v[11]); ce_desc(v[12], v[13]); ce_desc(v[14], v[15]);
    ce_desc(v[0], v[2]); ce_desc(v[1], v[3]); ce_desc(v[4], v[10]); ce_desc(v[5], v[11]); ce_desc(v[6], v[7]); ce_desc(v[8], v[9]); ce_desc(v[12], v[14]); ce_desc(v[13], v[15]);
    ce_desc(v[1], v[2]); ce_desc(v[3], v[12]); ce_desc(v[4], v[6]); ce_desc(v[5], v[7]); ce_desc(v[8], v[10]); ce_desc(v[9], v[11]); ce_desc(v[13], v[14]);
    ce_desc(v[1], v[4]); ce_desc(v[2], v[6]); ce_desc(v[5], v[8]); ce_desc(v[7], v[10]); ce_desc(v[9], v[13]); ce_desc(v[11], v[14]);
    ce_desc(v[2], v[4]); ce_desc(v[3], v[6]); ce_desc(v[9], v[12]); ce_desc(v[11], v[13]);
    ce_desc(v[3], v[5]); ce_desc(v[6], v[8]); ce_desc(v[7], v[9]); ce_desc(v[10], v[12]);
    ce_desc(v[3], v[4]); ce_desc(v[5], v[6]); ce_desc(v[7], v[8]); ce_desc(v[9], v[10]); ce_desc(v[11], v[12]);
    ce_desc(v[6], v[7]); ce_desc(v[8], v[9]);
}
template <int N> __device__ __forceinline__ void bitonic_merge_desc(float* v) {
#pragma unroll
    for (int j = N >> 1; j > 0; j >>= 1)
#pragma unroll
        for (int i = 0; i < N; ++i) { const int l = i ^ j; if (l > i) ce_desc(v[i], v[l]); }
}
__device__ __forceinline__ float vmed3f(float a, float b, float c) { float m; asm("v_med3_f32 %0, %1, %2, %3" : "=v"(m) : "v"(a), "v"(b), "v"(c)); return m; }
__device__ __forceinline__ void merge_top16(float* x, const float* y) {
#pragma unroll
    for (int i = 0; i < 8; ++i) { const float a = x[i], b = x[i + 8], c = y[7 - i], d = y[15 - i]; x[i] = vmaxf(a, c); x[i + 8] = vmed3f(a, c, vmaxf(b, d)); }
#pragma unroll
    for (int j = 4; j > 0; j >>= 1)
#pragma unroll
        for (int i = 0; i < 16; ++i) { const int l = i ^ j; if (l > i) ce_desc(x[i], x[l]); }
}
__device__ __forceinline__ void merge_top16_ce(float* x, const float* y) {
#pragma unroll
    for (int i = 0; i < 16; ++i) x[i] = vmaxf(x[i], y[15 - i]);
    bitonic_merge_desc<16>(x);
}
__device__ __forceinline__ void insert16(float* t, float x) {
#pragma unroll
    for (int k = 0; k < 16; ++k) ce_desc(t[k], x);
}
constexpr int SK_ROW = 272, SK_MAT = 128 * SK_ROW;
struct QFrag { bf16x8 q[8]; };
__device__ __forceinline__ void q_load(QFrag& f, const bf16_t* qrow  ) {
#pragma unroll
    for (int ks = 0; ks < 8; ++ks) f.q[ks] = *(const bf16x8*)(qrow + ks * 16);
}
__device__ __forceinline__ void p7_half(const QFrag& cur, QFrag& nxt, const bf16_t* nrow, const LAS unsigned char* skl  , int hi4, float* T) {
    f32x16 acc[4];
#pragma unroll
    for (int nb = 0; nb < 4; ++nb)
#pragma unroll
        for (int r = 0; r < 16; ++r) acc[nb][r] = 0.f;
#pragma unroll
    for (int ks = 0; ks < 8; ++ks) {
#pragma unroll
        for (int nb = 0; nb < 4; ++nb) { const bf16x8 ak = *(const LAS bf16x8*)(skl + nb * 32 * SK_ROW + ks * 32); acc[nb] = __builtin_amdgcn_mfma_f32_32x32x16_bf16(ak, cur.q[ks], acc[nb], 0, 0, 0); }
        if (ks & 1) __builtin_amdgcn_sched_barrier(0);
    }
    if (nrow) {
#pragma unroll
        for (int ks = 0; ks < 4; ++ks) nxt.q[ks] = *(const bf16x8*)(nrow + ks * 16); }
    __builtin_amdgcn_sched_barrier(0);
    float L[16];
#pragma unroll
    for (int nb = 0; nb < 4; ++nb) {
        float v[16];
#pragma unroll
        for (int r = 0; r < 16; ++r) { const float sc = acc[nb][r]; v[r] = __uint_as_float((__float_as_uint(sc) & ~127u) | (unsigned)(nb * 32 + (r & 3) + 8 * (r >> 2))); }
        sort16_desc(v);
        if (nb == 0) {
#pragma unroll
            for (int r = 0; r < 16; ++r) L[r] = v[r];
        } else merge_top16(L, v);
        if (nb == 1) {
            __builtin_amdgcn_sched_barrier(0);
            if (nrow) {
#pragma unroll
                for (int ks = 4; ks < 8; ++ks) nxt.q[ks] = *(const bf16x8*)(nrow + ks * 16); }
            __builtin_amdgcn_sched_barrier(0); }
    }
#pragma unroll
    for (int r = 0; r < 16; ++r) { const unsigned w = __builtin_bit_cast(unsigned, L[r]); T[r] = __builtin_bit_cast(float, w | (unsigned)hi4); }
}
__device__ __forceinline__ unsigned pick_byte(unsigned p0, unsigned p1, unsigned p2, unsigned p3, unsigned i) {
    const unsigned sel = (i & 7u) | 0x0c0c0c00u;
    const unsigned lo = __builtin_amdgcn_perm(p1, p0, sel), hi = __builtin_amdgcn_perm(p3, p2, sel);
    return (i & 8u) ? hi : lo;
}
__device__ __forceinline__ void p7_topk(const Args& a, unsigned char* lds, int tid, int lane, int wave) {
    const bf16_t* QP = (const bf16_t*)(a.ws + WS_QP); const bf16_t* SUBK = (const bf16_t*)(a.ws + WS_SUBK);
    unsigned short* EIDX = (unsigned short*)(a.ws + WS_EI); bf16_t* GATE = (bf16_t*)(a.ws + WS_GT); const float* SSQ = (const float*)(a.ws + WS_SS);
    const int r32 = lane & 31, hi = lane >> 5;
    const int hp = blockIdx.x & 3, grp = blockIdx.x >> 2, ngrp = gridDim.x >> 2;
    { const u32x4* src = (const u32x4*)(SUBK + (size_t)hp * 4 * 128 * 128);
      static_assert(4 * 128 * 16 == 16 * NTHR, "sub-key fill: 16 pieces per thread");
      u32x4 sk[16];
#pragma unroll
      for (int k = 0; k < 16; ++k) sk[k] = src[tid + k * NTHR];
#pragma unroll
      for (int k = 0; k < 16; ++k) { const int i = tid + k * NTHR, row = i >> 4, ch = i & 15; *(LAS u32x4*)((LAS unsigned char*)lds + row * SK_ROW + ch * 16) = sk[k]; } }
    __syncthreads();
    const LAS unsigned char* skl = (const LAS unsigned char*)lds + r32 * SK_ROW + 16 * hi;
#define QROW(tk, head, half) (QP + (((size_t)((tk) >> 8) * 8 + (head)) * 256 + ((tk) & 255)) * 256 + (half) * 128 + 8 * hi)
    for (int blk = grp * NWAVES + wave; blk < NTOK / 32; blk += ngrp * NWAVES) {
        const int tok = blk * 32 + r32;
        QFrag qa, qb; q_load(qa, QROW(tok, 2 * hp, 0));
        const float rs_l2e = 1.4426950408889634f / sqrtf(SSQ[tok] * (1.0f / DM) + EPS);
        float M0[16], M1[16];
        {
            float B0[16], B1[16];
            p7_half(qa, qb, QROW(tok, 2 * hp, 1), skl + 0 * SK_MAT, 4 * hi, M0);
            p7_half(qb, qa, QROW(tok, 2 * hp + 1, 0), skl + 1 * SK_MAT, 4 * hi, M1);
            p7_half(qa, qb, QROW(tok, 2 * hp + 1, 1), skl + 2 * SK_MAT, 4 * hi, B0);
            p7_half(qb, qa, (const bf16_t*)nullptr, skl + 3 * SK_MAT, 4 * hi, B1);
#pragma unroll
            for (int i = 0; i < 16; ++i) {
                const auto r0 = __builtin_amdgcn_permlane32_swap(__builtin_bit_cast(unsigned, M0[i]), __builtin_bit_cast(unsigned, B0[i]), false, false);
                const unsigned a0 = r0[0], b0 = r0[1]; M0[i] = __builtin_bit_cast(float, a0); B0[i] = __builtin_bit_cast(float, b0);
                const auto r1 = __builtin_amdgcn_permlane32_swap(__builtin_bit_cast(unsigned, M1[i]), __builtin_bit_cast(unsigned, B1[i]), false, false);
                const unsigned a1 = r1[0], b1 = r1[1]; M1[i] = __builtin_bit_cast(float, a1); B1[i] = __builtin_bit_cast(float, b1); }
            merge_top16(M0, B0); merge_top16(M1, B1);
        }
        const int h = 2 * hp + hi;
#define CAND(i, j) __builtin_bit_cast(float, (__builtin_bit_cast(unsigned, M0[i] + M1[j]) & ~255u) | (unsigned)((i) * 16 + (j)))
        float tc[16], l2[16], l3[16];
#pragma unroll
        for (int j = 0; j < 16; ++j) tc[j] = CAND(0, j);
#pragma unroll
        for (int j = 0; j < 8; ++j) { l2[j] = CAND(1, j); l2[8 + j] = CAND(15 - j, 0); }
        bitonic_merge_desc<16>(l2);
        merge_top16_ce(tc, l2);
        l3[0] = CAND(2, 0); l3[1] = CAND(2, 1); l3[2] = CAND(2, 2); l3[3] = CAND(2, 3); l3[4] = CAND(2, 4); l3[5] = CAND(3, 0); l3[6] = CAND(3, 1); l3[7] = CAND(3, 2); l3[8] = CAND(3, 3);
        l3[9] = CAND(4, 0); l3[10] = CAND(4, 1); l3[11] = CAND(4, 2); l3[12] = CAND(5, 0); l3[13] = CAND(5, 1); l3[14] = CAND(6, 0); l3[15] = CAND(6, 1);
        sort16_desc(l3);
        merge_top16_ce(tc, l3);
        insert16(tc, CAND(7, 0)); insert16(tc, CAND(7, 1));
#undef CAND
#define PK4(M, q) ((__builtin_bit_cast(unsigned, M[4 * (q)]) & 127u) | ((__builtin_bit_cast(unsigned, M[4 * (q) + 1]) & 127u) << 8) | ((__builtin_bit_cast(unsigned, M[4 * (q) + 2]) & 127u) << 16) | ((__builtin_bit_cast(unsigned, M[4 * (q) + 3]) & 127u) << 24))
        const unsigned a0 = PK4(M0, 0), a1 = PK4(M0, 1), a2 = PK4(M0, 2), a3 = PK4(M0, 3), b0 = PK4(M1, 0), b1 = PK4(M1, 1), b2 = PK4(M1, 2), b3 = PK4(M1, 3);
#undef PK4
        float e[16], sum = 0.f;
#pragma unroll
        for (int k = 0; k < 16; ++k) { e[k] = exp2f((tc[k] - tc[0]) * rs_l2e); sum += e[k]; }
        const float inv = 1.0f / sum;
        int eo[16];
#pragma unroll
        for (int k = 0; k < 16; ++k) { const unsigned code = __builtin_bit_cast(unsigned, tc[k]) & 255u; eo[k] = (int)(pick_byte(a0, a1, a2, a3, code >> 4) * 128u + pick_byte(b0, b1, b2, b3, code & 15u)); e[k] *= inv; }
        unsigned short* ep = EIDX + ((size_t)tok * 8 + h) * 16; bf16_t* gp = GATE + ((size_t)tok * 8 + h) * 16;
#pragma unroll
        for (int k = 0; k < 16; k += 8) { u32x4 pk; pk.x = (unsigned)eo[k] | ((unsigned)eo[k + 1] << 16); pk.y = (unsigned)eo[k + 2] | ((unsigned)eo[k + 3] << 16); pk.z = (unsigned)eo[k + 4] | ((unsigned)eo[k + 5] << 16); pk.w = (unsigned)eo[k + 6] | ((unsigned)eo[k + 7] << 16); *(u32x4*)(ep + k) = pk; }
#pragma unroll
        for (int k = 0; k < 16; k += 8) *(u32x4*)(gp + k) = (u32x4){pk2(e[k], e[k + 1]), pk2(e[k + 2], e[k + 3]), pk2(e[k + 4], e[k + 5]), pk2(e[k + 6], e[k + 7])};
    }
}

typedef _Float16 h2_t __attribute__((ext_vector_type(2)));
typedef float f32x2 __attribute__((ext_vector_type(2)));
__device__ __forceinline__ float dot32_fp4(u32x4 w, const h2_t* xh) {
    float acc = 0.f;
#pragma unroll
    for (int d = 0; d < 4; ++d) {
        const unsigned wd = w[d];
        acc = __builtin_amdgcn_fdot2(__builtin_amdgcn_cvt_scalef32_pk_f16_fp4(wd, 1.0f, 0), xh[4 * d], acc, false);
        acc = __builtin_amdgcn_fdot2(__builtin_amdgcn_cvt_scalef32_pk_f16_fp4(wd, 1.0f, 1), xh[4 * d + 1], acc, false);
        acc = __builtin_amdgcn_fdot2(__builtin_amdgcn_cvt_scalef32_pk_f16_fp4(wd, 1.0f, 2), xh[4 * d + 2], acc, false);
        acc = __builtin_amdgcn_fdot2(__builtin_amdgcn_cvt_scalef32_pk_f16_fp4(wd, 1.0f, 3), xh[4 * d + 3], acc, false);
    }
    return acc;
}
typedef int i32x4 __attribute__((ext_vector_type(4)));
struct PMeta { unsigned p[8]; };
#define GAS __attribute__((address_space(1)))
template <class T> __device__ __forceinline__ GAS T* sgpr_ptr(T* p) { asm volatile("" : "+s"(p)); return (GAS T*)p; }
__device__ __forceinline__ void pm_load(PMeta& m, const unsigned short* EIDX, int t  , int seg) {
    const GAS unsigned char* rb = sgpr_ptr((const unsigned char*)(EIDX + (size_t)t * 128)); const unsigned lo = (unsigned)seg * 32u;
#pragma unroll
    for (int q = 0; q < 2; ++q) { const u32x4 ev = __builtin_nontemporal_load((const GAS u32x4*)(rb + (lo + q * 16u))); m.p[4 * q] = ev.x; m.p[4 * q + 1] = ev.y; m.p[4 * q + 2] = ev.z; m.p[4 * q + 3] = ev.w; }
}
#define SCHED_FENCE() __builtin_amdgcn_sched_barrier(0)
__device__ __forceinline__ void rows16_load(u32x4 (&w)[16], const unsigned char* Tbase, unsigned lane_off, const PMeta& m) {
#pragma unroll
    for (int j = 0; j < 16; ++j) { const unsigned pw = m.p[j >> 1]; const unsigned e = (j & 1) ? (pw >> 16) : (pw & 0xffffu); w[j] = *(const u32x4*)(Tbase + (e * 128u + lane_off)); }
}
#define PEER_GEOM() const int s4 = blockIdx.x & 3, th = (blockIdx.x >> 2) & 1, wq = (blockIdx.x >> 3) * NWAVES + wave, NWQ = (gridDim.x >> 3) * NWAVES, t_beg = th * (NTOK / 2) + wq, t_end = (th + 1) * (NTOK / 2)
#define TCL(t) ((t) < t_end ? (t) : t_end - 1)
typedef int v8i_t __attribute__((ext_vector_type(8)));
struct UTok { u32x4 A[8][2]; u32x4 B[2][2]; };
__device__ __forceinline__ void u_issue(UTok& T, const unsigned char* Ts  , const unsigned char* x8row  , unsigned idlo, unsigned idhi, int lane) {
    const int r16 = lane >> 2; const unsigned c16 = (unsigned)(lane & 3) * 16u; const unsigned q16 = (unsigned)(lane >> 4) * 16u;
#pragma unroll
    for (int h = 0; h < 8; ++h) { const unsigned e = (unsigned)__shfl((int)(h < 4 ? idlo : idhi), (h & 3) * 16 + r16);
#pragma unroll
        for (int ks = 0; ks < 2; ++ks) T.A[h][ks] = *(const u32x4*)(Ts + (e * 128u + 64u * ks + c16)); }
#pragma unroll
    for (int ks = 0; ks < 2; ++ks)
#pragma unroll
        for (int hf = 0; hf < 2; ++hf) T.B[ks][hf] = __builtin_nontemporal_load((const GAS u32x4*)(sgpr_ptr(x8row) + (128u * ks + 64u * hf + q16)));
}
__device__ __forceinline__ void u_compute(const UTok& T, int lane, bf16_t* dst  ) {
    f32x4 acc[8];
#pragma unroll
    for (int h = 0; h < 8; ++h) {
        acc[h] = (f32x4){0.f, 0.f, 0.f, 0.f};
#pragma unroll
        for (int ks = 0; ks < 2; ++ks) {
            const int src = (4 * (lane & 15) + (lane >> 4)) * 4;
            const v8i_t av = {__builtin_amdgcn_ds_bpermute(src, (int)T.A[h][ks].x), __builtin_amdgcn_ds_bpermute(src, (int)T.A[h][ks].y), __builtin_amdgcn_ds_bpermute(src, (int)T.A[h][ks].z), __builtin_amdgcn_ds_bpermute(src, (int)T.A[h][ks].w), 0, 0, 0, 0};
            const v8i_t bv = {(int)T.B[ks][0].x, (int)T.B[ks][0].y, (int)T.B[ks][0].z, (int)T.B[ks][0].w, (int)T.B[ks][1].x, (int)T.B[ks][1].y, (int)T.B[ks][1].z, (int)T.B[ks][1].w};
            acc[h] = __builtin_amdgcn_mfma_scale_f32_16x16x128_f8f6f4(av, bv, acc[h], 4  , 0  , 0, 0x7F7F7F7F, 0, 0x7F7F7F7F);
        }
    }
    const int j16 = lane & 15; f32x4 r = acc[0];
#pragma unroll
    for (int h = 1; h < 8; ++h) r = (j16 == h) ? acc[h] : r;
    if (j16 < 8) __builtin_nontemporal_store((u32x2){pk2(r[0], r[1]), pk2(r[2], r[3])}, (GAS u32x2*)(sgpr_ptr((unsigned char*)dst) + (unsigned)(j16 * 16 + (lane >> 4) * 4) * 2u));
}
__device__ __forceinline__ void p8a_u(const Args& a, int lane, int wave) {
    const unsigned short* EIDX = (const unsigned short*)(a.ws + WS_EI); bf16_t* PB = (bf16_t*)(a.ws + WS_PB);
    PEER_GEOM();
    const unsigned char* Ts = a.ws + WS_UT + (size_t)s4 * SLICE4; const unsigned char* x8 = a.ws + WS_X8 + s4 * 256;
    bf16_t* pb = PB + (size_t)s4 * NTOK * 128;
#define IDLOAD(lo, hi, t) do { const GAS unsigned short* ip_ = sgpr_ptr(EIDX + (size_t)(t) * 128); lo = ip_[lane]; hi = ip_[64 + lane]; } while (0)
    UTok TA, TB; unsigned ia0, ia1, ib0, ib1;
    IDLOAD(ia0, ia1, TCL(t_beg)); IDLOAD(ib0, ib1, TCL(t_beg + NWQ));
    u_issue(TA, Ts, x8 + (size_t)TCL(t_beg) * DM, ia0, ia1, lane);
    IDLOAD(ia0, ia1, TCL(t_beg + 2 * NWQ));
    for (int t = t_beg; t < t_end; t += 2 * NWQ) {
        SCHED_FENCE();
        u_issue(TB, Ts, x8 + (size_t)TCL(t + NWQ) * DM, ib0, ib1, lane); IDLOAD(ib0, ib1, TCL(t + 3 * NWQ));
        SCHED_FENCE();
        u_compute(TA, lane, pb + (size_t)t * 128);
        SCHED_FENCE();
        u_issue(TA, Ts, x8 + (size_t)TCL(t + 2 * NWQ) * DM, ia0, ia1, lane); IDLOAD(ia0, ia1, TCL(t + 4 * NWQ));
        SCHED_FENCE();
        if (t + NWQ < t_end) u_compute(TB, lane, pb + (size_t)(t + NWQ) * 128);
    }
#undef IDLOAD
}
__device__ __forceinline__ void p8c_combine(const Args& a, unsigned char* lds, int tid) {
    const u32x2* PB = (const u32x2*)(a.ws + WS_PB); unsigned* AB = (unsigned*)(a.ws + WS_AB); const u32x2* GATE = (const u32x2*)(a.ws + WS_GT); const float* SS = (const float*)(a.ws + WS_SS);
    const unsigned short* EIDX = (const unsigned short*)(a.ws + WS_EI); const float* su = (const float*)(a.ws + WS_USC); const float* sv = (const float*)(a.ws + WS_VSC);
    const size_t n4 = (size_t)NTOK * 128 / 4, nth = (size_t)gridDim.x * NTHR;
    LAS float* su_l = (LAS float*)lds; LAS float* sv_l = su_l + 16384;
    const size_t n8 = n4 / 2; const u32x4* PB4 = (const u32x4*)PB; const u32x4* GATE4 = (const u32x4*)GATE; const u32x4* EIDX4 = (const u32x4*)EIDX; u32x2* AB2 = (u32x2*)AB;
    u32x4 cp[4], cg, ce; float css; u32x4 np[4], ng, ne; float nss;
    size_t i = (size_t)blockIdx.x * NTHR + tid;
    { const size_t i0 = i < n8 ? i : n8 - 1;
#pragma unroll
      for (int s2 = 0; s2 < 4; ++s2) cp[s2] = __builtin_nontemporal_load(PB4 + (size_t)s2 * n8 + i0);
      cg = __builtin_nontemporal_load(GATE4 + i0); ce = __builtin_nontemporal_load(EIDX4 + i0); css = SS[i0 >> 4]; }
    { f32x4 fu[8], fv[8];
#pragma unroll
      for (int k = 0; k < 8; ++k) { fu[k] = *(const f32x4*)(su + 4 * (tid + k * NTHR)); fv[k] = *(const f32x4*)(sv + 4 * (tid + k * NTHR)); }
#pragma unroll
      for (int k = 0; k < 8; ++k) { *(LAS f32x4*)(su_l + 4 * (tid + k * NTHR)) = fu[k]; *(LAS f32x4*)(sv_l + 4 * (tid + k * NTHR)) = fv[k]; } }
    __syncthreads();
    float calib;
    { unsigned a1 = 0u; a1 = __builtin_amdgcn_cvt_scalef32_pk_fp4_f32(a1, 1.0f, 1.0f, 1.0f, 0); a1 = __builtin_amdgcn_cvt_scalef32_pk_fp4_f32(a1, 1.0f, 1.0f, 1.0f, 1);
      a1 = __builtin_amdgcn_cvt_scalef32_pk_fp4_f32(a1, 1.0f, 1.0f, 1.0f, 2); a1 = __builtin_amdgcn_cvt_scalef32_pk_fp4_f32(a1, 1.0f, 1.0f, 1.0f, 3);
      unsigned b1 = (unsigned)__builtin_amdgcn_cvt_pk_fp8_f32(1.0f, 1.0f, 0, false); b1 = (unsigned)__builtin_amdgcn_cvt_pk_fp8_f32(1.0f, 1.0f, (int)b1, true);
      const v8i_t av = {(int)a1, (int)a1, (int)a1, (int)a1, 0, 0, 0, 0}, bv = {(int)b1, (int)b1, (int)b1, (int)b1, (int)b1, (int)b1, (int)b1, (int)b1};
      const f32x4 c = __builtin_amdgcn_mfma_scale_f32_16x16x128_f8f6f4(av, bv, (f32x4){0.f, 0.f, 0.f, 0.f}, 4, 0, 0, 0x7F7F7F7F, 0, 0x7F7F7F7F);
      calib = 128.0f / c[0] * (1.0f / X8SCALE); }
    for (; i < n8; i += nth) {
        const size_t in = i + nth < n8 ? i + nth : i;
#pragma unroll
        for (int s2 = 0; s2 < 4; ++s2) np[s2] = __builtin_nontemporal_load(PB4 + (size_t)s2 * n8 + in);
        ng = __builtin_nontemporal_load(GATE4 + in); ne = __builtin_nontemporal_load(EIDX4 + in); nss = SS[in >> 4];
        SCHED_FENCE();
        float d[8] = {0.f, 0.f, 0.f, 0.f, 0.f, 0.f, 0.f, 0.f};
#pragma unroll
        for (int s2 = 0; s2 < 4; ++s2)
#pragma unroll
            for (int w = 0; w < 4; ++w) { d[2 * w] += bflo(cp[s2][w]); d[2 * w + 1] += bfhi(cp[s2][w]); }
        const float cr = calib / sqrtf(css * (1.0f / DM) + EPS);
        float o[8];
#pragma unroll
        for (int j = 0; j < 8; ++j) { const unsigned ej = (j & 1) ? (ce[j >> 1] >> 16) : (ce[j >> 1] & 0xffffu); const float gj = (j & 1) ? bfhi(cg[j >> 1]) : bflo(cg[j >> 1]);
            const float z = d[j] * su_l[ej] * cr; o[j] = 0.5f * z * (1.0f + erff(z * 0.70710678118654752f)) * gj * sv_l[ej]; }
        unsigned w0 = (unsigned)__builtin_amdgcn_cvt_pk_fp8_f32(o[0] * A8SCALE, o[1] * A8SCALE, 0, false); w0 = (unsigned)__builtin_amdgcn_cvt_pk_fp8_f32(o[2] * A8SCALE, o[3] * A8SCALE, (int)w0, true);
        unsigned w1 = (unsigned)__builtin_amdgcn_cvt_pk_fp8_f32(o[4] * A8SCALE, o[5] * A8SCALE, 0, false); w1 = (unsigned)__builtin_amdgcn_cvt_pk_fp8_f32(o[6] * A8SCALE, o[7] * A8SCALE, (int)w1, true);
        AB2[i] = (u32x2){w0, w1};
#pragma unroll
        for (int s2 = 0; s2 < 4; ++s2) cp[s2] = np[s2];
        cg = ng; ce = ne; css = nss;
    }
}
typedef int v2i_t __attribute__((ext_vector_type(2)));
constexpr int VROW = 144, VIMG = 128 * VROW;
struct VRec { u32x4 a8[2]; u32x2 h; };
__device__ __forceinline__ void v_token(const u32x4 (&w)[16], const VRec& rc, LAS unsigned char* vl  , float oscale, int lane, float* dst  , bool do_store) {
    const int seg = lane >> 3, c8 = lane & 7, i16 = lane & 15, q = lane >> 4;
#pragma unroll
    for (int j = 0; j < 16; ++j) *(LAS u32x4*)(vl + (seg * 16 + j) * VROW + c8 * 16) = w[j];
    asm volatile("s_waitcnt lgkmcnt(0)" ::: "memory");
    const v8i_t av = {(int)rc.a8[0].x, (int)rc.a8[0].y, (int)rc.a8[0].z, (int)rc.a8[0].w, (int)rc.a8[1].x, (int)rc.a8[1].y, (int)rc.a8[1].z, (int)rc.a8[1].w};
    const LAS unsigned char* rp = vl + (32 * q + i16) * VROW;
    float val[4] = {0.f, 0.f, 0.f, 0.f};
#pragma unroll
    for (int cb = 0; cb < 16; ++cb) {
        const v2i_t r1 = __builtin_amdgcn_ds_read_tr4_b64_v2i32((LAS v2i_t*)(rp + cb * 8)), r2 = __builtin_amdgcn_ds_read_tr4_b64_v2i32((LAS v2i_t*)(rp + 16 * VROW + cb * 8));
        const v8i_t bv = {r1.x, r1.y, r2.x, r2.y, 0, 0, 0, 0};
        const f32x4 acc = __builtin_amdgcn_mfma_scale_f32_16x16x128_f8f6f4(av, bv, (f32x4){0.f, 0.f, 0.f, 0.f}, 0  , 4  , 0, 0x7F7F7F7F, 0, 0x7F7F7F7F);
        const float a0 = acc[0]; val[cb & 3] = (q == (cb >> 2)) ? a0 : val[cb & 3];
    }
    asm volatile("s_waitcnt lgkmcnt(0)" ::: "memory");
    if (do_store) {
        const f32x2 x01 = __builtin_amdgcn_cvt_pk_f32_fp8((int)rc.h.x, false), x23 = __builtin_amdgcn_cvt_pk_f32_fp8((int)rc.h.x, true), r01 = __builtin_amdgcn_cvt_pk_f32_fp8((int)rc.h.y, false), r23 = __builtin_amdgcn_cvt_pk_f32_fp8((int)rc.h.y, true);
        const float i8 = 1.0f / X8SCALE, ir = 1.0f / (X8SCALE * R8SCALE);
        *(GAS f32x4*)(sgpr_ptr((unsigned char*)dst) + (unsigned)lane * 16u) = (f32x4){x01[0] * i8 + r01[0] * ir + val[0] * oscale, x01[1] * i8 + r01[1] * ir + val[1] * oscale, x23[0] * i8 + r23[0] * ir + val[2] * oscale, x23[1] * i8 + r23[1] * ir + val[3] * oscale};
    } else asm volatile("" :: "v"(val[0]), "v"(val[1]), "v"(val[2]), "v"(val[3]));
}
__device__ __forceinline__ void p8b_v(const Args& a, unsigned char* lds, int lane, int wave, bool do_store) {
    const unsigned short* EIDX = (const unsigned short*)(a.ws + WS_EI); const unsigned char* AB = a.ws + WS_AB; const unsigned char* X8 = a.ws + WS_X8; const unsigned char* R8 = a.ws + WS_R8;
    PEER_GEOM();
    const int seg = lane >> 3, c8 = lane & 7, q = lane >> 4;
    const unsigned char* Ts = a.ws + WS_UT + (size_t)(4 + s4) * SLICE4; const unsigned loff = c8 * 16;
    LAS unsigned char* vl = (LAS unsigned char*)lds + wave * VIMG;
    float oscale;
    { unsigned a1 = 0u; a1 = __builtin_amdgcn_cvt_scalef32_pk_fp4_f32(a1, 1.0f, 1.0f, 1.0f, 0); a1 = __builtin_amdgcn_cvt_scalef32_pk_fp4_f32(a1, 1.0f, 1.0f, 1.0f, 1);
      a1 = __builtin_amdgcn_cvt_scalef32_pk_fp4_f32(a1, 1.0f, 1.0f, 1.0f, 2); a1 = __builtin_amdgcn_cvt_scalef32_pk_fp4_f32(a1, 1.0f, 1.0f, 1.0f, 3);
      unsigned b1 = (unsigned)__builtin_amdgcn_cvt_pk_fp8_f32(1.0f, 1.0f, 0, false); b1 = (unsigned)__builtin_amdgcn_cvt_pk_fp8_f32(1.0f, 1.0f, (int)b1, true);
      const v8i_t av = {(int)b1, (int)b1, (int)b1, (int)b1, (int)b1, (int)b1, (int)b1, (int)b1}, bv = {(int)a1, (int)a1, (int)a1, (int)a1, 0, 0, 0, 0};
      const f32x4 c = __builtin_amdgcn_mfma_scale_f32_16x16x128_f8f6f4(av, bv, (f32x4){0.f, 0.f, 0.f, 0.f}, 0, 4, 0, 0x7F7F7F7F, 0, 0x7F7F7F7F);
      oscale = 128.0f / c[0] * (1.0f / A8SCALE); }
    const unsigned aoff = (unsigned)q * 16u, hoff = (unsigned)(s4 * 256 + 4 * lane);
#define REC_LOAD(R, t) do { const GAS unsigned char* ab_ = sgpr_ptr(AB + (size_t)(t) * 128); R.a8[0] = __builtin_nontemporal_load((const GAS u32x4*)(ab_ + aoff)); R.a8[1] = __builtin_nontemporal_load((const GAS u32x4*)(ab_ + (64u + aoff))); \
        R.h.x = __builtin_nontemporal_load((const GAS unsigned*)(sgpr_ptr(X8 + (size_t)(t) * DM) + hoff)); R.h.y = __builtin_nontemporal_load((const GAS unsigned*)(sgpr_ptr(R8 + (size_t)(t) * DM) + hoff)); } while (0)
    PMeta mA, mB; u32x4 wA[16], wB[16]; VRec rA, rB;
    pm_load(mA, EIDX, TCL(t_beg), seg); pm_load(mB, EIDX, TCL(t_beg + NWQ), seg);
    rows16_load(wA, Ts, loff, mA); REC_LOAD(rA, TCL(t_beg));
    pm_load(mA, EIDX, TCL(t_beg + 2 * NWQ), seg);
    for (int t = t_beg; t < t_end; t += 2 * NWQ) {
        SCHED_FENCE();
        rows16_load(wB, Ts, loff, mB); REC_LOAD(rB, TCL(t + NWQ)); pm_load(mB, EIDX, TCL(t + 3 * NWQ), seg);
        SCHED_FENCE();
        v_token(wA, rA, vl, oscale, lane, a.out + (size_t)t * DM + s4 * 256, do_store);
        SCHED_FENCE();
        rows16_load(wA, Ts, loff, mA); REC_LOAD(rA, TCL(t + 2 * NWQ)); pm_load(mA, EIDX, TCL(t + 4 * NWQ), seg);
        SCHED_FENCE();
        if (t + NWQ < t_end) v_token(wB, rB, vl, oscale, lane, a.out + (size_t)(t + NWQ) * DM + s4 * 256, do_store);
    }
#undef REC_LOAD
#undef TCL
#undef PEER_GEOM
}

namespace pg8 {
#define PG8_LAS __attribute__((address_space(3)))
typedef unsigned short bf16_t;
typedef short bf16x8 __attribute__((ext_vector_type(8)));
typedef float f32x4 __attribute__((ext_vector_type(4)));
typedef unsigned u32x4 __attribute__((ext_vector_type(4)));
typedef int v4i_t __attribute__((ext_vector_type(4))); typedef int v8i_t __attribute__((ext_vector_type(8)));
constexpr int BM = 256, BK = 64, HALF = 128, HTB = HALF * BK * 2  , STAGE_BYTES = 8 * HTB, NXCD = 8, WGM = 8;

__host__ __device__ __forceinline__ int lds_byte(int r, int c) { const int st = (r >> 4) * 2 + (c >> 5), rr = r & 15, cc = c & 31, ob = rr * 64 + cc * 2; return st * 1024 + (ob ^ (((ob >> 9) & 1) << 5)); }
__host__ __device__ __forceinline__ void stage_rc(int b, int& R, int& C) { const int st = b / 1024, sb = b % 1024, swz = sb ^ (((sb >> 9) & 1) << 5); R = (st >> 1) * 16 + swz / 64; C = (st & 1) * 32 + (swz % 64) / 2; }
__host__ __device__ __forceinline__ int perm32(int rho) { const int n = rho >> 4, i = rho & 15; return 8 * (i >> 2) + 4 * n + (i & 3); }

struct Unit { int pm, pn; };
struct Gemm { const bf16_t* A; const bf16_t* Bt; int M, N, K; };

struct StaticOrder {
    int nM, nN, nwg, G, c;
    __host__ __device__ void init(int M, int N, int G_, int c_) { nM = M / BM; nN = N / BM; nwg = nM * nN; G = G_; c = c_; }
    __host__ __device__ bool next(int i, Unit& u) const {
        const long L = (long)i * G + c; if (L >= nwg) return false;
        int wgid = (int)L; { const int q = nwg / NXCD, r = nwg % NXCD, xcd = wgid % NXCD, off = wgid / NXCD; wgid = (xcd < r ? xcd * (q + 1) : r * (q + 1) + (xcd - r) * q) + off; }
        const int nig = WGM * nN, gid = wgid / nig, fm = gid * WGM, gsz = (nM - fm) < WGM ? (nM - fm) : WGM;
        u.pm = fm + ((wgid % nig) % gsz); u.pn = (wgid % nig) / gsz; return true;
    }
    __device__ __forceinline__ void a_ready(const Unit&) const {}
    __device__ __forceinline__ void done(const Unit&) const {}
};


__device__ __forceinline__ unsigned cvt_pk_bf16(float lo, float hi) { unsigned r; asm volatile("v_cvt_pk_bf16_f32 %0, %1, %2" : "=v"(r) : "v"(lo), "v"(hi)); return r; }
struct EpiInProj {
    static constexpr bool PERM = true, AFTER_DRAIN = false;
    bf16_t* O; bf16_t* QB; bf16_t* KB; bf16_t* VB; const float* rope; const float* qg; const float* kg;
    template <bool NORM> __device__ __forceinline__ void head_row(f32x4 a00, f32x4 a01, f32x4 a10, f32x4 a11, const float* g0, const float* g1, int t, int fq, bf16_t* dst  ) const {
        float x0[8] = {a00[0], a00[1], a00[2], a00[3], a01[0], a01[1], a01[2], a01[3]}, x1[8] = {a10[0], a10[1], a10[2], a10[3], a11[0], a11[1], a11[2], a11[3]};
        if (NORM) {
            float ss = 0.f;
#pragma unroll
            for (int e = 0; e < 8; ++e) ss += x0[e] * x0[e] + x1[e] * x1[e];
            ss += __shfl_xor(ss, 16); ss += __shfl_xor(ss, 32);
            const float rstd = 1.0f / sqrtf(ss * (1.0f / 64.0f) + 1e-6f);
            const float* r0 = rope + (((t >> 6) * 16 + (fq & 1) * 8) * 2); const float* r1 = rope + (((t & 63) * 16 + (fq & 1) * 8) * 2);
            f32x4 c0[4], c1[4];
#pragma unroll
            for (int q4 = 0; q4 < 4; ++q4) { c0[q4] = *(const f32x4*)(r0 + 4 * q4); c1[q4] = *(const f32x4*)(r1 + 4 * q4); }
#pragma unroll
            for (int e = 0; e < 8; ++e) { x0[e] *= rstd * g0[e]; x1[e] *= rstd * g1[e]; }
#pragma unroll
            for (int e = 0; e < 8; ++e) { const float o0 = __shfl_xor(x0[e], 32), o1 = __shfl_xor(x1[e], 32);
                const float cs0 = c0[e >> 1][(e & 1) * 2], sn0 = c0[e >> 1][(e & 1) * 2 + 1], cs1 = c1[e >> 1][(e & 1) * 2], sn1 = c1[e >> 1][(e & 1) * 2 + 1];
                x0[e] = (fq & 2) ? x0[e] * cs0 + o0 * sn0 : x0[e] * cs0 - o0 * sn0; x1[e] = (fq & 2) ? x1[e] * cs1 + o1 * sn1 : x1[e] * cs1 - o1 * sn1; }
        }
        u32x4 w; w.x = cvt_pk_bf16(x0[0], x0[1]); w.y = cvt_pk_bf16(x0[2], x0[3]); w.z = cvt_pk_bf16(x0[4], x0[5]); w.w = cvt_pk_bf16(x0[6], x0[7]); *(u32x4*)dst = w;
        w.x = cvt_pk_bf16(x1[0], x1[1]); w.y = cvt_pk_bf16(x1[2], x1[3]); w.z = cvt_pk_bf16(x1[4], x1[5]); w.w = cvt_pk_bf16(x1[6], x1[7]); *(u32x4*)(dst + 32) = w;
    }
    __device__ __forceinline__ void operator()(const f32x4 (&acc)[2][2][4][2], const Unit& u, int wr, int wc, int fr, int fq) const {
        const int row0 = u.pm * BM + wr * 64 + fr, pn = u.pn;
        if (pn < 2) {
            const int col0 = 256 * pn + wc * 32 + 8 * fq;
#pragma unroll
            for (int ai = 0; ai < 2; ++ai)
#pragma unroll
                for (int m = 0; m < 4; ++m) { bf16_t* rowp = O + (size_t)(row0 + ai * HALF + m * 16) * 1024 + col0;
#pragma unroll
                    for (int bj = 0; bj < 2; ++bj) { const f32x4 v0 = acc[ai][bj][m][0], v1 = acc[ai][bj][m][1];
                        u32x4 w; w.x = cvt_pk_bf16(v0[0], v0[1]); w.y = cvt_pk_bf16(v0[2], v0[3]); w.z = cvt_pk_bf16(v1[0], v1[1]); w.w = cvt_pk_bf16(v1[2], v1[3]);
                        *(u32x4*)(rowp + bj * HALF) = w; } }
        } else if (pn < 6) {
            const int col0 = 512 + 128 * (pn - 2) + wc * 32 + 8 * fq;
#pragma unroll
            for (int ai = 0; ai < 2; ++ai)
#pragma unroll
                for (int m = 0; m < 4; ++m) { const f32x4 v0 = acc[ai][0][m][0] * acc[ai][1][m][0], v1 = acc[ai][0][m][1] * acc[ai][1][m][1];
                    u32x4 w; w.x = cvt_pk_bf16(v0[0], v0[1]); w.y = cvt_pk_bf16(v0[2], v0[3]); w.z = cvt_pk_bf16(v1[0], v1[1]); w.w = cvt_pk_bf16(v1[2], v1[3]);
                    *(u32x4*)(O + (size_t)(row0 + ai * HALF + m * 16) * 1024 + col0) = w; }
        } else if (pn < 8) {
            float g0[8], g1[8];
#pragma unroll
            for (int e = 0; e < 8; ++e) { g0[e] = qg[8 * fq + e] * C2; g1[e] = qg[32 + 8 * fq + e] * C2; }
            const int hh = 4 * (pn - 6) + wc;
#pragma unroll
            for (int ai = 0; ai < 2; ++ai)
#pragma unroll
                for (int m = 0; m < 4; ++m) { const int r = row0 + ai * HALF + m * 16;
                    head_row<true>(acc[ai][0][m][0], acc[ai][0][m][1], acc[ai][1][m][0], acc[ai][1][m][1], g0, g1, r & 2047, fq, QB + (size_t)r * 512 + hh * 64 + 8 * fq); }
        } else {
            float g0[8], g1[8];
#pragma unroll
            for (int e = 0; e < 8; ++e) { g0[e] = kg[8 * fq + e]; g1[e] = kg[32 + 8 * fq + e]; }
            const int g = wc & 1;
#pragma unroll
            for (int ai = 0; ai < 2; ++ai)
#pragma unroll
                for (int m = 0; m < 4; ++m) { const int r = row0 + ai * HALF + m * 16, b = r >> 11, t = r & 2047; const size_t krow = ((size_t)(b * 2 + g) * KROWS + t) * 64 + 8 * fq;
                    if (wc < 2) head_row<true>(acc[ai][0][m][0], acc[ai][0][m][1], acc[ai][1][m][0], acc[ai][1][m][1], g0, g1, t, fq, KB + krow);
                    else head_row<false>(acc[ai][0][m][0], acc[ai][0][m][1], acc[ai][1][m][0], acc[ai][1][m][1], g0, g1, t, fq, VB + krow); }
        }
    }
};
struct EpiBf16 {
    static constexpr bool PERM = true, AFTER_DRAIN = false;
    bf16_t* O; int ldc; float scale;
    __device__ __forceinline__ void operator()(const f32x4 (&acc)[2][2][4][2], const Unit& u, int wr, int wc, int fr, int fq) const {
        bf16_t* tile = O + (size_t)(u.pm * (ldc / BM) + u.pn) * (BM * BM) + (wr * 64 + fr) * BM + wc * 32 + 8 * fq;
#pragma unroll
        for (int ai = 0; ai < 2; ++ai)
#pragma unroll
            for (int m = 0; m < 4; ++m) { bf16_t* rowp = tile + (ai * HALF + m * 16) * BM;
#pragma unroll
                for (int bj = 0; bj < 2; ++bj) { const f32x4 v0 = acc[ai][bj][m][0] * scale, v1 = acc[ai][bj][m][1] * scale;
                    u32x4 w; w.x = cvt_pk_bf16(v0[0], v0[1]); w.y = cvt_pk_bf16(v0[2], v0[3]); w.z = cvt_pk_bf16(v1[0], v1[1]); w.w = cvt_pk_bf16(v1[2], v1[3]);
                    *(u32x4*)(rowp + bj * HALF) = w; } }
    }
};
struct EpiResidNorm {
    static constexpr bool PERM = true, AFTER_DRAIN = false;
    const float* xp; const float* xs; float* out; int split_row; unsigned char* r8; unsigned char* h8; float* ss; float x8scale;
    __device__ __forceinline__ const float* xrow(int r, int col0) const { return (r < split_row ? xp + (size_t)r * 1024 : xs + (size_t)(r - split_row) * 1024) + col0; }
    __device__ __forceinline__ void operator()(const f32x4 (&acc)[2][2][4][2], const Unit& u, int wr, int wc, int fr, int fq) const {
        const int col0 = u.pn * BM + wc * 32 + 8 * fq, rbase = u.pm * BM + wr * 64 + fr;
        f32x4 xv[4][2][2]; u32x2 q8[2], p8[2]; u32x4 dq[2], dr[2]; float dsum[3];
#pragma unroll
        for (int m = 0; m < 4; ++m) { const float* xr = xrow(rbase + m * 16, col0);
#pragma unroll
            for (int bj = 0; bj < 2; ++bj) { xv[m][bj][0] = *(const f32x4*)(xr + bj * HALF); xv[m][bj][1] = *(const f32x4*)(xr + bj * HALF + 4); } }
#pragma unroll
        for (int ai = 0; ai < 2; ++ai)
#pragma unroll
            for (int m = 0; m < 4; ++m) { const int r = rbase + ai * HALF + m * 16;
                float s = 0.f;
                f32x4 h[2][2];
#pragma unroll
                for (int bj = 0; bj < 2; ++bj) { h[bj][0] = xv[m][bj][0] + acc[ai][bj][m][0]; h[bj][1] = xv[m][bj][1] + acc[ai][bj][m][1]; }
                if (ai == 0) { const float* xr = xrow(r + HALF, col0);
#pragma unroll
                    for (int bj = 0; bj < 2; ++bj) { xv[m][bj][0] = *(const f32x4*)(xr + bj * HALF); xv[m][bj][1] = *(const f32x4*)(xr + bj * HALF + 4); } }
#pragma unroll
                for (int bj = 0; bj < 2; ++bj) { const f32x4 h0 = h[bj][0], h1 = h[bj][1];
                    const f32x4 g0 = h0 * x8scale, g1 = h1 * x8scale;
                    unsigned w0 = (unsigned)__builtin_amdgcn_cvt_pk_fp8_f32(g0[0], g0[1], 0, false); w0 = (unsigned)__builtin_amdgcn_cvt_pk_fp8_f32(g0[2], g0[3], (int)w0, true);
                    unsigned w1 = (unsigned)__builtin_amdgcn_cvt_pk_fp8_f32(g1[0], g1[1], 0, false); w1 = (unsigned)__builtin_amdgcn_cvt_pk_fp8_f32(g1[2], g1[3], (int)w1, true);
                    const f32x2 d00 = __builtin_amdgcn_cvt_pk_f32_fp8((int)w0, false), d01 = __builtin_amdgcn_cvt_pk_f32_fp8((int)w0, true), d10 = __builtin_amdgcn_cvt_pk_f32_fp8((int)w1, false), d11 = __builtin_amdgcn_cvt_pk_f32_fp8((int)w1, true);
                    unsigned e0 = (unsigned)__builtin_amdgcn_cvt_pk_fp8_f32((g0[0] - d00[0]) * R8SCALE, (g0[1] - d00[1]) * R8SCALE, 0, false); e0 = (unsigned)__builtin_amdgcn_cvt_pk_fp8_f32((g0[2] - d01[0]) * R8SCALE, (g0[3] - d01[1]) * R8SCALE, (int)e0, true);
                    unsigned e1 = (unsigned)__builtin_amdgcn_cvt_pk_fp8_f32((g1[0] - d10[0]) * R8SCALE, (g1[1] - d10[1]) * R8SCALE, 0, false); e1 = (unsigned)__builtin_amdgcn_cvt_pk_fp8_f32((g1[2] - d11[0]) * R8SCALE, (g1[3] - d11[1]) * R8SCALE, (int)e1, true);
                    if (!(m & 1)) { q8[bj] = (u32x2){w0, w1}; p8[bj] = (u32x2){e0, e1}; }
                    else {
                        const auto sx = __builtin_amdgcn_permlane16_swap(q8[bj].x, w0, false, false), sy = __builtin_amdgcn_permlane16_swap(q8[bj].y, w1, false, false);
                        const unsigned ax = sx[0], bx = sx[1], ay = sy[0], by = sy[1];
                        const size_t qo = (size_t)((fq & 1) ? r : r - 16) * 1024 + (col0 - 8 * (fq & 1)) + bj * HALF;
                        const auto tx = __builtin_amdgcn_permlane16_swap(p8[bj].x, e0, false, false), ty = __builtin_amdgcn_permlane16_swap(p8[bj].y, e1, false, false);
                        const unsigned cx = tx[0], dx = tx[1], cy = ty[0], dy = ty[1];
                        if (ai == 0 && m == 1) { dq[bj] = (u32x4){ax, ay, bx, by}; dr[bj] = (u32x4){cx, cy, dx, dy}; }
                        else {
                            if (ai == 0 && m == 3) { const size_t qd = qo - (size_t)32 * 1024; *(u32x4*)(h8 + qd) = dq[bj]; *(u32x4*)(r8 + qd) = dr[bj]; }
                            *(u32x4*)(h8 + qo) = (u32x4){ax, ay, bx, by};
                            *(u32x4*)(r8 + qo) = (u32x4){cx, cy, dx, dy}; } }
                    s += ((h0[0] * h0[0] + h0[1] * h0[1]) + (h0[2] * h0[2] + h0[3] * h0[3])) + ((h1[0] * h1[0] + h1[1] * h1[1]) + (h1[2] * h1[2] + h1[3] * h1[3])); }
                s += __shfl_xor(s, 16); s += __shfl_xor(s, 32);
                if (ai == 0 && m < 3) dsum[m] = s;
                else { if (ai == 0) { if (fq == 0) { atomicAdd(ss + r - 48, dsum[0]); atomicAdd(ss + r - 32, dsum[1]); atomicAdd(ss + r - 16, dsum[2]); } }
                       if (fq == 0) atomicAdd(ss + r, s); }
 }
    }
};
struct EpiResid {
    static constexpr bool PERM = false, AFTER_DRAIN = false;
    const float* xp; const float* xs; float* out; int split_row;
    __device__ __forceinline__ void operator()(const f32x4 (&acc)[2][2][4][2], const Unit& u, int wr, int wc, int fr, int fq) const {
        const int col0 = u.pn * BM + wc * 32 + 4 * fq;
#pragma unroll
        for (int ai = 0; ai < 2; ++ai)
#pragma unroll
            for (int m = 0; m < 4; ++m) { const int r = u.pm * BM + ai * HALF + wr * 64 + m * 16 + fr;
                const float* xr = (r < split_row ? xp + (size_t)r * 1024 : xs + (size_t)(r - split_row) * 1024) + col0; float* orow = out + (size_t)r * 1024 + col0;
#pragma unroll
                for (int bj = 0; bj < 2; ++bj)
#pragma unroll
                    for (int n = 0; n < 2; ++n) { const f32x4 bs = *(const f32x4*)(xr + bj * HALF + n * 16); *(f32x4*)(orow + bj * HALF + n * 16) = bs + acc[ai][bj][m][n]; } }
    }
};

template <class Epi, class Sched, bool ALIGN_EPI = false, bool SP2 = false, bool FP8 = false>
__device__ __forceinline__ void gemm_phase(PG8_LAS unsigned char* lds, const Gemm g, const Sched& S, const Epi& E) {
    const int tid = threadIdx.x, wid = __builtin_amdgcn_readfirstlane(tid >> 6), lane = tid & 63, wr = wid >> 2, wc = wid & 3, fr = lane & 15, fq = lane >> 4;
    const int K = g.K, nt = K / BK;
    unsigned voffA[2], voffB[2];
#pragma unroll
    for (int i = 0; i < 2; ++i) { int R, C; stage_rc(tid * 16 + i * 8192, R, C); const int Rb = Epi::PERM ? ((R & ~31) + perm32(R & 31)) : R;
        voffA[i] = (unsigned)(R * K + C) * 2u; voffB[i] = (unsigned)(Rb * K + C) * 2u; }
    const size_t kstep = (size_t)(BK * 2);
    const size_t hstep = (size_t)HALF * K * 2;
    const size_t tstep = 2 * hstep;
    const unsigned ldsw = (unsigned)wid * 1024u;
    const int aoff = lds_byte(wr * 64 + fr, fq * 8), boff = lds_byte(wc * 32 + fr, fq * 8);
#define PG8_SA(b, h) (((b) * 2 + (h)) * HTB)
#define PG8_SB(b, h) ((4 + (b) * 2 + (h)) * HTB)
#define PG8_STAGE(bufoff, gbase, voff) do { _Pragma("unroll") for (int _i = 0; _i < 2; ++_i) \
        __builtin_amdgcn_global_load_lds((const unsigned*)((const char*)(gbase) + (voff)[_i]), (PG8_LAS unsigned*)(lds + (bufoff) + ldsw + _i * 8192), 16, 0, 0); } while (0)
#define PG8_LDA(dst, b, h) do { if constexpr (FP8) { _Pragma("unroll") for (int m = 0; m < 4; ++m) dst##8[m] = __builtin_shufflevector(*(const PG8_LAS v4i_t*)(lds + PG8_SA(b, h) + aoff + m * 2048), *(const PG8_LAS v4i_t*)(lds + PG8_SA(b, h) + aoff + m * 2048 + 1024), 0, 1, 2, 3, 4, 5, 6, 7); } \
        else { _Pragma("unroll") for (int m = 0; m < 4; ++m) _Pragma("unroll") for (int k = 0; k < 2; ++k) dst[m][k] = *(const PG8_LAS bf16x8*)(lds + PG8_SA(b, h) + aoff + m * 2048 + k * 1024); } } while (0)
#define PG8_LDB(dst, b, h) do { if constexpr (FP8) { _Pragma("unroll") for (int n = 0; n < 2; ++n) dst##8[n] = __builtin_shufflevector(*(const PG8_LAS v4i_t*)(lds + PG8_SB(b, h) + boff + n * 2048), *(const PG8_LAS v4i_t*)(lds + PG8_SB(b, h) + boff + n * 2048 + 1024), 0, 1, 2, 3, 4, 5, 6, 7); } \
        else { _Pragma("unroll") for (int n = 0; n < 2; ++n) _Pragma("unroll") for (int k = 0; k < 2; ++k) dst[n][k] = *(const PG8_LAS bf16x8*)(lds + PG8_SB(b, h) + boff + n * 2048 + k * 1024); } } while (0)
#define PG8_MMA(ai, bj, At, Bt) do { __builtin_amdgcn_s_setprio(1); _Pragma("unroll") for (int m = 0; m < 4; ++m) _Pragma("unroll") for (int n = 0; n < 2; ++n) { \
        if constexpr (FP8) { asm volatile("v_mfma_scale_f32_16x16x128_f8f6f4 %0, %1, %2, %0, %3, %3 op_sel_hi:[0,0,0]" : "+v"(acc[ai][bj][m][n]) : "v"(Bt##8[n]), "v"(At##8[m]), "v"(mfma_one)); } \
        else { _Pragma("unroll") for (int k = 0; k < 2; ++k) acc[ai][bj][m][n] = __builtin_amdgcn_mfma_f32_16x16x32_bf16(Bt[n][k], At[m][k], acc[ai][bj][m][n], 0, 0, 0); } } __builtin_amdgcn_s_setprio(0); } while (0)
#define PG8_WAIT_V(n) asm volatile("s_waitcnt vmcnt(" #n ")" ::: "memory")
#define PG8_WAIT_L(n) asm volatile("s_waitcnt lgkmcnt(" #n ")" ::: "memory")
#define PG8_BAR __builtin_amdgcn_s_barrier()
#define PG8_SCHED __builtin_amdgcn_sched_barrier(0)
    Unit cur, nxt; int ui = 0;
    if (!S.next(0, cur)) return;
    f32x4 acc[2][2][4][2];
#pragma unroll
    for (int a = 0; a < 2; ++a)
#pragma unroll
        for (int b = 0; b < 2; ++b)
#pragma unroll
            for (int m = 0; m < 4; ++m)
#pragma unroll
                for (int n = 0; n < 2; ++n) acc[a][b][m][n] = (f32x4){0.f, 0.f, 0.f, 0.f};
    const int mfma_one = 0x7F7F7F7F;
    bf16x8 At[4][2], B0[2][2], B1[2][2]; v8i_t At8[4], B08[2], B18[2];
    const char* cA = (const char*)g.A + (size_t)cur.pm * tstep; const char* cB = (const char*)g.Bt + (size_t)cur.pn * tstep;
    S.a_ready(cur);
    if constexpr (SP2) {
        PG8_STAGE(PG8_SB(0, 0), cB, voffB); PG8_STAGE(PG8_SB(0, 1), cB + hstep, voffB); PG8_STAGE(PG8_SA(0, 0), cA, voffA); PG8_STAGE(PG8_SA(0, 1), cA + hstep, voffA);
        if (wr == 1) PG8_BAR;
        PG8_WAIT_V(2); PG8_BAR;
        PG8_STAGE(PG8_SB(1, 0), cB + kstep, voffB); PG8_STAGE(PG8_SA(1, 0), cA + kstep, voffA); PG8_STAGE(PG8_SB(1, 1), cB + hstep + kstep, voffB);
        PG8_WAIT_V(6); PG8_BAR;
    } else {
        PG8_STAGE(PG8_SB(0, 0), cB, voffB); PG8_STAGE(PG8_SA(0, 0), cA, voffA); PG8_STAGE(PG8_SB(0, 1), cB + hstep, voffB); PG8_STAGE(PG8_SA(0, 1), cA + hstep, voffA);
        if (wr == 1) PG8_BAR;
        PG8_WAIT_V(4); PG8_BAR;
        PG8_STAGE(PG8_SB(1, 0), cB + kstep, voffB); PG8_STAGE(PG8_SA(1, 0), cA + kstep, voffA); PG8_STAGE(PG8_SB(1, 1), cB + hstep + kstep, voffB);
        PG8_WAIT_V(6); PG8_BAR;
    }
    for (;;) {
        const bool has_next = S.next(ui + 1, nxt);
        const char* nA = has_next ? (const char*)g.A + (size_t)nxt.pm * tstep : cA; const char* nB = has_next ? (const char*)g.Bt + (size_t)nxt.pn * tstep : cB;
#pragma nounroll
        for (int t = 0; t < nt; t += 2) {
            const bool last = (t == nt - 2);
            const char* a1 = cA + (size_t)(t + 1) * kstep;
            const char* a2 = last ? nA : cA + (size_t)(t + 2) * kstep; const char* b2 = last ? nB : cB + (size_t)(t + 2) * kstep;
            const char* a3 = a2 + kstep; const char* b3 = b2 + kstep;
            if (last && has_next) S.a_ready(nxt);
            if constexpr (SP2) {
            PG8_LDB(B0, 0, 0); PG8_LDB(B1, 0, 1); PG8_SCHED; PG8_LDA(At, 0, 0); PG8_STAGE(PG8_SA(1, 1), a1 + hstep, voffA);
            PG8_WAIT_V(8); PG8_WAIT_L(0); PG8_BAR; PG8_MMA(0, 0, At, B0); PG8_MMA(0, 1, At, B1); PG8_BAR; PG8_SCHED;
            PG8_LDA(At, 0, 1); PG8_STAGE(PG8_SB(0, 0), b2, voffB); PG8_STAGE(PG8_SB(0, 1), b2 + hstep, voffB); PG8_STAGE(PG8_SA(0, 0), a2, voffA);
            PG8_WAIT_V(8); PG8_WAIT_L(0); PG8_BAR; PG8_MMA(1, 0, At, B0); PG8_MMA(1, 1, At, B1); PG8_BAR; PG8_SCHED;
            PG8_LDB(B0, 1, 0); PG8_LDB(B1, 1, 1); PG8_SCHED; PG8_LDA(At, 1, 0); PG8_STAGE(PG8_SA(0, 1), a2 + hstep, voffA);
            PG8_WAIT_V(8); PG8_WAIT_L(0); PG8_BAR; PG8_MMA(0, 0, At, B0); PG8_MMA(0, 1, At, B1); PG8_BAR; PG8_SCHED;
            PG8_LDA(At, 1, 1); PG8_STAGE(PG8_SB(1, 0), b3, voffB); PG8_STAGE(PG8_SB(1, 1), b3 + hstep, voffB); PG8_STAGE(PG8_SA(1, 0), a3, voffA);
            PG8_WAIT_V(8); PG8_WAIT_L(0); PG8_BAR; PG8_MMA(1, 0, At, B0); PG8_MMA(1, 1, At, B1); PG8_BAR; PG8_SCHED;
            } else {
            PG8_LDB(B0, 0, 0); PG8_SCHED; PG8_LDA(At, 0, 0); PG8_STAGE(PG8_SA(1, 1), a1 + hstep, voffA);
            PG8_WAIT_L(8); PG8_BAR; PG8_WAIT_L(0); PG8_MMA(0, 0, At, B0); PG8_BAR; PG8_SCHED;
            PG8_LDB(B1, 0, 1); PG8_STAGE(PG8_SB(0, 0), b2, voffB);
            PG8_BAR; PG8_WAIT_L(0); PG8_MMA(0, 1, At, B1); PG8_BAR;
            PG8_LDA(At, 0, 1); PG8_STAGE(PG8_SA(0, 0), a2, voffA);
            PG8_BAR; PG8_WAIT_L(0); PG8_MMA(1, 0, At, B0); PG8_BAR; PG8_SCHED;
            PG8_STAGE(PG8_SB(0, 1), b2 + hstep, voffB);
            PG8_WAIT_V(6); PG8_BAR; PG8_MMA(1, 1, At, B1); PG8_BAR;
            PG8_LDB(B0, 1, 0); PG8_SCHED; PG8_LDA(At, 1, 0); PG8_STAGE(PG8_SA(0, 1), a2 + hstep, voffA);
            PG8_WAIT_L(8); PG8_BAR; PG8_WAIT_L(0); PG8_MMA(0, 0, At, B0); PG8_BAR; PG8_SCHED;
            PG8_LDB(B1, 1, 1); PG8_STAGE(PG8_SB(1, 0), b3, voffB);
            PG8_BAR; PG8_WAIT_L(0); PG8_MMA(0, 1, At, B1); PG8_BAR;
            PG8_LDA(At, 1, 1); PG8_STAGE(PG8_SA(1, 0), a3, voffA);
            PG8_BAR; PG8_WAIT_L(0); PG8_MMA(1, 0, At, B0); PG8_BAR; PG8_SCHED;
            PG8_STAGE(PG8_SB(1, 1), b3 + hstep, voffB);
            PG8_WAIT_V(6); PG8_BAR; PG8_MMA(1, 1, At, B1); PG8_BAR;
            }
        }
        if constexpr (ALIGN_EPI) { if (wr == 0) PG8_BAR; }
        if constexpr (FP8) asm volatile("s_nop 15\n\ts_nop 15" ::: "memory");
        if constexpr (!Epi::AFTER_DRAIN) { E(acc, cur, wr, wc, fr, fq); S.done(cur); }
        if (!has_next) break;
#pragma unroll
        for (int a = 0; a < 2; ++a)
#pragma unroll
            for (int b = 0; b < 2; ++b)
#pragma unroll
                for (int m = 0; m < 4; ++m)
#pragma unroll
                    for (int n = 0; n < 2; ++n) acc[a][b][m][n] = (f32x4){0.f, 0.f, 0.f, 0.f};
        if constexpr (FP8) asm volatile("s_nop 7" ::: "memory");
        cur = nxt; cA = nA; cB = nB; ++ui;
        if constexpr (ALIGN_EPI) { if (wr == 1) PG8_BAR; }
    }
    PG8_WAIT_V(0);
    if constexpr (!ALIGN_EPI) { if (wr == 0) PG8_BAR; }
    PG8_BAR;
    if constexpr (Epi::AFTER_DRAIN) { E.fused(acc, cur, wr, wc, fr, fq, lds, wid, lane); S.done(cur); }
#undef PG8_SA
#undef PG8_SB
#undef PG8_STAGE
#undef PG8_LDA
#undef PG8_LDB
#undef PG8_MMA
#undef PG8_WAIT_V
#undef PG8_WAIT_L
#undef PG8_BAR
#undef PG8_SCHED
}
}


#include <hip/hip_bf16.h>
#include <cmath>
namespace attn_body {
using bf16=__hip_bfloat16;
using bf16x8=__attribute__((ext_vector_type(8)))short;
using s16x4=__attribute__((ext_vector_type(4)))short;
using f32x16=__attribute__((ext_vector_type(16)))float;
using u32x4=__attribute__((ext_vector_type(4)))unsigned;
constexpr int SEQ=2048,D=64,QP=512,KVP=64,OP=1024,KVROWS=2112;
constexpr int NW=8,QBLK=32,QB=QBLK*NW,KVBLK=64,NQB=SEQ/QB,NT=KVROWS/KVBLK;
constexpr int ATTN_UNIT_ROWS=QB;
__device__ __forceinline__ int crow(int r,int hi){return (r&3)+8*(r>>2)+4*hi;}
#define SBAR() __builtin_amdgcn_sched_barrier(0)
__device__ __forceinline__ void tmask(f32x16&p0,f32x16&p1){
  const float NEG=-INFINITY;
  #pragma unroll
  for(int r=8;r<16;++r)p0[r]=NEG;
  #pragma unroll
  for(int r=0;r<16;++r)p1[r]=NEG;
}

constexpr int NSLOT=3, SLOTB=8192;
constexpr int LDS_K=0, LDS_V=NSLOT*SLOTB, LDS_WS=2*NSLOT*SLOTB, LDS_OST=LDS_WS+NW*64*4, LDS_BYTES=LDS_OST+NW*4096;
constexpr float C2=0.125f*1.4426950408889634f;
__device__ __forceinline__ void glds16(const void*gsrc,unsigned lds_dst){unsigned keep;
  asm volatile("s_mov_b32 %0, m0\n\ts_mov_b32 m0, %2\n\ts_nop 0\n\tglobal_load_lds_dwordx4 %1, off\n\ts_mov_b32 m0, %0":"=&s"(keep):"v"(gsrc),"s"(lds_dst):"memory");}
__device__ __forceinline__ float max3f(float a,float b,float c){float r;asm("v_max3_f32 %0, %1, %2, %3":"=v"(r):"v"(a),"v"(b),"v"(c));return r;}
__device__ __forceinline__ float max2f(float a,float b){float r;asm("v_max_f32_e32 %0, %1, %2":"=v"(r):"v"(a),"v"(b));return r;}
__device__ __forceinline__ float fadd_s(float a,float b){float r;asm("v_add_f32_e32 %0, %1, %2":"=v"(r):"v"(a),"v"(b));return r;}
__device__ __forceinline__ float fsub_s(float a,float b){float r;asm("v_sub_f32_e32 %0, %1, %2":"=v"(r):"v"(a),"v"(b));return r;}
typedef float f32x2_t __attribute__((ext_vector_type(2))); typedef float f32x4_t __attribute__((ext_vector_type(4))); typedef __bf16 bf16x2_t __attribute__((ext_vector_type(2)));
__device__ __forceinline__ unsigned cvtpk_s(float lo,float hi){f32x2_t v={lo,hi};bf16x2_t b=__builtin_convertvector(v,bf16x2_t);return __builtin_bit_cast(unsigned,b);}
#define WAIT_BAR(N) asm volatile("s_waitcnt vmcnt(" #N ") lgkmcnt(0)\n\ts_barrier":::"memory")

__device__ __forceinline__ void qkt(f32x16&p0,f32x16&p1,const char*Kslot,const bf16x8*qr,const f32x16&negm,int r32,int hi){
  const char*kb=Kslot+hi*1024+r32*16;
  #pragma unroll
  for(int d0=0;d0<4;++d0){
    const bf16x8 b0=*reinterpret_cast<const bf16x8*>(kb+d0*2048);
    const bf16x8 b1=*reinterpret_cast<const bf16x8*>(kb+d0*2048+512);
    if(d0==0){p0=__builtin_amdgcn_mfma_f32_32x32x16_bf16(b0,qr[0],negm,0,0,0);p1=__builtin_amdgcn_mfma_f32_32x32x16_bf16(b1,qr[0],negm,0,0,0);}
    else{p0=__builtin_amdgcn_mfma_f32_32x32x16_bf16(b0,qr[d0],p0,0,0,0);p1=__builtin_amdgcn_mfma_f32_32x32x16_bf16(b1,qr[d0],p1,0,0,0);}}
}
typedef __attribute__((address_space(3))) const char* lds_cptr;
typedef short v4i16_t __attribute__((ext_vector_type(4)));
__device__ __forceinline__ void kload8(bf16x8*kf,lds_cptr kp){
  kf[0]=*(const __attribute__((address_space(3))) bf16x8*)(kp);      kf[1]=*(const __attribute__((address_space(3))) bf16x8*)(kp+512);
  kf[2]=*(const __attribute__((address_space(3))) bf16x8*)(kp+2048); kf[3]=*(const __attribute__((address_space(3))) bf16x8*)(kp+2560);
  kf[4]=*(const __attribute__((address_space(3))) bf16x8*)(kp+4096); kf[5]=*(const __attribute__((address_space(3))) bf16x8*)(kp+4608);
  kf[6]=*(const __attribute__((address_space(3))) bf16x8*)(kp+6144); kf[7]=*(const __attribute__((address_space(3))) bf16x8*)(kp+6656);
}
__device__ __forceinline__ void kload2(bf16x8*kf,lds_cptr kp,int j){ kf[2*j]=*(const __attribute__((address_space(3))) bf16x8*)(kp+j*2048); kf[2*j+1]=*(const __attribute__((address_space(3))) bf16x8*)(kp+j*2048+512); }
__device__ __forceinline__ s16x4 vtr(lds_cptr p){ return __builtin_bit_cast(s16x4,__builtin_amdgcn_ds_read_tr16_b64_v4i16((__attribute__((address_space(3))) v4i16_t*)p)); }
__device__ __forceinline__ float rowmax(const f32x16&p0,const f32x16&p1){
  float a=max3f(p0[0],p0[1],p1[0]),b=max3f(p0[2],p0[3],p1[1]);a=max3f(a,p1[2],p1[3]);
  #pragma unroll
  for(int r=4;r<16;r+=4){a=max3f(a,p0[r],p0[r+1]);b=max3f(b,p0[r+2],p0[r+3]);a=max3f(a,p1[r],p1[r+1]);b=max3f(b,p1[r+2],p1[r+3]);}
  const float m=max2f(a,b);
  auto rr=__builtin_amdgcn_permlane32_swap(__float_as_uint(m),__float_as_uint(m),false,false);
  return max2f(__uint_as_float(rr[0]),__uint_as_float(rr[1]));
}
__device__ __forceinline__ void pv(f32x16*o,int vb,bf16x8 pa0,bf16x8 pa1,bf16x8 pa2,bf16x8 pa3){
  #pragma unroll
  for(int d0=0;d0<2;++d0){s16x4 lo[4],hi[4];
    #pragma unroll
    for(int ks=0;ks<4;++ks){
      asm volatile("ds_read_b64_tr_b16 %0,%1 offset:%c2":"=&v"(lo[ks]):"v"(vb),"i"(d0*4096+ks*1024):"memory");
      asm volatile("ds_read_b64_tr_b16 %0,%1 offset:%c2":"=&v"(hi[ks]):"v"(vb),"i"(d0*4096+ks*1024+512):"memory");}
    asm volatile("s_waitcnt lgkmcnt(0)":::"memory");SBAR();
    #define PK(k) (bf16x8){lo[k][0],lo[k][1],lo[k][2],lo[k][3],hi[k][0],hi[k][1],hi[k][2],hi[k][3]}
    o[d0]=__builtin_amdgcn_mfma_f32_32x32x16_bf16(pa0,PK(0),o[d0],0,0,0);
    o[d0]=__builtin_amdgcn_mfma_f32_32x32x16_bf16(pa1,PK(1),o[d0],0,0,0);
    o[d0]=__builtin_amdgcn_mfma_f32_32x32x16_bf16(pa2,PK(2),o[d0],0,0,0);
    o[d0]=__builtin_amdgcn_mfma_f32_32x32x16_bf16(pa3,PK(3),o[d0],0,0,0);
    #undef PK
  }
}

#ifndef ATTN_STORE16
#define ATTN_STORE16(p,v) (*(u32x4*)(p)=(v))
#endif
template<int THRL> __device__ __forceinline__ void attn_unit(int b,int h,int qb,const bf16*Q,const bf16*__restrict__ K,const bf16*__restrict__ V,bf16*O,const float*__restrict__ gain,char*shm){
  const int tid=threadIdx.x,lane=tid&63,r32=lane&31,hi=lane>>5; const int wid=__builtin_amdgcn_readfirstlane(tid>>6);
  const long rowbase=(long)b*SEQ; const int q0=qb*QB;
  const bf16*Qw=Q+(rowbase+q0+wid*QBLK)*QP+h*D;
  const bf16*Kh=K+(long)(b*2+(h>>2))*KVROWS*KVP,*Vh=V+(long)(b*2+(h>>2))*KVROWS*KVP;
  const unsigned lds0=(unsigned)(uintptr_t)shm;
  float*wsf=(float*)(shm+LDS_WS)+wid*64;
  const bf16*ksrc=Kh+(long)lane*KVP+wid*8;
  const bf16*vsrc=Vh+(long)(16*(wid&3)+(lane>>2))*KVP+(wid>>2)*32+(lane&3)*8;
  const unsigned kdst=lds0+LDS_K+wid*1024, vdst=lds0+LDS_V+wid*1024;
  #define DMA_K(t,slot) glds16(ksrc+(long)(t)*KVBLK*KVP,(unsigned)__builtin_amdgcn_readfirstlane(kdst+(slot)))
  #define DMA_V(t,slot) glds16(vsrc+(long)(t)*KVBLK*KVP,(unsigned)__builtin_amdgcn_readfirstlane(vdst+(slot)))
  const int vb0=(int)(lds0+LDS_V)+((lane>>4)&1)*32+(lane&3)*8+(4*hi+((lane&15)>>2))*64;
  const char*Kbase=shm+LDS_K; bf16x8 kf[8];
  const lds_cptr shm3=(lds_cptr)shm; const lds_cptr kp0=shm3+LDS_K+hi*1024+r32*16; const lds_cptr vp0=shm3+LDS_V+((lane>>4)&1)*32+(lane&3)*8+(4*hi+((lane&15)>>2))*64;
  DMA_K(0,0);DMA_V(0,0);DMA_K(1,SLOTB);
  bf16x8 qr[4];
  #pragma unroll
  for(int d0=0;d0<4;++d0)qr[d0]=*reinterpret_cast<const bf16x8*>(&Qw[(long)r32*QP+d0*16+hi*8]);
  float mhat=0.f,l_reg=0.f;f32x16 o[2];o[0]=f32x16{};o[1]=f32x16{};f32x16 negm=f32x16{};asm volatile("":"+v"(negm));
  #define CMASK(P0,P1,t) do{}while(0)
  bool resc=false;
  #define START(P0,P1) do{ const float rm=rowmax(P0,P1); resc=false; \
    { const float dl=rm; mhat=fadd_s(mhat,dl); \
      _Pragma("unroll") for(int r=0;r<16;++r){P0[r]=fsub_s(P0[r],dl);P1[r]=fsub_s(P1[r],dl);} \
      _Pragma("unroll") for(int r=0;r<16;++r)negm[r]=-mhat; asm volatile("":"+v"(negm)); } \
    _Pragma("unroll") for(int r=0;r<16;++r)P0[r]=__builtin_amdgcn_exp2f(P0[r]); }while(0)
  #define RESC() do{ if(resc){ asm volatile("s_waitcnt lgkmcnt(0)":::"memory"); \
      _Pragma("unroll") for(int d_=0;d_<2;++d_) _Pragma("unroll") for(int r=0;r<16;++r)o[d_][r]*=wsf[crow(r,hi)]; } }while(0)
  f32x16 pA0,pA1,pB0,pB1;
  int sl_prev=0,sl_cur=0,sl_next=SLOTB;
  #define ROT() do{sl_prev=sl_cur;sl_cur=sl_next;sl_next=(sl_next==(NSLOT-1)*SLOTB)?0:sl_next+SLOTB;}while(0)
  DMA_K(2,2*SLOTB);
  WAIT_BAR(3);
  qkt(pA0,pA1,Kbase,qr,negm,r32,hi);asm volatile("s_nop 15\n\ts_nop 7":"+v"(pA0),"+v"(pA1));CMASK(pA0,pA1,0);
  START(pA0,pA1);
  _Pragma("unroll") for(int r=0;r<16;++r)pA1[r]=__builtin_amdgcn_exp2f(pA1[r]);
  WAIT_BAR(0);
  DMA_K(3,0);DMA_V(1,SLOTB);
  ROT();
  kload8(kf,kp0+sl_cur);
  WAIT_BAR(2);
  s16x4 vlo[8],vhi[8]; u32x4 pw0,pw1,pw2,pw3;
  #define PKW(P,B) cvtpk_s(P[B],P[B+1])
  #define PAF(k) __builtin_bit_cast(bf16x8,pw##k)
  #define VFR(i) (bf16x8){vlo[i][0],vlo[i][1],vlo[i][2],vlo[i][3],vhi[i][0],vhi[i][1],vhi[i][2],vhi[i][3]}
  #define PIN(x) asm volatile("":"+v"(x))
  #define MX3(a,b,c) __builtin_fmaxf(__builtin_fmaxf((a),(b)),(c))
  #define GAPA(MF,A0,A1,A2,A3,W0,W1,PW) do{ MF; sacc+=A0; sacc+=A1; sacc+=A2; sacc+=A3; PIN(sacc); W0; W1; PIN(PW); SBAR(); }while(0)
  #define EX(v) __builtin_amdgcn_exp2f(v)
  #define GAPB(MF,X,B) do{ MF; X[B]=EX(X[B]); X[B+1]=EX(X[B+1]); X[B+2]=EX(X[B+2]); X[B+3]=EX(X[B+3]); PIN(X); SBAR(); }while(0)
  #define VRD(i) do{ vlo[i]=vtr(vp_+(((i)>>2)*4096+((i)&3)*1024)); vhi[i]=vtr(vp_+(((i)>>2)*4096+((i)&3)*1024+512)); }while(0)
  #define KRD(G,j) do{ if(G){ kload2(kf,kp0+sl_next,j); SBAR(); } }while(0)
  #define STEP(C0,C1,P0,P1,t,GK,GV,GL) do{ SBAR(); \
    const lds_cptr vp_=vp0+sl_prev; \
    VRD(0); SBAR(); float sacc=(P0[0]+P0[1]); \
    GAPA(C0=__builtin_amdgcn_mfma_f32_32x32x16_bf16(kf[0],qr[0],negm,0,0,0), P0[2],P0[3],P0[4],P0[5],     pw0[0]=PKW(P0,0), pw0[1]=PKW(P0,2), pw0); \
    VRD(4); SBAR(); GAPA(C1=__builtin_amdgcn_mfma_f32_32x32x16_bf16(kf[1],qr[0],negm,0,0,0), P0[6],P0[7],P0[8],P0[9],     pw0[2]=PKW(P0,4), pw0[3]=PKW(P0,6), pw0); \
    VRD(1); SBAR(); GAPA(C0=__builtin_amdgcn_mfma_f32_32x32x16_bf16(kf[2],qr[1],C0,0,0,0),   P0[10],P0[11],P0[12],P0[13], pw1[0]=PKW(P0,8), pw1[1]=PKW(P0,10), pw1); \
    VRD(5); SBAR(); GAPA(C1=__builtin_amdgcn_mfma_f32_32x32x16_bf16(kf[3],qr[1],C1,0,0,0),   P0[14],P0[15],P1[0],P1[1],   pw1[2]=PKW(P0,12),pw1[3]=PKW(P0,14), pw1); \
    VRD(2); SBAR(); GAPA(C0=__builtin_amdgcn_mfma_f32_32x32x16_bf16(kf[4],qr[2],C0,0,0,0),   P1[2],P1[3],P1[4],P1[5],     pw2[0]=PKW(P1,0), pw2[1]=PKW(P1,2), pw2); \
    VRD(6); SBAR(); GAPA(C1=__builtin_amdgcn_mfma_f32_32x32x16_bf16(kf[5],qr[2],C1,0,0,0),   P1[6],P1[7],P1[8],P1[9],     pw2[2]=PKW(P1,4), pw2[3]=PKW(P1,6), pw2); \
    VRD(3); SBAR(); GAPA(C0=__builtin_amdgcn_mfma_f32_32x32x16_bf16(kf[6],qr[3],C0,0,0,0),   P1[10],P1[11],P1[12],P1[13], pw3[0]=PKW(P1,8), pw3[1]=PKW(P1,10), pw3); \
    VRD(7); SBAR(); GAPA(C1=__builtin_amdgcn_mfma_f32_32x32x16_bf16(kf[7],qr[3],C1,0,0,0),   P1[14],P1[15],0.f,0.f,       pw3[2]=PKW(P1,12),pw3[3]=PKW(P1,14), pw3); \
    l_reg+=sacc; \
    if(GK){DMA_K((t)+3,sl_cur);} if(GV){DMA_V((t)+1,sl_next);} \
    CMASK(C0,C1,t); \
    { float a=MX3(C0[0],C0[1],C1[0]),b=MX3(C0[2],C0[3],C1[1]); a=MX3(a,C1[2],C1[3]); \
      _Pragma("unroll") for(int r=4;r<16;r+=4){a=MX3(a,C0[r],C0[r+1]);b=MX3(b,C0[r+2],C0[r+3]);a=MX3(a,C1[r],C1[r+1]);b=MX3(b,C1[r+2],C1[r+3]);} \
      float rm=__builtin_fmaxf(a,b); { auto rr=__builtin_amdgcn_permlane32_swap(__float_as_uint(rm),__float_as_uint(rm),false,false); rm=__builtin_fmaxf(__uint_as_float(rr[0]),__uint_as_float(rr[1])); } \
      resc=false; \
      if(__builtin_expect(__any(rm>(float)THRL),0)){ const float dl=__builtin_fmaxf(rm,0.f); mhat+=dl; \
        _Pragma("unroll") for(int r=0;r<16;++r){C0[r]-=dl;C1[r]-=dl;} \
        _Pragma("unroll") for(int r=0;r<16;++r)negm[r]=-mhat; asm volatile("":"+v"(negm)); \
        const float f=__builtin_amdgcn_exp2f(-dl); l_reg*=f; if(hi==0)wsf[r32]=f; resc=true; } } \
    SBAR(); \
    GAPB(o[0]=__builtin_amdgcn_mfma_f32_32x32x16_bf16(PAF(0),VFR(0),o[0],0,0,0), C0,0); \
    GAPB(o[1]=__builtin_amdgcn_mfma_f32_32x32x16_bf16(PAF(0),VFR(4),o[1],0,0,0), C0,4); \
    KRD(GL,0); GAPB(o[0]=__builtin_amdgcn_mfma_f32_32x32x16_bf16(PAF(1),VFR(1),o[0],0,0,0), C0,8); \
    KRD(GL,1); GAPB(o[1]=__builtin_amdgcn_mfma_f32_32x32x16_bf16(PAF(1),VFR(5),o[1],0,0,0), C0,12); \
    KRD(GL,2); GAPB(o[0]=__builtin_amdgcn_mfma_f32_32x32x16_bf16(PAF(2),VFR(2),o[0],0,0,0), C1,0); \
    KRD(GL,3); GAPB(o[1]=__builtin_amdgcn_mfma_f32_32x32x16_bf16(PAF(2),VFR(6),o[1],0,0,0), C1,4); \
    GAPB(o[0]=__builtin_amdgcn_mfma_f32_32x32x16_bf16(PAF(3),VFR(3),o[0],0,0,0), C1,8); \
    GAPB(o[1]=__builtin_amdgcn_mfma_f32_32x32x16_bf16(PAF(3),VFR(7),o[1],0,0,0), C1,12); \
    }while(0)
  int t=1;
  #undef CMASK
  #define CMASK(P0,P1,t) do{}while(0)
  for(;t+5<NT;t+=2){
    STEP(pB0,pB1,pA0,pA1,t,true,true,true);     WAIT_BAR(2); RESC(); ROT();
    STEP(pA0,pA1,pB0,pB1,t+1,true,true,true);   WAIT_BAR(2); RESC(); ROT();
  }
  #undef CMASK
  #define CMASK(P0,P1,t) do{ if((t)==NT-1)tmask(P0,P1); }while(0)
  #define ENDW(tt) do{ if((tt)+3<NT){WAIT_BAR(2);} else if((tt)+2<NT){WAIT_BAR(1);} else {WAIT_BAR(0);} }while(0)
  for(;t+1<NT;t+=2){
    STEP(pB0,pB1,pA0,pA1,t,(t+3<NT),(t+1<NT),(t+1<NT));       ENDW(t);   RESC(); ROT();
    STEP(pA0,pA1,pB0,pB1,t+1,(t+4<NT),(t+2<NT),(t+2<NT));     ENDW(t+1); RESC(); ROT();
  }
  static_assert((NT&1)==1&&NT>=7,"odd tile count: the pair loops end on tile NT-1 (scores in buffer A)");
  { float sacc=pA0[0]+pA0[1]; _Pragma("unroll") for(int r=2;r<16;++r)sacc+=pA0[r]; _Pragma("unroll") for(int r=0;r<16;++r)sacc+=pA1[r]; l_reg+=sacc;
    pw0=(u32x4){PKW(pA0,0),PKW(pA0,2),PKW(pA0,4),PKW(pA0,6)};pw1=(u32x4){PKW(pA0,8),PKW(pA0,10),PKW(pA0,12),PKW(pA0,14)};pw2=(u32x4){PKW(pA1,0),PKW(pA1,2),PKW(pA1,4),PKW(pA1,6)};pw3=(u32x4){PKW(pA1,8),PKW(pA1,10),PKW(pA1,12),PKW(pA1,14)};
    SBAR(); pv(o,vb0+sl_prev,PAF(0),PAF(1),PAF(2),PAF(3)); }
  #undef PKW
  #undef PAF
  #undef VFR
  #undef PIN
  #undef MX3
  #undef GAPA
  #undef GAPB
  #undef EX
  #undef VRD
  #undef KRD
  #undef STEP
  #undef ENDW
  {auto rr=__builtin_amdgcn_permlane32_swap(__float_as_uint(l_reg),__float_as_uint(l_reg),false,false);l_reg=__uint_as_float(rr[0])+__uint_as_float(rr[1]);}
  if(hi==0)wsf[32+r32]=l_reg;asm volatile("s_waitcnt lgkmcnt(0)":::"memory");
  float rli[16];
  #pragma unroll
  for(int r=0;r<16;++r)rli[r]=__builtin_amdgcn_rcpf(wsf[32+crow(r,hi)]);
  bf16*Ow=O+(rowbase+q0+wid*QBLK)*OP+h*D;
  { bf16*stg=(bf16*)(shm+LDS_OST)+wid*2048;
    #pragma unroll
    for(int r=0;r<16;++r){const int orow=crow(r,hi);
      #pragma unroll
      for(int d0=0;d0<2;++d0)stg[orow*64+d0*32+r32]=__float2bfloat16(o[d0][r]*rli[r]);}
    asm volatile("s_waitcnt lgkmcnt(0)":::"memory");
    #pragma unroll
    for(int i=0;i<4;++i){const int row=i*8+(lane>>3),ch=lane&7; const u32x4 v=*(const u32x4*)(stg+row*64+ch*8);
      float f[8]; f[0]=__uint_as_float(v.x<<16);f[1]=__uint_as_float(v.x&0xffff0000u);f[2]=__uint_as_float(v.y<<16);f[3]=__uint_as_float(v.y&0xffff0000u);
      f[4]=__uint_as_float(v.z<<16);f[5]=__uint_as_float(v.z&0xffff0000u);f[6]=__uint_as_float(v.w<<16);f[7]=__uint_as_float(v.w&0xffff0000u);
      float ss=0.f; _Pragma("unroll") for(int j=0;j<8;++j)ss+=f[j]*f[j];
      ss+=__shfl_xor(ss,1);ss+=__shfl_xor(ss,2);ss+=__shfl_xor(ss,4);
      const float rs=1.0f/sqrtf(ss*(1.0f/64.0f)+1e-6f); const f32x4_t g0=*(const f32x4_t*)(gain+h*D+ch*8),g1=*(const f32x4_t*)(gain+h*D+ch*8+4);
      u32x4 w; w[0]=cvtpk_s(f[0]*rs*g0[0],f[1]*rs*g0[1]);w[1]=cvtpk_s(f[2]*rs*g0[2],f[3]*rs*g0[3]);w[2]=cvtpk_s(f[4]*rs*g1[0],f[5]*rs*g1[1]);w[3]=cvtpk_s(f[6]*rs*g1[2],f[7]*rs*g1[3]);
      ATTN_STORE16(Ow+(long)row*OP+ch*8,w);} }
  asm volatile("s_waitcnt lgkmcnt(0)\n\ts_barrier":::"memory");
  #undef DMA_K
  #undef DMA_V
  #undef CMASK
  #undef START
  #undef RESC
  #undef ROT
}
constexpr int ATTN_LDS_BYTES=LDS_BYTES;
struct AttnTensors { const bf16* Q; const bf16* K; const bf16* V; bf16* O; const float* gain; };
struct AttnUnit { int b; int h; int qb; };
struct StaticOrder {
  int vcu;
  __device__ __forceinline__ explicit StaticOrder(int grid_,int block):vcu((grid_%8==0)?(block%8)*(grid_/8)+block/8:block),grid(grid_){}
  int grid;
  __device__ __forceinline__ bool next(int i,AttnUnit&u)const{ const int n=i*grid+vcu,pair=n>>5; if(pair>=48)return false; const int s=n&31; u.b=pair>>1; u.h=4*(pair&1)+(s>>3); u.qb=s&7; return true; }
};
template<class Sched,class Side,int THRL=8> __device__ __forceinline__ void attn_phase(char*lds,const AttnTensors&T,const Sched&S,int kside,const Side&side){
  AttnUnit u; int i=0;
  for(;i<kside&&S.next(i,u);++i){ attn_unit<THRL>(u.b,u.h,u.qb,T.Q,T.K,T.V,T.O,T.gain,lds); }
  side();
  for(;S.next(i,u);++i){ attn_unit<THRL>(u.b,u.h,u.qb,T.Q,T.K,T.V,T.O,T.gain,lds); }
}
#undef SBAR
#undef WAIT_BAR
}

typedef __attribute__((address_space(1))) unsigned gu32;
#define XB_TMO      128
#define XB_XCNT(j)  (256  + 64 * (j))
#define XB_XSUB(j)  (1280 + 64 * (j))
#define XB_XGEN(j)  (2304 + 64 * (j))
#define XB_TOP      3328
#define XB_TOPGEN   3392
#define XCD_BAR_WORDS 3456
#define XB_SPIN_CAP (1u << 18)

__device__ __forceinline__ unsigned xb_ld(unsigned* p)              { return __hip_atomic_load(p, __ATOMIC_RELAXED, __HIP_MEMORY_SCOPE_AGENT); }
__device__ __forceinline__ unsigned xb_add(unsigned* p, unsigned v) { return __hip_atomic_fetch_add(p, v, __ATOMIC_RELAXED, __HIP_MEMORY_SCOPE_AGENT); }
__device__ __forceinline__ unsigned xb_xcc_id() { return (unsigned)__builtin_amdgcn_s_getreg((3 << 11) | 20) & 0xFu; }
#define XB_SPIN(cond, bar) do { unsigned _sp = 0; while (cond) { __builtin_amdgcn_s_sleep(1); \
    if ((++_sp & 255u) == 0u) { if (xb_ld(&(bar)[XB_TMO])) break; if (_sp > XB_SPIN_CAP) { atomicAdd(&(bar)[XB_TMO], 1u); break; } } } } while (0)

struct XcdBarrier {
    unsigned* bar; unsigned x;
    volatile LAS unsigned* st;
};

__device__ __forceinline__ XcdBarrier xcd_barrier_post(unsigned* bar, volatile LAS unsigned* st) {
    XcdBarrier b; b.bar = bar; b.x = xb_xcc_id(); b.st = st;
    if (threadIdx.x == 0) (void)xb_add(&bar[XB_XCNT(b.x)], 1u);
    return b;
}
__device__ __forceinline__ void xcd_barrier_complete(unsigned* bar, unsigned x, unsigned& nloc, unsigned& nx) {
    const unsigned G = gridDim.x * gridDim.y * gridDim.z;
    unsigned sum, cnt, mine, sp = 0u;
    for (;;) {
        sum = 0u; cnt = 0u; mine = 0u;
#pragma unroll
        for (unsigned j = 0; j < 16; ++j) { const unsigned c = xb_ld(&bar[XB_XCNT(j)]); sum += c; cnt += (c > 0u) ? 1u : 0u; mine = (j == x) ? c : mine; }
        if (sum == G) break;
        __builtin_amdgcn_s_sleep(1);
        if ((++sp & 255u) == 0u) { if (xb_ld(&bar[XB_TMO])) break; if (sp > XB_SPIN_CAP) { atomicAdd(&bar[XB_TMO], 1u); break; } }
    }
    nloc = mine > 0u ? mine : 1u; nx = cnt > 0u ? cnt : 1u;
}

__device__ __forceinline__ void xcd_barrier(const XcdBarrier& b) {
    asm volatile("s_waitcnt vmcnt(0)" ::: "memory");
    __syncthreads();
    if (threadIdx.x == 0) {
        unsigned* bar = b.bar;
        __builtin_amdgcn_s_waitcnt(0);
        unsigned nloc = b.st[0], nx = b.st[1];
        if (nloc == 0u) { xcd_barrier_complete(bar, b.x, nloc, nx); b.st[0] = nloc; b.st[1] = nx; }
        const unsigned old = xb_add(&bar[XB_XSUB(b.x)], 1u);
        const unsigned gen = old / nloc;
        if (old + 1u == (gen + 1u) * nloc) {
            __builtin_amdgcn_fence(__ATOMIC_RELEASE, "agent");
            asm volatile("s_waitcnt vmcnt(0)" ::: "memory");
            const unsigned og = xb_add(&bar[XB_TOP], 1u);
            const unsigned tg = og / nx;
            if (og + 1u == (tg + 1u) * nx) xb_add(&bar[XB_TOPGEN], 1u);
            else XB_SPIN(xb_ld(&bar[XB_TOPGEN]) == tg, bar);
            __builtin_amdgcn_fence(__ATOMIC_ACQUIRE, "agent");
            xb_add(&bar[XB_XGEN(b.x)], 1u);
            asm volatile("s_waitcnt vmcnt(0)" ::: "memory");
        } else {
            XB_SPIN(xb_ld(&bar[XB_XGEN(b.x)]) == gen, bar);
            __builtin_amdgcn_fence(__ATOMIC_ACQUIRE, "agent");
            asm volatile("s_waitcnt vmcnt(0)" ::: "memory");
        }
    }
    __syncthreads();
}


__global__ void __launch_bounds__(NTHR, 2) enc_fwd(Args a) {
    extern __shared__ __attribute__((aligned(16))) unsigned char lds[];
    cg::grid_group grid = cg::this_grid();
    const int tid = threadIdx.x, lane = tid & 63, wave = __builtin_amdgcn_readfirstlane(tid >> 6);
    const int G = gridDim.x, gw = blockIdx.x * NWAVES + wave, NGW = G * NWAVES;
    const int lo = a.ph_lo, hi = a.ph_hi;
    volatile LAS unsigned* MISC = (volatile LAS unsigned*)((LAS unsigned char*)lds + LDS_BYTES - 64);
    if (tid < 16) MISC[tid] = 0u;
    __syncthreads();
    (void)xcd_barrier_post((unsigned*)(a.ws + WS_CTL) + 4096, MISC);
#define IN(k) (lo <= (k) && (k) < hi)
#ifndef PROBE_X2
#define PROBE_X2 -1
#endif
#define REP(k) for (int rep_ = 0; rep_ < ((k) == PROBE_X2 ? 2 : 1); ++rep_)
#define SEAM(k) do { if (IN(k) && IN((k) + 1)) { if (lo > 1000) grid.sync();   { XcdBarrier bar_; bar_.bar = (unsigned*)(a.ws + WS_CTL) + 4096; bar_.x = xb_xcc_id(); bar_.st = MISC; xcd_barrier(bar_); } } } while (0)
    if (IN(0)) REP(0) { p0_prologue(a, lds, tid, lane, wave); } SEAM(0);
    if (IN(1)) REP(1) { pg8::Gemm g{(const bf16_t*)(a.ws + WS_XA), (const bf16_t*)(a.ws + WS_WIN), NTOK, INW, DM}; pg8::StaticOrder S; S.init(NTOK, INW, G, (int)blockIdx.x);
        pg8::EpiInProj E{(bf16_t*)(a.ws + WS_Z), (bf16_t*)(a.ws + WS_Q), (bf16_t*)(a.ws + WS_KB), (bf16_t*)(a.ws + WS_VB), (const float*)(a.ws + WS_ROPE), a.qg, a.kg};
        const int nwg1 = (NTOK / 256) * (INW / 256), rounds1 = (nwg1 + G - 1) / G, nfull1 = nwg1 - (rounds1 - 1) * G;
        if (nfull1 >= G) kv_meta_rows(a, lane, gw, NGW);
        pg8::gemm_phase<pg8::EpiInProj, pg8::StaticOrder, true, true>((LAS unsigned char*)lds, g, S, E);
        if (nfull1 < G && (int)blockIdx.x >= nfull1) kv_meta_rows(a, lane, ((int)blockIdx.x - nfull1) * NWAVES + wave, (G - nfull1) * NWAVES); } SEAM(1);
    if (IN(3)) REP(3) { const attn_body::AttnTensors AT{(const attn_body::bf16*)(a.ws + WS_Q), (const attn_body::bf16*)(a.ws + WS_KB), (const attn_body::bf16*)(a.ws + WS_VB), (attn_body::bf16*)(a.ws + WS_XA) + 512, a.attn_g};
        const attn_body::StaticOrder S(G, (int)blockIdx.x);
        auto side = [&]() { p2_pass(a, lane, gw, NGW);
            __syncthreads(); };
        attn_body::attn_phase<attn_body::StaticOrder>((char*)lds, AT, S, (int)((blockIdx.x >> 3) * 6) >> 5, side); } SEAM(3);
    if (IN(4)) REP(4) { pg8::Gemm g{(const bf16_t*)(a.ws + WS_XA), (const bf16_t*)(a.ws + WS_WOUT), NTOK, DM, DM}; pg8::StaticOrder S; S.init(NTOK, DM, G, (int)blockIdx.x);
        pg8::EpiResidNorm E{a.xp, a.xs, a.out, NBP * SEQ, a.ws + WS_R8, a.ws + WS_X8, (float*)(a.ws + WS_SS), X8SCALE};
        pg8::gemm_phase<pg8::EpiResidNorm, pg8::StaticOrder, true, true>((LAS unsigned char*)lds, g, S, E); } SEAM(4);
    if (IN(6)) REP(6) { pg8::Gemm g{(const bf16_t*)(a.ws + WS_X8), (const bf16_t*)(a.ws + WS_WQ), NTOK, PQ, DM / 2}; pg8::StaticOrder S; S.init(NTOK, PQ, G, (int)blockIdx.x);
        pg8::EpiBf16 E{(bf16_t*)(a.ws + WS_QP), PQ, 1.0f / (X8SCALE * WQSCALE)};
        pg8::gemm_phase<pg8::EpiBf16, pg8::StaticOrder, true, true, true>((LAS unsigned char*)lds, g, S, E); } SEAM(6);
    if (IN(7)) REP(7) { p7_topk(a, lds, tid, lane, wave);
        table_fp4<false>(a.pu, a.ws + WS_UT, (float*)(a.ws + WS_USC), a.g_ffn, gw, NGW, lane);
        table_fp4<true>(a.pv, a.ws + WS_UT + 4 * SLICE4, (float*)(a.ws + WS_VSC), nullptr, gw, NGW, lane);
        __syncthreads(); } SEAM(7);
    if (IN(8)) REP(8) { p8a_u(a, lane, wave); } SEAM(8);
    if (IN(9)) REP(9) { p8c_combine(a, lds, tid); __syncthreads(); } SEAM(9);
    if (IN(10)) REP(10) { p8b_v(a, lds, lane, wave, rep_ == ((10 == PROBE_X2) ? 1 : 0)); }
#undef IN
#undef SEAM
}

extern "C" void kernel_launch(void* const* d_in, const int* in_sizes, int n_in, void* d_out, int out_size, void* d_ws, size_t ws_size, hipStream_t stream) {
    static int grid = 0;
    if (grid == 0) {
        if (n_in != 16 || out_size != NTOK * DM || ws_size < WS_END) { fprintf(stderr, "kernel_launch: unexpected shapes (n_in %d out %d ws %zu)\n", n_in, out_size, ws_size); grid = -1; return; }
        int dev = 0, cus = 0, per_cu = 0;
        (void)hipGetDevice(&dev); (void)hipDeviceGetAttribute(&cus, hipDeviceAttributeMultiprocessorCount, dev);
        (void)hipFuncSetAttribute((const void*)enc_fwd, hipFuncAttributeMaxDynamicSharedMemorySize, LDS_BYTES);
        (void)hipOccupancyMaxActiveBlocksPerMultiprocessor(&per_cu, (const void*)enc_fwd, NTHR, LDS_BYTES);
        if (per_cu < 1) { fprintf(stderr, "kernel_launch: occupancy query says %d blocks/CU\n", per_cu); per_cu = 1; }
        (void)hipGetLastError();
        grid = cus * 1;
    }
    if (grid < 0) return;
    (void)hipMemsetAsync((char*)d_ws + WS_CTL, 0, 64 * 1024, stream);
    Args a{};
    a.xp = (const float*)d_in[0]; a.xs = (const float*)d_in[1]; a.meta = (const float*)d_in[2]; a.g_mix = (const float*)d_in[3]; a.w_in = (const float*)d_in[4];
    a.conv_w = (const float*)d_in[5]; a.qg = (const float*)d_in[6]; a.kg = (const float*)d_in[7]; a.conv_g = (const float*)d_in[8]; a.attn_g = (const float*)d_in[9];
    a.w_out = (const float*)d_in[10]; a.g_ffn = (const float*)d_in[11]; a.wq = (const float*)d_in[12]; a.subk = (const float*)d_in[13]; a.pu = (const float*)d_in[14]; a.pv = (const float*)d_in[15];
    a.out = (float*)d_out; a.ws = (unsigned char*)d_ws;
    constexpr int NL = MK_N_LAUNCHES;
    for (int li = 0; li < NL; ++li) {
        a.ph_lo = (NL == 1) ? 0 : li; a.ph_hi = (NL == 1) ? NPHASE : li + 1;
        void* args[] = {&a};
        hipError_t e = hipLaunchCooperativeKernel((const void*)enc_fwd, dim3(grid), dim3(NTHR), args, LDS_BYTES, stream);
        if (e != hipSuccess) { fprintf(stderr, "kernel_launch: launch %d failed: %s\n", li, hipGetErrorString(e)); break; }
    }
}
```
